# Optimizing an MI355X kernel written in HIP

```python
import math
import jax
import jax.numpy as jnp
from jax import lax
import numpy as np


D_MODEL = 2048
BATCH = 4
SEQ = 4096
DEPTH = 1

HYENA_WIDTH = 1024
HYENA_ORDER = 2
HYENA_EMB = 33
HYENA_FILTER_HIDDEN = 64
HYENA_FAST_DECAY = 0.3
HYENA_SLOW_DECAY = 1.5
HYENA_TARGET = 1e-2
MLSTM_WIDTH = 1024
MLSTM_HEADS = 4
MLSTM_HEAD_DIM = MLSTM_WIDTH // MLSTM_HEADS
MLSTM_CHUNK = 128
N_MLSTM_GATES = 4 * MLSTM_HEADS
SHORT_CONV = 3
SHORT_CONV_CH = 3 * HYENA_WIDTH + 2 * MLSTM_WIDTH
IN_COLS = SHORT_CONV_CH + 2 * MLSTM_WIDTH + N_MLSTM_GATES + 2 * D_MODEL
FFN_HIDDEN = -(-8 * D_MODEL // (3 * 256)) * 256
RMS_EPS = 1e-6

kernel_name = 'hybrid_hyena_mlstm_encoder_block'


def rmsnorm(x, w):
    xf = x.astype(jnp.float32)
    y = xf * lax.rsqrt(jnp.mean(xf * xf, axis=-1, keepdims=True) + RMS_EPS)
    return (y * w.astype(jnp.float32)).astype(x.dtype)


def centred_depthwise_conv(u, w, b):
    K = w.shape[0]
    pad = K // 2
    L = u.shape[1]
    up = jnp.pad(u, ((0, 0), (pad, pad), (0, 0)))
    out = up[:, 0:L] * w[0] + b
    for j in range(1, K):
        out = out + up[:, j:j + L] * w[j]
    return out


def hyena_filters(L, w1, b1, f1, w2, b2, f2, w3):
    f32 = jnp.float32
    t = jnp.linspace(0.0, 1.0, L, dtype=f32)[:, None]
    bands = (HYENA_EMB - 1) // 2
    omega = 2.0 * math.pi * jnp.arange(L, dtype=f32) / L
    freqs = jnp.linspace(1e-4, bands - 1, bands, dtype=f32)
    ang = omega[:, None] * freqs[None, :]
    z = jnp.concatenate([t, jnp.cos(ang), -jnp.sin(ang)], axis=-1)
    h = jnp.sin(f1.astype(f32) * (z @ w1.astype(f32) + b1.astype(f32)))
    h = jnp.sin(f2.astype(f32) * (h @ w2.astype(f32) + b2.astype(f32)))
    h = h @ w3.astype(f32)
    max_decay = math.log(HYENA_TARGET) / HYENA_FAST_DECAY
    min_decay = math.log(HYENA_TARGET) / HYENA_SLOW_DECAY
    deltas = jnp.linspace(min_decay, max_decay, HYENA_WIDTH, dtype=f32)
    window = jnp.exp(-t * jnp.abs(deltas)[None, :])
    return h.reshape(L, HYENA_ORDER, 2, HYENA_WIDTH) * window[:, None, None, :]


def two_sided_spectrum(h):
    h_fwd = h[:, :, 0]
    h_bwd = h[:, :, 1]
    kern = jnp.concatenate([h_fwd, jnp.zeros_like(h_fwd[:1]), h_bwd[:0:-1]], axis=0)
    return jnp.fft.rfft(kern, axis=0)


def long_conv(u, kf, bias):
    L = u.shape[1]
    uf = jnp.fft.rfft(u, n=2 * L, axis=1)
    y = jnp.fft.irfft(uf * kf[None], n=2 * L, axis=1)[:, :L]
    return y + u * bias


def mlstm_direction(q, k, v, i_pre, f_pre):
    B, L, H, dh = q.shape
    nc = L // MLSTM_CHUNK

    def to_chunks(t):
        return t.reshape(B, nc, MLSTM_CHUNK, H, -1).transpose(0, 3, 1, 2, 4)

    qc = to_chunks(q)
    kc = to_chunks(k) * (dh ** -0.5)
    vc = to_chunks(v)
    ig = to_chunks(i_pre[..., None])[..., 0]
    logf = to_chunks(jax.nn.log_sigmoid(f_pre)[..., None])[..., 0]
    b = jnp.cumsum(logf, axis=-1)
    b_last = b[..., -1]
    a = b_last[..., None] - b + ig
    m_loc = jnp.max(a, axis=-1)

    def step(carry, xs):
        C, n, m = carry
        bl, a_c, ml, k_c, v_c = xs
        m_new = jnp.maximum(bl + m, ml)
        keep = jnp.exp(bl + m - m_new)
        w = jnp.exp(a_c - m_new[..., None])
        C_new = keep[..., None, None] * C + jnp.einsum('bhsv,bhsk->bhvk', v_c * w[..., None], k_c)
        n_new = keep[..., None] * n + jnp.einsum('bhs,bhsk->bhk', w, k_c)
        return (C_new, n_new, m_new), (C, n, m)

    xs = tuple(jnp.moveaxis(t, 2, 0) for t in (b_last, a, m_loc, kc, vc))
    init = (jnp.zeros((B, H, dh, dh), jnp.float32),
            jnp.zeros((B, H, dh), jnp.float32),
            jnp.zeros((B, H), jnp.float32))
    _, (C_prev, n_prev, m_prev) = lax.scan(step, init, xs)
    C_prev = jnp.moveaxis(C_prev, 0, 2)
    n_prev = jnp.moveaxis(n_prev, 0, 2)
    m_prev = jnp.moveaxis(m_prev, 0, 2)

    pos = jnp.arange(MLSTM_CHUNK)
    lower = pos[:, None] >= pos[None, :]
    dlog = b[..., :, None] - b[..., None, :] + ig[..., None, :]
    dlog = jnp.where(lower, dlog, -jnp.inf)
    inter = b + m_prev[..., None]
    m_j = jnp.maximum(inter, jnp.max(dlog, axis=-1))
    s = jnp.einsum('bhcjd,bhcsd->bhcjs', qc, kc) * jnp.exp(dlog - m_j[..., None])
    inter_w = jnp.exp(inter - m_j)
    num = (jnp.einsum('bhcjs,bhcsv->bhcjv', s, vc)
           + inter_w[..., None] * jnp.einsum('bhcjk,bhcvk->bhcjv', qc, C_prev))
    den = jnp.sum(s, axis=-1) + inter_w * jnp.einsum('bhcjk,bhck->bhcj', qc, n_prev)
    h = num / jnp.maximum(jnp.abs(den), jnp.exp(-m_j))[..., None]
    return h.transpose(0, 2, 3, 1, 4).reshape(B, L, H, dh)


def setup_inputs(seed: int = 0) -> dict:
    key = jax.random.key(seed)
    ks = jax.random.split(key, 24)
    f32 = jnp.float32

    def nrm(k, shape, scale):
        return jax.random.normal(k, shape, f32) * scale

    Ld = DEPTH
    H = MLSTM_HEADS
    FH = HYENA_FILTER_HIDDEN
    x = nrm(ks[0], (BATCH, SEQ, D_MODEL), 1.0)
    norm1_w = 1.0 + nrm(ks[1], (Ld, D_MODEL), 0.05)
    w_in = nrm(ks[2], (Ld, D_MODEL, IN_COLS), D_MODEL ** -0.5)
    conv_w = nrm(ks[3], (Ld, SHORT_CONV, SHORT_CONV_CH), SHORT_CONV ** -0.5)
    conv_b = nrm(ks[4], (Ld, SHORT_CONV_CH), 0.02)
    filt_w1 = nrm(ks[5], (Ld, HYENA_EMB, FH), HYENA_EMB ** -0.5)
    filt_b1 = nrm(ks[6], (Ld, FH), 0.1)
    filt_freq1 = 1.0 + nrm(ks[7], (Ld, FH), 0.05)
    filt_w2 = nrm(ks[8], (Ld, FH, FH), FH ** -0.5)
    filt_b2 = nrm(ks[9], (Ld, FH), 0.1)
    filt_freq2 = 1.0 + nrm(ks[10], (Ld, FH), 0.05)
    filt_w3 = nrm(ks[11], (Ld, FH, HYENA_ORDER * 2 * HYENA_WIDTH), 0.5 * SEQ ** -0.5)
    hyena_bias = nrm(ks[12], (Ld, HYENA_ORDER, HYENA_WIDTH), 0.5)
    f_base = jnp.linspace(3.0, 6.0, H, dtype=f32)
    zero_h = jnp.zeros((H,), f32)
    gate_base = jnp.stack([zero_h, f_base, zero_h, f_base])
    mlstm_gate_bias = gate_base[None] + nrm(ks[13], (Ld, 4, H), 0.1)
    w_branch_a = nrm(ks[14], (Ld, HYENA_WIDTH, D_MODEL), HYENA_WIDTH ** -0.5)
    w_branch_b = nrm(ks[15], (Ld, MLSTM_WIDTH, D_MODEL), MLSTM_WIDTH ** -0.5)
    w_out = nrm(ks[16], (Ld, D_MODEL, D_MODEL), D_MODEL ** -0.5)
    norm2_w = 1.0 + nrm(ks[17], (Ld, D_MODEL), 0.05)
    w_gate_up = nrm(ks[18], (Ld, D_MODEL, 2 * FFN_HIDDEN), D_MODEL ** -0.5)
    w_down = nrm(ks[19], (Ld, FFN_HIDDEN, D_MODEL), FFN_HIDDEN ** -0.5)
    norm_f_w = 1.0 + nrm(ks[20], (D_MODEL,), 0.05)
    return {'x': x, 'norm1_w': norm1_w, 'w_in': w_in, 'conv_w': conv_w, 'conv_b': conv_b,
            'filt_w1': filt_w1, 'filt_b1': filt_b1, 'filt_freq1': filt_freq1,
            'filt_w2': filt_w2, 'filt_b2': filt_b2, 'filt_freq2': filt_freq2, 'filt_w3': filt_w3,
            'hyena_bias': hyena_bias, 'mlstm_gate_bias': mlstm_gate_bias,
            'w_branch_a': w_branch_a, 'w_branch_b': w_branch_b, 'w_out': w_out,
            'norm2_w': norm2_w, 'w_gate_up': w_gate_up, 'w_down': w_down, 'norm_f_w': norm_f_w}


def reference(x, norm1_w, w_in, conv_w, conv_b, filt_w1, filt_b1, filt_freq1, filt_w2, filt_b2,
              filt_freq2, filt_w3, hyena_bias, mlstm_gate_bias, w_branch_a, w_branch_b, w_out,
              norm2_w, w_gate_up, w_down, norm_f_w):
    B, L, _ = x.shape
    f32 = jnp.float32
    HW, MW, H, dh = HYENA_WIDTH, MLSTM_WIDTH, MLSTM_HEADS, MLSTM_HEAD_DIM
    for l in range(DEPTH):
        hn = rmsnorm(x, norm1_w[l])
        proj = hn @ w_in[l]
        conv_out = centred_depthwise_conv(proj[..., :SHORT_CONV_CH], conv_w[l], conv_b[l])
        rest = proj[..., SHORT_CONV_CH:]

        hy = conv_out[..., :3 * HW].astype(f32)
        hv, hx1, hx2 = hy[..., :HW], hy[..., HW:2 * HW], hy[..., 2 * HW:]
        filt = hyena_filters(L, filt_w1[l], filt_b1[l], filt_freq1[l], filt_w2[l], filt_b2[l],
                             filt_freq2[l], filt_w3[l])
        kf = two_sided_spectrum(filt)
        hb = hyena_bias[l].astype(f32)
        z = hx1 * long_conv(hv, kf[:, 0], hb[0])
        y_a = (hx2 * long_conv(z, kf[:, 1], hb[1])).astype(x.dtype)

        qk = jax.nn.silu(conv_out[..., 3 * HW:].astype(f32))
        q = qk[..., :MW].reshape(B, L, H, dh)
        k = qk[..., MW:].reshape(B, L, H, dh)
        v = rest[..., :MW].astype(f32).reshape(B, L, H, dh)
        o = jax.nn.sigmoid(rest[..., MW:2 * MW].astype(f32))
        g = (rest[..., 2 * MW:2 * MW + N_MLSTM_GATES].astype(f32).reshape(B, L, 4, H)
             + mlstm_gate_bias[l].astype(f32))
        h_fwd = mlstm_direction(q, k, v, g[:, :, 0], g[:, :, 1])
        flip = lambda t: jnp.flip(t, axis=1)
        h_bwd = flip(mlstm_direction(flip(q), flip(k), flip(v), flip(g[:, :, 2]), flip(g[:, :, 3])))
        y_b = (o * (h_fwd + h_bwd).reshape(B, L, MW)).astype(x.dtype)

        merge = rest[..., 2 * MW + N_MLSTM_GATES:]
        gate_a = jax.nn.sigmoid(merge[..., :D_MODEL])
        gate_b = jax.nn.sigmoid(merge[..., D_MODEL:])
        mixed = gate_a * (y_a @ w_branch_a[l]) + gate_b * (y_b @ w_branch_b[l])
        x = x + mixed @ w_out[l]

        hn2 = rmsnorm(x, norm2_w[l])
        gu = hn2 @ w_gate_up[l]
        x = x + (jax.nn.silu(gu[..., :FFN_HIDDEN]) * gu[..., FFN_HIDDEN:]) @ w_down[l]
    return rmsnorm(x, norm_f_w)
```

```cpp
#include <hip/hip_runtime.h>
#include <hip/hip_cooperative_groups.h>
#include <cstdio>
namespace cg = cooperative_groups;

#define LAS __attribute__((address_space(3)))
typedef unsigned short bf16_t;
typedef short bf16x8 __attribute__((ext_vector_type(8)));
typedef short bf16x4 __attribute__((ext_vector_type(4)));
typedef float f32x4 __attribute__((ext_vector_type(4)));
typedef float f32x2 __attribute__((ext_vector_type(2)));
typedef unsigned u32x4 __attribute__((ext_vector_type(4)));
typedef unsigned u32x2 __attribute__((ext_vector_type(2)));

constexpr int NB = 4, SEQ = 4096, TOK = NB * SEQ, DM = 2048, HW = 1024, MW = 1024, NHEAD = 4, DH = 256, FFH = 5632;
constexpr int CONVC = 5120, INCOLS = 11280, NFILT = 4096;
constexpr float RMS_EPS = 1e-6f;
constexpr size_t MiB = 1u << 20;
constexpr size_t WS_BAR = 262144, WS_R1S = 0, WS_SS2 = 65536, WS_SS3 = 131072, WS_G = 1 * MiB, WS_H2 = 2 * MiB;
constexpr size_t WS_WA = 4 * MiB, WS_WB = 8 * MiB, WS_WOUT = 12 * MiB, WS_WGU = 20 * MiB, WS_WD = 64 * MiB, WS_WIN = 86 * MiB, WS_XB = 130 * MiB;
constexpr size_t WS_FILT = 194 * MiB, WS_HY = 258 * MiB, WS_R1 = 354 * MiB, WS_END = 482 * MiB;
constexpr size_t WS_YA = 86 * MiB, WS_YBF = 118 * MiB, WS_YBB = 150 * MiB, WS_X1B = 86 * MiB, WS_MIX = 194 * MiB, WS_HH = 258 * MiB;
constexpr int LDS_BYTES = 147456;

__device__ __forceinline__ unsigned f2bf(float f) { unsigned u = __float_as_uint(f); return (u + 0x7fffu + ((u >> 16) & 1u)) >> 16; }
__device__ __forceinline__ unsigned pk2(float lo, float hi) { unsigned r; asm volatile("v_cvt_pk_bf16_f32 %0, %1, %2" : "=v"(r) : "v"(lo), "v"(hi)); return r; }
__device__ __forceinline__ float bflo(unsigned w) { return __uint_as_float(w << 16); }
__device__ __forceinline__ float bfhi(unsigned w) { return __uint_as_float(w & 0xffff0000u); }
__device__ __forceinline__ float wave_sum(float v) {
#pragma unroll
    for (int o = 1; o < 64; o <<= 1) v += __shfl_xor(v, o);
    return v;
}
__device__ __forceinline__ int lane_id_opaque() { int l; asm volatile("v_mbcnt_lo_u32_b32 %0, -1, 0\n\tv_mbcnt_hi_u32_b32 %0, -1, %0" : "=v"(l)); return l; }
__device__ __forceinline__ float sigmoidf_(float x) { return 1.0f / (1.0f + __expf(-x)); }
__device__ __forceinline__ float siluf_(float x) { return x / (1.0f + __expf(-x)); }

namespace pg8 {
constexpr int BM = 256, BK = 64, HALF = 128, HTB = HALF * BK * 2, STAGE_BYTES = 8 * HTB, NXCD = 8, WGM = 8;
__device__ __forceinline__ int lds_byte(int r, int c) { const int st = (r >> 4) * 2 + (c >> 5), rr = r & 15, cc = c & 31, ob = rr * 64 + cc * 2; return st * 1024 + (ob ^ (((ob >> 9) & 1) << 5)); }
__device__ __forceinline__ void stage_rc(int b, int& R, int& C) { const int st = b / 1024, sb = b % 1024, swz = sb ^ (((sb >> 9) & 1) << 5); R = (st >> 1) * 16 + swz / 64; C = (st & 1) * 32 + (swz % 64) / 2; }
__device__ __forceinline__ int perm32(int rho) { const int n = rho >> 4, i = rho & 15; return 8 * (i >> 2) + 4 * n + (i & 3); }
struct GUnit { const char* A; const char* B; int pm, pn, sub; };
__device__ __forceinline__ void tile_of(int L, int nM, int nN, int& pm, int& pn) {
    const int nwg = nM * nN; int wgid = L; { const int q = nwg / NXCD, r = nwg % NXCD, xcd = wgid % NXCD, off = wgid / NXCD; wgid = (xcd < r ? xcd * (q + 1) : r * (q + 1) + (xcd - r) * q) + off; }
    const int nig = WGM * nN, gid = wgid / nig, fm = gid * WGM, gsz = (nM - fm) < WGM ? (nM - fm) : WGM;
    pm = fm + ((wgid % nig) % gsz); pn = (wgid % nig) / gsz;
}
typedef f32x4 Acc[2][2][4][2];
template <class Prog>
__device__ __forceinline__ void gemm_stream(LAS unsigned char* lds, const Prog& P, int wv) {
    int tid = (wv << 6) | lane_id_opaque(); asm volatile("" : "+v"(tid));
    const int wid = __builtin_amdgcn_readfirstlane(tid >> 6), lane = tid & 63, wr = wid >> 2, wc = wid & 3, fr = lane & 15, fq = lane >> 4;
    const int K = P.K, nt = K / BK;
    unsigned voffA[2], voffB[2];
#pragma unroll
    for (int i = 0; i < 2; ++i) { int R, C; stage_rc(tid * 16 + i * 8192, R, C); const int Rb = Prog::PERM ? ((R & ~31) + perm32(R & 31)) : R;
        voffA[i] = (unsigned)(R * K + C) * 2u; voffB[i] = (unsigned)(Rb * K + C) * 2u; }
    const size_t kstep = (size_t)(BK * 2);
    const size_t hstep = (size_t)HALF * K * 2;
    const unsigned ldsw = (unsigned)wid * 1024u;
    const int aoff = lds_byte(wr * 64 + fr, fq * 8), boff = lds_byte(wc * 32 + fr, fq * 8);
#define PG8_SA(b, h) (((b) * 2 + (h)) * HTB)
#define PG8_SB(b, h) ((4 + (b) * 2 + (h)) * HTB)
#define PG8_STAGE(bufoff, gbase, voff) do { _Pragma("unroll") for (int _i = 0; _i < 2; ++_i) \
        __builtin_amdgcn_global_load_lds((const unsigned*)((const char*)(gbase) + (voff)[_i]), (LAS unsigned*)(lds + (bufoff) + ldsw + _i * 8192), 16, 0, 0); } while (0)
#define PG8_LDA(dst, b, h) do { _Pragma("unroll") for (int m = 0; m < 4; ++m) _Pragma("unroll") for (int k = 0; k < 2; ++k) dst[m][k] = *(const LAS bf16x8*)(lds + PG8_SA(b, h) + aoff + m * 2048 + k * 1024); } while (0)
#define PG8_LDB(dst, b, h) do { _Pragma("unroll") for (int n = 0; n < 2; ++n) _Pragma("unroll") for (int k = 0; k < 2; ++k) dst[n][k] = *(const LAS bf16x8*)(lds + PG8_SB(b, h) + boff + n * 2048 + k * 1024); } while (0)
#define PG8_MMA(ai, bj, At, Bt) do { __builtin_amdgcn_s_setprio(1); _Pragma("unroll") for (int m = 0; m < 4; ++m) _Pragma("unroll") for (int n = 0; n < 2; ++n) _Pragma("unroll") for (int k = 0; k < 2; ++k) \
        acc[ai][bj][m][n] = __builtin_amdgcn_mfma_f32_16x16x32_bf16(Bt[n][k], At[m][k], acc[ai][bj][m][n], 0, 0, 0); __builtin_amdgcn_s_setprio(0); } while (0)
#define PG8_WAIT_V(n) asm volatile("s_waitcnt vmcnt(" #n ")" ::: "memory")
#define PG8_WAIT_L(n) asm volatile("s_waitcnt lgkmcnt(" #n ")" ::: "memory")
#define PG8_BAR __builtin_amdgcn_s_barrier()
#define PG8_SCHED __builtin_amdgcn_sched_barrier(0)
    GUnit cur, nxt; int ui = 0;
    if (!P.next(0, cur)) return;
    f32x4 acc[2][2][4][2];
#pragma unroll
    for (int a = 0; a < 2; ++a)
#pragma unroll
        for (int b = 0; b < 2; ++b)
#pragma unroll
            for (int m = 0; m < 4; ++m)
#pragma unroll
                for (int n = 0; n < 2; ++n) acc[a][b][m][n] = (f32x4){0.f, 0.f, 0.f, 0.f};
    bf16x8 At[4][2], B0[2][2], B1[2][2];
    const char* cA = cur.A; const char* cB = cur.B;
    PG8_STAGE(PG8_SB(0, 0), cB, voffB); PG8_STAGE(PG8_SA(0, 0), cA, voffA); PG8_STAGE(PG8_SB(0, 1), cB + hstep, voffB); PG8_STAGE(PG8_SA(0, 1), cA + hstep, voffA);
    if (wr == 1) PG8_BAR;
    PG8_WAIT_V(4); PG8_BAR;
    PG8_STAGE(PG8_SB(1, 0), cB + kstep, voffB); PG8_STAGE(PG8_SA(1, 0), cA + kstep, voffA); PG8_STAGE(PG8_SB(1, 1), cB + hstep + kstep, voffB);
    PG8_WAIT_V(6); PG8_BAR;
    for (;;) {
        const bool has_next = P.next(ui + 1, nxt);
        const char* nA = has_next ? nxt.A : cA; const char* nB = has_next ? nxt.B : cB;
        for (int t = 0; t < nt; t += 2) {
            const bool last = (t == nt - 2);
            const char* a1 = cA + (size_t)(t + 1) * kstep;
            const char* a2 = last ? nA : cA + (size_t)(t + 2) * kstep; const char* b2 = last ? nB : cB + (size_t)(t + 2) * kstep;
            const char* a3 = a2 + kstep; const char* b3 = b2 + kstep;
            PG8_LDB(B0, 0, 0); PG8_SCHED; PG8_LDA(At, 0, 0); PG8_STAGE(PG8_SA(1, 1), a1 + hstep, voffA);
            PG8_WAIT_L(8); PG8_BAR; PG8_WAIT_L(0); PG8_MMA(0, 0, At, B0); PG8_BAR; PG8_SCHED;
            PG8_LDB(B1, 0, 1); PG8_STAGE(PG8_SB(0, 0), b2, voffB);
            PG8_BAR; PG8_WAIT_L(0); PG8_MMA(0, 1, At, B1); PG8_BAR;
            PG8_LDA(At, 0, 1); PG8_STAGE(PG8_SA(0, 0), a2, voffA);
            PG8_BAR; PG8_WAIT_L(0); PG8_MMA(1, 0, At, B0); PG8_BAR; PG8_SCHED;
            PG8_STAGE(PG8_SB(0, 1), b2 + hstep, voffB);
            PG8_WAIT_V(6); PG8_BAR; PG8_MMA(1, 1, At, B1); PG8_BAR;
            PG8_LDB(B0, 1, 0); PG8_SCHED; PG8_LDA(At, 1, 0); PG8_STAGE(PG8_SA(0, 1), a2 + hstep, voffA);
            PG8_WAIT_L(8); PG8_BAR; PG8_WAIT_L(0); PG8_MMA(0, 0, At, B0); PG8_BAR; PG8_SCHED;
            PG8_LDB(B1, 1, 1); PG8_STAGE(PG8_SB(1, 0), b3, voffB);
            PG8_BAR; PG8_WAIT_L(0); PG8_MMA(0, 1, At, B1); PG8_BAR;
            PG8_LDA(At, 1, 1); PG8_STAGE(PG8_SA(1, 0), a3, voffA);
            PG8_BAR; PG8_WAIT_L(0); PG8_MMA(1, 0, At, B0); PG8_BAR; PG8_SCHED;
            PG8_STAGE(PG8_SB(1, 1), b3 + hstep, voffB);
            PG8_WAIT_V(6); PG8_BAR; PG8_MMA(1, 1, At, B1); PG8_BAR;
        }
        P.epi(acc, cur, wr, wc, fr, fq);
        if (!has_next) break;
        cur = nxt; cA = nA; cB = nB; ++ui;
    }
    PG8_WAIT_V(0);
    if (wr == 0) PG8_BAR;
    PG8_BAR;
#undef PG8_SA
#undef PG8_SB
#undef PG8_STAGE
#undef PG8_LDA
#undef PG8_LDB
#undef PG8_MMA
#undef PG8_WAIT_V
#undef PG8_WAIT_L
#undef PG8_BAR
#undef PG8_SCHED
}
__device__ __forceinline__ void zero_acc(Acc& acc) {
#pragma unroll
    for (int a = 0; a < 2; ++a)
#pragma unroll
        for (int b = 0; b < 2; ++b)
#pragma unroll
            for (int m = 0; m < 4; ++m)
#pragma unroll
                for (int n = 0; n < 2; ++n) acc[a][b][m][n] = (f32x4){0.f, 0.f, 0.f, 0.f};
}
}
using pg8::GUnit; using pg8::Acc;
struct HyProg {
    static constexpr bool PERM = true; int K, G, c; const bf16_t* W; const bf16_t* X; bf16_t* HY; const float* r1;
    __device__ __forceinline__ bool next(int i, GUnit& u) const { const int L = i * G + c; if (L >= 12 * 64) return false; pg8::tile_of(L, 12, 64, u.pm, u.pn);
        u.A = (const char*)(W + (size_t)u.pm * 256 * DM); u.B = (const char*)(X + (size_t)u.pn * 256 * DM); u.sub = 0; return true; }
    __device__ __forceinline__ void epi(Acc& acc, const GUnit& u, int wr, int wc, int fr, int fq) const {
        const int row0 = u.pm * 256 + wr * 64 + fr, col0 = u.pn * 256 + wc * 32 + 8 * fq;
        f32x4 sc[2][2];
#pragma unroll
        for (int bj = 0; bj < 2; ++bj) { sc[bj][0] = *(const f32x4*)(r1 + col0 + bj * 128); sc[bj][1] = *(const f32x4*)(r1 + col0 + bj * 128 + 4); }
#pragma unroll
        for (int ai = 0; ai < 2; ++ai)
#pragma unroll
            for (int m = 0; m < 4; ++m) { bf16_t* rowp = HY + (size_t)(row0 + ai * 128 + m * 16) * TOK + col0;
#pragma unroll
                for (int bj = 0; bj < 2; ++bj) { const f32x4 v0 = acc[ai][bj][m][0] * sc[bj][0], v1 = acc[ai][bj][m][1] * sc[bj][1];
                    u32x4 w; w.x = pk2(v0[0], v0[1]); w.y = pk2(v0[2], v0[3]); w.z = pk2(v1[0], v1[1]); w.w = pk2(v1[2], v1[3]);
                    *(u32x4*)(rowp + bj * 128) = w; } }
        pg8::zero_acc(acc);
    }
};
struct RestProg {
    static constexpr bool PERM = true; int K, G, c; const bf16_t* W; const bf16_t* X; bf16_t* R1; bf16_t* R2; const float* r1;
    __device__ __forceinline__ bool next(int i, GUnit& u) const { const int L = i * G + c; if (L >= 64 * 32) return false; pg8::tile_of(L, 64, 32, u.pm, u.pn);
        u.A = (const char*)(X + (size_t)u.pm * 256 * DM); u.B = (const char*)(W + (size_t)(3072 + u.pn * 256) * DM); u.sub = 0; return true; }
    __device__ __forceinline__ void epi(Acc& acc, const GUnit& u, int wr, int wc, int fr, int fq) const {
        const int row0 = u.pm * 256 + wr * 64 + fr; const bool sg = u.pn >= 12;
        bf16_t* base = u.pn < 16 ? R1 + u.pn * 256 : R2 + (u.pn - 16) * 256;
        const int col0 = wc * 32 + 8 * fq;
#pragma unroll
        for (int ai = 0; ai < 2; ++ai)
#pragma unroll
            for (int m = 0; m < 4; ++m) { const int row = row0 + ai * 128 + m * 16; const float s = r1[row]; bf16_t* rowp = base + (size_t)row * 4096 + col0;
#pragma unroll
                for (int bj = 0; bj < 2; ++bj) { f32x4 v0 = acc[ai][bj][m][0] * s, v1 = acc[ai][bj][m][1] * s;
                    if (sg) {
#pragma unroll
                        for (int j = 0; j < 4; ++j) { v0[j] = sigmoidf_(v0[j]); v1[j] = sigmoidf_(v1[j]); } }
                    u32x4 w; w.x = pk2(v0[0], v0[1]); w.y = pk2(v0[2], v0[3]); w.z = pk2(v1[0], v1[1]); w.w = pk2(v1[2], v1[3]);
                    *(u32x4*)(rowp + bj * 128) = w; } }
        pg8::zero_acc(acc);
    }
};
struct BranchProg {
    static constexpr bool PERM = true; int K, G, c; const bf16_t *YA, *YBF, *YBB, *WA, *WB; const bf16_t* R2; bf16_t* MIX;
    __device__ __forceinline__ bool next(int i, GUnit& u) const { const int ti = i / 3, sub = i - 3 * ti; const int L = ti * G + c; if (L >= 64 * 8) return false; pg8::tile_of(L, 64, 8, u.pm, u.pn);
        const bf16_t* a = sub == 0 ? YA : (sub == 1 ? YBF : YBB); const bf16_t* b = sub == 0 ? WA : WB;
        u.A = (const char*)(a + (size_t)u.pm * 256 * 1024); u.B = (const char*)(b + (size_t)u.pn * 256 * 1024); u.sub = sub; return true; }
    __device__ __forceinline__ void epi(Acc& acc, const GUnit& u, int wr, int wc, int fr, int fq) const {
        if (u.sub == 1) return;
        const int row0 = u.pm * 256 + wr * 64 + fr, col0 = u.pn * 256 + wc * 32 + 8 * fq;
#pragma unroll
        for (int ai = 0; ai < 2; ++ai)
#pragma unroll
            for (int m = 0; m < 4; ++m) { const int row = row0 + ai * 128 + m * 16; const bf16_t* gp = R2 + (size_t)row * 4096 + col0;
#pragma unroll
                for (int bj = 0; bj < 2; ++bj) {
                    const u32x4 gbw = *(const u32x4*)(gp + 2048 + bj * 128);
                    float gb[8] = {bflo(gbw.x), bfhi(gbw.x), bflo(gbw.y), bfhi(gbw.y), bflo(gbw.z), bfhi(gbw.z), bflo(gbw.w), bfhi(gbw.w)};
                    if (u.sub == 0) {
                        const u32x4 gaw = *(const u32x4*)(gp + bj * 128);
                        float ga[8] = {bflo(gaw.x), bfhi(gaw.x), bflo(gaw.y), bfhi(gaw.y), bflo(gaw.z), bfhi(gaw.z), bflo(gaw.w), bfhi(gaw.w)};
#pragma unroll
                        for (int j = 0; j < 4; ++j) { acc[ai][bj][m][0][j] *= ga[j] / fmaxf(gb[j], 1e-30f); acc[ai][bj][m][1][j] *= ga[4 + j] / fmaxf(gb[4 + j], 1e-30f); }
                    } else {
                        f32x4 v0 = acc[ai][bj][m][0], v1 = acc[ai][bj][m][1];
#pragma unroll
                        for (int j = 0; j < 4; ++j) { v0[j] *= fmaxf(gb[j], 1e-30f); v1[j] *= fmaxf(gb[4 + j], 1e-30f); }
                        u32x4 w; w.x = pk2(v0[0], v0[1]); w.y = pk2(v0[2], v0[3]); w.z = pk2(v1[0], v1[1]); w.w = pk2(v1[2], v1[3]);
                        *(u32x4*)(MIX + (size_t)row * DM + col0 + bj * 128) = w;
                    } } }
        if (u.sub == 2) pg8::zero_acc(acc);
    }
};
struct ResProg {
    static constexpr bool PERM = false; int K, G, c; const bf16_t* A; const bf16_t* B; const float* base; float* out; bf16_t* outb; float* ss;
    __device__ __forceinline__ bool next(int i, GUnit& u) const { const int L = i * G + c; if (L >= 64 * 8) return false; pg8::tile_of(L, 64, 8, u.pm, u.pn);
        u.A = (const char*)(A + (size_t)u.pm * 256 * K); u.B = (const char*)(B + (size_t)u.pn * 256 * K); u.sub = 0; return true; }
    __device__ __forceinline__ void epi(Acc& acc, const GUnit& u, int wr, int wc, int fr, int fq) const {
        const int row0 = u.pm * 256 + wr * 64 + fr, col0 = u.pn * 256 + wc * 32 + 4 * fq;
#pragma unroll
        for (int ai = 0; ai < 2; ++ai)
#pragma unroll
            for (int m = 0; m < 4; ++m) { const int row = row0 + ai * 128 + m * 16; const size_t off = (size_t)row * DM + col0; float s = 0.f;
#pragma unroll
                for (int bj = 0; bj < 2; ++bj)
#pragma unroll
                    for (int n = 0; n < 2; ++n) { const f32x4 bs = *(const f32x4*)(base + off + bj * 128 + n * 16); const f32x4 o = bs + acc[ai][bj][m][n];
                        *(f32x4*)(out + off + bj * 128 + n * 16) = o; s += (o[0] * o[0] + o[1] * o[1]) + (o[2] * o[2] + o[3] * o[3]);
                        if (outb) { u32x2 w; w.x = pk2(o[0], o[1]); w.y = pk2(o[2], o[3]); *(u32x2*)(outb + off + bj * 128 + n * 16) = w; } }
                s += __shfl_xor(s, 16); s += __shfl_xor(s, 32);
                if (fq == 0) unsafeAtomicAdd(ss + row, s); }
        pg8::zero_acc(acc);
    }
};
struct GuProg {
    static constexpr bool PERM = true; int K, G, c; const bf16_t* X; const bf16_t* W; bf16_t* HH; const float* ss2;
    __device__ __forceinline__ bool next(int i, GUnit& u) const { const int L = i * G + c; if (L >= 64 * 44) return false; pg8::tile_of(L, 64, 44, u.pm, u.pn);
        u.A = (const char*)(X + (size_t)u.pm * 256 * DM); u.B = (const char*)(W + (size_t)u.pn * 256 * DM); u.sub = 0; return true; }
    __device__ __forceinline__ void epi(Acc& acc, const GUnit& u, int wr, int wc, int fr, int fq) const {
        const int row0 = u.pm * 256 + wr * 64 + fr, col0 = u.pn * 128 + wc * 32 + 8 * fq;
#pragma unroll
        for (int ai = 0; ai < 2; ++ai)
#pragma unroll
            for (int m = 0; m < 4; ++m) { const int row = row0 + ai * 128 + m * 16; const float r2 = 1.0f / sqrtf(ss2[row] * (1.0f / DM) + RMS_EPS);
                float hv[8];
#pragma unroll
                for (int n = 0; n < 2; ++n)
#pragma unroll
                    for (int j = 0; j < 4; ++j) { const float g = acc[ai][0][m][n][j] * r2, uu = acc[ai][1][m][n][j] * r2; hv[4 * n + j] = siluf_(g) * uu; }
                u32x4 w; w.x = pk2(hv[0], hv[1]); w.y = pk2(hv[2], hv[3]); w.z = pk2(hv[4], hv[5]); w.w = pk2(hv[6], hv[7]);
                *(u32x4*)(HH + (size_t)row * FFH + col0) = w; }
        pg8::zero_acc(acc);
    }
};
struct Ctx {
    const float* in[21]; float* out; unsigned char* ws;
};
__device__ __forceinline__ void p0_transpose_item(const float* W, int Nsrc, int K, bf16_t* WT, int dst_row0, int src_col0, const float* kscale, LAS float* scr, int kb, int lane) {
    const int k0 = 64 * kb;
#pragma unroll 8
    for (int i = 0; i < 32; ++i) { const int kk = 2 * i + (lane >> 5); float v = W[(size_t)(k0 + kk) * Nsrc + src_col0 + (lane & 31)]; if (kscale) v *= kscale[k0 + kk]; scr[kk * 33 + (lane & 31)] = v; }
    asm volatile("s_waitcnt lgkmcnt(0)" ::: "memory");
    const int c = lane & 7;
#pragma unroll
    for (int j = 0; j < 4; ++j) { const int n = (lane >> 3) + 8 * j; const LAS float* s = scr + (8 * c) * 33 + n;
        u32x4 o; o.x = pk2(s[0 * 33], s[1 * 33]); o.y = pk2(s[2 * 33], s[3 * 33]); o.z = pk2(s[4 * 33], s[5 * 33]); o.w = pk2(s[6 * 33], s[7 * 33]);
        *(u32x4*)(WT + (size_t)(dst_row0 + n) * K + k0 + 8 * c) = o; }
    asm volatile("s_waitcnt lgkmcnt(0)" ::: "memory");
}
__device__ __forceinline__ void p0_prologue(const Ctx& C, LAS unsigned char* lds, int G, int wv) {
    int tid = (wv << 6) | lane_id_opaque(); asm volatile("" : "+v"(tid));
    const int lane = tid & 63, wave = __builtin_amdgcn_readfirstlane(tid >> 6);
    const int gw = blockIdx.x * 8 + wave, NGW = G * 8;
    unsigned char* ws = C.ws;
    LAS float* scr = (LAS float*)(lds + wave * 8704);
    constexpr int I_IN = 32 * 352, I_A = 16 * 64, I_O = 32 * 64, I_GU = 32 * 352, I_D = 88 * 64;
    constexpr int NIT = I_IN + 2 * I_A + I_O + I_GU + I_D;
    for (int it = gw; it < NIT; it += NGW) {
        int r = it;
        if (r < I_IN) { const int kb = r / 352, nb = r % 352, n0 = nb * 32; const int src = n0 < 7168 ? n0 : n0 + 16;
            p0_transpose_item(C.in[2], INCOLS, DM, (bf16_t*)(ws + WS_WIN), n0, src, C.in[1], scr, kb, lane); continue; } r -= I_IN;
        if (r < I_A) { p0_transpose_item(C.in[14], DM, HW, (bf16_t*)(ws + WS_WA), (r % 64) * 32, (r % 64) * 32, nullptr, scr, r / 64, lane); continue; } r -= I_A;
        if (r < I_A) { p0_transpose_item(C.in[15], DM, MW, (bf16_t*)(ws + WS_WB), (r % 64) * 32, (r % 64) * 32, nullptr, scr, r / 64, lane); continue; } r -= I_A;
        if (r < I_O) { p0_transpose_item(C.in[16], DM, DM, (bf16_t*)(ws + WS_WOUT), (r % 64) * 32, (r % 64) * 32, nullptr, scr, r / 64, lane); continue; } r -= I_O;
        if (r < I_GU) { const int kb = r / 352, nb = r % 352, n0 = nb * 32; const int pn = n0 >> 8, half = (n0 >> 7) & 1, i = n0 & 127;
            p0_transpose_item(C.in[18], 2 * FFH, DM, (bf16_t*)(ws + WS_WGU), n0, half * FFH + 128 * pn + i, C.in[17], scr, kb, lane); continue; } r -= I_GU;
        p0_transpose_item(C.in[19], DM, FFH, (bf16_t*)(ws + WS_WD), (r % 64) * 32, (r % 64) * 32, nullptr, scr, r / 64, lane);
    }
    for (int i = blockIdx.x * 512 + tid; i < TOK; i += G * 512) { ((float*)(ws + WS_SS2))[i] = 0.f; ((float*)(ws + WS_SS3))[i] = 0.f; }
    {
        const float* w1 = C.in[5]; const float* b1 = C.in[6]; const float* f1 = C.in[7]; const float* w2 = C.in[8]; const float* b2 = C.in[9]; const float* f2 = C.in[10];
        float* h2 = (float*)(ws + WS_H2);
        for (int t = gw; t < SEQ; t += NGW) {
            const float tl = (float)t / (float)(SEQ - 1);
            const float omega = 6.283185307179586f * (float)t / (float)SEQ;
            float a = b1[lane] + tl * w1[lane];
#pragma unroll 4
            for (int i = 0; i < 16; ++i) { const float fr = 1e-4f + (float)i * ((15.0f - 1e-4f) / 15.0f); const float ang = omega * fr; float sn, cs; sincosf(ang, &sn, &cs);
                a += cs * w1[(1 + i) * 64 + lane] - sn * w1[(17 + i) * 64 + lane]; }
            const float h1 = sinf(f1[lane] * a);
            float a2 = b2[lane];
#pragma unroll 8
            for (int i = 0; i < 64; ++i) a2 += __shfl(h1, i) * w2[i * 64 + lane];
            h2[t * 64 + lane] = sinf(f2[lane] * a2);
        }
    }
    __syncthreads();
    {
        LAS float* wg = (LAS float*)lds;
        const float* w_in = C.in[2]; const float* nw = C.in[1];
        for (int i = tid; i < DM * 16; i += 512) { const int k = i >> 4, g = i & 15; wg[g * DM + k] = w_in[(size_t)k * INCOLS + 7168 + g] * nw[k]; }
        __syncthreads();
        const float* x = C.in[0]; bf16_t* xb = (bf16_t*)(ws + WS_XB); float* r1 = (float*)(ws + WS_R1S); float* Gt = (float*)(ws + WS_G); const float* gbias = C.in[13];
        for (int row = gw; row < TOK; row += NGW) {
            const f32x4* xr = (const f32x4*)(x + (size_t)row * DM) + lane;
            f32x4 v[8]; float s = 0.f;
#pragma unroll
            for (int j = 0; j < 8; ++j) { v[j] = xr[64 * j]; s += (v[j].x * v[j].x + v[j].y * v[j].y) + (v[j].z * v[j].z + v[j].w * v[j].w); }
            const float r = 1.0f / sqrtf(wave_sum(s) * (1.0f / DM) + RMS_EPS);
            u32x2* o8 = (u32x2*)(xb + (size_t)row * DM) + lane;
#pragma unroll
            for (int j = 0; j < 8; ++j) { u32x2 w; w.x = pk2(v[j].x, v[j].y); w.y = pk2(v[j].z, v[j].w); o8[64 * j] = w; }
            float myg = 0.f;
#pragma unroll
            for (int g = 0; g < 16; ++g) { float a = 0.f;
#pragma unroll
                for (int j = 0; j < 8; ++j) { const f32x4 w = *(const LAS f32x4*)(wg + g * DM + 256 * j + 4 * lane); a += (v[j].x * w.x + v[j].y * w.y) + (v[j].z * w.z + v[j].w * w.w); }
                a = wave_sum(a); if (lane == g) myg = a; }
            if (lane < 16) Gt[(size_t)row * 16 + lane] = myg * r + gbias[lane];
            if (lane == 0) r1[row] = r;
        }
    }
}
__device__ __forceinline__ void p1_filters(const Ctx& C, LAS unsigned char* lds, int G, int wv) {
    int tid = (wv << 6) | lane_id_opaque(); asm volatile("" : "+v"(tid));
    LAS float* w3s = (LAS float*)lds;
    const float* w3 = C.in[11]; const float* h2 = (const float*)(C.ws + WS_H2); float* FILT = (float*)(C.ws + WS_FILT);
    for (int item = blockIdx.x; item < 512; item += G) {
        const int ntile = item >> 3, tt = item & 7, t = 512 * tt + tid;
        __syncthreads();
        for (int i = tid; i < 4096; i += 512) w3s[i] = w3[(size_t)(i >> 6) * NFILT + 64 * ntile + (i & 63)];
        __syncthreads();
        f32x4 hr[16];
#pragma unroll
        for (int j = 0; j < 16; ++j) hr[j] = *(const f32x4*)(h2 + (size_t)t * 64 + 4 * j);
        const float tl = (float)t / (float)(SEQ - 1);
#pragma unroll 1
        for (int n4 = 0; n4 < 16; ++n4) {
            float a[4] = {0.f, 0.f, 0.f, 0.f};
#pragma unroll
            for (int j = 0; j < 16; ++j) {
#pragma unroll
                for (int jj = 0; jj < 4; ++jj) { const f32x4 wv = *(const LAS f32x4*)(w3s + (4 * j + jj) * 64 + 4 * n4); const float hv = hr[j][jj];
                    a[0] = fmaf(hv, wv.x, a[0]); a[1] = fmaf(hv, wv.y, a[1]); a[2] = fmaf(hv, wv.z, a[2]); a[3] = fmaf(hv, wv.w, a[3]); }
            }
#pragma unroll
            for (int e = 0; e < 4; ++e) { const int n = 64 * ntile + 4 * n4 + e, ch = n & 1023;
                const float mind = -3.0701134573253945f, maxd = -15.350567286626973f;
                const float delta = mind + (float)ch * ((maxd - mind) / 1023.0f);
                FILT[(size_t)n * SEQ + t] = a[e] * expf(-tl * fabsf(delta)); }
        }
    }
    __syncthreads();
}
__device__ __forceinline__ void p7_final(const Ctx& C, int G, int wv) {
    int tid = (wv << 6) | lane_id_opaque(); asm volatile("" : "+v"(tid));
    const int lane = tid & 63, wave = tid >> 6, gw = blockIdx.x * 8 + wave, NGW = G * 8;
    const float* ss3 = (const float*)(C.ws + WS_SS3); const float* wf = C.in[20];
    f32x4 w[8];
#pragma unroll
    for (int j = 0; j < 8; ++j) w[j] = ((const f32x4*)wf)[64 * j + lane];
    for (int row = gw; row < TOK; row += NGW) {
        const float r = 1.0f / sqrtf(ss3[row] * (1.0f / DM) + RMS_EPS);
        f32x4* p = (f32x4*)(C.out + (size_t)row * DM) + lane;
        f32x4 v[8];
#pragma unroll
        for (int j = 0; j < 8; ++j) v[j] = p[64 * j];
#pragma unroll
        for (int j = 0; j < 8; ++j) p[64 * j] = v[j] * r * w[j];
    }
}
#ifndef FFT_HOST
#define FFT_DEV __device__ __forceinline__
#define FFT_PTR LAS f32x2*
#define FFT_SIN(x) __builtin_amdgcn_sinf(x)
#define FFT_COS(x) __builtin_amdgcn_cosf(x)
#else
#define FFT_DEV static inline
#define FFT_PTR f32x2*
#define FFT_SIN(x) sinf(6.283185307179586f * (x))
#define FFT_COS(x) cosf(6.283185307179586f * (x))
#endif
#define PADI(i) ((i) + ((i) >> 4))
FFT_DEV f32x2 cmul(f32x2 a, f32x2 b) { f32x2 r; r.x = a.x * b.x - a.y * b.y; r.y = a.x * b.y + a.y * b.x; return r; }
FFT_DEV f32x2 cmulc(f32x2 a, f32x2 b) { f32x2 r; r.x = a.x * b.x + a.y * b.y; r.y = a.y * b.x - a.x * b.y; return r; }
FFT_DEV f32x2 twid(float frac) { f32x2 r; r.x = FFT_COS(frac); r.y = -FFT_SIN(frac); return r; }
template <int INV> FFT_DEV void fft_r8_pass(FFT_PTR buf, int s, int ls  , int tid) {
    const float R = 0.70710678118654752f;
#pragma unroll 1
    for (int rep = 0; rep < 2; ++rep) {
        const int bf = tid + rep * 512, j = bf & (s - 1), blk = bf >> ls, base = blk * 8 * s + j;
        f32x2 x[8];
#pragma unroll
        for (int m = 0; m < 8; ++m) x[m] = buf[PADI(base + m * s)];
        f32x2 w1 = twid((float)j / (float)(8 * s));
        f32x2 w2 = cmul(w1, w1), w4 = cmul(w2, w2);
        if (INV) { w1.y = -w1.y; w2.y = -w2.y; w4.y = -w4.y; }
        const float sg = INV ? -1.f : 1.f;
        f32x2 c8[4]; c8[0] = (f32x2){1.f, 0.f}; c8[1] = (f32x2){R, -R * sg}; c8[2] = (f32x2){0.f, -1.f * sg}; c8[3] = (f32x2){-R, -R * sg};
        if (!INV) {
#pragma unroll
            for (int m = 0; m < 4; ++m) { f32x2 a = x[m], b = x[m + 4]; x[m] = a + b; x[m + 4] = cmul(a - b, cmul(w1, c8[m])); }
#pragma unroll
            for (int h = 0; h < 8; h += 4)
#pragma unroll
                for (int m = 0; m < 2; ++m) { f32x2 a = x[h + m], b = x[h + m + 2]; x[h + m] = a + b; x[h + m + 2] = cmul(a - b, cmul(w2, c8[2 * m])); }
#pragma unroll
            for (int m = 0; m < 8; m += 2) { f32x2 a = x[m], b = x[m + 1]; x[m] = a + b; x[m + 1] = cmul(a - b, w4); }
        } else {
#pragma unroll
            for (int m = 0; m < 8; m += 2) { f32x2 a = x[m], b = cmul(x[m + 1], w4); x[m] = a + b; x[m + 1] = a - b; }
#pragma unroll
            for (int h = 0; h < 8; h += 4)
#pragma unroll
                for (int m = 0; m < 2; ++m) { f32x2 a = x[h + m], b = cmul(x[h + m + 2], cmul(w2, c8[2 * m])); x[h + m] = a + b; x[h + m + 2] = a - b; }
#pragma unroll
            for (int m = 0; m < 4; ++m) { f32x2 a = x[m], b = cmul(x[m + 4], cmul(w1, c8[m])); x[m] = a + b; x[m + 4] = a - b; }
        }
#pragma unroll
        for (int m = 0; m < 8; ++m) buf[PADI(base + m * s)] = x[m];
    }
}
FFT_DEV void fft_r2_span1(FFT_PTR buf, int tid) {
#pragma unroll
    for (int rep = 0; rep < 8; ++rep) { const int p = 2 * (tid + rep * 512); f32x2 a = buf[PADI(p)], b = buf[PADI(p + 1)]; buf[PADI(p)] = a + b; buf[PADI(p + 1)] = a - b; }
}
#ifndef FFT_HOST
#define FFT_SYNC() __syncthreads()
__device__ __forceinline__ void fft_fwd(FFT_PTR buf, int tid) {
    FFT_SYNC(); fft_r8_pass<0>(buf, 1024, 10, tid); FFT_SYNC(); fft_r8_pass<0>(buf, 128, 7, tid); FFT_SYNC(); fft_r8_pass<0>(buf, 16, 4, tid); FFT_SYNC();
    fft_r8_pass<0>(buf, 2, 1, tid); FFT_SYNC(); fft_r2_span1(buf, tid); FFT_SYNC();
}
__device__ __forceinline__ void fft_inv(FFT_PTR buf, int tid) {
    FFT_SYNC(); fft_r2_span1(buf, tid); FFT_SYNC(); fft_r8_pass<1>(buf, 2, 1, tid); FFT_SYNC(); fft_r8_pass<1>(buf, 16, 4, tid); FFT_SYNC();
    fft_r8_pass<1>(buf, 128, 7, tid); FFT_SYNC(); fft_r8_pass<1>(buf, 1024, 10, tid); FFT_SYNC();
}
#endif
FFT_DEV unsigned brev13(unsigned p) {
    unsigned r = 0;
#ifndef FFT_HOST
    r = __brev(p) >> 19;
#else
    for (int i = 0; i < 13; ++i) r |= ((p >> i) & 1u) << (12 - i);
#endif
    return r;
}
FFT_DEV void fft_pointwise(FFT_PTR wb, FFT_PTR zk, int which, int tid) {
#pragma unroll 4
    for (int rep = 0; rep < 16; ++rep) {
        const unsigned p = tid + rep * 512, f = brev13(p), fn = (8192u - f) & 8191u, pn = brev13(fn);
        const f32x2 zf = zk[PADI(p)], zn = zk[PADI(pn)];
        f32x2 kf;
        if (which == 0) { kf.x = 0.5f * (zf.x + zn.x); kf.y = 0.5f * (zf.y - zn.y); }
        else            { kf.x = 0.5f * (zf.y + zn.y); kf.y = 0.5f * (zn.x - zf.x); }
        wb[PADI(p)] = cmul(wb[PADI(p)], kf);
    }
}
constexpr int ML_KS = 0, ML_KP = 528, ML_SS = 67584, ML_SP = 272, ML_VS = 102400, ML_VP = 80, ML_VW = 112640, ML_CS = 122880, ML_CP = 528, ML_NS = 139776, ML_SC = 140800;
static_assert(ML_SC + 7 * 512 + 64 <= LDS_BYTES, "mLSTM LDS map");
__device__ __forceinline__ bf16x8 tr_read2(unsigned a0, unsigned a1) {
    bf16x4 lo, hi;
    asm volatile("ds_read_b64_tr_b16 %0, %2\n\tds_read_b64_tr_b16 %1, %3\n\ts_waitcnt lgkmcnt(0)" : "=&v"(lo), "=&v"(hi) : "v"(a0), "v"(a1) : "memory");
    bf16x8 r; r[0] = lo[0]; r[1] = lo[1]; r[2] = lo[2]; r[3] = lo[3]; r[4] = hi[0]; r[5] = hi[1]; r[6] = hi[2]; r[7] = hi[3]; return r;
}
__device__ __forceinline__ float bf2f(short s) { return __uint_as_float(((unsigned)(unsigned short)s) << 16); }
__device__ __forceinline__ void unpack8(u32x4 w, float (&f)[8]) { f[0] = bflo(w.x); f[1] = bfhi(w.x); f[2] = bflo(w.y); f[3] = bfhi(w.y); f[4] = bflo(w.z); f[5] = bfhi(w.z); f[6] = bflo(w.w); f[7] = bfhi(w.w); }
__device__ __forceinline__ float logsigmoidf_(float x) { return fminf(x, 0.f) - log1pf(expf(-fabsf(x))); }

__device__ __forceinline__ void mlstm_item(const Ctx& C, LAS unsigned char* lds, int item, int wv) {
    int tid = (wv << 6) | lane_id_opaque(); asm volatile("" : "+v"(tid));
    const int lane = tid & 63, w = __builtin_amdgcn_readfirstlane(tid >> 6), r = lane & 15, g = lane >> 4, q4 = r >> 2, p4 = r & 3;
    const int vs = item & 7, dir = (item >> 3) & 1, bh = item >> 4, b = bh >> 2, h = bh & 3;
    const bf16_t* R1 = (const bf16_t*)(C.ws + WS_R1); const float* Gt = (const float*)(C.ws + WS_G);
    const float* cw = C.in[3]; const float* cb = C.in[4];
    bf16_t* Y = (bf16_t*)(C.ws + (dir ? WS_YBB : WS_YBF));
    LAS float* SC = (LAS float*)(lds + ML_SC);
    LAS float* s_cs = SC, *s_rj = SC + 128, *s_iw = SC + 256, *s_emj = SC + 384, *s_w = SC + 512, *s_dn = SC + 640, *s_misc = SC + 768;
    LAS float* NS = (LAS float*)(lds + ML_NS);
    const unsigned lbase = (unsigned)(size_t)lds;
    const int pc = tid & 31;
    for (int i = tid; i < (ML_NS + 1024 - ML_CS) / 4; i += 512) ((LAS unsigned*)(lds + ML_CS))[i] = 0u;
    f32x4 Cacc[3][2];
#pragma unroll
    for (int a = 0; a < 3; ++a) { Cacc[a][0] = (f32x4){0.f, 0.f, 0.f, 0.f}; Cacc[a][1] = (f32x4){0.f, 0.f, 0.f, 0.f}; }
    float m_prev = 0.f;
    __syncthreads();
#pragma unroll 1
    for (int c = 0; c < 32; ++c) {
        float ip = 0.f, xs = 0.f, csv = 0.f, pmx = 0.f, bcum = 0.f;
        if (tid < 128) {
            const int tau = c * 128 + tid, t = dir ? SEQ - 1 - tau : tau; const size_t tok = (size_t)b * SEQ + t;
            ip = Gt[tok * 16 + (dir * 2) * 4 + h]; const float fp = Gt[tok * 16 + (dir * 2 + 1) * 4 + h];
            xs = logsigmoidf_(fp);
#pragma unroll
            for (int o = 1; o < 64; o <<= 1) { const float y = __shfl_up(xs, o); if (lane >= o) xs += y; }
            if (tid == 63) s_misc[0] = xs;
        }
        __syncthreads();
        if (tid < 128) {
            bcum = xs + (w == 1 ? s_misc[0] : 0.f); csv = ip - bcum; pmx = csv;
#pragma unroll
            for (int o = 1; o < 64; o <<= 1) { const float y = __shfl_up(pmx, o); if (lane >= o) pmx = fmaxf(pmx, y); }
            if (tid == 63) s_misc[1] = pmx;
            if (tid == 127) s_misc[2] = bcum;
        }
        __syncthreads();
        if (tid < 128) { if (w == 1) pmx = fmaxf(pmx, s_misc[1]); if (tid == 127) s_misc[3] = pmx; }
        __syncthreads();
        const float b_last = s_misc[2], m_new = fmaxf(b_last + m_prev, b_last + s_misc[3]), keep = __expf(b_last + m_prev - m_new);
        if (tid < 128) {
            const float inter = bcum + m_prev, mj = fmaxf(inter, bcum + pmx);
            s_cs[tid] = csv; s_rj[tid] = bcum - mj; s_iw[tid] = __expf(inter - mj); s_emj[tid] = __expf(-mj); s_w[tid] = __expf(b_last + csv - m_new);
        }
        __syncthreads();
        float kw0[8], kw1[8], kw2[8], kbv[8];
        { const int ch = 4096 + h * 256 + 8 * pc;
          const f32x4 t0 = *(const f32x4*)(cw + ch), t1 = *(const f32x4*)(cw + ch + 4), t2 = *(const f32x4*)(cw + CONVC + ch), t3 = *(const f32x4*)(cw + CONVC + ch + 4);
          const f32x4 t4 = *(const f32x4*)(cw + 2 * CONVC + ch), t5 = *(const f32x4*)(cw + 2 * CONVC + ch + 4), t6 = *(const f32x4*)(cb + ch), t7 = *(const f32x4*)(cb + ch + 4);
#pragma unroll
          for (int e = 0; e < 4; ++e) { kw0[e] = t0[e]; kw0[4 + e] = t1[e]; kw1[e] = t2[e]; kw1[4 + e] = t3[e]; kw2[e] = t4[e]; kw2[4 + e] = t5[e]; kbv[e] = t6[e]; kbv[4 + e] = t7[e]; } }
#pragma unroll 1
        for (int i = 0; i < 8; ++i) {
            const int row = (tid >> 5) + 16 * i; const int tau = c * 128 + row, t = dir ? SEQ - 1 - tau : tau;
            const bf16_t* p = R1 + ((size_t)b * SEQ + t) * 4096 + 1024 + h * 256 + 8 * pc;
            u32x4 z = {0u, 0u, 0u, 0u};
            const u32x4 w0 = t > 0 ? *(const u32x4*)(p - 4096) : z, w1 = *(const u32x4*)p, w2 = t < SEQ - 1 ? *(const u32x4*)(p + 4096) : z;
            float a0[8], a1[8], a2[8]; unpack8(w0, a0); unpack8(w1, a1); unpack8(w2, a2);
            float v[8];
#pragma unroll
            for (int e = 0; e < 8; ++e) v[e] = siluf_(kw0[e] * a0[e] + kw1[e] * a1[e] + kw2[e] * a2[e] + kbv[e]) * 0.0625f;
            u32x4 o; o.x = pk2(v[0], v[1]); o.y = pk2(v[2], v[3]); o.z = pk2(v[4], v[5]); o.w = pk2(v[6], v[7]);
            *(LAS u32x4*)(lds + ML_KS + row * ML_KP + pc * 16) = o;
        }
        {
            const int row = tid >> 2, pv = tid & 3; const int tau = c * 128 + row, t = dir ? SEQ - 1 - tau : tau;
            const u32x4 vv = *(const u32x4*)(R1 + ((size_t)b * SEQ + t) * 4096 + 2048 + h * 256 + vs * 32 + 8 * pv);
            *(LAS u32x4*)(lds + ML_VS + row * ML_VP + pv * 16) = vv;
            float f[8]; unpack8(vv, f); const float ws_ = s_w[row];
            u32x4 o; o.x = pk2(f[0] * ws_, f[1] * ws_); o.y = pk2(f[2] * ws_, f[3] * ws_); o.z = pk2(f[4] * ws_, f[5] * ws_); o.w = pk2(f[6] * ws_, f[7] * ws_);
            *(LAS u32x4*)(lds + ML_VW + row * ML_VP + pv * 16) = o;
        }
        bf16x8 qf[8];
        {
            const int tau = c * 128 + 16 * w + r, t = dir ? SEQ - 1 - tau : tau;
            const bf16_t* p = R1 + ((size_t)b * SEQ + t) * 4096 + h * 256 + 8 * g;
            const bool has0 = t > 0, has2 = t < SEQ - 1;
            const float* cwq = cw + 3072 + h * 256 + 8 * g; const float* cbq = cb + 3072 + h * 256 + 8 * g;
            asm volatile("" : "+v"(cwq), "+v"(cbq));
#pragma unroll
            for (int kk = 0; kk < 8; ++kk) {
                u32x4 z = {0u, 0u, 0u, 0u};
                const u32x4 w0 = has0 ? *(const u32x4*)(p + 32 * kk - 4096) : z, w1 = *(const u32x4*)(p + 32 * kk), w2 = has2 ? *(const u32x4*)(p + 32 * kk + 4096) : z;
                float a0[8], a1[8], a2[8]; unpack8(w0, a0); unpack8(w1, a1); unpack8(w2, a2);
                const int ch = 32 * kk;
                const f32x4 c0a = *(const f32x4*)(cwq + ch), c0b = *(const f32x4*)(cwq + ch + 4), c1a = *(const f32x4*)(cwq + CONVC + ch), c1b = *(const f32x4*)(cwq + CONVC + ch + 4);
                const f32x4 c2a = *(const f32x4*)(cwq + 2 * CONVC + ch), c2b = *(const f32x4*)(cwq + 2 * CONVC + ch + 4), cba = *(const f32x4*)(cbq + ch), cbb = *(const f32x4*)(cbq + ch + 4);
                float v[8];
#pragma unroll
                for (int e = 0; e < 4; ++e) { v[e] = siluf_(c0a[e] * a0[e] + c1a[e] * a1[e] + c2a[e] * a2[e] + cba[e]); v[4 + e] = siluf_(c0b[e] * a0[4 + e] + c1b[e] * a1[4 + e] + c2b[e] * a2[4 + e] + cbb[e]); }
                u32x4 o; o.x = pk2(v[0], v[1]); o.y = pk2(v[2], v[3]); o.z = pk2(v[4], v[5]); o.w = pk2(v[6], v[7]);
                qf[kk] = __builtin_bit_cast(bf16x8, o);
                asm volatile("" ::: "memory");
            }
        }
        __syncthreads();
        {
            const float rjv = s_rj[16 * w + r]; const int jloc = 16 * w + r; float den1 = 0.f;
#pragma unroll 1
            for (int st = 0; st < 8; ++st) {
                if (st <= w) {
                    f32x4 acc = {0.f, 0.f, 0.f, 0.f};
#pragma unroll
                    for (int kk = 0; kk < 8; ++kk) { const bf16x8 kf = *(const LAS bf16x8*)(lds + ML_KS + (16 * st + r) * ML_KP + (32 * kk + 8 * g) * 2); acc = __builtin_amdgcn_mfma_f32_16x16x32_bf16(kf, qf[kk], acc, 0, 0, 0); }
                    const f32x4 c4 = *(const LAS f32x4*)(s_cs + 16 * st + 4 * g);
                    float v[4];
#pragma unroll
                    for (int i = 0; i < 4; ++i) { const int s = 16 * st + 4 * g + i; const float d = (s <= jloc) ? __expf(rjv + c4[i]) : 0.f; v[i] = acc[i] * d; den1 += v[i]; }
                    u32x2 o; o.x = pk2(v[0], v[1]); o.y = pk2(v[2], v[3]);
                    *(LAS u32x2*)(lds + ML_SS + jloc * ML_SP + (16 * st + 4 * g) * 2) = o;
                } else if (st == w + 1 && !(w & 1)) {
                    u32x2 o = {0u, 0u}; *(LAS u32x2*)(lds + ML_SS + jloc * ML_SP + (16 * st + 4 * g) * 2) = o;
                }
            }
            den1 += __shfl_xor(den1, 16); den1 += __shfl_xor(den1, 32);
            float d2 = 0.f;
#pragma unroll
            for (int kk = 0; kk < 8; ++kk) { const f32x4 n0 = *(const LAS f32x4*)(NS + 32 * kk + 8 * g), n1 = *(const LAS f32x4*)(NS + 32 * kk + 8 * g + 4);
#pragma unroll
                for (int e = 0; e < 4; ++e) { d2 += bf2f(qf[kk][e]) * n0[e]; d2 += bf2f(qf[kk][4 + e]) * n1[e]; } }
            d2 += __shfl_xor(d2, 16); d2 += __shfl_xor(d2, 32);
            if (g == 0) s_dn[jloc] = den1 + s_iw[jloc] * d2;
        }
        __syncthreads();
        {
            f32x4 n1[2], n2[2];
#pragma unroll
            for (int vt = 0; vt < 2; ++vt) { n1[vt] = (f32x4){0.f, 0.f, 0.f, 0.f}; n2[vt] = (f32x4){0.f, 0.f, 0.f, 0.f}; }
            const int nks = (w >> 1) + 1;
#pragma unroll 1
            for (int ks = 0; ks < nks; ++ks) {
                const bf16x8 af = *(const LAS bf16x8*)(lds + ML_SS + (16 * w + r) * ML_SP + (32 * ks + 8 * g) * 2);
#pragma unroll
                for (int vt = 0; vt < 2; ++vt) { const unsigned a0 = lbase + ML_VS + (32 * ks + 8 * g + q4) * ML_VP + (16 * vt + 4 * p4) * 2;
                    const bf16x8 bfr = tr_read2(a0, a0 + 4 * ML_VP); n1[vt] = __builtin_amdgcn_mfma_f32_16x16x32_bf16(af, bfr, n1[vt], 0, 0, 0); }
            }
#pragma unroll
            for (int kk = 0; kk < 8; ++kk)
#pragma unroll
                for (int vt = 0; vt < 2; ++vt) { const bf16x8 cf = *(const LAS bf16x8*)(lds + ML_CS + (16 * vt + r) * ML_CP + (32 * kk + 8 * g) * 2); n2[vt] = __builtin_amdgcn_mfma_f32_16x16x32_bf16(qf[kk], cf, n2[vt], 0, 0, 0); }
            const f32x4 iw4 = *(const LAS f32x4*)(s_iw + 16 * w + 4 * g), dn4 = *(const LAS f32x4*)(s_dn + 16 * w + 4 * g), em4 = *(const LAS f32x4*)(s_emj + 16 * w + 4 * g);
#pragma unroll
            for (int i = 0; i < 4; ++i) {
                const int tau = c * 128 + 16 * w + 4 * g + i, t = dir ? SEQ - 1 - tau : tau; const size_t tok = (size_t)b * SEQ + t;
                const float inv = 1.0f / fmaxf(fabsf(dn4[i]), em4[i]);
#pragma unroll
                for (int vt = 0; vt < 2; ++vt) { const int col = h * 256 + vs * 32 + 16 * vt + r;
                    const float og = __uint_as_float(((unsigned)R1[tok * 4096 + 3072 + col]) << 16);
                    const float hv = (n1[vt][i] + iw4[i] * n2[vt][i]) * inv * og;
                    Y[tok * 1024 + col] = (bf16_t)f2bf(hv); }
            }
        }
        __syncthreads();
        {
#pragma unroll
            for (int a = 0; a < 3; ++a) { Cacc[a][0] *= keep; Cacc[a][1] *= keep; }
#pragma unroll 1
            for (int ks = 0; ks < 4; ++ks) {
                bf16x8 af[3];
#pragma unroll
                for (int mt = 0; mt < 2; ++mt) { const unsigned a0 = lbase + ML_VW + (32 * ks + 8 * g + q4) * ML_VP + (16 * mt + 4 * p4) * 2; af[mt] = tr_read2(a0, a0 + 4 * ML_VP); }
                { const f32x4 wa = *(const LAS f32x4*)(s_w + 32 * ks + 8 * g), wb = *(const LAS f32x4*)(s_w + 32 * ks + 8 * g + 4);
                  u32x4 o; o.x = pk2(wa[0], wa[1]); o.y = pk2(wa[2], wa[3]); o.z = pk2(wb[0], wb[1]); o.w = pk2(wb[2], wb[3]);
                  if (r != 0) { o.x = 0u; o.y = 0u; o.z = 0u; o.w = 0u; }
                  af[2] = __builtin_bit_cast(bf16x8, o); }
#pragma unroll
                for (int nt = 0; nt < 2; ++nt) { const unsigned a0 = lbase + ML_KS + (32 * ks + 8 * g + q4) * ML_KP + (32 * w + 16 * nt + 4 * p4) * 2;
                    const bf16x8 bfr = tr_read2(a0, a0 + 4 * ML_KP);
#pragma unroll
                    for (int mt = 0; mt < 3; ++mt) Cacc[mt][nt] = __builtin_amdgcn_mfma_f32_16x16x32_bf16(af[mt], bfr, Cacc[mt][nt], 0, 0, 0); }
            }
#pragma unroll
            for (int mt = 0; mt < 2; ++mt)
#pragma unroll
                for (int nt = 0; nt < 2; ++nt)
#pragma unroll
                    for (int i = 0; i < 4; ++i) *(LAS bf16_t*)(lds + ML_CS + (16 * mt + 4 * g + i) * ML_CP + (32 * w + 16 * nt + r) * 2) = (bf16_t)f2bf(Cacc[mt][nt][i]);
            if (g == 0) { NS[32 * w + r] = Cacc[2][0][0]; NS[32 * w + 16 + r] = Cacc[2][1][0]; }
        }
        m_prev = m_new;
        __syncthreads();
    }
}
constexpr int HY_ZK = 0, HY_WB = 69632;
static_assert(HY_WB + 69632 <= LDS_BYTES, "hyena LDS map");
__device__ __forceinline__ float hy_conv(const bf16_t* p  , int off, int t, float w0, float w1, float w2, float bias) {
    const float a1 = __uint_as_float(((unsigned)p[off]) << 16);
    const float a0 = t > 0 ? __uint_as_float(((unsigned)p[off - 1]) << 16) : 0.f;
    const float a2 = t < SEQ - 1 ? __uint_as_float(((unsigned)p[off + 1]) << 16) : 0.f;
    return w0 * a0 + w1 * a1 + w2 * a2 + bias;
}
__device__ __forceinline__ void hyena_item(const Ctx& C, LAS unsigned char* lds, int ch, int wv) {
    int tid = (wv << 6) | lane_id_opaque(); asm volatile("" : "+v"(tid));
    LAS f32x2* zk = (LAS f32x2*)(lds + HY_ZK); LAS f32x2* wb = (LAS f32x2*)(lds + HY_WB);
    const float* FILT = (const float*)(C.ws + WS_FILT); const bf16_t* HYb = (const bf16_t*)(C.ws + WS_HY); bf16_t* YA = (bf16_t*)(C.ws + WS_YA);
    const float* cw = C.in[3]; const float* cb = C.in[4];
    float w0[3], w1[3], w2[3], bs[3];
#pragma unroll
    for (int s = 0; s < 3; ++s) { w0[s] = cw[s * 1024 + ch]; w1[s] = cw[CONVC + s * 1024 + ch]; w2[s] = cw[2 * CONVC + s * 1024 + ch]; bs[s] = cb[s * 1024 + ch]; }
    const float hb0 = C.in[12][ch], hb1 = C.in[12][1024 + ch];
    const float* F0 = FILT + (size_t)(0 * 1024 + ch) * SEQ; const float* F1 = FILT + (size_t)(1 * 1024 + ch) * SEQ;
    const float* F2 = FILT + (size_t)(2 * 1024 + ch) * SEQ; const float* F3 = FILT + (size_t)(3 * 1024 + ch) * SEQ;
    __syncthreads();
#pragma unroll 4
    for (int rep = 0; rep < 16; ++rep) { const int i = tid + 512 * rep; float a, b;
        if (i < SEQ) { a = F0[i]; b = F2[i]; } else if (i == SEQ) { a = 0.f; b = 0.f; } else { a = F1[2 * SEQ - i]; b = F3[2 * SEQ - i]; }
        zk[PADI(i)] = (f32x2){a * (1.0f / 8192.0f), b * (1.0f / 8192.0f)}; }
    fft_fwd(zk, tid);
#pragma unroll 1
    for (int p = 0; p < 2; ++p) {
        const int tb0 = (2 * p) * SEQ, tb1 = (2 * p + 1) * SEQ;
        f32x2 vv[8], zz[8];
        const bf16_t* pv0 = HYb + (size_t)ch * TOK + tb0 + tid; const bf16_t* pv1 = pv0 + SEQ; asm volatile("" : "+v"(pv0), "+v"(pv1));
#pragma unroll
        for (int m = 0; m < 8; ++m) { const int t = tid + 512 * m;
            vv[m].x = hy_conv(pv0, 512 * m, t, w0[0], w1[0], w2[0], bs[0]); vv[m].y = hy_conv(pv1, 512 * m, t, w0[0], w1[0], w2[0], bs[0]);
            wb[PADI(t)] = vv[m]; wb[PADI(t + SEQ)] = (f32x2){0.f, 0.f}; }
        fft_fwd(wb, tid); fft_pointwise(wb, zk, 0, tid); fft_inv(wb, tid);
        const bf16_t* px0 = HYb + (size_t)(1024 + ch) * TOK + tb0 + tid; const bf16_t* px1 = px0 + SEQ; asm volatile("" : "+v"(px0), "+v"(px1));
#pragma unroll
        for (int m = 0; m < 8; ++m) { const int t = tid + 512 * m; const f32x2 y = wb[PADI(t)];
            const float xa = hy_conv(px0, 512 * m, t, w0[1], w1[1], w2[1], bs[1]), xb_ = hy_conv(px1, 512 * m, t, w0[1], w1[1], w2[1], bs[1]);
            zz[m].x = xa * (y.x + vv[m].x * hb0); zz[m].y = xb_ * (y.y + vv[m].y * hb0); }
#pragma unroll
        for (int m = 0; m < 8; ++m) { const int t = tid + 512 * m; wb[PADI(t)] = zz[m]; wb[PADI(t + SEQ)] = (f32x2){0.f, 0.f}; }
        fft_fwd(wb, tid); fft_pointwise(wb, zk, 1, tid); fft_inv(wb, tid);
        const bf16_t* py0 = HYb + (size_t)(2048 + ch) * TOK + tb0 + tid; const bf16_t* py1 = py0 + SEQ; asm volatile("" : "+v"(py0), "+v"(py1));
#pragma unroll
        for (int m = 0; m < 8; ++m) { const int t = tid + 512 * m; const f32x2 y = wb[PADI(t)];
            const float xa = hy_conv(py0, 512 * m, t, w0[2], w1[2], w2[2], bs[2]), xb_ = hy_conv(py1, 512 * m, t, w0[2], w1[2], w2[2], bs[2]);
            YA[(size_t)(tb0 + t) * 1024 + ch] = (bf16_t)f2bf(xa * (y.x + zz[m].x * hb1));
            YA[(size_t)(tb1 + t) * 1024 + ch] = (bf16_t)f2bf(xb_ * (y.y + zz[m].y * hb1)); }
        __syncthreads();
    }
}
__device__ __forceinline__ void grid_bar(unsigned* cnt, unsigned target, int wv) {
    asm volatile("s_waitcnt vmcnt(0)" ::: "memory");
    __syncthreads();
    const int lane = lane_id_opaque();
    if (wv == 0 && lane == 0) {
        __builtin_amdgcn_fence(__ATOMIC_RELEASE, "agent");
        asm volatile("s_waitcnt vmcnt(0)" ::: "memory");
        __hip_atomic_fetch_add(cnt, 1u, __ATOMIC_RELAXED, __HIP_MEMORY_SCOPE_AGENT);
        while (__hip_atomic_load(cnt, __ATOMIC_RELAXED, __HIP_MEMORY_SCOPE_AGENT) < target) __builtin_amdgcn_s_sleep(2);
        __builtin_amdgcn_fence(__ATOMIC_ACQUIRE, "agent");
        asm volatile("s_waitcnt vmcnt(0)" ::: "memory");
    }
    __syncthreads();
}
struct Params { const float* in[21]; float* out; unsigned char* ws; };
__global__ void __launch_bounds__(512, 2) fwd_megakernel(Params prm) {
    extern __shared__ __attribute__((aligned(16))) unsigned char lds_raw[];
    LAS unsigned char* lds = (LAS unsigned char*)lds_raw;
    cg::grid_group grid = cg::this_grid();
    const int G = gridDim.x, bx = blockIdx.x;
    const int wv = __builtin_amdgcn_readfirstlane((int)(threadIdx.x >> 6));
    Ctx C;
#pragma unroll
    for (int i = 0; i < 21; ++i) C.in[i] = prm.in[i];
    C.out = prm.out; C.ws = prm.ws;
    unsigned char* ws = prm.ws;
    unsigned* gbar = (unsigned*)(ws + WS_BAR);
    if (bx == 0 && threadIdx.x == 0) *gbar = 0u;
    p0_prologue(C, lds, G, wv);
    grid.sync();
    p1_filters(C, lds, G, wv);
    { HyProg P; P.K = DM; P.G = G; P.c = bx; P.W = (const bf16_t*)(ws + WS_WIN); P.X = (const bf16_t*)(ws + WS_XB); P.HY = (bf16_t*)(ws + WS_HY); P.r1 = (const float*)(ws + WS_R1S);
      pg8::gemm_stream(lds, P, wv); }
    { RestProg P; P.K = DM; P.G = G; P.c = bx; P.W = (const bf16_t*)(ws + WS_WIN); P.X = (const bf16_t*)(ws + WS_XB); P.R1 = (bf16_t*)(ws + WS_R1); P.R2 = (bf16_t*)prm.out; P.r1 = (const float*)(ws + WS_R1S);
      pg8::gemm_stream(lds, P, wv); }
    grid_bar(gbar, 1u * (unsigned)G, wv);
    for (int item = bx; item < 256; item += G) mlstm_item(C, lds, item, wv);
    for (int idx = bx; idx < 1024; idx += G) { const int rd = idx >> 8, bb = idx & 255; hyena_item(C, lds, rd * 256 + (bb & 7) * 32 + (bb >> 3), wv); }
    grid_bar(gbar, 2u * (unsigned)G, wv);
    { BranchProg P; P.K = 1024; P.G = G; P.c = bx; P.YA = (const bf16_t*)(ws + WS_YA); P.YBF = (const bf16_t*)(ws + WS_YBF); P.YBB = (const bf16_t*)(ws + WS_YBB);
      P.WA = (const bf16_t*)(ws + WS_WA); P.WB = (const bf16_t*)(ws + WS_WB); P.R2 = (const bf16_t*)prm.out; P.MIX = (bf16_t*)(ws + WS_MIX);
      pg8::gemm_stream(lds, P, wv); }
    grid_bar(gbar, 3u * (unsigned)G, wv);
    { ResProg P; P.K = DM; P.G = G; P.c = bx; P.A = (const bf16_t*)(ws + WS_MIX); P.B = (const bf16_t*)(ws + WS_WOUT); P.base = prm.in[0]; P.out = prm.out; P.outb = (bf16_t*)(ws + WS_X1B); P.ss = (float*)(ws + WS_SS2);
      pg8::gemm_stream(lds, P, wv); }
    grid_bar(gbar, 4u * (unsigned)G, wv);
    { GuProg P; P.K = DM; P.G = G; P.c = bx; P.X = (const bf16_t*)(ws + WS_X1B); P.W = (const bf16_t*)(ws + WS_WGU); P.HH = (bf16_t*)(ws + WS_HH); P.ss2 = (const float*)(ws + WS_SS2);
      pg8::gemm_stream(lds, P, wv); }
    grid_bar(gbar, 5u * (unsigned)G, wv);
    { ResProg P; P.K = FFH; P.G = G; P.c = bx; P.A = (const bf16_t*)(ws + WS_HH); P.B = (const bf16_t*)(ws + WS_WD); P.base = prm.out; P.out = prm.out; P.outb = nullptr; P.ss = (float*)(ws + WS_SS3);
      pg8::gemm_stream(lds, P, wv); }
    grid_bar(gbar, 6u * (unsigned)G, wv);
    p7_final(C, G, wv);
}

extern "C" void kernel_launch(void* const* d_in, const int* in_sizes, int n_in, void* d_out, int out_size, void* d_ws, size_t ws_size, hipStream_t stream) {
    static int grid = 0;
    if (grid == 0) {
        int dev = 0, cus = 0, per_cu = 0;
        hipGetDevice(&dev); hipDeviceGetAttribute(&cus, hipDeviceAttributeMultiprocessorCount, dev);
        if (hipFuncSetAttribute((const void*)fwd_megakernel, hipFuncAttributeMaxDynamicSharedMemorySize, LDS_BYTES) != hipSuccess) { fprintf(stderr, "kernel_launch: hipFuncSetAttribute failed\n"); grid = -1; return; }
        if (hipOccupancyMaxActiveBlocksPerMultiprocessor(&per_cu, (const void*)fwd_megakernel, 512, LDS_BYTES) != hipSuccess || per_cu < 1) { fprintf(stderr, "kernel_launch: occupancy query gave %d\n", per_cu); per_cu = 1; }
        (void)hipGetLastError();
        grid = cus * 1;
        if (n_in != 21 || ws_size < WS_END) { fprintf(stderr, "kernel_launch: unexpected n_in %d or ws %zu\n", n_in, ws_size); grid = -1; return; }
    }
    if (grid < 0) return;
    Params p{};
    for (int i = 0; i < 21; ++i) p.in[i] = (const float*)d_in[i];
    p.out = (float*)d_out; p.ws = (unsigned char*)d_ws;
    void* args[] = {&p};
    hipError_t e = hipLaunchCooperativeKernel((const void*)fwd_megakernel, dim3(grid), dim3(512), args, LDS_BYTES, stream);
    if (e != hipSuccess) fprintf(stderr, "cooperative launch failed: %s (grid %d)\n", hipGetErrorString(e), grid);
}
```

```cpp
#include <hip/hip_runtime.h>
#include <hip/hip_cooperative_groups.h>
#include <cstdio>
namespace cg = cooperative_groups;

#define LAS __attribute__((address_space(3)))
typedef unsigned short bf16_t;
typedef short bf16x8 __attribute__((ext_vector_type(8)));
typedef short bf16x4 __attribute__((ext_vector_type(4)));
typedef float f32x4 __attribute__((ext_vector_type(4)));
typedef float f32x2 __attribute__((ext_vector_type(2)));
typedef unsigned u32x4 __attribute__((ext_vector_type(4)));
typedef unsigned u32x2 __attribute__((ext_vector_type(2)));

constexpr int NB = 4, SEQ = 4096, TOK = NB * SEQ, DM = 2048, HW = 1024, MW = 1024, NHEAD = 4, DH = 256, FFH = 5632;
constexpr int CONVC = 5120, INCOLS = 11280, NFILT = 4096;
constexpr float RMS_EPS = 1e-6f;
constexpr size_t MiB = 1u << 20;
constexpr size_t WS_BAR = 262144, WS_R1S = 0, WS_SS2 = 65536, WS_SS3 = 131072, WS_G = 1 * MiB, WS_H2 = 2 * MiB;
constexpr size_t WS_WA = 4 * MiB, WS_WB = 8 * MiB, WS_WOUT = 12 * MiB, WS_WGU = 20 * MiB, WS_WD = 64 * MiB, WS_WIN = 86 * MiB, WS_XB = 130 * MiB;
constexpr size_t WS_FILT = 194 * MiB, WS_HY = 258 * MiB, WS_R1A = 354 * MiB, WS_R1B = 418 * MiB, WS_END = 482 * MiB;
constexpr size_t WS_QKP = 86 * MiB, WS_YA = 150 * MiB, WS_YBF = 354 * MiB, WS_YBB = 386 * MiB, WS_X1B = 86 * MiB, WS_MIX = 194 * MiB, WS_HH = 258 * MiB;
constexpr int LDS_BYTES = 147456;

__device__ __forceinline__ unsigned f2bf(float f) { unsigned u = __float_as_uint(f); return (u + 0x7fffu + ((u >> 16) & 1u)) >> 16; }
__device__ __forceinline__ unsigned pk2(float lo, float hi) { unsigned r; asm volatile("v_cvt_pk_bf16_f32 %0, %1, %2" : "=v"(r) : "v"(lo), "v"(hi)); return r; }
__device__ __forceinline__ float bflo(unsigned w) { return __uint_as_float(w << 16); }
__device__ __forceinline__ float bfhi(unsigned w) { return __uint_as_float(w & 0xffff0000u); }
__device__ __forceinline__ float wave_sum(float v) {
#pragma unroll
    for (int o = 1; o < 64; o <<= 1) v += __shfl_xor(v, o);
    return v;
}
__device__ __forceinline__ int lane_id_opaque() { int l; asm volatile("v_mbcnt_lo_u32_b32 %0, -1, 0\n\tv_mbcnt_hi_u32_b32 %0, -1, %0" : "=v"(l)); return l; }
__device__ __forceinline__ float sigmoidf_(float x) { return 1.0f / (1.0f + __expf(-x)); }
__device__ __forceinline__ float siluf_(float x) { return x / (1.0f + __expf(-x)); }

namespace pg8 {
constexpr int BM = 256, BK = 64, HALF = 128, HTB = HALF * BK * 2, STAGE_BYTES = 8 * HTB, NXCD = 8, WGM = 8;
__device__ __forceinline__ int lds_byte(int r, int c) { const int st = (r >> 4) * 2 + (c >> 5), rr = r & 15, cc = c & 31, ob = rr * 64 + cc * 2; return st * 1024 + (ob ^ (((ob >> 9) & 1) << 5)); }
__device__ __forceinline__ void stage_rc(int b, int& R, int& C) { const int st = b / 1024, sb = b % 1024, swz = sb ^ (((sb >> 9) & 1) << 5); R = (st >> 1) * 16 + swz / 64; C = (st & 1) * 32 + (swz % 64) / 2; }
__device__ __forceinline__ int perm32(int rho) { const int n = rho >> 4, i = rho & 15; return 8 * (i >> 2) + 4 * n + (i & 3); }
struct GUnit { const char* A; const char* B; int pm, pn, sub; };
__device__ __forceinline__ void tile_of(int L, int nM, int nN, int& pm, int& pn) {
    const int nwg = nM * nN; int wgid = L; { const int q = nwg / NXCD, r = nwg % NXCD, xcd = wgid % NXCD, off = wgid / NXCD; wgid = (xcd < r ? xcd * (q + 1) : r * (q + 1) + (xcd - r) * q) + off; }
    const int nig = WGM * nN, gid = wgid / nig, fm = gid * WGM, gsz = (nM - fm) < WGM ? (nM - fm) : WGM;
    pm = fm + ((wgid % nig) % gsz); pn = (wgid % nig) / gsz;
}
typedef f32x4 Acc[2][2][4][2];
template <class Prog>
__device__ __forceinline__ void gemm_stream(LAS unsigned char* lds, const Prog& P, int wv) {
    int tid = (wv << 6) | lane_id_opaque(); asm volatile("" : "+v"(tid));
    const int wid = __builtin_amdgcn_readfirstlane(tid >> 6), lane = tid & 63, wr = wid >> 2, wc = wid & 3, fr = lane & 15, fq = lane >> 4;
    const int K = P.K, nt = K / BK;
    unsigned voffA[2], voffB[2];
#pragma unroll
    for (int i = 0; i < 2; ++i) { int R, C; stage_rc(tid * 16 + i * 8192, R, C); const int Rb = Prog::PERM ? ((R & ~31) + perm32(R & 31)) : R;
        voffA[i] = (unsigned)(R * K + C) * 2u; voffB[i] = (unsigned)(Rb * K + C) * 2u; }
    const size_t kstep = (size_t)(BK * 2);
    const size_t hstep = (size_t)HALF * K * 2;
    const unsigned ldsw = (unsigned)wid * 1024u;
    const int aoff = lds_byte(wr * 64 + fr, fq * 8), boff = lds_byte(wc * 32 + fr, fq * 8);
#define PG8_SA(b, h) (((b) * 2 + (h)) * HTB)
#define PG8_SB(b, h) ((4 + (b) * 2 + (h)) * HTB)
#define PG8_STAGE(bufoff, gbase, voff) do { _Pragma("unroll") for (int _i = 0; _i < 2; ++_i) \
        __builtin_amdgcn_global_load_lds((const unsigned*)((const char*)(gbase) + (voff)[_i]), (LAS unsigned*)(lds + (bufoff) + ldsw + _i * 8192), 16, 0, 0); } while (0)
#define PG8_LDA(dst, b, h) do { _Pragma("unroll") for (int m = 0; m < 4; ++m) _Pragma("unroll") for (int k = 0; k < 2; ++k) dst[m][k] = *(const LAS bf16x8*)(lds + PG8_SA(b, h) + aoff + m * 2048 + k * 1024); } while (0)
#define PG8_LDB(dst, b, h) do { _Pragma("unroll") for (int n = 0; n < 2; ++n) _Pragma("unroll") for (int k = 0; k < 2; ++k) dst[n][k] = *(const LAS bf16x8*)(lds + PG8_SB(b, h) + boff + n * 2048 + k * 1024); } while (0)
#define PG8_MMA(ai, bj, At, Bt) do { __builtin_amdgcn_s_setprio(1); _Pragma("unroll") for (int m = 0; m < 4; ++m) _Pragma("unroll") for (int n = 0; n < 2; ++n) _Pragma("unroll") for (int k = 0; k < 2; ++k) \
        acc[ai][bj][m][n] = __builtin_amdgcn_mfma_f32_16x16x32_bf16(Bt[n][k], At[m][k], acc[ai][bj][m][n], 0, 0, 0); __builtin_amdgcn_s_setprio(0); } while (0)
#define PG8_WAIT_V(n) asm volatile("s_waitcnt vmcnt(" #n ")" ::: "memory")
#define PG8_WAIT_L(n) asm volatile("s_waitcnt lgkmcnt(" #n ")" ::: "memory")
#define PG8_BAR __builtin_amdgcn_s_barrier()
#define PG8_SCHED __builtin_amdgcn_sched_barrier(0)
    GUnit cur, nxt; int ui = 0;
    if (!P.next(0, cur)) return;
    f32x4 acc[2][2][4][2];
#pragma unroll
    for (int a = 0; a < 2; ++a)
#pragma unroll
        for (int b = 0; b < 2; ++b)
#pragma unroll
            for (int m = 0; m < 4; ++m)
#pragma unroll
                for (int n = 0; n < 2; ++n) acc[a][b][m][n] = (f32x4){0.f, 0.f, 0.f, 0.f};
    bf16x8 At[4][2], B0[2][2], B1[2][2];
    const char* cA = cur.A; const char* cB = cur.B;
    PG8_STAGE(PG8_SB(0, 0), cB, voffB); PG8_STAGE(PG8_SA(0, 0), cA, voffA); PG8_STAGE(PG8_SB(0, 1), cB + hstep, voffB); PG8_STAGE(PG8_SA(0, 1), cA + hstep, voffA);
    if (wr == 1) PG8_BAR;
    PG8_WAIT_V(4); PG8_BAR;
    PG8_STAGE(PG8_SB(1, 0), cB + kstep, voffB); PG8_STAGE(PG8_SA(1, 0), cA + kstep, voffA); PG8_STAGE(PG8_SB(1, 1), cB + hstep + kstep, voffB);
    PG8_WAIT_V(6); PG8_BAR;
    for (;;) {
        const bool has_next = P.next(ui + 1, nxt);
        const char* nA = has_next ? nxt.A : cA; const char* nB = has_next ? nxt.B : cB;
        for (int t = 0; t < nt; t += 2) {
            const bool last = (t == nt - 2);
            const char* a1 = cA + (size_t)(t + 1) * kstep;
            const char* a2 = last ? nA : cA + (size_t)(t + 2) * kstep; const char* b2 = last ? nB : cB + (size_t)(t + 2) * kstep;
            const char* a3 = a2 + kstep; const char* b3 = b2 + kstep;
            PG8_LDB(B0, 0, 0); PG8_SCHED; PG8_LDA(At, 0, 0); PG8_STAGE(PG8_SA(1, 1), a1 + hstep, voffA);
            PG8_WAIT_L(8); PG8_BAR; PG8_WAIT_L(0); PG8_MMA(0, 0, At, B0); PG8_BAR; PG8_SCHED;
            PG8_LDB(B1, 0, 1); PG8_STAGE(PG8_SB(0, 0), b2, voffB);
            PG8_BAR; PG8_WAIT_L(0); PG8_MMA(0, 1, At, B1); PG8_BAR;
            PG8_LDA(At, 0, 1); PG8_STAGE(PG8_SA(0, 0), a2, voffA);
            PG8_BAR; PG8_WAIT_L(0); PG8_MMA(1, 0, At, B0); PG8_BAR; PG8_SCHED;
            PG8_STAGE(PG8_SB(0, 1), b2 + hstep, voffB);
            PG8_WAIT_V(6); PG8_BAR; PG8_MMA(1, 1, At, B1); PG8_BAR;
            PG8_LDB(B0, 1, 0); PG8_SCHED; PG8_LDA(At, 1, 0); PG8_STAGE(PG8_SA(0, 1), a2 + hstep, voffA);
            PG8_WAIT_L(8); PG8_BAR; PG8_WAIT_L(0); PG8_MMA(0, 0, At, B0); PG8_BAR; PG8_SCHED;
            PG8_LDB(B1, 1, 1); PG8_STAGE(PG8_SB(1, 0), b3, voffB);
            PG8_BAR; PG8_WAIT_L(0); PG8_MMA(0, 1, At, B1); PG8_BAR;
            PG8_LDA(At, 1, 1); PG8_STAGE(PG8_SA(1, 0), a3, voffA);
            PG8_BAR; PG8_WAIT_L(0); PG8_MMA(1, 0, At, B0); PG8_BAR; PG8_SCHED;
            PG8_STAGE(PG8_SB(1, 1), b3 + hstep, voffB);
            PG8_WAIT_V(6); PG8_BAR; PG8_MMA(1, 1, At, B1); PG8_BAR;
        }
        P.epi(acc, cur, wr, wc, fr, fq);
        if (!has_next) break;
        cur = nxt; cA = nA; cB = nB; ++ui;
    }
    PG8_WAIT_V(0);
    if (wr == 0) PG8_BAR;
    PG8_BAR;
#undef PG8_SA
#undef PG8_SB
#undef PG8_STAGE
#undef PG8_LDA
#undef PG8_LDB
#undef PG8_MMA
#undef PG8_WAIT_V
#undef PG8_WAIT_L
#undef PG8_BAR
#undef PG8_SCHED
}
__device__ __forceinline__ void zero_acc(Acc& acc) {
#pragma unroll
    for (int a = 0; a < 2; ++a)
#pragma unroll
        for (int b = 0; b < 2; ++b)
#pragma unroll
            for (int m = 0; m < 4; ++m)
#pragma unroll
                for (int n = 0; n < 2; ++n) acc[a][b][m][n] = (f32x4){0.f, 0.f, 0.f, 0.f};
}
}
using pg8::GUnit; using pg8::Acc;
struct HyProg {
    static constexpr bool PERM = true; int K, G, c; const bf16_t* W; const bf16_t* X; bf16_t* HY; const float* r1;
    __device__ __forceinline__ bool next(int i, GUnit& u) const { const int L = i * G + c; if (L >= 12 * 64) return false; pg8::tile_of(L, 12, 64, u.pm, u.pn);
        u.A = (const char*)(W + (size_t)u.pm * 256 * DM); u.B = (const char*)(X + (size_t)u.pn * 256 * DM); u.sub = 0; return true; }
    __device__ __forceinline__ void epi(Acc& acc, const GUnit& u, int wr, int wc, int fr, int fq) const {
        const int row0 = u.pm * 256 + wr * 64 + fr, col0 = u.pn * 256 + wc * 32 + 8 * fq;
        f32x4 sc[2][2];
#pragma unroll
        for (int bj = 0; bj < 2; ++bj) { sc[bj][0] = *(const f32x4*)(r1 + col0 + bj * 128); sc[bj][1] = *(const f32x4*)(r1 + col0 + bj * 128 + 4); }
#pragma unroll
        for (int ai = 0; ai < 2; ++ai)
#pragma unroll
            for (int m = 0; m < 4; ++m) { bf16_t* rowp = HY + (size_t)(row0 + ai * 128 + m * 16) * TOK + col0;
#pragma unroll
                for (int bj = 0; bj < 2; ++bj) { const f32x4 v0 = acc[ai][bj][m][0] * sc[bj][0], v1 = acc[ai][bj][m][1] * sc[bj][1];
                    u32x4 w; w.x = pk2(v0[0], v0[1]); w.y = pk2(v0[2], v0[3]); w.z = pk2(v1[0], v1[1]); w.w = pk2(v1[2], v1[3]);
                    *(u32x4*)(rowp + bj * 128) = w; } }
        pg8::zero_acc(acc);
    }
};
struct RestProg {
    static constexpr bool PERM = true; int K, G, c; const bf16_t* W; const bf16_t* X; bf16_t* R1A; bf16_t* R1B; bf16_t* R2; const float* r1;
    __device__ __forceinline__ bool next(int i, GUnit& u) const { const int L = i * G + c; if (L >= 64 * 32) return false; pg8::tile_of(L, 64, 32, u.pm, u.pn);
        u.A = (const char*)(X + (size_t)u.pm * 256 * DM); u.B = (const char*)(W + (size_t)(3072 + u.pn * 256) * DM); u.sub = 0; return true; }
    __device__ __forceinline__ void epi(Acc& acc, const GUnit& u, int wr, int wc, int fr, int fq) const {
        const int row0 = u.pm * 256 + wr * 64 + fr; const bool sg = u.pn >= 12;
        bf16_t* base = u.pn < 8 ? R1A + u.pn * 256 : (u.pn < 16 ? R1B + (u.pn - 8) * 256 : R2 + (u.pn - 16) * 256);
        const int pitch = u.pn < 16 ? 2048 : 4096;
        const int col0 = wc * 32 + 8 * fq;
#pragma unroll
        for (int ai = 0; ai < 2; ++ai)
#pragma unroll
            for (int m = 0; m < 4; ++m) { const int row = row0 + ai * 128 + m * 16; const float s = r1[row]; bf16_t* rowp = base + (size_t)row * pitch + col0;
#pragma unroll
                for (int bj = 0; bj < 2; ++bj) { f32x4 v0 = acc[ai][bj][m][0] * s, v1 = acc[ai][bj][m][1] * s;
                    if (sg) {
#pragma unroll
                        for (int j = 0; j < 4; ++j) { v0[j] = sigmoidf_(v0[j]); v1[j] = sigmoidf_(v1[j]); } }
                    u32x4 w; w.x = pk2(v0[0], v0[1]); w.y = pk2(v0[2], v0[3]); w.z = pk2(v1[0], v1[1]); w.w = pk2(v1[2], v1[3]);
                    *(u32x4*)(rowp + bj * 128) = w; } }
        pg8::zero_acc(acc);
    }
};
struct BranchProg {
    static constexpr bool PERM = true; int K, G, c; const bf16_t *YA, *YBF, *YBB, *WA, *WB; const bf16_t* R2; bf16_t* MIX;
    __device__ __forceinline__ bool next(int i, GUnit& u) const { const int ti = i / 3, sub = i - 3 * ti; const int L = ti * G + c; if (L >= 64 * 8) return false; pg8::tile_of(L, 64, 8, u.pm, u.pn);
        const bf16_t* a = sub == 0 ? YA : (sub == 1 ? YBF : YBB); const bf16_t* b = sub == 0 ? WA : WB;
        u.A = (const char*)(a + (size_t)u.pm * 256 * 1024); u.B = (const char*)(b + (size_t)u.pn * 256 * 1024); u.sub = sub; return true; }
    __device__ __forceinline__ void epi(Acc& acc, const GUnit& u, int wr, int wc, int fr, int fq) const {
        if (u.sub == 1) return;
        const int row0 = u.pm * 256 + wr * 64 + fr, col0 = u.pn * 256 + wc * 32 + 8 * fq;
#pragma unroll
        for (int ai = 0; ai < 2; ++ai)
#pragma unroll
            for (int m = 0; m < 4; ++m) { const int row = row0 + ai * 128 + m * 16; const bf16_t* gp = R2 + (size_t)row * 4096 + col0;
#pragma unroll
                for (int bj = 0; bj < 2; ++bj) {
                    const u32x4 gbw = *(const u32x4*)(gp + 2048 + bj * 128);
                    float gb[8] = {bflo(gbw.x), bfhi(gbw.x), bflo(gbw.y), bfhi(gbw.y), bflo(gbw.z), bfhi(gbw.z), bflo(gbw.w), bfhi(gbw.w)};
                    if (u.sub == 0) {
                        const u32x4 gaw = *(const u32x4*)(gp + bj * 128);
                        float ga[8] = {bflo(gaw.x), bfhi(gaw.x), bflo(gaw.y), bfhi(gaw.y), bflo(gaw.z), bfhi(gaw.z), bflo(gaw.w), bfhi(gaw.w)};
#pragma unroll
                        for (int j = 0; j < 4; ++j) { acc[ai][bj][m][0][j] *= ga[j] / fmaxf(gb[j], 1e-30f); acc[ai][bj][m][1][j] *= ga[4 + j] / fmaxf(gb[4 + j], 1e-30f); }
                    } else {
                        f32x4 v0 = acc[ai][bj][m][0], v1 = acc[ai][bj][m][1];
#pragma unroll
                        for (int j = 0; j < 4; ++j) { v0[j] *= fmaxf(gb[j], 1e-30f); v1[j] *= fmaxf(gb[4 + j], 1e-30f); }
                        u32x4 w; w.x = pk2(v0[0], v0[1]); w.y = pk2(v0[2], v0[3]); w.z = pk2(v1[0], v1[1]); w.w = pk2(v1[2], v1[3]);
                        *(u32x4*)(MIX + (size_t)row * DM + col0 + bj * 128) = w;
                    } } }
        if (u.sub == 2) pg8::zero_acc(acc);
    }
};
struct ResProg {
    static constexpr bool PERM = false; int K, G, c; const bf16_t* A; const bf16_t* B; const float* base; float* out; bf16_t* outb; float* ss;
    __device__ __forceinline__ bool next(int i, GUnit& u) const { const int L = i * G + c; if (L >= 64 * 8) return false; pg8::tile_of(L, 64, 8, u.pm, u.pn);
        u.A = (const char*)(A + (size_t)u.pm * 256 * K); u.B = (const char*)(B + (size_t)u.pn * 256 * K); u.sub = 0; return true; }
    __device__ __forceinline__ void epi(Acc& acc, const GUnit& u, int wr, int wc, int fr, int fq) const {
        const int row0 = u.pm * 256 + wr * 64 + fr, col0 = u.pn * 256 + wc * 32 + 4 * fq;
#pragma unroll
        for (int ai = 0; ai < 2; ++ai)
#pragma unroll
            for (int m = 0; m < 4; ++m) { const int row = row0 + ai * 128 + m * 16; const size_t off = (size_t)row * DM + col0; float s = 0.f;
#pragma unroll
                for (int bj = 0; bj < 2; ++bj)
#pragma unroll
                    for (int n = 0; n < 2; ++n) { const f32x4 bs = *(const f32x4*)(base + off + bj * 128 + n * 16); const f32x4 o = bs + acc[ai][bj][m][n];
                        *(f32x4*)(out + off + bj * 128 + n * 16) = o; s += (o[0] * o[0] + o[1] * o[1]) + (o[2] * o[2] + o[3] * o[3]);
                        if (outb) { u32x2 w; w.x = pk2(o[0], o[1]); w.y = pk2(o[2], o[3]); *(u32x2*)(outb + off + bj * 128 + n * 16) = w; } }
                s += __shfl_xor(s, 16); s += __shfl_xor(s, 32);
                if (fq == 0) unsafeAtomicAdd(ss + row, s); }
        pg8::zero_acc(acc);
    }
};
struct GuProg {
    static constexpr bool PERM = true; int K, G, c; const bf16_t* X; const bf16_t* W; bf16_t* HH; const float* ss2;
    __device__ __forceinline__ bool next(int i, GUnit& u) const { const int L = i * G + c; if (L >= 64 * 44) return false; pg8::tile_of(L, 64, 44, u.pm, u.pn);
        u.A = (const char*)(X + (size_t)u.pm * 256 * DM); u.B = (const char*)(W + (size_t)u.pn * 256 * DM); u.sub = 0; return true; }
    __device__ __forceinline__ void epi(Acc& acc, const GUnit& u, int wr, int wc, int fr, int fq) const {
        const int row0 = u.pm * 256 + wr * 64 + fr, col0 = u.pn * 128 + wc * 32 + 8 * fq;
#pragma unroll
        for (int ai = 0; ai < 2; ++ai)
#pragma unroll
            for (int m = 0; m < 4; ++m) { const int row = row0 + ai * 128 + m * 16; const float r2 = 1.0f / sqrtf(ss2[row] * (1.0f / DM) + RMS_EPS);
                float hv[8];
#pragma unroll
                for (int n = 0; n < 2; ++n)
#pragma unroll
                    for (int j = 0; j < 4; ++j) { const float g = acc[ai][0][m][n][j] * r2, uu = acc[ai][1][m][n][j] * r2; hv[4 * n + j] = siluf_(g) * uu; }
                u32x4 w; w.x = pk2(hv[0], hv[1]); w.y = pk2(hv[2], hv[3]); w.z = pk2(hv[4], hv[5]); w.w = pk2(hv[6], hv[7]);
                *(u32x4*)(HH + (size_t)row * FFH + col0) = w; }
        pg8::zero_acc(acc);
    }
};
struct Ctx {
    const float* in[21]; float* out; unsigned char* ws;
};
__device__ __forceinline__ void p0_transpose_item(const float* W, int Nsrc, int K, bf16_t* WT, int dst_row0, int src_col0, const float* kscale, LAS float* scr, int kb, int lane) {
    const int k0 = 64 * kb;
#pragma unroll 8
    for (int i = 0; i < 32; ++i) { const int kk = 2 * i + (lane >> 5); float v = W[(size_t)(k0 + kk) * Nsrc + src_col0 + (lane & 31)]; if (kscale) v *= kscale[k0 + kk]; scr[kk * 33 + (lane & 31)] = v; }
    asm volatile("s_waitcnt lgkmcnt(0)" ::: "memory");
    const int c = lane & 7;
#pragma unroll
    for (int j = 0; j < 4; ++j) { const int n = (lane >> 3) + 8 * j; const LAS float* s = scr + (8 * c) * 33 + n;
        u32x4 o; o.x = pk2(s[0 * 33], s[1 * 33]); o.y = pk2(s[2 * 33], s[3 * 33]); o.z = pk2(s[4 * 33], s[5 * 33]); o.w = pk2(s[6 * 33], s[7 * 33]);
        *(u32x4*)(WT + (size_t)(dst_row0 + n) * K + k0 + 8 * c) = o; }
    asm volatile("s_waitcnt lgkmcnt(0)" ::: "memory");
}
__device__ __forceinline__ void p0_prologue(const Ctx& C, LAS unsigned char* lds, int G, int wv) {
    int tid = (wv << 6) | lane_id_opaque(); asm volatile("" : "+v"(tid));
    const int lane = tid & 63, wave = __builtin_amdgcn_readfirstlane(tid >> 6);
    const int gw = blockIdx.x * 8 + wave, NGW = G * 8;
    unsigned char* ws = C.ws;
    LAS float* scr = (LAS float*)(lds + wave * 8704);
    constexpr int I_IN = 32 * 352, I_A = 16 * 64, I_O = 32 * 64, I_GU = 32 * 352, I_D = 88 * 64;
    constexpr int NIT = I_IN + 2 * I_A + I_O + I_GU + I_D;
    for (int it = gw; it < NIT; it += NGW) {
        int r = it;
        if (r < I_IN) { const int kb = r / 352, nb = r % 352, n0 = nb * 32; const int src = n0 < 7168 ? n0 : n0 + 16;
            p0_transpose_item(C.in[2], INCOLS, DM, (bf16_t*)(ws + WS_WIN), n0, src, C.in[1], scr, kb, lane); continue; } r -= I_IN;
        if (r < I_A) { p0_transpose_item(C.in[14], DM, HW, (bf16_t*)(ws + WS_WA), (r % 64) * 32, (r % 64) * 32, nullptr, scr, r / 64, lane); continue; } r -= I_A;
        if (r < I_A) { p0_transpose_item(C.in[15], DM, MW, (bf16_t*)(ws + WS_WB), (r % 64) * 32, (r % 64) * 32, nullptr, scr, r / 64, lane); continue; } r -= I_A;
        if (r < I_O) { p0_transpose_item(C.in[16], DM, DM, (bf16_t*)(ws + WS_WOUT), (r % 64) * 32, (r % 64) * 32, nullptr, scr, r / 64, lane); continue; } r -= I_O;
        if (r < I_GU) { const int kb = r / 352, nb = r % 352, n0 = nb * 32; const int pn = n0 >> 8, half = (n0 >> 7) & 1, i = n0 & 127;
            p0_transpose_item(C.in[18], 2 * FFH, DM, (bf16_t*)(ws + WS_WGU), n0, half * FFH + 128 * pn + i, C.in[17], scr, kb, lane); continue; } r -= I_GU;
        p0_transpose_item(C.in[19], DM, FFH, (bf16_t*)(ws + WS_WD), (r % 64) * 32, (r % 64) * 32, nullptr, scr, r / 64, lane);
    }
    for (int i = blockIdx.x * 512 + tid; i < TOK; i += G * 512) { ((float*)(ws + WS_SS2))[i] = 0.f; ((float*)(ws + WS_SS3))[i] = 0.f; }
    {
        const float* w1 = C.in[5]; const float* b1 = C.in[6]; const float* f1 = C.in[7]; const float* w2 = C.in[8]; const float* b2 = C.in[9]; const float* f2 = C.in[10];
        float* h2 = (float*)(ws + WS_H2);
        for (int t = gw; t < SEQ; t += NGW) {
            const float tl = (float)t / (float)(SEQ - 1);
            const float omega = 6.283185307179586f * (float)t / (float)SEQ;
            float a = b1[lane] + tl * w1[lane];
#pragma unroll 4
            for (int i = 0; i < 16; ++i) { const float fr = 1e-4f + (float)i * ((15.0f - 1e-4f) / 15.0f); const float ang = omega * fr; float sn, cs; sincosf(ang, &sn, &cs);
                a += cs * w1[(1 + i) * 64 + lane] - sn * w1[(17 + i) * 64 + lane]; }
            const float h1 = sinf(f1[lane] * a);
            float a2 = b2[lane];
#pragma unroll 8
            for (int i = 0; i < 64; ++i) a2 += __shfl(h1, i) * w2[i * 64 + lane];
            h2[t * 64 + lane] = sinf(f2[lane] * a2);
        }
    }
    __syncthreads();
    {
        LAS float* wg = (LAS float*)lds;
        const float* w_in = C.in[2]; const float* nw = C.in[1];
        for (int i = tid; i < DM * 16; i += 512) { const int k = i >> 4, g = i & 15; wg[g * DM + k] = w_in[(size_t)k * INCOLS + 7168 + g] * nw[k]; }
        __syncthreads();
        const float* x = C.in[0]; bf16_t* xb = (bf16_t*)(ws + WS_XB); float* r1 = (float*)(ws + WS_R1S); float* Gt = (float*)(ws + WS_G); const float* gbias = C.in[13];
        for (int row = gw; row < TOK; row += NGW) {
            const f32x4* xr = (const f32x4*)(x + (size_t)row * DM) + lane;
            f32x4 v[8]; float s = 0.f;
#pragma unroll
            for (int j = 0; j < 8; ++j) { v[j] = xr[64 * j]; s += (v[j].x * v[j].x + v[j].y * v[j].y) + (v[j].z * v[j].z + v[j].w * v[j].w); }
            const float r = 1.0f / sqrtf(wave_sum(s) * (1.0f / DM) + RMS_EPS);
            u32x2* o8 = (u32x2*)(xb + (size_t)row * DM) + lane;
#pragma unroll
            for (int j = 0; j < 8; ++j) { u32x2 w; w.x = pk2(v[j].x, v[j].y); w.y = pk2(v[j].z, v[j].w); o8[64 * j] = w; }
            float myg = 0.f;
#pragma unroll
            for (int g = 0; g < 16; ++g) { float a = 0.f;
#pragma unroll
                for (int j = 0; j < 8; ++j) { const f32x4 w = *(const LAS f32x4*)(wg + g * DM + 256 * j + 4 * lane); a += (v[j].x * w.x + v[j].y * w.y) + (v[j].z * w.z + v[j].w * w.w); }
                a = wave_sum(a); if (lane == g) myg = a; }
            if (lane < 16) Gt[(size_t)row * 16 + lane] = myg * r + gbias[lane];
            if (lane == 0) r1[row] = r;
        }
    }
}
__device__ __forceinline__ void p1_filters(const Ctx& C, LAS unsigned char* lds, int G, int wv) {
    int tid = (wv << 6) | lane_id_opaque(); asm volatile("" : "+v"(tid));
    LAS float* w3s = (LAS float*)lds;
    const float* w3 = C.in[11]; const float* h2 = (const float*)(C.ws + WS_H2); float* FILT = (float*)(C.ws + WS_FILT);
    for (int item = blockIdx.x; item < 512; item += G) {
        const int ntile = item >> 3, tt = item & 7, t = 512 * tt + tid;
        __syncthreads();
        for (int i = tid; i < 4096; i += 512) w3s[i] = w3[(size_t)(i >> 6) * NFILT + 64 * ntile + (i & 63)];
        __syncthreads();
        f32x4 hr[16];
#pragma unroll
        for (int j = 0; j < 16; ++j) hr[j] = *(const f32x4*)(h2 + (size_t)t * 64 + 4 * j);
        const float tl = (float)t / (float)(SEQ - 1);
#pragma unroll 1
        for (int n4 = 0; n4 < 16; ++n4) {
            float a[4] = {0.f, 0.f, 0.f, 0.f};
#pragma unroll
            for (int j = 0; j < 16; ++j) {
#pragma unroll
                for (int jj = 0; jj < 4; ++jj) { const f32x4 wv = *(const LAS f32x4*)(w3s + (4 * j + jj) * 64 + 4 * n4); const float hv = hr[j][jj];
                    a[0] = fmaf(hv, wv.x, a[0]); a[1] = fmaf(hv, wv.y, a[1]); a[2] = fmaf(hv, wv.z, a[2]); a[3] = fmaf(hv, wv.w, a[3]); }
            }
#pragma unroll
            for (int e = 0; e < 4; ++e) { const int n = 64 * ntile + 4 * n4 + e, ch = n & 1023;
                const float mind = -3.0701134573253945f, maxd = -15.350567286626973f;
                const float delta = mind + (float)ch * ((maxd - mind) / 1023.0f);
                FILT[(size_t)n * SEQ + t] = a[e] * expf(-tl * fabsf(delta)); }
        }
    }
    __syncthreads();
}
__device__ __forceinline__ void p7_final(const Ctx& C, int G, int wv) {
    int tid = (wv << 6) | lane_id_opaque(); asm volatile("" : "+v"(tid));
    const int lane = tid & 63, wave = tid >> 6, gw = blockIdx.x * 8 + wave, NGW = G * 8;
    const float* ss3 = (const float*)(C.ws + WS_SS3); const float* wf = C.in[20];
    f32x4 w[8];
#pragma unroll
    for (int j = 0; j < 8; ++j) w[j] = ((const f32x4*)wf)[64 * j + lane];
    for (int row = gw; row < TOK; row += NGW) {
        const float r = 1.0f / sqrtf(ss3[row] * (1.0f / DM) + RMS_EPS);
        f32x4* p = (f32x4*)(C.out + (size_t)row * DM) + lane;
        f32x4 v[8];
#pragma unroll
        for (int j = 0; j < 8; ++j) v[j] = p[64 * j];
#pragma unroll
        for (int j = 0; j < 8; ++j) p[64 * j] = v[j] * r * w[j];
    }
}
#ifndef FFT_HOST
#define FFT_DEV __device__ __forceinline__
#define FFT_PTR LAS f32x2*
#define FFT_SIN(x) __builtin_amdgcn_sinf(x)
#define FFT_COS(x) __builtin_amdgcn_cosf(x)
#else
#define FFT_DEV static inline
#define FFT_PTR f32x2*
#define FFT_SIN(x) sinf(6.283185307179586f * (x))
#define FFT_COS(x) cosf(6.283185307179586f * (x))
#endif
#define PADI(i) ((i) + ((i) >> 4))
FFT_DEV f32x2 cmul(f32x2 a, f32x2 b) { f32x2 r; r.x = a.x * b.x - a.y * b.y; r.y = a.x * b.y + a.y * b.x; return r; }
FFT_DEV f32x2 cmulc(f32x2 a, f32x2 b) { f32x2 r; r.x = a.x * b.x + a.y * b.y; r.y = a.y * b.x - a.x * b.y; return r; }
FFT_DEV f32x2 twid(float frac) { f32x2 r; r.x = FFT_COS(frac); r.y = -FFT_SIN(frac); return r; }
template <int INV> FFT_DEV void fft_r8_pass(FFT_PTR buf, int s, int ls  , int tid) {
    const float R = 0.70710678118654752f;
#pragma unroll 1
    for (int rep = 0; rep < 2; ++rep) {
        const int bf = tid + rep * 512, j = bf & (s - 1), blk = bf >> ls, base = blk * 8 * s + j;
        f32x2 x[8];
#pragma unroll
        for (int m = 0; m < 8; ++m) x[m] = buf[PADI(base + m * s)];
        f32x2 w1 = twid((float)j / (float)(8 * s));
        f32x2 w2 = cmul(w1, w1), w4 = cmul(w2, w2);
        if (INV) { w1.y = -w1.y; w2.y = -w2.y; w4.y = -w4.y; }
        const float sg = INV ? -1.f : 1.f;
        f32x2 c8[4]; c8[0] = (f32x2){1.f, 0.f}; c8[1] = (f32x2){R, -R * sg}; c8[2] = (f32x2){0.f, -1.f * sg}; c8[3] = (f32x2){-R, -R * sg};
        if (!INV) {
#pragma unroll
            for (int m = 0; m < 4; ++m) { f32x2 a = x[m], b = x[m + 4]; x[m] = a + b; x[m + 4] = cmul(a - b, cmul(w1, c8[m])); }
#pragma unroll
            for (int h = 0; h < 8; h += 4)
#pragma unroll
                for (int m = 0; m < 2; ++m) { f32x2 a = x[h + m], b = x[h + m + 2]; x[h + m] = a + b; x[h + m + 2] = cmul(a - b, cmul(w2, c8[2 * m])); }
#pragma unroll
            for (int m = 0; m < 8; m += 2) { f32x2 a = x[m], b = x[m + 1]; x[m] = a + b; x[m + 1] = cmul(a - b, w4); }
        } else {
#pragma unroll
            for (int m = 0; m < 8; m += 2) { f32x2 a = x[m], b = cmul(x[m + 1], w4); x[m] = a + b; x[m + 1] = a - b; }
#pragma unroll
            for (int h = 0; h < 8; h += 4)
#pragma unroll
                for (int m = 0; m < 2; ++m) { f32x2 a = x[h + m], b = cmul(x[h + m + 2], cmul(w2, c8[2 * m])); x[h + m] = a + b; x[h + m + 2] = a - b; }
#pragma unroll
            for (int m = 0; m < 4; ++m) { f32x2 a = x[m], b = cmul(x[m + 4], cmul(w1, c8[m])); x[m] = a + b; x[m + 4] = a - b; }
        }
#pragma unroll
        for (int m = 0; m < 8; ++m) buf[PADI(base + m * s)] = x[m];
    }
}
FFT_DEV void fft_r2_span1(FFT_PTR buf, int tid) {
#pragma unroll
    for (int rep = 0; rep < 8; ++rep) { const int p = 2 * (tid + rep * 512); f32x2 a = buf[PADI(p)], b = buf[PADI(p + 1)]; buf[PADI(p)] = a + b; buf[PADI(p + 1)] = a - b; }
}
#ifndef FFT_HOST
#define FFT_SYNC() __syncthreads()
__device__ __forceinline__ void fft_fwd(FFT_PTR buf, int tid) {
    FFT_SYNC(); fft_r8_pass<0>(buf, 1024, 10, tid); FFT_SYNC(); fft_r8_pass<0>(buf, 128, 7, tid); FFT_SYNC(); fft_r8_pass<0>(buf, 16, 4, tid); FFT_SYNC();
    fft_r8_pass<0>(buf, 2, 1, tid); FFT_SYNC(); fft_r2_span1(buf, tid); FFT_SYNC();
}
__device__ __forceinline__ void fft_inv(FFT_PTR buf, int tid) {
    FFT_SYNC(); fft_r2_span1(buf, tid); FFT_SYNC(); fft_r8_pass<1>(buf, 2, 1, tid); FFT_SYNC(); fft_r8_pass<1>(buf, 16, 4, tid); FFT_SYNC();
    fft_r8_pass<1>(buf, 128, 7, tid); FFT_SYNC(); fft_r8_pass<1>(buf, 1024, 10, tid); FFT_SYNC();
}
#endif
FFT_DEV unsigned brev13(unsigned p) {
    unsigned r = 0;
#ifndef FFT_HOST
    r = __brev(p) >> 19;
#else
    for (int i = 0; i < 13; ++i) r |= ((p >> i) & 1u) << (12 - i);
#endif
    return r;
}
FFT_DEV void fft_pointwise(FFT_PTR wb, FFT_PTR zk, int which, int tid) {
#pragma unroll 4
    for (int rep = 0; rep < 16; ++rep) {
        const unsigned p = tid + rep * 512, f = brev13(p), fn = (8192u - f) & 8191u, pn = brev13(fn);
        const f32x2 zf = zk[PADI(p)], zn = zk[PADI(pn)];
        f32x2 kf;
        if (which == 0) { kf.x = 0.5f * (zf.x + zn.x); kf.y = 0.5f * (zf.y - zn.y); }
        else            { kf.x = 0.5f * (zf.y + zn.y); kf.y = 0.5f * (zn.x - zf.x); }
        wb[PADI(p)] = cmul(wb[PADI(p)], kf);
    }
}
__device__ __forceinline__ void unpack8(u32x4 w, float (&f)[8]) { f[0] = bflo(w.x); f[1] = bfhi(w.x); f[2] = bflo(w.y); f[3] = bfhi(w.y); f[4] = bflo(w.z); f[5] = bfhi(w.z); f[6] = bflo(w.w); f[7] = bfhi(w.w); }
__device__ __forceinline__ void qk_prepass(const Ctx& C, int G, int wv) {
    int tid = (wv << 6) | lane_id_opaque(); asm volatile("" : "+v"(tid));
    const bf16_t* R1A = (const bf16_t*)(C.ws + WS_R1A); bf16_t* QKP = (bf16_t*)(C.ws + WS_QKP);
    const float* cw = C.in[3]; const float* cb = C.in[4];
    const int cg8 = tid & 255, half = tid >> 8, col = 8 * cg8;
    float k0[8], k1[8], k2[8], kb[8];
    { const int ch = 3072 + col;
      const f32x4 t0 = *(const f32x4*)(cw + ch), t1 = *(const f32x4*)(cw + ch + 4), t2 = *(const f32x4*)(cw + CONVC + ch), t3 = *(const f32x4*)(cw + CONVC + ch + 4);
      const f32x4 t4 = *(const f32x4*)(cw + 2 * CONVC + ch), t5 = *(const f32x4*)(cw + 2 * CONVC + ch + 4), t6 = *(const f32x4*)(cb + ch), t7 = *(const f32x4*)(cb + ch + 4);
#pragma unroll
      for (int e = 0; e < 4; ++e) { k0[e] = t0[e]; k0[4 + e] = t1[e]; k1[e] = t2[e]; k1[4 + e] = t3[e]; k2[e] = t4[e]; k2[4 + e] = t5[e]; kb[e] = t6[e]; kb[4 + e] = t7[e]; } }
    const float osc = col >= 1024 ? 0.0625f : 1.0f;
    for (int run = blockIdx.x; run < TOK / 64; run += G) {
        const int row0 = run * 64 + half * 32;
#pragma unroll 4
        for (int i = 0; i < 32; ++i) {
            const int row = row0 + i, t = row & (SEQ - 1);
            const bf16_t* p = R1A + (size_t)row * 2048 + col;
            const u32x4 z = {0u, 0u, 0u, 0u};
            const u32x4 w0 = t > 0 ? *(const u32x4*)(p - 2048) : z, w1 = *(const u32x4*)p, w2 = t < SEQ - 1 ? *(const u32x4*)(p + 2048) : z;
            float a0[8], a1[8], a2[8]; unpack8(w0, a0); unpack8(w1, a1); unpack8(w2, a2);
            float v[8];
#pragma unroll
            for (int e = 0; e < 8; ++e) v[e] = siluf_(k0[e] * a0[e] + k1[e] * a1[e] + k2[e] * a2[e] + kb[e]) * osc;
            u32x4 o; o.x = pk2(v[0], v[1]); o.y = pk2(v[2], v[3]); o.z = pk2(v[4], v[5]); o.w = pk2(v[6], v[7]);
            *(u32x4*)(QKP + (size_t)row * 2048 + col) = o;
        }
    }
}
constexpr int ML_KS = 0, ML_KP = 528, ML_SS = 67584, ML_SP = 272, ML_VS = 102400, ML_VP = 80, ML_VW = 112640, ML_CS = 122880, ML_CP = 528, ML_NS = 139776, ML_SC = 140800;
static_assert(ML_SC + 7 * 512 + 64 <= LDS_BYTES, "mLSTM LDS map");
__device__ __forceinline__ bf16x8 tr_read2(unsigned a0, unsigned a1) {
    bf16x4 lo, hi;
    asm volatile("ds_read_b64_tr_b16 %0, %2\n\tds_read_b64_tr_b16 %1, %3\n\ts_waitcnt lgkmcnt(0)" : "=&v"(lo), "=&v"(hi) : "v"(a0), "v"(a1) : "memory");
    bf16x8 r; r[0] = lo[0]; r[1] = lo[1]; r[2] = lo[2]; r[3] = lo[3]; r[4] = hi[0]; r[5] = hi[1]; r[6] = hi[2]; r[7] = hi[3]; return r;
}
__device__ __forceinline__ float bf2f(short s) { return __uint_as_float(((unsigned)(unsigned short)s) << 16); }
__device__ __forceinline__ float logsigmoidf_(float x) { return fminf(x, 0.f) - log1pf(expf(-fabsf(x))); }

__device__ __forceinline__ void mlstm_item(const Ctx& C, LAS unsigned char* lds, int item, int wv) {
    int tid = (wv << 6) | lane_id_opaque(); asm volatile("" : "+v"(tid));
    const int lane = tid & 63, w = __builtin_amdgcn_readfirstlane(tid >> 6), r = lane & 15, g = lane >> 4, q4 = r >> 2, p4 = r & 3;
    const int vs = item & 7, dir = (item >> 3) & 1, bh = item >> 4, b = bh >> 2, h = bh & 3;
    const bf16_t* QKP = (const bf16_t*)(C.ws + WS_QKP); const bf16_t* R1B = (const bf16_t*)(C.ws + WS_R1B); const float* Gt = (const float*)(C.ws + WS_G);
    bf16_t* Y = (bf16_t*)(C.ws + (dir ? WS_YBB : WS_YBF));
    LAS float* SC = (LAS float*)(lds + ML_SC);
    LAS float* s_cs = SC, *s_rj = SC + 128, *s_iw = SC + 256, *s_emj = SC + 384, *s_w = SC + 512, *s_dn = SC + 640, *s_misc = SC + 768;
    LAS float* NS = (LAS float*)(lds + ML_NS);
    const unsigned lbase = (unsigned)(size_t)lds;
    const int pc = tid & 31, krow = tid >> 5, vrow = tid >> 2, pv = tid & 3;
    for (int i = tid; i < (ML_NS + 1024 - ML_CS) / 4; i += 512) ((LAS unsigned*)(lds + ML_CS))[i] = 0u;
    f32x4 Cacc[3][2];
#pragma unroll
    for (int a = 0; a < 3; ++a) { Cacc[a][0] = (f32x4){0.f, 0.f, 0.f, 0.f}; Cacc[a][1] = (f32x4){0.f, 0.f, 0.f, 0.f}; }
    float m_prev = 0.f;
    u32x4 kreg[8], vreg, qn[8]; float ipn = 0.f, fpn = 0.f;
#define ML_TOK(c_, j_) ((size_t)b * SEQ + (dir ? SEQ - 1 - ((c_) * 128 + (j_)) : ((c_) * 128 + (j_))))
#define ML_PREFETCH(c_) do { \
        _Pragma("unroll") for (int i = 0; i < 8; ++i) kreg[i] = *(const u32x4*)(QKP + ML_TOK(c_, krow + 16 * i) * 2048 + 1024 + h * 256 + 8 * pc); \
        vreg = *(const u32x4*)(R1B + ML_TOK(c_, vrow) * 2048 + h * 256 + vs * 32 + 8 * pv); \
        { const bf16_t* qp = QKP + ML_TOK(c_, 16 * w + r) * 2048 + h * 256 + 8 * g; _Pragma("unroll") for (int kk = 0; kk < 8; ++kk) qn[kk] = *(const u32x4*)(qp + 32 * kk); } \
        if (tid < 128) { const size_t tk = ML_TOK(c_, tid); ipn = Gt[tk * 16 + (dir * 2) * 4 + h]; fpn = Gt[tk * 16 + (dir * 2 + 1) * 4 + h]; } } while (0)
    ML_PREFETCH(0);
    __syncthreads();
#pragma unroll 1
    for (int c = 0; c < 32; ++c) {
        float xs = 0.f, csv = 0.f, pmx = 0.f, bcum = 0.f; const float ip = ipn;
        if (tid < 128) {
            xs = logsigmoidf_(fpn);
#pragma unroll
            for (int o = 1; o < 64; o <<= 1) { const float y = __shfl_up(xs, o); if (lane >= o) xs += y; }
            if (tid == 63) s_misc[0] = xs;
        }
        __syncthreads();
        if (tid < 128) {
            bcum = xs + (w == 1 ? s_misc[0] : 0.f); csv = ip - bcum; pmx = csv;
#pragma unroll
            for (int o = 1; o < 64; o <<= 1) { const float y = __shfl_up(pmx, o); if (lane >= o) pmx = fmaxf(pmx, y); }
            if (tid == 63) s_misc[1] = pmx;
            if (tid == 127) s_misc[2] = bcum;
        }
        __syncthreads();
        if (tid < 128) { if (w == 1) pmx = fmaxf(pmx, s_misc[1]); if (tid == 127) s_misc[3] = pmx; }
        __syncthreads();
        const float b_last = s_misc[2], m_new = fmaxf(b_last + m_prev, b_last + s_misc[3]), keep = __expf(b_last + m_prev - m_new);
        if (tid < 128) {
            const float inter = bcum + m_prev, mj = fmaxf(inter, bcum + pmx);
            s_cs[tid] = csv; s_rj[tid] = bcum - mj; s_iw[tid] = __expf(inter - mj); s_emj[tid] = __expf(-mj); s_w[tid] = __expf(b_last + csv - m_new);
        }
        __syncthreads();
#pragma unroll
        for (int i = 0; i < 8; ++i) *(LAS u32x4*)(lds + ML_KS + (krow + 16 * i) * ML_KP + pc * 16) = kreg[i];
        {
            *(LAS u32x4*)(lds + ML_VS + vrow * ML_VP + pv * 16) = vreg;
            float f[8]; unpack8(vreg, f); const float ws_ = s_w[vrow];
            u32x4 o; o.x = pk2(f[0] * ws_, f[1] * ws_); o.y = pk2(f[2] * ws_, f[3] * ws_); o.z = pk2(f[4] * ws_, f[5] * ws_); o.w = pk2(f[6] * ws_, f[7] * ws_);
            *(LAS u32x4*)(lds + ML_VW + vrow * ML_VP + pv * 16) = o;
        }
        bf16x8 qf[8];
#pragma unroll
        for (int kk = 0; kk < 8; ++kk) qf[kk] = __builtin_bit_cast(bf16x8, qn[kk]);
        unsigned short ogr[4][2];
#pragma unroll
        for (int i = 0; i < 4; ++i)
#pragma unroll
            for (int vt = 0; vt < 2; ++vt) ogr[i][vt] = R1B[ML_TOK(c, 16 * w + 4 * g + i) * 2048 + 1024 + h * 256 + vs * 32 + 16 * vt + r];
        if (c < 31) ML_PREFETCH(c + 1);
        __syncthreads();
        {
            const float rjv = s_rj[16 * w + r]; const int jloc = 16 * w + r; float den1 = 0.f;
#pragma unroll 1
            for (int st = 0; st < 8; ++st) {
                if (st <= w) {
                    f32x4 acc = {0.f, 0.f, 0.f, 0.f};
#pragma unroll
                    for (int kk = 0; kk < 8; ++kk) { const bf16x8 kf = *(const LAS bf16x8*)(lds + ML_KS + (16 * st + r) * ML_KP + (32 * kk + 8 * g) * 2); acc = __builtin_amdgcn_mfma_f32_16x16x32_bf16(kf, qf[kk], acc, 0, 0, 0); }
                    const f32x4 c4 = *(const LAS f32x4*)(s_cs + 16 * st + 4 * g);
                    float v[4];
#pragma unroll
                    for (int i = 0; i < 4; ++i) { const int s = 16 * st + 4 * g + i; const float d = (s <= jloc) ? __expf(rjv + c4[i]) : 0.f; v[i] = acc[i] * d; den1 += v[i]; }
                    u32x2 o; o.x = pk2(v[0], v[1]); o.y = pk2(v[2], v[3]);
                    *(LAS u32x2*)(lds + ML_SS + jloc * ML_SP + (16 * st + 4 * g) * 2) = o;
                } else if (st == w + 1 && !(w & 1)) {
                    u32x2 o = {0u, 0u}; *(LAS u32x2*)(lds + ML_SS + jloc * ML_SP + (16 * st + 4 * g) * 2) = o;
                }
            }
            den1 += __shfl_xor(den1, 16); den1 += __shfl_xor(den1, 32);
            float d2 = 0.f;
#pragma unroll
            for (int kk = 0; kk < 8; ++kk) { const f32x4 n0 = *(const LAS f32x4*)(NS + 32 * kk + 8 * g), n1 = *(const LAS f32x4*)(NS + 32 * kk + 8 * g + 4);
#pragma unroll
                for (int e = 0; e < 4; ++e) { d2 += bf2f(qf[kk][e]) * n0[e]; d2 += bf2f(qf[kk][4 + e]) * n1[e]; } }
            d2 += __shfl_xor(d2, 16); d2 += __shfl_xor(d2, 32);
            if (g == 0) s_dn[jloc] = den1 + s_iw[jloc] * d2;
        }
        __syncthreads();
        {
            f32x4 n1[2], n2[2];
#pragma unroll
            for (int vt = 0; vt < 2; ++vt) { n1[vt] = (f32x4){0.f, 0.f, 0.f, 0.f}; n2[vt] = (f32x4){0.f, 0.f, 0.f, 0.f}; }
            const int nks = (w >> 1) + 1;
#pragma unroll 1
            for (int ks = 0; ks < nks; ++ks) {
                const bf16x8 af = *(const LAS bf16x8*)(lds + ML_SS + (16 * w + r) * ML_SP + (32 * ks + 8 * g) * 2);
#pragma unroll
                for (int vt = 0; vt < 2; ++vt) { const unsigned a0 = lbase + ML_VS + (32 * ks + 8 * g + q4) * ML_VP + (16 * vt + 4 * p4) * 2;
                    const bf16x8 bfr = tr_read2(a0, a0 + 4 * ML_VP); n1[vt] = __builtin_amdgcn_mfma_f32_16x16x32_bf16(af, bfr, n1[vt], 0, 0, 0); }
            }
#pragma unroll
            for (int kk = 0; kk < 8; ++kk)
#pragma unroll
                for (int vt = 0; vt < 2; ++vt) { const bf16x8 cf = *(const LAS bf16x8*)(lds + ML_CS + (16 * vt + r) * ML_CP + (32 * kk + 8 * g) * 2); n2[vt] = __builtin_amdgcn_mfma_f32_16x16x32_bf16(qf[kk], cf, n2[vt], 0, 0, 0); }
            const f32x4 iw4 = *(const LAS f32x4*)(s_iw + 16 * w + 4 * g), dn4 = *(const LAS f32x4*)(s_dn + 16 * w + 4 * g), em4 = *(const LAS f32x4*)(s_emj + 16 * w + 4 * g);
#pragma unroll
            for (int i = 0; i < 4; ++i) {
                const size_t tok = ML_TOK(c, 16 * w + 4 * g + i);
                const float inv = 1.0f / fmaxf(fabsf(dn4[i]), em4[i]);
#pragma unroll
                for (int vt = 0; vt < 2; ++vt) { const int col = h * 256 + vs * 32 + 16 * vt + r;
                    const float og = __uint_as_float(((unsigned)ogr[i][vt]) << 16);
                    const float hv = (n1[vt][i] + iw4[i] * n2[vt][i]) * inv * og;
                    Y[tok * 1024 + col] = (bf16_t)f2bf(hv); }
            }
        }
        __syncthreads();
        {
#pragma unroll
            for (int a = 0; a < 3; ++a) { Cacc[a][0] *= keep; Cacc[a][1] *= keep; }
#pragma unroll 1
            for (int ks = 0; ks < 4; ++ks) {
                bf16x8 af[3];
#pragma unroll
                for (int mt = 0; mt < 2; ++mt) { const unsigned a0 = lbase + ML_VW + (32 * ks + 8 * g + q4) * ML_VP + (16 * mt + 4 * p4) * 2; af[mt] = tr_read2(a0, a0 + 4 * ML_VP); }
                { const f32x4 wa = *(const LAS f32x4*)(s_w + 32 * ks + 8 * g), wb = *(const LAS f32x4*)(s_w + 32 * ks + 8 * g + 4);
                  u32x4 o; o.x = pk2(wa[0], wa[1]); o.y = pk2(wa[2], wa[3]); o.z = pk2(wb[0], wb[1]); o.w = pk2(wb[2], wb[3]);
                  if (r != 0) { o.x = 0u; o.y = 0u; o.z = 0u; o.w = 0u; }
                  af[2] = __builtin_bit_cast(bf16x8, o); }
#pragma unroll
                for (int nt = 0; nt < 2; ++nt) { const unsigned a0 = lbase + ML_KS + (32 * ks + 8 * g + q4) * ML_KP + (32 * w + 16 * nt + 4 * p4) * 2;
                    const bf16x8 bfr = tr_read2(a0, a0 + 4 * ML_KP);
#pragma unroll
                    for (int mt = 0; mt < 3; ++mt) Cacc[mt][nt] = __builtin_amdgcn_mfma_f32_16x16x32_bf16(af[mt], bfr, Cacc[mt][nt], 0, 0, 0); }
            }
#pragma unroll
            for (int mt = 0; mt < 2; ++mt)
#pragma unroll
                for (int nt = 0; nt < 2; ++nt)
#pragma unroll
                    for (int i = 0; i < 4; ++i) *(LAS bf16_t*)(lds + ML_CS + (16 * mt + 4 * g + i) * ML_CP + (32 * w + 16 * nt + r) * 2) = (bf16_t)f2bf(Cacc[mt][nt][i]);
            if (g == 0) { NS[32 * w + r] = Cacc[2][0][0]; NS[32 * w + 16 + r] = Cacc[2][1][0]; }
        }
        m_prev = m_new;
        __syncthreads();
    }
#undef ML_PREFETCH
#undef ML_TOK
}
constexpr int HY_ZK = 0, HY_WB = 69632;
static_assert(HY_WB + 69632 <= LDS_BYTES, "hyena LDS map");
__device__ __forceinline__ float hy_conv(const bf16_t* p  , int off, int t, float w0, float w1, float w2, float bias) {
    const float a1 = __uint_as_float(((unsigned)p[off]) << 16);
    const float a0 = t > 0 ? __uint_as_float(((unsigned)p[off - 1]) << 16) : 0.f;
    const float a2 = t < SEQ - 1 ? __uint_as_float(((unsigned)p[off + 1]) << 16) : 0.f;
    return w0 * a0 + w1 * a1 + w2 * a2 + bias;
}
__device__ __forceinline__ void hyena_item(const Ctx& C, LAS unsigned char* lds, int ch, int wv) {
    int tid = (wv << 6) | lane_id_opaque(); asm volatile("" : "+v"(tid));
    LAS f32x2* zk = (LAS f32x2*)(lds + HY_ZK); LAS f32x2* wb = (LAS f32x2*)(lds + HY_WB);
    const float* FILT = (const float*)(C.ws + WS_FILT); const bf16_t* HYb = (const bf16_t*)(C.ws + WS_HY); bf16_t* YA = (bf16_t*)(C.ws + WS_YA);
    const float* cw = C.in[3]; const float* cb = C.in[4];
    float w0[3], w1[3], w2[3], bs[3];
#pragma unroll
    for (int s = 0; s < 3; ++s) { w0[s] = cw[s * 1024 + ch]; w1[s] = cw[CONVC + s * 1024 + ch]; w2[s] = cw[2 * CONVC + s * 1024 + ch]; bs[s] = cb[s * 1024 + ch]; }
    const float hb0 = C.in[12][ch], hb1 = C.in[12][1024 + ch];
    const float* F0 = FILT + (size_t)(0 * 1024 + ch) * SEQ; const float* F1 = FILT + (size_t)(1 * 1024 + ch) * SEQ;
    const float* F2 = FILT + (size_t)(2 * 1024 + ch) * SEQ; const float* F3 = FILT + (size_t)(3 * 1024 + ch) * SEQ;
    __syncthreads();
#pragma unroll 4
    for (int rep = 0; rep < 16; ++rep) { const int i = tid + 512 * rep; float a, b;
        if (i < SEQ) { a = F0[i]; b = F2[i]; } else if (i == SEQ) { a = 0.f; b = 0.f; } else { a = F1[2 * SEQ - i]; b = F3[2 * SEQ - i]; }
        zk[PADI(i)] = (f32x2){a * (1.0f / 8192.0f), b * (1.0f / 8192.0f)}; }
    fft_fwd(zk, tid);
#pragma unroll 1
    for (int p = 0; p < 2; ++p) {
        const int tb0 = (2 * p) * SEQ, tb1 = (2 * p + 1) * SEQ;
        f32x2 vv[8], zz[8];
        const bf16_t* pv0 = HYb + (size_t)ch * TOK + tb0 + tid; const bf16_t* pv1 = pv0 + SEQ; asm volatile("" : "+v"(pv0), "+v"(pv1));
#pragma unroll
        for (int m = 0; m < 8; ++m) { const int t = tid + 512 * m;
            vv[m].x = hy_conv(pv0, 512 * m, t, w0[0], w1[0], w2[0], bs[0]); vv[m].y = hy_conv(pv1, 512 * m, t, w0[0], w1[0], w2[0], bs[0]);
            wb[PADI(t)] = vv[m]; wb[PADI(t + SEQ)] = (f32x2){0.f, 0.f}; }
        fft_fwd(wb, tid); fft_pointwise(wb, zk, 0, tid); fft_inv(wb, tid);
        const bf16_t* px0 = HYb + (size_t)(1024 + ch) * TOK + tb0 + tid; const bf16_t* px1 = px0 + SEQ; asm volatile("" : "+v"(px0), "+v"(px1));
#pragma unroll
        for (int m = 0; m < 8; ++m) { const int t = tid + 512 * m; const f32x2 y = wb[PADI(t)];
            const float xa = hy_conv(px0, 512 * m, t, w0[1], w1[1], w2[1], bs[1]), xb_ = hy_conv(px1, 512 * m, t, w0[1], w1[1], w2[1], bs[1]);
            zz[m].x = xa * (y.x + vv[m].x * hb0); zz[m].y = xb_ * (y.y + vv[m].y * hb0); }
#pragma unroll
        for (int m = 0; m < 8; ++m) { const int t = tid + 512 * m; wb[PADI(t)] = zz[m]; wb[PADI(t + SEQ)] = (f32x2){0.f, 0.f}; }
        fft_fwd(wb, tid); fft_pointwise(wb, zk, 1, tid); fft_inv(wb, tid);
        const bf16_t* py0 = HYb + (size_t)(2048 + ch) * TOK + tb0 + tid; const bf16_t* py1 = py0 + SEQ; asm volatile("" : "+v"(py0), "+v"(py1));
#pragma unroll
        for (int m = 0; m < 8; ++m) { const int t = tid + 512 * m; const f32x2 y = wb[PADI(t)];
            const float xa = hy_conv(py0, 512 * m, t, w0[2], w1[2], w2[2], bs[2]), xb_ = hy_conv(py1, 512 * m, t, w0[2], w1[2], w2[2], bs[2]);
            YA[(size_t)(tb0 + t) * 1024 + ch] = (bf16_t)f2bf(xa * (y.x + zz[m].x * hb1));
            YA[(size_t)(tb1 + t) * 1024 + ch] = (bf16_t)f2bf(xb_ * (y.y + zz[m].y * hb1)); }
        __syncthreads();
    }
}
#ifndef DUP_P0
#define DUP_P0 0
#endif
#ifndef DUP_ML
#define DUP_ML 0
#endif
#ifndef DUP_HY
#define DUP_HY 0
#endif
#ifndef DUP_REST
#define DUP_REST 0
#endif
#ifndef DUP_GU
#define DUP_GU 0
#endif
__device__ __forceinline__ void grid_bar(unsigned* cnt, unsigned target, int wv) {
    asm volatile("s_waitcnt vmcnt(0)" ::: "memory");
    __syncthreads();
    const int lane = lane_id_opaque();
    if (wv == 0 && lane == 0) {
        __builtin_amdgcn_fence(__ATOMIC_RELEASE, "agent");
        asm volatile("s_waitcnt vmcnt(0)" ::: "memory");
        __hip_atomic_fetch_add(cnt, 1u, __ATOMIC_RELAXED, __HIP_MEMORY_SCOPE_AGENT);
        while (__hip_atomic_load(cnt, __ATOMIC_RELAXED, __HIP_MEMORY_SCOPE_AGENT) < target) __builtin_amdgcn_s_sleep(2);
        __builtin_amdgcn_fence(__ATOMIC_ACQUIRE, "agent");
        asm volatile("s_waitcnt vmcnt(0)" ::: "memory");
    }
    __syncthreads();
}
struct Params { const float* in[21]; float* out; unsigned char* ws; };
__global__ void __launch_bounds__(512, 2) fwd_megakernel(Params prm) {
    extern __shared__ __attribute__((aligned(16))) unsigned char lds_raw[];
    LAS unsigned char* lds = (LAS unsigned char*)lds_raw;
    cg::grid_group grid = cg::this_grid();
    const int G = gridDim.x, bx = blockIdx.x;
    const int wv = __builtin_amdgcn_readfirstlane((int)(threadIdx.x >> 6));
    Ctx C;
#pragma unroll
    for (int i = 0; i < 21; ++i) C.in[i] = prm.in[i];
    C.out = prm.out; C.ws = prm.ws;
    unsigned char* ws = prm.ws;
    unsigned* gbar = (unsigned*)(ws + WS_BAR); unsigned bar_k = 0u;
#define GBAR() grid_bar(gbar, (++bar_k) * (unsigned)G, wv)
    if (bx == 0 && threadIdx.x == 0) *gbar = 0u;
    for (int rep = 0; rep < 1 + DUP_P0; ++rep) { p0_prologue(C, lds, G, wv); __syncthreads(); }
    grid.sync();
    p1_filters(C, lds, G, wv);
    { HyProg P; P.K = DM; P.G = G; P.c = bx; P.W = (const bf16_t*)(ws + WS_WIN); P.X = (const bf16_t*)(ws + WS_XB); P.HY = (bf16_t*)(ws + WS_HY); P.r1 = (const float*)(ws + WS_R1S);
      pg8::gemm_stream(lds, P, wv); }
    for (int rep = 0; rep < 1 + DUP_REST; ++rep) { RestProg P; P.K = DM; P.G = G; P.c = bx; P.W = (const bf16_t*)(ws + WS_WIN); P.X = (const bf16_t*)(ws + WS_XB); P.R1A = (bf16_t*)(ws + WS_R1A); P.R1B = (bf16_t*)(ws + WS_R1B); P.R2 = (bf16_t*)prm.out; P.r1 = (const float*)(ws + WS_R1S);
      pg8::gemm_stream(lds, P, wv); }
    GBAR();
    qk_prepass(C, G, wv);
    for (int rep = 0; rep < 1 + DUP_HY; ++rep) for (int idx = bx; idx < 1024; idx += G) { const int rd = idx >> 8, bb = idx & 255; hyena_item(C, lds, rd * 256 + (bb & 7) * 32 + (bb >> 3), wv); }
    GBAR();
    for (int rep = 0; rep < 1 + DUP_ML; ++rep) for (int item = bx; item < 256; item += G) mlstm_item(C, lds, item, wv);
    GBAR();
    { BranchProg P; P.K = 1024; P.G = G; P.c = bx; P.YA = (const bf16_t*)(ws + WS_YA); P.YBF = (const bf16_t*)(ws + WS_YBF); P.YBB = (const bf16_t*)(ws + WS_YBB);
      P.WA = (const bf16_t*)(ws + WS_WA); P.WB = (const bf16_t*)(ws + WS_WB); P.R2 = (const bf16_t*)prm.out; P.MIX = (bf16_t*)(ws + WS_MIX);
      pg8::gemm_stream(lds, P, wv); }
    GBAR();
    { ResProg P; P.K = DM; P.G = G; P.c = bx; P.A = (const bf16_t*)(ws + WS_MIX); P.B = (const bf16_t*)(ws + WS_WOUT); P.base = prm.in[0]; P.out = prm.out; P.outb = (bf16_t*)(ws + WS_X1B); P.ss = (float*)(ws + WS_SS2);
      pg8::gemm_stream(lds, P, wv); }
    GBAR();
    for (int rep = 0; rep < 1 + DUP_GU; ++rep) { GuProg P; P.K = DM; P.G = G; P.c = bx; P.X = (const bf16_t*)(ws + WS_X1B); P.W = (const bf16_t*)(ws + WS_WGU); P.HH = (bf16_t*)(ws + WS_HH); P.ss2 = (const float*)(ws + WS_SS2);
      pg8::gemm_stream(lds, P, wv); }
    GBAR();
    { ResProg P; P.K = FFH; P.G = G; P.c = bx; P.A = (const bf16_t*)(ws + WS_HH); P.B = (const bf16_t*)(ws + WS_WD); P.base = prm.out; P.out = prm.out; P.outb = nullptr; P.ss = (float*)(ws + WS_SS3);
      pg8::gemm_stream(lds, P, wv); }
    GBAR();
    p7_final(C, G, wv);
}

extern "C" void kernel_launch(void* const* d_in, const int* in_sizes, int n_in, void* d_out, int out_size, void* d_ws, size_t ws_size, hipStream_t stream) {
    static int grid = 0;
    if (grid == 0) {
        int dev = 0, cus = 0, per_cu = 0;
        hipGetDevice(&dev); hipDeviceGetAttribute(&cus, hipDeviceAttributeMultiprocessorCount, dev);
        if (hipFuncSetAttribute((const void*)fwd_megakernel, hipFuncAttributeMaxDynamicSharedMemorySize, LDS_BYTES) != hipSuccess) { fprintf(stderr, "kernel_launch: hipFuncSetAttribute failed\n"); grid = -1; return; }
        if (hipOccupancyMaxActiveBlocksPerMultiprocessor(&per_cu, (const void*)fwd_megakernel, 512, LDS_BYTES) != hipSuccess || per_cu < 1) { fprintf(stderr, "kernel_launch: occupancy query gave %d\n", per_cu); per_cu = 1; }
        (void)hipGetLastError();
        grid = cus * 1;
        if (n_in != 21 || ws_size < WS_END) { fprintf(stderr, "kernel_launch: unexpected n_in %d or ws %zu\n", n_in, ws_size); grid = -1; return; }
    }
    if (grid < 0) return;
    Params p{};
    for (int i = 0; i < 21; ++i) p.in[i] = (const float*)d_in[i];
    p.out = (float*)d_out; p.ws = (unsigned char*)d_ws;
    void* args[] = {&p};
    hipError_t e = hipLaunchCooperativeKernel((const void*)fwd_megakernel, dim3(grid), dim3(512), args, LDS_BYTES, stream);
    if (e != hipSuccess) fprintf(stderr, "cooperative launch failed: %s (grid %d)\n", hipGetErrorString(e), grid);
}
```

```cpp
#include <hip/hip_runtime.h>
#include <hip/hip_cooperative_groups.h>
#include <cstdio>
namespace cg = cooperative_groups;

#define LAS __attribute__((address_space(3)))
typedef unsigned short bf16_t;
typedef short bf16x8 __attribute__((ext_vector_type(8)));
typedef short bf16x4 __attribute__((ext_vector_type(4)));
typedef float f32x4 __attribute__((ext_vector_type(4)));
typedef float f32x2 __attribute__((ext_vector_type(2)));
typedef unsigned u32x4 __attribute__((ext_vector_type(4)));
typedef unsigned u32x2 __attribute__((ext_vector_type(2)));

constexpr int NB = 4, SEQ = 4096, TOK = NB * SEQ, DM = 2048, HW = 1024, MW = 1024, NHEAD = 4, DH = 256, FFH = 5632;
constexpr int CONVC = 5120, INCOLS = 11280, NFILT = 4096;
constexpr float RMS_EPS = 1e-6f;
constexpr size_t MiB = 1u << 20;
constexpr size_t WS_BAR = 262144, WS_R1S = 0, WS_SS2 = 65536, WS_SS3 = 131072, WS_G = 1 * MiB, WS_H2 = 2 * MiB;
constexpr size_t WS_WA = 4 * MiB, WS_WB = 8 * MiB, WS_WOUT = 12 * MiB, WS_WGU = 20 * MiB, WS_WD = 64 * MiB, WS_WIN = 86 * MiB, WS_XB = 130 * MiB;
constexpr size_t WS_FILT = 194 * MiB, WS_HY = 258 * MiB, WS_R1A = 354 * MiB, WS_R1B = 418 * MiB, WS_END = 482 * MiB;
constexpr size_t WS_QKP = 86 * MiB, WS_YA = 150 * MiB, WS_YBF = 354 * MiB, WS_YBB = 386 * MiB, WS_X1B = 86 * MiB, WS_MIX = 194 * MiB, WS_HH = 258 * MiB;
constexpr int LDS_BYTES = 147456;

__device__ __forceinline__ unsigned f2bf(float f) { unsigned u = __float_as_uint(f); return (u + 0x7fffu + ((u >> 16) & 1u)) >> 16; }
__device__ __forceinline__ unsigned pk2(float lo, float hi) { unsigned r; asm volatile("v_cvt_pk_bf16_f32 %0, %1, %2" : "=v"(r) : "v"(lo), "v"(hi)); return r; }
__device__ __forceinline__ float bflo(unsigned w) { return __uint_as_float(w << 16); }
__device__ __forceinline__ float bfhi(unsigned w) { return __uint_as_float(w & 0xffff0000u); }
__device__ __forceinline__ float wave_sum(float v) {
#pragma unroll
    for (int o = 1; o < 64; o <<= 1) v += __shfl_xor(v, o);
    return v;
}
__device__ __forceinline__ int lane_id_opaque() { int l; asm volatile("v_mbcnt_lo_u32_b32 %0, -1, 0\n\tv_mbcnt_hi_u32_b32 %0, -1, %0" : "=v"(l)); return l; }
__device__ __forceinline__ float sigmoidf_(float x) { return 1.0f / (1.0f + __expf(-x)); }
__device__ __forceinline__ float siluf_(float x) { return x / (1.0f + __expf(-x)); }

namespace pg8 {
constexpr int BM = 256, BK = 64, HALF = 128, HTB = HALF * BK * 2, STAGE_BYTES = 8 * HTB, NXCD = 8, WGM = 8;
__device__ __forceinline__ int lds_byte(int r, int c) { const int st = (r >> 4) * 2 + (c >> 5), rr = r & 15, cc = c & 31, ob = rr * 64 + cc * 2; return st * 1024 + (ob ^ (((ob >> 9) & 1) << 5)); }
__device__ __forceinline__ void stage_rc(int b, int& R, int& C) { const int st = b / 1024, sb = b % 1024, swz = sb ^ (((sb >> 9) & 1) << 5); R = (st >> 1) * 16 + swz / 64; C = (st & 1) * 32 + (swz % 64) / 2; }
__device__ __forceinline__ int perm32(int rho) { const int n = rho >> 4, i = rho & 15; return 8 * (i >> 2) + 4 * n + (i & 3); }
struct GUnit { const char* A; const char* B; int pm, pn, sub; };
__device__ __forceinline__ void tile_of(int L, int nM, int nN, int& pm, int& pn) {
    const int nwg = nM * nN; int wgid = L; { const int q = nwg / NXCD, r = nwg % NXCD, xcd = wgid % NXCD, off = wgid / NXCD; wgid = (xcd < r ? xcd * (q + 1) : r * (q + 1) + (xcd - r) * q) + off; }
    const int nig = WGM * nN, gid = wgid / nig, fm = gid * WGM, gsz = (nM - fm) < WGM ? (nM - fm) : WGM;
    pm = fm + ((wgid % nig) % gsz); pn = (wgid % nig) / gsz;
}
typedef f32x4 Acc[2][2][4][2];
template <class Prog>
__device__ __forceinline__ void gemm_stream(LAS unsigned char* lds, const Prog& P, int wv) {
    int tid = (wv << 6) | lane_id_opaque(); asm volatile("" : "+v"(tid));
    const int wid = __builtin_amdgcn_readfirstlane(tid >> 6), lane = tid & 63, wr = wid >> 2, wc = wid & 3, fr = lane & 15, fq = lane >> 4;
    const int K = P.K, nt = K / BK;
    unsigned voffA[2], voffB[2];
#pragma unroll
    for (int i = 0; i < 2; ++i) { int R, C; stage_rc(tid * 16 + i * 8192, R, C); const int Rb = Prog::PERM ? ((R & ~31) + perm32(R & 31)) : R;
        voffA[i] = (unsigned)(R * K + C) * 2u; voffB[i] = (unsigned)(Rb * K + C) * 2u; }
    const size_t kstep = (size_t)(BK * 2);
    const size_t hstep = (size_t)HALF * K * 2;
    const unsigned ldsw = (unsigned)wid * 1024u;
    const int aoff = lds_byte(wr * 64 + fr, fq * 8), boff = lds_byte(wc * 32 + fr, fq * 8);
#define PG8_SA(b, h) (((b) * 2 + (h)) * HTB)
#define PG8_SB(b, h) ((4 + (b) * 2 + (h)) * HTB)
#define PG8_STAGE(bufoff, gbase, voff) do { _Pragma("unroll") for (int _i = 0; _i < 2; ++_i) \
        __builtin_amdgcn_global_load_lds((const unsigned*)((const char*)(gbase) + (voff)[_i]), (LAS unsigned*)(lds + (bufoff) + ldsw + _i * 8192), 16, 0, 0); } while (0)
#define PG8_LDA(dst, b, h) do { _Pragma("unroll") for (int m = 0; m < 4; ++m) _Pragma("unroll") for (int k = 0; k < 2; ++k) dst[m][k] = *(const LAS bf16x8*)(lds + PG8_SA(b, h) + aoff + m * 2048 + k * 1024); } while (0)
#define PG8_LDB(dst, b, h) do { _Pragma("unroll") for (int n = 0; n < 2; ++n) _Pragma("unroll") for (int k = 0; k < 2; ++k) dst[n][k] = *(const LAS bf16x8*)(lds + PG8_SB(b, h) + boff + n * 2048 + k * 1024); } while (0)
#define PG8_MMA(ai, bj, At, Bt) do { __builtin_amdgcn_s_setprio(1); _Pragma("unroll") for (int m = 0; m < 4; ++m) _Pragma("unroll") for (int n = 0; n < 2; ++n) _Pragma("unroll") for (int k = 0; k < 2; ++k) \
        acc[ai][bj][m][n] = __builtin_amdgcn_mfma_f32_16x16x32_bf16(Bt[n][k], At[m][k], acc[ai][bj][m][n], 0, 0, 0); __builtin_amdgcn_s_setprio(0); } while (0)
#define PG8_WAIT_V(n) asm volatile("s_waitcnt vmcnt(" #n ")" ::: "memory")
#define PG8_WAIT_L(n) asm volatile("s_waitcnt lgkmcnt(" #n ")" ::: "memory")
#define PG8_BAR __builtin_amdgcn_s_barrier()
#define PG8_SCHED __builtin_amdgcn_sched_barrier(0)
    GUnit cur, nxt; int ui = 0;
    if (!P.next(0, cur)) return;
    f32x4 acc[2][2][4][2];
#pragma unroll
    for (int a = 0; a < 2; ++a)
#pragma unroll
        for (int b = 0; b < 2; ++b)
#pragma unroll
            for (int m = 0; m < 4; ++m)
#pragma unroll
                for (int n = 0; n < 2; ++n) acc[a][b][m][n] = (f32x4){0.f, 0.f, 0.f, 0.f};
    bf16x8 At[4][2], B0[2][2], B1[2][2];
    const char* cA = cur.A; const char* cB = cur.B;
    PG8_STAGE(PG8_SB(0, 0), cB, voffB); PG8_STAGE(PG8_SA(0, 0), cA, voffA); PG8_STAGE(PG8_SB(0, 1), cB + hstep, voffB); PG8_STAGE(PG8_SA(0, 1), cA + hstep, voffA);
    if (wr == 1) PG8_BAR;
    PG8_WAIT_V(4); PG8_BAR;
    PG8_STAGE(PG8_SB(1, 0), cB + kstep, voffB); PG8_STAGE(PG8_SA(1, 0), cA + kstep, voffA); PG8_STAGE(PG8_SB(1, 1), cB + hstep + kstep, voffB);
    PG8_WAIT_V(6); PG8_BAR;
    for (;;) {
        const bool has_next = P.next(ui + 1, nxt);
        const char* nA = has_next ? nxt.A : cA; const char* nB = has_next ? nxt.B : cB;
        for (int t = 0; t < nt; t += 2) {
            const bool last = (t == nt - 2);
            const char* a1 = cA + (size_t)(t + 1) * kstep;
            const char* a2 = last ? nA : cA + (size_t)(t + 2) * kstep; const char* b2 = last ? nB : cB + (size_t)(t + 2) * kstep;
            const char* a3 = a2 + kstep; const char* b3 = b2 + kstep;
            PG8_LDB(B0, 0, 0); PG8_SCHED; PG8_LDA(At, 0, 0); PG8_STAGE(PG8_SA(1, 1), a1 + hstep, voffA);
            PG8_WAIT_L(8); PG8_BAR; PG8_WAIT_L(0); PG8_MMA(0, 0, At, B0); PG8_BAR; PG8_SCHED;
            PG8_LDB(B1, 0, 1); PG8_STAGE(PG8_SB(0, 0), b2, voffB);
            PG8_BAR; PG8_WAIT_L(0); PG8_MMA(0, 1, At, B1); PG8_BAR;
            PG8_LDA(At, 0, 1); PG8_STAGE(PG8_SA(0, 0), a2, voffA);
            PG8_BAR; PG8_WAIT_L(0); PG8_MMA(1, 0, At, B0); PG8_BAR; PG8_SCHED;
            PG8_STAGE(PG8_SB(0, 1), b2 + hstep, voffB);
            PG8_WAIT_V(6); PG8_BAR; PG8_MMA(1, 1, At, B1); PG8_BAR;
            PG8_LDB(B0, 1, 0); PG8_SCHED; PG8_LDA(At, 1, 0); PG8_STAGE(PG8_SA(0, 1), a2 + hstep, voffA);
            PG8_WAIT_L(8); PG8_BAR; PG8_WAIT_L(0); PG8_MMA(0, 0, At, B0); PG8_BAR; PG8_SCHED;
            PG8_LDB(B1, 1, 1); PG8_STAGE(PG8_SB(1, 0), b3, voffB);
            PG8_BAR; PG8_WAIT_L(0); PG8_MMA(0, 1, At, B1); PG8_BAR;
            PG8_LDA(At, 1, 1); PG8_STAGE(PG8_SA(1, 0), a3, voffA);
            PG8_BAR; PG8_WAIT_L(0); PG8_MMA(1, 0, At, B0); PG8_BAR; PG8_SCHED;
            PG8_STAGE(PG8_SB(1, 1), b3 + hstep, voffB);
            PG8_WAIT_V(6); PG8_BAR; PG8_MMA(1, 1, At, B1); PG8_BAR;
        }
        P.epi(acc, cur, wr, wc, fr, fq);
        if (!has_next) break;
        cur = nxt; cA = nA; cB = nB; ++ui;
    }
    PG8_WAIT_V(0);
    if (wr == 0) PG8_BAR;
    PG8_BAR;
#undef PG8_SA
#undef PG8_SB
#undef PG8_STAGE
#undef PG8_LDA
#undef PG8_LDB
#undef PG8_MMA
#undef PG8_WAIT_V
#undef PG8_WAIT_L
#undef PG8_BAR
#undef PG8_SCHED
}
__device__ __forceinline__ void zero_acc(Acc& acc) {
#pragma unroll
    for (int a = 0; a < 2; ++a)
#pragma unroll
        for (int b = 0; b < 2; ++b)
#pragma unroll
            for (int m = 0; m < 4; ++m)
#pragma unroll
                for (int n = 0; n < 2; ++n) acc[a][b][m][n] = (f32x4){0.f, 0.f, 0.f, 0.f};
}
}
using pg8::GUnit; using pg8::Acc;
struct HyProg {
    static constexpr bool PERM = true; int K, G, c; const bf16_t* W; const bf16_t* X; bf16_t* HY; const float* r1;
    __device__ __forceinline__ bool next(int i, GUnit& u) const { const int L = i * G + c; if (L >= 12 * 64) return false; pg8::tile_of(L, 12, 64, u.pm, u.pn);
        u.A = (const char*)(W + (size_t)u.pm * 256 * DM); u.B = (const char*)(X + (size_t)u.pn * 256 * DM); u.sub = 0; return true; }
    __device__ __forceinline__ void epi(Acc& acc, const GUnit& u, int wr, int wc, int fr, int fq) const {
        const int row0 = u.pm * 256 + wr * 64 + fr, col0 = u.pn * 256 + wc * 32 + 8 * fq;
        f32x4 sc[2][2];
#pragma unroll
        for (int bj = 0; bj < 2; ++bj) { sc[bj][0] = *(const f32x4*)(r1 + col0 + bj * 128); sc[bj][1] = *(const f32x4*)(r1 + col0 + bj * 128 + 4); }
#pragma unroll
        for (int ai = 0; ai < 2; ++ai)
#pragma unroll
            for (int m = 0; m < 4; ++m) { bf16_t* rowp = HY + (size_t)(row0 + ai * 128 + m * 16) * TOK + col0;
#pragma unroll
                for (int bj = 0; bj < 2; ++bj) { const f32x4 v0 = acc[ai][bj][m][0] * sc[bj][0], v1 = acc[ai][bj][m][1] * sc[bj][1];
                    u32x4 w; w.x = pk2(v0[0], v0[1]); w.y = pk2(v0[2], v0[3]); w.z = pk2(v1[0], v1[1]); w.w = pk2(v1[2], v1[3]);
                    *(u32x4*)(rowp + bj * 128) = w; } }
        pg8::zero_acc(acc);
    }
};
struct RestProg {
    static constexpr bool PERM = true; int K, G, c; const bf16_t* W; const bf16_t* X; bf16_t* R1A; bf16_t* R1B; bf16_t* R2; const float* r1;
    __device__ __forceinline__ bool next(int i, GUnit& u) const { const int L = i * G + c; if (L >= 64 * 32) return false; pg8::tile_of(L, 64, 32, u.pm, u.pn);
        u.A = (const char*)(X + (size_t)u.pm * 256 * DM); u.B = (const char*)(W + (size_t)(3072 + u.pn * 256) * DM); u.sub = 0; return true; }
    __device__ __forceinline__ void epi(Acc& acc, const GUnit& u, int wr, int wc, int fr, int fq) const {
        const int row0 = u.pm * 256 + wr * 64 + fr; const bool sg = u.pn >= 12;
        bf16_t* base = u.pn < 8 ? R1A + u.pn * 256 : (u.pn < 16 ? R1B + (u.pn - 8) * 256 : R2 + (u.pn - 16) * 256);
        const int pitch = u.pn < 16 ? 2048 : 4096;
        const int col0 = wc * 32 + 8 * fq;
#pragma unroll
        for (int ai = 0; ai < 2; ++ai)
#pragma unroll
            for (int m = 0; m < 4; ++m) { const int row = row0 + ai * 128 + m * 16; const float s = r1[row]; bf16_t* rowp = base + (size_t)row * pitch + col0;
#pragma unroll
                for (int bj = 0; bj < 2; ++bj) { f32x4 v0 = acc[ai][bj][m][0] * s, v1 = acc[ai][bj][m][1] * s;
                    if (sg) {
#pragma unroll
                        for (int j = 0; j < 4; ++j) { v0[j] = sigmoidf_(v0[j]); v1[j] = sigmoidf_(v1[j]); } }
                    u32x4 w; w.x = pk2(v0[0], v0[1]); w.y = pk2(v0[2], v0[3]); w.z = pk2(v1[0], v1[1]); w.w = pk2(v1[2], v1[3]);
                    *(u32x4*)(rowp + bj * 128) = w; } }
        pg8::zero_acc(acc);
    }
};
struct BranchProg {
    static constexpr bool PERM = true; int K, G, c; const bf16_t *YA, *YBF, *YBB, *WA, *WB; const bf16_t* R2; bf16_t* MIX;
    __device__ __forceinline__ bool next(int i, GUnit& u) const { const int ti = i / 3, sub = i - 3 * ti; const int L = ti * G + c; if (L >= 64 * 8) return false; pg8::tile_of(L, 64, 8, u.pm, u.pn);
        const bf16_t* a = sub == 0 ? YA : (sub == 1 ? YBF : YBB); const bf16_t* b = sub == 0 ? WA : WB;
        u.A = (const char*)(a + (size_t)u.pm * 256 * 1024); u.B = (const char*)(b + (size_t)u.pn * 256 * 1024); u.sub = sub; return true; }
    __device__ __forceinline__ void epi(Acc& acc, const GUnit& u, int wr, int wc, int fr, int fq) const {
        if (u.sub == 1) return;
        const int row0 = u.pm * 256 + wr * 64 + fr, col0 = u.pn * 256 + wc * 32 + 8 * fq;
#pragma unroll
        for (int ai = 0; ai < 2; ++ai)
#pragma unroll
            for (int m = 0; m < 4; ++m) { const int row = row0 + ai * 128 + m * 16; const bf16_t* gp = R2 + (size_t)row * 4096 + col0;
#pragma unroll
                for (int bj = 0; bj < 2; ++bj) {
                    const u32x4 gbw = *(const u32x4*)(gp + 2048 + bj * 128);
                    float gb[8] = {bflo(gbw.x), bfhi(gbw.x), bflo(gbw.y), bfhi(gbw.y), bflo(gbw.z), bfhi(gbw.z), bflo(gbw.w), bfhi(gbw.w)};
                    if (u.sub == 0) {
                        const u32x4 gaw = *(const u32x4*)(gp + bj * 128);
                        float ga[8] = {bflo(gaw.x), bfhi(gaw.x), bflo(gaw.y), bfhi(gaw.y), bflo(gaw.z), bfhi(gaw.z), bflo(gaw.w), bfhi(gaw.w)};
#pragma unroll
                        for (int j = 0; j < 4; ++j) { acc[ai][bj][m][0][j] *= ga[j] / fmaxf(gb[j], 1e-30f); acc[ai][bj][m][1][j] *= ga[4 + j] / fmaxf(gb[4 + j], 1e-30f); }
                    } else {
                        f32x4 v0 = acc[ai][bj][m][0], v1 = acc[ai][bj][m][1];
#pragma unroll
                        for (int j = 0; j < 4; ++j) { v0[j] *= fmaxf(gb[j], 1e-30f); v1[j] *= fmaxf(gb[4 + j], 1e-30f); }
                        u32x4 w; w.x = pk2(v0[0], v0[1]); w.y = pk2(v0[2], v0[3]); w.z = pk2(v1[0], v1[1]); w.w = pk2(v1[2], v1[3]);
                        *(u32x4*)(MIX + (size_t)row * DM + col0 + bj * 128) = w;
                    } } }
        if (u.sub == 2) pg8::zero_acc(acc);
    }
};
struct ResProg {
    static constexpr bool PERM = false; int K, G, c; const bf16_t* A; const bf16_t* B; const float* base; float* out; bf16_t* outb; float* ss;
    __device__ __forceinline__ bool next(int i, GUnit& u) const { const int L = i * G + c; if (L >= 64 * 8) return false; pg8::tile_of(L, 64, 8, u.pm, u.pn);
        u.A = (const char*)(A + (size_t)u.pm * 256 * K); u.B = (const char*)(B + (size_t)u.pn * 256 * K); u.sub = 0; return true; }
    __device__ __forceinline__ void epi(Acc& acc, const GUnit& u, int wr, int wc, int fr, int fq) const {
        const int row0 = u.pm * 256 + wr * 64 + fr, col0 = u.pn * 256 + wc * 32 + 4 * fq;
#pragma unroll
        for (int ai = 0; ai < 2; ++ai)
#pragma unroll
            for (int m = 0; m < 4; ++m) { const int row = row0 + ai * 128 + m * 16; const size_t off = (size_t)row * DM + col0; float s = 0.f;
#pragma unroll
                for (int bj = 0; bj < 2; ++bj)
#pragma unroll
                    for (int n = 0; n < 2; ++n) { const f32x4 bs = *(const f32x4*)(base + off + bj * 128 + n * 16); const f32x4 o = bs + acc[ai][bj][m][n];
                        *(f32x4*)(out + off + bj * 128 + n * 16) = o; s += (o[0] * o[0] + o[1] * o[1]) + (o[2] * o[2] + o[3] * o[3]);
                        if (outb) { u32x2 w; w.x = pk2(o[0], o[1]); w.y = pk2(o[2], o[3]); *(u32x2*)(outb + off + bj * 128 + n * 16) = w; } }
                s += __shfl_xor(s, 16); s += __shfl_xor(s, 32);
                if (fq == 0) unsafeAtomicAdd(ss + row, s); }
        pg8::zero_acc(acc);
    }
};
struct GuProg {
    static constexpr bool PERM = true; int K, G, c; const bf16_t* X; const bf16_t* W; bf16_t* HH; const float* ss2;
    __device__ __forceinline__ bool next(int i, GUnit& u) const { const int L = i * G + c; if (L >= 64 * 44) return false; pg8::tile_of(L, 64, 44, u.pm, u.pn);
        u.A = (const char*)(X + (size_t)u.pm * 256 * DM); u.B = (const char*)(W + (size_t)u.pn * 256 * DM); u.sub = 0; return true; }
    __device__ __forceinline__ void epi(Acc& acc, const GUnit& u, int wr, int wc, int fr, int fq) const {
        const int row0 = u.pm * 256 + wr * 64 + fr, col0 = u.pn * 128 + wc * 32 + 8 * fq;
#pragma unroll
        for (int ai = 0; ai < 2; ++ai)
#pragma unroll
            for (int m = 0; m < 4; ++m) { const int row = row0 + ai * 128 + m * 16; const float r2 = 1.0f / sqrtf(ss2[row] * (1.0f / DM) + RMS_EPS);
                float hv[8];
#pragma unroll
                for (int n = 0; n < 2; ++n)
#pragma unroll
                    for (int j = 0; j < 4; ++j) { const float g = acc[ai][0][m][n][j] * r2, uu = acc[ai][1][m][n][j] * r2; hv[4 * n + j] = siluf_(g) * uu; }
                u32x4 w; w.x = pk2(hv[0], hv[1]); w.y = pk2(hv[2], hv[3]); w.z = pk2(hv[4], hv[5]); w.w = pk2(hv[6], hv[7]);
                *(u32x4*)(HH + (size_t)row * FFH + col0) = w; }
        pg8::zero_acc(acc);
    }
};
struct Ctx {
    const float* in[21]; float* out; unsigned char* ws;
};
__device__ __forceinline__ void p0_transpose_item(const float* W, int Nsrc, int K, bf16_t* WT, int dst_row0, int src_col0, const float* kscale, LAS float* scr, int kb, int lane) {
    const int k0 = 64 * kb;
    float tv[32];
    const float* wp = W + (size_t)(k0 + (lane >> 5)) * Nsrc + src_col0 + (lane & 31);
#pragma unroll
    for (int i = 0; i < 32; ++i) tv[i] = wp[(size_t)(2 * i) * Nsrc];
    if (kscale) {
#pragma unroll
        for (int i = 0; i < 32; ++i) tv[i] *= kscale[k0 + 2 * i + (lane >> 5)]; }
#pragma unroll
    for (int i = 0; i < 32; ++i) scr[(2 * i + (lane >> 5)) * 33 + (lane & 31)] = tv[i];
    asm volatile("s_waitcnt lgkmcnt(0)" ::: "memory");
    const int c = lane & 7;
#pragma unroll
    for (int j = 0; j < 4; ++j) { const int n = (lane >> 3) + 8 * j; const LAS float* s = scr + (8 * c) * 33 + n;
        u32x4 o; o.x = pk2(s[0 * 33], s[1 * 33]); o.y = pk2(s[2 * 33], s[3 * 33]); o.z = pk2(s[4 * 33], s[5 * 33]); o.w = pk2(s[6 * 33], s[7 * 33]);
        *(u32x4*)(WT + (size_t)(dst_row0 + n) * K + k0 + 8 * c) = o; }
    asm volatile("s_waitcnt lgkmcnt(0)" ::: "memory");
}
__device__ __forceinline__ void p0_prologue(const Ctx& C, LAS unsigned char* lds, int G, int wv) {
    int tid = (wv << 6) | lane_id_opaque(); asm volatile("" : "+v"(tid));
    const int lane = tid & 63, wave = __builtin_amdgcn_readfirstlane(tid >> 6);
    const int gw = blockIdx.x * 8 + wave, NGW = G * 8;
    unsigned char* ws = C.ws;
    LAS float* scr = (LAS float*)(lds + wave * 8704);
    constexpr int I_IN = 32 * 352, I_A = 16 * 64, I_O = 32 * 64, I_GU = 32 * 352, I_D = 88 * 64;
    constexpr int NIT = I_IN + 2 * I_A + I_O + I_GU + I_D;
    for (int it = gw; it < NIT; it += NGW) {
        int r = it;
        if (r < I_IN) { const int kb = r / 352, nb = r % 352, n0 = nb * 32; const int src = n0 < 7168 ? n0 : n0 + 16;
            p0_transpose_item(C.in[2], INCOLS, DM, (bf16_t*)(ws + WS_WIN), n0, src, C.in[1], scr, kb, lane); continue; } r -= I_IN;
        if (r < I_A) { p0_transpose_item(C.in[14], DM, HW, (bf16_t*)(ws + WS_WA), (r % 64) * 32, (r % 64) * 32, nullptr, scr, r / 64, lane); continue; } r -= I_A;
        if (r < I_A) { p0_transpose_item(C.in[15], DM, MW, (bf16_t*)(ws + WS_WB), (r % 64) * 32, (r % 64) * 32, nullptr, scr, r / 64, lane); continue; } r -= I_A;
        if (r < I_O) { p0_transpose_item(C.in[16], DM, DM, (bf16_t*)(ws + WS_WOUT), (r % 64) * 32, (r % 64) * 32, nullptr, scr, r / 64, lane); continue; } r -= I_O;
        if (r < I_GU) { const int kb = r / 352, nb = r % 352, n0 = nb * 32; const int pn = n0 >> 8, half = (n0 >> 7) & 1, i = n0 & 127;
            p0_transpose_item(C.in[18], 2 * FFH, DM, (bf16_t*)(ws + WS_WGU), n0, half * FFH + 128 * pn + i, C.in[17], scr, kb, lane); continue; } r -= I_GU;
        p0_transpose_item(C.in[19], DM, FFH, (bf16_t*)(ws + WS_WD), (r % 64) * 32, (r % 64) * 32, nullptr, scr, r / 64, lane);
    }
    for (int i = blockIdx.x * 512 + tid; i < TOK; i += G * 512) { ((float*)(ws + WS_SS2))[i] = 0.f; ((float*)(ws + WS_SS3))[i] = 0.f; }
    {
        const float* w1 = C.in[5]; const float* b1 = C.in[6]; const float* f1 = C.in[7]; const float* w2 = C.in[8]; const float* b2 = C.in[9]; const float* f2 = C.in[10];
        float* h2 = (float*)(ws + WS_H2);
        for (int t = gw; t < SEQ; t += NGW) {
            const float tl = (float)t / (float)(SEQ - 1);
            const float omega = 6.283185307179586f * (float)t / (float)SEQ;
            float a = b1[lane] + tl * w1[lane];
#pragma unroll 4
            for (int i = 0; i < 16; ++i) { const float fr = 1e-4f + (float)i * ((15.0f - 1e-4f) / 15.0f); const float ang = omega * fr; float sn, cs; sincosf(ang, &sn, &cs);
                a += cs * w1[(1 + i) * 64 + lane] - sn * w1[(17 + i) * 64 + lane]; }
            const float h1 = sinf(f1[lane] * a);
            float a2 = b2[lane];
#pragma unroll 8
            for (int i = 0; i < 64; ++i) a2 += __shfl(h1, i) * w2[i * 64 + lane];
            h2[t * 64 + lane] = sinf(f2[lane] * a2);
        }
    }
    __syncthreads();
    {
        LAS float* wg = (LAS float*)lds;
        const float* w_in = C.in[2]; const float* nw = C.in[1];
#pragma unroll 1
        for (int i0 = tid; i0 < DM * 16; i0 += 512 * 16) { float tw[16], tn[16];
#pragma unroll
            for (int u = 0; u < 16; ++u) { const int i = i0 + 512 * u, k = i >> 4, g = i & 15; tw[u] = w_in[(size_t)k * INCOLS + 7168 + g]; tn[u] = nw[k]; }
#pragma unroll
            for (int u = 0; u < 16; ++u) { const int i = i0 + 512 * u, k = i >> 4, g = i & 15; wg[g * DM + k] = tw[u] * tn[u]; } }
        __syncthreads();
        const float* x = C.in[0]; bf16_t* xb = (bf16_t*)(ws + WS_XB); float* r1 = (float*)(ws + WS_R1S); float* Gt = (float*)(ws + WS_G); const float* gbias = C.in[13];
        f32x4 vn[8];
        { const f32x4* xr = (const f32x4*)(x + (size_t)gw * DM) + lane;
#pragma unroll
          for (int j = 0; j < 8; ++j) vn[j] = xr[64 * j]; }
        for (int row = gw; row < TOK; row += NGW) {
            f32x4 v[8]; float s = 0.f;
#pragma unroll
            for (int j = 0; j < 8; ++j) { v[j] = vn[j]; s += (v[j].x * v[j].x + v[j].y * v[j].y) + (v[j].z * v[j].z + v[j].w * v[j].w); }
            if (row + NGW < TOK) { const f32x4* xr = (const f32x4*)(x + (size_t)(row + NGW) * DM) + lane;
#pragma unroll
                for (int j = 0; j < 8; ++j) vn[j] = xr[64 * j]; }
            const float r = 1.0f / sqrtf(wave_sum(s) * (1.0f / DM) + RMS_EPS);
            u32x2* o8 = (u32x2*)(xb + (size_t)row * DM) + lane;
#pragma unroll
            for (int j = 0; j < 8; ++j) { u32x2 w; w.x = pk2(v[j].x, v[j].y); w.y = pk2(v[j].z, v[j].w); o8[64 * j] = w; }
            float myg = 0.f;
#pragma unroll
            for (int g = 0; g < 16; ++g) { float a = 0.f;
#pragma unroll
                for (int j = 0; j < 8; ++j) { const f32x4 w = *(const LAS f32x4*)(wg + g * DM + 256 * j + 4 * lane); a += (v[j].x * w.x + v[j].y * w.y) + (v[j].z * w.z + v[j].w * w.w); }
                a = wave_sum(a); if (lane == g) myg = a; }
            if (lane < 16) Gt[(size_t)row * 16 + lane] = myg * r + gbias[lane];
            if (lane == 0) r1[row] = r;
        }
    }
}
__device__ __forceinline__ void p1_filters(const Ctx& C, LAS unsigned char* lds, int G, int wv) {
    int tid = (wv << 6) | lane_id_opaque(); asm volatile("" : "+v"(tid));
    LAS float* w3s = (LAS float*)lds;
    const float* w3 = C.in[11]; const float* h2 = (const float*)(C.ws + WS_H2); float* FILT = (float*)(C.ws + WS_FILT);
    for (int item = blockIdx.x; item < 512; item += G) {
        const int ntile = item >> 3, tt = item & 7, t = 512 * tt + tid;
        __syncthreads();
        for (int i = tid; i < 4096; i += 512) w3s[i] = w3[(size_t)(i >> 6) * NFILT + 64 * ntile + (i & 63)];
        __syncthreads();
        f32x4 hr[16];
#pragma unroll
        for (int j = 0; j < 16; ++j) hr[j] = *(const f32x4*)(h2 + (size_t)t * 64 + 4 * j);
        const float tl = (float)t / (float)(SEQ - 1);
#pragma unroll 1
        for (int n4 = 0; n4 < 16; ++n4) {
            float a[4] = {0.f, 0.f, 0.f, 0.f};
#pragma unroll
            for (int j = 0; j < 16; ++j) {
#pragma unroll
                for (int jj = 0; jj < 4; ++jj) { const f32x4 wv = *(const LAS f32x4*)(w3s + (4 * j + jj) * 64 + 4 * n4); const float hv = hr[j][jj];
                    a[0] = fmaf(hv, wv.x, a[0]); a[1] = fmaf(hv, wv.y, a[1]); a[2] = fmaf(hv, wv.z, a[2]); a[3] = fmaf(hv, wv.w, a[3]); }
            }
#pragma unroll
            for (int e = 0; e < 4; ++e) { const int n = 64 * ntile + 4 * n4 + e, ch = n & 1023;
                const float mind = -3.0701134573253945f, maxd = -15.350567286626973f;
                const float delta = mind + (float)ch * ((maxd - mind) / 1023.0f);
                FILT[(size_t)n * SEQ + t] = a[e] * expf(-tl * fabsf(delta)); }
        }
    }
    __syncthreads();
}
__device__ __forceinline__ void p7_final(const Ctx& C, int G, int wv) {
    int tid = (wv << 6) | lane_id_opaque(); asm volatile("" : "+v"(tid));
    const int lane = tid & 63, wave = tid >> 6, gw = blockIdx.x * 8 + wave, NGW = G * 8;
    const float* ss3 = (const float*)(C.ws + WS_SS3); const float* wf = C.in[20];
    f32x4 w[8];
#pragma unroll
    for (int j = 0; j < 8; ++j) w[j] = ((const f32x4*)wf)[64 * j + lane];
    for (int row = gw; row < TOK; row += NGW) {
        const float r = 1.0f / sqrtf(ss3[row] * (1.0f / DM) + RMS_EPS);
        f32x4* p = (f32x4*)(C.out + (size_t)row * DM) + lane;
        f32x4 v[8];
#pragma unroll
        for (int j = 0; j < 8; ++j) v[j] = p[64 * j];
#pragma unroll
        for (int j = 0; j < 8; ++j) p[64 * j] = v[j] * r * w[j];
    }
}
#ifndef FFT_HOST
#define FFT_DEV __device__ __forceinline__
#define FFT_PTR LAS f32x2*
#define FFT_SIN(x) __builtin_amdgcn_sinf(x)
#define FFT_COS(x) __builtin_amdgcn_cosf(x)
#else
#define FFT_DEV static inline
#define FFT_PTR f32x2*
#define FFT_SIN(x) sinf(6.283185307179586f * (x))
#define FFT_COS(x) cosf(6.283185307179586f * (x))
#endif
#define PADI(i) ((i) + ((i) >> 4))
FFT_DEV f32x2 cmul(f32x2 a, f32x2 b) { f32x2 r; r.x = a.x * b.x - a.y * b.y; r.y = a.x * b.y + a.y * b.x; return r; }
FFT_DEV f32x2 cmulc(f32x2 a, f32x2 b) { f32x2 r; r.x = a.x * b.x + a.y * b.y; r.y = a.y * b.x - a.x * b.y; return r; }
FFT_DEV f32x2 twid(float frac) { f32x2 r; r.x = FFT_COS(frac); r.y = -FFT_SIN(frac); return r; }
template <int M, int CJ> FFT_DEV f32x2 rot8(f32x2 d) {
    const float R = 0.70710678118654752f; f32x2 r;
    if (M == 0) return d;
    if (M == 2) { if (!CJ) { r.x = d.y; r.y = -d.x; } else { r.x = -d.y; r.y = d.x; } return r; }
    if (M == 1) { if (!CJ) { r.x = R * (d.x + d.y); r.y = R * (d.y - d.x); } else { r.x = R * (d.x - d.y); r.y = R * (d.x + d.y); } return r; }
    if (!CJ) { r.x = R * (d.y - d.x); r.y = -R * (d.x + d.y); } else { r.x = -R * (d.x + d.y); r.y = R * (d.x - d.y); } return r;
}
template <int INV, int ZHI, int LOW> FFT_DEV void fft_r8_pass(FFT_PTR buf, int s, int ls  , int tid) {
#pragma unroll 1
    for (int rep = 0; rep < 2; ++rep) {
        const int bf = tid + rep * 512, j = bf & (s - 1), blk = bf >> ls, base = blk * 8 * s + j;
        f32x2 x[8];
#pragma unroll
        for (int m = 0; m < (ZHI ? 4 : 8); ++m) x[m] = buf[PADI(base + m * s)];
        f32x2 w1 = twid((float)j / (float)(8 * s));
        f32x2 w2 = cmul(w1, w1), w4 = cmul(w2, w2);
        if (!INV) {
            if (ZHI) {
                x[4] = cmul(x[0], w1); x[5] = cmul(rot8<1, 0>(x[1]), w1); x[6] = cmul(rot8<2, 0>(x[2]), w1); x[7] = cmul(rot8<3, 0>(x[3]), w1);
            } else {
                { f32x2 a = x[0], b = x[4]; x[0] = a + b; x[4] = cmul(a - b, w1); }
                { f32x2 a = x[1], b = x[5]; x[1] = a + b; x[5] = cmul(rot8<1, 0>(a - b), w1); }
                { f32x2 a = x[2], b = x[6]; x[2] = a + b; x[6] = cmul(rot8<2, 0>(a - b), w1); }
                { f32x2 a = x[3], b = x[7]; x[3] = a + b; x[7] = cmul(rot8<3, 0>(a - b), w1); }
            }
#pragma unroll
            for (int h = 0; h < 8; h += 4) {
                { f32x2 a = x[h], b = x[h + 2]; x[h] = a + b; x[h + 2] = cmul(a - b, w2); }
                { f32x2 a = x[h + 1], b = x[h + 3]; x[h + 1] = a + b; x[h + 3] = cmul(rot8<2, 0>(a - b), w2); }
            }
#pragma unroll
            for (int m = 0; m < 8; m += 2) { f32x2 a = x[m], b = x[m + 1]; x[m] = a + b; x[m + 1] = cmul(a - b, w4); }
        } else {
#pragma unroll
            for (int m = 0; m < 8; m += 2) { f32x2 a = x[m], b = cmulc(x[m + 1], w4); x[m] = a + b; x[m + 1] = a - b; }
#pragma unroll
            for (int h = 0; h < 8; h += 4) {
                { f32x2 a = x[h], b = cmulc(x[h + 2], w2); x[h] = a + b; x[h + 2] = a - b; }
                { f32x2 a = x[h + 1], b = rot8<2, 1>(cmulc(x[h + 3], w2)); x[h + 1] = a + b; x[h + 3] = a - b; }
            }
            { f32x2 a = x[0], b = cmulc(x[4], w1); x[0] = a + b; if (!LOW) x[4] = a - b; }
            { f32x2 a = x[1], b = rot8<1, 1>(cmulc(x[5], w1)); x[1] = a + b; if (!LOW) x[5] = a - b; }
            { f32x2 a = x[2], b = rot8<2, 1>(cmulc(x[6], w1)); x[2] = a + b; if (!LOW) x[6] = a - b; }
            { f32x2 a = x[3], b = rot8<3, 1>(cmulc(x[7], w1)); x[3] = a + b; if (!LOW) x[7] = a - b; }
        }
#pragma unroll
        for (int m = 0; m < (LOW ? 4 : 8); ++m) buf[PADI(base + m * s)] = x[m];
    }
}
FFT_DEV void fft_r2_span1(FFT_PTR buf, int tid) {
#pragma unroll
    for (int rep = 0; rep < 8; ++rep) { const int p = 2 * (tid + rep * 512); f32x2 a = buf[PADI(p)], b = buf[PADI(p + 1)]; buf[PADI(p)] = a + b; buf[PADI(p + 1)] = a - b; }
}
#ifndef FFT_HOST
#define FFT_SYNC() __syncthreads()
template <int ZHI> __device__ __forceinline__ void fft_fwd(FFT_PTR buf, int tid) {
    FFT_SYNC(); fft_r8_pass<0, ZHI, 0>(buf, 1024, 10, tid); FFT_SYNC(); fft_r8_pass<0, 0, 0>(buf, 128, 7, tid); FFT_SYNC(); fft_r8_pass<0, 0, 0>(buf, 16, 4, tid); FFT_SYNC();
    fft_r8_pass<0, 0, 0>(buf, 2, 1, tid); FFT_SYNC(); fft_r2_span1(buf, tid); FFT_SYNC();
}
template <int LOW> __device__ __forceinline__ void fft_inv(FFT_PTR buf, int tid) {
    FFT_SYNC(); fft_r2_span1(buf, tid); FFT_SYNC(); fft_r8_pass<1, 0, 0>(buf, 2, 1, tid); FFT_SYNC(); fft_r8_pass<1, 0, 0>(buf, 16, 4, tid); FFT_SYNC();
    fft_r8_pass<1, 0, 0>(buf, 128, 7, tid); FFT_SYNC(); fft_r8_pass<1, 0, LOW>(buf, 1024, 10, tid); FFT_SYNC();
}
#endif
FFT_DEV unsigned brev13(unsigned p) {
    unsigned r = 0;
#ifndef FFT_HOST
    r = __brev(p) >> 19;
#else
    for (int i = 0; i < 13; ++i) r |= ((p >> i) & 1u) << (12 - i);
#endif
    return r;
}
FFT_DEV void fft_pointwise(FFT_PTR wb, FFT_PTR zk, int which, int tid) {
#pragma unroll 4
    for (int rep = 0; rep < 16; ++rep) {
        const unsigned p = tid + rep * 512, f = brev13(p), fn = (8192u - f) & 8191u, pn = brev13(fn);
        const f32x2 zf = zk[PADI(p)], zn = zk[PADI(pn)];
        f32x2 kf;
        if (which == 0) { kf.x = 0.5f * (zf.x + zn.x); kf.y = 0.5f * (zf.y - zn.y); }
        else            { kf.x = 0.5f * (zf.y + zn.y); kf.y = 0.5f * (zn.x - zf.x); }
        wb[PADI(p)] = cmul(wb[PADI(p)], kf);
    }
}
__device__ __forceinline__ void unpack8(u32x4 w, float (&f)[8]) { f[0] = bflo(w.x); f[1] = bfhi(w.x); f[2] = bflo(w.y); f[3] = bfhi(w.y); f[4] = bflo(w.z); f[5] = bfhi(w.z); f[6] = bflo(w.w); f[7] = bfhi(w.w); }
__device__ __forceinline__ void qk_prepass(const Ctx& C, int G, int wv) {
    int tid = (wv << 6) | lane_id_opaque(); asm volatile("" : "+v"(tid));
    const bf16_t* R1A = (const bf16_t*)(C.ws + WS_R1A); bf16_t* QKP = (bf16_t*)(C.ws + WS_QKP);
    const float* cw = C.in[3]; const float* cb = C.in[4];
    const int cg8 = tid & 255, half = tid >> 8, col = 8 * cg8;
    float k0[8], k1[8], k2[8], kb[8];
    { const int ch = 3072 + col;
      const f32x4 t0 = *(const f32x4*)(cw + ch), t1 = *(const f32x4*)(cw + ch + 4), t2 = *(const f32x4*)(cw + CONVC + ch), t3 = *(const f32x4*)(cw + CONVC + ch + 4);
      const f32x4 t4 = *(const f32x4*)(cw + 2 * CONVC + ch), t5 = *(const f32x4*)(cw + 2 * CONVC + ch + 4), t6 = *(const f32x4*)(cb + ch), t7 = *(const f32x4*)(cb + ch + 4);
#pragma unroll
      for (int e = 0; e < 4; ++e) { k0[e] = t0[e]; k0[4 + e] = t1[e]; k1[e] = t2[e]; k1[4 + e] = t3[e]; k2[e] = t4[e]; k2[4 + e] = t5[e]; kb[e] = t6[e]; kb[4 + e] = t7[e]; } }
    const float osc = col >= 1024 ? 0.0625f : 1.0f;
    for (int run = blockIdx.x; run < TOK / 64; run += G) {
        const int row0 = run * 64 + half * 32;
#pragma unroll 4
        for (int i = 0; i < 32; ++i) {
            const int row = row0 + i, t = row & (SEQ - 1);
            const bf16_t* p = R1A + (size_t)row * 2048 + col;
            const u32x4 z = {0u, 0u, 0u, 0u};
            u32x4 w0 = *(const u32x4*)(t > 0 ? p - 2048 : p), w1 = *(const u32x4*)p, w2 = *(const u32x4*)(t < SEQ - 1 ? p + 2048 : p);
            if (t == 0) w0 = z; if (t == SEQ - 1) w2 = z;
            float a0[8], a1[8], a2[8]; unpack8(w0, a0); unpack8(w1, a1); unpack8(w2, a2);
            float v[8];
#pragma unroll
            for (int e = 0; e < 8; ++e) v[e] = siluf_(k0[e] * a0[e] + k1[e] * a1[e] + k2[e] * a2[e] + kb[e]) * osc;
            u32x4 o; o.x = pk2(v[0], v[1]); o.y = pk2(v[2], v[3]); o.z = pk2(v[4], v[5]); o.w = pk2(v[6], v[7]);
            *(u32x4*)(QKP + (size_t)row * 2048 + col) = o;
        }
    }
}
constexpr int ML_KS = 0, ML_KP = 528, ML_SS = 67584, ML_SP = 272, ML_VS = 102400, ML_VP = 80, ML_VW = 112640, ML_CS = 122880, ML_CP = 528, ML_NS = 139776, ML_SC = 140800;
static_assert(ML_SC + 7 * 512 + 64 <= LDS_BYTES, "mLSTM LDS map");
__device__ __forceinline__ bf16x8 tr_read2(unsigned a0, unsigned a1) {
    bf16x4 lo, hi;
    asm volatile("ds_read_b64_tr_b16 %0, %2\n\tds_read_b64_tr_b16 %1, %3\n\ts_waitcnt lgkmcnt(0)" : "=&v"(lo), "=&v"(hi) : "v"(a0), "v"(a1) : "memory");
    bf16x8 r; r[0] = lo[0]; r[1] = lo[1]; r[2] = lo[2]; r[3] = lo[3]; r[4] = hi[0]; r[5] = hi[1]; r[6] = hi[2]; r[7] = hi[3]; return r;
}
__device__ __forceinline__ float bf2f(short s) { return __uint_as_float(((unsigned)(unsigned short)s) << 16); }
__device__ __forceinline__ float logsigmoidf_(float x) { return fminf(x, 0.f) - log1pf(expf(-fabsf(x))); }

__device__ __forceinline__ void mlstm_item(const Ctx& C, LAS unsigned char* lds, int item, int wv) {
    int tid = (wv << 6) | lane_id_opaque(); asm volatile("" : "+v"(tid));
    const int lane = tid & 63, w = __builtin_amdgcn_readfirstlane(tid >> 6), r = lane & 15, g = lane >> 4, q4 = r >> 2, p4 = r & 3;
    const int vs = item & 7, dir = (item >> 3) & 1, bh = item >> 4, b = bh >> 2, h = bh & 3;
    const bf16_t* QKP = (const bf16_t*)(C.ws + WS_QKP); const bf16_t* R1B = (const bf16_t*)(C.ws + WS_R1B); const float* Gt = (const float*)(C.ws + WS_G);
    bf16_t* Y = (bf16_t*)(C.ws + (dir ? WS_YBB : WS_YBF));
    LAS float* SC = (LAS float*)(lds + ML_SC);
    LAS float* s_cs = SC, *s_rj = SC + 128, *s_iw = SC + 256, *s_emj = SC + 384, *s_w = SC + 512, *s_dn = SC + 640, *s_misc = SC + 768;
    LAS float* NS = (LAS float*)(lds + ML_NS);
    const unsigned lbase = (unsigned)(size_t)lds;
    const int pc = tid & 31, krow = tid >> 5, vrow = tid >> 2, pv = tid & 3;
    for (int i = tid; i < (ML_NS + 1024 - ML_CS) / 4; i += 512) ((LAS unsigned*)(lds + ML_CS))[i] = 0u;
    f32x4 Cacc[3][2];
#pragma unroll
    for (int a = 0; a < 3; ++a) { Cacc[a][0] = (f32x4){0.f, 0.f, 0.f, 0.f}; Cacc[a][1] = (f32x4){0.f, 0.f, 0.f, 0.f}; }
    float m_prev = 0.f;
    u32x4 kreg[8], vreg, qn[8]; float ipn = 0.f, fpn = 0.f;
#define ML_TOK(c_, j_) ((size_t)b * SEQ + (dir ? SEQ - 1 - ((c_) * 128 + (j_)) : ((c_) * 128 + (j_))))
#define ML_PREFETCH(c_) do { \
        _Pragma("unroll") for (int i = 0; i < 8; ++i) kreg[i] = *(const u32x4*)(QKP + ML_TOK(c_, krow + 16 * i) * 2048 + 1024 + h * 256 + 8 * pc); \
        vreg = *(const u32x4*)(R1B + ML_TOK(c_, vrow) * 2048 + h * 256 + vs * 32 + 8 * pv); \
        { const bf16_t* qp = QKP + ML_TOK(c_, 16 * w + r) * 2048 + h * 256 + 8 * g; _Pragma("unroll") for (int kk = 0; kk < 8; ++kk) qn[kk] = *(const u32x4*)(qp + 32 * kk); } \
        if (tid < 128) { const size_t tk = ML_TOK(c_, tid); ipn = Gt[tk * 16 + (dir * 2) * 4 + h]; fpn = Gt[tk * 16 + (dir * 2 + 1) * 4 + h]; } } while (0)
    ML_PREFETCH(0);
    __syncthreads();
#pragma unroll 1
    for (int c = 0; c < 32; ++c) {
        float xs = 0.f, csv = 0.f, pmx = 0.f, bcum = 0.f; const float ip = ipn;
        if (tid < 128) {
            xs = logsigmoidf_(fpn);
#pragma unroll
            for (int o = 1; o < 64; o <<= 1) { const float y = __shfl_up(xs, o); if (lane >= o) xs += y; }
            if (tid == 63) s_misc[0] = xs;
        }
        __syncthreads();
        if (tid < 128) {
            bcum = xs + (w == 1 ? s_misc[0] : 0.f); csv = ip - bcum; pmx = csv;
#pragma unroll
            for (int o = 1; o < 64; o <<= 1) { const float y = __shfl_up(pmx, o); if (lane >= o) pmx = fmaxf(pmx, y); }
            if (tid == 63) s_misc[1] = pmx;
            if (tid == 127) s_misc[2] = bcum;
        }
        __syncthreads();
        if (tid < 128) { if (w == 1) pmx = fmaxf(pmx, s_misc[1]); if (tid == 127) s_misc[3] = pmx; }
        __syncthreads();
        const float b_last = s_misc[2], m_new = fmaxf(b_last + m_prev, b_last + s_misc[3]), keep = __expf(b_last + m_prev - m_new);
        if (tid < 128) {
            const float inter = bcum + m_prev, mj = fmaxf(inter, bcum + pmx);
            s_cs[tid] = csv; s_rj[tid] = bcum - mj; s_iw[tid] = __expf(inter - mj); s_emj[tid] = __expf(-mj); s_w[tid] = __expf(b_last + csv - m_new);
        }
        __syncthreads();
#pragma unroll
        for (int i = 0; i < 8; ++i) *(LAS u32x4*)(lds + ML_KS + (krow + 16 * i) * ML_KP + pc * 16) = kreg[i];
        {
            *(LAS u32x4*)(lds + ML_VS + vrow * ML_VP + pv * 16) = vreg;
            float f[8]; unpack8(vreg, f); const float ws_ = s_w[vrow];
            u32x4 o; o.x = pk2(f[0] * ws_, f[1] * ws_); o.y = pk2(f[2] * ws_, f[3] * ws_); o.z = pk2(f[4] * ws_, f[5] * ws_); o.w = pk2(f[6] * ws_, f[7] * ws_);
            *(LAS u32x4*)(lds + ML_VW + vrow * ML_VP + pv * 16) = o;
        }
        bf16x8 qf[8];
#pragma unroll
        for (int kk = 0; kk < 8; ++kk) qf[kk] = __builtin_bit_cast(bf16x8, qn[kk]);
        unsigned short ogr[4][2];
#pragma unroll
        for (int i = 0; i < 4; ++i)
#pragma unroll
            for (int vt = 0; vt < 2; ++vt) ogr[i][vt] = R1B[ML_TOK(c, 16 * w + 4 * g + i) * 2048 + 1024 + h * 256 + vs * 32 + 16 * vt + r];
        if (c < 31) ML_PREFETCH(c + 1);
        __syncthreads();
        {
            const float rjv = s_rj[16 * w + r]; const int jloc = 16 * w + r; float den1 = 0.f;
#pragma unroll 1
            for (int st = 0; st < 8; ++st) {
                if (st <= w) {
                    f32x4 acc = {0.f, 0.f, 0.f, 0.f};
#pragma unroll
                    for (int kk = 0; kk < 8; ++kk) { const bf16x8 kf = *(const LAS bf16x8*)(lds + ML_KS + (16 * st + r) * ML_KP + (32 * kk + 8 * g) * 2); acc = __builtin_amdgcn_mfma_f32_16x16x32_bf16(kf, qf[kk], acc, 0, 0, 0); }
                    const f32x4 c4 = *(const LAS f32x4*)(s_cs + 16 * st + 4 * g);
                    float v[4];
#pragma unroll
                    for (int i = 0; i < 4; ++i) { const int s = 16 * st + 4 * g + i; const float d = (s <= jloc) ? __expf(rjv + c4[i]) : 0.f; v[i] = acc[i] * d; den1 += v[i]; }
                    u32x2 o; o.x = pk2(v[0], v[1]); o.y = pk2(v[2], v[3]);
                    *(LAS u32x2*)(lds + ML_SS + jloc * ML_SP + (16 * st + 4 * g) * 2) = o;
                } else if (st == w + 1 && !(w & 1)) {
                    u32x2 o = {0u, 0u}; *(LAS u32x2*)(lds + ML_SS + jloc * ML_SP + (16 * st + 4 * g) * 2) = o;
                }
            }
            den1 += __shfl_xor(den1, 16); den1 += __shfl_xor(den1, 32);
            float d2 = 0.f;
#pragma unroll
            for (int kk = 0; kk < 8; ++kk) { const f32x4 n0 = *(const LAS f32x4*)(NS + 32 * kk + 8 * g), n1 = *(const LAS f32x4*)(NS + 32 * kk + 8 * g + 4);
#pragma unroll
                for (int e = 0; e < 4; ++e) { d2 += bf2f(qf[kk][e]) * n0[e]; d2 += bf2f(qf[kk][4 + e]) * n1[e]; } }
            d2 += __shfl_xor(d2, 16); d2 += __shfl_xor(d2, 32);
            if (g == 0) s_dn[jloc] = den1 + s_iw[jloc] * d2;
        }
        __syncthreads();
        {
            f32x4 n1[2], n2[2];
#pragma unroll
            for (int vt = 0; vt < 2; ++vt) { n1[vt] = (f32x4){0.f, 0.f, 0.f, 0.f}; n2[vt] = (f32x4){0.f, 0.f, 0.f, 0.f}; }
            const int nks = (w >> 1) + 1;
#pragma unroll 1
            for (int ks = 0; ks < nks; ++ks) {
                const bf16x8 af = *(const LAS bf16x8*)(lds + ML_SS + (16 * w + r) * ML_SP + (32 * ks + 8 * g) * 2);
#pragma unroll
                for (int vt = 0; vt < 2; ++vt) { const unsigned a0 = lbase + ML_VS + (32 * ks + 8 * g + q4) * ML_VP + (16 * vt + 4 * p4) * 2;
                    const bf16x8 bfr = tr_read2(a0, a0 + 4 * ML_VP); n1[vt] = __builtin_amdgcn_mfma_f32_16x16x32_bf16(af, bfr, n1[vt], 0, 0, 0); }
            }
#pragma unroll
            for (int kk = 0; kk < 8; ++kk)
#pragma unroll
                for (int vt = 0; vt < 2; ++vt) { const bf16x8 cf = *(const LAS bf16x8*)(lds + ML_CS + (16 * vt + r) * ML_CP + (32 * kk + 8 * g) * 2); n2[vt] = __builtin_amdgcn_mfma_f32_16x16x32_bf16(qf[kk], cf, n2[vt], 0, 0, 0); }
            const f32x4 iw4 = *(const LAS f32x4*)(s_iw + 16 * w + 4 * g), dn4 = *(const LAS f32x4*)(s_dn + 16 * w + 4 * g), em4 = *(const LAS f32x4*)(s_emj + 16 * w + 4 * g);
#pragma unroll
            for (int i = 0; i < 4; ++i) {
                const size_t tok = ML_TOK(c, 16 * w + 4 * g + i);
                const float inv = 1.0f / fmaxf(fabsf(dn4[i]), em4[i]);
#pragma unroll
                for (int vt = 0; vt < 2; ++vt) { const int col = h * 256 + vs * 32 + 16 * vt + r;
                    const float og = __uint_as_float(((unsigned)ogr[i][vt]) << 16);
                    const float hv = (n1[vt][i] + iw4[i] * n2[vt][i]) * inv * og;
                    Y[tok * 1024 + col] = (bf16_t)f2bf(hv); }
            }
        }
        __syncthreads();
        {
#pragma unroll
            for (int a = 0; a < 3; ++a) { Cacc[a][0] *= keep; Cacc[a][1] *= keep; }
#pragma unroll 1
            for (int ks = 0; ks < 4; ++ks) {
                bf16x8 af[3];
#pragma unroll
                for (int mt = 0; mt < 2; ++mt) { const unsigned a0 = lbase + ML_VW + (32 * ks + 8 * g + q4) * ML_VP + (16 * mt + 4 * p4) * 2; af[mt] = tr_read2(a0, a0 + 4 * ML_VP); }
                { const f32x4 wa = *(const LAS f32x4*)(s_w + 32 * ks + 8 * g), wb = *(const LAS f32x4*)(s_w + 32 * ks + 8 * g + 4);
                  u32x4 o; o.x = pk2(wa[0], wa[1]); o.y = pk2(wa[2], wa[3]); o.z = pk2(wb[0], wb[1]); o.w = pk2(wb[2], wb[3]);
                  if (r != 0) { o.x = 0u; o.y = 0u; o.z = 0u; o.w = 0u; }
                  af[2] = __builtin_bit_cast(bf16x8, o); }
#pragma unroll
                for (int nt = 0; nt < 2; ++nt) { const unsigned a0 = lbase + ML_KS + (32 * ks + 8 * g + q4) * ML_KP + (32 * w + 16 * nt + 4 * p4) * 2;
                    const bf16x8 bfr = tr_read2(a0, a0 + 4 * ML_KP);
#pragma unroll
                    for (int mt = 0; mt < 3; ++mt) Cacc[mt][nt] = __builtin_amdgcn_mfma_f32_16x16x32_bf16(af[mt], bfr, Cacc[mt][nt], 0, 0, 0); }
            }
#pragma unroll
            for (int mt = 0; mt < 2; ++mt)
#pragma unroll
                for (int nt = 0; nt < 2; ++nt)
#pragma unroll
                    for (int i = 0; i < 4; ++i) *(LAS bf16_t*)(lds + ML_CS + (16 * mt + 4 * g + i) * ML_CP + (32 * w + 16 * nt + r) * 2) = (bf16_t)f2bf(Cacc[mt][nt][i]);
            if (g == 0) { NS[32 * w + r] = Cacc[2][0][0]; NS[32 * w + 16 + r] = Cacc[2][1][0]; }
        }
        m_prev = m_new;
        __syncthreads();
    }
#undef ML_PREFETCH
#undef ML_TOK
}
constexpr int HY_ZK = 0, HY_WB = 69632;
static_assert(HY_WB + 69632 <= LDS_BYTES, "hyena LDS map");
#define GAS __attribute__((address_space(1)))
__device__ __forceinline__ float hy_conv(const GAS bf16_t* p  , int off, int t, float w0, float w1, float w2, float bias) {
    const unsigned r1 = p[off], r0 = p[off - 1], r2 = p[off + 1];
    const float a1 = __uint_as_float(r1 << 16);
    const float a0 = t > 0 ? __uint_as_float(r0 << 16) : 0.f;
    const float a2 = t < SEQ - 1 ? __uint_as_float(r2 << 16) : 0.f;
    return w0 * a0 + w1 * a1 + w2 * a2 + bias;
}
__device__ __forceinline__ void hyena_item(const Ctx& C, LAS unsigned char* lds, int ch, int wv) {
    int tid = (wv << 6) | lane_id_opaque(); asm volatile("" : "+v"(tid));
    LAS f32x2* zk = (LAS f32x2*)(lds + HY_ZK); LAS f32x2* wb = (LAS f32x2*)(lds + HY_WB);
    const float* FILT = (const float*)(C.ws + WS_FILT); const bf16_t* HYb = (const bf16_t*)(C.ws + WS_HY); bf16_t* YA = (bf16_t*)(C.ws + WS_YA);
    const float* cw = C.in[3]; const float* cb = C.in[4];
    float w0[3], w1[3], w2[3], bs[3];
#pragma unroll
    for (int s = 0; s < 3; ++s) { w0[s] = cw[s * 1024 + ch]; w1[s] = cw[CONVC + s * 1024 + ch]; w2[s] = cw[2 * CONVC + s * 1024 + ch]; bs[s] = cb[s * 1024 + ch]; }
    const float hb0 = C.in[12][ch], hb1 = C.in[12][1024 + ch];
    const float* F0 = FILT + (size_t)(0 * 1024 + ch) * SEQ; const float* F1 = FILT + (size_t)(1 * 1024 + ch) * SEQ;
    const float* F2 = FILT + (size_t)(2 * 1024 + ch) * SEQ; const float* F3 = FILT + (size_t)(3 * 1024 + ch) * SEQ;
    __syncthreads();
    {
        float fa[16], fb[16];
#pragma unroll
        for (int rep = 0; rep < 8; ++rep) { const int i = tid + 512 * rep; fa[rep] = F0[i]; fb[rep] = F2[i]; }
#pragma unroll
        for (int rep = 8; rep < 16; ++rep) { const int i = tid + 512 * rep; const int j = i == SEQ ? 1 : 2 * SEQ - i; fa[rep] = F1[j]; fb[rep] = F3[j]; }
        if (tid == 0) { fa[8] = 0.f; fb[8] = 0.f; }
#pragma unroll
        for (int rep = 0; rep < 16; ++rep) { const int i = tid + 512 * rep; zk[PADI(i)] = (f32x2){fa[rep] * (1.0f / 8192.0f), fb[rep] * (1.0f / 8192.0f)}; }
    }
    fft_fwd<0>(zk, tid);
#pragma unroll 1
    for (int p = 0; p < 2; ++p) {
        const int tb0 = (2 * p) * SEQ, tb1 = (2 * p + 1) * SEQ;
        f32x2 vv[8], zz[8];
        const bf16_t* pv0_ = HYb + (size_t)ch * TOK + tb0 + tid; asm volatile("" : "+v"(pv0_)); const GAS bf16_t* pv0 = (const GAS bf16_t*)pv0_; const GAS bf16_t* pv1 = pv0 + SEQ;
#pragma unroll
        for (int m = 0; m < 8; ++m) { const int t = tid + 512 * m;
            vv[m].x = hy_conv(pv0, 512 * m, t, w0[0], w1[0], w2[0], bs[0]); vv[m].y = hy_conv(pv1, 512 * m, t, w0[0], w1[0], w2[0], bs[0]);
            wb[PADI(t)] = vv[m]; }
        fft_fwd<1>(wb, tid); fft_pointwise(wb, zk, 0, tid); fft_inv<1>(wb, tid);
        const bf16_t* px0_ = HYb + (size_t)(1024 + ch) * TOK + tb0 + tid; asm volatile("" : "+v"(px0_)); const GAS bf16_t* px0 = (const GAS bf16_t*)px0_; const GAS bf16_t* px1 = px0 + SEQ;
#pragma unroll
        for (int m = 0; m < 8; ++m) { const int t = tid + 512 * m; const f32x2 y = wb[PADI(t)];
            const float xa = hy_conv(px0, 512 * m, t, w0[1], w1[1], w2[1], bs[1]), xb_ = hy_conv(px1, 512 * m, t, w0[1], w1[1], w2[1], bs[1]);
            zz[m].x = xa * (y.x + vv[m].x * hb0); zz[m].y = xb_ * (y.y + vv[m].y * hb0); }
#pragma unroll
        for (int m = 0; m < 8; ++m) { const int t = tid + 512 * m; wb[PADI(t)] = zz[m]; }
        fft_fwd<1>(wb, tid); fft_pointwise(wb, zk, 1, tid); fft_inv<1>(wb, tid);
        const bf16_t* py0_ = HYb + (size_t)(2048 + ch) * TOK + tb0 + tid; asm volatile("" : "+v"(py0_)); const GAS bf16_t* py0 = (const GAS bf16_t*)py0_; const GAS bf16_t* py1 = py0 + SEQ;
#pragma unroll
        for (int m = 0; m < 8; ++m) { const int t = tid + 512 * m; const f32x2 y = wb[PADI(t)];
            const float xa = hy_conv(py0, 512 * m, t, w0[2], w1[2], w2[2], bs[2]), xb_ = hy_conv(py1, 512 * m, t, w0[2], w1[2], w2[2], bs[2]);
            YA[(size_t)(tb0 + t) * 1024 + ch] = (bf16_t)f2bf(xa * (y.x + zz[m].x * hb1));
            YA[(size_t)(tb1 + t) * 1024 + ch] = (bf16_t)f2bf(xb_ * (y.y + zz[m].y * hb1)); }
        __syncthreads();
    }
}
#ifndef DUP_P0
#define DUP_P0 0
#endif
#ifndef DUP_ML
#define DUP_ML 0
#endif
#ifndef DUP_HY
#define DUP_HY 0
#endif
#ifndef DUP_REST
#define DUP_REST 0
#endif
#ifndef DUP_GU
#define DUP_GU 0
#endif
__device__ __forceinline__ void grid_bar(unsigned* cnt, unsigned target, int wv) {
    asm volatile("s_waitcnt vmcnt(0)" ::: "memory");
    __syncthreads();
    const int lane = lane_id_opaque();
    if (wv == 0 && lane == 0) {
        __builtin_amdgcn_fence(__ATOMIC_RELEASE, "agent");
        asm volatile("s_waitcnt vmcnt(0)" ::: "memory");
        __hip_atomic_fetch_add(cnt, 1u, __ATOMIC_RELAXED, __HIP_MEMORY_SCOPE_AGENT);
        while (__hip_atomic_load(cnt, __ATOMIC_RELAXED, __HIP_MEMORY_SCOPE_AGENT) < target) __builtin_amdgcn_s_sleep(2);
        __builtin_amdgcn_fence(__ATOMIC_ACQUIRE, "agent");
        asm volatile("s_waitcnt vmcnt(0)" ::: "memory");
    }
    __syncthreads();
}
struct Params { const float* in[21]; float* out; unsigned char* ws; };
__global__ void __launch_bounds__(512, 2) fwd_megakernel(Params prm) {
    extern __shared__ __attribute__((aligned(16))) unsigned char lds_raw[];
    LAS unsigned char* lds = (LAS unsigned char*)lds_raw;
    cg::grid_group grid = cg::this_grid();
    const int G = gridDim.x, bx = blockIdx.x;
    const int wv = __builtin_amdgcn_readfirstlane((int)(threadIdx.x >> 6));
    Ctx C;
#pragma unroll
    for (int i = 0; i < 21; ++i) C.in[i] = prm.in[i];
    C.out = prm.out; C.ws = prm.ws;
    unsigned char* ws = prm.ws;
    unsigned* gbar = (unsigned*)(ws + WS_BAR); unsigned bar_k = 0u;
#define GBAR() grid_bar(gbar, (++bar_k) * (unsigned)G, wv)
    if (bx == 0 && threadIdx.x == 0) *gbar = 0u;
    for (int rep = 0; rep < 1 + DUP_P0; ++rep) { p0_prologue(C, lds, G, wv); __syncthreads(); }
    grid.sync();
    p1_filters(C, lds, G, wv);
    { HyProg P; P.K = DM; P.G = G; P.c = bx; P.W = (const bf16_t*)(ws + WS_WIN); P.X = (const bf16_t*)(ws + WS_XB); P.HY = (bf16_t*)(ws + WS_HY); P.r1 = (const float*)(ws + WS_R1S);
      pg8::gemm_stream(lds, P, wv); }
    for (int rep = 0; rep < 1 + DUP_REST; ++rep) { RestProg P; P.K = DM; P.G = G; P.c = bx; P.W = (const bf16_t*)(ws + WS_WIN); P.X = (const bf16_t*)(ws + WS_XB); P.R1A = (bf16_t*)(ws + WS_R1A); P.R1B = (bf16_t*)(ws + WS_R1B); P.R2 = (bf16_t*)prm.out; P.r1 = (const float*)(ws + WS_R1S);
      pg8::gemm_stream(lds, P, wv); }
    GBAR();
    qk_prepass(C, G, wv);
    for (int rep = 0; rep < 1 + DUP_HY; ++rep) for (int idx = bx; idx < 1024; idx += G) { const int rd = idx >> 8, bb = idx & 255; hyena_item(C, lds, rd * 256 + (bb & 7) * 32 + (bb >> 3), wv); }
    GBAR();
    for (int rep = 0; rep < 1 + DUP_ML; ++rep) for (int item = bx; item < 256; item += G) mlstm_item(C, lds, item, wv);
    GBAR();
    { BranchProg P; P.K = 1024; P.G = G; P.c = bx; P.YA = (const bf16_t*)(ws + WS_YA); P.YBF = (const bf16_t*)(ws + WS_YBF); P.YBB = (const bf16_t*)(ws + WS_YBB);
      P.WA = (const bf16_t*)(ws + WS_WA); P.WB = (const bf16_t*)(ws + WS_WB); P.R2 = (const bf16_t*)prm.out; P.MIX = (bf16_t*)(ws + WS_MIX);
      pg8::gemm_stream(lds, P, wv); }
    GBAR();
    { ResProg P; P.K = DM; P.G = G; P.c = bx; P.A = (const bf16_t*)(ws + WS_MIX); P.B = (const bf16_t*)(ws + WS_WOUT); P.base = prm.in[0]; P.out = prm.out; P.outb = (bf16_t*)(ws + WS_X1B); P.ss = (float*)(ws + WS_SS2);
      pg8::gemm_stream(lds, P, wv); }
    GBAR();
    for (int rep = 0; rep < 1 + DUP_GU; ++rep) { GuProg P; P.K = DM; P.G = G; P.c = bx; P.X = (const bf16_t*)(ws + WS_X1B); P.W = (const bf16_t*)(ws + WS_WGU); P.HH = (bf16_t*)(ws + WS_HH); P.ss2 = (const float*)(ws + WS_SS2);
      pg8::gemm_stream(lds, P, wv); }
    GBAR();
    { ResProg P; P.K = FFH; P.G = G; P.c = bx; P.A = (const bf16_t*)(ws + WS_HH); P.B = (const bf16_t*)(ws + WS_WD); P.base = prm.out; P.out = prm.out; P.outb = nullptr; P.ss = (float*)(ws + WS_SS3);
      pg8::gemm_stream(lds, P, wv); }
    GBAR();
    p7_final(C, G, wv);
}

extern "C" void kernel_launch(void* const* d_in, const int* in_sizes, int n_in, void* d_out, int out_size, void* d_ws, size_t ws_size, hipStream_t stream) {
    static int grid = 0;
    if (grid == 0) {
        int dev = 0, cus = 0, per_cu = 0;
        hipGetDevice(&dev); hipDeviceGetAttribute(&cus, hipDeviceAttributeMultiprocessorCount, dev);
        if (hipFuncSetAttribute((const void*)fwd_megakernel, hipFuncAttributeMaxDynamicSharedMemorySize, LDS_BYTES) != hipSuccess) { fprintf(stderr, "kernel_launch: hipFuncSetAttribute failed\n"); grid = -1; return; }
        if (hipOccupancyMaxActiveBlocksPerMultiprocessor(&per_cu, (const void*)fwd_megakernel, 512, LDS_BYTES) != hipSuccess || per_cu < 1) { fprintf(stderr, "kernel_launch: occupancy query gave %d\n", per_cu); per_cu = 1; }
        (void)hipGetLastError();
        grid = cus * 1;
        if (n_in != 21 || ws_size < WS_END) { fprintf(stderr, "kernel_launch: unexpected n_in %d or ws %zu\n", n_in, ws_size); grid = -1; return; }
    }
    if (grid < 0) return;
    Params p{};
    for (int i = 0; i < 21; ++i) p.in[i] = (const float*)d_in[i];
    p.out = (float*)d_out; p.ws = (unsigned char*)d_ws;
    void* args[] = {&p};
    hipError_t e = hipLaunchCooperativeKernel((const void*)fwd_megakernel, dim3(grid), dim3(512), args, LDS_BYTES, stream);
    if (e != hipSuccess) fprintf(stderr, "cooperative launch failed: %s (grid %d)\n", hipGetErrorString(e), grid);
}
```

```cpp
#include <hip/hip_runtime.h>
#include <hip/hip_cooperative_groups.h>
#include <cstdio>
namespace cg = cooperative_groups;

#define LAS __attribute__((address_space(3)))
typedef unsigned short bf16_t;
typedef short bf16x8 __attribute__((ext_vector_type(8)));
typedef short bf16x4 __attribute__((ext_vector_type(4)));
typedef float f32x4 __attribute__((ext_vector_type(4)));
typedef float f32x2 __attribute__((ext_vector_type(2)));
typedef unsigned u32x4 __attribute__((ext_vector_type(4)));
typedef unsigned u32x2 __attribute__((ext_vector_type(2)));

constexpr int NB = 4, SEQ = 4096, TOK = NB * SEQ, DM = 2048, HW = 1024, MW = 1024, NHEAD = 4, DH = 256, FFH = 5632;
constexpr int CONVC = 5120, INCOLS = 11280, NFILT = 4096;
constexpr float RMS_EPS = 1e-6f;
constexpr size_t MiB = 1u << 20;
constexpr size_t WS_BAR = 262144, WS_R1S = 0, WS_SS2 = 65536, WS_SS3 = 131072, WS_G = 1 * MiB, WS_H2 = 2 * MiB;
constexpr size_t WS_WA = 4 * MiB, WS_WB = 8 * MiB, WS_WOUT = 12 * MiB, WS_WGU = 20 * MiB, WS_WD = 64 * MiB, WS_WIN = 86 * MiB, WS_XB = 130 * MiB;
constexpr size_t WS_FILT = 194 * MiB, WS_HY = 258 * MiB, WS_R1A = 354 * MiB, WS_R1B = 418 * MiB, WS_END = 482 * MiB;
constexpr size_t WS_QKP = 86 * MiB, WS_YA = 150 * MiB, WS_YBF = 354 * MiB, WS_YBB = 386 * MiB, WS_X1B = 86 * MiB, WS_MIX = 194 * MiB, WS_HH = 258 * MiB;
constexpr int LDS_BYTES = 147456;

__device__ __forceinline__ unsigned f2bf(float f) { unsigned u = __float_as_uint(f); return (u + 0x7fffu + ((u >> 16) & 1u)) >> 16; }
__device__ __forceinline__ unsigned pk2(float lo, float hi) { unsigned r; asm volatile("v_cvt_pk_bf16_f32 %0, %1, %2" : "=v"(r) : "v"(lo), "v"(hi)); return r; }
__device__ __forceinline__ float bflo(unsigned w) { return __uint_as_float(w << 16); }
__device__ __forceinline__ float bfhi(unsigned w) { return __uint_as_float(w & 0xffff0000u); }
__device__ __forceinline__ float wave_sum(float v) {
#pragma unroll
    for (int o = 1; o < 64; o <<= 1) v += __shfl_xor(v, o);
    return v;
}
__device__ __forceinline__ size_t blk_off(int row, int k, int K) { return ((size_t)(row >> 7) * (size_t)(K >> 6) + (size_t)(k >> 6)) * 8192 + (size_t)((row & 127) * 64 + (k & 63)); }
__device__ __forceinline__ int lane_id_opaque() { int l; asm volatile("v_mbcnt_lo_u32_b32 %0, -1, 0\n\tv_mbcnt_hi_u32_b32 %0, -1, %0" : "=v"(l)); return l; }
__device__ __forceinline__ float sigmoidf_(float x) { return 1.0f / (1.0f + __expf(-x)); }
__device__ __forceinline__ float siluf_(float x) { return x / (1.0f + __expf(-x)); }

namespace pg8 {
constexpr int BM = 256, BK = 64, HALF = 128, HTB = HALF * BK * 2, STAGE_BYTES = 8 * HTB, NXCD = 8, WGM = 8;
__device__ __forceinline__ int lds_byte(int r, int c) { const int st = (r >> 4) * 2 + (c >> 5), rr = r & 15, cc = c & 31, ob = rr * 64 + cc * 2; return st * 1024 + (ob ^ (((ob >> 9) & 1) << 5)); }
__device__ __forceinline__ void stage_rc(int b, int& R, int& C) { const int st = b / 1024, sb = b % 1024, swz = sb ^ (((sb >> 9) & 1) << 5); R = (st >> 1) * 16 + swz / 64; C = (st & 1) * 32 + (swz % 64) / 2; }
__device__ __forceinline__ int perm32(int rho) { const int n = rho >> 4, i = rho & 15; return 8 * (i >> 2) + 4 * n + (i & 3); }
struct GUnit { const char* A; const char* B; int pm, pn, sub; };
__device__ __forceinline__ void tile_of(int L, int nM, int nN, int& pm, int& pn) {
    const int nwg = nM * nN; int wgid = L; { const int q = nwg / NXCD, r = nwg % NXCD, xcd = wgid % NXCD, off = wgid / NXCD; wgid = (xcd < r ? xcd * (q + 1) : r * (q + 1) + (xcd - r) * q) + off; }
    const int nig = WGM * nN, gid = wgid / nig, fm = gid * WGM, gsz = (nM - fm) < WGM ? (nM - fm) : WGM;
    pm = fm + ((wgid % nig) % gsz); pn = (wgid % nig) / gsz;
}
typedef f32x4 Acc[2][2][4][2];
template <class Prog>
__device__ __forceinline__ void gemm_stream(LAS unsigned char* lds, const Prog& P, int wv) {
    int tid = (wv << 6) | lane_id_opaque(); asm volatile("" : "+v"(tid));
    const int wid = __builtin_amdgcn_readfirstlane(tid >> 6), lane = tid & 63, wr = wid >> 2, wc = wid & 3, fr = lane & 15, fq = lane >> 4;
    const int K = P.K, nt = K / BK;
    unsigned voffA[2], voffB[2];
#pragma unroll
    for (int i = 0; i < 2; ++i) { int R, C; stage_rc(tid * 16 + i * 8192, R, C); const int Rb = Prog::PERM ? ((R & ~31) + perm32(R & 31)) : R;
        voffA[i] = (unsigned)(R * 64 + C) * 2u; voffB[i] = (unsigned)(Rb * 64 + C) * 2u; }
    const size_t kstep = (size_t)(HALF * BK * 2);
    const size_t hstep = (size_t)HALF * K * 2;
    const unsigned ldsw = (unsigned)wid * 1024u;
    const int aoff = lds_byte(wr * 64 + fr, fq * 8), boff = lds_byte(wc * 32 + fr, fq * 8);
#define PG8_SA(b, h) (((b) * 2 + (h)) * HTB)
#define PG8_SB(b, h) ((4 + (b) * 2 + (h)) * HTB)
#define PG8_STAGE(bufoff, gbase, voff) do { _Pragma("unroll") for (int _i = 0; _i < 2; ++_i) \
        __builtin_amdgcn_global_load_lds((const unsigned*)((const char*)(gbase) + (voff)[_i]), (LAS unsigned*)(lds + (bufoff) + ldsw + _i * 8192), 16, 0, 0); } while (0)
#define PG8_LDA(dst, b, h) do { _Pragma("unroll") for (int m = 0; m < 4; ++m) _Pragma("unroll") for (int k = 0; k < 2; ++k) dst[m][k] = *(const LAS bf16x8*)(lds + PG8_SA(b, h) + aoff + m * 2048 + k * 1024); } while (0)
#define PG8_LDB(dst, b, h) do { _Pragma("unroll") for (int n = 0; n < 2; ++n) _Pragma("unroll") for (int k = 0; k < 2; ++k) dst[n][k] = *(const LAS bf16x8*)(lds + PG8_SB(b, h) + boff + n * 2048 + k * 1024); } while (0)
#define PG8_MMA(ai, bj, At, Bt) do { __builtin_amdgcn_s_setprio(1); _Pragma("unroll") for (int m = 0; m < 4; ++m) _Pragma("unroll") for (int n = 0; n < 2; ++n) _Pragma("unroll") for (int k = 0; k < 2; ++k) \
        acc[ai][bj][m][n] = __builtin_amdgcn_mfma_f32_16x16x32_bf16(Bt[n][k], At[m][k], acc[ai][bj][m][n], 0, 0, 0); __builtin_amdgcn_s_setprio(0); } while (0)
#define PG8_WAIT_V(n) asm volatile("s_waitcnt vmcnt(" #n ")" ::: "memory")
#define PG8_WAIT_L(n) asm volatile("s_waitcnt lgkmcnt(" #n ")" ::: "memory")
#define PG8_BAR __builtin_amdgcn_s_barrier()
#define PG8_SCHED __builtin_amdgcn_sched_barrier(0)
    GUnit cur, nxt; int ui = 0;
    if (!P.next(0, cur)) return;
    f32x4 acc[2][2][4][2];
#pragma unroll
    for (int a = 0; a < 2; ++a)
#pragma unroll
        for (int b = 0; b < 2; ++b)
#pragma unroll
            for (int m = 0; m < 4; ++m)
#pragma unroll
                for (int n = 0; n < 2; ++n) acc[a][b][m][n] = (f32x4){0.f, 0.f, 0.f, 0.f};
    bf16x8 At[4][2], B0[2][2], B1[2][2];
    const char* cA = cur.A; const char* cB = cur.B;
    PG8_STAGE(PG8_SB(0, 0), cB, voffB); PG8_STAGE(PG8_SA(0, 0), cA, voffA); PG8_STAGE(PG8_SB(0, 1), cB + hstep, voffB); PG8_STAGE(PG8_SA(0, 1), cA + hstep, voffA);
    if (wr == 1) PG8_BAR;
    PG8_WAIT_V(4); PG8_BAR;
    PG8_STAGE(PG8_SB(1, 0), cB + kstep, voffB); PG8_STAGE(PG8_SA(1, 0), cA + kstep, voffA); PG8_STAGE(PG8_SB(1, 1), cB + hstep + kstep, voffB);
    PG8_WAIT_V(6); PG8_BAR;
    for (;;) {
        const bool has_next = P.next(ui + 1, nxt);
        const char* nA = has_next ? nxt.A : cA; const char* nB = has_next ? nxt.B : cB;
        for (int t = 0; t < nt; t += 2) {
            const bool last = (t == nt - 2);
            const char* a1 = cA + (size_t)(t + 1) * kstep;
            const char* a2 = last ? nA : cA + (size_t)(t + 2) * kstep; const char* b2 = last ? nB : cB + (size_t)(t + 2) * kstep;
            const char* a3 = a2 + kstep; const char* b3 = b2 + kstep;
            PG8_LDB(B0, 0, 0); PG8_SCHED; PG8_LDA(At, 0, 0); PG8_STAGE(PG8_SA(1, 1), a1 + hstep, voffA);
            PG8_WAIT_L(8); PG8_BAR; PG8_WAIT_L(0); PG8_MMA(0, 0, At, B0); PG8_BAR; PG8_SCHED;
            PG8_LDB(B1, 0, 1); PG8_STAGE(PG8_SB(0, 0), b2, voffB);
            PG8_BAR; PG8_WAIT_L(0); PG8_MMA(0, 1, At, B1); PG8_BAR;
            PG8_LDA(At, 0, 1); PG8_STAGE(PG8_SA(0, 0), a2, voffA);
            PG8_BAR; PG8_WAIT_L(0); PG8_MMA(1, 0, At, B0); PG8_BAR; PG8_SCHED;
            PG8_STAGE(PG8_SB(0, 1), b2 + hstep, voffB);
            PG8_WAIT_V(6); PG8_BAR; PG8_MMA(1, 1, At, B1); PG8_BAR;
            PG8_LDB(B0, 1, 0); PG8_SCHED; PG8_LDA(At, 1, 0); PG8_STAGE(PG8_SA(0, 1), a2 + hstep, voffA);
            PG8_WAIT_L(8); PG8_BAR; PG8_WAIT_L(0); PG8_MMA(0, 0, At, B0); PG8_BAR; PG8_SCHED;
            PG8_LDB(B1, 1, 1); PG8_STAGE(PG8_SB(1, 0), b3, voffB);
            PG8_BAR; PG8_WAIT_L(0); PG8_MMA(0, 1, At, B1); PG8_BAR;
            PG8_LDA(At, 1, 1); PG8_STAGE(PG8_SA(1, 0), a3, voffA);
            PG8_BAR; PG8_WAIT_L(0); PG8_MMA(1, 0, At, B0); PG8_BAR; PG8_SCHED;
            PG8_STAGE(PG8_SB(1, 1), b3 + hstep, voffB);
            PG8_WAIT_V(6); PG8_BAR; PG8_MMA(1, 1, At, B1); PG8_BAR;
        }
        P.epi(acc, cur, wr, wc, fr, fq);
        if (!has_next) break;
        cur = nxt; cA = nA; cB = nB; ++ui;
    }
    PG8_WAIT_V(0);
    if (wr == 0) PG8_BAR;
    PG8_BAR;
#undef PG8_SA
#undef PG8_SB
#undef PG8_STAGE
#undef PG8_LDA
#undef PG8_LDB
#undef PG8_MMA
#undef PG8_WAIT_V
#undef PG8_WAIT_L
#undef PG8_BAR
#undef PG8_SCHED
}
__device__ __forceinline__ void zero_acc(Acc& acc) {
#pragma unroll
    for (int a = 0; a < 2; ++a)
#pragma unroll
        for (int b = 0; b < 2; ++b)
#pragma unroll
            for (int m = 0; m < 4; ++m)
#pragma unroll
                for (int n = 0; n < 2; ++n) acc[a][b][m][n] = (f32x4){0.f, 0.f, 0.f, 0.f};
}
}
using pg8::GUnit; using pg8::Acc;
struct HyProg {
    static constexpr bool PERM = true; int K, G, c; const bf16_t* W; const bf16_t* X; bf16_t* HY; const float* r1;
    __device__ __forceinline__ bool next(int i, GUnit& u) const { const int L = i * G + c; if (L >= 12 * 64) return false; pg8::tile_of(L, 12, 64, u.pm, u.pn);
        u.A = (const char*)(W + (size_t)u.pm * 256 * DM); u.B = (const char*)(X + (size_t)u.pn * 256 * DM); u.sub = 0; return true; }
    __device__ __forceinline__ void epi(Acc& acc, const GUnit& u, int wr, int wc, int fr, int fq) const {
        const int row0 = u.pm * 256 + wr * 64 + fr, col0 = u.pn * 256 + wc * 32 + 8 * fq;
        f32x4 sc[2][2];
#pragma unroll
        for (int bj = 0; bj < 2; ++bj) { sc[bj][0] = *(const f32x4*)(r1 + col0 + bj * 128); sc[bj][1] = *(const f32x4*)(r1 + col0 + bj * 128 + 4); }
#pragma unroll
        for (int ai = 0; ai < 2; ++ai)
#pragma unroll
            for (int m = 0; m < 4; ++m) { bf16_t* rowp = HY + (size_t)(row0 + ai * 128 + m * 16) * TOK + col0;
#pragma unroll
                for (int bj = 0; bj < 2; ++bj) { const f32x4 v0 = acc[ai][bj][m][0] * sc[bj][0], v1 = acc[ai][bj][m][1] * sc[bj][1];
                    u32x4 w; w.x = pk2(v0[0], v0[1]); w.y = pk2(v0[2], v0[3]); w.z = pk2(v1[0], v1[1]); w.w = pk2(v1[2], v1[3]);
                    *(u32x4*)(rowp + bj * 128) = w; } }
        pg8::zero_acc(acc);
    }
};
struct RestProg {
    static constexpr bool PERM = true; int K, G, c; const bf16_t* W; const bf16_t* X; bf16_t* R1A; bf16_t* R1B; bf16_t* R2; const float* r1;
    __device__ __forceinline__ bool next(int i, GUnit& u) const { const int L = i * G + c; if (L >= 64 * 32) return false; pg8::tile_of(L, 64, 32, u.pm, u.pn);
        u.A = (const char*)(X + (size_t)u.pm * 256 * DM); u.B = (const char*)(W + (size_t)(3072 + u.pn * 256) * DM); u.sub = 0; return true; }
    __device__ __forceinline__ void epi(Acc& acc, const GUnit& u, int wr, int wc, int fr, int fq) const {
        const int row0 = u.pm * 256 + wr * 64 + fr; const bool sg = u.pn >= 12;
        bf16_t* base = u.pn < 8 ? R1A + u.pn * 256 : (u.pn < 16 ? R1B + (u.pn - 8) * 256 : R2 + (u.pn - 16) * 256);
        const int pitch = u.pn < 16 ? 2048 : 4096;
        const int col0 = wc * 32 + 8 * fq;
#pragma unroll
        for (int ai = 0; ai < 2; ++ai)
#pragma unroll
            for (int m = 0; m < 4; ++m) { const int row = row0 + ai * 128 + m * 16; const float s = r1[row]; bf16_t* rowp = base + (size_t)row * pitch + col0;
#pragma unroll
                for (int bj = 0; bj < 2; ++bj) { f32x4 v0 = acc[ai][bj][m][0] * s, v1 = acc[ai][bj][m][1] * s;
                    if (sg) {
#pragma unroll
                        for (int j = 0; j < 4; ++j) { v0[j] = sigmoidf_(v0[j]); v1[j] = sigmoidf_(v1[j]); } }
                    u32x4 w; w.x = pk2(v0[0], v0[1]); w.y = pk2(v0[2], v0[3]); w.z = pk2(v1[0], v1[1]); w.w = pk2(v1[2], v1[3]);
                    *(u32x4*)(rowp + bj * 128) = w; } }
        pg8::zero_acc(acc);
    }
};
struct BranchProg {
    static constexpr bool PERM = true; int K, G, c; const bf16_t *YA, *YBF, *YBB, *WA, *WB; const bf16_t* R2; bf16_t* MIX;
    __device__ __forceinline__ bool next(int i, GUnit& u) const { const int ti = i / 3, sub = i - 3 * ti; const int L = ti * G + c; if (L >= 64 * 8) return false; pg8::tile_of(L, 64, 8, u.pm, u.pn);
        const bf16_t* a = sub == 0 ? YA : (sub == 1 ? YBF : YBB); const bf16_t* b = sub == 0 ? WA : WB;
        u.A = (const char*)(a + (size_t)u.pm * 256 * 1024); u.B = (const char*)(b + (size_t)u.pn * 256 * 1024); u.sub = sub; return true; }
    __device__ __forceinline__ void epi(Acc& acc, const GUnit& u, int wr, int wc, int fr, int fq) const {
        if (u.sub == 1) return;
        const int row0 = u.pm * 256 + wr * 64 + fr, col0 = u.pn * 256 + wc * 32 + 8 * fq;
#pragma unroll
        for (int ai = 0; ai < 2; ++ai)
#pragma unroll
            for (int m = 0; m < 4; ++m) { const int row = row0 + ai * 128 + m * 16; const bf16_t* gp = R2 + (size_t)row * 4096 + col0;
#pragma unroll
                for (int bj = 0; bj < 2; ++bj) {
                    const u32x4 gbw = *(const u32x4*)(gp + 2048 + bj * 128);
                    float gb[8] = {bflo(gbw.x), bfhi(gbw.x), bflo(gbw.y), bfhi(gbw.y), bflo(gbw.z), bfhi(gbw.z), bflo(gbw.w), bfhi(gbw.w)};
                    if (u.sub == 0) {
                        const u32x4 gaw = *(const u32x4*)(gp + bj * 128);
                        float ga[8] = {bflo(gaw.x), bfhi(gaw.x), bflo(gaw.y), bfhi(gaw.y), bflo(gaw.z), bfhi(gaw.z), bflo(gaw.w), bfhi(gaw.w)};
#pragma unroll
                        for (int j = 0; j < 4; ++j) { acc[ai][bj][m][0][j] *= ga[j] / fmaxf(gb[j], 1e-30f); acc[ai][bj][m][1][j] *= ga[4 + j] / fmaxf(gb[4 + j], 1e-30f); }
                    } else {
                        f32x4 v0 = acc[ai][bj][m][0], v1 = acc[ai][bj][m][1];
#pragma unroll
                        for (int j = 0; j < 4; ++j) { v0[j] *= fmaxf(gb[j], 1e-30f); v1[j] *= fmaxf(gb[4 + j], 1e-30f); }
                        u32x4 w; w.x = pk2(v0[0], v0[1]); w.y = pk2(v0[2], v0[3]); w.z = pk2(v1[0], v1[1]); w.w = pk2(v1[2], v1[3]);
                        *(u32x4*)(MIX + blk_off(row, col0 + bj * 128, DM)) = w;
                    } } }
        if (u.sub == 2) pg8::zero_acc(acc);
    }
};
struct ResProg {
    static constexpr bool PERM = false; int K, G, c; const bf16_t* A; const bf16_t* B; const float* base; float* out; bf16_t* outb; float* ss;
    __device__ __forceinline__ bool next(int i, GUnit& u) const { const int L = i * G + c; if (L >= 64 * 8) return false; pg8::tile_of(L, 64, 8, u.pm, u.pn);
        u.A = (const char*)(A + (size_t)u.pm * 256 * K); u.B = (const char*)(B + (size_t)u.pn * 256 * K); u.sub = 0; return true; }
    __device__ __forceinline__ void epi(Acc& acc, const GUnit& u, int wr, int wc, int fr, int fq) const {
        const int row0 = u.pm * 256 + wr * 64 + fr, col0 = u.pn * 256 + wc * 32 + 4 * fq;
#pragma unroll
        for (int ai = 0; ai < 2; ++ai)
#pragma unroll
            for (int m = 0; m < 4; ++m) { const int row = row0 + ai * 128 + m * 16; const size_t off = (size_t)row * DM + col0; float s = 0.f;
#pragma unroll
                for (int bj = 0; bj < 2; ++bj)
#pragma unroll
                    for (int n = 0; n < 2; ++n) { const f32x4 bs = *(const f32x4*)(base + off + bj * 128 + n * 16); const f32x4 o = bs + acc[ai][bj][m][n];
                        *(f32x4*)(out + off + bj * 128 + n * 16) = o; s += (o[0] * o[0] + o[1] * o[1]) + (o[2] * o[2] + o[3] * o[3]);
                        if (outb) { u32x2 w; w.x = pk2(o[0], o[1]); w.y = pk2(o[2], o[3]); *(u32x2*)(outb + blk_off(row, col0 + bj * 128 + n * 16, DM)) = w; } }
                s += __shfl_xor(s, 16); s += __shfl_xor(s, 32);
                if (fq == 0) unsafeAtomicAdd(ss + row, s); }
        pg8::zero_acc(acc);
    }
};
struct GuProg {
    static constexpr bool PERM = true; int K, G, c; const bf16_t* X; const bf16_t* W; bf16_t* HH; const float* ss2;
    __device__ __forceinline__ bool next(int i, GUnit& u) const { const int L = i * G + c; if (L >= 64 * 44) return false; pg8::tile_of(L, 64, 44, u.pm, u.pn);
        u.A = (const char*)(X + (size_t)u.pm * 256 * DM); u.B = (const char*)(W + (size_t)u.pn * 256 * DM); u.sub = 0; return true; }
    __device__ __forceinline__ void epi(Acc& acc, const GUnit& u, int wr, int wc, int fr, int fq) const {
        const int row0 = u.pm * 256 + wr * 64 + fr, col0 = u.pn * 128 + wc * 32 + 8 * fq;
#pragma unroll
        for (int ai = 0; ai < 2; ++ai)
#pragma unroll
            for (int m = 0; m < 4; ++m) { const int row = row0 + ai * 128 + m * 16; const float r2 = 1.0f / sqrtf(ss2[row] * (1.0f / DM) + RMS_EPS);
                float hv[8];
#pragma unroll
                for (int n = 0; n < 2; ++n)
#pragma unroll
                    for (int j = 0; j < 4; ++j) { const float g = acc[ai][0][m][n][j] * r2, uu = acc[ai][1][m][n][j] * r2; hv[4 * n + j] = siluf_(g) * uu; }
                u32x4 w; w.x = pk2(hv[0], hv[1]); w.y = pk2(hv[2], hv[3]); w.z = pk2(hv[4], hv[5]); w.w = pk2(hv[6], hv[7]);
                *(u32x4*)(HH + blk_off(row, col0, FFH)) = w; }
        pg8::zero_acc(acc);
    }
};
struct Ctx {
    const float* in[21]; float* out; unsigned char* ws;
};
__device__ __forceinline__ void p0_transpose_item(const float* W, int Nsrc, int K, bf16_t* WT, int dst_row0, int src_col0, const float* kscale, LAS float* scr, int kb, int lane) {
    const int k0 = 64 * kb;
    float tv[32];
    const float* wp = W + (size_t)(k0 + (lane >> 5)) * Nsrc + src_col0 + (lane & 31);
#pragma unroll
    for (int i = 0; i < 32; ++i) tv[i] = wp[(size_t)(2 * i) * Nsrc];
    if (kscale) {
#pragma unroll
        for (int i = 0; i < 32; ++i) tv[i] *= kscale[k0 + 2 * i + (lane >> 5)]; }
#pragma unroll
    for (int i = 0; i < 32; ++i) scr[(2 * i + (lane >> 5)) * 33 + (lane & 31)] = tv[i];
    asm volatile("s_waitcnt lgkmcnt(0)" ::: "memory");
    const int c = lane & 7;
#pragma unroll
    for (int j = 0; j < 4; ++j) { const int n = (lane >> 3) + 8 * j; const LAS float* s = scr + (8 * c) * 33 + n;
        u32x4 o; o.x = pk2(s[0 * 33], s[1 * 33]); o.y = pk2(s[2 * 33], s[3 * 33]); o.z = pk2(s[4 * 33], s[5 * 33]); o.w = pk2(s[6 * 33], s[7 * 33]);
        *(u32x4*)(WT + blk_off(dst_row0 + n, k0 + 8 * c, K)) = o; }
    asm volatile("s_waitcnt lgkmcnt(0)" ::: "memory");
}
__device__ __forceinline__ void p0_prologue(const Ctx& C, LAS unsigned char* lds, int G, int wv) {
    int tid = (wv << 6) | lane_id_opaque(); asm volatile("" : "+v"(tid));
    const int lane = tid & 63, wave = __builtin_amdgcn_readfirstlane(tid >> 6);
    const int gw = blockIdx.x * 8 + wave, NGW = G * 8;
    unsigned char* ws = C.ws;
    LAS float* scr = (LAS float*)(lds + wave * 8704);
    constexpr int I_IN = 32 * 352, I_A = 16 * 64, I_O = 32 * 64, I_GU = 32 * 352, I_D = 88 * 64;
    constexpr int NIT = I_IN + 2 * I_A + I_O + I_GU + I_D;
    for (int it = gw; it < NIT; it += NGW) {
        int r = it;
        if (r < I_IN) { const int kb = r / 352, nb = r % 352, n0 = nb * 32; const int src = n0 < 7168 ? n0 : n0 + 16;
            p0_transpose_item(C.in[2], INCOLS, DM, (bf16_t*)(ws + WS_WIN), n0, src, C.in[1], scr, kb, lane); continue; } r -= I_IN;
        if (r < I_A) { p0_transpose_item(C.in[14], DM, HW, (bf16_t*)(ws + WS_WA), (r % 64) * 32, (r % 64) * 32, nullptr, scr, r / 64, lane); continue; } r -= I_A;
        if (r < I_A) { p0_transpose_item(C.in[15], DM, MW, (bf16_t*)(ws + WS_WB), (r % 64) * 32, (r % 64) * 32, nullptr, scr, r / 64, lane); continue; } r -= I_A;
        if (r < I_O) { p0_transpose_item(C.in[16], DM, DM, (bf16_t*)(ws + WS_WOUT), (r % 64) * 32, (r % 64) * 32, nullptr, scr, r / 64, lane); continue; } r -= I_O;
        if (r < I_GU) { const int kb = r / 352, nb = r % 352, n0 = nb * 32; const int pn = n0 >> 8, half = (n0 >> 7) & 1, i = n0 & 127;
            p0_transpose_item(C.in[18], 2 * FFH, DM, (bf16_t*)(ws + WS_WGU), n0, half * FFH + 128 * pn + i, C.in[17], scr, kb, lane); continue; } r -= I_GU;
        p0_transpose_item(C.in[19], DM, FFH, (bf16_t*)(ws + WS_WD), (r % 64) * 32, (r % 64) * 32, nullptr, scr, r / 64, lane);
    }
    for (int i = blockIdx.x * 512 + tid; i < TOK; i += G * 512) { ((float*)(ws + WS_SS2))[i] = 0.f; ((float*)(ws + WS_SS3))[i] = 0.f; }
    {
        const float* w1 = C.in[5]; const float* b1 = C.in[6]; const float* f1 = C.in[7]; const float* w2 = C.in[8]; const float* b2 = C.in[9]; const float* f2 = C.in[10];
        float* h2 = (float*)(ws + WS_H2);
        for (int t = gw; t < SEQ; t += NGW) {
            const float tl = (float)t / (float)(SEQ - 1);
            const float omega = 6.283185307179586f * (float)t / (float)SEQ;
            float a = b1[lane] + tl * w1[lane];
#pragma unroll 4
            for (int i = 0; i < 16; ++i) { const float fr = 1e-4f + (float)i * ((15.0f - 1e-4f) / 15.0f); const float ang = omega * fr; float sn, cs; sincosf(ang, &sn, &cs);
                a += cs * w1[(1 + i) * 64 + lane] - sn * w1[(17 + i) * 64 + lane]; }
            const float h1 = sinf(f1[lane] * a);
            float a2 = b2[lane];
#pragma unroll 8
            for (int i = 0; i < 64; ++i) a2 += __shfl(h1, i) * w2[i * 64 + lane];
            h2[t * 64 + lane] = sinf(f2[lane] * a2);
        }
    }
    __syncthreads();
    {
        LAS float* wg = (LAS float*)lds;
        const float* w_in = C.in[2]; const float* nw = C.in[1];
#pragma unroll 1
        for (int i0 = tid; i0 < DM * 16; i0 += 512 * 16) { float tw[16], tn[16];
#pragma unroll
            for (int u = 0; u < 16; ++u) { const int i = i0 + 512 * u, k = i >> 4, g = i & 15; tw[u] = w_in[(size_t)k * INCOLS + 7168 + g]; tn[u] = nw[k]; }
#pragma unroll
            for (int u = 0; u < 16; ++u) { const int i = i0 + 512 * u, k = i >> 4, g = i & 15; wg[g * DM + k] = tw[u] * tn[u]; } }
        __syncthreads();
        const float* x = C.in[0]; bf16_t* xb = (bf16_t*)(ws + WS_XB); float* r1 = (float*)(ws + WS_R1S); float* Gt = (float*)(ws + WS_G); const float* gbias = C.in[13];
        f32x4 vn[8];
        { const f32x4* xr = (const f32x4*)(x + (size_t)gw * DM) + lane;
#pragma unroll
          for (int j = 0; j < 8; ++j) vn[j] = xr[64 * j]; }
        for (int row = gw; row < TOK; row += NGW) {
            f32x4 v[8]; float s = 0.f;
#pragma unroll
            for (int j = 0; j < 8; ++j) { v[j] = vn[j]; s += (v[j].x * v[j].x + v[j].y * v[j].y) + (v[j].z * v[j].z + v[j].w * v[j].w); }
            if (row + NGW < TOK) { const f32x4* xr = (const f32x4*)(x + (size_t)(row + NGW) * DM) + lane;
#pragma unroll
                for (int j = 0; j < 8; ++j) vn[j] = xr[64 * j]; }
            const float r = 1.0f / sqrtf(wave_sum(s) * (1.0f / DM) + RMS_EPS);
#pragma unroll
            for (int j = 0; j < 8; ++j) { u32x2 w; w.x = pk2(v[j].x, v[j].y); w.y = pk2(v[j].z, v[j].w); *(u32x2*)(xb + blk_off(row, 256 * j + 4 * lane, DM)) = w; }
            float myg = 0.f;
#pragma unroll
            for (int g = 0; g < 16; ++g) { float a = 0.f;
#pragma unroll
                for (int j = 0; j < 8; ++j) { const f32x4 w = *(const LAS f32x4*)(wg + g * DM + 256 * j + 4 * lane); a += (v[j].x * w.x + v[j].y * w.y) + (v[j].z * w.z + v[j].w * w.w); }
                a = wave_sum(a); if (lane == g) myg = a; }
            if (lane < 16) Gt[(size_t)row * 16 + lane] = myg * r + gbias[lane];
            if (lane == 0) r1[row] = r;
        }
    }
}
__device__ __forceinline__ void p1_filters(const Ctx& C, LAS unsigned char* lds, int G, int wv) {
    int tid = (wv << 6) | lane_id_opaque(); asm volatile("" : "+v"(tid));
    LAS float* w3s = (LAS float*)lds;
    const float* w3 = C.in[11]; const float* h2 = (const float*)(C.ws + WS_H2); float* FILT = (float*)(C.ws + WS_FILT);
    for (int item = blockIdx.x; item < 256; item += G) {
        const int ntile = item >> 2, tt = item & 3, t0 = 1024 * tt + tid, t1 = t0 + 512;
        __syncthreads();
        for (int i = tid; i < 4096; i += 512) w3s[i] = w3[(size_t)(i >> 6) * NFILT + 64 * ntile + (i & 63)];
        __syncthreads();
        f32x4 hr0[16], hr1[16];
#pragma unroll
        for (int j = 0; j < 16; ++j) { hr0[j] = *(const f32x4*)(h2 + (size_t)t0 * 64 + 4 * j); hr1[j] = *(const f32x4*)(h2 + (size_t)t1 * 64 + 4 * j); }
        const float tl0 = (float)t0 / (float)(SEQ - 1), tl1 = (float)t1 / (float)(SEQ - 1);
#pragma unroll 1
        for (int n4 = 0; n4 < 16; ++n4) {
            float a[4] = {0.f, 0.f, 0.f, 0.f}, c[4] = {0.f, 0.f, 0.f, 0.f};
#pragma unroll
            for (int j = 0; j < 16; ++j) {
#pragma unroll
                for (int jj = 0; jj < 4; ++jj) { const f32x4 wv = *(const LAS f32x4*)(w3s + (4 * j + jj) * 64 + 4 * n4); const float hv = hr0[j][jj], hw = hr1[j][jj];
                    a[0] = fmaf(hv, wv.x, a[0]); a[1] = fmaf(hv, wv.y, a[1]); a[2] = fmaf(hv, wv.z, a[2]); a[3] = fmaf(hv, wv.w, a[3]);
                    c[0] = fmaf(hw, wv.x, c[0]); c[1] = fmaf(hw, wv.y, c[1]); c[2] = fmaf(hw, wv.z, c[2]); c[3] = fmaf(hw, wv.w, c[3]); }
            }
#pragma unroll
            for (int e = 0; e < 4; ++e) { const int n = 64 * ntile + 4 * n4 + e, ch = n & 1023;
                const float mind = -3.0701134573253945f, maxd = -15.350567286626973f;
                const float delta = fabsf(mind + (float)ch * ((maxd - mind) / 1023.0f));
                FILT[(size_t)n * SEQ + t0] = a[e] * expf(-tl0 * delta); FILT[(size_t)n * SEQ + t1] = c[e] * expf(-tl1 * delta); }
        }
    }
    __syncthreads();
}
__device__ __forceinline__ void p7_final(const Ctx& C, int G, int wv) {
    int tid = (wv << 6) | lane_id_opaque(); asm volatile("" : "+v"(tid));
    const int lane = tid & 63, wave = tid >> 6, gw = blockIdx.x * 8 + wave, NGW = G * 8;
    const float* ss3 = (const float*)(C.ws + WS_SS3); const float* wf = C.in[20];
    f32x4 w[8];
#pragma unroll
    for (int j = 0; j < 8; ++j) w[j] = ((const f32x4*)wf)[64 * j + lane];
    for (int row = gw; row < TOK; row += 2 * NGW) {
        const int row2 = row + NGW;
        const bool has2 = row2 < TOK;
        const float r = 1.0f / sqrtf(ss3[row] * (1.0f / DM) + RMS_EPS), r2 = has2 ? 1.0f / sqrtf(ss3[row2] * (1.0f / DM) + RMS_EPS) : 0.f;
        f32x4* p = (f32x4*)(C.out + (size_t)row * DM) + lane; f32x4* p2 = (f32x4*)(C.out + (size_t)(has2 ? row2 : row) * DM) + lane;
        f32x4 v[8], u[8];
#pragma unroll
        for (int j = 0; j < 8; ++j) { v[j] = p[64 * j]; u[j] = p2[64 * j]; }
#pragma unroll
        for (int j = 0; j < 8; ++j) p[64 * j] = v[j] * r * w[j];
        if (has2) {
#pragma unroll
            for (int j = 0; j < 8; ++j) p2[64 * j] = u[j] * r2 * w[j]; }
    }
}
#ifndef FFT_HOST
#define FFT_DEV __device__ __forceinline__
#define FFT_PTR LAS f32x2*
#define FFT_SIN(x) __builtin_amdgcn_sinf(x)
#define FFT_COS(x) __builtin_amdgcn_cosf(x)
#else
#define FFT_DEV static inline
#define FFT_PTR f32x2*
#define FFT_SIN(x) sinf(6.283185307179586f * (x))
#define FFT_COS(x) cosf(6.283185307179586f * (x))
#endif
#define PADI(i) ((i) + ((i) >> 4))
FFT_DEV f32x2 cmul(f32x2 a, f32x2 b) { f32x2 r; r.x = a.x * b.x - a.y * b.y; r.y = a.x * b.y + a.y * b.x; return r; }
FFT_DEV f32x2 cmulc(f32x2 a, f32x2 b) { f32x2 r; r.x = a.x * b.x + a.y * b.y; r.y = a.y * b.x - a.x * b.y; return r; }
FFT_DEV f32x2 twid(float frac) { f32x2 r; r.x = FFT_COS(frac); r.y = -FFT_SIN(frac); return r; }
template <int M, int CJ> FFT_DEV f32x2 rot8(f32x2 d) {
    const float R = 0.70710678118654752f; f32x2 r;
    if (M == 0) return d;
    if (M == 2) { if (!CJ) { r.x = d.y; r.y = -d.x; } else { r.x = -d.y; r.y = d.x; } return r; }
    if (M == 1) { if (!CJ) { r.x = R * (d.x + d.y); r.y = R * (d.y - d.x); } else { r.x = R * (d.x - d.y); r.y = R * (d.x + d.y); } return r; }
    if (!CJ) { r.x = R * (d.y - d.x); r.y = -R * (d.x + d.y); } else { r.x = -R * (d.x + d.y); r.y = R * (d.x - d.y); } return r;
}
template <int INV, int ZHI, int LOW> FFT_DEV void fft_r8_pass(FFT_PTR buf, int s, int ls  , int tid) {
#pragma unroll
    for (int rep = 0; rep < 2; ++rep) {
        const int bf = tid + rep * 512, j = bf & (s - 1), blk = bf >> ls, base = blk * 8 * s + j;
        f32x2 x[8];
#pragma unroll
        for (int m = 0; m < (ZHI ? 4 : 8); ++m) x[m] = buf[PADI(base + m * s)];
        f32x2 w1 = twid((float)j / (float)(8 * s));
        f32x2 w2 = cmul(w1, w1), w4 = cmul(w2, w2);
        if (!INV) {
            if (ZHI) {
                x[4] = cmul(x[0], w1); x[5] = cmul(rot8<1, 0>(x[1]), w1); x[6] = cmul(rot8<2, 0>(x[2]), w1); x[7] = cmul(rot8<3, 0>(x[3]), w1);
            } else {
                { f32x2 a = x[0], b = x[4]; x[0] = a + b; x[4] = cmul(a - b, w1); }
                { f32x2 a = x[1], b = x[5]; x[1] = a + b; x[5] = cmul(rot8<1, 0>(a - b), w1); }
                { f32x2 a = x[2], b = x[6]; x[2] = a + b; x[6] = cmul(rot8<2, 0>(a - b), w1); }
                { f32x2 a = x[3], b = x[7]; x[3] = a + b; x[7] = cmul(rot8<3, 0>(a - b), w1); }
            }
#pragma unroll
            for (int h = 0; h < 8; h += 4) {
                { f32x2 a = x[h], b = x[h + 2]; x[h] = a + b; x[h + 2] = cmul(a - b, w2); }
                { f32x2 a = x[h + 1], b = x[h + 3]; x[h + 1] = a + b; x[h + 3] = cmul(rot8<2, 0>(a - b), w2); }
            }
#pragma unroll
            for (int m = 0; m < 8; m += 2) { f32x2 a = x[m], b = x[m + 1]; x[m] = a + b; x[m + 1] = cmul(a - b, w4); }
        } else {
#pragma unroll
            for (int m = 0; m < 8; m += 2) { f32x2 a = x[m], b = cmulc(x[m + 1], w4); x[m] = a + b; x[m + 1] = a - b; }
#pragma unroll
            for (int h = 0; h < 8; h += 4) {
                { f32x2 a = x[h], b = cmulc(x[h + 2], w2); x[h] = a + b; x[h + 2] = a - b; }
                { f32x2 a = x[h + 1], b = rot8<2, 1>(cmulc(x[h + 3], w2)); x[h + 1] = a + b; x[h + 3] = a - b; }
            }
            { f32x2 a = x[0], b = cmulc(x[4], w1); x[0] = a + b; if (!LOW) x[4] = a - b; }
            { f32x2 a = x[1], b = rot8<1, 1>(cmulc(x[5], w1)); x[1] = a + b; if (!LOW) x[5] = a - b; }
            { f32x2 a = x[2], b = rot8<2, 1>(cmulc(x[6], w1)); x[2] = a + b; if (!LOW) x[6] = a - b; }
            { f32x2 a = x[3], b = rot8<3, 1>(cmulc(x[7], w1)); x[3] = a + b; if (!LOW) x[7] = a - b; }
        }
#pragma unroll
        for (int m = 0; m < (LOW ? 4 : 8); ++m) buf[PADI(base + m * s)] = x[m];
    }
}
FFT_DEV void fft_r2_span1(FFT_PTR buf, int tid) {
#pragma unroll
    for (int rep = 0; rep < 8; ++rep) { const int p = 2 * (tid + rep * 512); f32x2 a = buf[PADI(p)], b = buf[PADI(p + 1)]; buf[PADI(p)] = a + b; buf[PADI(p + 1)] = a - b; }
}
#ifndef FFT_HOST
#define FFT_SYNC() __syncthreads()
template <int ZHI> __device__ __forceinline__ void fft_fwd(FFT_PTR buf, int tid) {
    FFT_SYNC(); fft_r8_pass<0, ZHI, 0>(buf, 1024, 10, tid); FFT_SYNC(); fft_r8_pass<0, 0, 0>(buf, 128, 7, tid); FFT_SYNC(); fft_r8_pass<0, 0, 0>(buf, 16, 4, tid); FFT_SYNC();
    fft_r8_pass<0, 0, 0>(buf, 2, 1, tid); FFT_SYNC(); fft_r2_span1(buf, tid); FFT_SYNC();
}
template <int LOW> __device__ __forceinline__ void fft_inv(FFT_PTR buf, int tid) {
    FFT_SYNC(); fft_r2_span1(buf, tid); FFT_SYNC(); fft_r8_pass<1, 0, 0>(buf, 2, 1, tid); FFT_SYNC(); fft_r8_pass<1, 0, 0>(buf, 16, 4, tid); FFT_SYNC();
    fft_r8_pass<1, 0, 0>(buf, 128, 7, tid); FFT_SYNC(); fft_r8_pass<1, 0, LOW>(buf, 1024, 10, tid); FFT_SYNC();
}
#endif
FFT_DEV unsigned brev13(unsigned p) {
    unsigned r = 0;
#ifndef FFT_HOST
    r = __brev(p) >> 19;
#else
    for (int i = 0; i < 13; ++i) r |= ((p >> i) & 1u) << (12 - i);
#endif
    return r;
}
FFT_DEV void fft_pointwise(FFT_PTR wb, FFT_PTR zk, int which, int tid) {
#pragma unroll 4
    for (int rep = 0; rep < 16; ++rep) {
        const unsigned p = tid + rep * 512, f = brev13(p), fn = (8192u - f) & 8191u, pn = brev13(fn);
        const f32x2 zf = zk[PADI(p)], zn = zk[PADI(pn)];
        f32x2 kf;
        if (which == 0) { kf.x = 0.5f * (zf.x + zn.x); kf.y = 0.5f * (zf.y - zn.y); }
        else            { kf.x = 0.5f * (zf.y + zn.y); kf.y = 0.5f * (zn.x - zf.x); }
        wb[PADI(p)] = cmul(wb[PADI(p)], kf);
    }
}
__device__ __forceinline__ void unpack8(u32x4 w, float (&f)[8]) { f[0] = bflo(w.x); f[1] = bfhi(w.x); f[2] = bflo(w.y); f[3] = bfhi(w.y); f[4] = bflo(w.z); f[5] = bfhi(w.z); f[6] = bflo(w.w); f[7] = bfhi(w.w); }
__device__ __forceinline__ void qk_prepass(const Ctx& C, int G, int wv) {
    int tid = (wv << 6) | lane_id_opaque(); asm volatile("" : "+v"(tid));
    const bf16_t* R1A = (const bf16_t*)(C.ws + WS_R1A); bf16_t* QKP = (bf16_t*)(C.ws + WS_QKP);
    const float* cw = C.in[3]; const float* cb = C.in[4];
    const int cg8 = tid & 255, half = tid >> 8, col = 8 * cg8;
    float k0[8], k1[8], k2[8], kb[8];
    { const int ch = 3072 + col;
      const f32x4 t0 = *(const f32x4*)(cw + ch), t1 = *(const f32x4*)(cw + ch + 4), t2 = *(const f32x4*)(cw + CONVC + ch), t3 = *(const f32x4*)(cw + CONVC + ch + 4);
      const f32x4 t4 = *(const f32x4*)(cw + 2 * CONVC + ch), t5 = *(const f32x4*)(cw + 2 * CONVC + ch + 4), t6 = *(const f32x4*)(cb + ch), t7 = *(const f32x4*)(cb + ch + 4);
#pragma unroll
      for (int e = 0; e < 4; ++e) { k0[e] = t0[e]; k0[4 + e] = t1[e]; k1[e] = t2[e]; k1[4 + e] = t3[e]; k2[e] = t4[e]; k2[4 + e] = t5[e]; kb[e] = t6[e]; kb[4 + e] = t7[e]; } }
    const float osc = col >= 1024 ? 0.0625f : 1.0f;
    for (int run = blockIdx.x; run < TOK / 64; run += G) {
        const int row0 = run * 64 + half * 32;
#pragma unroll 4
        for (int i = 0; i < 32; ++i) {
            const int row = row0 + i, t = row & (SEQ - 1);
            const bf16_t* p = R1A + (size_t)row * 2048 + col;
            const u32x4 z = {0u, 0u, 0u, 0u};
            u32x4 w0 = *(const u32x4*)(t > 0 ? p - 2048 : p), w1 = *(const u32x4*)p, w2 = *(const u32x4*)(t < SEQ - 1 ? p + 2048 : p);
            if (t == 0) w0 = z; if (t == SEQ - 1) w2 = z;
            float a0[8], a1[8], a2[8]; unpack8(w0, a0); unpack8(w1, a1); unpack8(w2, a2);
            float v[8];
#pragma unroll
            for (int e = 0; e < 8; ++e) v[e] = siluf_(k0[e] * a0[e] + k1[e] * a1[e] + k2[e] * a2[e] + kb[e]) * osc;
            u32x4 o; o.x = pk2(v[0], v[1]); o.y = pk2(v[2], v[3]); o.z = pk2(v[4], v[5]); o.w = pk2(v[6], v[7]);
            *(u32x4*)(QKP + (size_t)row * 2048 + col) = o;
        }
    }
}
constexpr int ML_KS = 0, ML_KP = 528, ML_SS = 67584, ML_SP = 272, ML_VS = 102400, ML_VP = 80, ML_VW = 112640, ML_CS = 122880, ML_CP = 528, ML_NS = 139776, ML_SC = 140800;
static_assert(ML_SC + 7 * 512 + 64 <= LDS_BYTES, "mLSTM LDS map");
__device__ __forceinline__ bf16x8 tr_read2(unsigned a0, unsigned a1) {
    bf16x4 lo, hi;
    asm volatile("ds_read_b64_tr_b16 %0, %2\n\tds_read_b64_tr_b16 %1, %3\n\ts_waitcnt lgkmcnt(0)" : "=&v"(lo), "=&v"(hi) : "v"(a0), "v"(a1) : "memory");
    bf16x8 r; r[0] = lo[0]; r[1] = lo[1]; r[2] = lo[2]; r[3] = lo[3]; r[4] = hi[0]; r[5] = hi[1]; r[6] = hi[2]; r[7] = hi[3]; return r;
}
__device__ __forceinline__ bf16x8 cat4(bf16x4 lo, bf16x4 hi) { bf16x8 r; r[0] = lo[0]; r[1] = lo[1]; r[2] = lo[2]; r[3] = lo[3]; r[4] = hi[0]; r[5] = hi[1]; r[6] = hi[2]; r[7] = hi[3]; return r; }
__device__ __forceinline__ void tr_read2x2(unsigned a, unsigned b, unsigned d, bf16x8& ra, bf16x8& rb) {
    bf16x4 l0, h0, l1, h1;
    asm volatile("ds_read_b64_tr_b16 %0, %4\n\tds_read_b64_tr_b16 %1, %5\n\tds_read_b64_tr_b16 %2, %6\n\tds_read_b64_tr_b16 %3, %7\n\ts_waitcnt lgkmcnt(0)"
        : "=&v"(l0), "=&v"(h0), "=&v"(l1), "=&v"(h1) : "v"(a), "v"(a + d), "v"(b), "v"(b + d) : "memory");
    ra = cat4(l0, h0); rb = cat4(l1, h1);
}
__device__ __forceinline__ void tr_read4x2(unsigned a, unsigned b, unsigned d, unsigned c, unsigned e, unsigned d2, bf16x8& ra, bf16x8& rb, bf16x8& rc, bf16x8& re) {
    bf16x4 l0, h0, l1, h1, l2, h2, l3, h3;
    asm volatile("ds_read_b64_tr_b16 %0, %8\n\tds_read_b64_tr_b16 %1, %9\n\tds_read_b64_tr_b16 %2, %10\n\tds_read_b64_tr_b16 %3, %11\n\t"
                 "ds_read_b64_tr_b16 %4, %12\n\tds_read_b64_tr_b16 %5, %13\n\tds_read_b64_tr_b16 %6, %14\n\tds_read_b64_tr_b16 %7, %15\n\ts_waitcnt lgkmcnt(0)"
        : "=&v"(l0), "=&v"(h0), "=&v"(l1), "=&v"(h1), "=&v"(l2), "=&v"(h2), "=&v"(l3), "=&v"(h3)
        : "v"(a), "v"(a + d), "v"(b), "v"(b + d), "v"(c), "v"(c + d2), "v"(e), "v"(e + d2) : "memory");
    ra = cat4(l0, h0); rb = cat4(l1, h1); rc = cat4(l2, h2); re = cat4(l3, h3);
}
__device__ __forceinline__ float bf2f(short s) { return __uint_as_float(((unsigned)(unsigned short)s) << 16); }
__device__ __forceinline__ float logsigmoidf_(float x) { return fminf(x, 0.f) - log1pf(expf(-fabsf(x))); }

__device__ __forceinline__ void mlstm_item(const Ctx& C, LAS unsigned char* lds, int item, int wv) {
    int tid = (wv << 6) | lane_id_opaque(); asm volatile("" : "+v"(tid));
    const int lane = tid & 63, w = __builtin_amdgcn_readfirstlane(tid >> 6), r = lane & 15, g = lane >> 4, q4 = r >> 2, p4 = r & 3;
    const int vs = item & 7, dir = (item >> 3) & 1, bh = item >> 4, b = bh >> 2, h = bh & 3;
    const bf16_t* QKP = (const bf16_t*)(C.ws + WS_QKP); const bf16_t* R1B = (const bf16_t*)(C.ws + WS_R1B); const float* Gt = (const float*)(C.ws + WS_G);
    bf16_t* Y = (bf16_t*)(C.ws + (dir ? WS_YBB : WS_YBF));
    LAS float* SC = (LAS float*)(lds + ML_SC);
    LAS float* s_cs = SC, *s_rj = SC + 128, *s_iw = SC + 256, *s_emj = SC + 384, *s_w = SC + 512, *s_dn = SC + 640, *s_misc = SC + 768;
    LAS float* NS = (LAS float*)(lds + ML_NS);
    const unsigned lbase = (unsigned)(size_t)lds;
    const int pc = tid & 31, krow = tid >> 5, vrow = tid >> 2, pv = tid & 3;
    const int sw = w < 4 ? w : 11 - w;
    for (int i = tid; i < (ML_NS + 1024 - ML_CS) / 4; i += 512) ((LAS unsigned*)(lds + ML_CS))[i] = 0u;
    f32x4 Cacc[3][2];
#pragma unroll
    for (int a = 0; a < 3; ++a) { Cacc[a][0] = (f32x4){0.f, 0.f, 0.f, 0.f}; Cacc[a][1] = (f32x4){0.f, 0.f, 0.f, 0.f}; }
    float m_prev = 0.f;
    u32x4 kreg[8], vreg, qn[8]; float ipn = 0.f, fpn = 0.f;
#define ML_TOK(c_, j_) ((size_t)b * SEQ + (dir ? SEQ - 1 - ((c_) * 128 + (j_)) : ((c_) * 128 + (j_))))
#define ML_PREFETCH(c_) do { \
        _Pragma("unroll") for (int i = 0; i < 8; ++i) kreg[i] = *(const u32x4*)(QKP + ML_TOK(c_, krow + 16 * i) * 2048 + 1024 + h * 256 + 8 * pc); \
        vreg = *(const u32x4*)(R1B + ML_TOK(c_, vrow) * 2048 + h * 256 + vs * 32 + 8 * pv); \
        { const bf16_t* qp = QKP + ML_TOK(c_, 16 * sw + r) * 2048 + h * 256 + 8 * g; _Pragma("unroll") for (int kk = 0; kk < 8; ++kk) qn[kk] = *(const u32x4*)(qp + 32 * kk); } \
        if (tid < 128) { const size_t tk = ML_TOK(c_, tid); ipn = Gt[tk * 16 + (dir * 2) * 4 + h]; fpn = Gt[tk * 16 + (dir * 2 + 1) * 4 + h]; } } while (0)
    ML_PREFETCH(0);
    __syncthreads();
#define ML_BAR() do { asm volatile("s_waitcnt lgkmcnt(0)" ::: "memory"); __builtin_amdgcn_s_barrier(); asm volatile("" ::: "memory"); } while (0)
#pragma unroll 1
    for (int c = 0; c < 32; ++c) {
        float xs = 0.f, csv = 0.f, pmx = 0.f, bcum = 0.f; const float ip = ipn;
        if (tid < 128) {
            xs = logsigmoidf_(fpn);
#pragma unroll
            for (int o = 1; o < 64; o <<= 1) { const float y = __shfl_up(xs, o); if (lane >= o) xs += y; }
            if (tid == 63) s_misc[0] = xs;
        }
        ML_BAR();
        if (tid < 128) {
            bcum = xs + (w == 1 ? s_misc[0] : 0.f); csv = ip - bcum; pmx = csv;
#pragma unroll
            for (int o = 1; o < 64; o <<= 1) { const float y = __shfl_up(pmx, o); if (lane >= o) pmx = fmaxf(pmx, y); }
            if (tid == 63) s_misc[1] = pmx;
            if (tid == 127) s_misc[2] = bcum;
        }
        ML_BAR();
        if (tid < 128) { if (w == 1) pmx = fmaxf(pmx, s_misc[1]); if (tid == 127) s_misc[3] = pmx; }
        ML_BAR();
        const float b_last = s_misc[2], m_new = fmaxf(b_last + m_prev, b_last + s_misc[3]), keep = __expf(b_last + m_prev - m_new);
        if (tid < 128) {
            const float inter = bcum + m_prev, mj = fmaxf(inter, bcum + pmx);
            s_cs[tid] = csv; s_rj[tid] = bcum - mj; s_iw[tid] = __expf(inter - mj); s_emj[tid] = __expf(-mj); s_w[tid] = __expf(b_last + csv - m_new);
        }
        ML_BAR();
#pragma unroll
        for (int i = 0; i < 8; ++i) *(LAS u32x4*)(lds + ML_KS + (krow + 16 * i) * ML_KP + pc * 16) = kreg[i];
        {
            *(LAS u32x4*)(lds + ML_VS + vrow * ML_VP + pv * 16) = vreg;
            float f[8]; unpack8(vreg, f); const float ws_ = s_w[vrow];
            u32x4 o; o.x = pk2(f[0] * ws_, f[1] * ws_); o.y = pk2(f[2] * ws_, f[3] * ws_); o.z = pk2(f[4] * ws_, f[5] * ws_); o.w = pk2(f[6] * ws_, f[7] * ws_);
            *(LAS u32x4*)(lds + ML_VW + vrow * ML_VP + pv * 16) = o;
        }
        bf16x8 qf[8];
#pragma unroll
        for (int kk = 0; kk < 8; ++kk) qf[kk] = __builtin_bit_cast(bf16x8, qn[kk]);
        unsigned short ogr[4][2];
#pragma unroll
        for (int i = 0; i < 4; ++i)
#pragma unroll
            for (int vt = 0; vt < 2; ++vt) ogr[i][vt] = R1B[ML_TOK(c, 16 * sw + 4 * g + i) * 2048 + 1024 + h * 256 + vs * 32 + 16 * vt + r];
        if (c < 31) ML_PREFETCH(c + 1);
        ML_BAR();
        {
            const float rjv = s_rj[16 * sw + r]; const int jloc = 16 * sw + r; float den1 = 0.f;
#pragma unroll 1
            for (int st = 0; st < 8; ++st) {
                if (st <= sw) {
                    f32x4 acc = {0.f, 0.f, 0.f, 0.f};
#pragma unroll
                    for (int kk = 0; kk < 8; ++kk) { const bf16x8 kf = *(const LAS bf16x8*)(lds + ML_KS + (16 * st + r) * ML_KP + (32 * kk + 8 * g) * 2); acc = __builtin_amdgcn_mfma_f32_16x16x32_bf16(kf, qf[kk], acc, 0, 0, 0); }
                    const f32x4 c4 = *(const LAS f32x4*)(s_cs + 16 * st + 4 * g);
                    float v[4];
#pragma unroll
                    for (int i = 0; i < 4; ++i) { const int s = 16 * st + 4 * g + i; const float d = (s <= jloc) ? __expf(rjv + c4[i]) : 0.f; v[i] = acc[i] * d; den1 += v[i]; }
                    u32x2 o; o.x = pk2(v[0], v[1]); o.y = pk2(v[2], v[3]);
                    *(LAS u32x2*)(lds + ML_SS + jloc * ML_SP + (16 * st + 4 * g) * 2) = o;
                } else if (st == sw + 1 && !(sw & 1)) {
                    u32x2 o = {0u, 0u}; *(LAS u32x2*)(lds + ML_SS + jloc * ML_SP + (16 * st + 4 * g) * 2) = o;
                }
            }
            den1 += __shfl_xor(den1, 16); den1 += __shfl_xor(den1, 32);
            float d2 = 0.f;
#pragma unroll
            for (int kk = 0; kk < 8; ++kk) { const f32x4 n0 = *(const LAS f32x4*)(NS + 32 * kk + 8 * g), n1 = *(const LAS f32x4*)(NS + 32 * kk + 8 * g + 4);
#pragma unroll
                for (int e = 0; e < 4; ++e) { d2 += bf2f(qf[kk][e]) * n0[e]; d2 += bf2f(qf[kk][4 + e]) * n1[e]; } }
            d2 += __shfl_xor(d2, 16); d2 += __shfl_xor(d2, 32);
            if (g == 0) s_dn[jloc] = den1 + s_iw[jloc] * d2;
        }
        ML_BAR();
        {
            f32x4 n1[2], n2[2];
#pragma unroll
            for (int vt = 0; vt < 2; ++vt) { n1[vt] = (f32x4){0.f, 0.f, 0.f, 0.f}; n2[vt] = (f32x4){0.f, 0.f, 0.f, 0.f}; }
            const int nks = (sw >> 1) + 1;
#pragma unroll 1
            for (int ks = 0; ks < nks; ++ks) {
                const bf16x8 af = *(const LAS bf16x8*)(lds + ML_SS + (16 * sw + r) * ML_SP + (32 * ks + 8 * g) * 2);
                const unsigned a0 = lbase + ML_VS + (32 * ks + 8 * g + q4) * ML_VP + (4 * p4) * 2;
                bf16x8 b0, b1; tr_read2x2(a0, a0 + 32, 4 * ML_VP, b0, b1);
                n1[0] = __builtin_amdgcn_mfma_f32_16x16x32_bf16(af, b0, n1[0], 0, 0, 0); n1[1] = __builtin_amdgcn_mfma_f32_16x16x32_bf16(af, b1, n1[1], 0, 0, 0);
            }
#pragma unroll
            for (int kk = 0; kk < 8; ++kk)
#pragma unroll
                for (int vt = 0; vt < 2; ++vt) { const bf16x8 cf = *(const LAS bf16x8*)(lds + ML_CS + (16 * vt + r) * ML_CP + (32 * kk + 8 * g) * 2); n2[vt] = __builtin_amdgcn_mfma_f32_16x16x32_bf16(qf[kk], cf, n2[vt], 0, 0, 0); }
            const f32x4 iw4 = *(const LAS f32x4*)(s_iw + 16 * sw + 4 * g), dn4 = *(const LAS f32x4*)(s_dn + 16 * sw + 4 * g), em4 = *(const LAS f32x4*)(s_emj + 16 * sw + 4 * g);
#pragma unroll
            for (int i = 0; i < 4; ++i) {
                const size_t tok = ML_TOK(c, 16 * sw + 4 * g + i);
                const float inv = 1.0f / fmaxf(fabsf(dn4[i]), em4[i]);
#pragma unroll
                for (int vt = 0; vt < 2; ++vt) { const int col = h * 256 + vs * 32 + 16 * vt + r;
                    const float og = __uint_as_float(((unsigned)ogr[i][vt]) << 16);
                    const float hv = (n1[vt][i] + iw4[i] * n2[vt][i]) * inv * og;
                    Y[blk_off((int)tok, col, 1024)] = (bf16_t)f2bf(hv); }
            }
        }
        ML_BAR();
        {
#pragma unroll
            for (int a = 0; a < 3; ++a) { Cacc[a][0] *= keep; Cacc[a][1] *= keep; }
#pragma unroll 1
            for (int ks = 0; ks < 4; ++ks) {
                bf16x8 af[3], bq[2];
                { const unsigned av = lbase + ML_VW + (32 * ks + 8 * g + q4) * ML_VP + (4 * p4) * 2, ak = lbase + ML_KS + (32 * ks + 8 * g + q4) * ML_KP + (32 * w + 4 * p4) * 2;
                  tr_read4x2(av, av + 32, 4 * ML_VP, ak, ak + 32, 4 * ML_KP, af[0], af[1], bq[0], bq[1]); }
                { const f32x4 wa = *(const LAS f32x4*)(s_w + 32 * ks + 8 * g), wb = *(const LAS f32x4*)(s_w + 32 * ks + 8 * g + 4);
                  u32x4 o; o.x = pk2(wa[0], wa[1]); o.y = pk2(wa[2], wa[3]); o.z = pk2(wb[0], wb[1]); o.w = pk2(wb[2], wb[3]);
                  if (r != 0) { o.x = 0u; o.y = 0u; o.z = 0u; o.w = 0u; }
                  af[2] = __builtin_bit_cast(bf16x8, o); }
#pragma unroll
                for (int nt = 0; nt < 2; ++nt)
#pragma unroll
                    for (int mt = 0; mt < 3; ++mt) Cacc[mt][nt] = __builtin_amdgcn_mfma_f32_16x16x32_bf16(af[mt], bq[nt], Cacc[mt][nt], 0, 0, 0);
            }
#pragma unroll
            for (int mt = 0; mt < 2; ++mt)
#pragma unroll
                for (int nt = 0; nt < 2; ++nt)
#pragma unroll
                    for (int i = 0; i < 4; ++i) *(LAS bf16_t*)(lds + ML_CS + (16 * mt + 4 * g + i) * ML_CP + (32 * w + 16 * nt + r) * 2) = (bf16_t)f2bf(Cacc[mt][nt][i]);
            if (g == 0) { NS[32 * w + r] = Cacc[2][0][0]; NS[32 * w + 16 + r] = Cacc[2][1][0]; }
        }
        m_prev = m_new;
        ML_BAR();
    }
#undef ML_BAR
#undef ML_PREFETCH
#undef ML_TOK
}
constexpr int HY_ZK = 0, HY_WB = 69632;
static_assert(HY_WB + 69632 <= LDS_BYTES, "hyena LDS map");
#define GAS __attribute__((address_space(1)))
__device__ __forceinline__ float hy_conv(const GAS bf16_t* p  , int off, int t, float w0, float w1, float w2, float bias) {
    const unsigned r1 = p[off], r0 = p[off - 1], r2 = p[off + 1];
    const float a1 = __uint_as_float(r1 << 16);
    const float a0 = t > 0 ? __uint_as_float(r0 << 16) : 0.f;
    const float a2 = t < SEQ - 1 ? __uint_as_float(r2 << 16) : 0.f;
    return w0 * a0 + w1 * a1 + w2 * a2 + bias;
}
__device__ __forceinline__ void hyena_item(const Ctx& C, LAS unsigned char* lds, int ch, int wv) {
    int tid = (wv << 6) | lane_id_opaque(); asm volatile("" : "+v"(tid));
    LAS f32x2* zk = (LAS f32x2*)(lds + HY_ZK); LAS f32x2* wb = (LAS f32x2*)(lds + HY_WB);
    const float* FILT = (const float*)(C.ws + WS_FILT); const bf16_t* HYb = (const bf16_t*)(C.ws + WS_HY); bf16_t* YA = (bf16_t*)(C.ws + WS_YA);
    const float* cw = C.in[3]; const float* cb = C.in[4];
    float w0[3], w1[3], w2[3], bs[3];
#pragma unroll
    for (int s = 0; s < 3; ++s) { w0[s] = cw[s * 1024 + ch]; w1[s] = cw[CONVC + s * 1024 + ch]; w2[s] = cw[2 * CONVC + s * 1024 + ch]; bs[s] = cb[s * 1024 + ch]; }
    const float hb0 = C.in[12][ch], hb1 = C.in[12][1024 + ch];
    const float* F0 = FILT + (size_t)(0 * 1024 + ch) * SEQ; const float* F1 = FILT + (size_t)(1 * 1024 + ch) * SEQ;
    const float* F2 = FILT + (size_t)(2 * 1024 + ch) * SEQ; const float* F3 = FILT + (size_t)(3 * 1024 + ch) * SEQ;
    __syncthreads();
    {
        float fa[16], fb[16];
#pragma unroll
        for (int rep = 0; rep < 8; ++rep) { const int i = tid + 512 * rep; fa[rep] = F0[i]; fb[rep] = F2[i]; }
#pragma unroll
        for (int rep = 8; rep < 16; ++rep) { const int i = tid + 512 * rep; const int j = i == SEQ ? 1 : 2 * SEQ - i; fa[rep] = F1[j]; fb[rep] = F3[j]; }
        if (tid == 0) { fa[8] = 0.f; fb[8] = 0.f; }
#pragma unroll
        for (int rep = 0; rep < 16; ++rep) { const int i = tid + 512 * rep; zk[PADI(i)] = (f32x2){fa[rep] * (1.0f / 8192.0f), fb[rep] * (1.0f / 8192.0f)}; }
    }
    fft_fwd<0>(zk, tid);
#pragma unroll 1
    for (int p = 0; p < 2; ++p) {
        const int tb0 = (2 * p) * SEQ, tb1 = (2 * p + 1) * SEQ;
        f32x2 vv[8], zz[8];
        const bf16_t* pv0_ = HYb + (size_t)ch * TOK + tb0 + tid; asm volatile("" : "+v"(pv0_)); const GAS bf16_t* pv0 = (const GAS bf16_t*)pv0_; const GAS bf16_t* pv1 = pv0 + SEQ;
#pragma unroll
        for (int m = 0; m < 8; ++m) { const int t = tid + 512 * m;
            vv[m].x = hy_conv(pv0, 512 * m, t, w0[0], w1[0], w2[0], bs[0]); vv[m].y = hy_conv(pv1, 512 * m, t, w0[0], w1[0], w2[0], bs[0]);
            wb[PADI(t)] = vv[m]; }
        fft_fwd<1>(wb, tid); fft_pointwise(wb, zk, 0, tid); fft_inv<1>(wb, tid);
        const bf16_t* px0_ = HYb + (size_t)(1024 + ch) * TOK + tb0 + tid; asm volatile("" : "+v"(px0_)); const GAS bf16_t* px0 = (const GAS bf16_t*)px0_; const GAS bf16_t* px1 = px0 + SEQ;
#pragma unroll
        for (int m = 0; m < 8; ++m) { const int t = tid + 512 * m; const f32x2 y = wb[PADI(t)];
            const float xa = hy_conv(px0, 512 * m, t, w0[1], w1[1], w2[1], bs[1]), xb_ = hy_conv(px1, 512 * m, t, w0[1], w1[1], w2[1], bs[1]);
            zz[m].x = xa * (y.x + vv[m].x * hb0); zz[m].y = xb_ * (y.y + vv[m].y * hb0); }
#pragma unroll
        for (int m = 0; m < 8; ++m) { const int t = tid + 512 * m; wb[PADI(t)] = zz[m]; }
        fft_fwd<1>(wb, tid); fft_pointwise(wb, zk, 1, tid); fft_inv<1>(wb, tid);
        const bf16_t* py0_ = HYb + (size_t)(2048 + ch) * TOK + tb0 + tid; asm volatile("" : "+v"(py0_)); const GAS bf16_t* py0 = (const GAS bf16_t*)py0_; const GAS bf16_t* py1 = py0 + SEQ;
#pragma unroll
        for (int m = 0; m < 8; ++m) { const int t = tid + 512 * m; const f32x2 y = wb[PADI(t)];
            const float xa = hy_conv(py0, 512 * m, t, w0[2], w1[2], w2[2], bs[2]), xb_ = hy_conv(py1, 512 * m, t, w0[2], w1[2], w2[2], bs[2]);
            YA[blk_off(tb0 + t, ch, 1024)] = (bf16_t)f2bf(xa * (y.x + zz[m].x * hb1));
            YA[blk_off(tb1 + t, ch, 1024)] = (bf16_t)f2bf(xb_ * (y.y + zz[m].y * hb1)); }
        __syncthreads();
    }
}
#ifndef DUP_P0
#define DUP_P0 0
#endif
#ifndef DUP_ML
#define DUP_ML 0
#endif
#ifndef DUP_HY
#define DUP_HY 0
#endif
#ifndef DUP_REST
#define DUP_REST 0
#endif
#ifndef DUP_GU
#define DUP_GU 0
#endif
__device__ __forceinline__ void grid_bar(unsigned* cnt, unsigned target, int wv) {
    asm volatile("s_waitcnt vmcnt(0)" ::: "memory");
    __syncthreads();
    const int lane = lane_id_opaque();
    if (wv == 0 && lane == 0) {
        __builtin_amdgcn_fence(__ATOMIC_RELEASE, "agent");
        asm volatile("s_waitcnt vmcnt(0)" ::: "memory");
        __hip_atomic_fetch_add(cnt, 1u, __ATOMIC_RELAXED, __HIP_MEMORY_SCOPE_AGENT);
        while (__hip_atomic_load(cnt, __ATOMIC_RELAXED, __HIP_MEMORY_SCOPE_AGENT) < target) __builtin_amdgcn_s_sleep(2);
        __builtin_amdgcn_fence(__ATOMIC_ACQUIRE, "agent");
        asm volatile("s_waitcnt vmcnt(0)" ::: "memory");
    }
    __syncthreads();
}
struct Params { const float* in[21]; float* out; unsigned char* ws; };
__global__ void __launch_bounds__(512, 2) fwd_megakernel(Params prm) {
    extern __shared__ __attribute__((aligned(16))) unsigned char lds_raw[];
    LAS unsigned char* lds = (LAS unsigned char*)lds_raw;
    cg::grid_group grid = cg::this_grid();
    const int G = gridDim.x, bx = blockIdx.x;
    const int wv = __builtin_amdgcn_readfirstlane((int)(threadIdx.x >> 6));
    Ctx C;
#pragma unroll
    for (int i = 0; i < 21; ++i) C.in[i] = prm.in[i];
    C.out = prm.out; C.ws = prm.ws;
    unsigned char* ws = prm.ws;
    unsigned* gbar = (unsigned*)(ws + WS_BAR); unsigned bar_k = 0u;
#define GBAR() grid_bar(gbar, (++bar_k) * (unsigned)G, wv)
    if (bx == 0 && threadIdx.x == 0) *gbar = 0u;
    for (int rep = 0; rep < 1 + DUP_P0; ++rep) { p0_prologue(C, lds, G, wv); __syncthreads(); }
    grid.sync();
    p1_filters(C, lds, G, wv);
    { HyProg P; P.K = DM; P.G = G; P.c = bx; P.W = (const bf16_t*)(ws + WS_WIN); P.X = (const bf16_t*)(ws + WS_XB); P.HY = (bf16_t*)(ws + WS_HY); P.r1 = (const float*)(ws + WS_R1S);
      pg8::gemm_stream(lds, P, wv); }
    for (int rep = 0; rep < 1 + DUP_REST; ++rep) { RestProg P; P.K = DM; P.G = G; P.c = bx; P.W = (const bf16_t*)(ws + WS_WIN); P.X = (const bf16_t*)(ws + WS_XB); P.R1A = (bf16_t*)(ws + WS_R1A); P.R1B = (bf16_t*)(ws + WS_R1B); P.R2 = (bf16_t*)prm.out; P.r1 = (const float*)(ws + WS_R1S);
      pg8::gemm_stream(lds, P, wv); }
    GBAR();
    qk_prepass(C, G, wv);
    for (int rep = 0; rep < 1 + DUP_HY; ++rep) for (int idx = bx; idx < 1024; idx += G) { const int rd = idx >> 8, bb = idx & 255; hyena_item(C, lds, rd * 256 + (bb & 7) * 32 + (bb >> 3), wv); }
    GBAR();
    for (int rep = 0; rep < 1 + DUP_ML; ++rep) for (int item = bx; item < 256; item += G) mlstm_item(C, lds, item, wv);
    GBAR();
    { BranchProg P; P.K = 1024; P.G = G; P.c = bx; P.YA = (const bf16_t*)(ws + WS_YA); P.YBF = (const bf16_t*)(ws + WS_YBF); P.YBB = (const bf16_t*)(ws + WS_YBB);
      P.WA = (const bf16_t*)(ws + WS_WA); P.WB = (const bf16_t*)(ws + WS_WB); P.R2 = (const bf16_t*)prm.out; P.MIX = (bf16_t*)(ws + WS_MIX);
      pg8::gemm_stream(lds, P, wv); }
    GBAR();
    { ResProg P; P.K = DM; P.G = G; P.c = bx; P.A = (const bf16_t*)(ws + WS_MIX); P.B = (const bf16_t*)(ws + WS_WOUT); P.base = prm.in[0]; P.out = prm.out; P.outb = (bf16_t*)(ws + WS_X1B); P.ss = (float*)(ws + WS_SS2);
      pg8::gemm_stream(lds, P, wv); }
    GBAR();
    for (int rep = 0; rep < 1 + DUP_GU; ++rep) { GuProg P; P.K = DM; P.G = G; P.c = bx; P.X = (const bf16_t*)(ws + WS_X1B); P.W = (const bf16_t*)(ws + WS_WGU); P.HH = (bf16_t*)(ws + WS_HH); P.ss2 = (const float*)(ws + WS_SS2);
      pg8::gemm_stream(lds, P, wv); }
    GBAR();
    { ResProg P; P.K = FFH; P.G = G; P.c = bx; P.A = (const bf16_t*)(ws + WS_HH); P.B = (const bf16_t*)(ws + WS_WD); P.base = prm.out; P.out = prm.out; P.outb = nullptr; P.ss = (float*)(ws + WS_SS3);
      pg8::gemm_stream(lds, P, wv); }
    GBAR();
    p7_final(C, G, wv);
}

extern "C" void kernel_launch(void* const* d_in, const int* in_sizes, int n_in, void* d_out, int out_size, void* d_ws, size_t ws_size, hipStream_t stream) {
    static int grid = 0;
    if (grid == 0) {
        int dev = 0, cus = 0, per_cu = 0;
        hipGetDevice(&dev); hipDeviceGetAttribute(&cus, hipDeviceAttributeMultiprocessorCount, dev);
        if (hipFuncSetAttribute((const void*)fwd_megakernel, hipFuncAttributeMaxDynamicSharedMemorySize, LDS_BYTES) != hipSuccess) { fprintf(stderr, "kernel_launch: hipFuncSetAttribute failed\n"); grid = -1; return; }
        if (hipOccupancyMaxActiveBlocksPerMultiprocessor(&per_cu, (const void*)fwd_megakernel, 512, LDS_BYTES) != hipSuccess || per_cu < 1) { fprintf(stderr, "kernel_launch: occupancy query gave %d\n", per_cu); per_cu = 1; }
        (void)hipGetLastError();
        grid = cus * 1;
        if (n_in != 21 || ws_size < WS_END) { fprintf(stderr, "kernel_launch: unexpected n_in %d or ws %zu\n", n_in, ws_size); grid = -1; return; }
    }
    if (grid < 0) return;
    Params p{};
    for (int i = 0; i < 21; ++i) p.in[i] = (const float*)d_in[i];
    p.out = (float*)d_out; p.ws = (unsigned char*)d_ws;
    void* args[] = {&p};
    hipError_t e = hipLaunchCooperativeKernel((const void*)fwd_megakernel, dim3(grid), dim3(512), args, LDS_BYTES, stream);
    if (e != hipSuccess) fprintf(stderr, "cooperative launch failed: %s (grid %d)\n", hipGetErrorString(e), grid);
}
```

```cpp
#include <hip/hip_runtime.h>
#include <hip/hip_cooperative_groups.h>
#include <cstdio>
namespace cg = cooperative_groups;

#define LAS __attribute__((address_space(3)))
typedef unsigned short bf16_t;
typedef short bf16x8 __attribute__((ext_vector_type(8)));
typedef short bf16x4 __attribute__((ext_vector_type(4)));
typedef float f32x4 __attribute__((ext_vector_type(4)));
typedef float f32x2 __attribute__((ext_vector_type(2)));
typedef unsigned u32x4 __attribute__((ext_vector_type(4)));
typedef unsigned u32x2 __attribute__((ext_vector_type(2)));

constexpr int NB = 4, SEQ = 4096, TOK = NB * SEQ, DM = 2048, HW = 1024, MW = 1024, NHEAD = 4, DH = 256, FFH = 5632;
constexpr int CONVC = 5120, INCOLS = 11280, NFILT = 4096;
constexpr float RMS_EPS = 1e-6f;
constexpr size_t MiB = 1u << 20;
constexpr size_t WS_BAR = 262144, WS_R1S = 0, WS_SS2 = 65536, WS_SS3 = 131072, WS_G = 1 * MiB, WS_H2 = 2 * MiB;
constexpr size_t WS_WA = 4 * MiB, WS_WB = 8 * MiB, WS_WOUT = 12 * MiB, WS_WGU = 20 * MiB, WS_WD = 64 * MiB, WS_WIN = 86 * MiB, WS_XB = 130 * MiB;
constexpr size_t WS_FILT = 194 * MiB, WS_HY = 258 * MiB, WS_R1A = 354 * MiB, WS_R1B = 418 * MiB, WS_END = 482 * MiB;
constexpr size_t WS_QKP = 86 * MiB, WS_YA = 150 * MiB, WS_YBF = 354 * MiB, WS_YBB = 386 * MiB, WS_X1B = 86 * MiB, WS_MIX = 194 * MiB, WS_HH = 258 * MiB;
constexpr int LDS_BYTES = 155648;

__device__ __forceinline__ unsigned f2bf(float f) { unsigned u = __float_as_uint(f); return (u + 0x7fffu + ((u >> 16) & 1u)) >> 16; }
__device__ __forceinline__ unsigned pk2(float lo, float hi) { unsigned r; asm volatile("v_cvt_pk_bf16_f32 %0, %1, %2" : "=v"(r) : "v"(lo), "v"(hi)); return r; }
__device__ __forceinline__ float bflo(unsigned w) { return __uint_as_float(w << 16); }
__device__ __forceinline__ float bfhi(unsigned w) { return __uint_as_float(w & 0xffff0000u); }
__device__ __forceinline__ float wave_sum(float v) {
#pragma unroll
    for (int o = 1; o < 64; o <<= 1) v += __shfl_xor(v, o);
    return v;
}
__device__ __forceinline__ size_t blk_off(int row, int k, int K) { return ((size_t)(row >> 7) * (size_t)(K >> 6) + (size_t)(k >> 6)) * 8192 + (size_t)((row & 127) * 64 + (k & 63)); }
__device__ __forceinline__ int lane_id_opaque() { int l; asm volatile("v_mbcnt_lo_u32_b32 %0, -1, 0\n\tv_mbcnt_hi_u32_b32 %0, -1, %0" : "=v"(l)); return l; }
__device__ __forceinline__ float sigmoidf_(float x) { return 1.0f / (1.0f + __expf(-x)); }
__device__ __forceinline__ float siluf_(float x) { return x / (1.0f + __expf(-x)); }

namespace pg8 {
constexpr int BM = 256, BK = 64, HALF = 128, HTB = HALF * BK * 2, STAGE_BYTES = 8 * HTB, NXCD = 8, WGM = 8;
__device__ __forceinline__ int lds_byte(int r, int c) { const int st = (r >> 4) * 2 + (c >> 5), rr = r & 15, cc = c & 31, ob = rr * 64 + cc * 2; return st * 1024 + (ob ^ (((ob >> 9) & 1) << 5)); }
__device__ __forceinline__ void stage_rc(int b, int& R, int& C) { const int st = b / 1024, sb = b % 1024, swz = sb ^ (((sb >> 9) & 1) << 5); R = (st >> 1) * 16 + swz / 64; C = (st & 1) * 32 + (swz % 64) / 2; }
__device__ __forceinline__ int perm32(int rho) { const int n = rho >> 4, i = rho & 15; return 8 * (i >> 2) + 4 * n + (i & 3); }
struct GUnit { const char* A; const char* B; int pm, pn, sub; };
__device__ __forceinline__ void tile_of(int L, int nM, int nN, int& pm, int& pn) {
    const int nwg = nM * nN; int wgid = L; { const int q = nwg / NXCD, r = nwg % NXCD, xcd = wgid % NXCD, off = wgid / NXCD; wgid = (xcd < r ? xcd * (q + 1) : r * (q + 1) + (xcd - r) * q) + off; }
    const int nig = WGM * nN, gid = wgid / nig, fm = gid * WGM, gsz = (nM - fm) < WGM ? (nM - fm) : WGM;
    pm = fm + ((wgid % nig) % gsz); pn = (wgid % nig) / gsz;
}
typedef f32x4 Acc[2][2][4][2];
template <class Prog>
__device__ __forceinline__ void gemm_stream(LAS unsigned char* lds, const Prog& P, int wv) {
    int tid = (wv << 6) | lane_id_opaque(); asm volatile("" : "+v"(tid));
    const int wid = __builtin_amdgcn_readfirstlane(tid >> 6), lane = tid & 63, wr = wid >> 2, wc = wid & 3, fr = lane & 15, fq = lane >> 4;
    const int K = P.K, nt = K / BK;
    unsigned voffA[2], voffB[2];
#pragma unroll
    for (int i = 0; i < 2; ++i) { int R, C; stage_rc(tid * 16 + i * 8192, R, C); const int Rb = Prog::PERM ? ((R & ~31) + perm32(R & 31)) : R;
        voffA[i] = (unsigned)(R * 64 + C) * 2u; voffB[i] = (unsigned)(Rb * 64 + C) * 2u; }
    const size_t kstep = (size_t)(HALF * BK * 2);
    const size_t hstep = (size_t)HALF * K * 2;
    const unsigned ldsw = (unsigned)wid * 1024u;
    const int aoff = lds_byte(wr * 64 + fr, fq * 8), boff = lds_byte(wc * 32 + fr, fq * 8);
#define PG8_SA(b, h) (((b) * 2 + (h)) * HTB)
#define PG8_SB(b, h) ((4 + (b) * 2 + (h)) * HTB)
#define PG8_STAGE(bufoff, gbase, voff) do { _Pragma("unroll") for (int _i = 0; _i < 2; ++_i) \
        __builtin_amdgcn_global_load_lds((const unsigned*)((const char*)(gbase) + (voff)[_i]), (LAS unsigned*)(lds + (bufoff) + ldsw + _i * 8192), 16, 0, 0); } while (0)
#define PG8_LDA(dst, b, h) do { _Pragma("unroll") for (int m = 0; m < 4; ++m) _Pragma("unroll") for (int k = 0; k < 2; ++k) dst[m][k] = *(const LAS bf16x8*)(lds + PG8_SA(b, h) + aoff + m * 2048 + k * 1024); } while (0)
#define PG8_LDB(dst, b, h) do { _Pragma("unroll") for (int n = 0; n < 2; ++n) _Pragma("unroll") for (int k = 0; k < 2; ++k) dst[n][k] = *(const LAS bf16x8*)(lds + PG8_SB(b, h) + boff + n * 2048 + k * 1024); } while (0)
#define PG8_MMA(ai, bj, At, Bt) do { __builtin_amdgcn_s_setprio(1); _Pragma("unroll") for (int m = 0; m < 4; ++m) _Pragma("unroll") for (int n = 0; n < 2; ++n) _Pragma("unroll") for (int k = 0; k < 2; ++k) \
        acc[ai][bj][m][n] = __builtin_amdgcn_mfma_f32_16x16x32_bf16(Bt[n][k], At[m][k], acc[ai][bj][m][n], 0, 0, 0); __builtin_amdgcn_s_setprio(0); } while (0)
#define PG8_WAIT_V(n) asm volatile("s_waitcnt vmcnt(" #n ")" ::: "memory")
#define PG8_WAIT_L(n) asm volatile("s_waitcnt lgkmcnt(" #n ")" ::: "memory")
#define PG8_BAR __builtin_amdgcn_s_barrier()
#define PG8_SCHED __builtin_amdgcn_sched_barrier(0)
    GUnit cur, nxt; int ui = 0;
    if (!P.next(0, cur)) return;
    f32x4 acc[2][2][4][2];
#pragma unroll
    for (int a = 0; a < 2; ++a)
#pragma unroll
        for (int b = 0; b < 2; ++b)
#pragma unroll
            for (int m = 0; m < 4; ++m)
#pragma unroll
                for (int n = 0; n < 2; ++n) acc[a][b][m][n] = (f32x4){0.f, 0.f, 0.f, 0.f};
    bf16x8 At[4][2], B0[2][2], B1[2][2];
    const char* cA = cur.A; const char* cB = cur.B;
    PG8_STAGE(PG8_SB(0, 0), cB, voffB); PG8_STAGE(PG8_SA(0, 0), cA, voffA); PG8_STAGE(PG8_SB(0, 1), cB + hstep, voffB); PG8_STAGE(PG8_SA(0, 1), cA + hstep, voffA);
    if (wr == 1) PG8_BAR;
    PG8_WAIT_V(4); PG8_BAR;
    PG8_STAGE(PG8_SB(1, 0), cB + kstep, voffB); PG8_STAGE(PG8_SA(1, 0), cA + kstep, voffA); PG8_STAGE(PG8_SB(1, 1), cB + hstep + kstep, voffB);
    PG8_WAIT_V(6); PG8_BAR;
    for (;;) {
        const bool has_next = P.next(ui + 1, nxt);
        const char* nA = has_next ? nxt.A : cA; const char* nB = has_next ? nxt.B : cB;
        for (int t = 0; t < nt; t += 2) {
            const bool last = (t == nt - 2);
            const char* a1 = cA + (size_t)(t + 1) * kstep;
            const char* a2 = last ? nA : cA + (size_t)(t + 2) * kstep; const char* b2 = last ? nB : cB + (size_t)(t + 2) * kstep;
            const char* a3 = a2 + kstep; const char* b3 = b2 + kstep;
            PG8_LDB(B0, 0, 0); PG8_SCHED; PG8_LDA(At, 0, 0); PG8_STAGE(PG8_SA(1, 1), a1 + hstep, voffA);
            PG8_WAIT_L(8); PG8_BAR; PG8_WAIT_L(0); PG8_MMA(0, 0, At, B0); PG8_BAR; PG8_SCHED;
            PG8_LDB(B1, 0, 1); PG8_STAGE(PG8_SB(0, 0), b2, voffB);
            PG8_BAR; PG8_WAIT_L(0); PG8_MMA(0, 1, At, B1); PG8_BAR;
            PG8_LDA(At, 0, 1); PG8_STAGE(PG8_SA(0, 0), a2, voffA);
            PG8_BAR; PG8_WAIT_L(0); PG8_MMA(1, 0, At, B0); PG8_BAR; PG8_SCHED;
            PG8_STAGE(PG8_SB(0, 1), b2 + hstep, voffB);
            PG8_WAIT_V(6); PG8_BAR; PG8_MMA(1, 1, At, B1); PG8_BAR;
            PG8_LDB(B0, 1, 0); PG8_SCHED; PG8_LDA(At, 1, 0); PG8_STAGE(PG8_SA(0, 1), a2 + hstep, voffA);
            PG8_WAIT_L(8); PG8_BAR; PG8_WAIT_L(0); PG8_MMA(0, 0, At, B0); PG8_BAR; PG8_SCHED;
            PG8_LDB(B1, 1, 1); PG8_STAGE(PG8_SB(1, 0), b3, voffB);
            PG8_BAR; PG8_WAIT_L(0); PG8_MMA(0, 1, At, B1); PG8_BAR;
            PG8_LDA(At, 1, 1); PG8_STAGE(PG8_SA(1, 0), a3, voffA);
            PG8_BAR; PG8_WAIT_L(0); PG8_MMA(1, 0, At, B0); PG8_BAR; PG8_SCHED;
            PG8_STAGE(PG8_SB(1, 1), b3 + hstep, voffB);
            PG8_WAIT_V(6); PG8_BAR; PG8_MMA(1, 1, At, B1); PG8_BAR;
        }
        P.epi(acc, cur, wr, wc, fr, fq);
        if (!has_next) break;
        cur = nxt; cA = nA; cB = nB; ++ui;
    }
    PG8_WAIT_V(0);
    if (wr == 0) PG8_BAR;
    PG8_BAR;
#undef PG8_SA
#undef PG8_SB
#undef PG8_STAGE
#undef PG8_LDA
#undef PG8_LDB
#undef PG8_MMA
#undef PG8_WAIT_V
#undef PG8_WAIT_L
#undef PG8_BAR
#undef PG8_SCHED
}
__device__ __forceinline__ void zero_acc(Acc& acc) {
#pragma unroll
    for (int a = 0; a < 2; ++a)
#pragma unroll
        for (int b = 0; b < 2; ++b)
#pragma unroll
            for (int m = 0; m < 4; ++m)
#pragma unroll
                for (int n = 0; n < 2; ++n) acc[a][b][m][n] = (f32x4){0.f, 0.f, 0.f, 0.f};
}
}
using pg8::GUnit; using pg8::Acc;
struct HyProg {
    static constexpr bool PERM = true; int K, G, c; const bf16_t* W; const bf16_t* X; bf16_t* HY; const float* r1;
    __device__ __forceinline__ bool next(int i, GUnit& u) const { const int L = i * G + c; if (L >= 12 * 64) return false; pg8::tile_of(L, 12, 64, u.pm, u.pn);
        u.A = (const char*)(W + (size_t)u.pm * 256 * DM); u.B = (const char*)(X + (size_t)u.pn * 256 * DM); u.sub = 0; return true; }
    __device__ __forceinline__ void epi(Acc& acc, const GUnit& u, int wr, int wc, int fr, int fq) const {
        const int row0 = u.pm * 256 + wr * 64 + fr, col0 = u.pn * 256 + wc * 32 + 8 * fq;
        f32x4 sc[2][2];
#pragma unroll
        for (int bj = 0; bj < 2; ++bj) { sc[bj][0] = *(const f32x4*)(r1 + col0 + bj * 128); sc[bj][1] = *(const f32x4*)(r1 + col0 + bj * 128 + 4); }
#pragma unroll
        for (int ai = 0; ai < 2; ++ai)
#pragma unroll
            for (int m = 0; m < 4; ++m) { bf16_t* rowp = HY + (size_t)(row0 + ai * 128 + m * 16) * TOK + col0;
#pragma unroll
                for (int bj = 0; bj < 2; ++bj) { const f32x4 v0 = acc[ai][bj][m][0] * sc[bj][0], v1 = acc[ai][bj][m][1] * sc[bj][1];
                    u32x4 w; w.x = pk2(v0[0], v0[1]); w.y = pk2(v0[2], v0[3]); w.z = pk2(v1[0], v1[1]); w.w = pk2(v1[2], v1[3]);
                    *(u32x4*)(rowp + bj * 128) = w; } }
        pg8::zero_acc(acc);
    }
};
struct RestProg {
    static constexpr bool PERM = true; int K, G, c; const bf16_t* W; const bf16_t* X; bf16_t* R1A; bf16_t* R1B; bf16_t* R2; const float* r1;
    __device__ __forceinline__ bool next(int i, GUnit& u) const { const int L = i * G + c; if (L >= 64 * 32) return false; pg8::tile_of(L, 64, 32, u.pm, u.pn);
        u.A = (const char*)(X + (size_t)u.pm * 256 * DM); u.B = (const char*)(W + (size_t)(3072 + u.pn * 256) * DM); u.sub = 0; return true; }
    __device__ __forceinline__ void epi(Acc& acc, const GUnit& u, int wr, int wc, int fr, int fq) const {
        const int row0 = u.pm * 256 + wr * 64 + fr; const bool sg = u.pn >= 12;
        bf16_t* base = u.pn < 8 ? R1A + u.pn * 256 : (u.pn < 16 ? R1B + (u.pn - 8) * 256 : R2 + (u.pn - 16) * 256);
        const int pitch = u.pn < 16 ? 2048 : 4096;
        const int col0 = wc * 32 + 8 * fq;
#pragma unroll
        for (int ai = 0; ai < 2; ++ai)
#pragma unroll
            for (int m = 0; m < 4; ++m) { const int row = row0 + ai * 128 + m * 16; const float s = r1[row]; bf16_t* rowp = base + (size_t)row * pitch + col0;
#pragma unroll
                for (int bj = 0; bj < 2; ++bj) { f32x4 v0 = acc[ai][bj][m][0] * s, v1 = acc[ai][bj][m][1] * s;
                    if (sg) {
#pragma unroll
                        for (int j = 0; j < 4; ++j) { v0[j] = sigmoidf_(v0[j]); v1[j] = sigmoidf_(v1[j]); } }
                    u32x4 w; w.x = pk2(v0[0], v0[1]); w.y = pk2(v0[2], v0[3]); w.z = pk2(v1[0], v1[1]); w.w = pk2(v1[2], v1[3]);
                    *(u32x4*)(rowp + bj * 128) = w; } }
        pg8::zero_acc(acc);
    }
};
struct BranchProg {
    static constexpr bool PERM = true; int K, G, c; const bf16_t *YA, *YBF, *YBB, *WA, *WB; const bf16_t* R2; bf16_t* MIX;
    __device__ __forceinline__ bool next(int i, GUnit& u) const { const int ti = i / 3, sub = i - 3 * ti; const int L = ti * G + c; if (L >= 64 * 8) return false; pg8::tile_of(L, 64, 8, u.pm, u.pn);
        const bf16_t* a = sub == 0 ? YA : (sub == 1 ? YBF : YBB); const bf16_t* b = sub == 0 ? WA : WB;
        u.A = (const char*)(a + (size_t)u.pm * 256 * 1024); u.B = (const char*)(b + (size_t)u.pn * 256 * 1024); u.sub = sub; return true; }
    __device__ __forceinline__ void epi(Acc& acc, const GUnit& u, int wr, int wc, int fr, int fq) const {
        if (u.sub == 1) return;
        const int row0 = u.pm * 256 + wr * 64 + fr, col0 = u.pn * 256 + wc * 32 + 8 * fq;
#pragma unroll
        for (int ai = 0; ai < 2; ++ai)
#pragma unroll
            for (int m = 0; m < 4; ++m) { const int row = row0 + ai * 128 + m * 16; const bf16_t* gp = R2 + (size_t)row * 4096 + col0;
#pragma unroll
                for (int bj = 0; bj < 2; ++bj) {
                    const u32x4 gbw = *(const u32x4*)(gp + 2048 + bj * 128);
                    float gb[8] = {bflo(gbw.x), bfhi(gbw.x), bflo(gbw.y), bfhi(gbw.y), bflo(gbw.z), bfhi(gbw.z), bflo(gbw.w), bfhi(gbw.w)};
                    if (u.sub == 0) {
                        const u32x4 gaw = *(const u32x4*)(gp + bj * 128);
                        float ga[8] = {bflo(gaw.x), bfhi(gaw.x), bflo(gaw.y), bfhi(gaw.y), bflo(gaw.z), bfhi(gaw.z), bflo(gaw.w), bfhi(gaw.w)};
#pragma unroll
                        for (int j = 0; j < 4; ++j) { acc[ai][bj][m][0][j] *= ga[j] / fmaxf(gb[j], 1e-30f); acc[ai][bj][m][1][j] *= ga[4 + j] / fmaxf(gb[4 + j], 1e-30f); }
                    } else {
                        f32x4 v0 = acc[ai][bj][m][0], v1 = acc[ai][bj][m][1];
#pragma unroll
                        for (int j = 0; j < 4; ++j) { v0[j] *= fmaxf(gb[j], 1e-30f); v1[j] *= fmaxf(gb[4 + j], 1e-30f); }
                        u32x4 w; w.x = pk2(v0[0], v0[1]); w.y = pk2(v0[2], v0[3]); w.z = pk2(v1[0], v1[1]); w.w = pk2(v1[2], v1[3]);
                        *(u32x4*)(MIX + blk_off(row, col0 + bj * 128, DM)) = w;
                    } } }
        if (u.sub == 2) pg8::zero_acc(acc);
    }
};
struct ResProg {
    static constexpr bool PERM = false; int K, G, c; const bf16_t* A; const bf16_t* B; const float* base; float* out; bf16_t* outb; float* ss;
    __device__ __forceinline__ bool next(int i, GUnit& u) const { const int L = i * G + c; if (L >= 64 * 8) return false; pg8::tile_of(L, 64, 8, u.pm, u.pn);
        u.A = (const char*)(A + (size_t)u.pm * 256 * K); u.B = (const char*)(B + (size_t)u.pn * 256 * K); u.sub = 0; return true; }
    __device__ __forceinline__ void epi(Acc& acc, const GUnit& u, int wr, int wc, int fr, int fq) const {
        const int row0 = u.pm * 256 + wr * 64 + fr, col0 = u.pn * 256 + wc * 32 + 4 * fq;
#pragma unroll
        for (int ai = 0; ai < 2; ++ai)
#pragma unroll
            for (int m = 0; m < 4; ++m) { const int row = row0 + ai * 128 + m * 16; const size_t off = (size_t)row * DM + col0; float s = 0.f;
#pragma unroll
                for (int bj = 0; bj < 2; ++bj)
#pragma unroll
                    for (int n = 0; n < 2; ++n) { const f32x4 bs = *(const f32x4*)(base + off + bj * 128 + n * 16); const f32x4 o = bs + acc[ai][bj][m][n];
                        *(f32x4*)(out + off + bj * 128 + n * 16) = o; s += (o[0] * o[0] + o[1] * o[1]) + (o[2] * o[2] + o[3] * o[3]);
                        if (outb) { u32x2 w; w.x = pk2(o[0], o[1]); w.y = pk2(o[2], o[3]); *(u32x2*)(outb + blk_off(row, col0 + bj * 128 + n * 16, DM)) = w; } }
                s += __shfl_xor(s, 16); s += __shfl_xor(s, 32);
                if (fq == 0) unsafeAtomicAdd(ss + row, s); }
        pg8::zero_acc(acc);
    }
};
struct GuProg {
    static constexpr bool PERM = true; int K, G, c; const bf16_t* X; const bf16_t* W; bf16_t* HH; const float* ss2;
    __device__ __forceinline__ bool next(int i, GUnit& u) const { const int L = i * G + c; if (L >= 64 * 44) return false; pg8::tile_of(L, 64, 44, u.pm, u.pn);
        u.A = (const char*)(X + (size_t)u.pm * 256 * DM); u.B = (const char*)(W + (size_t)u.pn * 256 * DM); u.sub = 0; return true; }
    __device__ __forceinline__ void epi(Acc& acc, const GUnit& u, int wr, int wc, int fr, int fq) const {
        const int row0 = u.pm * 256 + wr * 64 + fr, col0 = u.pn * 128 + wc * 32 + 8 * fq;
#pragma unroll
        for (int ai = 0; ai < 2; ++ai)
#pragma unroll
            for (int m = 0; m < 4; ++m) { const int row = row0 + ai * 128 + m * 16; const float r2 = 1.0f / sqrtf(ss2[row] * (1.0f / DM) + RMS_EPS);
                float hv[8];
#pragma unroll
                for (int n = 0; n < 2; ++n)
#pragma unroll
                    for (int j = 0; j < 4; ++j) { const float g = acc[ai][0][m][n][j] * r2, uu = acc[ai][1][m][n][j] * r2; hv[4 * n + j] = siluf_(g) * uu; }
                u32x4 w; w.x = pk2(hv[0], hv[1]); w.y = pk2(hv[2], hv[3]); w.z = pk2(hv[4], hv[5]); w.w = pk2(hv[6], hv[7]);
                *(u32x4*)(HH + blk_off(row, col0, FFH)) = w; }
        pg8::zero_acc(acc);
    }
};
struct Ctx {
    const float* in[21]; float* out; unsigned char* ws;
};
__device__ __forceinline__ void p0_transpose_item(const float* W, int Nsrc, int K, bf16_t* WT, int dst_row0, int src_col0, const float* kscale, LAS float* scr, int kb, int lane) {
    const int k0 = 64 * kb;
    float tv[32];
    const float* wp = W + (size_t)(k0 + (lane >> 5)) * Nsrc + src_col0 + (lane & 31);
#pragma unroll
    for (int i = 0; i < 32; ++i) tv[i] = wp[(size_t)(2 * i) * Nsrc];
    if (kscale) {
#pragma unroll
        for (int i = 0; i < 32; ++i) tv[i] *= kscale[k0 + 2 * i + (lane >> 5)]; }
#pragma unroll
    for (int i = 0; i < 32; ++i) scr[(2 * i + (lane >> 5)) * 33 + (lane & 31)] = tv[i];
    asm volatile("s_waitcnt lgkmcnt(0)" ::: "memory");
    const int c = lane & 7;
#pragma unroll
    for (int j = 0; j < 4; ++j) { const int n = (lane >> 3) + 8 * j; const LAS float* s = scr + (8 * c) * 33 + n;
        u32x4 o; o.x = pk2(s[0 * 33], s[1 * 33]); o.y = pk2(s[2 * 33], s[3 * 33]); o.z = pk2(s[4 * 33], s[5 * 33]); o.w = pk2(s[6 * 33], s[7 * 33]);
        *(u32x4*)(WT + blk_off(dst_row0 + n, k0 + 8 * c, K)) = o; }
    asm volatile("s_waitcnt lgkmcnt(0)" ::: "memory");
}
__device__ __forceinline__ void p0_prologue(const Ctx& C, LAS unsigned char* lds, int G, int wv) {
    int tid = (wv << 6) | lane_id_opaque(); asm volatile("" : "+v"(tid));
    const int lane = tid & 63, wave = __builtin_amdgcn_readfirstlane(tid >> 6);
    const int gw = blockIdx.x * 8 + wave, NGW = G * 8;
    unsigned char* ws = C.ws;
    LAS float* scr = (LAS float*)(lds + wave * 8704);
    constexpr int I_IN = 32 * 352, I_A = 16 * 64, I_O = 32 * 64, I_GU = 32 * 352, I_D = 88 * 64;
    constexpr int NIT = I_IN + 2 * I_A + I_O + I_GU + I_D;
    for (int it = gw; it < NIT; it += NGW) {
        int r = it;
        if (r < I_IN) { const int kb = r / 352, nb = r % 352, n0 = nb * 32; const int src = n0 < 7168 ? n0 : n0 + 16;
            p0_transpose_item(C.in[2], INCOLS, DM, (bf16_t*)(ws + WS_WIN), n0, src, C.in[1], scr, kb, lane); continue; } r -= I_IN;
        if (r < I_A) { p0_transpose_item(C.in[14], DM, HW, (bf16_t*)(ws + WS_WA), (r % 64) * 32, (r % 64) * 32, nullptr, scr, r / 64, lane); continue; } r -= I_A;
        if (r < I_A) { p0_transpose_item(C.in[15], DM, MW, (bf16_t*)(ws + WS_WB), (r % 64) * 32, (r % 64) * 32, nullptr, scr, r / 64, lane); continue; } r -= I_A;
        if (r < I_O) { p0_transpose_item(C.in[16], DM, DM, (bf16_t*)(ws + WS_WOUT), (r % 64) * 32, (r % 64) * 32, nullptr, scr, r / 64, lane); continue; } r -= I_O;
        if (r < I_GU) { const int kb = r / 352, nb = r % 352, n0 = nb * 32; const int pn = n0 >> 8, half = (n0 >> 7) & 1, i = n0 & 127;
            p0_transpose_item(C.in[18], 2 * FFH, DM, (bf16_t*)(ws + WS_WGU), n0, half * FFH + 128 * pn + i, C.in[17], scr, kb, lane); continue; } r -= I_GU;
        p0_transpose_item(C.in[19], DM, FFH, (bf16_t*)(ws + WS_WD), (r % 64) * 32, (r % 64) * 32, nullptr, scr, r / 64, lane);
    }
    for (int i = blockIdx.x * 512 + tid; i < TOK; i += G * 512) { ((float*)(ws + WS_SS2))[i] = 0.f; ((float*)(ws + WS_SS3))[i] = 0.f; }
    {
        const float* w1 = C.in[5]; const float* b1 = C.in[6]; const float* f1 = C.in[7]; const float* w2 = C.in[8]; const float* b2 = C.in[9]; const float* f2 = C.in[10];
        float* h2 = (float*)(ws + WS_H2);
        for (int t = gw; t < SEQ; t += NGW) {
            const float tl = (float)t / (float)(SEQ - 1);
            const float omega = 6.283185307179586f * (float)t / (float)SEQ;
            float a = b1[lane] + tl * w1[lane];
            float sn, cs;
            { const int bi = lane & 15; const float fr = 1e-4f + (float)bi * ((15.0f - 1e-4f) / 15.0f); sincosf(omega * fr, &sn, &cs); }
#pragma unroll
            for (int i = 0; i < 16; ++i) a += __shfl(cs, i) * w1[(1 + i) * 64 + lane] - __shfl(sn, i) * w1[(17 + i) * 64 + lane];
            const float h1 = sinf(f1[lane] * a);
            float a2 = b2[lane];
#pragma unroll 8
            for (int i = 0; i < 64; ++i) a2 += __shfl(h1, i) * w2[i * 64 + lane];
            h2[t * 64 + lane] = sinf(f2[lane] * a2);
        }
    }
    __syncthreads();
    {
        constexpr int WGP = 2056;
        LAS bf16_t* wgb = (LAS bf16_t*)lds;
        const float* w_in = C.in[2]; const float* nw = C.in[1];
#pragma unroll 1
        for (int i0 = tid; i0 < DM * 16; i0 += 512 * 16) { float tw[16], tn[16];
#pragma unroll
            for (int u = 0; u < 16; ++u) { const int i = i0 + 512 * u, k = i >> 4, g = i & 15; tw[u] = w_in[(size_t)k * INCOLS + 7168 + g]; tn[u] = nw[k]; }
#pragma unroll
            for (int u = 0; u < 16; ++u) { const int i = i0 + 512 * u, k = i >> 4, g = i & 15; wgb[g * WGP + k] = (bf16_t)f2bf(tw[u] * tn[u]); } }
        __syncthreads();
        const float* x = C.in[0]; bf16_t* xb = (bf16_t*)(ws + WS_XB); float* r1 = (float*)(ws + WS_R1S); float* Gt = (float*)(ws + WS_G); const float* gbias = C.in[13];
        const int r = lane & 15, g = lane >> 4; const bool act = r < 8;
        for (int rb = gw; rb < TOK / 8; rb += NGW) {
            const int row = rb * 8 + (r & 7);
            const float* xp = x + (size_t)row * DM + 8 * g;
            f32x4 acc = {0.f, 0.f, 0.f, 0.f}; float ss = 0.f;
#pragma unroll 8
            for (int kk = 0; kk < 64; ++kk) {
                const f32x4 a = *(const f32x4*)(xp + 32 * kk), b = *(const f32x4*)(xp + 32 * kk + 4);
                ss += ((a.x * a.x + a.y * a.y) + (a.z * a.z + a.w * a.w)) + ((b.x * b.x + b.y * b.y) + (b.z * b.z + b.w * b.w));
                u32x4 o; o.x = pk2(a.x, a.y); o.y = pk2(a.z, a.w); o.z = pk2(b.x, b.y); o.w = pk2(b.z, b.w);
                *(u32x4*)(xb + blk_off(row, 32 * kk + 8 * g, DM)) = o;
                if (!act) { o.x = 0u; o.y = 0u; o.z = 0u; o.w = 0u; }
                const bf16x8 bw = *(const LAS bf16x8*)(wgb + r * WGP + 32 * kk + 8 * g);
                acc = __builtin_amdgcn_mfma_f32_16x16x32_bf16(__builtin_bit_cast(bf16x8, o), bw, acc, 0, 0, 0);
            }
            ss += __shfl_xor(ss, 16); ss += __shfl_xor(ss, 32);
            const float rinv = 1.0f / sqrtf(ss * (1.0f / DM) + RMS_EPS);
            const float gb = gbias[r];
#pragma unroll
            for (int i = 0; i < 4; ++i) { const int m = 4 * g + i; const float rv = __shfl(rinv, m & 7); if (g < 2) Gt[(size_t)(rb * 8 + m) * 16 + r] = acc[i] * rv + gb; }
            if (lane < 8) r1[rb * 8 + lane] = rinv;
        }
    }
}
__device__ __forceinline__ void p1_filters(const Ctx& C, LAS unsigned char* lds, int G, int wv) {
    int tid = (wv << 6) | lane_id_opaque(); asm volatile("" : "+v"(tid));
    LAS float* w3s = (LAS float*)lds;
    const float* w3 = C.in[11]; const float* h2 = (const float*)(C.ws + WS_H2); float* FILT = (float*)(C.ws + WS_FILT);
    for (int item = blockIdx.x; item < 256; item += G) {
        const int ntile = item >> 2, tt = item & 3, t0 = 1024 * tt + tid, t1 = t0 + 512;
        __syncthreads();
        for (int i = tid; i < 4096; i += 512) w3s[i] = w3[(size_t)(i >> 6) * NFILT + 64 * ntile + (i & 63)];
        __syncthreads();
        f32x4 hr0[16], hr1[16];
#pragma unroll
        for (int j = 0; j < 16; ++j) { hr0[j] = *(const f32x4*)(h2 + (size_t)t0 * 64 + 4 * j); hr1[j] = *(const f32x4*)(h2 + (size_t)t1 * 64 + 4 * j); }
        const float tl0 = (float)t0 / (float)(SEQ - 1), tl1 = (float)t1 / (float)(SEQ - 1);
#pragma unroll 1
        for (int n4 = 0; n4 < 16; ++n4) {
            float a[4] = {0.f, 0.f, 0.f, 0.f}, c[4] = {0.f, 0.f, 0.f, 0.f};
#pragma unroll
            for (int j = 0; j < 16; ++j) {
#pragma unroll
                for (int jj = 0; jj < 4; ++jj) { const f32x4 wv = *(const LAS f32x4*)(w3s + (4 * j + jj) * 64 + 4 * n4); const float hv = hr0[j][jj], hw = hr1[j][jj];
                    a[0] = fmaf(hv, wv.x, a[0]); a[1] = fmaf(hv, wv.y, a[1]); a[2] = fmaf(hv, wv.z, a[2]); a[3] = fmaf(hv, wv.w, a[3]);
                    c[0] = fmaf(hw, wv.x, c[0]); c[1] = fmaf(hw, wv.y, c[1]); c[2] = fmaf(hw, wv.z, c[2]); c[3] = fmaf(hw, wv.w, c[3]); }
            }
#pragma unroll
            for (int e = 0; e < 4; ++e) { const int n = 64 * ntile + 4 * n4 + e, ch = n & 1023;
                const float mind = -3.0701134573253945f, maxd = -15.350567286626973f;
                const float delta = fabsf(mind + (float)ch * ((maxd - mind) / 1023.0f));
                FILT[(size_t)n * SEQ + t0] = a[e] * expf(-tl0 * delta); FILT[(size_t)n * SEQ + t1] = c[e] * expf(-tl1 * delta); }
        }
    }
    __syncthreads();
}
__device__ __forceinline__ void p7_final(const Ctx& C, int G, int wv) {
    int tid = (wv << 6) | lane_id_opaque(); asm volatile("" : "+v"(tid));
    const int lane = tid & 63, wave = tid >> 6, gw = blockIdx.x * 8 + wave, NGW = G * 8;
    const float* ss3 = (const float*)(C.ws + WS_SS3); const float* wf = C.in[20];
    f32x4 w[8];
#pragma unroll
    for (int j = 0; j < 8; ++j) w[j] = ((const f32x4*)wf)[64 * j + lane];
    for (int row = gw; row < TOK; row += 2 * NGW) {
        const int row2 = row + NGW;
        const bool has2 = row2 < TOK;
        const float r = 1.0f / sqrtf(ss3[row] * (1.0f / DM) + RMS_EPS), r2 = has2 ? 1.0f / sqrtf(ss3[row2] * (1.0f / DM) + RMS_EPS) : 0.f;
        f32x4* p = (f32x4*)(C.out + (size_t)row * DM) + lane; f32x4* p2 = (f32x4*)(C.out + (size_t)(has2 ? row2 : row) * DM) + lane;
        f32x4 v[8], u[8];
#pragma unroll
        for (int j = 0; j < 8; ++j) { v[j] = p[64 * j]; u[j] = p2[64 * j]; }
#pragma unroll
        for (int j = 0; j < 8; ++j) p[64 * j] = v[j] * r * w[j];
        if (has2) {
#pragma unroll
            for (int j = 0; j < 8; ++j) p2[64 * j] = u[j] * r2 * w[j]; }
    }
}
#ifndef FFT_HOST
#define FFT_DEV __device__ __forceinline__
#define FFT_PTR LAS f32x2*
#define FFT_SIN(x) __builtin_amdgcn_sinf(x)
#define FFT_COS(x) __builtin_amdgcn_cosf(x)
#else
#define FFT_DEV static inline
#define FFT_PTR f32x2*
#define FFT_SIN(x) sinf(6.283185307179586f * (x))
#define FFT_COS(x) cosf(6.283185307179586f * (x))
#endif
#define PADI(i) ((i) + ((i) >> 4))
FFT_DEV f32x2 cmul(f32x2 a, f32x2 b) { f32x2 r; r.x = a.x * b.x - a.y * b.y; r.y = a.x * b.y + a.y * b.x; return r; }
FFT_DEV f32x2 cmulc(f32x2 a, f32x2 b) { f32x2 r; r.x = a.x * b.x + a.y * b.y; r.y = a.y * b.x - a.x * b.y; return r; }
FFT_DEV f32x2 twid(float frac) { f32x2 r; r.x = FFT_COS(frac); r.y = -FFT_SIN(frac); return r; }
template <int M, int CJ> FFT_DEV f32x2 rot8(f32x2 d) {
    const float R = 0.70710678118654752f; f32x2 r;
    if (M == 0) return d;
    if (M == 2) { if (!CJ) { r.x = d.y; r.y = -d.x; } else { r.x = -d.y; r.y = d.x; } return r; }
    if (M == 1) { if (!CJ) { r.x = R * (d.x + d.y); r.y = R * (d.y - d.x); } else { r.x = R * (d.x - d.y); r.y = R * (d.x + d.y); } return r; }
    if (!CJ) { r.x = R * (d.y - d.x); r.y = -R * (d.x + d.y); } else { r.x = -R * (d.x + d.y); r.y = R * (d.x - d.y); } return r;
}
template <int INV, int ZHI, int LOW> FFT_DEV void fft_r8_pass(FFT_PTR buf, int s, int ls  , int tid) {
#pragma unroll
    for (int rep = 0; rep < 2; ++rep) {
        const int bf = tid + rep * 512, j = bf & (s - 1), blk = bf >> ls, base = blk * 8 * s + j;
        f32x2 x[8];
#pragma unroll
        for (int m = 0; m < (ZHI ? 4 : 8); ++m) x[m] = buf[PADI(base + m * s)];
        f32x2 w1 = twid((float)j / (float)(8 * s));
        f32x2 w2 = cmul(w1, w1), w4 = cmul(w2, w2);
        if (!INV) {
            if (ZHI) {
                x[4] = cmul(x[0], w1); x[5] = cmul(rot8<1, 0>(x[1]), w1); x[6] = cmul(rot8<2, 0>(x[2]), w1); x[7] = cmul(rot8<3, 0>(x[3]), w1);
            } else {
                { f32x2 a = x[0], b = x[4]; x[0] = a + b; x[4] = cmul(a - b, w1); }
                { f32x2 a = x[1], b = x[5]; x[1] = a + b; x[5] = cmul(rot8<1, 0>(a - b), w1); }
                { f32x2 a = x[2], b = x[6]; x[2] = a + b; x[6] = cmul(rot8<2, 0>(a - b), w1); }
                { f32x2 a = x[3], b = x[7]; x[3] = a + b; x[7] = cmul(rot8<3, 0>(a - b), w1); }
            }
#pragma unroll
            for (int h = 0; h < 8; h += 4) {
                { f32x2 a = x[h], b = x[h + 2]; x[h] = a + b; x[h + 2] = cmul(a - b, w2); }
                { f32x2 a = x[h + 1], b = x[h + 3]; x[h + 1] = a + b; x[h + 3] = cmul(rot8<2, 0>(a - b), w2); }
            }
#pragma unroll
            for (int m = 0; m < 8; m += 2) { f32x2 a = x[m], b = x[m + 1]; x[m] = a + b; x[m + 1] = cmul(a - b, w4); }
        } else {
#pragma unroll
            for (int m = 0; m < 8; m += 2) { f32x2 a = x[m], b = cmulc(x[m + 1], w4); x[m] = a + b; x[m + 1] = a - b; }
#pragma unroll
            for (int h = 0; h < 8; h += 4) {
                { f32x2 a = x[h], b = cmulc(x[h + 2], w2); x[h] = a + b; x[h + 2] = a - b; }
                { f32x2 a = x[h + 1], b = rot8<2, 1>(cmulc(x[h + 3], w2)); x[h + 1] = a + b; x[h + 3] = a - b; }
            }
            { f32x2 a = x[0], b = cmulc(x[4], w1); x[0] = a + b; if (!LOW) x[4] = a - b; }
            { f32x2 a = x[1], b = rot8<1, 1>(cmulc(x[5], w1)); x[1] = a + b; if (!LOW) x[5] = a - b; }
            { f32x2 a = x[2], b = rot8<2, 1>(cmulc(x[6], w1)); x[2] = a + b; if (!LOW) x[6] = a - b; }
            { f32x2 a = x[3], b = rot8<3, 1>(cmulc(x[7], w1)); x[3] = a + b; if (!LOW) x[7] = a - b; }
        }
#pragma unroll
        for (int m = 0; m < (LOW ? 4 : 8); ++m) buf[PADI(base + m * s)] = x[m];
    }
}
FFT_DEV void fft_r2_span1(FFT_PTR buf, int tid) {
#pragma unroll
    for (int rep = 0; rep < 8; ++rep) { const int p = 2 * (tid + rep * 512); f32x2 a = buf[PADI(p)], b = buf[PADI(p + 1)]; buf[PADI(p)] = a + b; buf[PADI(p + 1)] = a - b; }
}
#ifndef FFT_HOST
#define FFT_SYNC() __syncthreads()
template <int ZHI> __device__ __forceinline__ void fft_fwd(FFT_PTR buf, int tid) {
    FFT_SYNC(); fft_r8_pass<0, ZHI, 0>(buf, 1024, 10, tid); FFT_SYNC(); fft_r8_pass<0, 0, 0>(buf, 128, 7, tid); FFT_SYNC(); fft_r8_pass<0, 0, 0>(buf, 16, 4, tid); FFT_SYNC();
    fft_r8_pass<0, 0, 0>(buf, 2, 1, tid); FFT_SYNC(); fft_r2_span1(buf, tid); FFT_SYNC();
}
template <int LOW> __device__ __forceinline__ void fft_inv(FFT_PTR buf, int tid) {
    FFT_SYNC(); fft_r2_span1(buf, tid); FFT_SYNC(); fft_r8_pass<1, 0, 0>(buf, 2, 1, tid); FFT_SYNC(); fft_r8_pass<1, 0, 0>(buf, 16, 4, tid); FFT_SYNC();
    fft_r8_pass<1, 0, 0>(buf, 128, 7, tid); FFT_SYNC(); fft_r8_pass<1, 0, LOW>(buf, 1024, 10, tid); FFT_SYNC();
}
#endif
FFT_DEV unsigned brev13(unsigned p) {
    unsigned r = 0;
#ifndef FFT_HOST
    r = __brev(p) >> 19;
#else
    for (int i = 0; i < 13; ++i) r |= ((p >> i) & 1u) << (12 - i);
#endif
    return r;
}
FFT_DEV void fft_pointwise(FFT_PTR wb, FFT_PTR zk, int which, int tid) {
#pragma unroll 4
    for (int rep = 0; rep < 16; ++rep) {
        const unsigned p = tid + rep * 512, f = brev13(p), fn = (8192u - f) & 8191u, pn = brev13(fn);
        const f32x2 zf = zk[PADI(p)], zn = zk[PADI(pn)];
        f32x2 kf;
        if (which == 0) { kf.x = 0.5f * (zf.x + zn.x); kf.y = 0.5f * (zf.y - zn.y); }
        else            { kf.x = 0.5f * (zf.y + zn.y); kf.y = 0.5f * (zn.x - zf.x); }
        wb[PADI(p)] = cmul(wb[PADI(p)], kf);
    }
}
__device__ __forceinline__ void unpack8(u32x4 w, float (&f)[8]) { f[0] = bflo(w.x); f[1] = bfhi(w.x); f[2] = bflo(w.y); f[3] = bfhi(w.y); f[4] = bflo(w.z); f[5] = bfhi(w.z); f[6] = bflo(w.w); f[7] = bfhi(w.w); }
__device__ __forceinline__ void qk_prepass(const Ctx& C, int G, int wv) {
    int tid = (wv << 6) | lane_id_opaque(); asm volatile("" : "+v"(tid));
    const bf16_t* R1A = (const bf16_t*)(C.ws + WS_R1A); bf16_t* QKP = (bf16_t*)(C.ws + WS_QKP);
    const float* cw = C.in[3]; const float* cb = C.in[4];
    const int cg8 = tid & 255, half = tid >> 8, col = 8 * cg8;
    float k0[8], k1[8], k2[8], kb[8];
    { const int ch = 3072 + col;
      const f32x4 t0 = *(const f32x4*)(cw + ch), t1 = *(const f32x4*)(cw + ch + 4), t2 = *(const f32x4*)(cw + CONVC + ch), t3 = *(const f32x4*)(cw + CONVC + ch + 4);
      const f32x4 t4 = *(const f32x4*)(cw + 2 * CONVC + ch), t5 = *(const f32x4*)(cw + 2 * CONVC + ch + 4), t6 = *(const f32x4*)(cb + ch), t7 = *(const f32x4*)(cb + ch + 4);
#pragma unroll
      for (int e = 0; e < 4; ++e) { k0[e] = t0[e]; k0[4 + e] = t1[e]; k1[e] = t2[e]; k1[4 + e] = t3[e]; k2[e] = t4[e]; k2[4 + e] = t5[e]; kb[e] = t6[e]; kb[4 + e] = t7[e]; } }
    const float osc = col >= 1024 ? 0.0625f : 1.0f;
    for (int run = blockIdx.x; run < TOK / 64; run += G) {
        const int row0 = run * 64 + half * 32;
#pragma unroll 4
        for (int i = 0; i < 32; ++i) {
            const int row = row0 + i, t = row & (SEQ - 1);
            const bf16_t* p = R1A + (size_t)row * 2048 + col;
            const u32x4 z = {0u, 0u, 0u, 0u};
            u32x4 w0 = *(const u32x4*)(t > 0 ? p - 2048 : p), w1 = *(const u32x4*)p, w2 = *(const u32x4*)(t < SEQ - 1 ? p + 2048 : p);
            if (t == 0) w0 = z; if (t == SEQ - 1) w2 = z;
            float a0[8], a1[8], a2[8]; unpack8(w0, a0); unpack8(w1, a1); unpack8(w2, a2);
            float v[8];
#pragma unroll
            for (int e = 0; e < 8; ++e) v[e] = siluf_(k0[e] * a0[e] + k1[e] * a1[e] + k2[e] * a2[e] + kb[e]) * osc;
            u32x4 o; o.x = pk2(v[0], v[1]); o.y = pk2(v[2], v[3]); o.z = pk2(v[4], v[5]); o.w = pk2(v[6], v[7]);
            *(u32x4*)(QKP + (size_t)row * 2048 + col) = o;
        }
    }
}
constexpr int ML_KS = 0, ML_KP = 528, ML_SS = 76032, ML_SP = 272, ML_VS = 110848, ML_VP = 80, ML_VW = 121088, ML_CS = 131328, ML_CP = 528, ML_SC = 148224;
static_assert(ML_SC + 7 * 512 + 64 <= LDS_BYTES - 16, "mLSTM LDS map");
__device__ __forceinline__ bf16x8 tr_read2(unsigned a0, unsigned a1) {
    bf16x4 lo, hi;
    asm volatile("ds_read_b64_tr_b16 %0, %2\n\tds_read_b64_tr_b16 %1, %3\n\ts_waitcnt lgkmcnt(0)" : "=&v"(lo), "=&v"(hi) : "v"(a0), "v"(a1) : "memory");
    bf16x8 r; r[0] = lo[0]; r[1] = lo[1]; r[2] = lo[2]; r[3] = lo[3]; r[4] = hi[0]; r[5] = hi[1]; r[6] = hi[2]; r[7] = hi[3]; return r;
}
__device__ __forceinline__ bf16x8 cat4(bf16x4 lo, bf16x4 hi) { bf16x8 r; r[0] = lo[0]; r[1] = lo[1]; r[2] = lo[2]; r[3] = lo[3]; r[4] = hi[0]; r[5] = hi[1]; r[6] = hi[2]; r[7] = hi[3]; return r; }
__device__ __forceinline__ void tr_read2x2(unsigned a, unsigned b, unsigned d, bf16x8& ra, bf16x8& rb) {
    bf16x4 l0, h0, l1, h1;
    asm volatile("ds_read_b64_tr_b16 %0, %4\n\tds_read_b64_tr_b16 %1, %5\n\tds_read_b64_tr_b16 %2, %6\n\tds_read_b64_tr_b16 %3, %7\n\ts_waitcnt lgkmcnt(0)"
        : "=&v"(l0), "=&v"(h0), "=&v"(l1), "=&v"(h1) : "v"(a), "v"(a + d), "v"(b), "v"(b + d) : "memory");
    ra = cat4(l0, h0); rb = cat4(l1, h1);
}
__device__ __forceinline__ void tr_read4x2(unsigned a, unsigned b, unsigned d, unsigned c, unsigned e, unsigned d2, bf16x8& ra, bf16x8& rb, bf16x8& rc, bf16x8& re) {
    bf16x4 l0, h0, l1, h1, l2, h2, l3, h3;
    asm volatile("ds_read_b64_tr_b16 %0, %8\n\tds_read_b64_tr_b16 %1, %9\n\tds_read_b64_tr_b16 %2, %10\n\tds_read_b64_tr_b16 %3, %11\n\t"
                 "ds_read_b64_tr_b16 %4, %12\n\tds_read_b64_tr_b16 %5, %13\n\tds_read_b64_tr_b16 %6, %14\n\tds_read_b64_tr_b16 %7, %15\n\ts_waitcnt lgkmcnt(0)"
        : "=&v"(l0), "=&v"(h0), "=&v"(l1), "=&v"(h1), "=&v"(l2), "=&v"(h2), "=&v"(l3), "=&v"(h3)
        : "v"(a), "v"(a + d), "v"(b), "v"(b + d), "v"(c), "v"(c + d2), "v"(e), "v"(e + d2) : "memory");
    ra = cat4(l0, h0); rb = cat4(l1, h1); rc = cat4(l2, h2); re = cat4(l3, h3);
}
__device__ __forceinline__ float bf2f(short s) { return __uint_as_float(((unsigned)(unsigned short)s) << 16); }
__device__ __forceinline__ float logsigmoidf_(float x) { return fminf(x, 0.f) - log1pf(expf(-fabsf(x))); }

__device__ __forceinline__ void mlstm_item(const Ctx& C, LAS unsigned char* lds, int item, int wv) {
    int tid = (wv << 6) | lane_id_opaque(); asm volatile("" : "+v"(tid));
    const int lane = tid & 63, w = __builtin_amdgcn_readfirstlane(tid >> 6), r = lane & 15, g = lane >> 4, q4 = r >> 2, p4 = r & 3;
    const int vs = item & 7, dir = (item >> 3) & 1, bh = item >> 4, b = bh >> 2, h = bh & 3;
    const bf16_t* QKP = (const bf16_t*)(C.ws + WS_QKP); const bf16_t* R1B = (const bf16_t*)(C.ws + WS_R1B); const float* Gt = (const float*)(C.ws + WS_G);
    bf16_t* Y = (bf16_t*)(C.ws + (dir ? WS_YBB : WS_YBF));
    LAS float* SC = (LAS float*)(lds + ML_SC);
    LAS float* s_cs = SC, *s_rj = SC + 128, *s_iw = SC + 256, *s_emj = SC + 384, *s_w = SC + 512, *s_dn = SC + 640, *s_misc = SC + 768;
    const unsigned lbase = (unsigned)(size_t)lds;
    const int pc = tid & 31, krow = tid >> 5, vrow = tid >> 2, pv = tid & 3;
    const int sw = w < 4 ? w : 11 - w;
    for (int i = tid; i < 16896 / 4; i += 512) ((LAS unsigned*)(lds + ML_CS))[i] = 0u;
    for (int i = tid; i < 16 * ML_KP / 4; i += 512) ((LAS unsigned*)(lds + ML_KS + 128 * ML_KP))[i] = 0u;
    f32x4 Cacc[3][2];
#pragma unroll
    for (int a = 0; a < 3; ++a) { Cacc[a][0] = (f32x4){0.f, 0.f, 0.f, 0.f}; Cacc[a][1] = (f32x4){0.f, 0.f, 0.f, 0.f}; }
    float m_prev = 0.f;
    u32x4 kreg[8], vreg, qn[8]; float ipn = 0.f, fpn = 0.f;
#define ML_TOK(c_, j_) ((size_t)b * SEQ + (dir ? SEQ - 1 - ((c_) * 128 + (j_)) : ((c_) * 128 + (j_))))
#define ML_PREFETCH(c_) do { \
        _Pragma("unroll") for (int i = 0; i < 8; ++i) kreg[i] = *(const u32x4*)(QKP + ML_TOK(c_, krow + 16 * i) * 2048 + 1024 + h * 256 + 8 * pc); \
        vreg = *(const u32x4*)(R1B + ML_TOK(c_, vrow) * 2048 + h * 256 + vs * 32 + 8 * pv); \
        { const bf16_t* qp = QKP + ML_TOK(c_, 16 * sw + r) * 2048 + h * 256 + 8 * g; _Pragma("unroll") for (int kk = 0; kk < 8; ++kk) qn[kk] = *(const u32x4*)(qp + 32 * kk); } \
        if (tid < 128) { const size_t tk = ML_TOK(c_, tid); ipn = Gt[tk * 16 + (dir * 2) * 4 + h]; fpn = Gt[tk * 16 + (dir * 2 + 1) * 4 + h]; } } while (0)
    ML_PREFETCH(0);
    __syncthreads();
#define ML_BAR() do { asm volatile("s_waitcnt lgkmcnt(0)" ::: "memory"); __builtin_amdgcn_s_barrier(); asm volatile("" ::: "memory"); } while (0)
#pragma unroll 1
    for (int c = 0; c < 32; ++c) {
        float xs = 0.f, csv = 0.f, pmx = 0.f, bcum = 0.f; const float ip = ipn;
        if (tid < 128) {
            xs = logsigmoidf_(fpn);
#pragma unroll
            for (int o = 1; o < 64; o <<= 1) { const float y = __shfl_up(xs, o); if (lane >= o) xs += y; }
            if (tid == 63) s_misc[0] = xs;
        }
        ML_BAR();
        if (tid < 128) {
            bcum = xs + (w == 1 ? s_misc[0] : 0.f); csv = ip - bcum; pmx = csv;
#pragma unroll
            for (int o = 1; o < 64; o <<= 1) { const float y = __shfl_up(pmx, o); if (lane >= o) pmx = fmaxf(pmx, y); }
            if (tid == 63) s_misc[1] = pmx;
            if (tid == 127) s_misc[2] = bcum;
        }
        ML_BAR();
        if (tid < 128) { if (w == 1) pmx = fmaxf(pmx, s_misc[1]); if (tid == 127) s_misc[3] = pmx; }
        ML_BAR();
        const float b_last = s_misc[2], m_new = fmaxf(b_last + m_prev, b_last + s_misc[3]), keep = __expf(b_last + m_prev - m_new);
        if (tid < 128) {
            const float inter = bcum + m_prev, mj = fmaxf(inter, bcum + pmx);
            s_cs[tid] = csv; s_rj[tid] = bcum - mj; s_iw[tid] = __expf(inter - mj); s_emj[tid] = __expf(-mj); s_w[tid] = __expf(b_last + csv - m_new);
        }
        ML_BAR();
#pragma unroll
        for (int i = 0; i < 8; ++i) *(LAS u32x4*)(lds + ML_KS + (krow + 16 * i) * ML_KP + pc * 16) = kreg[i];
        {
            *(LAS u32x4*)(lds + ML_VS + vrow * ML_VP + pv * 16) = vreg;
            float f[8]; unpack8(vreg, f); const float ws_ = s_w[vrow];
            u32x4 o; o.x = pk2(f[0] * ws_, f[1] * ws_); o.y = pk2(f[2] * ws_, f[3] * ws_); o.z = pk2(f[4] * ws_, f[5] * ws_); o.w = pk2(f[6] * ws_, f[7] * ws_);
            *(LAS u32x4*)(lds + ML_VW + vrow * ML_VP + pv * 16) = o;
        }
        bf16x8 qf[8];
#pragma unroll
        for (int kk = 0; kk < 8; ++kk) qf[kk] = __builtin_bit_cast(bf16x8, qn[kk]);
        unsigned short ogr[4][2];
#pragma unroll
        for (int i = 0; i < 4; ++i)
#pragma unroll
            for (int vt = 0; vt < 2; ++vt) ogr[i][vt] = R1B[ML_TOK(c, 16 * sw + 4 * g + i) * 2048 + 1024 + h * 256 + vs * 32 + 16 * vt + r];
        if (c < 31) ML_PREFETCH(c + 1);
        ML_BAR();
        {
            const float rjv = s_rj[16 * sw + r]; const int jloc = 16 * sw + r; float den1 = 0.f;
#pragma unroll 1
            for (int st = 0; st < 8; ++st) {
                if (st <= sw) {
                    f32x4 acc = {0.f, 0.f, 0.f, 0.f};
#pragma unroll
                    for (int kk = 0; kk < 8; ++kk) { const bf16x8 kf = *(const LAS bf16x8*)(lds + ML_KS + (16 * st + r) * ML_KP + (32 * kk + 8 * g) * 2); acc = __builtin_amdgcn_mfma_f32_16x16x32_bf16(kf, qf[kk], acc, 0, 0, 0); }
                    const f32x4 c4 = *(const LAS f32x4*)(s_cs + 16 * st + 4 * g);
                    float v[4];
#pragma unroll
                    for (int i = 0; i < 4; ++i) { const int s = 16 * st + 4 * g + i; const float d = (s <= jloc) ? __expf(rjv + c4[i]) : 0.f; v[i] = acc[i] * d; den1 += v[i]; }
                    u32x2 o; o.x = pk2(v[0], v[1]); o.y = pk2(v[2], v[3]);
                    *(LAS u32x2*)(lds + ML_SS + jloc * ML_SP + (16 * st + 4 * g) * 2) = o;
                } else if (st == sw + 1 && !(sw & 1)) {
                    u32x2 o = {0u, 0u}; *(LAS u32x2*)(lds + ML_SS + jloc * ML_SP + (16 * st + 4 * g) * 2) = o;
                }
            }
            den1 += __shfl_xor(den1, 16); den1 += __shfl_xor(den1, 32);
            f32x4 dacc = {0.f, 0.f, 0.f, 0.f};
#pragma unroll
            for (int kk = 0; kk < 8; ++kk) { const bf16x8 kf = *(const LAS bf16x8*)(lds + ML_KS + (128 + r) * ML_KP + (32 * kk + 8 * g) * 2); dacc = __builtin_amdgcn_mfma_f32_16x16x32_bf16(kf, qf[kk], dacc, 0, 0, 0); }
            const float d2 = dacc[0];
            if (g == 0) s_dn[jloc] = den1 + s_iw[jloc] * d2;
        }
        ML_BAR();
        {
            f32x4 n1[2], n2[2];
#pragma unroll
            for (int vt = 0; vt < 2; ++vt) { n1[vt] = (f32x4){0.f, 0.f, 0.f, 0.f}; n2[vt] = (f32x4){0.f, 0.f, 0.f, 0.f}; }
            const int nks = (sw >> 1) + 1;
#pragma unroll 1
            for (int ks = 0; ks < nks; ++ks) {
                const bf16x8 af = *(const LAS bf16x8*)(lds + ML_SS + (16 * sw + r) * ML_SP + (32 * ks + 8 * g) * 2);
                const unsigned a0 = lbase + ML_VS + (32 * ks + 8 * g + q4) * ML_VP + (4 * p4) * 2;
                bf16x8 b0, b1; tr_read2x2(a0, a0 + 32, 4 * ML_VP, b0, b1);
                n1[0] = __builtin_amdgcn_mfma_f32_16x16x32_bf16(af, b0, n1[0], 0, 0, 0); n1[1] = __builtin_amdgcn_mfma_f32_16x16x32_bf16(af, b1, n1[1], 0, 0, 0);
            }
#pragma unroll
            for (int kk = 0; kk < 8; ++kk)
#pragma unroll
                for (int vt = 0; vt < 2; ++vt) { const bf16x8 cf = *(const LAS bf16x8*)(lds + ML_CS + (16 * vt + r) * ML_CP + (32 * kk + 8 * g) * 2); n2[vt] = __builtin_amdgcn_mfma_f32_16x16x32_bf16(qf[kk], cf, n2[vt], 0, 0, 0); }
            const f32x4 iw4 = *(const LAS f32x4*)(s_iw + 16 * sw + 4 * g), dn4 = *(const LAS f32x4*)(s_dn + 16 * sw + 4 * g), em4 = *(const LAS f32x4*)(s_emj + 16 * sw + 4 * g);
#pragma unroll
            for (int i = 0; i < 4; ++i) {
                const size_t tok = ML_TOK(c, 16 * sw + 4 * g + i);
                const float inv = 1.0f / fmaxf(fabsf(dn4[i]), em4[i]);
#pragma unroll
                for (int vt = 0; vt < 2; ++vt) { const int col = h * 256 + vs * 32 + 16 * vt + r;
                    const float og = __uint_as_float(((unsigned)ogr[i][vt]) << 16);
                    const float hv = (n1[vt][i] + iw4[i] * n2[vt][i]) * inv * og;
                    Y[blk_off((int)tok, col, 1024)] = (bf16_t)f2bf(hv); }
            }
        }
        ML_BAR();
        {
#pragma unroll
            for (int a = 0; a < 3; ++a) { Cacc[a][0] *= keep; Cacc[a][1] *= keep; }
#pragma unroll 1
            for (int ks = 0; ks < 4; ++ks) {
                bf16x8 af[3], bq[2];
                { const unsigned av = lbase + ML_VW + (32 * ks + 8 * g + q4) * ML_VP + (4 * p4) * 2, ak = lbase + ML_KS + (32 * ks + 8 * g + q4) * ML_KP + (32 * w + 4 * p4) * 2;
                  tr_read4x2(av, av + 32, 4 * ML_VP, ak, ak + 32, 4 * ML_KP, af[0], af[1], bq[0], bq[1]); }
                { const f32x4 wa = *(const LAS f32x4*)(s_w + 32 * ks + 8 * g), wb = *(const LAS f32x4*)(s_w + 32 * ks + 8 * g + 4);
                  u32x4 o; o.x = pk2(wa[0], wa[1]); o.y = pk2(wa[2], wa[3]); o.z = pk2(wb[0], wb[1]); o.w = pk2(wb[2], wb[3]);
                  if (r != 0) { o.x = 0u; o.y = 0u; o.z = 0u; o.w = 0u; }
                  af[2] = __builtin_bit_cast(bf16x8, o); }
#pragma unroll
                for (int nt = 0; nt < 2; ++nt)
#pragma unroll
                    for (int mt = 0; mt < 3; ++mt) Cacc[mt][nt] = __builtin_amdgcn_mfma_f32_16x16x32_bf16(af[mt], bq[nt], Cacc[mt][nt], 0, 0, 0);
            }
#pragma unroll
            for (int mt = 0; mt < 2; ++mt)
#pragma unroll
                for (int nt = 0; nt < 2; ++nt)
#pragma unroll
                    for (int i = 0; i < 4; ++i) *(LAS bf16_t*)(lds + ML_CS + (16 * mt + 4 * g + i) * ML_CP + (32 * w + 16 * nt + r) * 2) = (bf16_t)f2bf(Cacc[mt][nt][i]);
            if (g == 0) { *(LAS bf16_t*)(lds + ML_KS + 128 * ML_KP + (32 * w + r) * 2) = (bf16_t)f2bf(Cacc[2][0][0]); *(LAS bf16_t*)(lds + ML_KS + 128 * ML_KP + (32 * w + 16 + r) * 2) = (bf16_t)f2bf(Cacc[2][1][0]); }
        }
        m_prev = m_new;
        ML_BAR();
    }
#undef ML_BAR
#undef ML_PREFETCH
#undef ML_TOK
}
constexpr int HY_ZK = 0, HY_WB = 69632;
static_assert(HY_WB + 69632 <= LDS_BYTES, "hyena LDS map");
#define GAS __attribute__((address_space(1)))
__device__ __forceinline__ float hy_conv(const GAS bf16_t* p  , int off, int t, float w0, float w1, float w2, float bias) {
    const unsigned r1 = p[off], r0 = p[off - 1], r2 = p[off + 1];
    const float a1 = __uint_as_float(r1 << 16);
    const float a0 = t > 0 ? __uint_as_float(r0 << 16) : 0.f;
    const float a2 = t < SEQ - 1 ? __uint_as_float(r2 << 16) : 0.f;
    return w0 * a0 + w1 * a1 + w2 * a2 + bias;
}
__device__ __forceinline__ void hyena_item(const Ctx& C, LAS unsigned char* lds, int ch, int wv) {
    int tid = (wv << 6) | lane_id_opaque(); asm volatile("" : "+v"(tid));
    LAS f32x2* zk = (LAS f32x2*)(lds + HY_ZK); LAS f32x2* wb = (LAS f32x2*)(lds + HY_WB);
    const float* FILT = (const float*)(C.ws + WS_FILT); const bf16_t* HYb = (const bf16_t*)(C.ws + WS_HY); bf16_t* YA = (bf16_t*)(C.ws + WS_YA);
    const float* cw = C.in[3]; const float* cb = C.in[4];
    float w0[3], w1[3], w2[3], bs[3];
#pragma unroll
    for (int s = 0; s < 3; ++s) { w0[s] = cw[s * 1024 + ch]; w1[s] = cw[CONVC + s * 1024 + ch]; w2[s] = cw[2 * CONVC + s * 1024 + ch]; bs[s] = cb[s * 1024 + ch]; }
    const float hb0 = C.in[12][ch], hb1 = C.in[12][1024 + ch];
    const float* F0 = FILT + (size_t)(0 * 1024 + ch) * SEQ; const float* F1 = FILT + (size_t)(1 * 1024 + ch) * SEQ;
    const float* F2 = FILT + (size_t)(2 * 1024 + ch) * SEQ; const float* F3 = FILT + (size_t)(3 * 1024 + ch) * SEQ;
    __syncthreads();
    {
        float fa[16], fb[16];
#pragma unroll
        for (int rep = 0; rep < 8; ++rep) { const int i = tid + 512 * rep; fa[rep] = F0[i]; fb[rep] = F2[i]; }
#pragma unroll
        for (int rep = 8; rep < 16; ++rep) { const int i = tid + 512 * rep; const int j = i == SEQ ? 1 : 2 * SEQ - i; fa[rep] = F1[j]; fb[rep] = F3[j]; }
        if (tid == 0) { fa[8] = 0.f; fb[8] = 0.f; }
#pragma unroll
        for (int rep = 0; rep < 16; ++rep) { const int i = tid + 512 * rep; zk[PADI(i)] = (f32x2){fa[rep] * (1.0f / 8192.0f), fb[rep] * (1.0f / 8192.0f)}; }
    }
    fft_fwd<0>(zk, tid);
#pragma unroll 1
    for (int p = 0; p < 2; ++p) {
        const int tb0 = (2 * p) * SEQ, tb1 = (2 * p + 1) * SEQ;
        f32x2 vv[8], zz[8];
        const bf16_t* pv0_ = HYb + (size_t)ch * TOK + tb0 + tid; asm volatile("" : "+v"(pv0_)); const GAS bf16_t* pv0 = (const GAS bf16_t*)pv0_; const GAS bf16_t* pv1 = pv0 + SEQ;
#pragma unroll
        for (int m = 0; m < 8; ++m) { const int t = tid + 512 * m;
            vv[m].x = hy_conv(pv0, 512 * m, t, w0[0], w1[0], w2[0], bs[0]); vv[m].y = hy_conv(pv1, 512 * m, t, w0[0], w1[0], w2[0], bs[0]);
            wb[PADI(t)] = vv[m]; }
        fft_fwd<1>(wb, tid); fft_pointwise(wb, zk, 0, tid); fft_inv<1>(wb, tid);
        const bf16_t* px0_ = HYb + (size_t)(1024 + ch) * TOK + tb0 + tid; asm volatile("" : "+v"(px0_)); const GAS bf16_t* px0 = (const GAS bf16_t*)px0_; const GAS bf16_t* px1 = px0 + SEQ;
#pragma unroll
        for (int m = 0; m < 8; ++m) { const int t = tid + 512 * m; const f32x2 y = wb[PADI(t)];
            const float xa = hy_conv(px0, 512 * m, t, w0[1], w1[1], w2[1], bs[1]), xb_ = hy_conv(px1, 512 * m, t, w0[1], w1[1], w2[1], bs[1]);
            zz[m].x = xa * (y.x + vv[m].x * hb0); zz[m].y = xb_ * (y.y + vv[m].y * hb0); }
#pragma unroll
        for (int m = 0; m < 8; ++m) { const int t = tid + 512 * m; wb[PADI(t)] = zz[m]; }
        fft_fwd<1>(wb, tid); fft_pointwise(wb, zk, 1, tid); fft_inv<1>(wb, tid);
        const bf16_t* py0_ = HYb + (size_t)(2048 + ch) * TOK + tb0 + tid; asm volatile("" : "+v"(py0_)); const GAS bf16_t* py0 = (const GAS bf16_t*)py0_; const GAS bf16_t* py1 = py0 + SEQ;
#pragma unroll
        for (int m = 0; m < 8; ++m) { const int t = tid + 512 * m; const f32x2 y = wb[PADI(t)];
            const float xa = hy_conv(py0, 512 * m, t, w0[2], w1[2], w2[2], bs[2]), xb_ = hy_conv(py1, 512 * m, t, w0[2], w1[2], w2[2], bs[2]);
            YA[blk_off(tb0 + t, ch, 1024)] = (bf16_t)f2bf(xa * (y.x + zz[m].x * hb1));
            YA[blk_off(tb1 + t, ch, 1024)] = (bf16_t)f2bf(xb_ * (y.y + zz[m].y * hb1)); }
        __syncthreads();
    }
}
#ifndef DUP_FILT
#define DUP_FILT 0
#endif
#ifndef DUP_PRE
#define DUP_PRE 0
#endif
#ifndef DUP_P0
#define DUP_P0 0
#endif
#ifndef DUP_ML
#define DUP_ML 0
#endif
#ifndef DUP_HY
#define DUP_HY 0
#endif
#ifndef DUP_REST
#define DUP_REST 0
#endif
#ifndef DUP_GU
#define DUP_GU 0
#endif
#define XB_TMO      128
#define XB_XCNT(j)  (256  + 64 * (j))
#define XB_XSUB(j)  (1280 + 64 * (j))
#define XB_XGEN(j)  (2304 + 64 * (j))
#define XB_TOP      3328
#define XB_TOPGEN   3392
#define XCD_BAR_WORDS 3456
#define XB_SPIN_CAP (1u << 22)
__device__ __forceinline__ unsigned xb_ld(unsigned* p)              { return __hip_atomic_load(p, __ATOMIC_RELAXED, __HIP_MEMORY_SCOPE_AGENT); }
__device__ __forceinline__ unsigned xb_add(unsigned* p, unsigned v) { return __hip_atomic_fetch_add(p, v, __ATOMIC_RELAXED, __HIP_MEMORY_SCOPE_AGENT); }
__device__ __forceinline__ unsigned xb_xcc_id() { return (unsigned)__builtin_amdgcn_s_getreg((3 << 11) | 20) & 0xFu; }
#define XB_SPIN(cond, bar) do { unsigned _sp = 0; while (cond) { __builtin_amdgcn_s_sleep(1); \
    if ((++_sp & 255u) == 0u) { if (xb_ld(&(bar)[XB_TMO])) break; if (_sp > XB_SPIN_CAP) { atomicAdd(&(bar)[XB_TMO], 1u); break; } } } } while (0)
__device__ __forceinline__ void xcd_barrier_complete(unsigned* bar, unsigned x, unsigned G, unsigned& nloc, unsigned& nx) {
    unsigned sum, cnt, mine, sp = 0u;
    for (;;) {
        sum = 0u; cnt = 0u; mine = 0u;
#pragma unroll
        for (unsigned j = 0; j < 16; ++j) { const unsigned c = xb_ld(&bar[XB_XCNT(j)]); sum += c; cnt += (c > 0u) ? 1u : 0u; mine = (j == x) ? c : mine; }
        if (sum == G) break;
        __builtin_amdgcn_s_sleep(1);
        if ((++sp & 255u) == 0u) { if (xb_ld(&bar[XB_TMO])) break; if (sp > XB_SPIN_CAP) { atomicAdd(&bar[XB_TMO], 1u); break; } }
    }
    nloc = mine > 0u ? mine : 1u; nx = cnt > 0u ? cnt : 1u;
}
__device__ __forceinline__ void grid_bar(unsigned* bar, volatile LAS unsigned* st, unsigned G, int wv) {
    asm volatile("s_waitcnt vmcnt(0)" ::: "memory");
    __syncthreads();
    const int lane = lane_id_opaque();
    if (wv == 0 && lane == 0) {
        __builtin_amdgcn_s_waitcnt(0);
        const unsigned x = xb_xcc_id();
        unsigned nloc = st[0], nx = st[1];
        if (nloc == 0u) { xcd_barrier_complete(bar, x, G, nloc, nx); st[0] = nloc; st[1] = nx; }
        const unsigned old = xb_add(&bar[XB_XSUB(x)], 1u);
        const unsigned gen = old / nloc;
        if (old + 1u == (gen + 1u) * nloc) {
            __builtin_amdgcn_fence(__ATOMIC_RELEASE, "agent");
            asm volatile("s_waitcnt vmcnt(0)" ::: "memory");
            const unsigned og = xb_add(&bar[XB_TOP], 1u);
            const unsigned tg = og / nx;
            if (og + 1u == (tg + 1u) * nx) xb_add(&bar[XB_TOPGEN], 1u);
            else XB_SPIN(xb_ld(&bar[XB_TOPGEN]) == tg, bar);
            __builtin_amdgcn_fence(__ATOMIC_ACQUIRE, "agent");
            xb_add(&bar[XB_XGEN(x)], 1u);
            asm volatile("s_waitcnt vmcnt(0)" ::: "memory");
        } else {
            XB_SPIN(xb_ld(&bar[XB_XGEN(x)]) == gen, bar);
            __builtin_amdgcn_fence(__ATOMIC_ACQUIRE, "agent");
            asm volatile("s_waitcnt vmcnt(0)" ::: "memory");
        }
    }
    __syncthreads();
}
struct Params { const float* in[21]; float* out; unsigned char* ws; };
__global__ void __launch_bounds__(512, 2) fwd_megakernel(Params prm) {
    extern __shared__ __attribute__((aligned(16))) unsigned char lds_raw[];
    LAS unsigned char* lds = (LAS unsigned char*)lds_raw;
    cg::grid_group grid = cg::this_grid();
    const int G = gridDim.x, bx = blockIdx.x;
    const int wv = __builtin_amdgcn_readfirstlane((int)(threadIdx.x >> 6));
    Ctx C;
#pragma unroll
    for (int i = 0; i < 21; ++i) C.in[i] = prm.in[i];
    C.out = prm.out; C.ws = prm.ws;
    unsigned char* ws = prm.ws;
    unsigned* gbar = (unsigned*)(ws + WS_BAR);
    volatile LAS unsigned* bst = (volatile LAS unsigned*)(lds + LDS_BYTES - 16);
#ifndef DUP_BAR
#define DUP_BAR 0
#endif
#define GBAR() do { for (int rb_ = 0; rb_ < 1 + DUP_BAR; ++rb_) grid_bar(gbar, bst, (unsigned)G, wv); } while (0)
    if (bx == 0) for (int i = threadIdx.x; i < XCD_BAR_WORDS; i += 512) gbar[i] = 0u;
    if (threadIdx.x < 4) ((LAS unsigned*)(lds + LDS_BYTES - 16))[threadIdx.x] = 0u;
    for (int rep = 0; rep < 1 + DUP_P0; ++rep) { p0_prologue(C, lds, G, wv); __syncthreads(); }
    grid.sync();
    if (threadIdx.x == 0) (void)xb_add(&gbar[XB_XCNT(xb_xcc_id())], 1u);
    for (int rep = 0; rep < 1 + DUP_FILT; ++rep) p1_filters(C, lds, G, wv);
    { HyProg P; P.K = DM; P.G = G; P.c = bx; P.W = (const bf16_t*)(ws + WS_WIN); P.X = (const bf16_t*)(ws + WS_XB); P.HY = (bf16_t*)(ws + WS_HY); P.r1 = (const float*)(ws + WS_R1S);
      pg8::gemm_stream(lds, P, wv); }
    for (int rep = 0; rep < 1 + DUP_REST; ++rep) { RestProg P; P.K = DM; P.G = G; P.c = bx; P.W = (const bf16_t*)(ws + WS_WIN); P.X = (const bf16_t*)(ws + WS_XB); P.R1A = (bf16_t*)(ws + WS_R1A); P.R1B = (bf16_t*)(ws + WS_R1B); P.R2 = (bf16_t*)prm.out; P.r1 = (const float*)(ws + WS_R1S);
      pg8::gemm_stream(lds, P, wv); }
    GBAR();
    for (int rep = 0; rep < 1 + DUP_PRE; ++rep) qk_prepass(C, G, wv);
    for (int rep = 0; rep < 1 + DUP_HY; ++rep) for (int idx = bx; idx < 1024; idx += G) { const int rd = idx >> 8, bb = idx & 255; hyena_item(C, lds, rd * 256 + (bb & 7) * 32 + (bb >> 3), wv); }
    GBAR();
    for (int rep = 0; rep < 1 + DUP_ML; ++rep) for (int item = bx; item < 256; item += G) mlstm_item(C, lds, item, wv);
    GBAR();
    { BranchProg P; P.K = 1024; P.G = G; P.c = bx; P.YA = (const bf16_t*)(ws + WS_YA); P.YBF = (const bf16_t*)(ws + WS_YBF); P.YBB = (const bf16_t*)(ws + WS_YBB);
      P.WA = (const bf16_t*)(ws + WS_WA); P.WB = (const bf16_t*)(ws + WS_WB); P.R2 = (const bf16_t*)prm.out; P.MIX = (bf16_t*)(ws + WS_MIX);
      pg8::gemm_stream(lds, P, wv); }
    GBAR();
    { ResProg P; P.K = DM; P.G = G; P.c = bx; P.A = (const bf16_t*)(ws + WS_MIX); P.B = (const bf16_t*)(ws + WS_WOUT); P.base = prm.in[0]; P.out = prm.out; P.outb = (bf16_t*)(ws + WS_X1B); P.ss = (float*)(ws + WS_SS2);
      pg8::gemm_stream(lds, P, wv); }
    GBAR();
    for (int rep = 0; rep < 1 + DUP_GU; ++rep) { GuProg P; P.K = DM; P.G = G; P.c = bx; P.X = (const bf16_t*)(ws + WS_X1B); P.W = (const bf16_t*)(ws + WS_WGU); P.HH = (bf16_t*)(ws + WS_HH); P.ss2 = (const float*)(ws + WS_SS2);
      pg8::gemm_stream(lds, P, wv); }
    GBAR();
    { ResProg P; P.K = FFH; P.G = G; P.c = bx; P.A = (const bf16_t*)(ws + WS_HH); P.B = (const bf16_t*)(ws + WS_WD); P.base = prm.out; P.out = prm.out; P.outb = nullptr; P.ss = (float*)(ws + WS_SS3);
      pg8::gemm_stream(lds, P, wv); }
    GBAR();
    p7_final(C, G, wv);
}

extern "C" void kernel_launch(void* const* d_in, const int* in_sizes, int n_in, void* d_out, int out_size, void* d_ws, size_t ws_size, hipStream_t stream) {
    static int grid = 0;
    if (grid == 0) {
        int dev = 0, cus = 0, per_cu = 0;
        hipGetDevice(&dev); hipDeviceGetAttribute(&cus, hipDeviceAttributeMultiprocessorCount, dev);
        if (hipFuncSetAttribute((const void*)fwd_megakernel, hipFuncAttributeMaxDynamicSharedMemorySize, LDS_BYTES) != hipSuccess) { fprintf(stderr, "kernel_launch: hipFuncSetAttribute failed\n"); grid = -1; return; }
        if (hipOccupancyMaxActiveBlocksPerMultiprocessor(&per_cu, (const void*)fwd_megakernel, 512, LDS_BYTES) != hipSuccess || per_cu < 1) { fprintf(stderr, "kernel_launch: occupancy query gave %d\n", per_cu); per_cu = 1; }
        (void)hipGetLastError();
        grid = cus * 1;
        if (n_in != 21 || ws_size < WS_END) { fprintf(stderr, "kernel_launch: unexpected n_in %d or ws %zu\n", n_in, ws_size); grid = -1; return; }
    }
    if (grid < 0) return;
    Params p{};
    for (int i = 0; i < 21; ++i) p.in[i] = (const float*)d_in[i];
    p.out = (float*)d_out; p.ws = (unsigned char*)d_ws;
    void* args[] = {&p};
    hipError_t e = hipLaunchCooperativeKernel((const void*)fwd_megakernel, dim3(grid), dim3(512), args, LDS_BYTES, stream);
    if (e != hipSuccess) fprintf(stderr, "cooperative launch failed: %s (grid %d)\n", hipGetErrorString(e), grid);
}
```

```cpp
#include <hip/hip_runtime.h>
#include <hip/hip_cooperative_groups.h>
#include <cstdio>
namespace cg = cooperative_groups;

#define LAS __attribute__((address_space(3)))
typedef unsigned short bf16_t;
typedef short bf16x8 __attribute__((ext_vector_type(8)));
typedef short bf16x4 __attribute__((ext_vector_type(4)));
typedef float f32x4 __attribute__((ext_vector_type(4)));
typedef float f32x2 __attribute__((ext_vector_type(2)));
typedef unsigned u32x4 __attribute__((ext_vector_type(4)));
typedef unsigned u32x2 __attribute__((ext_vector_type(2)));

constexpr int NB = 4, SEQ = 4096, TOK = NB * SEQ, DM = 2048, HW = 1024, MW = 1024, NHEAD = 4, DH = 256, FFH = 5632;
constexpr int CONVC = 5120, INCOLS = 11280, NFILT = 4096;
constexpr float RMS_EPS = 1e-6f;
constexpr size_t MiB = 1u << 20;
constexpr size_t WS_BAR = 262144, WS_R1S = 0, WS_SS2 = 65536, WS_SS3 = 131072, WS_G = 1 * MiB, WS_H2 = 2 * MiB;
constexpr size_t WS_WA = 4 * MiB, WS_WB = 8 * MiB, WS_WOUT = 12 * MiB, WS_WGU = 20 * MiB, WS_WD = 64 * MiB, WS_WIN = 86 * MiB, WS_XB = 130 * MiB;
constexpr size_t WS_FILT = 194 * MiB, WS_HY = 258 * MiB, WS_R1A = 354 * MiB, WS_R1B = 418 * MiB, WS_END = 494 * MiB;
constexpr size_t WS_QKP = 86 * MiB, WS_YA = 150 * MiB, WS_YBF = 354 * MiB, WS_YBB = 386 * MiB, WS_X1B = 86 * MiB, WS_MIX = 194 * MiB, WS_HH = 258 * MiB;
constexpr size_t WS_GSC = 482 * MiB;
constexpr int LDS_BYTES = 155648;

__device__ __forceinline__ unsigned f2bf(float f) { unsigned u = __float_as_uint(f); return (u + 0x7fffu + ((u >> 16) & 1u)) >> 16; }
__device__ __forceinline__ unsigned pk2(float lo, float hi) { unsigned r; asm volatile("v_cvt_pk_bf16_f32 %0, %1, %2" : "=v"(r) : "v"(lo), "v"(hi)); return r; }
__device__ __forceinline__ float bflo(unsigned w) { return __uint_as_float(w << 16); }
__device__ __forceinline__ float bfhi(unsigned w) { return __uint_as_float(w & 0xffff0000u); }
__device__ __forceinline__ float wave_sum(float v) {
#pragma unroll
    for (int o = 1; o < 64; o <<= 1) v += __shfl_xor(v, o);
    return v;
}
__device__ __forceinline__ size_t blk_off(int row, int k, int K) { return ((size_t)(row >> 7) * (size_t)(K >> 6) + (size_t)(k >> 6)) * 8192 + (size_t)((row & 127) * 64 + (k & 63)); }
__device__ __forceinline__ int lane_id_opaque() { int l; asm volatile("v_mbcnt_lo_u32_b32 %0, -1, 0\n\tv_mbcnt_hi_u32_b32 %0, -1, %0" : "=v"(l)); return l; }
__device__ __forceinline__ float sigmoidf_(float x) { return 1.0f / (1.0f + __expf(-x)); }
__device__ __forceinline__ float siluf_(float x) { return x / (1.0f + __expf(-x)); }

namespace pg8 {
constexpr int BM = 256, BK = 64, HALF = 128, HTB = HALF * BK * 2, STAGE_BYTES = 8 * HTB, NXCD = 8, WGM = 8;
__device__ __forceinline__ int lds_byte(int r, int c) { const int st = (r >> 4) * 2 + (c >> 5), rr = r & 15, cc = c & 31, ob = rr * 64 + cc * 2; return st * 1024 + (ob ^ (((ob >> 9) & 1) << 5)); }
__device__ __forceinline__ void stage_rc(int b, int& R, int& C) { const int st = b / 1024, sb = b % 1024, swz = sb ^ (((sb >> 9) & 1) << 5); R = (st >> 1) * 16 + swz / 64; C = (st & 1) * 32 + (swz % 64) / 2; }
__device__ __forceinline__ int perm32(int rho) { const int n = rho >> 4, i = rho & 15; return 8 * (i >> 2) + 4 * n + (i & 3); }
struct GUnit { const char* A; const char* B; int pm, pn, sub; };
__device__ __forceinline__ void tile_of(int L, int nM, int nN, int& pm, int& pn) {
    const int nwg = nM * nN; int wgid = L; { const int q = nwg / NXCD, r = nwg % NXCD, xcd = wgid % NXCD, off = wgid / NXCD; wgid = (xcd < r ? xcd * (q + 1) : r * (q + 1) + (xcd - r) * q) + off; }
    const int nig = WGM * nN, gid = wgid / nig, fm = gid * WGM, gsz = (nM - fm) < WGM ? (nM - fm) : WGM;
    pm = fm + ((wgid % nig) % gsz); pn = (wgid % nig) / gsz;
}
typedef f32x4 Acc[2][2][4][2];
template <class Prog>
__device__ __forceinline__ void gemm_stream(LAS unsigned char* lds, const Prog& P, int wv) {
    int tid = (wv << 6) | lane_id_opaque(); asm volatile("" : "+v"(tid));
    const int wid = __builtin_amdgcn_readfirstlane(tid >> 6), lane = tid & 63, wr = wid >> 2, wc = wid & 3, fr = lane & 15, fq = lane >> 4;
    const int K = P.K, nt = K / BK;
    unsigned voffA[2], voffB[2];
#pragma unroll
    for (int i = 0; i < 2; ++i) { int R, C; stage_rc(tid * 16 + i * 8192, R, C); const int Rb = Prog::PERM ? ((R & ~31) + perm32(R & 31)) : R;
        voffA[i] = (unsigned)(R * 64 + C) * 2u; voffB[i] = (unsigned)(Rb * 64 + C) * 2u; }
    const size_t kstep = (size_t)(HALF * BK * 2);
    const size_t hstep = (size_t)HALF * K * 2;
    const unsigned ldsw = (unsigned)wid * 1024u;
    const int aoff = lds_byte(wr * 64 + fr, fq * 8), boff = lds_byte(wc * 32 + fr, fq * 8);
#define PG8_SA(b, h) (((b) * 2 + (h)) * HTB)
#define PG8_SB(b, h) ((4 + (b) * 2 + (h)) * HTB)
#define PG8_STAGE(bufoff, gbase, voff) do { _Pragma("unroll") for (int _i = 0; _i < 2; ++_i) \
        __builtin_amdgcn_global_load_lds((const unsigned*)((const char*)(gbase) + (voff)[_i]), (LAS unsigned*)(lds + (bufoff) + ldsw + _i * 8192), 16, 0, 0); } while (0)
#define PG8_LDA(dst, b, h) do { _Pragma("unroll") for (int m = 0; m < 4; ++m) _Pragma("unroll") for (int k = 0; k < 2; ++k) dst[m][k] = *(const LAS bf16x8*)(lds + PG8_SA(b, h) + aoff + m * 2048 + k * 1024); } while (0)
#define PG8_LDB(dst, b, h) do { _Pragma("unroll") for (int n = 0; n < 2; ++n) _Pragma("unroll") for (int k = 0; k < 2; ++k) dst[n][k] = *(const LAS bf16x8*)(lds + PG8_SB(b, h) + boff + n * 2048 + k * 1024); } while (0)
#define PG8_MMA(ai, bj, At, Bt) do { __builtin_amdgcn_s_setprio(1); _Pragma("unroll") for (int m = 0; m < 4; ++m) _Pragma("unroll") for (int n = 0; n < 2; ++n) _Pragma("unroll") for (int k = 0; k < 2; ++k) \
        acc[ai][bj][m][n] = __builtin_amdgcn_mfma_f32_16x16x32_bf16(Bt[n][k], At[m][k], acc[ai][bj][m][n], 0, 0, 0); __builtin_amdgcn_s_setprio(0); } while (0)
#define PG8_WAIT_V(n) asm volatile("s_waitcnt vmcnt(" #n ")" ::: "memory")
#define PG8_WAIT_L(n) asm volatile("s_waitcnt lgkmcnt(" #n ")" ::: "memory")
#define PG8_BAR __builtin_amdgcn_s_barrier()
#define PG8_SCHED __builtin_amdgcn_sched_barrier(0)
    GUnit cur, nxt; int ui = 0;
    if (!P.next(0, cur)) return;
    f32x4 acc[2][2][4][2];
#pragma unroll
    for (int a = 0; a < 2; ++a)
#pragma unroll
        for (int b = 0; b < 2; ++b)
#pragma unroll
            for (int m = 0; m < 4; ++m)
#pragma unroll
                for (int n = 0; n < 2; ++n) acc[a][b][m][n] = (f32x4){0.f, 0.f, 0.f, 0.f};
    bf16x8 At[4][2], B0[2][2], B1[2][2];
    const char* cA = cur.A; const char* cB = cur.B;
    PG8_STAGE(PG8_SB(0, 0), cB, voffB); PG8_STAGE(PG8_SA(0, 0), cA, voffA); PG8_STAGE(PG8_SB(0, 1), cB + hstep, voffB); PG8_STAGE(PG8_SA(0, 1), cA + hstep, voffA);
    if (wr == 1) PG8_BAR;
    PG8_WAIT_V(4); PG8_BAR;
    PG8_STAGE(PG8_SB(1, 0), cB + kstep, voffB); PG8_STAGE(PG8_SA(1, 0), cA + kstep, voffA); PG8_STAGE(PG8_SB(1, 1), cB + hstep + kstep, voffB);
    PG8_WAIT_V(6); PG8_BAR;
    for (;;) {
        const bool has_next = P.next(ui + 1, nxt);
        const char* nA = has_next ? nxt.A : cA; const char* nB = has_next ? nxt.B : cB;
        for (int t = 0; t < nt; t += 2) {
            const bool last = (t == nt - 2);
            const char* a1 = cA + (size_t)(t + 1) * kstep;
            const char* a2 = last ? nA : cA + (size_t)(t + 2) * kstep; const char* b2 = last ? nB : cB + (size_t)(t + 2) * kstep;
            const char* a3 = a2 + kstep; const char* b3 = b2 + kstep;
            PG8_LDB(B0, 0, 0); PG8_SCHED; PG8_LDA(At, 0, 0); PG8_STAGE(PG8_SA(1, 1), a1 + hstep, voffA);
            PG8_WAIT_L(8); PG8_BAR; PG8_WAIT_L(0); PG8_MMA(0, 0, At, B0); PG8_BAR; PG8_SCHED;
            PG8_LDB(B1, 0, 1); PG8_STAGE(PG8_SB(0, 0), b2, voffB);
            PG8_BAR; PG8_WAIT_L(0); PG8_MMA(0, 1, At, B1); PG8_BAR;
            PG8_LDA(At, 0, 1); PG8_STAGE(PG8_SA(0, 0), a2, voffA);
            PG8_BAR; PG8_WAIT_L(0); PG8_MMA(1, 0, At, B0); PG8_BAR; PG8_SCHED;
            PG8_STAGE(PG8_SB(0, 1), b2 + hstep, voffB);
            PG8_WAIT_V(6); PG8_BAR; PG8_MMA(1, 1, At, B1); PG8_BAR;
            PG8_LDB(B0, 1, 0); PG8_SCHED; PG8_LDA(At, 1, 0); PG8_STAGE(PG8_SA(0, 1), a2 + hstep, voffA);
            PG8_WAIT_L(8); PG8_BAR; PG8_WAIT_L(0); PG8_MMA(0, 0, At, B0); PG8_BAR; PG8_SCHED;
            PG8_LDB(B1, 1, 1); PG8_STAGE(PG8_SB(1, 0), b3, voffB);
            PG8_BAR; PG8_WAIT_L(0); PG8_MMA(0, 1, At, B1); PG8_BAR;
            PG8_LDA(At, 1, 1); PG8_STAGE(PG8_SA(1, 0), a3, voffA);
            PG8_BAR; PG8_WAIT_L(0); PG8_MMA(1, 0, At, B0); PG8_BAR; PG8_SCHED;
            PG8_STAGE(PG8_SB(1, 1), b3 + hstep, voffB);
            PG8_WAIT_V(6); PG8_BAR; PG8_MMA(1, 1, At, B1); PG8_BAR;
        }
        P.epi(acc, cur, wr, wc, fr, fq);
        if (!has_next) break;
        cur = nxt; cA = nA; cB = nB; ++ui;
    }
    PG8_WAIT_V(0);
    if (wr == 0) PG8_BAR;
    PG8_BAR;
#undef PG8_SA
#undef PG8_SB
#undef PG8_STAGE
#undef PG8_LDA
#undef PG8_LDB
#undef PG8_MMA
#undef PG8_WAIT_V
#undef PG8_WAIT_L
#undef PG8_BAR
#undef PG8_SCHED
}
__device__ __forceinline__ void zero_acc(Acc& acc) {
#pragma unroll
    for (int a = 0; a < 2; ++a)
#pragma unroll
        for (int b = 0; b < 2; ++b)
#pragma unroll
            for (int m = 0; m < 4; ++m)
#pragma unroll
                for (int n = 0; n < 2; ++n) acc[a][b][m][n] = (f32x4){0.f, 0.f, 0.f, 0.f};
}
}
using pg8::GUnit; using pg8::Acc;
struct HyProg {
    static constexpr bool PERM = true; int K, G, c; const bf16_t* W; const bf16_t* X; bf16_t* HY; const float* r1;
    __device__ __forceinline__ bool next(int i, GUnit& u) const { const int L = i * G + c; if (L >= 12 * 64) return false; pg8::tile_of(L, 12, 64, u.pm, u.pn);
        u.A = (const char*)(W + (size_t)u.pm * 256 * DM); u.B = (const char*)(X + (size_t)u.pn * 256 * DM); u.sub = 0; return true; }
    __device__ __forceinline__ void epi(Acc& acc, const GUnit& u, int wr, int wc, int fr, int fq) const {
        const int row0 = u.pm * 256 + wr * 64 + fr, col0 = u.pn * 256 + wc * 32 + 8 * fq;
        f32x4 sc[2][2];
#pragma unroll
        for (int bj = 0; bj < 2; ++bj) { sc[bj][0] = *(const f32x4*)(r1 + col0 + bj * 128); sc[bj][1] = *(const f32x4*)(r1 + col0 + bj * 128 + 4); }
#pragma unroll
        for (int ai = 0; ai < 2; ++ai)
#pragma unroll
            for (int m = 0; m < 4; ++m) { bf16_t* rowp = HY + (size_t)(row0 + ai * 128 + m * 16) * TOK + col0;
#pragma unroll
                for (int bj = 0; bj < 2; ++bj) { const f32x4 v0 = acc[ai][bj][m][0] * sc[bj][0], v1 = acc[ai][bj][m][1] * sc[bj][1];
                    u32x4 w; w.x = pk2(v0[0], v0[1]); w.y = pk2(v0[2], v0[3]); w.z = pk2(v1[0], v1[1]); w.w = pk2(v1[2], v1[3]);
                    *(u32x4*)(rowp + bj * 128) = w; } }
        pg8::zero_acc(acc);
    }
};
struct RestProg {
    static constexpr bool PERM = true; int K, G, c; const bf16_t* W; const bf16_t* X; bf16_t* R1A; bf16_t* R1B; bf16_t* R2; const float* r1;
    __device__ __forceinline__ bool next(int i, GUnit& u) const { const int L = i * G + c; if (L >= 64 * 32) return false; pg8::tile_of(L, 64, 32, u.pm, u.pn);
        u.A = (const char*)(X + (size_t)u.pm * 256 * DM); u.B = (const char*)(W + (size_t)(3072 + u.pn * 256) * DM); u.sub = 0; return true; }
    __device__ __forceinline__ void epi(Acc& acc, const GUnit& u, int wr, int wc, int fr, int fq) const {
        const int row0 = u.pm * 256 + wr * 64 + fr; const bool sg = u.pn >= 12;
        bf16_t* base = u.pn < 8 ? R1A + u.pn * 256 : (u.pn < 16 ? R1B + (u.pn - 8) * 256 : R2 + (u.pn - 16) * 256);
        const int pitch = u.pn < 16 ? 2048 : 4096;
        const int col0 = wc * 32 + 8 * fq;
#pragma unroll
        for (int ai = 0; ai < 2; ++ai)
#pragma unroll
            for (int m = 0; m < 4; ++m) { const int row = row0 + ai * 128 + m * 16; const float s = r1[row]; bf16_t* rowp = base + (size_t)row * pitch + col0;
#pragma unroll
                for (int bj = 0; bj < 2; ++bj) { f32x4 v0 = acc[ai][bj][m][0] * s, v1 = acc[ai][bj][m][1] * s;
                    if (sg) {
#pragma unroll
                        for (int j = 0; j < 4; ++j) { v0[j] = sigmoidf_(v0[j]); v1[j] = sigmoidf_(v1[j]); } }
                    u32x4 w; w.x = pk2(v0[0], v0[1]); w.y = pk2(v0[2], v0[3]); w.z = pk2(v1[0], v1[1]); w.w = pk2(v1[2], v1[3]);
                    *(u32x4*)(rowp + bj * 128) = w; } }
        pg8::zero_acc(acc);
    }
};
struct BranchProg {
    static constexpr bool PERM = true; int K, G, c; const bf16_t *YA, *YBF, *YBB, *WA, *WB; const bf16_t* R2; bf16_t* MIX;
    __device__ __forceinline__ bool next(int i, GUnit& u) const { const int ti = i / 3, sub = i - 3 * ti; const int L = ti * G + c; if (L >= 64 * 8) return false; pg8::tile_of(L, 64, 8, u.pm, u.pn);
        const bf16_t* a = sub == 0 ? YA : (sub == 1 ? YBF : YBB); const bf16_t* b = sub == 0 ? WA : WB;
        u.A = (const char*)(a + (size_t)u.pm * 256 * 1024); u.B = (const char*)(b + (size_t)u.pn * 256 * 1024); u.sub = sub; return true; }
    __device__ __forceinline__ void epi(Acc& acc, const GUnit& u, int wr, int wc, int fr, int fq) const {
        if (u.sub == 1) return;
        const int row0 = u.pm * 256 + wr * 64 + fr, col0 = u.pn * 256 + wc * 32 + 8 * fq;
#pragma unroll
        for (int ai = 0; ai < 2; ++ai)
#pragma unroll
            for (int m = 0; m < 4; ++m) { const int row = row0 + ai * 128 + m * 16; const bf16_t* gp = R2 + (size_t)row * 4096 + col0;
#pragma unroll
                for (int bj = 0; bj < 2; ++bj) {
                    const u32x4 gbw = *(const u32x4*)(gp + 2048 + bj * 128);
                    float gb[8] = {bflo(gbw.x), bfhi(gbw.x), bflo(gbw.y), bfhi(gbw.y), bflo(gbw.z), bfhi(gbw.z), bflo(gbw.w), bfhi(gbw.w)};
                    if (u.sub == 0) {
                        const u32x4 gaw = *(const u32x4*)(gp + bj * 128);
                        float ga[8] = {bflo(gaw.x), bfhi(gaw.x), bflo(gaw.y), bfhi(gaw.y), bflo(gaw.z), bfhi(gaw.z), bflo(gaw.w), bfhi(gaw.w)};
#pragma unroll
                        for (int j = 0; j < 4; ++j) { acc[ai][bj][m][0][j] *= ga[j] / fmaxf(gb[j], 1e-30f); acc[ai][bj][m][1][j] *= ga[4 + j] / fmaxf(gb[4 + j], 1e-30f); }
                    } else {
                        f32x4 v0 = acc[ai][bj][m][0], v1 = acc[ai][bj][m][1];
#pragma unroll
                        for (int j = 0; j < 4; ++j) { v0[j] *= fmaxf(gb[j], 1e-30f); v1[j] *= fmaxf(gb[4 + j], 1e-30f); }
                        u32x4 w; w.x = pk2(v0[0], v0[1]); w.y = pk2(v0[2], v0[3]); w.z = pk2(v1[0], v1[1]); w.w = pk2(v1[2], v1[3]);
                        *(u32x4*)(MIX + blk_off(row, col0 + bj * 128, DM)) = w;
                    } } }
        if (u.sub == 2) pg8::zero_acc(acc);
    }
};
struct ResProg {
    static constexpr bool PERM = false; int K, G, c; const bf16_t* A; const bf16_t* B; const float* base; float* out; bf16_t* outb; float* ss;
    __device__ __forceinline__ bool next(int i, GUnit& u) const { const int L = i * G + c; if (L >= 64 * 8) return false; pg8::tile_of(L, 64, 8, u.pm, u.pn);
        u.A = (const char*)(A + (size_t)u.pm * 256 * K); u.B = (const char*)(B + (size_t)u.pn * 256 * K); u.sub = 0; return true; }
    __device__ __forceinline__ void epi(Acc& acc, const GUnit& u, int wr, int wc, int fr, int fq) const {
        const int row0 = u.pm * 256 + wr * 64 + fr, col0 = u.pn * 256 + wc * 32 + 4 * fq;
#pragma unroll
        for (int ai = 0; ai < 2; ++ai)
#pragma unroll
            for (int m = 0; m < 4; ++m) { const int row = row0 + ai * 128 + m * 16; const size_t off = (size_t)row * DM + col0; float s = 0.f;
#pragma unroll
                for (int bj = 0; bj < 2; ++bj)
#pragma unroll
                    for (int n = 0; n < 2; ++n) { const f32x4 bs = *(const f32x4*)(base + off + bj * 128 + n * 16); const f32x4 o = bs + acc[ai][bj][m][n];
                        *(f32x4*)(out + off + bj * 128 + n * 16) = o; s += (o[0] * o[0] + o[1] * o[1]) + (o[2] * o[2] + o[3] * o[3]);
                        if (outb) { u32x2 w; w.x = pk2(o[0], o[1]); w.y = pk2(o[2], o[3]); *(u32x2*)(outb + blk_off(row, col0 + bj * 128 + n * 16, DM)) = w; } }
                s += __shfl_xor(s, 16); s += __shfl_xor(s, 32);
                if (fq == 0) unsafeAtomicAdd(ss + row, s); }
        pg8::zero_acc(acc);
    }
};
struct GuProg {
    static constexpr bool PERM = true; int K, G, c; const bf16_t* X; const bf16_t* W; bf16_t* HH; const float* ss2;
    __device__ __forceinline__ bool next(int i, GUnit& u) const { const int L = i * G + c; if (L >= 64 * 44) return false; pg8::tile_of(L, 64, 44, u.pm, u.pn);
        u.A = (const char*)(X + (size_t)u.pm * 256 * DM); u.B = (const char*)(W + (size_t)u.pn * 256 * DM); u.sub = 0; return true; }
    __device__ __forceinline__ void epi(Acc& acc, const GUnit& u, int wr, int wc, int fr, int fq) const {
        const int row0 = u.pm * 256 + wr * 64 + fr, col0 = u.pn * 128 + wc * 32 + 8 * fq;
#pragma unroll
        for (int ai = 0; ai < 2; ++ai)
#pragma unroll
            for (int m = 0; m < 4; ++m) { const int row = row0 + ai * 128 + m * 16; const float r2 = 1.0f / sqrtf(ss2[row] * (1.0f / DM) + RMS_EPS);
                float hv[8];
#pragma unroll
                for (int n = 0; n < 2; ++n)
#pragma unroll
                    for (int j = 0; j < 4; ++j) { const float g = acc[ai][0][m][n][j] * r2, uu = acc[ai][1][m][n][j] * r2; hv[4 * n + j] = siluf_(g) * uu; }
                u32x4 w; w.x = pk2(hv[0], hv[1]); w.y = pk2(hv[2], hv[3]); w.z = pk2(hv[4], hv[5]); w.w = pk2(hv[6], hv[7]);
                *(u32x4*)(HH + blk_off(row, col0, FFH)) = w; }
        pg8::zero_acc(acc);
    }
};
struct Ctx {
    const float* in[21]; float* out; unsigned char* ws;
};
__device__ __forceinline__ void p0_transpose_item(const float* W, int Nsrc, int K, bf16_t* WT, int dst_row0, int src_col0, const float* kscale, LAS float* scr, int kb, int lane) {
    const int k0 = 64 * kb;
    float tv[32];
    const float* wp = W + (size_t)(k0 + (lane >> 5)) * Nsrc + src_col0 + (lane & 31);
#pragma unroll
    for (int i = 0; i < 32; ++i) tv[i] = wp[(size_t)(2 * i) * Nsrc];
    if (kscale) {
#pragma unroll
        for (int i = 0; i < 32; ++i) tv[i] *= kscale[k0 + 2 * i + (lane >> 5)]; }
#pragma unroll
    for (int i = 0; i < 32; ++i) scr[(2 * i + (lane >> 5)) * 33 + (lane & 31)] = tv[i];
    asm volatile("s_waitcnt lgkmcnt(0)" ::: "memory");
    const int c = lane & 7;
#pragma unroll
    for (int j = 0; j < 4; ++j) { const int n = (lane >> 3) + 8 * j; const LAS float* s = scr + (8 * c) * 33 + n;
        u32x4 o; o.x = pk2(s[0 * 33], s[1 * 33]); o.y = pk2(s[2 * 33], s[3 * 33]); o.z = pk2(s[4 * 33], s[5 * 33]); o.w = pk2(s[6 * 33], s[7 * 33]);
        *(u32x4*)(WT + blk_off(dst_row0 + n, k0 + 8 * c, K)) = o; }
    asm volatile("s_waitcnt lgkmcnt(0)" ::: "memory");
}
__device__ __forceinline__ void p0_prologue(const Ctx& C, LAS unsigned char* lds, int G, int wv) {
    int tid = (wv << 6) | lane_id_opaque(); asm volatile("" : "+v"(tid));
    const int lane = tid & 63, wave = __builtin_amdgcn_readfirstlane(tid >> 6);
    const int gw = blockIdx.x * 8 + wave, NGW = G * 8;
    unsigned char* ws = C.ws;
    LAS float* scr = (LAS float*)(lds + wave * 8704);
    constexpr int I_IN = 32 * 352, I_A = 16 * 64, I_O = 32 * 64, I_GU = 32 * 352, I_D = 88 * 64;
    constexpr int NIT = I_IN + 2 * I_A + I_O + I_GU + I_D;
    for (int it = gw; it < NIT; it += NGW) {
        int r = it;
        if (r < I_IN) { const int kb = r / 352, nb = r % 352, n0 = nb * 32; const int src = n0 < 7168 ? n0 : n0 + 16;
            p0_transpose_item(C.in[2], INCOLS, DM, (bf16_t*)(ws + WS_WIN), n0, src, C.in[1], scr, kb, lane); continue; } r -= I_IN;
        if (r < I_A) { p0_transpose_item(C.in[14], DM, HW, (bf16_t*)(ws + WS_WA), (r % 64) * 32, (r % 64) * 32, nullptr, scr, r / 64, lane); continue; } r -= I_A;
        if (r < I_A) { p0_transpose_item(C.in[15], DM, MW, (bf16_t*)(ws + WS_WB), (r % 64) * 32, (r % 64) * 32, nullptr, scr, r / 64, lane); continue; } r -= I_A;
        if (r < I_O) { p0_transpose_item(C.in[16], DM, DM, (bf16_t*)(ws + WS_WOUT), (r % 64) * 32, (r % 64) * 32, nullptr, scr, r / 64, lane); continue; } r -= I_O;
        if (r < I_GU) { const int kb = r / 352, nb = r % 352, n0 = nb * 32; const int pn = n0 >> 8, half = (n0 >> 7) & 1, i = n0 & 127;
            p0_transpose_item(C.in[18], 2 * FFH, DM, (bf16_t*)(ws + WS_WGU), n0, half * FFH + 128 * pn + i, C.in[17], scr, kb, lane); continue; } r -= I_GU;
        p0_transpose_item(C.in[19], DM, FFH, (bf16_t*)(ws + WS_WD), (r % 64) * 32, (r % 64) * 32, nullptr, scr, r / 64, lane);
    }
    for (int i = blockIdx.x * 512 + tid; i < TOK; i += G * 512) { ((float*)(ws + WS_SS2))[i] = 0.f; ((float*)(ws + WS_SS3))[i] = 0.f; }
    {
        const float* w1 = C.in[5]; const float* b1 = C.in[6]; const float* f1 = C.in[7]; const float* w2 = C.in[8]; const float* b2 = C.in[9]; const float* f2 = C.in[10];
        float* h2 = (float*)(ws + WS_H2);
        for (int t = gw; t < SEQ; t += NGW) {
            const float tl = (float)t / (float)(SEQ - 1);
            const float omega = 6.283185307179586f * (float)t / (float)SEQ;
            float a = b1[lane] + tl * w1[lane];
            float sn, cs;
            { const int bi = lane & 15; const float fr = 1e-4f + (float)bi * ((15.0f - 1e-4f) / 15.0f); sincosf(omega * fr, &sn, &cs); }
#pragma unroll
            for (int i = 0; i < 16; ++i) a += __shfl(cs, i) * w1[(1 + i) * 64 + lane] - __shfl(sn, i) * w1[(17 + i) * 64 + lane];
            const float h1 = sinf(f1[lane] * a);
            float a2 = b2[lane];
#pragma unroll 8
            for (int i = 0; i < 64; ++i) a2 += __shfl(h1, i) * w2[i * 64 + lane];
            h2[t * 64 + lane] = sinf(f2[lane] * a2);
        }
    }
    __syncthreads();
    {
        constexpr int WGP = 2056;
        LAS bf16_t* wgb = (LAS bf16_t*)lds;
        const float* w_in = C.in[2]; const float* nw = C.in[1];
#pragma unroll 1
        for (int i0 = tid; i0 < DM * 16; i0 += 512 * 16) { float tw[16], tn[16];
#pragma unroll
            for (int u = 0; u < 16; ++u) { const int i = i0 + 512 * u, k = i >> 4, g = i & 15; tw[u] = w_in[(size_t)k * INCOLS + 7168 + g]; tn[u] = nw[k]; }
#pragma unroll
            for (int u = 0; u < 16; ++u) { const int i = i0 + 512 * u, k = i >> 4, g = i & 15; wgb[g * WGP + k] = (bf16_t)f2bf(tw[u] * tn[u]); } }
        __syncthreads();
        const float* x = C.in[0]; bf16_t* xb = (bf16_t*)(ws + WS_XB); float* r1 = (float*)(ws + WS_R1S); float* Gt = (float*)(ws + WS_G); const float* gbias = C.in[13];
        const int r = lane & 15, g = lane >> 4; const bool act = r < 8;
        for (int rb = gw; rb < TOK / 8; rb += NGW) {
            const int row = rb * 8 + (r & 7);
            const float* xp = x + (size_t)row * DM + 8 * g;
            f32x4 acc = {0.f, 0.f, 0.f, 0.f}; float ss = 0.f;
#pragma unroll 8
            for (int kk = 0; kk < 64; ++kk) {
                const f32x4 a = *(const f32x4*)(xp + 32 * kk), b = *(const f32x4*)(xp + 32 * kk + 4);
                ss += ((a.x * a.x + a.y * a.y) + (a.z * a.z + a.w * a.w)) + ((b.x * b.x + b.y * b.y) + (b.z * b.z + b.w * b.w));
                u32x4 o; o.x = pk2(a.x, a.y); o.y = pk2(a.z, a.w); o.z = pk2(b.x, b.y); o.w = pk2(b.z, b.w);
                *(u32x4*)(xb + blk_off(row, 32 * kk + 8 * g, DM)) = o;
                if (!act) { o.x = 0u; o.y = 0u; o.z = 0u; o.w = 0u; }
                const bf16x8 bw = *(const LAS bf16x8*)(wgb + r * WGP + 32 * kk + 8 * g);
                acc = __builtin_amdgcn_mfma_f32_16x16x32_bf16(__builtin_bit_cast(bf16x8, o), bw, acc, 0, 0, 0);
            }
            ss += __shfl_xor(ss, 16); ss += __shfl_xor(ss, 32);
            const float rinv = 1.0f / sqrtf(ss * (1.0f / DM) + RMS_EPS);
            const float gb = gbias[r];
#pragma unroll
            for (int i = 0; i < 4; ++i) { const int m = 4 * g + i; const float rv = __shfl(rinv, m & 7); if (g < 2) Gt[(size_t)(rb * 8 + m) * 16 + r] = acc[i] * rv + gb; }
            if (lane < 8) r1[rb * 8 + lane] = rinv;
        }
    }
}
__device__ __forceinline__ void p1_filters(const Ctx& C, LAS unsigned char* lds, int G, int wv) {
    int tid = (wv << 6) | lane_id_opaque(); asm volatile("" : "+v"(tid));
    const int lane = tid & 63, w = tid >> 6, r = lane & 15, g = lane >> 4;
    const float* w3 = C.in[11]; const float* h2 = (const float*)(C.ws + WS_H2); float* FILT = (float*)(C.ws + WS_FILT);
    for (int item = blockIdx.x; item < 256; item += G) {
        const int n0 = 64 * (item >> 2), t0 = 1024 * (item & 3) + 128 * w;
        bf16x8 af[4][2];
#pragma unroll
        for (int mt = 0; mt < 4; ++mt)
#pragma unroll
            for (int ks = 0; ks < 2; ++ks) { float v[8];
#pragma unroll
                for (int e = 0; e < 8; ++e) v[e] = w3[(size_t)(32 * ks + 8 * g + e) * NFILT + n0 + 16 * mt + r];
                u32x4 o; o.x = pk2(v[0], v[1]); o.y = pk2(v[2], v[3]); o.z = pk2(v[4], v[5]); o.w = pk2(v[6], v[7]); af[mt][ks] = __builtin_bit_cast(bf16x8, o); }
        float dl[4][4];
#pragma unroll
        for (int mt = 0; mt < 4; ++mt)
#pragma unroll
            for (int i = 0; i < 4; ++i) { const int ch = (n0 + 16 * mt + 4 * g + i) & 1023; const float mind = -3.0701134573253945f, maxd = -15.350567286626973f;
                dl[mt][i] = fabsf(mind + (float)ch * ((maxd - mind) / 1023.0f)); }
#pragma unroll 2
        for (int nt = 0; nt < 8; ++nt) {
            const int t = t0 + 16 * nt + r;
            bf16x8 bfr[2];
#pragma unroll
            for (int ks = 0; ks < 2; ++ks) { const f32x4 a = *(const f32x4*)(h2 + (size_t)t * 64 + 32 * ks + 8 * g), b = *(const f32x4*)(h2 + (size_t)t * 64 + 32 * ks + 8 * g + 4);
                u32x4 o; o.x = pk2(a.x, a.y); o.y = pk2(a.z, a.w); o.z = pk2(b.x, b.y); o.w = pk2(b.z, b.w); bfr[ks] = __builtin_bit_cast(bf16x8, o); }
            const float tl = (float)t / (float)(SEQ - 1);
#pragma unroll
            for (int mt = 0; mt < 4; ++mt) {
                f32x4 acc = {0.f, 0.f, 0.f, 0.f};
                acc = __builtin_amdgcn_mfma_f32_16x16x32_bf16(af[mt][0], bfr[0], acc, 0, 0, 0);
                acc = __builtin_amdgcn_mfma_f32_16x16x32_bf16(af[mt][1], bfr[1], acc, 0, 0, 0);
#pragma unroll
                for (int i = 0; i < 4; ++i) FILT[(size_t)(n0 + 16 * mt + 4 * g + i) * SEQ + t] = acc[i] * expf(-tl * dl[mt][i]);
            }
        }
    }
}
__device__ __forceinline__ void p7_final(const Ctx& C, int G, int wv) {
    int tid = (wv << 6) | lane_id_opaque(); asm volatile("" : "+v"(tid));
    const int lane = tid & 63, wave = tid >> 6, gw = blockIdx.x * 8 + wave, NGW = G * 8;
    const float* ss3 = (const float*)(C.ws + WS_SS3); const float* wf = C.in[20];
    f32x4 w[8];
#pragma unroll
    for (int j = 0; j < 8; ++j) w[j] = ((const f32x4*)wf)[64 * j + lane];
    for (int row = gw; row < TOK; row += 2 * NGW) {
        const int row2 = row + NGW;
        const bool has2 = row2 < TOK;
        const float r = 1.0f / sqrtf(ss3[row] * (1.0f / DM) + RMS_EPS), r2 = has2 ? 1.0f / sqrtf(ss3[row2] * (1.0f / DM) + RMS_EPS) : 0.f;
        f32x4* p = (f32x4*)(C.out + (size_t)row * DM) + lane; f32x4* p2 = (f32x4*)(C.out + (size_t)(has2 ? row2 : row) * DM) + lane;
        f32x4 v[8], u[8];
#pragma unroll
        for (int j = 0; j < 8; ++j) { v[j] = p[64 * j]; u[j] = p2[64 * j]; }
#pragma unroll
        for (int j = 0; j < 8; ++j) p[64 * j] = v[j] * r * w[j];
        if (has2) {
#pragma unroll
            for (int j = 0; j < 8; ++j) p2[64 * j] = u[j] * r2 * w[j]; }
    }
}
#ifndef FFT_HOST
#define FFT_DEV __device__ __forceinline__
#define FFT_PTR LAS f32x2*
#define FFT_SIN(x) __builtin_amdgcn_sinf(x)
#define FFT_COS(x) __builtin_amdgcn_cosf(x)
#else
#define FFT_DEV static inline
#define FFT_PTR f32x2*
#define FFT_SIN(x) sinf(6.283185307179586f * (x))
#define FFT_COS(x) cosf(6.283185307179586f * (x))
#endif
#define PADI(i) ((i) + ((i) >> 4))
FFT_DEV f32x2 cmul(f32x2 a, f32x2 b) { f32x2 r; r.x = a.x * b.x - a.y * b.y; r.y = a.x * b.y + a.y * b.x; return r; }
FFT_DEV f32x2 cmulc(f32x2 a, f32x2 b) { f32x2 r; r.x = a.x * b.x + a.y * b.y; r.y = a.y * b.x - a.x * b.y; return r; }
FFT_DEV f32x2 twid(float frac) { f32x2 r; r.x = FFT_COS(frac); r.y = -FFT_SIN(frac); return r; }
template <int M, int CJ> FFT_DEV f32x2 rot8(f32x2 d) {
    const float R = 0.70710678118654752f; f32x2 r;
    if (M == 0) return d;
    if (M == 2) { if (!CJ) { r.x = d.y; r.y = -d.x; } else { r.x = -d.y; r.y = d.x; } return r; }
    if (M == 1) { if (!CJ) { r.x = R * (d.x + d.y); r.y = R * (d.y - d.x); } else { r.x = R * (d.x - d.y); r.y = R * (d.x + d.y); } return r; }
    if (!CJ) { r.x = R * (d.y - d.x); r.y = -R * (d.x + d.y); } else { r.x = -R * (d.x + d.y); r.y = R * (d.x - d.y); } return r;
}
template <int INV, int ZHI, int LOW> FFT_DEV void fft_r8_pass(FFT_PTR buf, int s, int ls  , int tid) {
#pragma unroll 1
    for (int rep = 0; rep < 2; ++rep) {
        const int bf = tid + rep * 512, j = bf & (s - 1), blk = bf >> ls, base = blk * 8 * s + j;
        f32x2 x[8];
#pragma unroll
        for (int m = 0; m < (ZHI ? 4 : 8); ++m) x[m] = buf[PADI(base + m * s)];
        f32x2 w1 = twid((float)j / (float)(8 * s));
        f32x2 w2 = cmul(w1, w1), w4 = cmul(w2, w2);
        if (!INV) {
            if (ZHI) {
                x[4] = cmul(x[0], w1); x[5] = cmul(rot8<1, 0>(x[1]), w1); x[6] = cmul(rot8<2, 0>(x[2]), w1); x[7] = cmul(rot8<3, 0>(x[3]), w1);
            } else {
                { f32x2 a = x[0], b = x[4]; x[0] = a + b; x[4] = cmul(a - b, w1); }
                { f32x2 a = x[1], b = x[5]; x[1] = a + b; x[5] = cmul(rot8<1, 0>(a - b), w1); }
                { f32x2 a = x[2], b = x[6]; x[2] = a + b; x[6] = cmul(rot8<2, 0>(a - b), w1); }
                { f32x2 a = x[3], b = x[7]; x[3] = a + b; x[7] = cmul(rot8<3, 0>(a - b), w1); }
            }
#pragma unroll
            for (int h = 0; h < 8; h += 4) {
                { f32x2 a = x[h], b = x[h + 2]; x[h] = a + b; x[h + 2] = cmul(a - b, w2); }
                { f32x2 a = x[h + 1], b = x[h + 3]; x[h + 1] = a + b; x[h + 3] = cmul(rot8<2, 0>(a - b), w2); }
            }
#pragma unroll
            for (int m = 0; m < 8; m += 2) { f32x2 a = x[m], b = x[m + 1]; x[m] = a + b; x[m + 1] = cmul(a - b, w4); }
        } else {
#pragma unroll
            for (int m = 0; m < 8; m += 2) { f32x2 a = x[m], b = cmulc(x[m + 1], w4); x[m] = a + b; x[m + 1] = a - b; }
#pragma unroll
            for (int h = 0; h < 8; h += 4) {
                { f32x2 a = x[h], b = cmulc(x[h + 2], w2); x[h] = a + b; x[h + 2] = a - b; }
                { f32x2 a = x[h + 1], b = rot8<2, 1>(cmulc(x[h + 3], w2)); x[h + 1] = a + b; x[h + 3] = a - b; }
            }
            { f32x2 a = x[0], b = cmulc(x[4], w1); x[0] = a + b; if (!LOW) x[4] = a - b; }
            { f32x2 a = x[1], b = rot8<1, 1>(cmulc(x[5], w1)); x[1] = a + b; if (!LOW) x[5] = a - b; }
            { f32x2 a = x[2], b = rot8<2, 1>(cmulc(x[6], w1)); x[2] = a + b; if (!LOW) x[6] = a - b; }
            { f32x2 a = x[3], b = rot8<3, 1>(cmulc(x[7], w1)); x[3] = a + b; if (!LOW) x[7] = a - b; }
        }
#pragma unroll
        for (int m = 0; m < (LOW ? 4 : 8); ++m) buf[PADI(base + m * s)] = x[m];
    }
}
FFT_DEV void fft_r2_span1(FFT_PTR buf, int tid) {
#pragma unroll
    for (int rep = 0; rep < 8; ++rep) { const int p = 2 * (tid + rep * 512); f32x2 a = buf[PADI(p)], b = buf[PADI(p + 1)]; buf[PADI(p)] = a + b; buf[PADI(p + 1)] = a - b; }
}
template <int J, int CJ> FFT_DEV f32x2 rot16(f32x2 d) {
    const float C1 = 0.92387953251128674f, S1 = 0.38268343236508977f;
    if ((J & 1) == 0) return rot8<J / 2, CJ>(d);
    const float wr = (J == 1) ? C1 : (J == 3) ? S1 : (J == 5) ? -S1 : -C1;
    const float wi = ((J == 1) ? -S1 : (J == 3) ? -C1 : (J == 5) ? -C1 : -S1) * (CJ ? -1.f : 1.f);
    f32x2 r; r.x = d.x * wr - d.y * wi; r.y = d.x * wi + d.y * wr; return r;
}
FFT_DEV unsigned brev13(unsigned p);
FFT_DEV void fft16_dif(f32x2 (&x)[16]) {
#define BF_(i, j, ROT) { const f32x2 a_ = x[i], b_ = x[j]; x[i] = a_ + b_; x[j] = ROT(a_ - b_); }
    BF_(0, 8, (rot16<0, 0>)) BF_(1, 9, (rot16<1, 0>)) BF_(2, 10, (rot16<2, 0>)) BF_(3, 11, (rot16<3, 0>)) BF_(4, 12, (rot16<4, 0>)) BF_(5, 13, (rot16<5, 0>)) BF_(6, 14, (rot16<6, 0>)) BF_(7, 15, (rot16<7, 0>))
#pragma unroll
    for (int h = 0; h < 16; h += 8) { BF_(h + 0, h + 4, (rot8<0, 0>)) BF_(h + 1, h + 5, (rot8<1, 0>)) BF_(h + 2, h + 6, (rot8<2, 0>)) BF_(h + 3, h + 7, (rot8<3, 0>)) }
#pragma unroll
    for (int h = 0; h < 16; h += 4) { BF_(h + 0, h + 2, (rot8<0, 0>)) BF_(h + 1, h + 3, (rot8<2, 0>)) }
#pragma unroll
    for (int h = 0; h < 16; h += 2) { BF_(h, h + 1, (rot8<0, 0>)) }
#undef BF_
}
FFT_DEV void fft16_dit_inv(f32x2 (&x)[16]) {
#define BI_(i, j, ROT) { const f32x2 a_ = x[i], b_ = ROT(x[j]); x[i] = a_ + b_; x[j] = a_ - b_; }
#pragma unroll
    for (int h = 0; h < 16; h += 2) { BI_(h, h + 1, (rot8<0, 1>)) }
#pragma unroll
    for (int h = 0; h < 16; h += 4) { BI_(h + 0, h + 2, (rot8<0, 1>)) BI_(h + 1, h + 3, (rot8<2, 1>)) }
#pragma unroll
    for (int h = 0; h < 16; h += 8) { BI_(h + 0, h + 4, (rot8<0, 1>)) BI_(h + 1, h + 5, (rot8<1, 1>)) BI_(h + 2, h + 6, (rot8<2, 1>)) BI_(h + 3, h + 7, (rot8<3, 1>)) }
    BI_(0, 8, (rot16<0, 1>)) BI_(1, 9, (rot16<1, 1>)) BI_(2, 10, (rot16<2, 1>)) BI_(3, 11, (rot16<3, 1>)) BI_(4, 12, (rot16<4, 1>)) BI_(5, 13, (rot16<5, 1>)) BI_(6, 14, (rot16<6, 1>)) BI_(7, 15, (rot16<7, 1>))
#undef BI_
}
template <int MODE> FFT_DEV void fft_mid_pass(FFT_PTR wb, FFT_PTR zk, int tid) {
    f32x2 x[16];
#pragma unroll
    for (int e = 0; e < 16; ++e) x[e] = wb[PADI(16 * tid + e)];
    fft16_dif(x);
    if (MODE != 0) {
#pragma unroll
        for (int e = 0; e < 16; ++e) {
            const unsigned p = 16u * (unsigned)tid + (unsigned)e, f = brev13(p), fn = (8192u - f) & 8191u, pn = brev13(fn);
            const f32x2 zf = zk[PADI(p)], zn = zk[PADI(pn)];
            f32x2 kf;
            if (MODE == 1) { kf.x = 0.5f * (zf.x + zn.x); kf.y = 0.5f * (zf.y - zn.y); }
            else           { kf.x = 0.5f * (zf.y + zn.y); kf.y = 0.5f * (zn.x - zf.x); }
            x[e] = cmul(x[e], kf);
        }
        fft16_dit_inv(x);
    }
#pragma unroll
    for (int e = 0; e < 16; ++e) wb[PADI(16 * tid + e)] = x[e];
}
#ifndef FFT_HOST
#define FFT_SYNC() __syncthreads()
__device__ __forceinline__ void fft_fwd_full(FFT_PTR buf, int tid) {
    FFT_SYNC(); fft_r8_pass<0, 0, 0>(buf, 1024, 10, tid); FFT_SYNC(); fft_r8_pass<0, 0, 0>(buf, 128, 7, tid); FFT_SYNC(); fft_r8_pass<0, 0, 0>(buf, 16, 4, tid); FFT_SYNC();
    fft_mid_pass<0>(buf, buf, tid); FFT_SYNC();
}
template <int WHICH> __device__ __forceinline__ void fft_conv(FFT_PTR wb, FFT_PTR zk, int tid) {
    FFT_SYNC(); fft_r8_pass<0, 1, 0>(wb, 1024, 10, tid); FFT_SYNC(); fft_r8_pass<0, 0, 0>(wb, 128, 7, tid); FFT_SYNC(); fft_r8_pass<0, 0, 0>(wb, 16, 4, tid); FFT_SYNC();
    fft_mid_pass<1 + WHICH>(wb, zk, tid); FFT_SYNC();
    fft_r8_pass<1, 0, 0>(wb, 16, 4, tid); FFT_SYNC(); fft_r8_pass<1, 0, 0>(wb, 128, 7, tid); FFT_SYNC(); fft_r8_pass<1, 0, 1>(wb, 1024, 10, tid); FFT_SYNC();
}
#endif
FFT_DEV unsigned brev13(unsigned p) {
    unsigned r = 0;
#ifndef FFT_HOST
    r = __brev(p) >> 19;
#else
    for (int i = 0; i < 13; ++i) r |= ((p >> i) & 1u) << (12 - i);
#endif
    return r;
}
FFT_DEV void fft_pointwise(FFT_PTR wb, FFT_PTR zk, int which, int tid) {
#pragma unroll 4
    for (int rep = 0; rep < 16; ++rep) {
        const unsigned p = tid + rep * 512, f = brev13(p), fn = (8192u - f) & 8191u, pn = brev13(fn);
        const f32x2 zf = zk[PADI(p)], zn = zk[PADI(pn)];
        f32x2 kf;
        if (which == 0) { kf.x = 0.5f * (zf.x + zn.x); kf.y = 0.5f * (zf.y - zn.y); }
        else            { kf.x = 0.5f * (zf.y + zn.y); kf.y = 0.5f * (zn.x - zf.x); }
        wb[PADI(p)] = cmul(wb[PADI(p)], kf);
    }
}
__device__ __forceinline__ void unpack8(u32x4 w, float (&f)[8]) { f[0] = bflo(w.x); f[1] = bfhi(w.x); f[2] = bflo(w.y); f[3] = bfhi(w.y); f[4] = bflo(w.z); f[5] = bfhi(w.z); f[6] = bflo(w.w); f[7] = bfhi(w.w); }
__device__ __forceinline__ void qk_prepass(const Ctx& C, int G, int wv) {
    int tid = (wv << 6) | lane_id_opaque(); asm volatile("" : "+v"(tid));
    const bf16_t* R1A = (const bf16_t*)(C.ws + WS_R1A); bf16_t* QKP = (bf16_t*)(C.ws + WS_QKP);
    const float* cw = C.in[3]; const float* cb = C.in[4];
    const int cg8 = tid & 255, half = tid >> 8, col = 8 * cg8;
    float k0[8], k1[8], k2[8], kb[8];
    { const int ch = 3072 + col;
      const f32x4 t0 = *(const f32x4*)(cw + ch), t1 = *(const f32x4*)(cw + ch + 4), t2 = *(const f32x4*)(cw + CONVC + ch), t3 = *(const f32x4*)(cw + CONVC + ch + 4);
      const f32x4 t4 = *(const f32x4*)(cw + 2 * CONVC + ch), t5 = *(const f32x4*)(cw + 2 * CONVC + ch + 4), t6 = *(const f32x4*)(cb + ch), t7 = *(const f32x4*)(cb + ch + 4);
#pragma unroll
      for (int e = 0; e < 4; ++e) { k0[e] = t0[e]; k0[4 + e] = t1[e]; k1[e] = t2[e]; k1[4 + e] = t3[e]; k2[e] = t4[e]; k2[4 + e] = t5[e]; kb[e] = t6[e]; kb[4 + e] = t7[e]; } }
    const float osc = col >= 1024 ? 0.0625f : 1.0f;
    for (int run = blockIdx.x; run < TOK / 64; run += G) {
        const int row0 = run * 64 + half * 32;
#pragma unroll 4
        for (int i = 0; i < 32; ++i) {
            const int row = row0 + i, t = row & (SEQ - 1);
            const bf16_t* p = R1A + (size_t)row * 2048 + col;
            const u32x4 z = {0u, 0u, 0u, 0u};
            u32x4 w0 = *(const u32x4*)(t > 0 ? p - 2048 : p), w1 = *(const u32x4*)p, w2 = *(const u32x4*)(t < SEQ - 1 ? p + 2048 : p);
            if (t == 0) w0 = z; if (t == SEQ - 1) w2 = z;
            float a0[8], a1[8], a2[8]; unpack8(w0, a0); unpack8(w1, a1); unpack8(w2, a2);
            float v[8];
#pragma unroll
            for (int e = 0; e < 8; ++e) v[e] = siluf_(k0[e] * a0[e] + k1[e] * a1[e] + k2[e] * a2[e] + kb[e]) * osc;
            u32x4 o; o.x = pk2(v[0], v[1]); o.y = pk2(v[2], v[3]); o.z = pk2(v[4], v[5]); o.w = pk2(v[6], v[7]);
            *(u32x4*)(QKP + (size_t)row * 2048 + col) = o;
        }
    }
}
constexpr int ML_KS = 0, ML_KP = 528, ML_SS = 76032, ML_SP = 272, ML_VS = 110848, ML_VP = 80, ML_VW = 121088, ML_CS = 131328, ML_CP = 528, ML_SC = 148224;
static_assert(ML_SC + 7 * 512 + 64 + 5 * 128 <= LDS_BYTES - 16, "mLSTM LDS map");
__device__ __forceinline__ bf16x8 tr_read2(unsigned a0, unsigned a1) {
    bf16x4 lo, hi;
    asm volatile("ds_read_b64_tr_b16 %0, %2\n\tds_read_b64_tr_b16 %1, %3\n\ts_waitcnt lgkmcnt(0)" : "=&v"(lo), "=&v"(hi) : "v"(a0), "v"(a1) : "memory");
    bf16x8 r; r[0] = lo[0]; r[1] = lo[1]; r[2] = lo[2]; r[3] = lo[3]; r[4] = hi[0]; r[5] = hi[1]; r[6] = hi[2]; r[7] = hi[3]; return r;
}
__device__ __forceinline__ bf16x8 cat4(bf16x4 lo, bf16x4 hi) { bf16x8 r; r[0] = lo[0]; r[1] = lo[1]; r[2] = lo[2]; r[3] = lo[3]; r[4] = hi[0]; r[5] = hi[1]; r[6] = hi[2]; r[7] = hi[3]; return r; }
__device__ __forceinline__ void tr_read2x2(unsigned a, unsigned b, unsigned d, bf16x8& ra, bf16x8& rb) {
    bf16x4 l0, h0, l1, h1;
    asm volatile("ds_read_b64_tr_b16 %0, %4\n\tds_read_b64_tr_b16 %1, %5\n\tds_read_b64_tr_b16 %2, %6\n\tds_read_b64_tr_b16 %3, %7\n\ts_waitcnt lgkmcnt(0)"
        : "=&v"(l0), "=&v"(h0), "=&v"(l1), "=&v"(h1) : "v"(a), "v"(a + d), "v"(b), "v"(b + d) : "memory");
    ra = cat4(l0, h0); rb = cat4(l1, h1);
}
__device__ __forceinline__ void tr_read4x2(unsigned a, unsigned b, unsigned d, unsigned c, unsigned e, unsigned d2, bf16x8& ra, bf16x8& rb, bf16x8& rc, bf16x8& re) {
    bf16x4 l0, h0, l1, h1, l2, h2, l3, h3;
    asm volatile("ds_read_b64_tr_b16 %0, %8\n\tds_read_b64_tr_b16 %1, %9\n\tds_read_b64_tr_b16 %2, %10\n\tds_read_b64_tr_b16 %3, %11\n\t"
                 "ds_read_b64_tr_b16 %4, %12\n\tds_read_b64_tr_b16 %5, %13\n\tds_read_b64_tr_b16 %6, %14\n\tds_read_b64_tr_b16 %7, %15\n\ts_waitcnt lgkmcnt(0)"
        : "=&v"(l0), "=&v"(h0), "=&v"(l1), "=&v"(h1), "=&v"(l2), "=&v"(h2), "=&v"(l3), "=&v"(h3)
        : "v"(a), "v"(a + d), "v"(b), "v"(b + d), "v"(c), "v"(c + d2), "v"(e), "v"(e + d2) : "memory");
    ra = cat4(l0, h0); rb = cat4(l1, h1); rc = cat4(l2, h2); re = cat4(l3, h3);
}
__device__ __forceinline__ float bf2f(short s) { return __uint_as_float(((unsigned)(unsigned short)s) << 16); }
__device__ __forceinline__ float logsigmoidf_(float x) { return fminf(x, 0.f) - log1pf(expf(-fabsf(x))); }

__device__ __forceinline__ void mlstm_item(const Ctx& C, LAS unsigned char* lds, int item, int wv) {
    int tid = (wv << 6) | lane_id_opaque(); asm volatile("" : "+v"(tid));
    const int lane = tid & 63, w = __builtin_amdgcn_readfirstlane(tid >> 6), r = lane & 15, g = lane >> 4, q4 = r >> 2, p4 = r & 3;
    const int vs = item & 7, dir = (item >> 3) & 1, bh = item >> 4, b = bh >> 2, h = bh & 3;
    const bf16_t* QKP = (const bf16_t*)(C.ws + WS_QKP); const bf16_t* R1B = (const bf16_t*)(C.ws + WS_R1B); const float* Gt = (const float*)(C.ws + WS_G);
    bf16_t* Y = (bf16_t*)(C.ws + (dir ? WS_YBB : WS_YBF));
    LAS float* SC = (LAS float*)(lds + ML_SC);
    LAS float* s_cs = SC, *s_rj = SC + 128, *s_iw = SC + 256, *s_emj = SC + 384, *s_w = SC + 512, *s_dn = SC + 640, *s_misc = SC + 768;
    LAS float* c_bl = SC + 784, *c_mx = SC + 816, *c_mp = SC + 848, *c_mn = SC + 880, *c_kp = SC + 912;
    float* GS = (float*)(C.ws + WS_GSC) + (size_t)item * 3 * SEQ;
    const unsigned lbase = (unsigned)(size_t)lds;
    const int pc = tid & 31, krow = tid >> 5, vrow = tid >> 2, pv = tid & 3;
    const int sw = w < 4 ? w : 11 - w;
    for (int i = tid; i < 16896 / 4; i += 512) ((LAS unsigned*)(lds + ML_CS))[i] = 0u;
    for (int i = tid; i < 16 * ML_KP / 4; i += 512) ((LAS unsigned*)(lds + ML_KS + 128 * ML_KP))[i] = 0u;
    f32x4 Cacc[3][2];
#pragma unroll
    for (int a = 0; a < 3; ++a) { Cacc[a][0] = (f32x4){0.f, 0.f, 0.f, 0.f}; Cacc[a][1] = (f32x4){0.f, 0.f, 0.f, 0.f}; }
    u32x4 kreg[8], vreg, qn[8]; float bn = 0.f, csn = 0.f, pmn = 0.f;
#define ML_TOK(c_, j_) ((size_t)b * SEQ + (dir ? SEQ - 1 - ((c_) * 128 + (j_)) : ((c_) * 128 + (j_))))
#define ML_PREFETCH(c_) do { \
        _Pragma("unroll") for (int i = 0; i < 8; ++i) kreg[i] = *(const u32x4*)(QKP + ML_TOK(c_, krow + 16 * i) * 2048 + 1024 + h * 256 + 8 * pc); \
        vreg = *(const u32x4*)(R1B + ML_TOK(c_, vrow) * 2048 + h * 256 + vs * 32 + 8 * pv); \
        { const bf16_t* qp = QKP + ML_TOK(c_, 16 * sw + r) * 2048 + h * 256 + 8 * g; _Pragma("unroll") for (int kk = 0; kk < 8; ++kk) qn[kk] = *(const u32x4*)(qp + 32 * kk); } \
        if (tid < 128) { const int ta = (c_) * 128 + tid; bn = GS[ta]; csn = GS[SEQ + ta]; pmn = GS[2 * SEQ + ta]; } } while (0)
    {
#pragma unroll 1
        for (int q = 0; q < 4; ++q) {
            const int c = 4 * w + q; float carry_b = 0.f, carry_m = -3.0e38f;
#pragma unroll
            for (int hf = 0; hf < 2; ++hf) {
                const int ta = c * 128 + hf * 64 + lane; const size_t tk = (size_t)b * SEQ + (dir ? SEQ - 1 - ta : ta);
                const float ip = Gt[tk * 16 + (dir * 2) * 4 + h], fp = Gt[tk * 16 + (dir * 2 + 1) * 4 + h];
                float xs = logsigmoidf_(fp);
#pragma unroll
                for (int o = 1; o < 64; o <<= 1) { const float y = __shfl_up(xs, o); if (lane >= o) xs += y; }
                const float bj = xs + carry_b; const float cj = ip - bj; float pm = cj;
#pragma unroll
                for (int o = 1; o < 64; o <<= 1) { const float y = __shfl_up(pm, o); if (lane >= o) pm = fmaxf(pm, y); }
                pm = fmaxf(pm, carry_m);
                GS[ta] = bj; GS[SEQ + ta] = cj; GS[2 * SEQ + ta] = pm;
                carry_b = __shfl(bj, 63); carry_m = __shfl(pm, 63);
            }
            if (lane == 0) { c_bl[c] = carry_b; c_mx[c] = carry_m; }
        }
        __syncthreads();
        if (tid == 0) { float m = 0.f;
            for (int c = 0; c < 32; ++c) { const float bl = c_bl[c], mn = fmaxf(bl + m, bl + c_mx[c]); c_mp[c] = m; c_mn[c] = mn; c_kp[c] = __expf(bl + m - mn); m = mn; } }
        __syncthreads();
    }
    ML_PREFETCH(0);
    __syncthreads();
#define ML_BAR() do { asm volatile("s_waitcnt lgkmcnt(0)" ::: "memory"); __builtin_amdgcn_s_barrier(); asm volatile("" ::: "memory"); } while (0)
#pragma unroll 1
    for (int c = 0; c < 32; ++c) {
        const float m_prev = c_mp[c], m_new = c_mn[c], keep = c_kp[c], b_last = c_bl[c];
        if (tid < 128) {
            const float inter = bn + m_prev, mj = fmaxf(inter, bn + pmn);
            s_cs[tid] = csn; s_rj[tid] = bn - mj; s_iw[tid] = __expf(inter - mj); s_emj[tid] = __expf(-mj); s_w[tid] = __expf(b_last + csn - m_new);
        }
        ML_BAR();
#pragma unroll
        for (int i = 0; i < 8; ++i) *(LAS u32x4*)(lds + ML_KS + (krow + 16 * i) * ML_KP + pc * 16) = kreg[i];
        {
            *(LAS u32x4*)(lds + ML_VS + vrow * ML_VP + pv * 16) = vreg;
            float f[8]; unpack8(vreg, f); const float ws_ = s_w[vrow];
            u32x4 o; o.x = pk2(f[0] * ws_, f[1] * ws_); o.y = pk2(f[2] * ws_, f[3] * ws_); o.z = pk2(f[4] * ws_, f[5] * ws_); o.w = pk2(f[6] * ws_, f[7] * ws_);
            *(LAS u32x4*)(lds + ML_VW + vrow * ML_VP + pv * 16) = o;
        }
        bf16x8 qf[8];
#pragma unroll
        for (int kk = 0; kk < 8; ++kk) qf[kk] = __builtin_bit_cast(bf16x8, qn[kk]);
        unsigned short ogr[4][2];
#pragma unroll
        for (int i = 0; i < 4; ++i)
#pragma unroll
            for (int vt = 0; vt < 2; ++vt) ogr[i][vt] = R1B[ML_TOK(c, 16 * sw + 4 * g + i) * 2048 + 1024 + h * 256 + vs * 32 + 16 * vt + r];
        if (c < 31) ML_PREFETCH(c + 1);
        ML_BAR();
        {
            const float rjv = s_rj[16 * sw + r]; const int jloc = 16 * sw + r; float den1 = 0.f;
#pragma unroll 2
            for (int st = 0; st < 8; ++st) {
                if (st <= sw) {
                    f32x4 acc = {0.f, 0.f, 0.f, 0.f};
#pragma unroll
                    for (int kk = 0; kk < 8; ++kk) { const bf16x8 kf = *(const LAS bf16x8*)(lds + ML_KS + (16 * st + r) * ML_KP + (32 * kk + 8 * g) * 2); acc = __builtin_amdgcn_mfma_f32_16x16x32_bf16(kf, qf[kk], acc, 0, 0, 0); }
                    const f32x4 c4 = *(const LAS f32x4*)(s_cs + 16 * st + 4 * g);
                    float v[4];
#pragma unroll
                    for (int i = 0; i < 4; ++i) { const int s = 16 * st + 4 * g + i; const float d = (s <= jloc) ? __expf(rjv + c4[i]) : 0.f; v[i] = acc[i] * d; den1 += v[i]; }
                    u32x2 o; o.x = pk2(v[0], v[1]); o.y = pk2(v[2], v[3]);
                    *(LAS u32x2*)(lds + ML_SS + jloc * ML_SP + (16 * st + 4 * g) * 2) = o;
                } else if (st == sw + 1 && !(sw & 1)) {
                    u32x2 o = {0u, 0u}; *(LAS u32x2*)(lds + ML_SS + jloc * ML_SP + (16 * st + 4 * g) * 2) = o;
                }
            }
            den1 += __shfl_xor(den1, 16); den1 += __shfl_xor(den1, 32);
            f32x4 dacc = {0.f, 0.f, 0.f, 0.f};
#pragma unroll
            for (int kk = 0; kk < 8; ++kk) { const bf16x8 kf = *(const LAS bf16x8*)(lds + ML_KS + (128 + r) * ML_KP + (32 * kk + 8 * g) * 2); dacc = __builtin_amdgcn_mfma_f32_16x16x32_bf16(kf, qf[kk], dacc, 0, 0, 0); }
            const float d2 = dacc[0];
            if (g == 0) s_dn[jloc] = den1 + s_iw[jloc] * d2;
        }
        ML_BAR();
        {
            f32x4 n1[2], n2[2];
#pragma unroll
            for (int vt = 0; vt < 2; ++vt) { n1[vt] = (f32x4){0.f, 0.f, 0.f, 0.f}; n2[vt] = (f32x4){0.f, 0.f, 0.f, 0.f}; }
            const int nks = (sw >> 1) + 1;
#pragma unroll 1
            for (int ks = 0; ks < nks; ++ks) {
                const bf16x8 af = *(const LAS bf16x8*)(lds + ML_SS + (16 * sw + r) * ML_SP + (32 * ks + 8 * g) * 2);
                const unsigned a0 = lbase + ML_VS + (32 * ks + 8 * g + q4) * ML_VP + (4 * p4) * 2;
                bf16x8 b0, b1; tr_read2x2(a0, a0 + 32, 4 * ML_VP, b0, b1);
                n1[0] = __builtin_amdgcn_mfma_f32_16x16x32_bf16(af, b0, n1[0], 0, 0, 0); n1[1] = __builtin_amdgcn_mfma_f32_16x16x32_bf16(af, b1, n1[1], 0, 0, 0);
            }
#pragma unroll
            for (int kk = 0; kk < 8; ++kk)
#pragma unroll
                for (int vt = 0; vt < 2; ++vt) { const bf16x8 cf = *(const LAS bf16x8*)(lds + ML_CS + (16 * vt + r) * ML_CP + (32 * kk + 8 * g) * 2); n2[vt] = __builtin_amdgcn_mfma_f32_16x16x32_bf16(qf[kk], cf, n2[vt], 0, 0, 0); }
            const f32x4 iw4 = *(const LAS f32x4*)(s_iw + 16 * sw + 4 * g), dn4 = *(const LAS f32x4*)(s_dn + 16 * sw + 4 * g), em4 = *(const LAS f32x4*)(s_emj + 16 * sw + 4 * g);
#pragma unroll
            for (int i = 0; i < 4; ++i) {
                const size_t tok = ML_TOK(c, 16 * sw + 4 * g + i);
                const float inv = 1.0f / fmaxf(fabsf(dn4[i]), em4[i]);
#pragma unroll
                for (int vt = 0; vt < 2; ++vt) { const int col = h * 256 + vs * 32 + 16 * vt + r;
                    const float og = __uint_as_float(((unsigned)ogr[i][vt]) << 16);
                    const float hv = (n1[vt][i] + iw4[i] * n2[vt][i]) * inv * og;
                    Y[blk_off((int)tok, col, 1024)] = (bf16_t)f2bf(hv); }
            }
        }
        ML_BAR();
        {
#pragma unroll
            for (int a = 0; a < 3; ++a) { Cacc[a][0] *= keep; Cacc[a][1] *= keep; }
#pragma unroll 1
            for (int ks = 0; ks < 4; ++ks) {
                bf16x8 af[3], bq[2];
                { const unsigned av = lbase + ML_VW + (32 * ks + 8 * g + q4) * ML_VP + (4 * p4) * 2, ak = lbase + ML_KS + (32 * ks + 8 * g + q4) * ML_KP + (32 * w + 4 * p4) * 2;
                  tr_read4x2(av, av + 32, 4 * ML_VP, ak, ak + 32, 4 * ML_KP, af[0], af[1], bq[0], bq[1]); }
                { const f32x4 wa = *(const LAS f32x4*)(s_w + 32 * ks + 8 * g), wb = *(const LAS f32x4*)(s_w + 32 * ks + 8 * g + 4);
                  u32x4 o; o.x = pk2(wa[0], wa[1]); o.y = pk2(wa[2], wa[3]); o.z = pk2(wb[0], wb[1]); o.w = pk2(wb[2], wb[3]);
                  if (r != 0) { o.x = 0u; o.y = 0u; o.z = 0u; o.w = 0u; }
                  af[2] = __builtin_bit_cast(bf16x8, o); }
#pragma unroll
                for (int nt = 0; nt < 2; ++nt)
#pragma unroll
                    for (int mt = 0; mt < 3; ++mt) Cacc[mt][nt] = __builtin_amdgcn_mfma_f32_16x16x32_bf16(af[mt], bq[nt], Cacc[mt][nt], 0, 0, 0);
            }
#pragma unroll
            for (int mt = 0; mt < 2; ++mt)
#pragma unroll
                for (int nt = 0; nt < 2; ++nt)
#pragma unroll
                    for (int i = 0; i < 4; ++i) *(LAS bf16_t*)(lds + ML_CS + (16 * mt + 4 * g + i) * ML_CP + (32 * w + 16 * nt + r) * 2) = (bf16_t)f2bf(Cacc[mt][nt][i]);
            if (g == 0) { *(LAS bf16_t*)(lds + ML_KS + 128 * ML_KP + (32 * w + r) * 2) = (bf16_t)f2bf(Cacc[2][0][0]); *(LAS bf16_t*)(lds + ML_KS + 128 * ML_KP + (32 * w + 16 + r) * 2) = (bf16_t)f2bf(Cacc[2][1][0]); }
        }
        ML_BAR();
    }
#undef ML_BAR
#undef ML_PREFETCH
#undef ML_TOK
}
constexpr int HY_ZK = 0, HY_WB = 69632;
static_assert(HY_WB + 69632 <= LDS_BYTES, "hyena LDS map");
#define GAS __attribute__((address_space(1)))
__device__ __forceinline__ float hy_conv(const GAS bf16_t* p  , int off, int t, float w0, float w1, float w2, float bias) {
    const unsigned r1 = p[off], r0 = p[off - 1], r2 = p[off + 1];
    const float a1 = __uint_as_float(r1 << 16);
    const float a0 = t > 0 ? __uint_as_float(r0 << 16) : 0.f;
    const float a2 = t < SEQ - 1 ? __uint_as_float(r2 << 16) : 0.f;
    return w0 * a0 + w1 * a1 + w2 * a2 + bias;
}
__device__ __forceinline__ void hyena_item(const Ctx& C, LAS unsigned char* lds, int ch, int wv) {
    int tid = (wv << 6) | lane_id_opaque(); asm volatile("" : "+v"(tid));
    LAS f32x2* zk = (LAS f32x2*)(lds + HY_ZK); LAS f32x2* wb = (LAS f32x2*)(lds + HY_WB);
    const float* FILT = (const float*)(C.ws + WS_FILT); const bf16_t* HYb = (const bf16_t*)(C.ws + WS_HY); bf16_t* YA = (bf16_t*)(C.ws + WS_YA);
    const float* cw = C.in[3]; const float* cb = C.in[4];
    float w0[3], w1[3], w2[3], bs[3];
#pragma unroll
    for (int s = 0; s < 3; ++s) { w0[s] = cw[s * 1024 + ch]; w1[s] = cw[CONVC + s * 1024 + ch]; w2[s] = cw[2 * CONVC + s * 1024 + ch]; bs[s] = cb[s * 1024 + ch]; }
    const float hb0 = C.in[12][ch], hb1 = C.in[12][1024 + ch];
    const float* F0 = FILT + (size_t)(0 * 1024 + ch) * SEQ; const float* F1 = FILT + (size_t)(1 * 1024 + ch) * SEQ;
    const float* F2 = FILT + (size_t)(2 * 1024 + ch) * SEQ; const float* F3 = FILT + (size_t)(3 * 1024 + ch) * SEQ;
    __syncthreads();
    {
        float fa[16], fb[16];
#pragma unroll
        for (int rep = 0; rep < 8; ++rep) { const int i = tid + 512 * rep; fa[rep] = F0[i]; fb[rep] = F2[i]; }
#pragma unroll
        for (int rep = 8; rep < 16; ++rep) { const int i = tid + 512 * rep; const int j = i == SEQ ? 1 : 2 * SEQ - i; fa[rep] = F1[j]; fb[rep] = F3[j]; }
        if (tid == 0) { fa[8] = 0.f; fb[8] = 0.f; }
#pragma unroll
        for (int rep = 0; rep < 16; ++rep) { const int i = tid + 512 * rep; zk[PADI(i)] = (f32x2){fa[rep] * (1.0f / 8192.0f), fb[rep] * (1.0f / 8192.0f)}; }
    }
    fft_fwd_full(zk, tid);
#pragma unroll 1
    for (int p = 0; p < 2; ++p) {
        const int tb0 = (2 * p) * SEQ, tb1 = (2 * p + 1) * SEQ;
        f32x2 vv[8], zz[8];
        const bf16_t* pv0_ = HYb + (size_t)ch * TOK + tb0 + tid; asm volatile("" : "+v"(pv0_)); const GAS bf16_t* pv0 = (const GAS bf16_t*)pv0_; const GAS bf16_t* pv1 = pv0 + SEQ;
#pragma unroll
        for (int m = 0; m < 8; ++m) { const int t = tid + 512 * m;
            vv[m].x = hy_conv(pv0, 512 * m, t, w0[0], w1[0], w2[0], bs[0]); vv[m].y = hy_conv(pv1, 512 * m, t, w0[0], w1[0], w2[0], bs[0]);
            wb[PADI(t)] = vv[m]; }
        fft_conv<0>(wb, zk, tid);
        const bf16_t* px0_ = HYb + (size_t)(1024 + ch) * TOK + tb0 + tid; asm volatile("" : "+v"(px0_)); const GAS bf16_t* px0 = (const GAS bf16_t*)px0_; const GAS bf16_t* px1 = px0 + SEQ;
#pragma unroll
        for (int m = 0; m < 8; ++m) { const int t = tid + 512 * m; const f32x2 y = wb[PADI(t)];
            const float xa = hy_conv(px0, 512 * m, t, w0[1], w1[1], w2[1], bs[1]), xb_ = hy_conv(px1, 512 * m, t, w0[1], w1[1], w2[1], bs[1]);
            zz[m].x = xa * (y.x + vv[m].x * hb0); zz[m].y = xb_ * (y.y + vv[m].y * hb0); }
#pragma unroll
        for (int m = 0; m < 8; ++m) { const int t = tid + 512 * m; wb[PADI(t)] = zz[m]; }
        fft_conv<1>(wb, zk, tid);
        const bf16_t* py0_ = HYb + (size_t)(2048 + ch) * TOK + tb0 + tid; asm volatile("" : "+v"(py0_)); const GAS bf16_t* py0 = (const GAS bf16_t*)py0_; const GAS bf16_t* py1 = py0 + SEQ;
#pragma unroll
        for (int m = 0; m < 8; ++m) { const int t = tid + 512 * m; const f32x2 y = wb[PADI(t)];
            const float xa = hy_conv(py0, 512 * m, t, w0[2], w1[2], w2[2], bs[2]), xb_ = hy_conv(py1, 512 * m, t, w0[2], w1[2], w2[2], bs[2]);
            YA[blk_off(tb0 + t, ch, 1024)] = (bf16_t)f2bf(xa * (y.x + zz[m].x * hb1));
            YA[blk_off(tb1 + t, ch, 1024)] = (bf16_t)f2bf(xb_ * (y.y + zz[m].y * hb1)); }
        __syncthreads();
    }
}
#ifndef DUP_FILT
#define DUP_FILT 0
#endif
#ifndef DUP_PRE
#define DUP_PRE 0
#endif
#ifndef DUP_P0
#define DUP_P0 0
#endif
#ifndef DUP_ML
#define DUP_ML 0
#endif
#ifndef DUP_HY
#define DUP_HY 0
#endif
#ifndef DUP_REST
#define DUP_REST 0
#endif
#ifndef DUP_GU
#define DUP_GU 0
#endif
#define XB_TMO      128
#define XB_XCNT(j)  (256  + 64 * (j))
#define XB_XSUB(j)  (1280 + 64 * (j))
#define XB_XGEN(j)  (2304 + 64 * (j))
#define XB_TOP      3328
#define XB_TOPGEN   3392
#define XCD_BAR_WORDS 3456
#define XB_SPIN_CAP (1u << 22)
__device__ __forceinline__ unsigned xb_ld(unsigned* p)              { return __hip_atomic_load(p, __ATOMIC_RELAXED, __HIP_MEMORY_SCOPE_AGENT); }
__device__ __forceinline__ unsigned xb_add(unsigned* p, unsigned v) { return __hip_atomic_fetch_add(p, v, __ATOMIC_RELAXED, __HIP_MEMORY_SCOPE_AGENT); }
__device__ __forceinline__ unsigned xb_xcc_id() { return (unsigned)__builtin_amdgcn_s_getreg((3 << 11) | 20) & 0xFu; }
#define XB_SPIN(cond, bar) do { unsigned _sp = 0; while (cond) { __builtin_amdgcn_s_sleep(1); \
    if ((++_sp & 255u) == 0u) { if (xb_ld(&(bar)[XB_TMO])) break; if (_sp > XB_SPIN_CAP) { atomicAdd(&(bar)[XB_TMO], 1u); break; } } } } while (0)
__device__ __forceinline__ void xcd_barrier_complete(unsigned* bar, unsigned x, unsigned G, unsigned& nloc, unsigned& nx) {
    unsigned sum, cnt, mine, sp = 0u;
    for (;;) {
        sum = 0u; cnt = 0u; mine = 0u;
#pragma unroll
        for (unsigned j = 0; j < 16; ++j) { const unsigned c = xb_ld(&bar[XB_XCNT(j)]); sum += c; cnt += (c > 0u) ? 1u : 0u; mine = (j == x) ? c : mine; }
        if (sum == G) break;
        __builtin_amdgcn_s_sleep(1);
        if ((++sp & 255u) == 0u) { if (xb_ld(&bar[XB_TMO])) break; if (sp > XB_SPIN_CAP) { atomicAdd(&bar[XB_TMO], 1u); break; } }
    }
    nloc = mine > 0u ? mine : 1u; nx = cnt > 0u ? cnt : 1u;
}
__device__ __forceinline__ void grid_bar(unsigned* bar, volatile LAS unsigned* st, unsigned G, int wv) {
    asm volatile("s_waitcnt vmcnt(0)" ::: "memory");
    __syncthreads();
    const int lane = lane_id_opaque();
    if (wv == 0 && lane == 0) {
        __builtin_amdgcn_s_waitcnt(0);
        const unsigned x = xb_xcc_id();
        unsigned nloc = st[0], nx = st[1];
        if (nloc == 0u) { xcd_barrier_complete(bar, x, G, nloc, nx); st[0] = nloc; st[1] = nx; }
        const unsigned old = xb_add(&bar[XB_XSUB(x)], 1u);
        const unsigned gen = old / nloc;
        if (old + 1u == (gen + 1u) * nloc) {
            __builtin_amdgcn_fence(__ATOMIC_RELEASE, "agent");
            asm volatile("s_waitcnt vmcnt(0)" ::: "memory");
            const unsigned og = xb_add(&bar[XB_TOP], 1u);
            const unsigned tg = og / nx;
            if (og + 1u == (tg + 1u) * nx) xb_add(&bar[XB_TOPGEN], 1u);
            else XB_SPIN(xb_ld(&bar[XB_TOPGEN]) == tg, bar);
            __builtin_amdgcn_fence(__ATOMIC_ACQUIRE, "agent");
            xb_add(&bar[XB_XGEN(x)], 1u);
            asm volatile("s_waitcnt vmcnt(0)" ::: "memory");
        } else {
            XB_SPIN(xb_ld(&bar[XB_XGEN(x)]) == gen, bar);
            __builtin_amdgcn_fence(__ATOMIC_ACQUIRE, "agent");
            asm volatile("s_waitcnt vmcnt(0)" ::: "memory");
        }
    }
    __syncthreads();
}
struct Params { const float* in[21]; float* out; unsigned char* ws; };
__global__ void __launch_bounds__(512, 2) fwd_megakernel(Params prm) {
    extern __shared__ __attribute__((aligned(16))) unsigned char lds_raw[];
    LAS unsigned char* lds = (LAS unsigned char*)lds_raw;
    cg::grid_group grid = cg::this_grid();
    const int G = gridDim.x, bx = blockIdx.x;
    const int wv = __builtin_amdgcn_readfirstlane((int)(threadIdx.x >> 6));
    Ctx C;
#pragma unroll
    for (int i = 0; i < 21; ++i) C.in[i] = prm.in[i];
    C.out = prm.out; C.ws = prm.ws;
    unsigned char* ws = prm.ws;
    unsigned* gbar = (unsigned*)(ws + WS_BAR);
    volatile LAS unsigned* bst = (volatile LAS unsigned*)(lds + LDS_BYTES - 16);
#ifndef DUP_BAR
#define DUP_BAR 0
#endif
#define GBAR() do { for (int rb_ = 0; rb_ < 1 + DUP_BAR; ++rb_) grid_bar(gbar, bst, (unsigned)G, wv); } while (0)
    if (bx == 0) for (int i = threadIdx.x; i < XCD_BAR_WORDS; i += 512) gbar[i] = 0u;
    if (threadIdx.x < 4) ((LAS unsigned*)(lds + LDS_BYTES - 16))[threadIdx.x] = 0u;
    grid.sync();
    if (threadIdx.x == 0) (void)xb_add(&gbar[XB_XCNT(xb_xcc_id())], 1u);
    for (int rep = 0; rep < 1 + DUP_P0; ++rep) { p0_prologue(C, lds, G, wv); __syncthreads(); }
    GBAR();
    for (int rep = 0; rep < 1 + DUP_FILT; ++rep) p1_filters(C, lds, G, wv);
    { HyProg P; P.K = DM; P.G = G; P.c = bx; P.W = (const bf16_t*)(ws + WS_WIN); P.X = (const bf16_t*)(ws + WS_XB); P.HY = (bf16_t*)(ws + WS_HY); P.r1 = (const float*)(ws + WS_R1S);
      pg8::gemm_stream(lds, P, wv); }
    for (int rep = 0; rep < 1 + DUP_REST; ++rep) { RestProg P; P.K = DM; P.G = G; P.c = bx; P.W = (const bf16_t*)(ws + WS_WIN); P.X = (const bf16_t*)(ws + WS_XB); P.R1A = (bf16_t*)(ws + WS_R1A); P.R1B = (bf16_t*)(ws + WS_R1B); P.R2 = (bf16_t*)prm.out; P.r1 = (const float*)(ws + WS_R1S);
      pg8::gemm_stream(lds, P, wv); }
    GBAR();
    for (int rep = 0; rep < 1 + DUP_PRE; ++rep) qk_prepass(C, G, wv);
    for (int rep = 0; rep < 1 + DUP_HY; ++rep) for (int idx = bx; idx < 1024; idx += G) { const int rd = idx >> 8, bb = idx & 255; hyena_item(C, lds, rd * 256 + (bb & 7) * 32 + (bb >> 3), wv); }
    GBAR();
    for (int rep = 0; rep < 1 + DUP_ML; ++rep) for (int item = bx; item < 256; item += G) mlstm_item(C, lds, item, wv);
    GBAR();
    { BranchProg P; P.K = 1024; P.G = G; P.c = bx; P.YA = (const bf16_t*)(ws + WS_YA); P.YBF = (const bf16_t*)(ws + WS_YBF); P.YBB = (const bf16_t*)(ws + WS_YBB);
      P.WA = (const bf16_t*)(ws + WS_WA); P.WB = (const bf16_t*)(ws + WS_WB); P.R2 = (const bf16_t*)prm.out; P.MIX = (bf16_t*)(ws + WS_MIX);
      pg8::gemm_stream(lds, P, wv); }
    GBAR();
    { ResProg P; P.K = DM; P.G = G; P.c = bx; P.A = (const bf16_t*)(ws + WS_MIX); P.B = (const bf16_t*)(ws + WS_WOUT); P.base = prm.in[0]; P.out = prm.out; P.outb = (bf16_t*)(ws + WS_X1B); P.ss = (float*)(ws + WS_SS2);
      pg8::gemm_stream(lds, P, wv); }
    GBAR();
    for (int rep = 0; rep < 1 + DUP_GU; ++rep) { GuProg P; P.K = DM; P.G = G; P.c = bx; P.X = (const bf16_t*)(ws + WS_X1B); P.W = (const bf16_t*)(ws + WS_WGU); P.HH = (bf16_t*)(ws + WS_HH); P.ss2 = (const float*)(ws + WS_SS2);
      pg8::gemm_stream(lds, P, wv); }
    GBAR();
    { ResProg P; P.K = FFH; P.G = G; P.c = bx; P.A = (const bf16_t*)(ws + WS_HH); P.B = (const bf16_t*)(ws + WS_WD); P.base = prm.out; P.out = prm.out; P.outb = nullptr; P.ss = (float*)(ws + WS_SS3);
      pg8::gemm_stream(lds, P, wv); }
    GBAR();
    p7_final(C, G, wv);
}

extern "C" void kernel_launch(void* const* d_in, const int* in_sizes, int n_in, void* d_out, int out_size, void* d_ws, size_t ws_size, hipStream_t stream) {
    static int grid = 0;
    if (grid == 0) {
        int dev = 0, cus = 0, per_cu = 0;
        hipGetDevice(&dev); hipDeviceGetAttribute(&cus, hipDeviceAttributeMultiprocessorCount, dev);
        if (hipFuncSetAttribute((const void*)fwd_megakernel, hipFuncAttributeMaxDynamicSharedMemorySize, LDS_BYTES) != hipSuccess) { fprintf(stderr, "kernel_launch: hipFuncSetAttribute failed\n"); grid = -1; return; }
        if (hipOccupancyMaxActiveBlocksPerMultiprocessor(&per_cu, (const void*)fwd_megakernel, 512, LDS_BYTES) != hipSuccess || per_cu < 1) { fprintf(stderr, "kernel_launch: occupancy query gave %d\n", per_cu); per_cu = 1; }
        (void)hipGetLastError();
        grid = cus * 1;
        if (n_in != 21 || ws_size < WS_END) { fprintf(stderr, "kernel_launch: unexpected n_in %d or ws %zu\n", n_in, ws_size); grid = -1; return; }
    }
    if (grid < 0) return;
    Params p{};
    for (int i = 0; i < 21; ++i) p.in[i] = (const float*)d_in[i];
    p.out = (float*)d_out; p.ws = (unsigned char*)d_ws;
    void* args[] = {&p};
    hipError_t e = hipLaunchCooperativeKernel((const void*)fwd_megakernel, dim3(grid), dim3(512), args, LDS_BYTES, stream);
    if (e != hipSuccess) fprintf(stderr, "cooperative launch failed: %s (grid %d)\n", hipGetErrorString(e), grid);
}
```

```cpp
#include <hip/hip_runtime.h>
#include <hip/hip_cooperative_groups.h>
#include <cstdio>
namespace cg = cooperative_groups;

#define LAS __attribute__((address_space(3)))
typedef unsigned short bf16_t;
typedef short bf16x8 __attribute__((ext_vector_type(8)));
typedef short bf16x4 __attribute__((ext_vector_type(4)));
typedef float f32x4 __attribute__((ext_vector_type(4)));
typedef float f32x2 __attribute__((ext_vector_type(2)));
typedef unsigned u32x4 __attribute__((ext_vector_type(4)));
typedef unsigned u32x2 __attribute__((ext_vector_type(2)));

constexpr int NB = 4, SEQ = 4096, TOK = NB * SEQ, DM = 2048, HW = 1024, MW = 1024, NHEAD = 4, DH = 256, FFH = 5632;
constexpr int CONVC = 5120, INCOLS = 11280, NFILT = 4096;
constexpr float RMS_EPS = 1e-6f;
constexpr size_t MiB = 1u << 20;
constexpr size_t WS_BAR = 262144, WS_R1S = 0, WS_SS2 = 65536, WS_SS3 = 131072, WS_G = 1 * MiB, WS_H2 = 2 * MiB;
constexpr size_t WS_WA = 4 * MiB, WS_WB = 8 * MiB, WS_WOUT = 12 * MiB, WS_WGU = 20 * MiB, WS_WD = 64 * MiB, WS_WIN = 86 * MiB, WS_XB = 130 * MiB;
constexpr size_t WS_FILT = 194 * MiB, WS_HY = 258 * MiB, WS_R1A = 354 * MiB, WS_R1B = 418 * MiB, WS_END = 494 * MiB;
constexpr size_t WS_QKP = 86 * MiB, WS_YA = 150 * MiB, WS_YBF = 354 * MiB, WS_YBB = 386 * MiB, WS_X1B = 86 * MiB, WS_MIX = 194 * MiB, WS_HH = 258 * MiB;
constexpr size_t WS_GSC = 482 * MiB;
constexpr int LDS_BYTES = 155648;

__device__ __forceinline__ unsigned f2bf(float f) { unsigned u = __float_as_uint(f); return (u + 0x7fffu + ((u >> 16) & 1u)) >> 16; }
__device__ __forceinline__ unsigned pk2(float lo, float hi) { unsigned r; asm volatile("v_cvt_pk_bf16_f32 %0, %1, %2" : "=v"(r) : "v"(lo), "v"(hi)); return r; }
__device__ __forceinline__ float bflo(unsigned w) { return __uint_as_float(w << 16); }
__device__ __forceinline__ float bfhi(unsigned w) { return __uint_as_float(w & 0xffff0000u); }
__device__ __forceinline__ float wave_sum(float v) {
#pragma unroll
    for (int o = 1; o < 64; o <<= 1) v += __shfl_xor(v, o);
    return v;
}
__device__ __forceinline__ size_t blk_off(int row, int k, int K) { return ((size_t)(row >> 7) * (size_t)(K >> 6) + (size_t)(k >> 6)) * 8192 + (size_t)((row & 127) * 64 + (k & 63)); }
__device__ __forceinline__ int lane_id_opaque() { int l; asm volatile("v_mbcnt_lo_u32_b32 %0, -1, 0\n\tv_mbcnt_hi_u32_b32 %0, -1, %0" : "=v"(l)); return l; }
__device__ __forceinline__ float sigmoidf_(float x) { return 1.0f / (1.0f + __expf(-x)); }
__device__ __forceinline__ float siluf_(float x) { return x / (1.0f + __expf(-x)); }

namespace pg8 {
constexpr int BM = 256, BK = 64, HALF = 128, HTB = HALF * BK * 2, STAGE_BYTES = 8 * HTB, NXCD = 8, WGM = 8;
__device__ __forceinline__ int lds_byte(int r, int c) { const int st = (r >> 4) * 2 + (c >> 5), rr = r & 15, cc = c & 31, ob = rr * 64 + cc * 2; return st * 1024 + (ob ^ (((ob >> 9) & 1) << 5)); }
__device__ __forceinline__ void stage_rc(int b, int& R, int& C) { const int st = b / 1024, sb = b % 1024, swz = sb ^ (((sb >> 9) & 1) << 5); R = (st >> 1) * 16 + swz / 64; C = (st & 1) * 32 + (swz % 64) / 2; }
__device__ __forceinline__ int perm32(int rho) { const int n = rho >> 4, i = rho & 15; return 8 * (i >> 2) + 4 * n + (i & 3); }
struct GUnit { const char* A; const char* B; int pm, pn, sub; };
__device__ __forceinline__ void tile_of(int L, int nM, int nN, int& pm, int& pn) {
    const int nwg = nM * nN; int wgid = L; { const int q = nwg / NXCD, r = nwg % NXCD, xcd = wgid % NXCD, off = wgid / NXCD; wgid = (xcd < r ? xcd * (q + 1) : r * (q + 1) + (xcd - r) * q) + off; }
    const int nig = WGM * nN, gid = wgid / nig, fm = gid * WGM, gsz = (nM - fm) < WGM ? (nM - fm) : WGM;
    pm = fm + ((wgid % nig) % gsz); pn = (wgid % nig) / gsz;
}
typedef f32x4 Acc[2][2][4][2];
template <class Prog>
__device__ __forceinline__ void gemm_stream(LAS unsigned char* lds, const Prog& P, int wv) {
    int tid = (wv << 6) | lane_id_opaque(); asm volatile("" : "+v"(tid));
    const int wid = __builtin_amdgcn_readfirstlane(tid >> 6), lane = tid & 63, wr = wid >> 2, wc = wid & 3, fr = lane & 15, fq = lane >> 4;
    const int K = P.K, nt = K / BK;
    unsigned voffA[2], voffB[2];
#pragma unroll
    for (int i = 0; i < 2; ++i) { int R, C; stage_rc(tid * 16 + i * 8192, R, C); const int Rb = Prog::PERM ? ((R & ~31) + perm32(R & 31)) : R;
        voffA[i] = (unsigned)(R * 64 + C) * 2u; voffB[i] = (unsigned)(Rb * 64 + C) * 2u; }
    const size_t kstep = (size_t)(HALF * BK * 2);
    const size_t hstep = (size_t)HALF * K * 2;
    const unsigned ldsw = (unsigned)wid * 1024u;
    const int aoff = lds_byte(wr * 64 + fr, fq * 8), boff = lds_byte(wc * 32 + fr, fq * 8);
#define PG8_SA(b, h) (((b) * 2 + (h)) * HTB)
#define PG8_SB(b, h) ((4 + (b) * 2 + (h)) * HTB)
#define PG8_STAGE(bufoff, gbase, voff) do { _Pragma("unroll") for (int _i = 0; _i < 2; ++_i) \
        __builtin_amdgcn_global_load_lds((const unsigned*)((const char*)(gbase) + (voff)[_i]), (LAS unsigned*)(lds + (bufoff) + ldsw + _i * 8192), 16, 0, 0); } while (0)
#define PG8_LDA(dst, b, h) do { _Pragma("unroll") for (int m = 0; m < 4; ++m) _Pragma("unroll") for (int k = 0; k < 2; ++k) dst[m][k] = *(const LAS bf16x8*)(lds + PG8_SA(b, h) + aoff + m * 2048 + k * 1024); } while (0)
#define PG8_LDB(dst, b, h) do { _Pragma("unroll") for (int n = 0; n < 2; ++n) _Pragma("unroll") for (int k = 0; k < 2; ++k) dst[n][k] = *(const LAS bf16x8*)(lds + PG8_SB(b, h) + boff + n * 2048 + k * 1024); } while (0)
#define PG8_MMA(ai, bj, At, Bt) do { __builtin_amdgcn_s_setprio(1); _Pragma("unroll") for (int m = 0; m < 4; ++m) _Pragma("unroll") for (int n = 0; n < 2; ++n) _Pragma("unroll") for (int k = 0; k < 2; ++k) \
        acc[ai][bj][m][n] = __builtin_amdgcn_mfma_f32_16x16x32_bf16(Bt[n][k], At[m][k], acc[ai][bj][m][n], 0, 0, 0); __builtin_amdgcn_s_setprio(0); } while (0)
#define PG8_WAIT_V(n) asm volatile("s_waitcnt vmcnt(" #n ")" ::: "memory")
#define PG8_WAIT_L(n) asm volatile("s_waitcnt lgkmcnt(" #n ")" ::: "memory")
#define PG8_BAR __builtin_amdgcn_s_barrier()
#define PG8_SCHED __builtin_amdgcn_sched_barrier(0)
    GUnit cur, nxt; int ui = 0;
    if (!P.next(0, cur)) return;
    f32x4 acc[2][2][4][2];
#pragma unroll
    for (int a = 0; a < 2; ++a)
#pragma unroll
        for (int b = 0; b < 2; ++b)
#pragma unroll
            for (int m = 0; m < 4; ++m)
#pragma unroll
                for (int n = 0; n < 2; ++n) acc[a][b][m][n] = (f32x4){0.f, 0.f, 0.f, 0.f};
    bf16x8 At[4][2], B0[2][2], B1[2][2];
    const char* cA = cur.A; const char* cB = cur.B;
    PG8_STAGE(PG8_SB(0, 0), cB, voffB); PG8_STAGE(PG8_SA(0, 0), cA, voffA); PG8_STAGE(PG8_SB(0, 1), cB + hstep, voffB); PG8_STAGE(PG8_SA(0, 1), cA + hstep, voffA);
    if (wr == 1) PG8_BAR;
    PG8_WAIT_V(4); PG8_BAR;
    PG8_STAGE(PG8_SB(1, 0), cB + kstep, voffB); PG8_STAGE(PG8_SA(1, 0), cA + kstep, voffA); PG8_STAGE(PG8_SB(1, 1), cB + hstep + kstep, voffB);
    PG8_WAIT_V(6); PG8_BAR;
    for (;;) {
        const bool has_next = P.next(ui + 1, nxt);
        const char* nA = has_next ? nxt.A : cA; const char* nB = has_next ? nxt.B : cB;
        for (int t = 0; t < nt; t += 2) {
            const bool last = (t == nt - 2);
            const char* a1 = cA + (size_t)(t + 1) * kstep;
            const char* a2 = last ? nA : cA + (size_t)(t + 2) * kstep; const char* b2 = last ? nB : cB + (size_t)(t + 2) * kstep;
            const char* a3 = a2 + kstep; const char* b3 = b2 + kstep;
            PG8_LDB(B0, 0, 0); PG8_SCHED; PG8_LDA(At, 0, 0); PG8_STAGE(PG8_SA(1, 1), a1 + hstep, voffA);
            PG8_WAIT_L(8); PG8_BAR; PG8_WAIT_L(0); PG8_MMA(0, 0, At, B0); PG8_BAR; PG8_SCHED;
            PG8_LDB(B1, 0, 1); PG8_STAGE(PG8_SB(0, 0), b2, voffB);
            PG8_BAR; PG8_WAIT_L(0); PG8_MMA(0, 1, At, B1); PG8_BAR;
            PG8_LDA(At, 0, 1); PG8_STAGE(PG8_SA(0, 0), a2, voffA);
            PG8_BAR; PG8_WAIT_L(0); PG8_MMA(1, 0, At, B0); PG8_BAR; PG8_SCHED;
            PG8_STAGE(PG8_SB(0, 1), b2 + hstep, voffB);
            PG8_WAIT_V(6); PG8_BAR; PG8_MMA(1, 1, At, B1); PG8_BAR;
            PG8_LDB(B0, 1, 0); PG8_SCHED; PG8_LDA(At, 1, 0); PG8_STAGE(PG8_SA(0, 1), a2 + hstep, voffA);
            PG8_WAIT_L(8); PG8_BAR; PG8_WAIT_L(0); PG8_MMA(0, 0, At, B0); PG8_BAR; PG8_SCHED;
            PG8_LDB(B1, 1, 1); PG8_STAGE(PG8_SB(1, 0), b3, voffB);
            PG8_BAR; PG8_WAIT_L(0); PG8_MMA(0, 1, At, B1); PG8_BAR;
            PG8_LDA(At, 1, 1); PG8_STAGE(PG8_SA(1, 0), a3, voffA);
            PG8_BAR; PG8_WAIT_L(0); PG8_MMA(1, 0, At, B0); PG8_BAR; PG8_SCHED;
            PG8_STAGE(PG8_SB(1, 1), b3 + hstep, voffB);
            PG8_WAIT_V(6); PG8_BAR; PG8_MMA(1, 1, At, B1); PG8_BAR;
        }
        P.epi(acc, cur, wr, wc, fr, fq);
        if (!has_next) break;
        cur = nxt; cA = nA; cB = nB; ++ui;
    }
    PG8_WAIT_V(0);
    if (wr == 0) PG8_BAR;
    PG8_BAR;
#undef PG8_SA
#undef PG8_SB
#undef PG8_STAGE
#undef PG8_LDA
#undef PG8_LDB
#undef PG8_MMA
#undef PG8_WAIT_V
#undef PG8_WAIT_L
#undef PG8_BAR
#undef PG8_SCHED
}
__device__ __forceinline__ void zero_acc(Acc& acc) {
#pragma unroll
    for (int a = 0; a < 2; ++a)
#pragma unroll
        for (int b = 0; b < 2; ++b)
#pragma unroll
            for (int m = 0; m < 4; ++m)
#pragma unroll
                for (int n = 0; n < 2; ++n) acc[a][b][m][n] = (f32x4){0.f, 0.f, 0.f, 0.f};
}
}
using pg8::GUnit; using pg8::Acc;
__device__ __forceinline__ void unpack8(u32x4 w, float (&f)[8]) { f[0] = bflo(w.x); f[1] = bfhi(w.x); f[2] = bflo(w.y); f[3] = bfhi(w.y); f[4] = bflo(w.z); f[5] = bfhi(w.z); f[6] = bflo(w.w); f[7] = bfhi(w.w); }
struct HyProg {
    static constexpr bool PERM = true; int K, G, c; const bf16_t* W; const bf16_t* X; bf16_t* HY; const float* r1;
    __device__ __forceinline__ bool next(int i, GUnit& u) const { const int L = i * G + c; if (L >= 12 * 64) return false; pg8::tile_of(L, 12, 64, u.pm, u.pn);
        u.A = (const char*)(W + (size_t)u.pm * 256 * DM); u.B = (const char*)(X + (size_t)u.pn * 256 * DM); u.sub = 0; return true; }
    __device__ __forceinline__ void epi(Acc& acc, const GUnit& u, int wr, int wc, int fr, int fq) const {
        const int row0 = u.pm * 256 + wr * 64 + fr, col0 = u.pn * 256 + wc * 32 + 8 * fq;
        f32x4 sc[2][2];
#pragma unroll
        for (int bj = 0; bj < 2; ++bj) { sc[bj][0] = *(const f32x4*)(r1 + col0 + bj * 128); sc[bj][1] = *(const f32x4*)(r1 + col0 + bj * 128 + 4); }
#pragma unroll
        for (int ai = 0; ai < 2; ++ai)
#pragma unroll
            for (int m = 0; m < 4; ++m) { bf16_t* rowp = HY + (size_t)(row0 + ai * 128 + m * 16) * TOK + col0;
#pragma unroll
                for (int bj = 0; bj < 2; ++bj) { const f32x4 v0 = acc[ai][bj][m][0] * sc[bj][0], v1 = acc[ai][bj][m][1] * sc[bj][1];
                    u32x4 w; w.x = pk2(v0[0], v0[1]); w.y = pk2(v0[2], v0[3]); w.z = pk2(v1[0], v1[1]); w.w = pk2(v1[2], v1[3]);
                    *(u32x4*)(rowp + bj * 128) = w; } }
        pg8::zero_acc(acc);
    }
};
struct RestProg {
    static constexpr bool PERM = true; int K, G, c; const bf16_t* W; const bf16_t* X; bf16_t* R1A; bf16_t* R1B; bf16_t* R2; const float* r1;
    __device__ __forceinline__ bool next(int i, GUnit& u) const { const int L = i * G + c; if (L >= 64 * 32) return false; pg8::tile_of(L, 64, 32, u.pm, u.pn);
        u.A = (const char*)(X + (size_t)u.pm * 256 * DM); u.B = (const char*)(W + (size_t)(3072 + u.pn * 256) * DM); u.sub = 0; return true; }
    __device__ __forceinline__ void epi(Acc& acc, const GUnit& u, int wr, int wc, int fr, int fq) const {
        const int row0 = u.pm * 256 + wr * 64 + fr; const bool sg = u.pn >= 12;
        bf16_t* base = u.pn < 8 ? R1A + u.pn * 256 : (u.pn < 16 ? R1B + (u.pn - 8) * 256 : R2 + (u.pn - 16) * 256);
        const int pitch = u.pn < 16 ? 2048 : 4096;
        const int col0 = wc * 32 + 8 * fq;
        float rs[2][4];
#pragma unroll
        for (int ai = 0; ai < 2; ++ai)
#pragma unroll
            for (int m = 0; m < 4; ++m) rs[ai][m] = r1[row0 + ai * 128 + m * 16];
#pragma unroll
        for (int ai = 0; ai < 2; ++ai)
#pragma unroll
            for (int m = 0; m < 4; ++m) { const int row = row0 + ai * 128 + m * 16; const float s = rs[ai][m]; bf16_t* rowp = base + (size_t)row * pitch + col0;
#pragma unroll
                for (int bj = 0; bj < 2; ++bj) { f32x4 v0 = acc[ai][bj][m][0] * s, v1 = acc[ai][bj][m][1] * s;
                    if (sg) {
#pragma unroll
                        for (int j = 0; j < 4; ++j) { v0[j] = sigmoidf_(v0[j]); v1[j] = sigmoidf_(v1[j]); } }
                    u32x4 w; w.x = pk2(v0[0], v0[1]); w.y = pk2(v0[2], v0[3]); w.z = pk2(v1[0], v1[1]); w.w = pk2(v1[2], v1[3]);
                    *(u32x4*)(rowp + bj * 128) = w; } }
        pg8::zero_acc(acc);
    }
};
struct BranchProg {
    static constexpr bool PERM = true; int K, G, c; const bf16_t *YA, *YBF, *YBB, *WA, *WB; const bf16_t* R2; bf16_t* MIX;
    __device__ __forceinline__ bool next(int i, GUnit& u) const { const int ti = i / 3, sub = i - 3 * ti; const int L = ti * G + c; if (L >= 64 * 8) return false; pg8::tile_of(L, 64, 8, u.pm, u.pn);
        const bf16_t* a = sub == 0 ? YA : (sub == 1 ? YBF : YBB); const bf16_t* b = sub == 0 ? WA : WB;
        u.A = (const char*)(a + (size_t)u.pm * 256 * 1024); u.B = (const char*)(b + (size_t)u.pn * 256 * 1024); u.sub = sub; return true; }
    __device__ __forceinline__ void epi(Acc& acc, const GUnit& u, int wr, int wc, int fr, int fq) const {
        if (u.sub == 1) return;
        const int row0 = u.pm * 256 + wr * 64 + fr, col0 = u.pn * 256 + wc * 32 + 8 * fq;
#pragma unroll
        for (int ai = 0; ai < 2; ++ai) {
            u32x4 gbw[4][2], gaw[4][2];
#pragma unroll
            for (int m = 0; m < 4; ++m)
#pragma unroll
                for (int bj = 0; bj < 2; ++bj) { const bf16_t* gp = R2 + (size_t)(row0 + ai * 128 + m * 16) * 4096 + col0 + bj * 128;
                    gbw[m][bj] = *(const u32x4*)(gp + 2048); if (u.sub == 0) gaw[m][bj] = *(const u32x4*)gp; else gaw[m][bj] = gbw[m][bj]; }
#pragma unroll
            for (int m = 0; m < 4; ++m) { const int row = row0 + ai * 128 + m * 16;
#pragma unroll
                for (int bj = 0; bj < 2; ++bj) {
                    float gb[8], ga[8]; unpack8(gbw[m][bj], gb); unpack8(gaw[m][bj], ga);
                    if (u.sub == 0) {
#pragma unroll
                        for (int j = 0; j < 4; ++j) { acc[ai][bj][m][0][j] *= ga[j] / fmaxf(gb[j], 1e-30f); acc[ai][bj][m][1][j] *= ga[4 + j] / fmaxf(gb[4 + j], 1e-30f); }
                    } else {
                        f32x4 v0 = acc[ai][bj][m][0], v1 = acc[ai][bj][m][1];
#pragma unroll
                        for (int j = 0; j < 4; ++j) { v0[j] *= fmaxf(gb[j], 1e-30f); v1[j] *= fmaxf(gb[4 + j], 1e-30f); }
                        u32x4 w; w.x = pk2(v0[0], v0[1]); w.y = pk2(v0[2], v0[3]); w.z = pk2(v1[0], v1[1]); w.w = pk2(v1[2], v1[3]);
                        *(u32x4*)(MIX + blk_off(row, col0 + bj * 128, DM)) = w;
                    } } }
        }
        if (u.sub == 2) pg8::zero_acc(acc);
    }
};
struct ResProg {
    static constexpr bool PERM = false; int K, G, c; const bf16_t* A; const bf16_t* B; const float* base; float* out; bf16_t* outb; float* ss;
    __device__ __forceinline__ bool next(int i, GUnit& u) const { const int L = i * G + c; if (L >= 64 * 8) return false; pg8::tile_of(L, 64, 8, u.pm, u.pn);
        u.A = (const char*)(A + (size_t)u.pm * 256 * K); u.B = (const char*)(B + (size_t)u.pn * 256 * K); u.sub = 0; return true; }
    __device__ __forceinline__ void epi(Acc& acc, const GUnit& u, int wr, int wc, int fr, int fq) const {
        const int row0 = u.pm * 256 + wr * 64 + fr, col0 = u.pn * 256 + wc * 32 + 4 * fq;
#pragma unroll
        for (int ai = 0; ai < 2; ++ai) {
            f32x4 bs[4][2][2];
#pragma unroll
            for (int m = 0; m < 4; ++m)
#pragma unroll
                for (int bj = 0; bj < 2; ++bj)
#pragma unroll
                    for (int n = 0; n < 2; ++n) bs[m][bj][n] = *(const f32x4*)(base + (size_t)(row0 + ai * 128 + m * 16) * DM + col0 + bj * 128 + n * 16);
#pragma unroll
            for (int m = 0; m < 4; ++m) { const int row = row0 + ai * 128 + m * 16; const size_t off = (size_t)row * DM + col0; float s = 0.f;
#pragma unroll
                for (int bj = 0; bj < 2; ++bj)
#pragma unroll
                    for (int n = 0; n < 2; ++n) { const f32x4 o = bs[m][bj][n] + acc[ai][bj][m][n];
                        *(f32x4*)(out + off + bj * 128 + n * 16) = o; s += (o[0] * o[0] + o[1] * o[1]) + (o[2] * o[2] + o[3] * o[3]);
                        if (outb) { u32x2 w; w.x = pk2(o[0], o[1]); w.y = pk2(o[2], o[3]); *(u32x2*)(outb + blk_off(row, col0 + bj * 128 + n * 16, DM)) = w; } }
                s += __shfl_xor(s, 16); s += __shfl_xor(s, 32);
                if (fq == 0) unsafeAtomicAdd(ss + row, s); }
        }
        pg8::zero_acc(acc);
    }
};
struct GuProg {
    static constexpr bool PERM = true; int K, G, c; const bf16_t* X; const bf16_t* W; bf16_t* HH; const float* ss2;
    __device__ __forceinline__ bool next(int i, GUnit& u) const { const int L = i * G + c; if (L >= 64 * 44) return false; pg8::tile_of(L, 64, 44, u.pm, u.pn);
        u.A = (const char*)(X + (size_t)u.pm * 256 * DM); u.B = (const char*)(W + (size_t)u.pn * 256 * DM); u.sub = 0; return true; }
    __device__ __forceinline__ void epi(Acc& acc, const GUnit& u, int wr, int wc, int fr, int fq) const {
        const int row0 = u.pm * 256 + wr * 64 + fr, col0 = u.pn * 128 + wc * 32 + 8 * fq;
        float sq[2][4];
#pragma unroll
        for (int ai = 0; ai < 2; ++ai)
#pragma unroll
            for (int m = 0; m < 4; ++m) sq[ai][m] = ss2[row0 + ai * 128 + m * 16];
#pragma unroll
        for (int ai = 0; ai < 2; ++ai)
#pragma unroll
            for (int m = 0; m < 4; ++m) { const int row = row0 + ai * 128 + m * 16; const float r2 = 1.0f / sqrtf(sq[ai][m] * (1.0f / DM) + RMS_EPS);
                float hv[8];
#pragma unroll
                for (int n = 0; n < 2; ++n)
#pragma unroll
                    for (int j = 0; j < 4; ++j) { const float g = acc[ai][0][m][n][j] * r2, uu = acc[ai][1][m][n][j] * r2; hv[4 * n + j] = siluf_(g) * uu; }
                u32x4 w; w.x = pk2(hv[0], hv[1]); w.y = pk2(hv[2], hv[3]); w.z = pk2(hv[4], hv[5]); w.w = pk2(hv[6], hv[7]);
                *(u32x4*)(HH + blk_off(row, col0, FFH)) = w; }
        pg8::zero_acc(acc);
    }
};
struct Ctx {
    const float* in[21]; float* out; unsigned char* ws;
};
struct TpItem { const float* W; const float* ks; bf16_t* WT; int Nsrc, K, dst_row0, src_col0, kb; };
__device__ __forceinline__ TpItem tp_decode(const Ctx& C, int it) {
    constexpr int I_IN = 32 * 352, I_A = 16 * 64, I_O = 32 * 64, I_GU = 32 * 352;
    unsigned char* ws = C.ws; TpItem t; int r = it;
    if (r < I_IN) { const int nb = r % 352, n0 = nb * 32; t.W = C.in[2]; t.ks = C.in[1]; t.WT = (bf16_t*)(ws + WS_WIN); t.Nsrc = INCOLS; t.K = DM; t.dst_row0 = n0; t.src_col0 = n0 < 7168 ? n0 : n0 + 16; t.kb = r / 352; return t; } r -= I_IN;
    if (r < I_A) { t.W = C.in[14]; t.ks = nullptr; t.WT = (bf16_t*)(ws + WS_WA); t.Nsrc = DM; t.K = HW; t.dst_row0 = (r % 64) * 32; t.src_col0 = t.dst_row0; t.kb = r / 64; return t; } r -= I_A;
    if (r < I_A) { t.W = C.in[15]; t.ks = nullptr; t.WT = (bf16_t*)(ws + WS_WB); t.Nsrc = DM; t.K = MW; t.dst_row0 = (r % 64) * 32; t.src_col0 = t.dst_row0; t.kb = r / 64; return t; } r -= I_A;
    if (r < I_O) { t.W = C.in[16]; t.ks = nullptr; t.WT = (bf16_t*)(ws + WS_WOUT); t.Nsrc = DM; t.K = DM; t.dst_row0 = (r % 64) * 32; t.src_col0 = t.dst_row0; t.kb = r / 64; return t; } r -= I_O;
    if (r < I_GU) { const int nb = r % 352, n0 = nb * 32; const int pn = n0 >> 8, half = (n0 >> 7) & 1, i = n0 & 127;
        t.W = C.in[18]; t.ks = C.in[17]; t.WT = (bf16_t*)(ws + WS_WGU); t.Nsrc = 2 * FFH; t.K = DM; t.dst_row0 = n0; t.src_col0 = half * FFH + 128 * pn + i; t.kb = r / 352; return t; } r -= I_GU;
    t.W = C.in[19]; t.ks = nullptr; t.WT = (bf16_t*)(ws + WS_WD); t.Nsrc = DM; t.K = FFH; t.dst_row0 = (r % 64) * 32; t.src_col0 = t.dst_row0; t.kb = r / 64; return t;
}
__device__ __forceinline__ void tp_load(const TpItem& t, int lane, float (&tv)[32], float (&sv)[32]) {
    const int k0 = 64 * t.kb; const float* wp = t.W + (size_t)(k0 + (lane >> 5)) * t.Nsrc + t.src_col0 + (lane & 31);
#pragma unroll
    for (int i = 0; i < 32; ++i) tv[i] = wp[(size_t)(2 * i) * t.Nsrc];
    const float* kp = t.ks ? t.ks + k0 + (lane >> 5) : nullptr;
#pragma unroll
    for (int i = 0; i < 32; ++i) sv[i] = kp ? kp[2 * i] : 1.0f;
}
__device__ __forceinline__ void p0_prologue(const Ctx& C, LAS unsigned char* lds, int G, int wv) {
    int tid = (wv << 6) | lane_id_opaque(); asm volatile("" : "+v"(tid));
    const int lane = tid & 63, wave = __builtin_amdgcn_readfirstlane(tid >> 6);
    const int gw = blockIdx.x * 8 + wave, NGW = G * 8;
    unsigned char* ws = C.ws;
    LAS float* scr = (LAS float*)(lds + wave * 8704);
    {
        constexpr int NIT = 32 * 352 + 2 * 16 * 64 + 32 * 64 + 32 * 352 + 88 * 64;
        float tv[32], sv[32]; TpItem cur, nxt; int it = gw;
        if (it < NIT) { cur = tp_decode(C, it); tp_load(cur, lane, tv, sv); }
        while (it < NIT) {
#pragma unroll
            for (int i = 0; i < 32; ++i) scr[(2 * i + (lane >> 5)) * 33 + (lane & 31)] = tv[i] * sv[i];
            asm volatile("s_waitcnt lgkmcnt(0)" ::: "memory");
            const int nit = it + NGW;
            if (nit < NIT) { nxt = tp_decode(C, nit); tp_load(nxt, lane, tv, sv); }
            const int c = lane & 7, k0 = 64 * cur.kb;
#pragma unroll
            for (int j = 0; j < 4; ++j) { const int n = (lane >> 3) + 8 * j; const LAS float* sp = scr + (8 * c) * 33 + n;
                u32x4 o; o.x = pk2(sp[0 * 33], sp[1 * 33]); o.y = pk2(sp[2 * 33], sp[3 * 33]); o.z = pk2(sp[4 * 33], sp[5 * 33]); o.w = pk2(sp[6 * 33], sp[7 * 33]);
                *(u32x4*)(cur.WT + blk_off(cur.dst_row0 + n, k0 + 8 * c, cur.K)) = o; }
            asm volatile("s_waitcnt lgkmcnt(0)" ::: "memory");
            cur = nxt; it = nit;
        }
    }
    for (int i = blockIdx.x * 512 + tid; i < TOK; i += G * 512) { ((float*)(ws + WS_SS2))[i] = 0.f; ((float*)(ws + WS_SS3))[i] = 0.f; }
    {
        const float* w1 = C.in[5]; const float* b1 = C.in[6]; const float* f1 = C.in[7]; const float* w2 = C.in[8]; const float* b2 = C.in[9]; const float* f2 = C.in[10];
        float* h2 = (float*)(ws + WS_H2);
        for (int t = gw; t < SEQ; t += NGW) {
            const float tl = (float)t / (float)(SEQ - 1);
            const float omega = 6.283185307179586f * (float)t / (float)SEQ;
            float a = b1[lane] + tl * w1[lane];
            float sn, cs;
            { const int bi = lane & 15; const float fr = 1e-4f + (float)bi * ((15.0f - 1e-4f) / 15.0f); sincosf(omega * fr, &sn, &cs); }
#pragma unroll
            for (int i = 0; i < 16; ++i) a += __shfl(cs, i) * w1[(1 + i) * 64 + lane] - __shfl(sn, i) * w1[(17 + i) * 64 + lane];
            const float h1 = sinf(f1[lane] * a);
            float a2 = b2[lane];
#pragma unroll 8
            for (int i = 0; i < 64; ++i) a2 += __shfl(h1, i) * w2[i * 64 + lane];
            h2[t * 64 + lane] = sinf(f2[lane] * a2);
        }
    }
    __syncthreads();
    {
        constexpr int WGP = 2056;
        LAS bf16_t* wgb = (LAS bf16_t*)lds;
        const float* w_in = C.in[2]; const float* nw = C.in[1];
#pragma unroll 1
        for (int i0 = tid; i0 < DM * 16; i0 += 512 * 16) { float tw[16], tn[16];
#pragma unroll
            for (int u = 0; u < 16; ++u) { const int i = i0 + 512 * u, k = i >> 4, g = i & 15; tw[u] = w_in[(size_t)k * INCOLS + 7168 + g]; tn[u] = nw[k]; }
#pragma unroll
            for (int u = 0; u < 16; ++u) { const int i = i0 + 512 * u, k = i >> 4, g = i & 15; wgb[g * WGP + k] = (bf16_t)f2bf(tw[u] * tn[u]); } }
        __syncthreads();
        const float* x = C.in[0]; bf16_t* xb = (bf16_t*)(ws + WS_XB); float* r1 = (float*)(ws + WS_R1S); float* Gt = (float*)(ws + WS_G); const float* gbias = C.in[13];
        const int r = lane & 15, g = lane >> 4; const bool act = r < 8;
        for (int rb = gw; rb < TOK / 8; rb += NGW) {
            const int row = rb * 8 + (r & 7);
            const float* xp = x + (size_t)row * DM + 8 * g;
            f32x4 acc = {0.f, 0.f, 0.f, 0.f}; float ss = 0.f;
#pragma unroll 1
            for (int k8 = 0; k8 < 64; k8 += 8) {
                f32x4 la[8], lb[8];
#pragma unroll
                for (int u = 0; u < 8; ++u) { la[u] = *(const f32x4*)(xp + 32 * (k8 + u)); lb[u] = *(const f32x4*)(xp + 32 * (k8 + u) + 4); }
#pragma unroll
                for (int u = 0; u < 8; ++u) { const int kk = k8 + u; const f32x4 a = la[u], b = lb[u];
                    ss += ((a.x * a.x + a.y * a.y) + (a.z * a.z + a.w * a.w)) + ((b.x * b.x + b.y * b.y) + (b.z * b.z + b.w * b.w));
                    u32x4 o; o.x = pk2(a.x, a.y); o.y = pk2(a.z, a.w); o.z = pk2(b.x, b.y); o.w = pk2(b.z, b.w);
                    *(u32x4*)(xb + blk_off(row, 32 * kk + 8 * g, DM)) = o;
                    if (!act) { o.x = 0u; o.y = 0u; o.z = 0u; o.w = 0u; }
                    const bf16x8 bw = *(const LAS bf16x8*)(wgb + r * WGP + 32 * kk + 8 * g);
                    acc = __builtin_amdgcn_mfma_f32_16x16x32_bf16(__builtin_bit_cast(bf16x8, o), bw, acc, 0, 0, 0); }
            }
            ss += __shfl_xor(ss, 16); ss += __shfl_xor(ss, 32);
            const float rinv = 1.0f / sqrtf(ss * (1.0f / DM) + RMS_EPS);
            const float gb = gbias[r];
#pragma unroll
            for (int i = 0; i < 4; ++i) { const int m = 4 * g + i; const float rv = __shfl(rinv, m & 7); if (g < 2) Gt[(size_t)(rb * 8 + m) * 16 + r] = acc[i] * rv + gb; }
            if (lane < 8) r1[rb * 8 + lane] = rinv;
        }
    }
}
__device__ __forceinline__ void p1_filters(const Ctx& C, LAS unsigned char* lds, int G, int wv) {
    int tid = (wv << 6) | lane_id_opaque(); asm volatile("" : "+v"(tid));
    const int lane = tid & 63, w = tid >> 6, r = lane & 15, g = lane >> 4;
    const float* w3 = C.in[11]; const float* h2 = (const float*)(C.ws + WS_H2); float* FILT = (float*)(C.ws + WS_FILT);
    for (int item = blockIdx.x; item < 256; item += G) {
        const int n0 = 64 * (item >> 2), t0 = 1024 * (item & 3) + 128 * w;
        bf16x8 af[4][2];
#pragma unroll
        for (int mt = 0; mt < 4; ++mt)
#pragma unroll
            for (int ks = 0; ks < 2; ++ks) { float v[8];
#pragma unroll
                for (int e = 0; e < 8; ++e) v[e] = w3[(size_t)(32 * ks + 8 * g + e) * NFILT + n0 + 16 * mt + r];
                u32x4 o; o.x = pk2(v[0], v[1]); o.y = pk2(v[2], v[3]); o.z = pk2(v[4], v[5]); o.w = pk2(v[6], v[7]); af[mt][ks] = __builtin_bit_cast(bf16x8, o); }
        float dl[4][4];
#pragma unroll
        for (int mt = 0; mt < 4; ++mt)
#pragma unroll
            for (int i = 0; i < 4; ++i) { const int ch = (n0 + 16 * mt + 4 * g + i) & 1023; const float mind = -3.0701134573253945f, maxd = -15.350567286626973f;
                dl[mt][i] = fabsf(mind + (float)ch * ((maxd - mind) / 1023.0f)); }
        bf16x8 bfr[8][2];
#pragma unroll
        for (int nt = 0; nt < 8; ++nt) { const int t = t0 + 16 * nt + r;
#pragma unroll
            for (int ks = 0; ks < 2; ++ks) { const f32x4 a = *(const f32x4*)(h2 + (size_t)t * 64 + 32 * ks + 8 * g), b = *(const f32x4*)(h2 + (size_t)t * 64 + 32 * ks + 8 * g + 4);
                u32x4 o; o.x = pk2(a.x, a.y); o.y = pk2(a.z, a.w); o.z = pk2(b.x, b.y); o.w = pk2(b.z, b.w); bfr[nt][ks] = __builtin_bit_cast(bf16x8, o); } }
#pragma unroll
        for (int nt = 0; nt < 8; ++nt) {
            const int t = t0 + 16 * nt + r;
            const float tl = (float)t / (float)(SEQ - 1);
#pragma unroll
            for (int mt = 0; mt < 4; ++mt) {
                f32x4 acc = {0.f, 0.f, 0.f, 0.f};
                acc = __builtin_amdgcn_mfma_f32_16x16x32_bf16(af[mt][0], bfr[nt][0], acc, 0, 0, 0);
                acc = __builtin_amdgcn_mfma_f32_16x16x32_bf16(af[mt][1], bfr[nt][1], acc, 0, 0, 0);
#pragma unroll
                for (int i = 0; i < 4; ++i) FILT[(size_t)(n0 + 16 * mt + 4 * g + i) * SEQ + t] = acc[i] * expf(-tl * dl[mt][i]);
            }
        }
    }
}
__device__ __forceinline__ void p7_final(const Ctx& C, int G, int wv) {
    int tid = (wv << 6) | lane_id_opaque(); asm volatile("" : "+v"(tid));
    const int lane = tid & 63, wave = tid >> 6, gw = blockIdx.x * 8 + wave, NGW = G * 8;
    const float* ss3 = (const float*)(C.ws + WS_SS3); const float* wf = C.in[20];
    f32x4 w[8];
#pragma unroll
    for (int j = 0; j < 8; ++j) w[j] = ((const f32x4*)wf)[64 * j + lane];
    for (int row = gw; row < TOK; row += 2 * NGW) {
        const int row2 = row + NGW;
        const bool has2 = row2 < TOK;
        const float r = 1.0f / sqrtf(ss3[row] * (1.0f / DM) + RMS_EPS), r2 = has2 ? 1.0f / sqrtf(ss3[row2] * (1.0f / DM) + RMS_EPS) : 0.f;
        f32x4* p = (f32x4*)(C.out + (size_t)row * DM) + lane; f32x4* p2 = (f32x4*)(C.out + (size_t)(has2 ? row2 : row) * DM) + lane;
        f32x4 v[8], u[8];
#pragma unroll
        for (int j = 0; j < 8; ++j) { v[j] = p[64 * j]; u[j] = p2[64 * j]; }
#pragma unroll
        for (int j = 0; j < 8; ++j) p[64 * j] = v[j] * r * w[j];
        if (has2) {
#pragma unroll
            for (int j = 0; j < 8; ++j) p2[64 * j] = u[j] * r2 * w[j]; }
    }
}
#ifndef FFT_HOST
#define FFT_DEV __device__ __forceinline__
#define FFT_PTR LAS f32x2*
#define FFT_SIN(x) __builtin_amdgcn_sinf(x)
#define FFT_COS(x) __builtin_amdgcn_cosf(x)
#else
#define FFT_DEV static inline
#define FFT_PTR f32x2*
#define FFT_SIN(x) sinf(6.283185307179586f * (x))
#define FFT_COS(x) cosf(6.283185307179586f * (x))
#endif
#define PADI(i) ((i) + ((i) >> 4))
FFT_DEV f32x2 cmul(f32x2 a, f32x2 b) { f32x2 r; r.x = a.x * b.x - a.y * b.y; r.y = a.x * b.y + a.y * b.x; return r; }
FFT_DEV f32x2 cmulc(f32x2 a, f32x2 b) { f32x2 r; r.x = a.x * b.x + a.y * b.y; r.y = a.y * b.x - a.x * b.y; return r; }
FFT_DEV f32x2 twid(float frac) { f32x2 r; r.x = FFT_COS(frac); r.y = -FFT_SIN(frac); return r; }
template <int M, int CJ> FFT_DEV f32x2 rot8(f32x2 d) {
    const float R = 0.70710678118654752f; f32x2 r;
    if (M == 0) return d;
    if (M == 2) { if (!CJ) { r.x = d.y; r.y = -d.x; } else { r.x = -d.y; r.y = d.x; } return r; }
    if (M == 1) { if (!CJ) { r.x = R * (d.x + d.y); r.y = R * (d.y - d.x); } else { r.x = R * (d.x - d.y); r.y = R * (d.x + d.y); } return r; }
    if (!CJ) { r.x = R * (d.y - d.x); r.y = -R * (d.x + d.y); } else { r.x = -R * (d.x + d.y); r.y = R * (d.x - d.y); } return r;
}
template <int INV, int ZHI, int LOW> FFT_DEV void fft_r8_pass(FFT_PTR buf, int s, int ls  , int tid) {
#pragma unroll 1
    for (int rep = 0; rep < 2; ++rep) {
        const int bf = tid + rep * 512, j = bf & (s - 1), blk = bf >> ls, base = blk * 8 * s + j;
        f32x2 x[8];
#pragma unroll
        for (int m = 0; m < (ZHI ? 4 : 8); ++m) x[m] = buf[PADI(base + m * s)];
        f32x2 w1 = twid((float)j / (float)(8 * s));
        f32x2 w2 = cmul(w1, w1), w4 = cmul(w2, w2);
        if (!INV) {
            if (ZHI) {
                x[4] = cmul(x[0], w1); x[5] = cmul(rot8<1, 0>(x[1]), w1); x[6] = cmul(rot8<2, 0>(x[2]), w1); x[7] = cmul(rot8<3, 0>(x[3]), w1);
            } else {
                { f32x2 a = x[0], b = x[4]; x[0] = a + b; x[4] = cmul(a - b, w1); }
                { f32x2 a = x[1], b = x[5]; x[1] = a + b; x[5] = cmul(rot8<1, 0>(a - b), w1); }
                { f32x2 a = x[2], b = x[6]; x[2] = a + b; x[6] = cmul(rot8<2, 0>(a - b), w1); }
                { f32x2 a = x[3], b = x[7]; x[3] = a + b; x[7] = cmul(rot8<3, 0>(a - b), w1); }
            }
#pragma unroll
            for (int h = 0; h < 8; h += 4) {
                { f32x2 a = x[h], b = x[h + 2]; x[h] = a + b; x[h + 2] = cmul(a - b, w2); }
                { f32x2 a = x[h + 1], b = x[h + 3]; x[h + 1] = a + b; x[h + 3] = cmul(rot8<2, 0>(a - b), w2); }
            }
#pragma unroll
            for (int m = 0; m < 8; m += 2) { f32x2 a = x[m], b = x[m + 1]; x[m] = a + b; x[m + 1] = cmul(a - b, w4); }
        } else {
#pragma unroll
            for (int m = 0; m < 8; m += 2) { f32x2 a = x[m], b = cmulc(x[m + 1], w4); x[m] = a + b; x[m + 1] = a - b; }
#pragma unroll
            for (int h = 0; h < 8; h += 4) {
                { f32x2 a = x[h], b = cmulc(x[h + 2], w2); x[h] = a + b; x[h + 2] = a - b; }
                { f32x2 a = x[h + 1], b = rot8<2, 1>(cmulc(x[h + 3], w2)); x[h + 1] = a + b; x[h + 3] = a - b; }
            }
            { f32x2 a = x[0], b = cmulc(x[4], w1); x[0] = a + b; if (!LOW) x[4] = a - b; }
            { f32x2 a = x[1], b = rot8<1, 1>(cmulc(x[5], w1)); x[1] = a + b; if (!LOW) x[5] = a - b; }
            { f32x2 a = x[2], b = rot8<2, 1>(cmulc(x[6], w1)); x[2] = a + b; if (!LOW) x[6] = a - b; }
            { f32x2 a = x[3], b = rot8<3, 1>(cmulc(x[7], w1)); x[3] = a + b; if (!LOW) x[7] = a - b; }
        }
#pragma unroll
        for (int m = 0; m < (LOW ? 4 : 8); ++m) buf[PADI(base + m * s)] = x[m];
    }
}
FFT_DEV void fft_r2_span1(FFT_PTR buf, int tid) {
#pragma unroll
    for (int rep = 0; rep < 8; ++rep) { const int p = 2 * (tid + rep * 512); f32x2 a = buf[PADI(p)], b = buf[PADI(p + 1)]; buf[PADI(p)] = a + b; buf[PADI(p + 1)] = a - b; }
}
template <int J, int CJ> FFT_DEV f32x2 rot16(f32x2 d) {
    const float C1 = 0.92387953251128674f, S1 = 0.38268343236508977f;
    if ((J & 1) == 0) return rot8<J / 2, CJ>(d);
    const float wr = (J == 1) ? C1 : (J == 3) ? S1 : (J == 5) ? -S1 : -C1;
    const float wi = ((J == 1) ? -S1 : (J == 3) ? -C1 : (J == 5) ? -C1 : -S1) * (CJ ? -1.f : 1.f);
    f32x2 r; r.x = d.x * wr - d.y * wi; r.y = d.x * wi + d.y * wr; return r;
}
FFT_DEV unsigned brev13(unsigned p);
FFT_DEV void fft16_dif(f32x2 (&x)[16]) {
#define BF_(i, j, ROT) { const f32x2 a_ = x[i], b_ = x[j]; x[i] = a_ + b_; x[j] = ROT(a_ - b_); }
    BF_(0, 8, (rot16<0, 0>)) BF_(1, 9, (rot16<1, 0>)) BF_(2, 10, (rot16<2, 0>)) BF_(3, 11, (rot16<3, 0>)) BF_(4, 12, (rot16<4, 0>)) BF_(5, 13, (rot16<5, 0>)) BF_(6, 14, (rot16<6, 0>)) BF_(7, 15, (rot16<7, 0>))
#pragma unroll
    for (int h = 0; h < 16; h += 8) { BF_(h + 0, h + 4, (rot8<0, 0>)) BF_(h + 1, h + 5, (rot8<1, 0>)) BF_(h + 2, h + 6, (rot8<2, 0>)) BF_(h + 3, h + 7, (rot8<3, 0>)) }
#pragma unroll
    for (int h = 0; h < 16; h += 4) { BF_(h + 0, h + 2, (rot8<0, 0>)) BF_(h + 1, h + 3, (rot8<2, 0>)) }
#pragma unroll
    for (int h = 0; h < 16; h += 2) { BF_(h, h + 1, (rot8<0, 0>)) }
#undef BF_
}
FFT_DEV void fft16_dit_inv(f32x2 (&x)[16]) {
#define BI_(i, j, ROT) { const f32x2 a_ = x[i], b_ = ROT(x[j]); x[i] = a_ + b_; x[j] = a_ - b_; }
#pragma unroll
    for (int h = 0; h < 16; h += 2) { BI_(h, h + 1, (rot8<0, 1>)) }
#pragma unroll
    for (int h = 0; h < 16; h += 4) { BI_(h + 0, h + 2, (rot8<0, 1>)) BI_(h + 1, h + 3, (rot8<2, 1>)) }
#pragma unroll
    for (int h = 0; h < 16; h += 8) { BI_(h + 0, h + 4, (rot8<0, 1>)) BI_(h + 1, h + 5, (rot8<1, 1>)) BI_(h + 2, h + 6, (rot8<2, 1>)) BI_(h + 3, h + 7, (rot8<3, 1>)) }
    BI_(0, 8, (rot16<0, 1>)) BI_(1, 9, (rot16<1, 1>)) BI_(2, 10, (rot16<2, 1>)) BI_(3, 11, (rot16<3, 1>)) BI_(4, 12, (rot16<4, 1>)) BI_(5, 13, (rot16<5, 1>)) BI_(6, 14, (rot16<6, 1>)) BI_(7, 15, (rot16<7, 1>))
#undef BI_
}
template <int MODE> FFT_DEV void fft_mid_pass(FFT_PTR wb, FFT_PTR zk, int tid) {
    f32x2 x[16];
#pragma unroll
    for (int e = 0; e < 16; ++e) x[e] = wb[PADI(16 * tid + e)];
    fft16_dif(x);
    if (MODE != 0) {
#pragma unroll
        for (int e = 0; e < 16; ++e) {
            const unsigned p = 16u * (unsigned)tid + (unsigned)e, f = brev13(p), fn = (8192u - f) & 8191u, pn = brev13(fn);
            const f32x2 zf = zk[PADI(p)], zn = zk[PADI(pn)];
            f32x2 kf;
            if (MODE == 1) { kf.x = 0.5f * (zf.x + zn.x); kf.y = 0.5f * (zf.y - zn.y); }
            else           { kf.x = 0.5f * (zf.y + zn.y); kf.y = 0.5f * (zn.x - zf.x); }
            x[e] = cmul(x[e], kf);
        }
        fft16_dit_inv(x);
    }
#pragma unroll
    for (int e = 0; e < 16; ++e) wb[PADI(16 * tid + e)] = x[e];
}
#ifndef FFT_HOST
#define FFT_SYNC() do { asm volatile("s_waitcnt lgkmcnt(0)" ::: "memory"); __builtin_amdgcn_s_barrier(); asm volatile("" ::: "memory"); } while (0)
__device__ __forceinline__ void fft_fwd_full(FFT_PTR buf, int tid) {
    FFT_SYNC(); fft_r8_pass<0, 0, 0>(buf, 1024, 10, tid); FFT_SYNC(); fft_r8_pass<0, 0, 0>(buf, 128, 7, tid); FFT_SYNC(); fft_r8_pass<0, 0, 0>(buf, 16, 4, tid); FFT_SYNC();
    fft_mid_pass<0>(buf, buf, tid); FFT_SYNC();
}
template <int WHICH> __device__ __forceinline__ void fft_conv(FFT_PTR wb, FFT_PTR zk, int tid) {
    FFT_SYNC(); fft_r8_pass<0, 1, 0>(wb, 1024, 10, tid); FFT_SYNC(); fft_r8_pass<0, 0, 0>(wb, 128, 7, tid); FFT_SYNC(); fft_r8_pass<0, 0, 0>(wb, 16, 4, tid); FFT_SYNC();
    fft_mid_pass<1 + WHICH>(wb, zk, tid); FFT_SYNC();
    fft_r8_pass<1, 0, 0>(wb, 16, 4, tid); FFT_SYNC(); fft_r8_pass<1, 0, 0>(wb, 128, 7, tid); FFT_SYNC(); fft_r8_pass<1, 0, 1>(wb, 1024, 10, tid); FFT_SYNC();
}
#endif
FFT_DEV unsigned brev13(unsigned p) {
    unsigned r = 0;
#ifndef FFT_HOST
    r = __brev(p) >> 19;
#else
    for (int i = 0; i < 13; ++i) r |= ((p >> i) & 1u) << (12 - i);
#endif
    return r;
}
FFT_DEV void fft_pointwise(FFT_PTR wb, FFT_PTR zk, int which, int tid) {
#pragma unroll 4
    for (int rep = 0; rep < 16; ++rep) {
        const unsigned p = tid + rep * 512, f = brev13(p), fn = (8192u - f) & 8191u, pn = brev13(fn);
        const f32x2 zf = zk[PADI(p)], zn = zk[PADI(pn)];
        f32x2 kf;
        if (which == 0) { kf.x = 0.5f * (zf.x + zn.x); kf.y = 0.5f * (zf.y - zn.y); }
        else            { kf.x = 0.5f * (zf.y + zn.y); kf.y = 0.5f * (zn.x - zf.x); }
        wb[PADI(p)] = cmul(wb[PADI(p)], kf);
    }
}
__device__ __forceinline__ void qk_prepass(const Ctx& C, int G, int wv) {
    int tid = (wv << 6) | lane_id_opaque(); asm volatile("" : "+v"(tid));
    const bf16_t* R1A = (const bf16_t*)(C.ws + WS_R1A); bf16_t* QKP = (bf16_t*)(C.ws + WS_QKP);
    const float* cw = C.in[3]; const float* cb = C.in[4];
    const int cg8 = tid & 255, half = tid >> 8, col = 8 * cg8;
    float k0[8], k1[8], k2[8], kb[8];
    { const int ch = 3072 + col;
      const f32x4 t0 = *(const f32x4*)(cw + ch), t1 = *(const f32x4*)(cw + ch + 4), t2 = *(const f32x4*)(cw + CONVC + ch), t3 = *(const f32x4*)(cw + CONVC + ch + 4);
      const f32x4 t4 = *(const f32x4*)(cw + 2 * CONVC + ch), t5 = *(const f32x4*)(cw + 2 * CONVC + ch + 4), t6 = *(const f32x4*)(cb + ch), t7 = *(const f32x4*)(cb + ch + 4);
#pragma unroll
      for (int e = 0; e < 4; ++e) { k0[e] = t0[e]; k0[4 + e] = t1[e]; k1[e] = t2[e]; k1[4 + e] = t3[e]; k2[e] = t4[e]; k2[4 + e] = t5[e]; kb[e] = t6[e]; kb[4 + e] = t7[e]; } }
    const float osc = col >= 1024 ? 0.0625f : 1.0f;
    for (int run = blockIdx.x; run < TOK / 64; run += G) {
        const int row0 = run * 64 + half * 32;
#pragma unroll 1
        for (int i0 = 0; i0 < 32; i0 += 4) {
            u32x4 w0[4], w1[4], w2[4];
#pragma unroll
            for (int u = 0; u < 4; ++u) { const int row = row0 + i0 + u, t = row & (SEQ - 1); const bf16_t* p = R1A + (size_t)row * 2048 + col;
                w0[u] = *(const u32x4*)(t > 0 ? p - 2048 : p); w1[u] = *(const u32x4*)p; w2[u] = *(const u32x4*)(t < SEQ - 1 ? p + 2048 : p); }
#pragma unroll
            for (int u = 0; u < 4; ++u) { const int row = row0 + i0 + u, t = row & (SEQ - 1);
                const u32x4 z = {0u, 0u, 0u, 0u}; if (t == 0) w0[u] = z; if (t == SEQ - 1) w2[u] = z;
                float a0[8], a1[8], a2[8]; unpack8(w0[u], a0); unpack8(w1[u], a1); unpack8(w2[u], a2);
                float v[8];
#pragma unroll
                for (int e = 0; e < 8; ++e) v[e] = siluf_(k0[e] * a0[e] + k1[e] * a1[e] + k2[e] * a2[e] + kb[e]) * osc;
                u32x4 o; o.x = pk2(v[0], v[1]); o.y = pk2(v[2], v[3]); o.z = pk2(v[4], v[5]); o.w = pk2(v[6], v[7]);
                *(u32x4*)(QKP + (size_t)row * 2048 + col) = o; }
        }
    }
}
constexpr int ML_KS = 0, ML_KP = 528, ML_SS = 76032, ML_SP = 272, ML_VS = 110848, ML_VP = 80, ML_VW = 121088, ML_CS = 131328, ML_CP = 528, ML_SC = 148224;
static_assert(ML_SC + 7 * 512 + 64 + 5 * 128 <= LDS_BYTES - 16, "mLSTM LDS map");
__device__ __forceinline__ bf16x8 tr_read2(unsigned a0, unsigned a1) {
    bf16x4 lo, hi;
    asm volatile("ds_read_b64_tr_b16 %0, %2\n\tds_read_b64_tr_b16 %1, %3\n\ts_waitcnt lgkmcnt(0)" : "=&v"(lo), "=&v"(hi) : "v"(a0), "v"(a1) : "memory");
    bf16x8 r; r[0] = lo[0]; r[1] = lo[1]; r[2] = lo[2]; r[3] = lo[3]; r[4] = hi[0]; r[5] = hi[1]; r[6] = hi[2]; r[7] = hi[3]; return r;
}
__device__ __forceinline__ bf16x8 cat4(bf16x4 lo, bf16x4 hi) { bf16x8 r; r[0] = lo[0]; r[1] = lo[1]; r[2] = lo[2]; r[3] = lo[3]; r[4] = hi[0]; r[5] = hi[1]; r[6] = hi[2]; r[7] = hi[3]; return r; }
__device__ __forceinline__ void tr_read2x2(unsigned a, unsigned b, unsigned d, bf16x8& ra, bf16x8& rb) {
    bf16x4 l0, h0, l1, h1;
    asm volatile("ds_read_b64_tr_b16 %0, %4\n\tds_read_b64_tr_b16 %1, %5\n\tds_read_b64_tr_b16 %2, %6\n\tds_read_b64_tr_b16 %3, %7\n\ts_waitcnt lgkmcnt(0)"
        : "=&v"(l0), "=&v"(h0), "=&v"(l1), "=&v"(h1) : "v"(a), "v"(a + d), "v"(b), "v"(b + d) : "memory");
    ra = cat4(l0, h0); rb = cat4(l1, h1);
}
__device__ __forceinline__ void tr_read4x2(unsigned a, unsigned b, unsigned d, unsigned c, unsigned e, unsigned d2, bf16x8& ra, bf16x8& rb, bf16x8& rc, bf16x8& re) {
    bf16x4 l0, h0, l1, h1, l2, h2, l3, h3;
    asm volatile("ds_read_b64_tr_b16 %0, %8\n\tds_read_b64_tr_b16 %1, %9\n\tds_read_b64_tr_b16 %2, %10\n\tds_read_b64_tr_b16 %3, %11\n\t"
                 "ds_read_b64_tr_b16 %4, %12\n\tds_read_b64_tr_b16 %5, %13\n\tds_read_b64_tr_b16 %6, %14\n\tds_read_b64_tr_b16 %7, %15\n\ts_waitcnt lgkmcnt(0)"
        : "=&v"(l0), "=&v"(h0), "=&v"(l1), "=&v"(h1), "=&v"(l2), "=&v"(h2), "=&v"(l3), "=&v"(h3)
        : "v"(a), "v"(a + d), "v"(b), "v"(b + d), "v"(c), "v"(c + d2), "v"(e), "v"(e + d2) : "memory");
    ra = cat4(l0, h0); rb = cat4(l1, h1); rc = cat4(l2, h2); re = cat4(l3, h3);
}
__device__ __forceinline__ float bf2f(short s) { return __uint_as_float(((unsigned)(unsigned short)s) << 16); }
__device__ __forceinline__ float logsigmoidf_(float x) { return fminf(x, 0.f) - log1pf(expf(-fabsf(x))); }

__device__ __forceinline__ void mlstm_item(const Ctx& C, LAS unsigned char* lds, int item, int wv) {
    int tid = (wv << 6) | lane_id_opaque(); asm volatile("" : "+v"(tid));
    const int lane = tid & 63, w = __builtin_amdgcn_readfirstlane(tid >> 6), r = lane & 15, g = lane >> 4, q4 = r >> 2, p4 = r & 3;
    const int vs = item & 7, dir = (item >> 3) & 1, bh = item >> 4, b = bh >> 2, h = bh & 3;
    const bf16_t* QKP = (const bf16_t*)(C.ws + WS_QKP); const bf16_t* R1B = (const bf16_t*)(C.ws + WS_R1B); const float* Gt = (const float*)(C.ws + WS_G);
    bf16_t* Y = (bf16_t*)(C.ws + (dir ? WS_YBB : WS_YBF));
    LAS float* SC = (LAS float*)(lds + ML_SC);
    LAS float* s_cs = SC, *s_rj = SC + 128, *s_iw = SC + 256, *s_emj = SC + 384, *s_w = SC + 512, *s_dn = SC + 640, *s_misc = SC + 768;
    LAS float* c_bl = SC + 784, *c_mx = SC + 816, *c_mp = SC + 848, *c_mn = SC + 880, *c_kp = SC + 912;
    float* GS = (float*)(C.ws + WS_GSC) + (size_t)item * 3 * SEQ;
    const unsigned lbase = (unsigned)(size_t)lds;
    const int pc = tid & 31, krow = tid >> 5, vrow = tid >> 2, pv = tid & 3;
    const int sw = w < 4 ? w : 11 - w;
    for (int i = tid; i < 16896 / 4; i += 512) ((LAS unsigned*)(lds + ML_CS))[i] = 0u;
    for (int i = tid; i < 16 * ML_KP / 4; i += 512) ((LAS unsigned*)(lds + ML_KS + 128 * ML_KP))[i] = 0u;
    f32x4 Cacc[3][2];
#pragma unroll
    for (int a = 0; a < 3; ++a) { Cacc[a][0] = (f32x4){0.f, 0.f, 0.f, 0.f}; Cacc[a][1] = (f32x4){0.f, 0.f, 0.f, 0.f}; }
    u32x4 kreg[8], vreg, qn[8]; float bn = 0.f, csn = 0.f, pmn = 0.f;
#define ML_TOK(c_, j_) ((size_t)b * SEQ + (dir ? SEQ - 1 - ((c_) * 128 + (j_)) : ((c_) * 128 + (j_))))
#define ML_PREFETCH(c_) do { \
        _Pragma("unroll") for (int i = 0; i < 8; ++i) kreg[i] = *(const u32x4*)(QKP + ML_TOK(c_, krow + 16 * i) * 2048 + 1024 + h * 256 + 8 * pc); \
        vreg = *(const u32x4*)(R1B + ML_TOK(c_, vrow) * 2048 + h * 256 + vs * 32 + 8 * pv); \
        { const bf16_t* qp = QKP + ML_TOK(c_, 16 * sw + r) * 2048 + h * 256 + 8 * g; _Pragma("unroll") for (int kk = 0; kk < 8; ++kk) qn[kk] = *(const u32x4*)(qp + 32 * kk); } \
        if (tid < 128) { const int ta = (c_) * 128 + tid; bn = GS[ta]; csn = GS[SEQ + ta]; pmn = GS[2 * SEQ + ta]; } } while (0)
    {
        float gi[8], gf[8];
#pragma unroll
        for (int u = 0; u < 8; ++u) { const int ta = (4 * w) * 128 + u * 64 + lane; const size_t tk = (size_t)b * SEQ + (dir ? SEQ - 1 - ta : ta);
            gi[u] = Gt[tk * 16 + (dir * 2) * 4 + h]; gf[u] = Gt[tk * 16 + (dir * 2 + 1) * 4 + h]; }
#pragma unroll
        for (int q = 0; q < 4; ++q) {
            const int c = 4 * w + q; float carry_b = 0.f, carry_m = -3.0e38f;
#pragma unroll
            for (int hf = 0; hf < 2; ++hf) {
                const int ta = c * 128 + hf * 64 + lane;
                const float ip = gi[2 * q + hf], fp = gf[2 * q + hf];
                float xs = logsigmoidf_(fp);
#pragma unroll
                for (int o = 1; o < 64; o <<= 1) { const float y = __shfl_up(xs, o); if (lane >= o) xs += y; }
                const float bj = xs + carry_b; const float cj = ip - bj; float pm = cj;
#pragma unroll
                for (int o = 1; o < 64; o <<= 1) { const float y = __shfl_up(pm, o); if (lane >= o) pm = fmaxf(pm, y); }
                pm = fmaxf(pm, carry_m);
                GS[ta] = bj; GS[SEQ + ta] = cj; GS[2 * SEQ + ta] = pm;
                carry_b = __shfl(bj, 63); carry_m = __shfl(pm, 63);
            }
            if (lane == 0) { c_bl[c] = carry_b; c_mx[c] = carry_m; }
        }
        __syncthreads();
        if (tid == 0) { float m = 0.f;
            for (int c = 0; c < 32; ++c) { const float bl = c_bl[c], mn = fmaxf(bl + m, bl + c_mx[c]); c_mp[c] = m; c_mn[c] = mn; c_kp[c] = __expf(bl + m - mn); m = mn; } }
        __syncthreads();
    }
    ML_PREFETCH(0);
    __syncthreads();
#define ML_BAR() do { asm volatile("s_waitcnt lgkmcnt(0)" ::: "memory"); __builtin_amdgcn_s_barrier(); asm volatile("" ::: "memory"); } while (0)
#pragma unroll 1
    for (int c = 0; c < 32; ++c) {
        const float m_prev = c_mp[c], m_new = c_mn[c], keep = c_kp[c], b_last = c_bl[c];
        if (tid < 128) {
            const float inter = bn + m_prev, mj = fmaxf(inter, bn + pmn);
            s_cs[tid] = csn; s_rj[tid] = bn - mj; s_iw[tid] = __expf(inter - mj); s_emj[tid] = __expf(-mj); s_w[tid] = __expf(b_last + csn - m_new);
        }
        ML_BAR();
#pragma unroll
        for (int i = 0; i < 8; ++i) *(LAS u32x4*)(lds + ML_KS + (krow + 16 * i) * ML_KP + pc * 16) = kreg[i];
        {
            *(LAS u32x4*)(lds + ML_VS + vrow * ML_VP + pv * 16) = vreg;
            float f[8]; unpack8(vreg, f); const float ws_ = s_w[vrow];
            u32x4 o; o.x = pk2(f[0] * ws_, f[1] * ws_); o.y = pk2(f[2] * ws_, f[3] * ws_); o.z = pk2(f[4] * ws_, f[5] * ws_); o.w = pk2(f[6] * ws_, f[7] * ws_);
            *(LAS u32x4*)(lds + ML_VW + vrow * ML_VP + pv * 16) = o;
        }
        bf16x8 qf[8];
#pragma unroll
        for (int kk = 0; kk < 8; ++kk) qf[kk] = __builtin_bit_cast(bf16x8, qn[kk]);
        unsigned short ogr[4][2];
#pragma unroll
        for (int i = 0; i < 4; ++i)
#pragma unroll
            for (int vt = 0; vt < 2; ++vt) ogr[i][vt] = R1B[ML_TOK(c, 16 * sw + 4 * g + i) * 2048 + 1024 + h * 256 + vs * 32 + 16 * vt + r];
        if (c < 31) ML_PREFETCH(c + 1);
        ML_BAR();
        {
            const float rjv = s_rj[16 * sw + r]; const int jloc = 16 * sw + r; float den1 = 0.f;
#pragma unroll 2
            for (int st = 0; st < 8; ++st) {
                if (st <= sw) {
                    f32x4 acc = {0.f, 0.f, 0.f, 0.f};
#pragma unroll
                    for (int kk = 0; kk < 8; ++kk) { const bf16x8 kf = *(const LAS bf16x8*)(lds + ML_KS + (16 * st + r) * ML_KP + (32 * kk + 8 * g) * 2); acc = __builtin_amdgcn_mfma_f32_16x16x32_bf16(kf, qf[kk], acc, 0, 0, 0); }
                    const f32x4 c4 = *(const LAS f32x4*)(s_cs + 16 * st + 4 * g);
                    float v[4];
#pragma unroll
                    for (int i = 0; i < 4; ++i) { const int s = 16 * st + 4 * g + i; const float d = (s <= jloc) ? __expf(rjv + c4[i]) : 0.f; v[i] = acc[i] * d; den1 += v[i]; }
                    u32x2 o; o.x = pk2(v[0], v[1]); o.y = pk2(v[2], v[3]);
                    *(LAS u32x2*)(lds + ML_SS + jloc * ML_SP + (16 * st + 4 * g) * 2) = o;
                } else if (st == sw + 1 && !(sw & 1)) {
                    u32x2 o = {0u, 0u}; *(LAS u32x2*)(lds + ML_SS + jloc * ML_SP + (16 * st + 4 * g) * 2) = o;
                }
            }
            den1 += __shfl_xor(den1, 16); den1 += __shfl_xor(den1, 32);
            f32x4 dacc = {0.f, 0.f, 0.f, 0.f};
#pragma unroll
            for (int kk = 0; kk < 8; ++kk) { const bf16x8 kf = *(const LAS bf16x8*)(lds + ML_KS + (128 + r) * ML_KP + (32 * kk + 8 * g) * 2); dacc = __builtin_amdgcn_mfma_f32_16x16x32_bf16(kf, qf[kk], dacc, 0, 0, 0); }
            const float d2 = dacc[0];
            if (g == 0) s_dn[jloc] = den1 + s_iw[jloc] * d2;
        }
        ML_BAR();
        {
            f32x4 n1[2], n2[2];
#pragma unroll
            for (int vt = 0; vt < 2; ++vt) { n1[vt] = (f32x4){0.f, 0.f, 0.f, 0.f}; n2[vt] = (f32x4){0.f, 0.f, 0.f, 0.f}; }
            const int nks = (sw >> 1) + 1;
#pragma unroll 1
            for (int ks = 0; ks < nks; ++ks) {
                const bf16x8 af = *(const LAS bf16x8*)(lds + ML_SS + (16 * sw + r) * ML_SP + (32 * ks + 8 * g) * 2);
                const unsigned a0 = lbase + ML_VS + (32 * ks + 8 * g + q4) * ML_VP + (4 * p4) * 2;
                bf16x8 b0, b1; tr_read2x2(a0, a0 + 32, 4 * ML_VP, b0, b1);
                n1[0] = __builtin_amdgcn_mfma_f32_16x16x32_bf16(af, b0, n1[0], 0, 0, 0); n1[1] = __builtin_amdgcn_mfma_f32_16x16x32_bf16(af, b1, n1[1], 0, 0, 0);
            }
#pragma unroll
            for (int kk = 0; kk < 8; ++kk)
#pragma unroll
                for (int vt = 0; vt < 2; ++vt) { const bf16x8 cf = *(const LAS bf16x8*)(lds + ML_CS + (16 * vt + r) * ML_CP + (32 * kk + 8 * g) * 2); n2[vt] = __builtin_amdgcn_mfma_f32_16x16x32_bf16(qf[kk], cf, n2[vt], 0, 0, 0); }
            const f32x4 iw4 = *(const LAS f32x4*)(s_iw + 16 * sw + 4 * g), dn4 = *(const LAS f32x4*)(s_dn + 16 * sw + 4 * g), em4 = *(const LAS f32x4*)(s_emj + 16 * sw + 4 * g);
#pragma unroll
            for (int i = 0; i < 4; ++i) {
                const size_t tok = ML_TOK(c, 16 * sw + 4 * g + i);
                const float inv = 1.0f / fmaxf(fabsf(dn4[i]), em4[i]);
#pragma unroll
                for (int vt = 0; vt < 2; ++vt) { const int col = h * 256 + vs * 32 + 16 * vt + r;
                    const float og = __uint_as_float(((unsigned)ogr[i][vt]) << 16);
                    const float hv = (n1[vt][i] + iw4[i] * n2[vt][i]) * inv * og;
                    Y[blk_off((int)tok, col, 1024)] = (bf16_t)f2bf(hv); }
            }
        }
        ML_BAR();
        {
#pragma unroll
            for (int a = 0; a < 3; ++a) { Cacc[a][0] *= keep; Cacc[a][1] *= keep; }
#pragma unroll 1
            for (int ks = 0; ks < 4; ++ks) {
                bf16x8 af[3], bq[2];
                { const unsigned av = lbase + ML_VW + (32 * ks + 8 * g + q4) * ML_VP + (4 * p4) * 2, ak = lbase + ML_KS + (32 * ks + 8 * g + q4) * ML_KP + (32 * w + 4 * p4) * 2;
                  tr_read4x2(av, av + 32, 4 * ML_VP, ak, ak + 32, 4 * ML_KP, af[0], af[1], bq[0], bq[1]); }
                { const f32x4 wa = *(const LAS f32x4*)(s_w + 32 * ks + 8 * g), wb = *(const LAS f32x4*)(s_w + 32 * ks + 8 * g + 4);
                  u32x4 o; o.x = pk2(wa[0], wa[1]); o.y = pk2(wa[2], wa[3]); o.z = pk2(wb[0], wb[1]); o.w = pk2(wb[2], wb[3]);
                  if (r != 0) { o.x = 0u; o.y = 0u; o.z = 0u; o.w = 0u; }
                  af[2] = __builtin_bit_cast(bf16x8, o); }
#pragma unroll
                for (int nt = 0; nt < 2; ++nt)
#pragma unroll
                    for (int mt = 0; mt < 3; ++mt) Cacc[mt][nt] = __builtin_amdgcn_mfma_f32_16x16x32_bf16(af[mt], bq[nt], Cacc[mt][nt], 0, 0, 0);
            }
#pragma unroll
            for (int mt = 0; mt < 2; ++mt)
#pragma unroll
                for (int nt = 0; nt < 2; ++nt)
#pragma unroll
                    for (int i = 0; i < 4; ++i) *(LAS bf16_t*)(lds + ML_CS + (16 * mt + 4 * g + i) * ML_CP + (32 * w + 16 * nt + r) * 2) = (bf16_t)f2bf(Cacc[mt][nt][i]);
            if (g == 0) { *(LAS bf16_t*)(lds + ML_KS + 128 * ML_KP + (32 * w + r) * 2) = (bf16_t)f2bf(Cacc[2][0][0]); *(LAS bf16_t*)(lds + ML_KS + 128 * ML_KP + (32 * w + 16 + r) * 2) = (bf16_t)f2bf(Cacc[2][1][0]); }
        }
        ML_BAR();
    }
#undef ML_BAR
#undef ML_PREFETCH
#undef ML_TOK
}
constexpr int HY_ZK = 0, HY_WB = 69632;
static_assert(HY_WB + 69632 <= LDS_BYTES, "hyena LDS map");
#define GAS __attribute__((address_space(1)))
struct HyRaw { u32x4 c; unsigned l, r; };
__device__ __forceinline__ HyRaw hy_load(const bf16_t* rowp, int tid) { HyRaw x; const GAS bf16_t* p = (const GAS bf16_t*)rowp + 8 * tid; x.c = *(const GAS u32x4*)p; x.l = p[-1]; x.r = p[8]; return x; }
__device__ __forceinline__ void hy_conv8(const HyRaw& x, int tid, float w0, float w1, float w2, float bias, float (&o)[8]) {
    float a[10];
    a[0] = tid > 0 ? __uint_as_float(x.l << 16) : 0.f; a[9] = tid < 511 ? __uint_as_float(x.r << 16) : 0.f;
    a[1] = bflo(x.c.x); a[2] = bfhi(x.c.x); a[3] = bflo(x.c.y); a[4] = bfhi(x.c.y); a[5] = bflo(x.c.z); a[6] = bfhi(x.c.z); a[7] = bflo(x.c.w); a[8] = bfhi(x.c.w);
#pragma unroll
    for (int m = 0; m < 8; ++m) o[m] = w0 * a[m] + w1 * a[m + 1] + w2 * a[m + 2] + bias;
}
__device__ __forceinline__ void hyena_item(const Ctx& C, LAS unsigned char* lds, int ch, int wv) {
    int tid = (wv << 6) | lane_id_opaque(); asm volatile("" : "+v"(tid));
    LAS f32x2* zk = (LAS f32x2*)(lds + HY_ZK); LAS f32x2* wb = (LAS f32x2*)(lds + HY_WB);
    const float* FILT = (const float*)(C.ws + WS_FILT); const bf16_t* HYb = (const bf16_t*)(C.ws + WS_HY); bf16_t* YA = (bf16_t*)(C.ws + WS_YA);
    const float* cw = C.in[3]; const float* cb = C.in[4];
    float w0[3], w1[3], w2[3], bs[3];
#pragma unroll
    for (int s = 0; s < 3; ++s) { w0[s] = cw[s * 1024 + ch]; w1[s] = cw[CONVC + s * 1024 + ch]; w2[s] = cw[2 * CONVC + s * 1024 + ch]; bs[s] = cb[s * 1024 + ch]; }
    const float hb0 = C.in[12][ch], hb1 = C.in[12][1024 + ch];
    const float* F0 = FILT + (size_t)(0 * 1024 + ch) * SEQ; const float* F1 = FILT + (size_t)(1 * 1024 + ch) * SEQ;
    const float* F2 = FILT + (size_t)(2 * 1024 + ch) * SEQ; const float* F3 = FILT + (size_t)(3 * 1024 + ch) * SEQ;
    __syncthreads();
    {
        float fa[16], fb[16];
#pragma unroll
        for (int rep = 0; rep < 8; ++rep) { const int i = tid + 512 * rep; fa[rep] = F0[i]; fb[rep] = F2[i]; }
#pragma unroll
        for (int rep = 8; rep < 16; ++rep) { const int i = tid + 512 * rep; const int j = i == SEQ ? 1 : 2 * SEQ - i; fa[rep] = F1[j]; fb[rep] = F3[j]; }
        if (tid == 0) { fa[8] = 0.f; fb[8] = 0.f; }
#pragma unroll
        for (int rep = 0; rep < 16; ++rep) { const int i = tid + 512 * rep; zk[PADI(i)] = (f32x2){fa[rep] * (1.0f / 8192.0f), fb[rep] * (1.0f / 8192.0f)}; }
    }
    fft_fwd_full(zk, tid);
    const bf16_t* rv = HYb + (size_t)ch * TOK; const bf16_t* rx1 = HYb + (size_t)(1024 + ch) * TOK; const bf16_t* rx2 = HYb + (size_t)(2048 + ch) * TOK;
    HyRaw qa = hy_load(rv, tid), qb = hy_load(rv + SEQ, tid);
#pragma unroll 1
    for (int p = 0; p < 2; ++p) {
        const int tb0 = (2 * p) * SEQ, tb1 = (2 * p + 1) * SEQ;
        f32x2 vv[8], zz[8];
        { float va[8], vb[8]; hy_conv8(qa, tid, w0[0], w1[0], w2[0], bs[0], va); hy_conv8(qb, tid, w0[0], w1[0], w2[0], bs[0], vb);
#pragma unroll
          for (int m = 0; m < 8; ++m) { vv[m].x = va[m]; vv[m].y = vb[m]; wb[PADI(8 * tid + m)] = vv[m]; } }
        qa = hy_load(rx1 + tb0, tid); qb = hy_load(rx1 + tb1, tid);
        fft_conv<0>(wb, zk, tid);
        { float xa[8], xb_[8]; hy_conv8(qa, tid, w0[1], w1[1], w2[1], bs[1], xa); hy_conv8(qb, tid, w0[1], w1[1], w2[1], bs[1], xb_);
#pragma unroll
          for (int m = 0; m < 8; ++m) { const f32x2 y = wb[PADI(8 * tid + m)]; zz[m].x = xa[m] * (y.x + vv[m].x * hb0); zz[m].y = xb_[m] * (y.y + vv[m].y * hb0); }
#pragma unroll
          for (int m = 0; m < 8; ++m) wb[PADI(8 * tid + m)] = zz[m]; }
        qa = hy_load(rx2 + tb0, tid); qb = hy_load(rx2 + tb1, tid);
        fft_conv<1>(wb, zk, tid);
        { float xa[8], xb_[8]; hy_conv8(qa, tid, w0[2], w1[2], w2[2], bs[2], xa); hy_conv8(qb, tid, w0[2], w1[2], w2[2], bs[2], xb_);
          if (p == 0) { qa = hy_load(rv + 2 * SEQ, tid); qb = hy_load(rv + 3 * SEQ, tid); }
#pragma unroll
          for (int m = 0; m < 8; ++m) { const int t = 8 * tid + m; const f32x2 y = wb[PADI(t)];
              YA[blk_off(tb0 + t, ch, 1024)] = (bf16_t)f2bf(xa[m] * (y.x + zz[m].x * hb1));
              YA[blk_off(tb1 + t, ch, 1024)] = (bf16_t)f2bf(xb_[m] * (y.y + zz[m].y * hb1)); } }
        FFT_SYNC();
    }
}
#ifndef DUP_FILT
#define DUP_FILT 0
#endif
#ifndef DUP_PRE
#define DUP_PRE 0
#endif
#ifndef DUP_P0
#define DUP_P0 0
#endif
#ifndef DUP_ML
#define DUP_ML 0
#endif
#ifndef DUP_HY
#define DUP_HY 0
#endif
#ifndef DUP_REST
#define DUP_REST 0
#endif
#ifndef DUP_GU
#define DUP_GU 0
#endif
#define XB_TMO      128
#define XB_XCNT(j)  (256  + 64 * (j))
#define XB_XSUB(j)  (1280 + 64 * (j))
#define XB_XGEN(j)  (2304 + 64 * (j))
#define XB_TOP      3328
#define XB_TOPGEN   3392
#define XCD_BAR_WORDS 3456
#define XB_SPIN_CAP (1u << 22)
__device__ __forceinline__ unsigned xb_ld(unsigned* p)              { return __hip_atomic_load(p, __ATOMIC_RELAXED, __HIP_MEMORY_SCOPE_AGENT); }
__device__ __forceinline__ unsigned xb_add(unsigned* p, unsigned v) { return __hip_atomic_fetch_add(p, v, __ATOMIC_RELAXED, __HIP_MEMORY_SCOPE_AGENT); }
__device__ __forceinline__ unsigned xb_xcc_id() { return (unsigned)__builtin_amdgcn_s_getreg((3 << 11) | 20) & 0xFu; }
#define XB_SPIN(cond, bar) do { unsigned _sp = 0; while (cond) { __builtin_amdgcn_s_sleep(1); \
    if ((++_sp & 255u) == 0u) { if (xb_ld(&(bar)[XB_TMO])) break; if (_sp > XB_SPIN_CAP) { atomicAdd(&(bar)[XB_TMO], 1u); break; } } } } while (0)
__device__ __forceinline__ void xcd_barrier_complete(unsigned* bar, unsigned x, unsigned G, unsigned& nloc, unsigned& nx) {
    unsigned sum, cnt, mine, sp = 0u;
    for (;;) {
        sum = 0u; cnt = 0u; mine = 0u;
#pragma unroll
        for (unsigned j = 0; j < 16; ++j) { const unsigned c = xb_ld(&bar[XB_XCNT(j)]); sum += c; cnt += (c > 0u) ? 1u : 0u; mine = (j == x) ? c : mine; }
        if (sum == G) break;
        __builtin_amdgcn_s_sleep(1);
        if ((++sp & 255u) == 0u) { if (xb_ld(&bar[XB_TMO])) break; if (sp > XB_SPIN_CAP) { atomicAdd(&bar[XB_TMO], 1u); break; } }
    }
    nloc = mine > 0u ? mine : 1u; nx = cnt > 0u ? cnt : 1u;
}
__device__ __forceinline__ void grid_bar(unsigned* bar, volatile LAS unsigned* st, unsigned G, int wv) {
    asm volatile("s_waitcnt vmcnt(0)" ::: "memory");
    __syncthreads();
    const int lane = lane_id_opaque();
    if (wv == 0 && lane == 0) {
        __builtin_amdgcn_s_waitcnt(0);
        const unsigned x = xb_xcc_id();
        unsigned nloc = st[0], nx = st[1];
        if (nloc == 0u) { xcd_barrier_complete(bar, x, G, nloc, nx); st[0] = nloc; st[1] = nx; }
        const unsigned old = xb_add(&bar[XB_XSUB(x)], 1u);
        const unsigned gen = old / nloc;
        if (old + 1u == (gen + 1u) * nloc) {
            __builtin_amdgcn_fence(__ATOMIC_RELEASE, "agent");
            asm volatile("s_waitcnt vmcnt(0)" ::: "memory");
            const unsigned og = xb_add(&bar[XB_TOP], 1u);
            const unsigned tg = og / nx;
            if (og + 1u == (tg + 1u) * nx) xb_add(&bar[XB_TOPGEN], 1u);
            else XB_SPIN(xb_ld(&bar[XB_TOPGEN]) == tg, bar);
            __builtin_amdgcn_fence(__ATOMIC_ACQUIRE, "agent");
            xb_add(&bar[XB_XGEN(x)], 1u);
            asm volatile("s_waitcnt vmcnt(0)" ::: "memory");
        } else {
            XB_SPIN(xb_ld(&bar[XB_XGEN(x)]) == gen, bar);
            __builtin_amdgcn_fence(__ATOMIC_ACQUIRE, "agent");
            asm volatile("s_waitcnt vmcnt(0)" ::: "memory");
        }
    }
    __syncthreads();
}
struct Params { const float* in[21]; float* out; unsigned char* ws; };
__global__ void __launch_bounds__(512, 2) fwd_megakernel(Params prm) {
    extern __shared__ __attribute__((aligned(16))) unsigned char lds_raw[];
    LAS unsigned char* lds = (LAS unsigned char*)lds_raw;
    cg::grid_group grid = cg::this_grid();
    const int G = gridDim.x, bx = blockIdx.x;
    const int wv = __builtin_amdgcn_readfirstlane((int)(threadIdx.x >> 6));
    Ctx C;
#pragma unroll
    for (int i = 0; i < 21; ++i) C.in[i] = prm.in[i];
    C.out = prm.out; C.ws = prm.ws;
    unsigned char* ws = prm.ws;
    unsigned* gbar = (unsigned*)(ws + WS_BAR);
    volatile LAS unsigned* bst = (volatile LAS unsigned*)(lds + LDS_BYTES - 16);
#ifndef DUP_BAR
#define DUP_BAR 0
#endif
#define GBAR() do { for (int rb_ = 0; rb_ < 1 + DUP_BAR; ++rb_) grid_bar(gbar, bst, (unsigned)G, wv); } while (0)
    if (bx == 0) for (int i = threadIdx.x; i < XCD_BAR_WORDS; i += 512) gbar[i] = 0u;
    if (threadIdx.x < 4) ((LAS unsigned*)(lds + LDS_BYTES - 16))[threadIdx.x] = 0u;
    grid.sync();
    if (threadIdx.x == 0) (void)xb_add(&gbar[XB_XCNT(xb_xcc_id())], 1u);
    for (int rep = 0; rep < 1 + DUP_P0; ++rep) { p0_prologue(C, lds, G, wv); __syncthreads(); }
    GBAR();
    for (int rep = 0; rep < 1 + DUP_FILT; ++rep) p1_filters(C, lds, G, wv);
    { HyProg P; P.K = DM; P.G = G; P.c = bx; P.W = (const bf16_t*)(ws + WS_WIN); P.X = (const bf16_t*)(ws + WS_XB); P.HY = (bf16_t*)(ws + WS_HY); P.r1 = (const float*)(ws + WS_R1S);
      pg8::gemm_stream(lds, P, wv); }
    for (int rep = 0; rep < 1 + DUP_REST; ++rep) { RestProg P; P.K = DM; P.G = G; P.c = bx; P.W = (const bf16_t*)(ws + WS_WIN); P.X = (const bf16_t*)(ws + WS_XB); P.R1A = (bf16_t*)(ws + WS_R1A); P.R1B = (bf16_t*)(ws + WS_R1B); P.R2 = (bf16_t*)prm.out; P.r1 = (const float*)(ws + WS_R1S);
      pg8::gemm_stream(lds, P, wv); }
    GBAR();
    for (int rep = 0; rep < 1 + DUP_PRE; ++rep) qk_prepass(C, G, wv);
    for (int rep = 0; rep < 1 + DUP_HY; ++rep) for (int idx = bx; idx < 1024; idx += G) { const int rd = idx >> 8, bb = idx & 255; hyena_item(C, lds, rd * 256 + (bb & 7) * 32 + (bb >> 3), wv); }
    GBAR();
    for (int rep = 0; rep < 1 + DUP_ML; ++rep) for (int item = bx; item < 256; item += G) mlstm_item(C, lds, item, wv);
    GBAR();
    { BranchProg P; P.K = 1024; P.G = G; P.c = bx; P.YA = (const bf16_t*)(ws + WS_YA); P.YBF = (const bf16_t*)(ws + WS_YBF); P.YBB = (const bf16_t*)(ws + WS_YBB);
      P.WA = (const bf16_t*)(ws + WS_WA); P.WB = (const bf16_t*)(ws + WS_WB); P.R2 = (const bf16_t*)prm.out; P.MIX = (bf16_t*)(ws + WS_MIX);
      pg8::gemm_stream(lds, P, wv); }
    GBAR();
    { ResProg P; P.K = DM; P.G = G; P.c = bx; P.A = (const bf16_t*)(ws + WS_MIX); P.B = (const bf16_t*)(ws + WS_WOUT); P.base = prm.in[0]; P.out = prm.out; P.outb = (bf16_t*)(ws + WS_X1B); P.ss = (float*)(ws + WS_SS2);
      pg8::gemm_stream(lds, P, wv); }
    GBAR();
    for (int rep = 0; rep < 1 + DUP_GU; ++rep) { GuProg P; P.K = DM; P.G = G; P.c = bx; P.X = (const bf16_t*)(ws + WS_X1B); P.W = (const bf16_t*)(ws + WS_WGU); P.HH = (bf16_t*)(ws + WS_HH); P.ss2 = (const float*)(ws + WS_SS2);
      pg8::gemm_stream(lds, P, wv); }
    GBAR();
    { ResProg P; P.K = FFH; P.G = G; P.c = bx; P.A = (const bf16_t*)(ws + WS_HH); P.B = (const bf16_t*)(ws + WS_WD); P.base = prm.out; P.out = prm.out; P.outb = nullptr; P.ss = (float*)(ws + WS_SS3);
      pg8::gemm_stream(lds, P, wv); }
    GBAR();
    p7_final(C, G, wv);
}

extern "C" void kernel_launch(void* const* d_in, const int* in_sizes, int n_in, void* d_out, int out_size, void* d_ws, size_t ws_size, hipStream_t stream) {
    static int grid = 0;
    if (grid == 0) {
        int dev = 0, cus = 0, per_cu = 0;
        hipGetDevice(&dev); hipDeviceGetAttribute(&cus, hipDeviceAttributeMultiprocessorCount, dev);
        if (hipFuncSetAttribute((const void*)fwd_megakernel, hipFuncAttributeMaxDynamicSharedMemorySize, LDS_BYTES) != hipSuccess) { fprintf(stderr, "kernel_launch: hipFuncSetAttribute failed\n"); grid = -1; return; }
        if (hipOccupancyMaxActiveBlocksPerMultiprocessor(&per_cu, (const void*)fwd_megakernel, 512, LDS_BYTES) != hipSuccess || per_cu < 1) { fprintf(stderr, "kernel_launch: occupancy query gave %d\n", per_cu); per_cu = 1; }
        (void)hipGetLastError();
        grid = cus * 1;
        if (n_in != 21 || ws_size < WS_END) { fprintf(stderr, "kernel_launch: unexpected n_in %d or ws %zu\n", n_in, ws_size); grid = -1; return; }
    }
    if (grid < 0) return;
    Params p{};
    for (int i = 0; i < 21; ++i) p.in[i] = (const float*)d_in[i];
    p.out = (float*)d_out; p.ws = (unsigned char*)d_ws;
    void* args[] = {&p};
    hipError_t e = hipLaunchCooperativeKernel((const void*)fwd_megakernel, dim3(grid), dim3(512), args, LDS_BYTES, stream);
    if (e != hipSuccess) fprintf(stderr, "cooperative launch failed: %s (grid %d)\n", hipGetErrorString(e), grid);
}
```

```cpp
#include <hip/hip_runtime.h>
#include <hip/hip_cooperative_groups.h>
#include <cstdio>
namespace cg = cooperative_groups;

#define LAS __attribute__((address_space(3)))
typedef unsigned short bf16_t;
typedef short bf16x8 __attribute__((ext_vector_type(8)));
typedef short bf16x4 __attribute__((ext_vector_type(4)));
typedef float f32x4 __attribute__((ext_vector_type(4)));
typedef float f32x2 __attribute__((ext_vector_type(2)));
typedef unsigned u32x4 __attribute__((ext_vector_type(4)));
typedef unsigned u32x2 __attribute__((ext_vector_type(2)));

constexpr int NB = 4, SEQ = 4096, TOK = NB * SEQ, DM = 2048, HW = 1024, MW = 1024, NHEAD = 4, DH = 256, FFH = 5632;
constexpr int CONVC = 5120, INCOLS = 11280, NFILT = 4096;
constexpr float RMS_EPS = 1e-6f;
constexpr size_t MiB = 1u << 20;
constexpr size_t WS_PCNT = 393216, WS_BAR = 262144, WS_R1S = 0, WS_SS2 = 65536, WS_SS3 = 131072, WS_G = 1 * MiB, WS_H2 = 2 * MiB;
constexpr size_t WS_WA = 4 * MiB, WS_WB = 8 * MiB, WS_WOUT = 12 * MiB, WS_WGU = 20 * MiB, WS_WD = 64 * MiB, WS_WIN = 86 * MiB, WS_XB = 130 * MiB;
constexpr size_t WS_FILT = 194 * MiB, WS_HY = 258 * MiB, WS_R1A = 354 * MiB, WS_R1B = 418 * MiB, WS_END = 494 * MiB;
constexpr size_t WS_QKP = 86 * MiB, WS_YA = 150 * MiB, WS_YBF = 354 * MiB, WS_YBB = 386 * MiB, WS_X1B = 86 * MiB, WS_MIX = 194 * MiB, WS_HH = 258 * MiB;
constexpr size_t WS_GSC = 482 * MiB;
constexpr int LDS_BYTES = 155648;

__device__ __forceinline__ unsigned f2bf(float f) { unsigned u = __float_as_uint(f); return (u + 0x7fffu + ((u >> 16) & 1u)) >> 16; }
__device__ __forceinline__ unsigned pk2(float lo, float hi) { unsigned r; asm volatile("v_cvt_pk_bf16_f32 %0, %1, %2" : "=v"(r) : "v"(lo), "v"(hi)); return r; }
__device__ __forceinline__ float bflo(unsigned w) { return __uint_as_float(w << 16); }
__device__ __forceinline__ float bfhi(unsigned w) { return __uint_as_float(w & 0xffff0000u); }
__device__ __forceinline__ float wave_sum(float v) {
#pragma unroll
    for (int o = 1; o < 64; o <<= 1) v += __shfl_xor(v, o);
    return v;
}
__device__ __forceinline__ size_t blk_off(int row, int k, int K) { return ((size_t)(row >> 7) * (size_t)(K >> 6) + (size_t)(k >> 6)) * 8192 + (size_t)((row & 127) * 64 + (k & 63)); }
__device__ __forceinline__ int lane_id_opaque() { int l; asm volatile("v_mbcnt_lo_u32_b32 %0, -1, 0\n\tv_mbcnt_hi_u32_b32 %0, -1, %0" : "=v"(l)); return l; }
__device__ __forceinline__ float sigmoidf_(float x) { return 1.0f / (1.0f + __expf(-x)); }
__device__ __forceinline__ float siluf_(float x) { return x / (1.0f + __expf(-x)); }

namespace pg8 {
constexpr int BM = 256, BK = 64, HALF = 128, HTB = HALF * BK * 2, STAGE_BYTES = 8 * HTB, NXCD = 8, WGM = 8;
__device__ __forceinline__ int lds_byte(int r, int c) { const int st = (r >> 4) * 2 + (c >> 5), rr = r & 15, cc = c & 31, ob = rr * 64 + cc * 2; return st * 1024 + (ob ^ (((ob >> 9) & 1) << 5)); }
__device__ __forceinline__ void stage_rc(int b, int& R, int& C) { const int st = b / 1024, sb = b % 1024, swz = sb ^ (((sb >> 9) & 1) << 5); R = (st >> 1) * 16 + swz / 64; C = (st & 1) * 32 + (swz % 64) / 2; }
__device__ __forceinline__ int perm32(int rho) { const int n = rho >> 4, i = rho & 15; return 8 * (i >> 2) + 4 * n + (i & 3); }
struct GUnit { const char* A; const char* B; int pm, pn, sub; };
__device__ __forceinline__ void tile_of(int L, int nM, int nN, int& pm, int& pn) {
    const int nwg = nM * nN; int wgid = L; { const int q = nwg / NXCD, r = nwg % NXCD, xcd = wgid % NXCD, off = wgid / NXCD; wgid = (xcd < r ? xcd * (q + 1) : r * (q + 1) + (xcd - r) * q) + off; }
    const int nig = WGM * nN, gid = wgid / nig, fm = gid * WGM, gsz = (nM - fm) < WGM ? (nM - fm) : WGM;
    pm = fm + ((wgid % nig) % gsz); pn = (wgid % nig) / gsz;
}
typedef f32x4 Acc[2][2][4][2];
template <class Prog>
__device__ __forceinline__ void gemm_stream(LAS unsigned char* lds, const Prog& P, int wv) {
    int tid = (wv << 6) | lane_id_opaque(); asm volatile("" : "+v"(tid));
    const int wid = __builtin_amdgcn_readfirstlane(tid >> 6), lane = tid & 63, wr = wid >> 2, wc = wid & 3, fr = lane & 15, fq = lane >> 4;
    const int K = P.K, nt = K / BK;
    unsigned voffA[2], voffB[2];
#pragma unroll
    for (int i = 0; i < 2; ++i) { int R, C; stage_rc(tid * 16 + i * 8192, R, C); const int Rb = Prog::PERM ? ((R & ~31) + perm32(R & 31)) : R;
        voffA[i] = (unsigned)(R * 64 + C) * 2u; voffB[i] = (unsigned)(Rb * 64 + C) * 2u; }
    const size_t kstep = (size_t)(HALF * BK * 2);
    const size_t hstep = (size_t)HALF * K * 2;
    const unsigned ldsw = (unsigned)wid * 1024u;
    const int aoff = lds_byte(wr * 64 + fr, fq * 8), boff = lds_byte(wc * 32 + fr, fq * 8);
#define PG8_SA(b, h) (((b) * 2 + (h)) * HTB)
#define PG8_SB(b, h) ((4 + (b) * 2 + (h)) * HTB)
#define PG8_STAGE(bufoff, gbase, voff) do { _Pragma("unroll") for (int _i = 0; _i < 2; ++_i) \
        __builtin_amdgcn_global_load_lds((const unsigned*)((const char*)(gbase) + (voff)[_i]), (LAS unsigned*)(lds + (bufoff) + ldsw + _i * 8192), 16, 0, 0); } while (0)
#define PG8_LDA(dst, b, h) do { _Pragma("unroll") for (int m = 0; m < 4; ++m) _Pragma("unroll") for (int k = 0; k < 2; ++k) dst[m][k] = *(const LAS bf16x8*)(lds + PG8_SA(b, h) + aoff + m * 2048 + k * 1024); } while (0)
#define PG8_LDB(dst, b, h) do { _Pragma("unroll") for (int n = 0; n < 2; ++n) _Pragma("unroll") for (int k = 0; k < 2; ++k) dst[n][k] = *(const LAS bf16x8*)(lds + PG8_SB(b, h) + boff + n * 2048 + k * 1024); } while (0)
#define PG8_MMA(ai, bj, At, Bt) do { __builtin_amdgcn_s_setprio(1); _Pragma("unroll") for (int m = 0; m < 4; ++m) _Pragma("unroll") for (int n = 0; n < 2; ++n) _Pragma("unroll") for (int k = 0; k < 2; ++k) \
        acc[ai][bj][m][n] = __builtin_amdgcn_mfma_f32_16x16x32_bf16(Bt[n][k], At[m][k], acc[ai][bj][m][n], 0, 0, 0); __builtin_amdgcn_s_setprio(0); } while (0)
#define PG8_WAIT_V(n) asm volatile("s_waitcnt vmcnt(" #n ")" ::: "memory")
#define PG8_WAIT_L(n) asm volatile("s_waitcnt lgkmcnt(" #n ")" ::: "memory")
#define PG8_BAR __builtin_amdgcn_s_barrier()
#define PG8_SCHED __builtin_amdgcn_sched_barrier(0)
    GUnit cur, nxt; int ui = 0;
    if (!P.next(0, cur)) return;
    f32x4 acc[2][2][4][2];
#pragma unroll
    for (int a = 0; a < 2; ++a)
#pragma unroll
        for (int b = 0; b < 2; ++b)
#pragma unroll
            for (int m = 0; m < 4; ++m)
#pragma unroll
                for (int n = 0; n < 2; ++n) acc[a][b][m][n] = (f32x4){0.f, 0.f, 0.f, 0.f};
    bf16x8 At[4][2], B0[2][2], B1[2][2];
    const char* cA = cur.A; const char* cB = cur.B;
    PG8_STAGE(PG8_SB(0, 0), cB, voffB); PG8_STAGE(PG8_SA(0, 0), cA, voffA); PG8_STAGE(PG8_SB(0, 1), cB + hstep, voffB); PG8_STAGE(PG8_SA(0, 1), cA + hstep, voffA);
    if (wr == 1) PG8_BAR;
    PG8_WAIT_V(4); PG8_BAR;
    PG8_STAGE(PG8_SB(1, 0), cB + kstep, voffB); PG8_STAGE(PG8_SA(1, 0), cA + kstep, voffA); PG8_STAGE(PG8_SB(1, 1), cB + hstep + kstep, voffB);
    PG8_WAIT_V(6); PG8_BAR;
    for (;;) {
        const bool has_next = P.next(ui + 1, nxt);
        const char* nA = has_next ? nxt.A : cA; const char* nB = has_next ? nxt.B : cB;
        for (int t = 0; t < nt; t += 2) {
            const bool last = (t == nt - 2);
            const char* a1 = cA + (size_t)(t + 1) * kstep;
            const char* a2 = last ? nA : cA + (size_t)(t + 2) * kstep; const char* b2 = last ? nB : cB + (size_t)(t + 2) * kstep;
            const char* a3 = a2 + kstep; const char* b3 = b2 + kstep;
            PG8_LDB(B0, 0, 0); PG8_SCHED; PG8_LDA(At, 0, 0); PG8_STAGE(PG8_SA(1, 1), a1 + hstep, voffA);
            PG8_WAIT_L(8); PG8_BAR; PG8_WAIT_L(0); PG8_MMA(0, 0, At, B0); PG8_BAR; PG8_SCHED;
            PG8_LDB(B1, 0, 1); PG8_STAGE(PG8_SB(0, 0), b2, voffB);
            PG8_BAR; PG8_WAIT_L(0); PG8_MMA(0, 1, At, B1); PG8_BAR;
            PG8_LDA(At, 0, 1); PG8_STAGE(PG8_SA(0, 0), a2, voffA);
            PG8_BAR; PG8_WAIT_L(0); PG8_MMA(1, 0, At, B0); PG8_BAR; PG8_SCHED;
            PG8_STAGE(PG8_SB(0, 1), b2 + hstep, voffB);
            PG8_WAIT_V(6); PG8_BAR; PG8_MMA(1, 1, At, B1); PG8_BAR;
            PG8_LDB(B0, 1, 0); PG8_SCHED; PG8_LDA(At, 1, 0); PG8_STAGE(PG8_SA(0, 1), a2 + hstep, voffA);
            PG8_WAIT_L(8); PG8_BAR; PG8_WAIT_L(0); PG8_MMA(0, 0, At, B0); PG8_BAR; PG8_SCHED;
            PG8_LDB(B1, 1, 1); PG8_STAGE(PG8_SB(1, 0), b3, voffB);
            PG8_BAR; PG8_WAIT_L(0); PG8_MMA(0, 1, At, B1); PG8_BAR;
            PG8_LDA(At, 1, 1); PG8_STAGE(PG8_SA(1, 0), a3, voffA);
            PG8_BAR; PG8_WAIT_L(0); PG8_MMA(1, 0, At, B0); PG8_BAR; PG8_SCHED;
            PG8_STAGE(PG8_SB(1, 1), b3 + hstep, voffB);
            PG8_WAIT_V(6); PG8_BAR; PG8_MMA(1, 1, At, B1); PG8_BAR;
        }
        P.epi(acc, cur, wr, wc, fr, fq);
        if (!has_next) break;
        cur = nxt; cA = nA; cB = nB; ++ui;
    }
    PG8_WAIT_V(0);
    if (wr == 0) PG8_BAR;
    PG8_BAR;
#undef PG8_SA
#undef PG8_SB
#undef PG8_STAGE
#undef PG8_LDA
#undef PG8_LDB
#undef PG8_MMA
#undef PG8_WAIT_V
#undef PG8_WAIT_L
#undef PG8_BAR
#undef PG8_SCHED
}
__device__ __forceinline__ void zero_acc(Acc& acc) {
#pragma unroll
    for (int a = 0; a < 2; ++a)
#pragma unroll
        for (int b = 0; b < 2; ++b)
#pragma unroll
            for (int m = 0; m < 4; ++m)
#pragma unroll
                for (int n = 0; n < 2; ++n) acc[a][b][m][n] = (f32x4){0.f, 0.f, 0.f, 0.f};
}
}
using pg8::GUnit; using pg8::Acc;
__device__ __forceinline__ void unpack8(u32x4 w, float (&f)[8]) { f[0] = bflo(w.x); f[1] = bfhi(w.x); f[2] = bflo(w.y); f[3] = bfhi(w.y); f[4] = bflo(w.z); f[5] = bfhi(w.z); f[6] = bflo(w.w); f[7] = bfhi(w.w); }
struct HyProg {
    static constexpr bool PERM = true; int K, G, c; const bf16_t* W; const bf16_t* X; bf16_t* HY; const float* r1;
    __device__ __forceinline__ bool next(int i, GUnit& u) const { const int L = i * G + c; if (L >= 12 * 64) return false; pg8::tile_of(L, 12, 64, u.pm, u.pn);
        u.A = (const char*)(W + (size_t)u.pm * 256 * DM); u.B = (const char*)(X + (size_t)u.pn * 256 * DM); u.sub = 0; return true; }
    __device__ __forceinline__ void epi(Acc& acc, const GUnit& u, int wr, int wc, int fr, int fq) const {
        const int row0 = u.pm * 256 + wr * 64 + fr, col0 = u.pn * 256 + wc * 32 + 8 * fq;
        f32x4 sc[2][2];
#pragma unroll
        for (int bj = 0; bj < 2; ++bj) { sc[bj][0] = *(const f32x4*)(r1 + col0 + bj * 128); sc[bj][1] = *(const f32x4*)(r1 + col0 + bj * 128 + 4); }
#pragma unroll
        for (int ai = 0; ai < 2; ++ai)
#pragma unroll
            for (int m = 0; m < 4; ++m) { bf16_t* rowp = HY + (size_t)(row0 + ai * 128 + m * 16) * TOK + col0;
#pragma unroll
                for (int bj = 0; bj < 2; ++bj) { const f32x4 v0 = acc[ai][bj][m][0] * sc[bj][0], v1 = acc[ai][bj][m][1] * sc[bj][1];
                    u32x4 w; w.x = pk2(v0[0], v0[1]); w.y = pk2(v0[2], v0[3]); w.z = pk2(v1[0], v1[1]); w.w = pk2(v1[2], v1[3]);
                    *(u32x4*)(rowp + bj * 128) = w; } }
        pg8::zero_acc(acc);
    }
};
struct RestProg {
    static constexpr bool PERM = true; int K, G, c; const bf16_t* W; const bf16_t* X; bf16_t* R1A; bf16_t* R1B; bf16_t* R2; const float* r1;
    __device__ __forceinline__ bool next(int i, GUnit& u) const { const int L = i * G + c; if (L >= 64 * 32) return false; pg8::tile_of(L, 64, 32, u.pm, u.pn);
        u.A = (const char*)(X + (size_t)u.pm * 256 * DM); u.B = (const char*)(W + (size_t)(3072 + u.pn * 256) * DM); u.sub = 0; return true; }
    __device__ __forceinline__ void epi(Acc& acc, const GUnit& u, int wr, int wc, int fr, int fq) const {
        const int row0 = u.pm * 256 + wr * 64 + fr; const bool sg = u.pn >= 12;
        bf16_t* base = u.pn < 8 ? R1A + u.pn * 256 : (u.pn < 16 ? R1B + (u.pn - 8) * 256 : R2 + (u.pn - 16) * 256);
        const int pitch = u.pn < 16 ? 2048 : 4096;
        const int col0 = wc * 32 + 8 * fq;
        float rs[2][4];
#pragma unroll
        for (int ai = 0; ai < 2; ++ai)
#pragma unroll
            for (int m = 0; m < 4; ++m) rs[ai][m] = r1[row0 + ai * 128 + m * 16];
#pragma unroll
        for (int ai = 0; ai < 2; ++ai)
#pragma unroll
            for (int m = 0; m < 4; ++m) { const int row = row0 + ai * 128 + m * 16; const float s = rs[ai][m]; bf16_t* rowp = base + (size_t)row * pitch + col0;
#pragma unroll
                for (int bj = 0; bj < 2; ++bj) { f32x4 v0 = acc[ai][bj][m][0] * s, v1 = acc[ai][bj][m][1] * s;
                    if (sg) {
#pragma unroll
                        for (int j = 0; j < 4; ++j) { v0[j] = sigmoidf_(v0[j]); v1[j] = sigmoidf_(v1[j]); } }
                    u32x4 w; w.x = pk2(v0[0], v0[1]); w.y = pk2(v0[2], v0[3]); w.z = pk2(v1[0], v1[1]); w.w = pk2(v1[2], v1[3]);
                    *(u32x4*)(rowp + bj * 128) = w; } }
        pg8::zero_acc(acc);
    }
};
struct BranchProg {
    static constexpr bool PERM = true; int K, G, c; const bf16_t *YA, *YBF, *YBB, *WA, *WB; const bf16_t* R2; bf16_t* MIX;
    __device__ __forceinline__ bool next(int i, GUnit& u) const { const int ti = i / 3, sub = i - 3 * ti; const int L = ti * G + c; if (L >= 64 * 8) return false; pg8::tile_of(L, 64, 8, u.pm, u.pn);
        const bf16_t* a = sub == 0 ? YA : (sub == 1 ? YBF : YBB); const bf16_t* b = sub == 0 ? WA : WB;
        u.A = (const char*)(a + (size_t)u.pm * 256 * 1024); u.B = (const char*)(b + (size_t)u.pn * 256 * 1024); u.sub = sub; return true; }
    __device__ __forceinline__ void epi(Acc& acc, const GUnit& u, int wr, int wc, int fr, int fq) const {
        if (u.sub == 1) return;
        const int row0 = u.pm * 256 + wr * 64 + fr, col0 = u.pn * 256 + wc * 32 + 8 * fq;
#pragma unroll
        for (int ai = 0; ai < 2; ++ai) {
            u32x4 gbw[4][2], gaw[4][2];
#pragma unroll
            for (int m = 0; m < 4; ++m)
#pragma unroll
                for (int bj = 0; bj < 2; ++bj) { const bf16_t* gp = R2 + (size_t)(row0 + ai * 128 + m * 16) * 4096 + col0 + bj * 128;
                    gbw[m][bj] = *(const u32x4*)(gp + 2048); if (u.sub == 0) gaw[m][bj] = *(const u32x4*)gp; else gaw[m][bj] = gbw[m][bj]; }
#pragma unroll
            for (int m = 0; m < 4; ++m) { const int row = row0 + ai * 128 + m * 16;
#pragma unroll
                for (int bj = 0; bj < 2; ++bj) {
                    float gb[8], ga[8]; unpack8(gbw[m][bj], gb); unpack8(gaw[m][bj], ga);
                    if (u.sub == 0) {
#pragma unroll
                        for (int j = 0; j < 4; ++j) { acc[ai][bj][m][0][j] *= ga[j] / fmaxf(gb[j], 1e-30f); acc[ai][bj][m][1][j] *= ga[4 + j] / fmaxf(gb[4 + j], 1e-30f); }
                    } else {
                        f32x4 v0 = acc[ai][bj][m][0], v1 = acc[ai][bj][m][1];
#pragma unroll
                        for (int j = 0; j < 4; ++j) { v0[j] *= fmaxf(gb[j], 1e-30f); v1[j] *= fmaxf(gb[4 + j], 1e-30f); }
                        u32x4 w; w.x = pk2(v0[0], v0[1]); w.y = pk2(v0[2], v0[3]); w.z = pk2(v1[0], v1[1]); w.w = pk2(v1[2], v1[3]);
                        *(u32x4*)(MIX + blk_off(row, col0 + bj * 128, DM)) = w;
                    } } }
        }
        if (u.sub == 2) pg8::zero_acc(acc);
    }
};
struct ResProg {
    static constexpr bool PERM = false; int K, G, c; const bf16_t* A; const bf16_t* B; const float* base; float* out; bf16_t* outb; float* ss;
    __device__ __forceinline__ bool next(int i, GUnit& u) const { const int L = i * G + c; if (L >= 64 * 8) return false; pg8::tile_of(L, 64, 8, u.pm, u.pn);
        u.A = (const char*)(A + (size_t)u.pm * 256 * K); u.B = (const char*)(B + (size_t)u.pn * 256 * K); u.sub = 0; return true; }
    __device__ __forceinline__ void epi(Acc& acc, const GUnit& u, int wr, int wc, int fr, int fq) const {
        const int row0 = u.pm * 256 + wr * 64 + fr, col0 = u.pn * 256 + wc * 32 + 4 * fq;
#pragma unroll
        for (int ai = 0; ai < 2; ++ai) {
            f32x4 bs[4][2][2];
#pragma unroll
            for (int m = 0; m < 4; ++m)
#pragma unroll
                for (int bj = 0; bj < 2; ++bj)
#pragma unroll
                    for (int n = 0; n < 2; ++n) bs[m][bj][n] = *(const f32x4*)(base + (size_t)(row0 + ai * 128 + m * 16) * DM + col0 + bj * 128 + n * 16);
#pragma unroll
            for (int m = 0; m < 4; ++m) { const int row = row0 + ai * 128 + m * 16; const size_t off = (size_t)row * DM + col0; float s = 0.f;
#pragma unroll
                for (int bj = 0; bj < 2; ++bj)
#pragma unroll
                    for (int n = 0; n < 2; ++n) { const f32x4 o = bs[m][bj][n] + acc[ai][bj][m][n];
                        *(f32x4*)(out + off + bj * 128 + n * 16) = o; s += (o[0] * o[0] + o[1] * o[1]) + (o[2] * o[2] + o[3] * o[3]);
                        if (outb) { u32x2 w; w.x = pk2(o[0], o[1]); w.y = pk2(o[2], o[3]); *(u32x2*)(outb + blk_off(row, col0 + bj * 128 + n * 16, DM)) = w; } }
                s += __shfl_xor(s, 16); s += __shfl_xor(s, 32);
                if (fq == 0) unsafeAtomicAdd(ss + row, s); }
        }
        pg8::zero_acc(acc);
    }
};
struct GuProg {
    static constexpr bool PERM = true; int K, G, c; const bf16_t* X; const bf16_t* W; bf16_t* HH; const float* ss2;
    __device__ __forceinline__ bool next(int i, GUnit& u) const { const int L = i * G + c; if (L >= 64 * 44) return false; pg8::tile_of(L, 64, 44, u.pm, u.pn);
        u.A = (const char*)(X + (size_t)u.pm * 256 * DM); u.B = (const char*)(W + (size_t)u.pn * 256 * DM); u.sub = 0; return true; }
    __device__ __forceinline__ void epi(Acc& acc, const GUnit& u, int wr, int wc, int fr, int fq) const {
        const int row0 = u.pm * 256 + wr * 64 + fr, col0 = u.pn * 128 + wc * 32 + 8 * fq;
        float sq[2][4];
#pragma unroll
        for (int ai = 0; ai < 2; ++ai)
#pragma unroll
            for (int m = 0; m < 4; ++m) sq[ai][m] = ss2[row0 + ai * 128 + m * 16];
#pragma unroll
        for (int ai = 0; ai < 2; ++ai)
#pragma unroll
            for (int m = 0; m < 4; ++m) { const int row = row0 + ai * 128 + m * 16; const float r2 = 1.0f / sqrtf(sq[ai][m] * (1.0f / DM) + RMS_EPS);
                float hv[8];
#pragma unroll
                for (int n = 0; n < 2; ++n)
#pragma unroll
                    for (int j = 0; j < 4; ++j) { const float g = acc[ai][0][m][n][j] * r2, uu = acc[ai][1][m][n][j] * r2; hv[4 * n + j] = siluf_(g) * uu; }
                u32x4 w; w.x = pk2(hv[0], hv[1]); w.y = pk2(hv[2], hv[3]); w.z = pk2(hv[4], hv[5]); w.w = pk2(hv[6], hv[7]);
                *(u32x4*)(HH + blk_off(row, col0, FFH)) = w; }
        pg8::zero_acc(acc);
    }
};
struct Ctx {
    const float* in[21]; float* out; unsigned char* ws;
};
struct TpItem { const float* W; const float* ks; bf16_t* WT; int Nsrc, K, dst_row0, src_col0, kb; };
__device__ __forceinline__ TpItem tp_decode(const Ctx& C, int it) {
    constexpr int I_IN = 32 * 352, I_A = 16 * 64, I_O = 32 * 64, I_GU = 32 * 352;
    unsigned char* ws = C.ws; TpItem t; int r = it;
    if (r < I_IN) { const int nb = r % 352, n0 = nb * 32; t.W = C.in[2]; t.ks = C.in[1]; t.WT = (bf16_t*)(ws + WS_WIN); t.Nsrc = INCOLS; t.K = DM; t.dst_row0 = n0; t.src_col0 = n0 < 7168 ? n0 : n0 + 16; t.kb = r / 352; return t; } r -= I_IN;
    if (r < I_A) { t.W = C.in[14]; t.ks = nullptr; t.WT = (bf16_t*)(ws + WS_WA); t.Nsrc = DM; t.K = HW; t.dst_row0 = (r % 64) * 32; t.src_col0 = t.dst_row0; t.kb = r / 64; return t; } r -= I_A;
    if (r < I_A) { t.W = C.in[15]; t.ks = nullptr; t.WT = (bf16_t*)(ws + WS_WB); t.Nsrc = DM; t.K = MW; t.dst_row0 = (r % 64) * 32; t.src_col0 = t.dst_row0; t.kb = r / 64; return t; } r -= I_A;
    if (r < I_O) { t.W = C.in[16]; t.ks = nullptr; t.WT = (bf16_t*)(ws + WS_WOUT); t.Nsrc = DM; t.K = DM; t.dst_row0 = (r % 64) * 32; t.src_col0 = t.dst_row0; t.kb = r / 64; return t; } r -= I_O;
    if (r < I_GU) { const int nb = r % 352, n0 = nb * 32; const int pn = n0 >> 8, half = (n0 >> 7) & 1, i = n0 & 127;
        t.W = C.in[18]; t.ks = C.in[17]; t.WT = (bf16_t*)(ws + WS_WGU); t.Nsrc = 2 * FFH; t.K = DM; t.dst_row0 = n0; t.src_col0 = half * FFH + 128 * pn + i; t.kb = r / 352; return t; } r -= I_GU;
    t.W = C.in[19]; t.ks = nullptr; t.WT = (bf16_t*)(ws + WS_WD); t.Nsrc = DM; t.K = FFH; t.dst_row0 = (r % 64) * 32; t.src_col0 = t.dst_row0; t.kb = r / 64; return t;
}
__device__ __forceinline__ void tp_load(const TpItem& t, int lane, float (&tv)[32], float (&sv)[32]) {
    const int k0 = 64 * t.kb; const float* wp = t.W + (size_t)(k0 + (lane >> 5)) * t.Nsrc + t.src_col0 + (lane & 31);
#pragma unroll
    for (int i = 0; i < 32; ++i) tv[i] = wp[(size_t)(2 * i) * t.Nsrc];
    const float* kp = t.ks ? t.ks + k0 + (lane >> 5) : nullptr;
#pragma unroll
    for (int i = 0; i < 32; ++i) sv[i] = kp ? kp[2 * i] : 1.0f;
}
__device__ __forceinline__ void p0_prologue(const Ctx& C, LAS unsigned char* lds, int G, int wv) {
    int tid = (wv << 6) | lane_id_opaque(); asm volatile("" : "+v"(tid));
    const int lane = tid & 63, wave = __builtin_amdgcn_readfirstlane(tid >> 6);
    const int gw = blockIdx.x * 8 + wave, NGW = G * 8;
    unsigned char* ws = C.ws;
    LAS float* scr = (LAS float*)(lds + wave * 8704);
    {
        constexpr int NIT = 32 * 352 + 2 * 16 * 64 + 32 * 64 + 32 * 352 + 88 * 64;
        float tv[32], sv[32]; TpItem cur, nxt; int it = gw;
        if (it < NIT) { cur = tp_decode(C, it); tp_load(cur, lane, tv, sv); }
        while (it < NIT) {
#pragma unroll
            for (int i = 0; i < 32; ++i) scr[(2 * i + (lane >> 5)) * 33 + (lane & 31)] = tv[i] * sv[i];
            asm volatile("s_waitcnt lgkmcnt(0)" ::: "memory");
            const int nit = it + NGW;
            if (nit < NIT) { nxt = tp_decode(C, nit); tp_load(nxt, lane, tv, sv); }
            const int c = lane & 7, k0 = 64 * cur.kb;
#pragma unroll
            for (int j = 0; j < 4; ++j) { const int n = (lane >> 3) + 8 * j; const LAS float* sp = scr + (8 * c) * 33 + n;
                u32x4 o; o.x = pk2(sp[0 * 33], sp[1 * 33]); o.y = pk2(sp[2 * 33], sp[3 * 33]); o.z = pk2(sp[4 * 33], sp[5 * 33]); o.w = pk2(sp[6 * 33], sp[7 * 33]);
                *(u32x4*)(cur.WT + blk_off(cur.dst_row0 + n, k0 + 8 * c, cur.K)) = o; }
            asm volatile("s_waitcnt lgkmcnt(0)" ::: "memory");
            cur = nxt; it = nit;
        }
    }
    for (int i = blockIdx.x * 512 + tid; i < TOK; i += G * 512) { ((float*)(ws + WS_SS2))[i] = 0.f; ((float*)(ws + WS_SS3))[i] = 0.f; }
    {
        const float* w1 = C.in[5]; const float* b1 = C.in[6]; const float* f1 = C.in[7]; const float* w2 = C.in[8]; const float* b2 = C.in[9]; const float* f2 = C.in[10];
        float* h2 = (float*)(ws + WS_H2);
        for (int t = gw; t < SEQ; t += NGW) {
            const float tl = (float)t / (float)(SEQ - 1);
            const float omega = 6.283185307179586f * (float)t / (float)SEQ;
            float a = b1[lane] + tl * w1[lane];
            float sn, cs;
            { const int bi = lane & 15; const float fr = 1e-4f + (float)bi * ((15.0f - 1e-4f) / 15.0f); sincosf(omega * fr, &sn, &cs); }
#pragma unroll
            for (int i = 0; i < 16; ++i) a += __shfl(cs, i) * w1[(1 + i) * 64 + lane] - __shfl(sn, i) * w1[(17 + i) * 64 + lane];
            const float h1 = sinf(f1[lane] * a);
            float a2 = b2[lane];
#pragma unroll 8
            for (int i = 0; i < 64; ++i) a2 += __shfl(h1, i) * w2[i * 64 + lane];
            h2[t * 64 + lane] = sinf(f2[lane] * a2);
        }
    }
    __syncthreads();
    {
        constexpr int WGP = 2056;
        LAS bf16_t* wgb = (LAS bf16_t*)lds;
        const float* w_in = C.in[2]; const float* nw = C.in[1];
#pragma unroll 1
        for (int i0 = tid; i0 < DM * 16; i0 += 512 * 16) { float tw[16], tn[16];
#pragma unroll
            for (int u = 0; u < 16; ++u) { const int i = i0 + 512 * u, k = i >> 4, g = i & 15; tw[u] = w_in[(size_t)k * INCOLS + 7168 + g]; tn[u] = nw[k]; }
#pragma unroll
            for (int u = 0; u < 16; ++u) { const int i = i0 + 512 * u, k = i >> 4, g = i & 15; wgb[g * WGP + k] = (bf16_t)f2bf(tw[u] * tn[u]); } }
        __syncthreads();
        const float* x = C.in[0]; bf16_t* xb = (bf16_t*)(ws + WS_XB); float* r1 = (float*)(ws + WS_R1S); float* Gt = (float*)(ws + WS_G); const float* gbias = C.in[13];
        const int r = lane & 15, g = lane >> 4; const bool act = r < 8;
        for (int rb = gw; rb < TOK / 8; rb += NGW) {
            const int row = rb * 8 + (r & 7);
            const float* xp = x + (size_t)row * DM + 8 * g;
            f32x4 acc = {0.f, 0.f, 0.f, 0.f}; float ss = 0.f;
#pragma unroll 1
            for (int k8 = 0; k8 < 64; k8 += 8) {
                f32x4 la[8], lb[8];
#pragma unroll
                for (int u = 0; u < 8; ++u) { la[u] = *(const f32x4*)(xp + 32 * (k8 + u)); lb[u] = *(const f32x4*)(xp + 32 * (k8 + u) + 4); }
#pragma unroll
                for (int u = 0; u < 8; ++u) { const int kk = k8 + u; const f32x4 a = la[u], b = lb[u];
                    ss += ((a.x * a.x + a.y * a.y) + (a.z * a.z + a.w * a.w)) + ((b.x * b.x + b.y * b.y) + (b.z * b.z + b.w * b.w));
                    u32x4 o; o.x = pk2(a.x, a.y); o.y = pk2(a.z, a.w); o.z = pk2(b.x, b.y); o.w = pk2(b.z, b.w);
                    *(u32x4*)(xb + blk_off(row, 32 * kk + 8 * g, DM)) = o;
                    if (!act) { o.x = 0u; o.y = 0u; o.z = 0u; o.w = 0u; }
                    const bf16x8 bw = *(const LAS bf16x8*)(wgb + r * WGP + 32 * kk + 8 * g);
                    acc = __builtin_amdgcn_mfma_f32_16x16x32_bf16(__builtin_bit_cast(bf16x8, o), bw, acc, 0, 0, 0); }
            }
            ss += __shfl_xor(ss, 16); ss += __shfl_xor(ss, 32);
            const float rinv = 1.0f / sqrtf(ss * (1.0f / DM) + RMS_EPS);
            const float gb = gbias[r];
#pragma unroll
            for (int i = 0; i < 4; ++i) { const int m = 4 * g + i; const float rv = __shfl(rinv, m & 7); if (g < 2) Gt[(size_t)(rb * 8 + m) * 16 + r] = acc[i] * rv + gb; }
            if (lane < 8) r1[rb * 8 + lane] = rinv;
        }
    }
}
__device__ __forceinline__ void p1_filters(const Ctx& C, LAS unsigned char* lds, int G, int wv) {
    int tid = (wv << 6) | lane_id_opaque(); asm volatile("" : "+v"(tid));
    const int lane = tid & 63, w = tid >> 6, r = lane & 15, g = lane >> 4;
    const float* w3 = C.in[11]; const float* h2 = (const float*)(C.ws + WS_H2); float* FILT = (float*)(C.ws + WS_FILT);
    for (int item = blockIdx.x; item < 256; item += G) {
        const int n0 = 64 * (item >> 2), t0 = 1024 * (item & 3) + 128 * w;
        bf16x8 af[4][2];
#pragma unroll
        for (int mt = 0; mt < 4; ++mt)
#pragma unroll
            for (int ks = 0; ks < 2; ++ks) { float v[8];
#pragma unroll
                for (int e = 0; e < 8; ++e) v[e] = w3[(size_t)(32 * ks + 8 * g + e) * NFILT + n0 + 16 * mt + r];
                u32x4 o; o.x = pk2(v[0], v[1]); o.y = pk2(v[2], v[3]); o.z = pk2(v[4], v[5]); o.w = pk2(v[6], v[7]); af[mt][ks] = __builtin_bit_cast(bf16x8, o); }
        float dl[4][4];
#pragma unroll
        for (int mt = 0; mt < 4; ++mt)
#pragma unroll
            for (int i = 0; i < 4; ++i) { const int ch = (n0 + 16 * mt + 4 * g + i) & 1023; const float mind = -3.0701134573253945f, maxd = -15.350567286626973f;
                dl[mt][i] = fabsf(mind + (float)ch * ((maxd - mind) / 1023.0f)); }
        bf16x8 bfr[8][2];
#pragma unroll
        for (int nt = 0; nt < 8; ++nt) { const int t = t0 + 16 * nt + r;
#pragma unroll
            for (int ks = 0; ks < 2; ++ks) { const f32x4 a = *(const f32x4*)(h2 + (size_t)t * 64 + 32 * ks + 8 * g), b = *(const f32x4*)(h2 + (size_t)t * 64 + 32 * ks + 8 * g + 4);
                u32x4 o; o.x = pk2(a.x, a.y); o.y = pk2(a.z, a.w); o.z = pk2(b.x, b.y); o.w = pk2(b.z, b.w); bfr[nt][ks] = __builtin_bit_cast(bf16x8, o); } }
#pragma unroll
        for (int nt = 0; nt < 8; ++nt) {
            const int t = t0 + 16 * nt + r;
            const float tl = (float)t / (float)(SEQ - 1);
#pragma unroll
            for (int mt = 0; mt < 4; ++mt) {
                f32x4 acc = {0.f, 0.f, 0.f, 0.f};
                acc = __builtin_amdgcn_mfma_f32_16x16x32_bf16(af[mt][0], bfr[nt][0], acc, 0, 0, 0);
                acc = __builtin_amdgcn_mfma_f32_16x16x32_bf16(af[mt][1], bfr[nt][1], acc, 0, 0, 0);
#pragma unroll
                for (int i = 0; i < 4; ++i) FILT[(size_t)(n0 + 16 * mt + 4 * g + i) * SEQ + t] = acc[i] * expf(-tl * dl[mt][i]);
            }
        }
    }
}
__device__ __forceinline__ void p7_final(const Ctx& C, int G, int wv) {
    int tid = (wv << 6) | lane_id_opaque(); asm volatile("" : "+v"(tid));
    const int lane = tid & 63, wave = tid >> 6, gw = blockIdx.x * 8 + wave, NGW = G * 8;
    const float* ss3 = (const float*)(C.ws + WS_SS3); const float* wf = C.in[20];
    f32x4 w[8];
#pragma unroll
    for (int j = 0; j < 8; ++j) w[j] = ((const f32x4*)wf)[64 * j + lane];
    for (int row = gw; row < TOK; row += 2 * NGW) {
        const int row2 = row + NGW;
        const bool has2 = row2 < TOK;
        const float r = 1.0f / sqrtf(ss3[row] * (1.0f / DM) + RMS_EPS), r2 = has2 ? 1.0f / sqrtf(ss3[row2] * (1.0f / DM) + RMS_EPS) : 0.f;
        f32x4* p = (f32x4*)(C.out + (size_t)row * DM) + lane; f32x4* p2 = (f32x4*)(C.out + (size_t)(has2 ? row2 : row) * DM) + lane;
        f32x4 v[8], u[8];
#pragma unroll
        for (int j = 0; j < 8; ++j) { v[j] = p[64 * j]; u[j] = p2[64 * j]; }
#pragma unroll
        for (int j = 0; j < 8; ++j) p[64 * j] = v[j] * r * w[j];
        if (has2) {
#pragma unroll
            for (int j = 0; j < 8; ++j) p2[64 * j] = u[j] * r2 * w[j]; }
    }
}
#ifndef FFT_HOST
#define FFT_DEV __device__ __forceinline__
#define FFT_PTR LAS f32x2*
#define FFT_SIN(x) __builtin_amdgcn_sinf(x)
#define FFT_COS(x) __builtin_amdgcn_cosf(x)
#else
#define FFT_DEV static inline
#define FFT_PTR f32x2*
#define FFT_SIN(x) sinf(6.283185307179586f * (x))
#define FFT_COS(x) cosf(6.283185307179586f * (x))
#endif
#define PADI(i) ((i) + ((i) >> 4))
FFT_DEV f32x2 cmul(f32x2 a, f32x2 b) { f32x2 r; r.x = a.x * b.x - a.y * b.y; r.y = a.x * b.y + a.y * b.x; return r; }
FFT_DEV f32x2 cmulc(f32x2 a, f32x2 b) { f32x2 r; r.x = a.x * b.x + a.y * b.y; r.y = a.y * b.x - a.x * b.y; return r; }
FFT_DEV f32x2 twid(float frac) { f32x2 r; r.x = FFT_COS(frac); r.y = -FFT_SIN(frac); return r; }
template <int M, int CJ> FFT_DEV f32x2 rot8(f32x2 d) {
    const float R = 0.70710678118654752f; f32x2 r;
    if (M == 0) return d;
    if (M == 2) { if (!CJ) { r.x = d.y; r.y = -d.x; } else { r.x = -d.y; r.y = d.x; } return r; }
    if (M == 1) { if (!CJ) { r.x = R * (d.x + d.y); r.y = R * (d.y - d.x); } else { r.x = R * (d.x - d.y); r.y = R * (d.x + d.y); } return r; }
    if (!CJ) { r.x = R * (d.y - d.x); r.y = -R * (d.x + d.y); } else { r.x = -R * (d.x + d.y); r.y = R * (d.x - d.y); } return r;
}
template <int INV, int ZHI, int LOW> FFT_DEV void fft_r8_pass(FFT_PTR buf, int s, int ls  , int tid) {
#pragma unroll 1
    for (int rep = 0; rep < 2; ++rep) {
        const int bf = tid + rep * 512, j = bf & (s - 1), blk = bf >> ls, base = blk * 8 * s + j;
        f32x2 x[8];
#pragma unroll
        for (int m = 0; m < (ZHI ? 4 : 8); ++m) x[m] = buf[PADI(base + m * s)];
        f32x2 w1 = twid((float)j / (float)(8 * s));
        f32x2 w2 = cmul(w1, w1), w4 = cmul(w2, w2);
        if (!INV) {
            if (ZHI) {
                x[4] = cmul(x[0], w1); x[5] = cmul(rot8<1, 0>(x[1]), w1); x[6] = cmul(rot8<2, 0>(x[2]), w1); x[7] = cmul(rot8<3, 0>(x[3]), w1);
            } else {
                { f32x2 a = x[0], b = x[4]; x[0] = a + b; x[4] = cmul(a - b, w1); }
                { f32x2 a = x[1], b = x[5]; x[1] = a + b; x[5] = cmul(rot8<1, 0>(a - b), w1); }
                { f32x2 a = x[2], b = x[6]; x[2] = a + b; x[6] = cmul(rot8<2, 0>(a - b), w1); }
                { f32x2 a = x[3], b = x[7]; x[3] = a + b; x[7] = cmul(rot8<3, 0>(a - b), w1); }
            }
#pragma unroll
            for (int h = 0; h < 8; h += 4) {
                { f32x2 a = x[h], b = x[h + 2]; x[h] = a + b; x[h + 2] = cmul(a - b, w2); }
                { f32x2 a = x[h + 1], b = x[h + 3]; x[h + 1] = a + b; x[h + 3] = cmul(rot8<2, 0>(a - b), w2); }
            }
#pragma unroll
            for (int m = 0; m < 8; m += 2) { f32x2 a = x[m], b = x[m + 1]; x[m] = a + b; x[m + 1] = cmul(a - b, w4); }
        } else {
#pragma unroll
            for (int m = 0; m < 8; m += 2) { f32x2 a = x[m], b = cmulc(x[m + 1], w4); x[m] = a + b; x[m + 1] = a - b; }
#pragma unroll
            for (int h = 0; h < 8; h += 4) {
                { f32x2 a = x[h], b = cmulc(x[h + 2], w2); x[h] = a + b; x[h + 2] = a - b; }
                { f32x2 a = x[h + 1], b = rot8<2, 1>(cmulc(x[h + 3], w2)); x[h + 1] = a + b; x[h + 3] = a - b; }
            }
            { f32x2 a = x[0], b = cmulc(x[4], w1); x[0] = a + b; if (!LOW) x[4] = a - b; }
            { f32x2 a = x[1], b = rot8<1, 1>(cmulc(x[5], w1)); x[1] = a + b; if (!LOW) x[5] = a - b; }
            { f32x2 a = x[2], b = rot8<2, 1>(cmulc(x[6], w1)); x[2] = a + b; if (!LOW) x[6] = a - b; }
            { f32x2 a = x[3], b = rot8<3, 1>(cmulc(x[7], w1)); x[3] = a + b; if (!LOW) x[7] = a - b; }
        }
#pragma unroll
        for (int m = 0; m < (LOW ? 4 : 8); ++m) buf[PADI(base + m * s)] = x[m];
    }
}
FFT_DEV void fft_r2_span1(FFT_PTR buf, int tid) {
#pragma unroll
    for (int rep = 0; rep < 8; ++rep) { const int p = 2 * (tid + rep * 512); f32x2 a = buf[PADI(p)], b = buf[PADI(p + 1)]; buf[PADI(p)] = a + b; buf[PADI(p + 1)] = a - b; }
}
template <int J, int CJ> FFT_DEV f32x2 rot16(f32x2 d) {
    const float C1 = 0.92387953251128674f, S1 = 0.38268343236508977f;
    if ((J & 1) == 0) return rot8<J / 2, CJ>(d);
    const float wr = (J == 1) ? C1 : (J == 3) ? S1 : (J == 5) ? -S1 : -C1;
    const float wi = ((J == 1) ? -S1 : (J == 3) ? -C1 : (J == 5) ? -C1 : -S1) * (CJ ? -1.f : 1.f);
    f32x2 r; r.x = d.x * wr - d.y * wi; r.y = d.x * wi + d.y * wr; return r;
}
FFT_DEV unsigned brev13(unsigned p);
FFT_DEV void fft16_dif(f32x2 (&x)[16]) {
#define BF_(i, j, ROT) { const f32x2 a_ = x[i], b_ = x[j]; x[i] = a_ + b_; x[j] = ROT(a_ - b_); }
    BF_(0, 8, (rot16<0, 0>)) BF_(1, 9, (rot16<1, 0>)) BF_(2, 10, (rot16<2, 0>)) BF_(3, 11, (rot16<3, 0>)) BF_(4, 12, (rot16<4, 0>)) BF_(5, 13, (rot16<5, 0>)) BF_(6, 14, (rot16<6, 0>)) BF_(7, 15, (rot16<7, 0>))
#pragma unroll
    for (int h = 0; h < 16; h += 8) { BF_(h + 0, h + 4, (rot8<0, 0>)) BF_(h + 1, h + 5, (rot8<1, 0>)) BF_(h + 2, h + 6, (rot8<2, 0>)) BF_(h + 3, h + 7, (rot8<3, 0>)) }
#pragma unroll
    for (int h = 0; h < 16; h += 4) { BF_(h + 0, h + 2, (rot8<0, 0>)) BF_(h + 1, h + 3, (rot8<2, 0>)) }
#pragma unroll
    for (int h = 0; h < 16; h += 2) { BF_(h, h + 1, (rot8<0, 0>)) }
#undef BF_
}
FFT_DEV void fft16_dit_inv(f32x2 (&x)[16]) {
#define BI_(i, j, ROT) { const f32x2 a_ = x[i], b_ = ROT(x[j]); x[i] = a_ + b_; x[j] = a_ - b_; }
#pragma unroll
    for (int h = 0; h < 16; h += 2) { BI_(h, h + 1, (rot8<0, 1>)) }
#pragma unroll
    for (int h = 0; h < 16; h += 4) { BI_(h + 0, h + 2, (rot8<0, 1>)) BI_(h + 1, h + 3, (rot8<2, 1>)) }
#pragma unroll
    for (int h = 0; h < 16; h += 8) { BI_(h + 0, h + 4, (rot8<0, 1>)) BI_(h + 1, h + 5, (rot8<1, 1>)) BI_(h + 2, h + 6, (rot8<2, 1>)) BI_(h + 3, h + 7, (rot8<3, 1>)) }
    BI_(0, 8, (rot16<0, 1>)) BI_(1, 9, (rot16<1, 1>)) BI_(2, 10, (rot16<2, 1>)) BI_(3, 11, (rot16<3, 1>)) BI_(4, 12, (rot16<4, 1>)) BI_(5, 13, (rot16<5, 1>)) BI_(6, 14, (rot16<6, 1>)) BI_(7, 15, (rot16<7, 1>))
#undef BI_
}
template <int MODE> FFT_DEV void fft_mid_pass(FFT_PTR wb, FFT_PTR zk, int tid) {
    f32x2 x[16];
#pragma unroll
    for (int e = 0; e < 16; ++e) x[e] = wb[PADI(16 * tid + e)];
    fft16_dif(x);
    if (MODE != 0) {
#pragma unroll
        for (int e = 0; e < 16; ++e) {
            const unsigned p = 16u * (unsigned)tid + (unsigned)e, f = brev13(p), fn = (8192u - f) & 8191u, pn = brev13(fn);
            const f32x2 zf = zk[PADI(p)], zn = zk[PADI(pn)];
            f32x2 kf;
            if (MODE == 1) { kf.x = 0.5f * (zf.x + zn.x); kf.y = 0.5f * (zf.y - zn.y); }
            else           { kf.x = 0.5f * (zf.y + zn.y); kf.y = 0.5f * (zn.x - zf.x); }
            x[e] = cmul(x[e], kf);
        }
        fft16_dit_inv(x);
    }
#pragma unroll
    for (int e = 0; e < 16; ++e) wb[PADI(16 * tid + e)] = x[e];
}
#ifndef FFT_HOST
#define FFT_SYNC() do { asm volatile("s_waitcnt lgkmcnt(0)" ::: "memory"); __builtin_amdgcn_s_barrier(); asm volatile("" ::: "memory"); } while (0)
__device__ __forceinline__ void fft_fwd_full(FFT_PTR buf, int tid) {
    FFT_SYNC(); fft_r8_pass<0, 0, 0>(buf, 1024, 10, tid); FFT_SYNC(); fft_r8_pass<0, 0, 0>(buf, 128, 7, tid); FFT_SYNC(); fft_r8_pass<0, 0, 0>(buf, 16, 4, tid); FFT_SYNC();
    fft_mid_pass<0>(buf, buf, tid); FFT_SYNC();
}
template <int WHICH> __device__ __forceinline__ void fft_conv(FFT_PTR wb, FFT_PTR zk, int tid) {
    FFT_SYNC(); fft_r8_pass<0, 1, 0>(wb, 1024, 10, tid); FFT_SYNC(); fft_r8_pass<0, 0, 0>(wb, 128, 7, tid); FFT_SYNC(); fft_r8_pass<0, 0, 0>(wb, 16, 4, tid); FFT_SYNC();
    fft_mid_pass<1 + WHICH>(wb, zk, tid); FFT_SYNC();
    fft_r8_pass<1, 0, 0>(wb, 16, 4, tid); FFT_SYNC(); fft_r8_pass<1, 0, 0>(wb, 128, 7, tid); FFT_SYNC(); fft_r8_pass<1, 0, 1>(wb, 1024, 10, tid); FFT_SYNC();
}
#endif
FFT_DEV unsigned brev13(unsigned p) {
    unsigned r = 0;
#ifndef FFT_HOST
    r = __brev(p) >> 19;
#else
    for (int i = 0; i < 13; ++i) r |= ((p >> i) & 1u) << (12 - i);
#endif
    return r;
}
FFT_DEV void fft_pointwise(FFT_PTR wb, FFT_PTR zk, int which, int tid) {
#pragma unroll 4
    for (int rep = 0; rep < 16; ++rep) {
        const unsigned p = tid + rep * 512, f = brev13(p), fn = (8192u - f) & 8191u, pn = brev13(fn);
        const f32x2 zf = zk[PADI(p)], zn = zk[PADI(pn)];
        f32x2 kf;
        if (which == 0) { kf.x = 0.5f * (zf.x + zn.x); kf.y = 0.5f * (zf.y - zn.y); }
        else            { kf.x = 0.5f * (zf.y + zn.y); kf.y = 0.5f * (zn.x - zf.x); }
        wb[PADI(p)] = cmul(wb[PADI(p)], kf);
    }
}
__device__ __forceinline__ void qk_prepass(const Ctx& C, int G, int wv) {
    int tid = (wv << 6) | lane_id_opaque(); asm volatile("" : "+v"(tid));
    const bf16_t* R1A = (const bf16_t*)(C.ws + WS_R1A); bf16_t* QKP = (bf16_t*)(C.ws + WS_QKP);
    const float* cw = C.in[3]; const float* cb = C.in[4];
    const int cg8 = tid & 255, half = tid >> 8, col = 8 * cg8;
    float k0[8], k1[8], k2[8], kb[8];
    { const int ch = 3072 + col;
      const f32x4 t0 = *(const f32x4*)(cw + ch), t1 = *(const f32x4*)(cw + ch + 4), t2 = *(const f32x4*)(cw + CONVC + ch), t3 = *(const f32x4*)(cw + CONVC + ch + 4);
      const f32x4 t4 = *(const f32x4*)(cw + 2 * CONVC + ch), t5 = *(const f32x4*)(cw + 2 * CONVC + ch + 4), t6 = *(const f32x4*)(cb + ch), t7 = *(const f32x4*)(cb + ch + 4);
#pragma unroll
      for (int e = 0; e < 4; ++e) { k0[e] = t0[e]; k0[4 + e] = t1[e]; k1[e] = t2[e]; k1[4 + e] = t3[e]; k2[e] = t4[e]; k2[4 + e] = t5[e]; kb[e] = t6[e]; kb[4 + e] = t7[e]; } }
    const float osc = col >= 1024 ? 0.0625f : 1.0f;
    for (int run = blockIdx.x; run < TOK / 64; run += G) {
        const int row0 = run * 64 + half * 32;
#pragma unroll 1
        for (int i0 = 0; i0 < 32; i0 += 4) {
            u32x4 w0[4], w1[4], w2[4];
#pragma unroll
            for (int u = 0; u < 4; ++u) { const int row = row0 + i0 + u, t = row & (SEQ - 1); const bf16_t* p = R1A + (size_t)row * 2048 + col;
                w0[u] = *(const u32x4*)(t > 0 ? p - 2048 : p); w1[u] = *(const u32x4*)p; w2[u] = *(const u32x4*)(t < SEQ - 1 ? p + 2048 : p); }
#pragma unroll
            for (int u = 0; u < 4; ++u) { const int row = row0 + i0 + u, t = row & (SEQ - 1);
                const u32x4 z = {0u, 0u, 0u, 0u}; if (t == 0) w0[u] = z; if (t == SEQ - 1) w2[u] = z;
                float a0[8], a1[8], a2[8]; unpack8(w0[u], a0); unpack8(w1[u], a1); unpack8(w2[u], a2);
                float v[8];
#pragma unroll
                for (int e = 0; e < 8; ++e) v[e] = siluf_(k0[e] * a0[e] + k1[e] * a1[e] + k2[e] * a2[e] + kb[e]) * osc;
                u32x4 o; o.x = pk2(v[0], v[1]); o.y = pk2(v[2], v[3]); o.z = pk2(v[4], v[5]); o.w = pk2(v[6], v[7]);
                *(u32x4*)(QKP + (size_t)row * 2048 + col) = o; }
        }
    }
}
constexpr int ML_KS = 0, ML_KP = 528, ML_SS = 76032, ML_SP = 272, ML_VS = 110848, ML_VP = 80, ML_VW = 121088, ML_CS = 131328, ML_CP = 528, ML_SC = 148224;
static_assert(ML_SC + 7 * 512 + 64 + 5 * 128 <= LDS_BYTES - 16, "mLSTM LDS map");
__device__ __forceinline__ bf16x8 tr_read2(unsigned a0, unsigned a1) {
    bf16x4 lo, hi;
    asm volatile("ds_read_b64_tr_b16 %0, %2\n\tds_read_b64_tr_b16 %1, %3\n\ts_waitcnt lgkmcnt(0)" : "=&v"(lo), "=&v"(hi) : "v"(a0), "v"(a1) : "memory");
    bf16x8 r; r[0] = lo[0]; r[1] = lo[1]; r[2] = lo[2]; r[3] = lo[3]; r[4] = hi[0]; r[5] = hi[1]; r[6] = hi[2]; r[7] = hi[3]; return r;
}
__device__ __forceinline__ bf16x8 cat4(bf16x4 lo, bf16x4 hi) { bf16x8 r; r[0] = lo[0]; r[1] = lo[1]; r[2] = lo[2]; r[3] = lo[3]; r[4] = hi[0]; r[5] = hi[1]; r[6] = hi[2]; r[7] = hi[3]; return r; }
__device__ __forceinline__ void tr_read2x2(unsigned a, unsigned b, unsigned d, bf16x8& ra, bf16x8& rb) {
    bf16x4 l0, h0, l1, h1;
    asm volatile("ds_read_b64_tr_b16 %0, %4\n\tds_read_b64_tr_b16 %1, %5\n\tds_read_b64_tr_b16 %2, %6\n\tds_read_b64_tr_b16 %3, %7\n\ts_waitcnt lgkmcnt(0)"
        : "=&v"(l0), "=&v"(h0), "=&v"(l1), "=&v"(h1) : "v"(a), "v"(a + d), "v"(b), "v"(b + d) : "memory");
    ra = cat4(l0, h0); rb = cat4(l1, h1);
}
__device__ __forceinline__ void tr_read4x2(unsigned a, unsigned b, unsigned d, unsigned c, unsigned e, unsigned d2, bf16x8& ra, bf16x8& rb, bf16x8& rc, bf16x8& re) {
    bf16x4 l0, h0, l1, h1, l2, h2, l3, h3;
    asm volatile("ds_read_b64_tr_b16 %0, %8\n\tds_read_b64_tr_b16 %1, %9\n\tds_read_b64_tr_b16 %2, %10\n\tds_read_b64_tr_b16 %3, %11\n\t"
                 "ds_read_b64_tr_b16 %4, %12\n\tds_read_b64_tr_b16 %5, %13\n\tds_read_b64_tr_b16 %6, %14\n\tds_read_b64_tr_b16 %7, %15\n\ts_waitcnt lgkmcnt(0)"
        : "=&v"(l0), "=&v"(h0), "=&v"(l1), "=&v"(h1), "=&v"(l2), "=&v"(h2), "=&v"(l3), "=&v"(h3)
        : "v"(a), "v"(a + d), "v"(b), "v"(b + d), "v"(c), "v"(c + d2), "v"(e), "v"(e + d2) : "memory");
    ra = cat4(l0, h0); rb = cat4(l1, h1); rc = cat4(l2, h2); re = cat4(l3, h3);
}
__device__ __forceinline__ float bf2f(short s) { return __uint_as_float(((unsigned)(unsigned short)s) << 16); }
__device__ __forceinline__ float logsigmoidf_(float x) { return fminf(x, 0.f) - log1pf(expf(-fabsf(x))); }

__device__ __forceinline__ void mlstm_item(const Ctx& C, LAS unsigned char* lds, int item, int wv) {
    int tid = (wv << 6) | lane_id_opaque(); asm volatile("" : "+v"(tid));
    const int lane = tid & 63, w = __builtin_amdgcn_readfirstlane(tid >> 6), r = lane & 15, g = lane >> 4, q4 = r >> 2, p4 = r & 3;
    const int vs = item & 7, dir = (item >> 3) & 1, bh = item >> 4, b = bh >> 2, h = bh & 3;
    const bf16_t* QKP = (const bf16_t*)(C.ws + WS_QKP); const bf16_t* R1B = (const bf16_t*)(C.ws + WS_R1B); const float* Gt = (const float*)(C.ws + WS_G);
    bf16_t* Y = (bf16_t*)(C.ws + (dir ? WS_YBB : WS_YBF));
    LAS float* SC = (LAS float*)(lds + ML_SC);
    LAS float* s_cs = SC, *s_rj = SC + 128, *s_iw = SC + 256, *s_emj = SC + 384, *s_w = SC + 512, *s_dn = SC + 640, *s_misc = SC + 768;
    LAS float* c_bl = SC + 784, *c_mx = SC + 816, *c_mp = SC + 848, *c_mn = SC + 880, *c_kp = SC + 912;
    float* GS = (float*)(C.ws + WS_GSC) + (size_t)item * 3 * SEQ;
    const unsigned lbase = (unsigned)(size_t)lds;
    const int pc = tid & 31, krow = tid >> 5, vrow = tid >> 2, pv = tid & 3;
    const int sw = w < 4 ? w : 11 - w;
    for (int i = tid; i < 16896 / 4; i += 512) ((LAS unsigned*)(lds + ML_CS))[i] = 0u;
    for (int i = tid; i < 16 * ML_KP / 4; i += 512) ((LAS unsigned*)(lds + ML_KS + 128 * ML_KP))[i] = 0u;
    f32x4 Cacc[3][2];
#pragma unroll
    for (int a = 0; a < 3; ++a) { Cacc[a][0] = (f32x4){0.f, 0.f, 0.f, 0.f}; Cacc[a][1] = (f32x4){0.f, 0.f, 0.f, 0.f}; }
    u32x4 kreg[8], vreg, qn[8]; float bn = 0.f, csn = 0.f, pmn = 0.f;
#define ML_TOK(c_, j_) ((size_t)b * SEQ + (dir ? SEQ - 1 - ((c_) * 128 + (j_)) : ((c_) * 128 + (j_))))
#define ML_PREFETCH(c_) do { \
        _Pragma("unroll") for (int i = 0; i < 8; ++i) kreg[i] = *(const u32x4*)(QKP + ML_TOK(c_, krow + 16 * i) * 2048 + 1024 + h * 256 + 8 * pc); \
        vreg = *(const u32x4*)(R1B + ML_TOK(c_, vrow) * 2048 + h * 256 + vs * 32 + 8 * pv); \
        { const bf16_t* qp = QKP + ML_TOK(c_, 16 * sw + r) * 2048 + h * 256 + 8 * g; _Pragma("unroll") for (int kk = 0; kk < 8; ++kk) qn[kk] = *(const u32x4*)(qp + 32 * kk); } \
        if (tid < 128) { const int ta = (c_) * 128 + tid; bn = GS[ta]; csn = GS[SEQ + ta]; pmn = GS[2 * SEQ + ta]; } } while (0)
    {
        float gi[8], gf[8];
#pragma unroll
        for (int u = 0; u < 8; ++u) { const int ta = (4 * w) * 128 + u * 64 + lane; const size_t tk = (size_t)b * SEQ + (dir ? SEQ - 1 - ta : ta);
            gi[u] = Gt[tk * 16 + (dir * 2) * 4 + h]; gf[u] = Gt[tk * 16 + (dir * 2 + 1) * 4 + h]; }
#pragma unroll
        for (int q = 0; q < 4; ++q) {
            const int c = 4 * w + q; float carry_b = 0.f, carry_m = -3.0e38f;
#pragma unroll
            for (int hf = 0; hf < 2; ++hf) {
                const int ta = c * 128 + hf * 64 + lane;
                const float ip = gi[2 * q + hf], fp = gf[2 * q + hf];
                float xs = logsigmoidf_(fp);
#pragma unroll
                for (int o = 1; o < 64; o <<= 1) { const float y = __shfl_up(xs, o); if (lane >= o) xs += y; }
                const float bj = xs + carry_b; const float cj = ip - bj; float pm = cj;
#pragma unroll
                for (int o = 1; o < 64; o <<= 1) { const float y = __shfl_up(pm, o); if (lane >= o) pm = fmaxf(pm, y); }
                pm = fmaxf(pm, carry_m);
                GS[ta] = bj; GS[SEQ + ta] = cj; GS[2 * SEQ + ta] = pm;
                carry_b = __shfl(bj, 63); carry_m = __shfl(pm, 63);
            }
            if (lane == 0) { c_bl[c] = carry_b; c_mx[c] = carry_m; }
        }
        __syncthreads();
        if (tid == 0) { float m = 0.f;
            for (int c = 0; c < 32; ++c) { const float bl = c_bl[c], mn = fmaxf(bl + m, bl + c_mx[c]); c_mp[c] = m; c_mn[c] = mn; c_kp[c] = __expf(bl + m - mn); m = mn; } }
        __syncthreads();
    }
    ML_PREFETCH(0);
    __syncthreads();
#define ML_BAR() do { asm volatile("s_waitcnt lgkmcnt(0)" ::: "memory"); __builtin_amdgcn_s_barrier(); asm volatile("" ::: "memory"); } while (0)
#pragma unroll 1
    for (int c = 0; c < 32; ++c) {
        const float m_prev = c_mp[c], m_new = c_mn[c], keep = c_kp[c], b_last = c_bl[c];
        if (tid < 128) {
            const float inter = bn + m_prev, mj = fmaxf(inter, bn + pmn);
            s_cs[tid] = csn; s_rj[tid] = bn - mj; s_iw[tid] = __expf(inter - mj); s_emj[tid] = __expf(-mj); s_w[tid] = __expf(b_last + csn - m_new);
        }
        ML_BAR();
#pragma unroll
        for (int i = 0; i < 8; ++i) *(LAS u32x4*)(lds + ML_KS + (krow + 16 * i) * ML_KP + pc * 16) = kreg[i];
        {
            *(LAS u32x4*)(lds + ML_VS + vrow * ML_VP + pv * 16) = vreg;
            float f[8]; unpack8(vreg, f); const float ws_ = s_w[vrow];
            u32x4 o; o.x = pk2(f[0] * ws_, f[1] * ws_); o.y = pk2(f[2] * ws_, f[3] * ws_); o.z = pk2(f[4] * ws_, f[5] * ws_); o.w = pk2(f[6] * ws_, f[7] * ws_);
            *(LAS u32x4*)(lds + ML_VW + vrow * ML_VP + pv * 16) = o;
        }
        bf16x8 qf[8];
#pragma unroll
        for (int kk = 0; kk < 8; ++kk) qf[kk] = __builtin_bit_cast(bf16x8, qn[kk]);
        unsigned short ogr[4][2];
#pragma unroll
        for (int i = 0; i < 4; ++i)
#pragma unroll
            for (int vt = 0; vt < 2; ++vt) ogr[i][vt] = R1B[ML_TOK(c, 16 * sw + 4 * g + i) * 2048 + 1024 + h * 256 + vs * 32 + 16 * vt + r];
        if (c < 31) ML_PREFETCH(c + 1);
        ML_BAR();
        {
            const float rjv = s_rj[16 * sw + r]; const int jloc = 16 * sw + r; float den1 = 0.f;
#pragma unroll 2
            for (int st = 0; st < 8; ++st) {
                if (st <= sw) {
                    f32x4 acc = {0.f, 0.f, 0.f, 0.f};
#pragma unroll
                    for (int kk = 0; kk < 8; ++kk) { const bf16x8 kf = *(const LAS bf16x8*)(lds + ML_KS + (16 * st + r) * ML_KP + (32 * kk + 8 * g) * 2); acc = __builtin_amdgcn_mfma_f32_16x16x32_bf16(kf, qf[kk], acc, 0, 0, 0); }
                    const f32x4 c4 = *(const LAS f32x4*)(s_cs + 16 * st + 4 * g);
                    float v[4];
#pragma unroll
                    for (int i = 0; i < 4; ++i) { const int s = 16 * st + 4 * g + i; const float d = (s <= jloc) ? __expf(rjv + c4[i]) : 0.f; v[i] = acc[i] * d; den1 += v[i]; }
                    u32x2 o; o.x = pk2(v[0], v[1]); o.y = pk2(v[2], v[3]);
                    *(LAS u32x2*)(lds + ML_SS + jloc * ML_SP + (16 * st + 4 * g) * 2) = o;
                } else if (st == sw + 1 && !(sw & 1)) {
                    u32x2 o = {0u, 0u}; *(LAS u32x2*)(lds + ML_SS + jloc * ML_SP + (16 * st + 4 * g) * 2) = o;
                }
            }
            den1 += __shfl_xor(den1, 16); den1 += __shfl_xor(den1, 32);
            f32x4 dacc = {0.f, 0.f, 0.f, 0.f};
#pragma unroll
            for (int kk = 0; kk < 8; ++kk) { const bf16x8 kf = *(const LAS bf16x8*)(lds + ML_KS + (128 + r) * ML_KP + (32 * kk + 8 * g) * 2); dacc = __builtin_amdgcn_mfma_f32_16x16x32_bf16(kf, qf[kk], dacc, 0, 0, 0); }
            const float d2 = dacc[0];
            if (g == 0) s_dn[jloc] = den1 + s_iw[jloc] * d2;
        }
        ML_BAR();
        {
            f32x4 n1[2], n2[2];
#pragma unroll
            for (int vt = 0; vt < 2; ++vt) { n1[vt] = (f32x4){0.f, 0.f, 0.f, 0.f}; n2[vt] = (f32x4){0.f, 0.f, 0.f, 0.f}; }
            const int nks = (sw >> 1) + 1;
#pragma unroll 1
            for (int ks = 0; ks < nks; ++ks) {
                const bf16x8 af = *(const LAS bf16x8*)(lds + ML_SS + (16 * sw + r) * ML_SP + (32 * ks + 8 * g) * 2);
                const unsigned a0 = lbase + ML_VS + (32 * ks + 8 * g + q4) * ML_VP + (4 * p4) * 2;
                bf16x8 b0, b1; tr_read2x2(a0, a0 + 32, 4 * ML_VP, b0, b1);
                n1[0] = __builtin_amdgcn_mfma_f32_16x16x32_bf16(af, b0, n1[0], 0, 0, 0); n1[1] = __builtin_amdgcn_mfma_f32_16x16x32_bf16(af, b1, n1[1], 0, 0, 0);
            }
#pragma unroll
            for (int kk = 0; kk < 8; ++kk)
#pragma unroll
                for (int vt = 0; vt < 2; ++vt) { const bf16x8 cf = *(const LAS bf16x8*)(lds + ML_CS + (16 * vt + r) * ML_CP + (32 * kk + 8 * g) * 2); n2[vt] = __builtin_amdgcn_mfma_f32_16x16x32_bf16(qf[kk], cf, n2[vt], 0, 0, 0); }
            const f32x4 iw4 = *(const LAS f32x4*)(s_iw + 16 * sw + 4 * g), dn4 = *(const LAS f32x4*)(s_dn + 16 * sw + 4 * g), em4 = *(const LAS f32x4*)(s_emj + 16 * sw + 4 * g);
#pragma unroll
            for (int i = 0; i < 4; ++i) {
                const size_t tok = ML_TOK(c, 16 * sw + 4 * g + i);
                const float inv = 1.0f / fmaxf(fabsf(dn4[i]), em4[i]);
#pragma unroll
                for (int vt = 0; vt < 2; ++vt) { const int col = h * 256 + vs * 32 + 16 * vt + r;
                    const float og = __uint_as_float(((unsigned)ogr[i][vt]) << 16);
                    const float hv = (n1[vt][i] + iw4[i] * n2[vt][i]) * inv * og;
                    Y[blk_off((int)tok, col, 1024)] = (bf16_t)f2bf(hv); }
            }
        }
        ML_BAR();
        {
#pragma unroll
            for (int a = 0; a < 3; ++a) { Cacc[a][0] *= keep; Cacc[a][1] *= keep; }
#pragma unroll 1
            for (int ks = 0; ks < 4; ++ks) {
                bf16x8 af[3], bq[2];
                { const unsigned av = lbase + ML_VW + (32 * ks + 8 * g + q4) * ML_VP + (4 * p4) * 2, ak = lbase + ML_KS + (32 * ks + 8 * g + q4) * ML_KP + (32 * w + 4 * p4) * 2;
                  tr_read4x2(av, av + 32, 4 * ML_VP, ak, ak + 32, 4 * ML_KP, af[0], af[1], bq[0], bq[1]); }
                { const f32x4 wa = *(const LAS f32x4*)(s_w + 32 * ks + 8 * g), wb = *(const LAS f32x4*)(s_w + 32 * ks + 8 * g + 4);
                  u32x4 o; o.x = pk2(wa[0], wa[1]); o.y = pk2(wa[2], wa[3]); o.z = pk2(wb[0], wb[1]); o.w = pk2(wb[2], wb[3]);
                  if (r != 0) { o.x = 0u; o.y = 0u; o.z = 0u; o.w = 0u; }
                  af[2] = __builtin_bit_cast(bf16x8, o); }
#pragma unroll
                for (int nt = 0; nt < 2; ++nt)
#pragma unroll
                    for (int mt = 0; mt < 3; ++mt) Cacc[mt][nt] = __builtin_amdgcn_mfma_f32_16x16x32_bf16(af[mt], bq[nt], Cacc[mt][nt], 0, 0, 0);
            }
#pragma unroll
            for (int mt = 0; mt < 2; ++mt)
#pragma unroll
                for (int nt = 0; nt < 2; ++nt)
#pragma unroll
                    for (int i = 0; i < 4; ++i) *(LAS bf16_t*)(lds + ML_CS + (16 * mt + 4 * g + i) * ML_CP + (32 * w + 16 * nt + r) * 2) = (bf16_t)f2bf(Cacc[mt][nt][i]);
            if (g == 0) { *(LAS bf16_t*)(lds + ML_KS + 128 * ML_KP + (32 * w + r) * 2) = (bf16_t)f2bf(Cacc[2][0][0]); *(LAS bf16_t*)(lds + ML_KS + 128 * ML_KP + (32 * w + 16 + r) * 2) = (bf16_t)f2bf(Cacc[2][1][0]); }
        }
        ML_BAR();
    }
#undef ML_BAR
#undef ML_PREFETCH
#undef ML_TOK
}
constexpr int HY_ZK = 0, HY_WB = 69632;
static_assert(HY_WB + 69632 <= LDS_BYTES, "hyena LDS map");
#define GAS __attribute__((address_space(1)))
struct HyRaw { u32x4 c; unsigned l, r; };
__device__ __forceinline__ HyRaw hy_load(const bf16_t* rowp, int tid) { HyRaw x; const GAS bf16_t* p = (const GAS bf16_t*)rowp + 8 * tid; x.c = *(const GAS u32x4*)p; x.l = p[-1]; x.r = p[8]; return x; }
__device__ __forceinline__ void hy_conv8(const HyRaw& x, int tid, float w0, float w1, float w2, float bias, float (&o)[8]) {
    float a[10];
    a[0] = tid > 0 ? __uint_as_float(x.l << 16) : 0.f; a[9] = tid < 511 ? __uint_as_float(x.r << 16) : 0.f;
    a[1] = bflo(x.c.x); a[2] = bfhi(x.c.x); a[3] = bflo(x.c.y); a[4] = bfhi(x.c.y); a[5] = bflo(x.c.z); a[6] = bfhi(x.c.z); a[7] = bflo(x.c.w); a[8] = bfhi(x.c.w);
#pragma unroll
    for (int m = 0; m < 8; ++m) o[m] = w0 * a[m] + w1 * a[m + 1] + w2 * a[m + 2] + bias;
}
__device__ __forceinline__ void hyena_item(const Ctx& C, LAS unsigned char* lds, int ch, int wv) {
    int tid = (wv << 6) | lane_id_opaque(); asm volatile("" : "+v"(tid));
    LAS f32x2* zk = (LAS f32x2*)(lds + HY_ZK); LAS f32x2* wb = (LAS f32x2*)(lds + HY_WB);
    const float* FILT = (const float*)(C.ws + WS_FILT); const bf16_t* HYb = (const bf16_t*)(C.ws + WS_HY); bf16_t* YA = (bf16_t*)(C.ws + WS_YA);
    const float* cw = C.in[3]; const float* cb = C.in[4];
    float w0[3], w1[3], w2[3], bs[3];
#pragma unroll
    for (int s = 0; s < 3; ++s) { w0[s] = cw[s * 1024 + ch]; w1[s] = cw[CONVC + s * 1024 + ch]; w2[s] = cw[2 * CONVC + s * 1024 + ch]; bs[s] = cb[s * 1024 + ch]; }
    const float hb0 = C.in[12][ch], hb1 = C.in[12][1024 + ch];
    const float* F0 = FILT + (size_t)(0 * 1024 + ch) * SEQ; const float* F1 = FILT + (size_t)(1 * 1024 + ch) * SEQ;
    const float* F2 = FILT + (size_t)(2 * 1024 + ch) * SEQ; const float* F3 = FILT + (size_t)(3 * 1024 + ch) * SEQ;
    __syncthreads();
    {
        float fa[16], fb[16];
#pragma unroll
        for (int rep = 0; rep < 8; ++rep) { const int i = tid + 512 * rep; fa[rep] = F0[i]; fb[rep] = F2[i]; }
#pragma unroll
        for (int rep = 8; rep < 16; ++rep) { const int i = tid + 512 * rep; const int j = i == SEQ ? 1 : 2 * SEQ - i; fa[rep] = F1[j]; fb[rep] = F3[j]; }
        if (tid == 0) { fa[8] = 0.f; fb[8] = 0.f; }
#pragma unroll
        for (int rep = 0; rep < 16; ++rep) { const int i = tid + 512 * rep; zk[PADI(i)] = (f32x2){fa[rep] * (1.0f / 8192.0f), fb[rep] * (1.0f / 8192.0f)}; }
    }
    fft_fwd_full(zk, tid);
    const bf16_t* rv = HYb + (size_t)ch * TOK; const bf16_t* rx1 = HYb + (size_t)(1024 + ch) * TOK; const bf16_t* rx2 = HYb + (size_t)(2048 + ch) * TOK;
    HyRaw qa = hy_load(rv, tid), qb = hy_load(rv + SEQ, tid);
#pragma unroll 1
    for (int p = 0; p < 2; ++p) {
        const int tb0 = (2 * p) * SEQ, tb1 = (2 * p + 1) * SEQ;
        f32x2 vv[8], zz[8];
        { float va[8], vb[8]; hy_conv8(qa, tid, w0[0], w1[0], w2[0], bs[0], va); hy_conv8(qb, tid, w0[0], w1[0], w2[0], bs[0], vb);
#pragma unroll
          for (int m = 0; m < 8; ++m) { vv[m].x = va[m]; vv[m].y = vb[m]; wb[PADI(8 * tid + m)] = vv[m]; } }
        qa = hy_load(rx1 + tb0, tid); qb = hy_load(rx1 + tb1, tid);
        fft_conv<0>(wb, zk, tid);
        { float xa[8], xb_[8]; hy_conv8(qa, tid, w0[1], w1[1], w2[1], bs[1], xa); hy_conv8(qb, tid, w0[1], w1[1], w2[1], bs[1], xb_);
#pragma unroll
          for (int m = 0; m < 8; ++m) { const f32x2 y = wb[PADI(8 * tid + m)]; zz[m].x = xa[m] * (y.x + vv[m].x * hb0); zz[m].y = xb_[m] * (y.y + vv[m].y * hb0); }
#pragma unroll
          for (int m = 0; m < 8; ++m) wb[PADI(8 * tid + m)] = zz[m]; }
        qa = hy_load(rx2 + tb0, tid); qb = hy_load(rx2 + tb1, tid);
        fft_conv<1>(wb, zk, tid);
        { float xa[8], xb_[8]; hy_conv8(qa, tid, w0[2], w1[2], w2[2], bs[2], xa); hy_conv8(qb, tid, w0[2], w1[2], w2[2], bs[2], xb_);
          if (p == 0) { qa = hy_load(rv + 2 * SEQ, tid); qb = hy_load(rv + 3 * SEQ, tid); }
#pragma unroll
          for (int m = 0; m < 8; ++m) { const int t = 8 * tid + m; const f32x2 y = wb[PADI(t)];
              YA[blk_off(tb0 + t, ch, 1024)] = (bf16_t)f2bf(xa[m] * (y.x + zz[m].x * hb1));
              YA[blk_off(tb1 + t, ch, 1024)] = (bf16_t)f2bf(xb_[m] * (y.y + zz[m].y * hb1)); } }
        FFT_SYNC();
    }
}
#ifndef DUP_FILT
#define DUP_FILT 0
#endif
#ifndef DUP_PRE
#define DUP_PRE 0
#endif
#ifndef DUP_P0
#define DUP_P0 0
#endif
#ifndef DUP_ML
#define DUP_ML 0
#endif
#ifndef DUP_HY
#define DUP_HY 0
#endif
#ifndef DUP_REST
#define DUP_REST 0
#endif
#ifndef DUP_GU
#define DUP_GU 0
#endif
#define XB_TMO      128
#define XB_XCNT(j)  (256  + 64 * (j))
#define XB_XSUB(j)  (1280 + 64 * (j))
#define XB_XGEN(j)  (2304 + 64 * (j))
#define XB_TOP      3328
#define XB_TOPGEN   3392
#define XCD_BAR_WORDS 3456
#define XB_SPIN_CAP (1u << 22)
__device__ __forceinline__ unsigned xb_ld(unsigned* p)              { return __hip_atomic_load(p, __ATOMIC_RELAXED, __HIP_MEMORY_SCOPE_AGENT); }
__device__ __forceinline__ unsigned xb_add(unsigned* p, unsigned v) { return __hip_atomic_fetch_add(p, v, __ATOMIC_RELAXED, __HIP_MEMORY_SCOPE_AGENT); }
__device__ __forceinline__ unsigned xb_xcc_id() { return (unsigned)__builtin_amdgcn_s_getreg((3 << 11) | 20) & 0xFu; }
#define XB_SPIN(cond, bar) do { unsigned _sp = 0; while (cond) { __builtin_amdgcn_s_sleep(1); \
    if ((++_sp & 255u) == 0u) { if (xb_ld(&(bar)[XB_TMO])) break; if (_sp > XB_SPIN_CAP) { atomicAdd(&(bar)[XB_TMO], 1u); break; } } } } while (0)
__device__ __forceinline__ void xcd_barrier_complete(unsigned* bar, unsigned x, unsigned G, unsigned& nloc, unsigned& nx) {
    unsigned sum, cnt, mine, sp = 0u;
    for (;;) {
        sum = 0u; cnt = 0u; mine = 0u;
#pragma unroll
        for (unsigned j = 0; j < 16; ++j) { const unsigned c = xb_ld(&bar[XB_XCNT(j)]); sum += c; cnt += (c > 0u) ? 1u : 0u; mine = (j == x) ? c : mine; }
        if (sum == G) break;
        __builtin_amdgcn_s_sleep(1);
        if ((++sp & 255u) == 0u) { if (xb_ld(&bar[XB_TMO])) break; if (sp > XB_SPIN_CAP) { atomicAdd(&bar[XB_TMO], 1u); break; } }
    }
    nloc = mine > 0u ? mine : 1u; nx = cnt > 0u ? cnt : 1u;
}
__device__ __forceinline__ void grid_bar(unsigned* bar, volatile LAS unsigned* st, unsigned G, int wv) {
    asm volatile("s_waitcnt vmcnt(0)" ::: "memory");
    __syncthreads();
    const int lane = lane_id_opaque();
    if (wv == 0 && lane == 0) {
        __builtin_amdgcn_s_waitcnt(0);
        const unsigned x = xb_xcc_id();
        unsigned nloc = st[0], nx = st[1];
        if (nloc == 0u) { xcd_barrier_complete(bar, x, G, nloc, nx); st[0] = nloc; st[1] = nx; }
        const unsigned old = xb_add(&bar[XB_XSUB(x)], 1u);
        const unsigned gen = old / nloc;
        if (old + 1u == (gen + 1u) * nloc) {
            __builtin_amdgcn_fence(__ATOMIC_RELEASE, "agent");
            asm volatile("s_waitcnt vmcnt(0)" ::: "memory");
            const unsigned og = xb_add(&bar[XB_TOP], 1u);
            const unsigned tg = og / nx;
            if (og + 1u == (tg + 1u) * nx) xb_add(&bar[XB_TOPGEN], 1u);
            else XB_SPIN(xb_ld(&bar[XB_TOPGEN]) == tg, bar);
            __builtin_amdgcn_fence(__ATOMIC_ACQUIRE, "agent");
            xb_add(&bar[XB_XGEN(x)], 1u);
            asm volatile("s_waitcnt vmcnt(0)" ::: "memory");
        } else {
            XB_SPIN(xb_ld(&bar[XB_XGEN(x)]) == gen, bar);
            __builtin_amdgcn_fence(__ATOMIC_ACQUIRE, "agent");
            asm volatile("s_waitcnt vmcnt(0)" ::: "memory");
        }
    }
    __syncthreads();
}
__device__ __forceinline__ void p6_finalize(const Ctx& C, int G, int bx, int wv) {
    int tid = (wv << 6) | lane_id_opaque(); asm volatile("" : "+v"(tid));
    unsigned* pcnt = (unsigned*)(C.ws + WS_PCNT); const float* ss3 = (const float*)(C.ws + WS_SS3); const float* wf = C.in[20]; float* out = C.out;
    asm volatile("s_waitcnt vmcnt(0)" ::: "memory");
    __syncthreads();
    if (tid == 0) {
        __builtin_amdgcn_fence(__ATOMIC_RELEASE, "agent"); asm volatile("s_waitcnt vmcnt(0)" ::: "memory");
        for (int i = 0; ; ++i) { const int L = i * G + bx; if (L >= 64 * 8) break; int pm, pn; pg8::tile_of(L, 64, 8, pm, pn); xb_add(&pcnt[64 * pm], 1u); }
    }
    for (int i = 0; ; ++i) {
        const int L = i * G + bx; if (L >= 64 * 8) break; int pm, pn; pg8::tile_of(L, 64, 8, pm, pn);
        if (tid == 0) { unsigned sp = 0; while (xb_ld(&pcnt[64 * pm]) < 8u) { __builtin_amdgcn_s_sleep(1); if (++sp > (1u << 20)) break; }
            __builtin_amdgcn_fence(__ATOMIC_ACQUIRE, "agent"); asm volatile("s_waitcnt vmcnt(0)" ::: "memory"); }
        __syncthreads();
        const int c4 = tid & 63; const f32x4 wv4 = *(const f32x4*)(wf + 256 * pn + 4 * c4);
#pragma unroll 1
        for (int k0 = 0; k0 < 32; k0 += 8) {
            f32x4 v[8]; float rr[8];
#pragma unroll
            for (int k = 0; k < 8; ++k) { const int row = 256 * pm + (tid >> 6) + 8 * (k0 + k);
                v[k] = *(const f32x4*)(out + (size_t)row * DM + 256 * pn + 4 * c4);
                rr[k] = __hip_atomic_load(ss3 + row, __ATOMIC_RELAXED, __HIP_MEMORY_SCOPE_AGENT); }
#pragma unroll
            for (int k = 0; k < 8; ++k) { const int row = 256 * pm + (tid >> 6) + 8 * (k0 + k); const float r = 1.0f / sqrtf(rr[k] * (1.0f / DM) + RMS_EPS);
                *(f32x4*)(out + (size_t)row * DM + 256 * pn + 4 * c4) = v[k] * r * wv4; }
        }
    }
}
struct Params { const float* in[21]; float* out; unsigned char* ws; };
__global__ void __launch_bounds__(512, 2) fwd_megakernel(Params prm) {
    extern __shared__ __attribute__((aligned(16))) unsigned char lds_raw[];
    LAS unsigned char* lds = (LAS unsigned char*)lds_raw;
    cg::grid_group grid = cg::this_grid();
    const int G = gridDim.x, bx = blockIdx.x;
    const int wv = __builtin_amdgcn_readfirstlane((int)(threadIdx.x >> 6));
    Ctx C;
#pragma unroll
    for (int i = 0; i < 21; ++i) C.in[i] = prm.in[i];
    C.out = prm.out; C.ws = prm.ws;
    unsigned char* ws = prm.ws;
    unsigned* gbar = (unsigned*)(ws + WS_BAR);
    volatile LAS unsigned* bst = (volatile LAS unsigned*)(lds + LDS_BYTES - 16);
#ifndef DUP_BAR
#define DUP_BAR 0
#endif
#define GBAR() do { for (int rb_ = 0; rb_ < 1 + DUP_BAR; ++rb_) grid_bar(gbar, bst, (unsigned)G, wv); } while (0)
    if (bx == 0) for (int i = threadIdx.x; i < XCD_BAR_WORDS; i += 512) gbar[i] = 0u;
    if (bx == 1 || G == 1) for (int i = threadIdx.x; i < 64 * 64; i += 512) ((unsigned*)(ws + WS_PCNT))[i] = 0u;
    if (threadIdx.x < 4) ((LAS unsigned*)(lds + LDS_BYTES - 16))[threadIdx.x] = 0u;
    grid.sync();
    if (threadIdx.x == 0) (void)xb_add(&gbar[XB_XCNT(xb_xcc_id())], 1u);
    for (int rep = 0; rep < 1 + DUP_P0; ++rep) { p0_prologue(C, lds, G, wv); __syncthreads(); }
    GBAR();
    for (int rep = 0; rep < 1 + DUP_FILT; ++rep) p1_filters(C, lds, G, wv);
    { HyProg P; P.K = DM; P.G = G; P.c = bx; P.W = (const bf16_t*)(ws + WS_WIN); P.X = (const bf16_t*)(ws + WS_XB); P.HY = (bf16_t*)(ws + WS_HY); P.r1 = (const float*)(ws + WS_R1S);
      pg8::gemm_stream(lds, P, wv); }
    for (int rep = 0; rep < 1 + DUP_REST; ++rep) { RestProg P; P.K = DM; P.G = G; P.c = bx; P.W = (const bf16_t*)(ws + WS_WIN); P.X = (const bf16_t*)(ws + WS_XB); P.R1A = (bf16_t*)(ws + WS_R1A); P.R1B = (bf16_t*)(ws + WS_R1B); P.R2 = (bf16_t*)prm.out; P.r1 = (const float*)(ws + WS_R1S);
      pg8::gemm_stream(lds, P, wv); }
    GBAR();
    for (int rep = 0; rep < 1 + DUP_PRE; ++rep) qk_prepass(C, G, wv);
    for (int rep = 0; rep < 1 + DUP_HY; ++rep) for (int idx = bx; idx < 1024; idx += G) { const int rd = idx >> 8, bb = idx & 255; hyena_item(C, lds, rd * 256 + (bb & 7) * 32 + (bb >> 3), wv); }
    GBAR();
    for (int rep = 0; rep < 1 + DUP_ML; ++rep) for (int item = bx; item < 256; item += G) mlstm_item(C, lds, item, wv);
    GBAR();
    { BranchProg P; P.K = 1024; P.G = G; P.c = bx; P.YA = (const bf16_t*)(ws + WS_YA); P.YBF = (const bf16_t*)(ws + WS_YBF); P.YBB = (const bf16_t*)(ws + WS_YBB);
      P.WA = (const bf16_t*)(ws + WS_WA); P.WB = (const bf16_t*)(ws + WS_WB); P.R2 = (const bf16_t*)prm.out; P.MIX = (bf16_t*)(ws + WS_MIX);
      pg8::gemm_stream(lds, P, wv); }
    GBAR();
    { ResProg P; P.K = DM; P.G = G; P.c = bx; P.A = (const bf16_t*)(ws + WS_MIX); P.B = (const bf16_t*)(ws + WS_WOUT); P.base = prm.in[0]; P.out = prm.out; P.outb = (bf16_t*)(ws + WS_X1B); P.ss = (float*)(ws + WS_SS2);
      pg8::gemm_stream(lds, P, wv); }
    GBAR();
    for (int rep = 0; rep < 1 + DUP_GU; ++rep) { GuProg P; P.K = DM; P.G = G; P.c = bx; P.X = (const bf16_t*)(ws + WS_X1B); P.W = (const bf16_t*)(ws + WS_WGU); P.HH = (bf16_t*)(ws + WS_HH); P.ss2 = (const float*)(ws + WS_SS2);
      pg8::gemm_stream(lds, P, wv); }
    GBAR();
    { ResProg P; P.K = FFH; P.G = G; P.c = bx; P.A = (const bf16_t*)(ws + WS_HH); P.B = (const bf16_t*)(ws + WS_WD); P.base = prm.out; P.out = prm.out; P.outb = nullptr; P.ss = (float*)(ws + WS_SS3);
      pg8::gemm_stream(lds, P, wv); }
    p6_finalize(C, G, bx, wv);
}

extern "C" void kernel_launch(void* const* d_in, const int* in_sizes, int n_in, void* d_out, int out_size, void* d_ws, size_t ws_size, hipStream_t stream) {
    static int grid = 0;
    if (grid == 0) {
        int dev = 0, cus = 0, per_cu = 0;
        hipGetDevice(&dev); hipDeviceGetAttribute(&cus, hipDeviceAttributeMultiprocessorCount, dev);
        if (hipFuncSetAttribute((const void*)fwd_megakernel, hipFuncAttributeMaxDynamicSharedMemorySize, LDS_BYTES) != hipSuccess) { fprintf(stderr, "kernel_launch: hipFuncSetAttribute failed\n"); grid = -1; return; }
        if (hipOccupancyMaxActiveBlocksPerMultiprocessor(&per_cu, (const void*)fwd_megakernel, 512, LDS_BYTES) != hipSuccess || per_cu < 1) { fprintf(stderr, "kernel_launch: occupancy query gave %d\n", per_cu); per_cu = 1; }
        (void)hipGetLastError();
        grid = cus * 1;
        if (n_in != 21 || ws_size < WS_END) { fprintf(stderr, "kernel_launch: unexpected n_in %d or ws %zu\n", n_in, ws_size); grid = -1; return; }
    }
    if (grid < 0) return;
    Params p{};
    for (int i = 0; i < 21; ++i) p.in[i] = (const float*)d_in[i];
    p.out = (float*)d_out; p.ws = (unsigned char*)d_ws;
    void* args[] = {&p};
    hipError_t e = hipLaunchCooperativeKernel((const void*)fwd_megakernel, dim3(grid), dim3(512), args, LDS_BYTES, stream);
    if (e != hipSuccess) fprintf(stderr, "cooperative launch failed: %s (grid %d)\n", hipGetErrorString(e), grid);
}
```

```cpp
#include <hip/hip_runtime.h>
#include <hip/hip_cooperative_groups.h>
#include <cstdio>
namespace cg = cooperative_groups;

#define LAS __attribute__((address_space(3)))
typedef unsigned short bf16_t;
typedef short bf16x8 __attribute__((ext_vector_type(8)));
typedef short bf16x4 __attribute__((ext_vector_type(4)));
typedef float f32x4 __attribute__((ext_vector_type(4)));
typedef float f32x2 __attribute__((ext_vector_type(2)));
typedef unsigned u32x4 __attribute__((ext_vector_type(4)));
typedef unsigned u32x2 __attribute__((ext_vector_type(2)));

constexpr int NB = 4, SEQ = 4096, TOK = NB * SEQ, DM = 2048, HW = 1024, MW = 1024, NHEAD = 4, DH = 256, FFH = 5632;
constexpr int CONVC = 5120, INCOLS = 11280, NFILT = 4096;
constexpr float RMS_EPS = 1e-6f;
constexpr size_t MiB = 1u << 20;
constexpr size_t WS_PCNT = 393216, WS_BAR = 262144, WS_R1S = 0, WS_SS2 = 65536, WS_SS3 = 131072, WS_G = 1 * MiB, WS_H2 = 2 * MiB;
constexpr size_t WS_WA = 4 * MiB, WS_WB = 8 * MiB, WS_WOUT = 12 * MiB, WS_WGU = 20 * MiB, WS_WD = 64 * MiB, WS_WIN = 86 * MiB, WS_XB = 130 * MiB;
constexpr size_t WS_FILT = 194 * MiB, WS_HY = 258 * MiB, WS_R1A = 354 * MiB, WS_R1B = 418 * MiB, WS_END = 494 * MiB;
constexpr size_t WS_QKP = 86 * MiB, WS_YA = 150 * MiB, WS_YBF = 354 * MiB, WS_YBB = 386 * MiB, WS_X1B = 86 * MiB, WS_MIX = 194 * MiB, WS_HH = 258 * MiB;
constexpr size_t WS_GSC = 482 * MiB;
constexpr int LDS_BYTES = 155648;

__device__ __forceinline__ unsigned f2bf(float f) { unsigned u = __float_as_uint(f); return (u + 0x7fffu + ((u >> 16) & 1u)) >> 16; }
__device__ __forceinline__ unsigned pk2(float lo, float hi) { unsigned r; asm volatile("v_cvt_pk_bf16_f32 %0, %1, %2" : "=v"(r) : "v"(lo), "v"(hi)); return r; }
__device__ __forceinline__ float bflo(unsigned w) { return __uint_as_float(w << 16); }
__device__ __forceinline__ float bfhi(unsigned w) { return __uint_as_float(w & 0xffff0000u); }
__device__ __forceinline__ float wave_sum(float v) {
#pragma unroll
    for (int o = 1; o < 64; o <<= 1) v += __shfl_xor(v, o);
    return v;
}
__device__ __forceinline__ size_t blk_off(int row, int k, int K) { return ((size_t)(row >> 7) * (size_t)(K >> 6) + (size_t)(k >> 6)) * 8192 + (size_t)((row & 127) * 64 + (k & 63)); }
__device__ __forceinline__ int lane_id_opaque() { int l; asm volatile("v_mbcnt_lo_u32_b32 %0, -1, 0\n\tv_mbcnt_hi_u32_b32 %0, -1, %0" : "=v"(l)); return l; }
__device__ __forceinline__ float sigmoidf_(float x) { return 1.0f / (1.0f + __expf(-x)); }
__device__ __forceinline__ float siluf_(float x) { return x / (1.0f + __expf(-x)); }

namespace pg8 {
constexpr int BM = 256, BK = 64, HALF = 128, HTB = HALF * BK * 2, STAGE_BYTES = 8 * HTB, NXCD = 8, WGM = 8;
__device__ __forceinline__ int lds_byte(int r, int c) { const int st = (r >> 4) * 2 + (c >> 5), rr = r & 15, cc = c & 31, ob = rr * 64 + cc * 2; return st * 1024 + (ob ^ (((ob >> 9) & 1) << 5)); }
__device__ __forceinline__ void stage_rc(int b, int& R, int& C) { const int st = b / 1024, sb = b % 1024, swz = sb ^ (((sb >> 9) & 1) << 5); R = (st >> 1) * 16 + swz / 64; C = (st & 1) * 32 + (swz % 64) / 2; }
__device__ __forceinline__ int perm32(int rho) { const int n = rho >> 4, i = rho & 15; return 8 * (i >> 2) + 4 * n + (i & 3); }
struct GUnit { const char* A; const char* B; int pm, pn, sub; };
__device__ __forceinline__ void tile_of(int L, int nM, int nN, int& pm, int& pn) {
    const int nwg = nM * nN; int wgid = L; { const int q = nwg / NXCD, r = nwg % NXCD, xcd = wgid % NXCD, off = wgid / NXCD; wgid = (xcd < r ? xcd * (q + 1) : r * (q + 1) + (xcd - r) * q) + off; }
    const int nig = WGM * nN, gid = wgid / nig, fm = gid * WGM, gsz = (nM - fm) < WGM ? (nM - fm) : WGM;
    pm = fm + ((wgid % nig) % gsz); pn = (wgid % nig) / gsz;
}
typedef f32x4 Acc[2][2][4][2];
template <class Prog>
__device__ __forceinline__ void gemm_stream(LAS unsigned char* lds, const Prog& P, int wv) {
    int tid = (wv << 6) | lane_id_opaque(); asm volatile("" : "+v"(tid));
    const int wid = __builtin_amdgcn_readfirstlane(tid >> 6), lane = tid & 63, wr = wid >> 2, wc = wid & 3, fr = lane & 15, fq = lane >> 4;
    const int K = P.K, nt = K / BK;
    unsigned voffA[2], voffB[2];
#pragma unroll
    for (int i = 0; i < 2; ++i) { int R, C; stage_rc(tid * 16 + i * 8192, R, C); const int Rb = Prog::PERM ? ((R & ~31) + perm32(R & 31)) : R;
        voffA[i] = (unsigned)(R * 64 + C) * 2u; voffB[i] = (unsigned)(Rb * 64 + C) * 2u; }
    const size_t kstep = (size_t)(HALF * BK * 2);
    const size_t hstep = (size_t)HALF * K * 2;
    const unsigned ldsw = (unsigned)wid * 1024u;
    const int aoff = lds_byte(wr * 64 + fr, fq * 8), boff = lds_byte(wc * 32 + fr, fq * 8);
#define PG8_SA(b, h) (((b) * 2 + (h)) * HTB)
#define PG8_SB(b, h) ((4 + (b) * 2 + (h)) * HTB)
#define PG8_STAGE(bufoff, gbase, voff) do { _Pragma("unroll") for (int _i = 0; _i < 2; ++_i) \
        __builtin_amdgcn_global_load_lds((const unsigned*)((const char*)(gbase) + (voff)[_i]), (LAS unsigned*)(lds + (bufoff) + ldsw + _i * 8192), 16, 0, 0); } while (0)
#define PG8_LDA(dst, b, h) do { _Pragma("unroll") for (int m = 0; m < 4; ++m) _Pragma("unroll") for (int k = 0; k < 2; ++k) dst[m][k] = *(const LAS bf16x8*)(lds + PG8_SA(b, h) + aoff + m * 2048 + k * 1024); } while (0)
#define PG8_LDB(dst, b, h) do { _Pragma("unroll") for (int n = 0; n < 2; ++n) _Pragma("unroll") for (int k = 0; k < 2; ++k) dst[n][k] = *(const LAS bf16x8*)(lds + PG8_SB(b, h) + boff + n * 2048 + k * 1024); } while (0)
#define PG8_MMA(ai, bj, At, Bt) do { __builtin_amdgcn_s_setprio(1); _Pragma("unroll") for (int m = 0; m < 4; ++m) _Pragma("unroll") for (int n = 0; n < 2; ++n) _Pragma("unroll") for (int k = 0; k < 2; ++k) \
        acc[ai][bj][m][n] = __builtin_amdgcn_mfma_f32_16x16x32_bf16(Bt[n][k], At[m][k], acc[ai][bj][m][n], 0, 0, 0); __builtin_amdgcn_s_setprio(0); } while (0)
#define PG8_WAIT_V(n) asm volatile("s_waitcnt vmcnt(" #n ")" ::: "memory")
#define PG8_WAIT_L(n) asm volatile("s_waitcnt lgkmcnt(" #n ")" ::: "memory")
#define PG8_BAR __builtin_amdgcn_s_barrier()
#define PG8_SCHED __builtin_amdgcn_sched_barrier(0)
    GUnit cur, nxt; int ui = 0;
    if (!P.next(0, cur)) return;
    f32x4 acc[2][2][4][2];
#pragma unroll
    for (int a = 0; a < 2; ++a)
#pragma unroll
        for (int b = 0; b < 2; ++b)
#pragma unroll
            for (int m = 0; m < 4; ++m)
#pragma unroll
                for (int n = 0; n < 2; ++n) acc[a][b][m][n] = (f32x4){0.f, 0.f, 0.f, 0.f};
    bf16x8 At[4][2], B0[2][2], B1[2][2];
    const char* cA = cur.A; const char* cB = cur.B;
    PG8_STAGE(PG8_SB(0, 0), cB, voffB); PG8_STAGE(PG8_SA(0, 0), cA, voffA); PG8_STAGE(PG8_SB(0, 1), cB + hstep, voffB); PG8_STAGE(PG8_SA(0, 1), cA + hstep, voffA);
    if (wr == 1) PG8_BAR;
    PG8_WAIT_V(4); PG8_BAR;
    PG8_STAGE(PG8_SB(1, 0), cB + kstep, voffB); PG8_STAGE(PG8_SA(1, 0), cA + kstep, voffA); PG8_STAGE(PG8_SB(1, 1), cB + hstep + kstep, voffB);
    PG8_WAIT_V(6); PG8_BAR;
    for (;;) {
        const bool has_next = P.next(ui + 1, nxt);
        const char* nA = has_next ? nxt.A : cA; const char* nB = has_next ? nxt.B : cB;
        for (int t = 0; t < nt; t += 2) {
            const bool last = (t == nt - 2);
            const char* a1 = cA + (size_t)(t + 1) * kstep;
            const char* a2 = last ? nA : cA + (size_t)(t + 2) * kstep; const char* b2 = last ? nB : cB + (size_t)(t + 2) * kstep;
            const char* a3 = a2 + kstep; const char* b3 = b2 + kstep;
            PG8_LDB(B0, 0, 0); PG8_SCHED; PG8_LDA(At, 0, 0); PG8_STAGE(PG8_SA(1, 1), a1 + hstep, voffA);
            PG8_WAIT_L(8); PG8_BAR; PG8_WAIT_L(0); PG8_MMA(0, 0, At, B0); PG8_BAR; PG8_SCHED;
            PG8_LDB(B1, 0, 1); PG8_STAGE(PG8_SB(0, 0), b2, voffB);
            PG8_BAR; PG8_WAIT_L(0); PG8_MMA(0, 1, At, B1); PG8_BAR;
            PG8_LDA(At, 0, 1); PG8_STAGE(PG8_SA(0, 0), a2, voffA);
            PG8_BAR; PG8_WAIT_L(0); PG8_MMA(1, 0, At, B0); PG8_BAR; PG8_SCHED;
            PG8_STAGE(PG8_SB(0, 1), b2 + hstep, voffB);
            PG8_WAIT_V(6); PG8_BAR; PG8_MMA(1, 1, At, B1); PG8_BAR;
            PG8_LDB(B0, 1, 0); PG8_SCHED; PG8_LDA(At, 1, 0); PG8_STAGE(PG8_SA(0, 1), a2 + hstep, voffA);
            PG8_WAIT_L(8); PG8_BAR; PG8_WAIT_L(0); PG8_MMA(0, 0, At, B0); PG8_BAR; PG8_SCHED;
            PG8_LDB(B1, 1, 1); PG8_STAGE(PG8_SB(1, 0), b3, voffB);
            PG8_BAR; PG8_WAIT_L(0); PG8_MMA(0, 1, At, B1); PG8_BAR;
            PG8_LDA(At, 1, 1); PG8_STAGE(PG8_SA(1, 0), a3, voffA);
            PG8_BAR; PG8_WAIT_L(0); PG8_MMA(1, 0, At, B0); PG8_BAR; PG8_SCHED;
            PG8_STAGE(PG8_SB(1, 1), b3 + hstep, voffB);
            PG8_WAIT_V(6); PG8_BAR; PG8_MMA(1, 1, At, B1); PG8_BAR;
        }
        P.epi(acc, cur, wr, wc, fr, fq);
        if (!has_next) break;
        cur = nxt; cA = nA; cB = nB; ++ui;
    }
    PG8_WAIT_V(0);
    if (wr == 0) PG8_BAR;
    PG8_BAR;
#undef PG8_SA
#undef PG8_SB
#undef PG8_STAGE
#undef PG8_LDA
#undef PG8_LDB
#undef PG8_MMA
#undef PG8_WAIT_V
#undef PG8_WAIT_L
#undef PG8_BAR
#undef PG8_SCHED
}
__device__ __forceinline__ void zero_acc(Acc& acc) {
#pragma unroll
    for (int a = 0; a < 2; ++a)
#pragma unroll
        for (int b = 0; b < 2; ++b)
#pragma unroll
            for (int m = 0; m < 4; ++m)
#pragma unroll
                for (int n = 0; n < 2; ++n) acc[a][b][m][n] = (f32x4){0.f, 0.f, 0.f, 0.f};
}
}
using pg8::GUnit; using pg8::Acc;
__device__ __forceinline__ void unpack8(u32x4 w, float (&f)[8]) { f[0] = bflo(w.x); f[1] = bfhi(w.x); f[2] = bflo(w.y); f[3] = bfhi(w.y); f[4] = bflo(w.z); f[5] = bfhi(w.z); f[6] = bflo(w.w); f[7] = bfhi(w.w); }
struct HyProg {
    static constexpr bool PERM = true; int K, G, c; const bf16_t* W; const bf16_t* X; bf16_t* HY; const float* r1;
    __device__ __forceinline__ bool next(int i, GUnit& u) const { const int L = i * G + c; if (L >= 12 * 64) return false; pg8::tile_of(L, 12, 64, u.pm, u.pn);
        u.A = (const char*)(W + (size_t)u.pm * 256 * DM); u.B = (const char*)(X + (size_t)u.pn * 256 * DM); u.sub = 0; return true; }
    __device__ __forceinline__ void epi(Acc& acc, const GUnit& u, int wr, int wc, int fr, int fq) const {
        const int row0 = u.pm * 256 + wr * 64 + fr, col0 = u.pn * 256 + wc * 32 + 8 * fq;
        f32x4 sc[2][2];
#pragma unroll
        for (int bj = 0; bj < 2; ++bj) { sc[bj][0] = *(const f32x4*)(r1 + col0 + bj * 128); sc[bj][1] = *(const f32x4*)(r1 + col0 + bj * 128 + 4); }
#pragma unroll
        for (int ai = 0; ai < 2; ++ai)
#pragma unroll
            for (int m = 0; m < 4; ++m) { bf16_t* rowp = HY + (size_t)(row0 + ai * 128 + m * 16) * TOK + col0;
#pragma unroll
                for (int bj = 0; bj < 2; ++bj) { const f32x4 v0 = acc[ai][bj][m][0] * sc[bj][0], v1 = acc[ai][bj][m][1] * sc[bj][1];
                    u32x4 w; w.x = pk2(v0[0], v0[1]); w.y = pk2(v0[2], v0[3]); w.z = pk2(v1[0], v1[1]); w.w = pk2(v1[2], v1[3]);
                    *(u32x4*)(rowp + bj * 128) = w; } }
        pg8::zero_acc(acc);
    }
};
struct RestProg {
    static constexpr bool PERM = true; int K, G, c; const bf16_t* W; const bf16_t* X; bf16_t* R1A; bf16_t* R1B; bf16_t* R2; const float* r1;
    __device__ __forceinline__ bool next(int i, GUnit& u) const { const int L = i * G + c; if (L >= 64 * 32) return false; pg8::tile_of(L, 64, 32, u.pm, u.pn);
        u.A = (const char*)(X + (size_t)u.pm * 256 * DM); u.B = (const char*)(W + (size_t)(3072 + u.pn * 256) * DM); u.sub = 0; return true; }
    __device__ __forceinline__ void epi(Acc& acc, const GUnit& u, int wr, int wc, int fr, int fq) const {
        const int row0 = u.pm * 256 + wr * 64 + fr; const bool sg = u.pn >= 12;
        bf16_t* base = u.pn < 8 ? R1A + u.pn * 256 : (u.pn < 16 ? R1B + (u.pn - 8) * 256 : R2 + (u.pn - 16) * 256);
        const int pitch = u.pn < 16 ? 2048 : 4096;
        const int col0 = wc * 32 + 8 * fq;
        float rs[2][4];
#pragma unroll
        for (int ai = 0; ai < 2; ++ai)
#pragma unroll
            for (int m = 0; m < 4; ++m) rs[ai][m] = r1[row0 + ai * 128 + m * 16];
#pragma unroll
        for (int ai = 0; ai < 2; ++ai)
#pragma unroll
            for (int m = 0; m < 4; ++m) { const int row = row0 + ai * 128 + m * 16; const float s = rs[ai][m]; bf16_t* rowp = base + (size_t)row * pitch + col0;
#pragma unroll
                for (int bj = 0; bj < 2; ++bj) { f32x4 v0 = acc[ai][bj][m][0] * s, v1 = acc[ai][bj][m][1] * s;
                    if (sg) {
#pragma unroll
                        for (int j = 0; j < 4; ++j) { v0[j] = sigmoidf_(v0[j]); v1[j] = sigmoidf_(v1[j]); } }
                    u32x4 w; w.x = pk2(v0[0], v0[1]); w.y = pk2(v0[2], v0[3]); w.z = pk2(v1[0], v1[1]); w.w = pk2(v1[2], v1[3]);
                    *(u32x4*)(rowp + bj * 128) = w; } }
        pg8::zero_acc(acc);
    }
};
struct BranchProg {
    static constexpr bool PERM = true; int K, G, c; const bf16_t *YA, *YBF, *YBB, *WA, *WB; const bf16_t* R2; bf16_t* MIX;
    __device__ __forceinline__ bool next(int i, GUnit& u) const { const int ti = i / 3, sub = i - 3 * ti; const int L = ti * G + c; if (L >= 64 * 8) return false; pg8::tile_of(L, 64, 8, u.pm, u.pn);
        const bf16_t* a = sub == 0 ? YA : (sub == 1 ? YBF : YBB); const bf16_t* b = sub == 0 ? WA : WB;
        u.A = (const char*)(a + (size_t)u.pm * 256 * 1024); u.B = (const char*)(b + (size_t)u.pn * 256 * 1024); u.sub = sub; return true; }
    __device__ __forceinline__ void epi(Acc& acc, const GUnit& u, int wr, int wc, int fr, int fq) const {
        if (u.sub == 1) return;
        const int row0 = u.pm * 256 + wr * 64 + fr, col0 = u.pn * 256 + wc * 32 + 8 * fq;
#pragma unroll
        for (int ai = 0; ai < 2; ++ai) {
            u32x4 gbw[4][2], gaw[4][2];
#pragma unroll
            for (int m = 0; m < 4; ++m)
#pragma unroll
                for (int bj = 0; bj < 2; ++bj) { const bf16_t* gp = R2 + (size_t)(row0 + ai * 128 + m * 16) * 4096 + col0 + bj * 128;
                    gbw[m][bj] = *(const u32x4*)(gp + 2048); if (u.sub == 0) gaw[m][bj] = *(const u32x4*)gp; else gaw[m][bj] = gbw[m][bj]; }
#pragma unroll
            for (int m = 0; m < 4; ++m) { const int row = row0 + ai * 128 + m * 16;
#pragma unroll
                for (int bj = 0; bj < 2; ++bj) {
                    float gb[8], ga[8]; unpack8(gbw[m][bj], gb); unpack8(gaw[m][bj], ga);
                    if (u.sub == 0) {
#pragma unroll
                        for (int j = 0; j < 4; ++j) { acc[ai][bj][m][0][j] *= ga[j] / fmaxf(gb[j], 1e-30f); acc[ai][bj][m][1][j] *= ga[4 + j] / fmaxf(gb[4 + j], 1e-30f); }
                    } else {
                        f32x4 v0 = acc[ai][bj][m][0], v1 = acc[ai][bj][m][1];
#pragma unroll
                        for (int j = 0; j < 4; ++j) { v0[j] *= fmaxf(gb[j], 1e-30f); v1[j] *= fmaxf(gb[4 + j], 1e-30f); }
                        u32x4 w; w.x = pk2(v0[0], v0[1]); w.y = pk2(v0[2], v0[3]); w.z = pk2(v1[0], v1[1]); w.w = pk2(v1[2], v1[3]);
                        *(u32x4*)(MIX + blk_off(row, col0 + bj * 128, DM)) = w;
                    } } }
        }
        if (u.sub == 2) pg8::zero_acc(acc);
    }
};
struct ResProg {
    static constexpr bool PERM = false; int K, G, c; const bf16_t* A; const bf16_t* B; const float* base; float* out; bf16_t* outb; float* ss;
    __device__ __forceinline__ bool next(int i, GUnit& u) const { const int L = i * G + c; if (L >= 64 * 8) return false; pg8::tile_of(L, 64, 8, u.pm, u.pn);
        u.A = (const char*)(A + (size_t)u.pm * 256 * K); u.B = (const char*)(B + (size_t)u.pn * 256 * K); u.sub = 0; return true; }
    __device__ __forceinline__ void epi(Acc& acc, const GUnit& u, int wr, int wc, int fr, int fq) const {
        const int row0 = u.pm * 256 + wr * 64 + fr, col0 = u.pn * 256 + wc * 32 + 4 * fq;
#pragma unroll
        for (int ai = 0; ai < 2; ++ai) {
            f32x4 bs[4][2][2];
#pragma unroll
            for (int m = 0; m < 4; ++m)
#pragma unroll
                for (int bj = 0; bj < 2; ++bj)
#pragma unroll
                    for (int n = 0; n < 2; ++n) bs[m][bj][n] = *(const f32x4*)(base + (size_t)(row0 + ai * 128 + m * 16) * DM + col0 + bj * 128 + n * 16);
#pragma unroll
            for (int m = 0; m < 4; ++m) { const int row = row0 + ai * 128 + m * 16; const size_t off = (size_t)row * DM + col0; float s = 0.f;
#pragma unroll
                for (int bj = 0; bj < 2; ++bj)
#pragma unroll
                    for (int n = 0; n < 2; ++n) { const f32x4 o = bs[m][bj][n] + acc[ai][bj][m][n];
                        *(f32x4*)(out + off + bj * 128 + n * 16) = o; s += (o[0] * o[0] + o[1] * o[1]) + (o[2] * o[2] + o[3] * o[3]);
                        if (outb) { u32x2 w; w.x = pk2(o[0], o[1]); w.y = pk2(o[2], o[3]); *(u32x2*)(outb + blk_off(row, col0 + bj * 128 + n * 16, DM)) = w; } }
                s += __shfl_xor(s, 16); s += __shfl_xor(s, 32);
                if (fq == 0) unsafeAtomicAdd(ss + row, s); }
        }
        pg8::zero_acc(acc);
    }
};
struct GuProg {
    static constexpr bool PERM = true; int K, G, c; const bf16_t* X; const bf16_t* W; bf16_t* HH; const float* ss2;
    __device__ __forceinline__ bool next(int i, GUnit& u) const { const int L = i * G + c; if (L >= 64 * 44) return false; pg8::tile_of(L, 64, 44, u.pm, u.pn);
        u.A = (const char*)(X + (size_t)u.pm * 256 * DM); u.B = (const char*)(W + (size_t)u.pn * 256 * DM); u.sub = 0; return true; }
    __device__ __forceinline__ void epi(Acc& acc, const GUnit& u, int wr, int wc, int fr, int fq) const {
        const int row0 = u.pm * 256 + wr * 64 + fr, col0 = u.pn * 128 + wc * 32 + 8 * fq;
        float sq[2][4];
#pragma unroll
        for (int ai = 0; ai < 2; ++ai)
#pragma unroll
            for (int m = 0; m < 4; ++m) sq[ai][m] = ss2[row0 + ai * 128 + m * 16];
#pragma unroll
        for (int ai = 0; ai < 2; ++ai)
#pragma unroll
            for (int m = 0; m < 4; ++m) { const int row = row0 + ai * 128 + m * 16; const float r2 = 1.0f / sqrtf(sq[ai][m] * (1.0f / DM) + RMS_EPS);
                float hv[8];
#pragma unroll
                for (int n = 0; n < 2; ++n)
#pragma unroll
                    for (int j = 0; j < 4; ++j) { const float g = acc[ai][0][m][n][j] * r2, uu = acc[ai][1][m][n][j] * r2; hv[4 * n + j] = siluf_(g) * uu; }
                u32x4 w; w.x = pk2(hv[0], hv[1]); w.y = pk2(hv[2], hv[3]); w.z = pk2(hv[4], hv[5]); w.w = pk2(hv[6], hv[7]);
                *(u32x4*)(HH + blk_off(row, col0, FFH)) = w; }
        pg8::zero_acc(acc);
    }
};
struct Ctx {
    const float* in[21]; float* out; unsigned char* ws;
};
struct TpItem { const float* W; const float* ks; bf16_t* WT; int Nsrc, K, dst_row0, src_col0, kb; };
__device__ __forceinline__ TpItem tp_decode(const Ctx& C, int it) {
    constexpr int I_IN = 32 * 352, I_A = 16 * 64, I_O = 32 * 64, I_GU = 32 * 352;
    unsigned char* ws = C.ws; TpItem t; int r = it;
    if (r < I_IN) { const int nb = r % 352, n0 = nb * 32; t.W = C.in[2]; t.ks = C.in[1]; t.WT = (bf16_t*)(ws + WS_WIN); t.Nsrc = INCOLS; t.K = DM; t.dst_row0 = n0; t.src_col0 = n0 < 7168 ? n0 : n0 + 16; t.kb = r / 352; return t; } r -= I_IN;
    if (r < I_A) { t.W = C.in[14]; t.ks = nullptr; t.WT = (bf16_t*)(ws + WS_WA); t.Nsrc = DM; t.K = HW; t.dst_row0 = (r % 64) * 32; t.src_col0 = t.dst_row0; t.kb = r / 64; return t; } r -= I_A;
    if (r < I_A) { t.W = C.in[15]; t.ks = nullptr; t.WT = (bf16_t*)(ws + WS_WB); t.Nsrc = DM; t.K = MW; t.dst_row0 = (r % 64) * 32; t.src_col0 = t.dst_row0; t.kb = r / 64; return t; } r -= I_A;
    if (r < I_O) { t.W = C.in[16]; t.ks = nullptr; t.WT = (bf16_t*)(ws + WS_WOUT); t.Nsrc = DM; t.K = DM; t.dst_row0 = (r % 64) * 32; t.src_col0 = t.dst_row0; t.kb = r / 64; return t; } r -= I_O;
    if (r < I_GU) { const int nb = r % 352, n0 = nb * 32; const int pn = n0 >> 8, half = (n0 >> 7) & 1, i = n0 & 127;
        t.W = C.in[18]; t.ks = C.in[17]; t.WT = (bf16_t*)(ws + WS_WGU); t.Nsrc = 2 * FFH; t.K = DM; t.dst_row0 = n0; t.src_col0 = half * FFH + 128 * pn + i; t.kb = r / 352; return t; } r -= I_GU;
    t.W = C.in[19]; t.ks = nullptr; t.WT = (bf16_t*)(ws + WS_WD); t.Nsrc = DM; t.K = FFH; t.dst_row0 = (r % 64) * 32; t.src_col0 = t.dst_row0; t.kb = r / 64; return t;
}
__device__ __forceinline__ void tp_load(const TpItem& t, int lane, float (&tv)[32], float (&sv)[32]) {
    const int k0 = 64 * t.kb; const float* wp = t.W + (size_t)(k0 + (lane >> 5)) * t.Nsrc + t.src_col0 + (lane & 31);
#pragma unroll
    for (int i = 0; i < 32; ++i) tv[i] = wp[(size_t)(2 * i) * t.Nsrc];
    const float* kp = t.ks ? t.ks + k0 + (lane >> 5) : nullptr;
#pragma unroll
    for (int i = 0; i < 32; ++i) sv[i] = kp ? kp[2 * i] : 1.0f;
}
__device__ __forceinline__ void p0_prologue(const Ctx& C, LAS unsigned char* lds, int G, int wv) {
    int tid = (wv << 6) | lane_id_opaque(); asm volatile("" : "+v"(tid));
    const int lane = tid & 63, wave = __builtin_amdgcn_readfirstlane(tid >> 6);
    const int gw = blockIdx.x * 8 + wave, NGW = G * 8;
    unsigned char* ws = C.ws;
    LAS float* scr = (LAS float*)(lds + wave * 8704);
    {
        constexpr int NIT = 32 * 352 + 2 * 16 * 64 + 32 * 64 + 32 * 352 + 88 * 64;
        float tv[32], sv[32]; TpItem cur, nxt; int it = gw;
        if (it < NIT) { cur = tp_decode(C, it); tp_load(cur, lane, tv, sv); }
        while (it < NIT) {
#pragma unroll
            for (int i = 0; i < 32; ++i) scr[(2 * i + (lane >> 5)) * 33 + (lane & 31)] = tv[i] * sv[i];
            asm volatile("s_waitcnt lgkmcnt(0)" ::: "memory");
            const int nit = it + NGW;
            if (nit < NIT) { nxt = tp_decode(C, nit); tp_load(nxt, lane, tv, sv); }
            const int c = lane & 7, k0 = 64 * cur.kb;
#pragma unroll
            for (int j = 0; j < 4; ++j) { const int n = (lane >> 3) + 8 * j; const LAS float* sp = scr + (8 * c) * 33 + n;
                u32x4 o; o.x = pk2(sp[0 * 33], sp[1 * 33]); o.y = pk2(sp[2 * 33], sp[3 * 33]); o.z = pk2(sp[4 * 33], sp[5 * 33]); o.w = pk2(sp[6 * 33], sp[7 * 33]);
                *(u32x4*)(cur.WT + blk_off(cur.dst_row0 + n, k0 + 8 * c, cur.K)) = o; }
            asm volatile("s_waitcnt lgkmcnt(0)" ::: "memory");
            cur = nxt; it = nit;
        }
    }
    for (int i = blockIdx.x * 512 + tid; i < TOK; i += G * 512) { ((float*)(ws + WS_SS2))[i] = 0.f; ((float*)(ws + WS_SS3))[i] = 0.f; }
    {
        const float* w1 = C.in[5]; const float* b1 = C.in[6]; const float* f1 = C.in[7]; const float* w2 = C.in[8]; const float* b2 = C.in[9]; const float* f2 = C.in[10];
        float* h2 = (float*)(ws + WS_H2);
        for (int t = gw; t < SEQ; t += NGW) {
            const float tl = (float)t / (float)(SEQ - 1);
            const float omega = 6.283185307179586f * (float)t / (float)SEQ;
            float a = b1[lane] + tl * w1[lane];
            float sn, cs;
            { const int bi = lane & 15; const float fr = 1e-4f + (float)bi * ((15.0f - 1e-4f) / 15.0f); sincosf(omega * fr, &sn, &cs); }
#pragma unroll
            for (int i = 0; i < 16; ++i) a += __shfl(cs, i) * w1[(1 + i) * 64 + lane] - __shfl(sn, i) * w1[(17 + i) * 64 + lane];
            const float h1 = sinf(f1[lane] * a);
            float a2 = b2[lane];
#pragma unroll 8
            for (int i = 0; i < 64; ++i) a2 += __shfl(h1, i) * w2[i * 64 + lane];
            h2[t * 64 + lane] = sinf(f2[lane] * a2);
        }
    }
    __syncthreads();
    {
        constexpr int WGP = 2056;
        LAS bf16_t* wgb = (LAS bf16_t*)lds;
        const float* w_in = C.in[2]; const float* nw = C.in[1];
#pragma unroll 1
        for (int i0 = tid; i0 < DM * 16; i0 += 512 * 16) { float tw[16], tn[16];
#pragma unroll
            for (int u = 0; u < 16; ++u) { const int i = i0 + 512 * u, k = i >> 4, g = i & 15; tw[u] = w_in[(size_t)k * INCOLS + 7168 + g]; tn[u] = nw[k]; }
#pragma unroll
            for (int u = 0; u < 16; ++u) { const int i = i0 + 512 * u, k = i >> 4, g = i & 15; wgb[g * WGP + k] = (bf16_t)f2bf(tw[u] * tn[u]); } }
        __syncthreads();
        const float* x = C.in[0]; bf16_t* xb = (bf16_t*)(ws + WS_XB); float* r1 = (float*)(ws + WS_R1S); float* Gt = (float*)(ws + WS_G); const float* gbias = C.in[13];
        const int r = lane & 15, g = lane >> 4; const bool act = r < 8;
        for (int rb = gw; rb < TOK / 8; rb += NGW) {
            const int row = rb * 8 + (r & 7);
            const float* xp = x + (size_t)row * DM + 8 * g;
            f32x4 acc = {0.f, 0.f, 0.f, 0.f}; float ss = 0.f;
#pragma unroll 1
            for (int k8 = 0; k8 < 64; k8 += 8) {
                f32x4 la[8], lb[8];
#pragma unroll
                for (int u = 0; u < 8; ++u) { la[u] = *(const f32x4*)(xp + 32 * (k8 + u)); lb[u] = *(const f32x4*)(xp + 32 * (k8 + u) + 4); }
#pragma unroll
                for (int u = 0; u < 8; ++u) { const int kk = k8 + u; const f32x4 a = la[u], b = lb[u];
                    ss += ((a.x * a.x + a.y * a.y) + (a.z * a.z + a.w * a.w)) + ((b.x * b.x + b.y * b.y) + (b.z * b.z + b.w * b.w));
                    u32x4 o; o.x = pk2(a.x, a.y); o.y = pk2(a.z, a.w); o.z = pk2(b.x, b.y); o.w = pk2(b.z, b.w);
                    *(u32x4*)(xb + blk_off(row, 32 * kk + 8 * g, DM)) = o;
                    if (!act) { o.x = 0u; o.y = 0u; o.z = 0u; o.w = 0u; }
                    const bf16x8 bw = *(const LAS bf16x8*)(wgb + r * WGP + 32 * kk + 8 * g);
                    acc = __builtin_amdgcn_mfma_f32_16x16x32_bf16(__builtin_bit_cast(bf16x8, o), bw, acc, 0, 0, 0); }
            }
            ss += __shfl_xor(ss, 16); ss += __shfl_xor(ss, 32);
            const float rinv = 1.0f / sqrtf(ss * (1.0f / DM) + RMS_EPS);
            const float gb = gbias[r];
#pragma unroll
            for (int i = 0; i < 4; ++i) { const int m = 4 * g + i; const float rv = __shfl(rinv, m & 7); if (g < 2) Gt[(size_t)(rb * 8 + m) * 16 + r] = acc[i] * rv + gb; }
            if (lane < 8) r1[rb * 8 + lane] = rinv;
        }
    }
}
__device__ __forceinline__ void p1_filters(const Ctx& C, LAS unsigned char* lds, int G, int wv) {
    int tid = (wv << 6) | lane_id_opaque(); asm volatile("" : "+v"(tid));
    const int lane = tid & 63, w = tid >> 6, r = lane & 15, g = lane >> 4;
    const float* w3 = C.in[11]; const float* h2 = (const float*)(C.ws + WS_H2); float* FILT = (float*)(C.ws + WS_FILT);
    for (int item = blockIdx.x; item < 256; item += G) {
        const int n0 = 64 * (item >> 2), t0 = 1024 * (item & 3) + 128 * w;
        bf16x8 af[4][2];
#pragma unroll
        for (int mt = 0; mt < 4; ++mt)
#pragma unroll
            for (int ks = 0; ks < 2; ++ks) { float v[8];
#pragma unroll
                for (int e = 0; e < 8; ++e) v[e] = w3[(size_t)(32 * ks + 8 * g + e) * NFILT + n0 + 16 * mt + r];
                u32x4 o; o.x = pk2(v[0], v[1]); o.y = pk2(v[2], v[3]); o.z = pk2(v[4], v[5]); o.w = pk2(v[6], v[7]); af[mt][ks] = __builtin_bit_cast(bf16x8, o); }
        float dl[4][4];
#pragma unroll
        for (int mt = 0; mt < 4; ++mt)
#pragma unroll
            for (int i = 0; i < 4; ++i) { const int ch = (n0 + 16 * mt + 4 * g + i) & 1023; const float mind = -3.0701134573253945f, maxd = -15.350567286626973f;
                dl[mt][i] = fabsf(mind + (float)ch * ((maxd - mind) / 1023.0f)); }
        bf16x8 bfr[8][2];
#pragma unroll
        for (int nt = 0; nt < 8; ++nt) { const int t = t0 + 16 * nt + r;
#pragma unroll
            for (int ks = 0; ks < 2; ++ks) { const f32x4 a = *(const f32x4*)(h2 + (size_t)t * 64 + 32 * ks + 8 * g), b = *(const f32x4*)(h2 + (size_t)t * 64 + 32 * ks + 8 * g + 4);
                u32x4 o; o.x = pk2(a.x, a.y); o.y = pk2(a.z, a.w); o.z = pk2(b.x, b.y); o.w = pk2(b.z, b.w); bfr[nt][ks] = __builtin_bit_cast(bf16x8, o); } }
#pragma unroll
        for (int nt = 0; nt < 8; ++nt) {
            const int t = t0 + 16 * nt + r;
            const float tl = (float)t / (float)(SEQ - 1);
#pragma unroll
            for (int mt = 0; mt < 4; ++mt) {
                f32x4 acc = {0.f, 0.f, 0.f, 0.f};
                acc = __builtin_amdgcn_mfma_f32_16x16x32_bf16(af[mt][0], bfr[nt][0], acc, 0, 0, 0);
                acc = __builtin_amdgcn_mfma_f32_16x16x32_bf16(af[mt][1], bfr[nt][1], acc, 0, 0, 0);
#pragma unroll
                for (int i = 0; i < 4; ++i) FILT[(size_t)(n0 + 16 * mt + 4 * g + i) * SEQ + t] = acc[i] * expf(-tl * dl[mt][i]);
            }
        }
    }
}
__device__ __forceinline__ void p7_final(const Ctx& C, int G, int wv) {
    int tid = (wv << 6) | lane_id_opaque(); asm volatile("" : "+v"(tid));
    const int lane = tid & 63, wave = tid >> 6, gw = blockIdx.x * 8 + wave, NGW = G * 8;
    const float* ss3 = (const float*)(C.ws + WS_SS3); const float* wf = C.in[20];
    f32x4 w[8];
#pragma unroll
    for (int j = 0; j < 8; ++j) w[j] = ((const f32x4*)wf)[64 * j + lane];
    for (int row = gw; row < TOK; row += 2 * NGW) {
        const int row2 = row + NGW;
        const bool has2 = row2 < TOK;
        const float r = 1.0f / sqrtf(ss3[row] * (1.0f / DM) + RMS_EPS), r2 = has2 ? 1.0f / sqrtf(ss3[row2] * (1.0f / DM) + RMS_EPS) : 0.f;
        f32x4* p = (f32x4*)(C.out + (size_t)row * DM) + lane; f32x4* p2 = (f32x4*)(C.out + (size_t)(has2 ? row2 : row) * DM) + lane;
        f32x4 v[8], u[8];
#pragma unroll
        for (int j = 0; j < 8; ++j) { v[j] = p[64 * j]; u[j] = p2[64 * j]; }
#pragma unroll
        for (int j = 0; j < 8; ++j) p[64 * j] = v[j] * r * w[j];
        if (has2) {
#pragma unroll
            for (int j = 0; j < 8; ++j) p2[64 * j] = u[j] * r2 * w[j]; }
    }
}
#ifndef FFT_HOST
#define FFT_DEV __device__ __forceinline__
#define FFT_PTR LAS f32x2*
#define FFT_SIN(x) __builtin_amdgcn_sinf(x)
#define FFT_COS(x) __builtin_amdgcn_cosf(x)
#else
#define FFT_DEV static inline
#define FFT_PTR f32x2*
#define FFT_SIN(x) sinf(6.283185307179586f * (x))
#define FFT_COS(x) cosf(6.283185307179586f * (x))
#endif
#define PADI(i) ((i) + ((i) >> 4))
FFT_DEV f32x2 cmul(f32x2 a, f32x2 b) { f32x2 r; r.x = a.x * b.x - a.y * b.y; r.y = a.x * b.y + a.y * b.x; return r; }
FFT_DEV f32x2 cmulc(f32x2 a, f32x2 b) { f32x2 r; r.x = a.x * b.x + a.y * b.y; r.y = a.y * b.x - a.x * b.y; return r; }
FFT_DEV f32x2 twid(float frac) { f32x2 r; r.x = FFT_COS(frac); r.y = -FFT_SIN(frac); return r; }
template <int M, int CJ> FFT_DEV f32x2 rot8(f32x2 d) {
    const float R = 0.70710678118654752f; f32x2 r;
    if (M == 0) return d;
    if (M == 2) { if (!CJ) { r.x = d.y; r.y = -d.x; } else { r.x = -d.y; r.y = d.x; } return r; }
    if (M == 1) { if (!CJ) { r.x = R * (d.x + d.y); r.y = R * (d.y - d.x); } else { r.x = R * (d.x - d.y); r.y = R * (d.x + d.y); } return r; }
    if (!CJ) { r.x = R * (d.y - d.x); r.y = -R * (d.x + d.y); } else { r.x = -R * (d.x + d.y); r.y = R * (d.x - d.y); } return r;
}
template <int INV, int ZHI, int LOW> FFT_DEV void fft_r8_pass(FFT_PTR buf, int s, int ls  , int tid) {
#pragma unroll 1
    for (int rep = 0; rep < 2; ++rep) {
        const int bf = tid + rep * 512, j = bf & (s - 1), blk = bf >> ls, base = blk * 8 * s + j;
        f32x2 x[8];
#pragma unroll
        for (int m = 0; m < (ZHI ? 4 : 8); ++m) x[m] = buf[PADI(base + m * s)];
        f32x2 w1 = twid((float)j / (float)(8 * s));
        f32x2 w2 = cmul(w1, w1), w4 = cmul(w2, w2);
        if (!INV) {
            if (ZHI) {
                x[4] = cmul(x[0], w1); x[5] = cmul(rot8<1, 0>(x[1]), w1); x[6] = cmul(rot8<2, 0>(x[2]), w1); x[7] = cmul(rot8<3, 0>(x[3]), w1);
            } else {
                { f32x2 a = x[0], b = x[4]; x[0] = a + b; x[4] = cmul(a - b, w1); }
                { f32x2 a = x[1], b = x[5]; x[1] = a + b; x[5] = cmul(rot8<1, 0>(a - b), w1); }
                { f32x2 a = x[2], b = x[6]; x[2] = a + b; x[6] = cmul(rot8<2, 0>(a - b), w1); }
                { f32x2 a = x[3], b = x[7]; x[3] = a + b; x[7] = cmul(rot8<3, 0>(a - b), w1); }
            }
#pragma unroll
            for (int h = 0; h < 8; h += 4) {
                { f32x2 a = x[h], b = x[h + 2]; x[h] = a + b; x[h + 2] = cmul(a - b, w2); }
                { f32x2 a = x[h + 1], b = x[h + 3]; x[h + 1] = a + b; x[h + 3] = cmul(rot8<2, 0>(a - b), w2); }
            }
#pragma unroll
            for (int m = 0; m < 8; m += 2) { f32x2 a = x[m], b = x[m + 1]; x[m] = a + b; x[m + 1] = cmul(a - b, w4); }
        } else {
#pragma unroll
            for (int m = 0; m < 8; m += 2) { f32x2 a = x[m], b = cmulc(x[m + 1], w4); x[m] = a + b; x[m + 1] = a - b; }
#pragma unroll
            for (int h = 0; h < 8; h += 4) {
                { f32x2 a = x[h], b = cmulc(x[h + 2], w2); x[h] = a + b; x[h + 2] = a - b; }
                { f32x2 a = x[h + 1], b = rot8<2, 1>(cmulc(x[h + 3], w2)); x[h + 1] = a + b; x[h + 3] = a - b; }
            }
            { f32x2 a = x[0], b = cmulc(x[4], w1); x[0] = a + b; if (!LOW) x[4] = a - b; }
            { f32x2 a = x[1], b = rot8<1, 1>(cmulc(x[5], w1)); x[1] = a + b; if (!LOW) x[5] = a - b; }
            { f32x2 a = x[2], b = rot8<2, 1>(cmulc(x[6], w1)); x[2] = a + b; if (!LOW) x[6] = a - b; }
            { f32x2 a = x[3], b = rot8<3, 1>(cmulc(x[7], w1)); x[3] = a + b; if (!LOW) x[7] = a - b; }
        }
#pragma unroll
        for (int m = 0; m < (LOW ? 4 : 8); ++m) buf[PADI(base + m * s)] = x[m];
    }
}
FFT_DEV void fft_r2_span1(FFT_PTR buf, int tid) {
#pragma unroll
    for (int rep = 0; rep < 8; ++rep) { const int p = 2 * (tid + rep * 512); f32x2 a = buf[PADI(p)], b = buf[PADI(p + 1)]; buf[PADI(p)] = a + b; buf[PADI(p + 1)] = a - b; }
}
template <int J, int CJ> FFT_DEV f32x2 rot16(f32x2 d) {
    const float C1 = 0.92387953251128674f, S1 = 0.38268343236508977f;
    if ((J & 1) == 0) return rot8<J / 2, CJ>(d);
    const float wr = (J == 1) ? C1 : (J == 3) ? S1 : (J == 5) ? -S1 : -C1;
    const float wi = ((J == 1) ? -S1 : (J == 3) ? -C1 : (J == 5) ? -C1 : -S1) * (CJ ? -1.f : 1.f);
    f32x2 r; r.x = d.x * wr - d.y * wi; r.y = d.x * wi + d.y * wr; return r;
}
FFT_DEV unsigned brev13(unsigned p);
FFT_DEV void fft16_dif(f32x2 (&x)[16]) {
#define BF_(i, j, ROT) { const f32x2 a_ = x[i], b_ = x[j]; x[i] = a_ + b_; x[j] = ROT(a_ - b_); }
    BF_(0, 8, (rot16<0, 0>)) BF_(1, 9, (rot16<1, 0>)) BF_(2, 10, (rot16<2, 0>)) BF_(3, 11, (rot16<3, 0>)) BF_(4, 12, (rot16<4, 0>)) BF_(5, 13, (rot16<5, 0>)) BF_(6, 14, (rot16<6, 0>)) BF_(7, 15, (rot16<7, 0>))
#pragma unroll
    for (int h = 0; h < 16; h += 8) { BF_(h + 0, h + 4, (rot8<0, 0>)) BF_(h + 1, h + 5, (rot8<1, 0>)) BF_(h + 2, h + 6, (rot8<2, 0>)) BF_(h + 3, h + 7, (rot8<3, 0>)) }
#pragma unroll
    for (int h = 0; h < 16; h += 4) { BF_(h + 0, h + 2, (rot8<0, 0>)) BF_(h + 1, h + 3, (rot8<2, 0>)) }
#pragma unroll
    for (int h = 0; h < 16; h += 2) { BF_(h, h + 1, (rot8<0, 0>)) }
#undef BF_
}
FFT_DEV void fft16_dit_inv(f32x2 (&x)[16]) {
#define BI_(i, j, ROT) { const f32x2 a_ = x[i], b_ = ROT(x[j]); x[i] = a_ + b_; x[j] = a_ - b_; }
#pragma unroll
    for (int h = 0; h < 16; h += 2) { BI_(h, h + 1, (rot8<0, 1>)) }
#pragma unroll
    for (int h = 0; h < 16; h += 4) { BI_(h + 0, h + 2, (rot8<0, 1>)) BI_(h + 1, h + 3, (rot8<2, 1>)) }
#pragma unroll
    for (int h = 0; h < 16; h += 8) { BI_(h + 0, h + 4, (rot8<0, 1>)) BI_(h + 1, h + 5, (rot8<1, 1>)) BI_(h + 2, h + 6, (rot8<2, 1>)) BI_(h + 3, h + 7, (rot8<3, 1>)) }
    BI_(0, 8, (rot16<0, 1>)) BI_(1, 9, (rot16<1, 1>)) BI_(2, 10, (rot16<2, 1>)) BI_(3, 11, (rot16<3, 1>)) BI_(4, 12, (rot16<4, 1>)) BI_(5, 13, (rot16<5, 1>)) BI_(6, 14, (rot16<6, 1>)) BI_(7, 15, (rot16<7, 1>))
#undef BI_
}
template <int MODE> FFT_DEV void fft_mid_pass(FFT_PTR wb, FFT_PTR zk, int tid) {
    f32x2 x[16];
#pragma unroll
    for (int e = 0; e < 16; ++e) x[e] = wb[PADI(16 * tid + e)];
    fft16_dif(x);
    if (MODE != 0) {
#pragma unroll
        for (int e = 0; e < 16; ++e) {
            const unsigned p = 16u * (unsigned)tid + (unsigned)e, f = brev13(p), fn = (8192u - f) & 8191u, pn = brev13(fn);
            const f32x2 zf = zk[PADI(p)], zn = zk[PADI(pn)];
            f32x2 kf;
            if (MODE == 1) { kf.x = 0.5f * (zf.x + zn.x); kf.y = 0.5f * (zf.y - zn.y); }
            else           { kf.x = 0.5f * (zf.y + zn.y); kf.y = 0.5f * (zn.x - zf.x); }
            x[e] = cmul(x[e], kf);
        }
        fft16_dit_inv(x);
    }
#pragma unroll
    for (int e = 0; e < 16; ++e) wb[PADI(16 * tid + e)] = x[e];
}
#ifndef FFT_HOST
#define FFT_SYNC() do { asm volatile("s_waitcnt lgkmcnt(0)" ::: "memory"); __builtin_amdgcn_s_barrier(); asm volatile("" ::: "memory"); } while (0)
__device__ __forceinline__ void fft_fwd_full(FFT_PTR buf, int tid) {
    FFT_SYNC(); fft_r8_pass<0, 0, 0>(buf, 1024, 10, tid); FFT_SYNC(); fft_r8_pass<0, 0, 0>(buf, 128, 7, tid); FFT_SYNC(); fft_r8_pass<0, 0, 0>(buf, 16, 4, tid); FFT_SYNC();
    fft_mid_pass<0>(buf, buf, tid); FFT_SYNC();
}
template <int WHICH> __device__ __forceinline__ void fft_conv(FFT_PTR wb, FFT_PTR zk, int tid) {
    FFT_SYNC(); fft_r8_pass<0, 1, 0>(wb, 1024, 10, tid); FFT_SYNC(); fft_r8_pass<0, 0, 0>(wb, 128, 7, tid); FFT_SYNC(); fft_r8_pass<0, 0, 0>(wb, 16, 4, tid); FFT_SYNC();
    fft_mid_pass<1 + WHICH>(wb, zk, tid); FFT_SYNC();
    fft_r8_pass<1, 0, 0>(wb, 16, 4, tid); FFT_SYNC(); fft_r8_pass<1, 0, 0>(wb, 128, 7, tid); FFT_SYNC(); fft_r8_pass<1, 0, 1>(wb, 1024, 10, tid); FFT_SYNC();
}
#endif
FFT_DEV unsigned brev13(unsigned p) {
    unsigned r = 0;
#ifndef FFT_HOST
    r = __brev(p) >> 19;
#else
    for (int i = 0; i < 13; ++i) r |= ((p >> i) & 1u) << (12 - i);
#endif
    return r;
}
FFT_DEV void fft_pointwise(FFT_PTR wb, FFT_PTR zk, int which, int tid) {
#pragma unroll 4
    for (int rep = 0; rep < 16; ++rep) {
        const unsigned p = tid + rep * 512, f = brev13(p), fn = (8192u - f) & 8191u, pn = brev13(fn);
        const f32x2 zf = zk[PADI(p)], zn = zk[PADI(pn)];
        f32x2 kf;
        if (which == 0) { kf.x = 0.5f * (zf.x + zn.x); kf.y = 0.5f * (zf.y - zn.y); }
        else            { kf.x = 0.5f * (zf.y + zn.y); kf.y = 0.5f * (zn.x - zf.x); }
        wb[PADI(p)] = cmul(wb[PADI(p)], kf);
    }
}
__device__ __forceinline__ void qk_prepass(const Ctx& C, int G, int wv) {
    int tid = (wv << 6) | lane_id_opaque(); asm volatile("" : "+v"(tid));
    const bf16_t* R1A = (const bf16_t*)(C.ws + WS_R1A); bf16_t* QKP = (bf16_t*)(C.ws + WS_QKP);
    const float* cw = C.in[3]; const float* cb = C.in[4];
    const int cg8 = tid & 255, half = tid >> 8, col = 8 * cg8;
    float k0[8], k1[8], k2[8], kb[8];
    { const int ch = 3072 + col;
      const f32x4 t0 = *(const f32x4*)(cw + ch), t1 = *(const f32x4*)(cw + ch + 4), t2 = *(const f32x4*)(cw + CONVC + ch), t3 = *(const f32x4*)(cw + CONVC + ch + 4);
      const f32x4 t4 = *(const f32x4*)(cw + 2 * CONVC + ch), t5 = *(const f32x4*)(cw + 2 * CONVC + ch + 4), t6 = *(const f32x4*)(cb + ch), t7 = *(const f32x4*)(cb + ch + 4);
#pragma unroll
      for (int e = 0; e < 4; ++e) { k0[e] = t0[e]; k0[4 + e] = t1[e]; k1[e] = t2[e]; k1[4 + e] = t3[e]; k2[e] = t4[e]; k2[4 + e] = t5[e]; kb[e] = t6[e]; kb[4 + e] = t7[e]; } }
    const float osc = col >= 1024 ? 0.0625f : 1.0f;
    for (int run = blockIdx.x; run < TOK / 64; run += G) {
        const int row0 = run * 64 + half * 32;
#pragma unroll 1
        for (int i0 = 0; i0 < 32; i0 += 4) {
            u32x4 w0[4], w1[4], w2[4];
#pragma unroll
            for (int u = 0; u < 4; ++u) { const int row = row0 + i0 + u, t = row & (SEQ - 1); const bf16_t* p = R1A + (size_t)row * 2048 + col;
                w0[u] = *(const u32x4*)(t > 0 ? p - 2048 : p); w1[u] = *(const u32x4*)p; w2[u] = *(const u32x4*)(t < SEQ - 1 ? p + 2048 : p); }
#pragma unroll
            for (int u = 0; u < 4; ++u) { const int row = row0 + i0 + u, t = row & (SEQ - 1);
                const u32x4 z = {0u, 0u, 0u, 0u}; if (t == 0) w0[u] = z; if (t == SEQ - 1) w2[u] = z;
                float a0[8], a1[8], a2[8]; unpack8(w0[u], a0); unpack8(w1[u], a1); unpack8(w2[u], a2);
                float v[8];
#pragma unroll
                for (int e = 0; e < 8; ++e) v[e] = siluf_(k0[e] * a0[e] + k1[e] * a1[e] + k2[e] * a2[e] + kb[e]) * osc;
                u32x4 o; o.x = pk2(v[0], v[1]); o.y = pk2(v[2], v[3]); o.z = pk2(v[4], v[5]); o.w = pk2(v[6], v[7]);
                *(u32x4*)(QKP + (size_t)row * 2048 + col) = o; }
        }
    }
}
constexpr int ML_KS = 0, ML_KP = 528, ML_SS = 76032, ML_SP = 272, ML_VS = 110848, ML_VP = 80, ML_VW = 121088, ML_CS = 131328, ML_CP = 528, ML_SC = 148224;
static_assert(ML_SC + 7 * 512 + 64 + 5 * 128 <= LDS_BYTES - 16, "mLSTM LDS map");
__device__ __forceinline__ bf16x8 tr_read2(unsigned a0, unsigned a1) {
    bf16x4 lo, hi;
    asm volatile("ds_read_b64_tr_b16 %0, %2\n\tds_read_b64_tr_b16 %1, %3\n\ts_waitcnt lgkmcnt(0)" : "=&v"(lo), "=&v"(hi) : "v"(a0), "v"(a1) : "memory");
    bf16x8 r; r[0] = lo[0]; r[1] = lo[1]; r[2] = lo[2]; r[3] = lo[3]; r[4] = hi[0]; r[5] = hi[1]; r[6] = hi[2]; r[7] = hi[3]; return r;
}
__device__ __forceinline__ bf16x8 cat4(bf16x4 lo, bf16x4 hi) { bf16x8 r; r[0] = lo[0]; r[1] = lo[1]; r[2] = lo[2]; r[3] = lo[3]; r[4] = hi[0]; r[5] = hi[1]; r[6] = hi[2]; r[7] = hi[3]; return r; }
__device__ __forceinline__ void tr_read2x2(unsigned a, unsigned b, unsigned d, bf16x8& ra, bf16x8& rb) {
    bf16x4 l0, h0, l1, h1;
    asm volatile("ds_read_b64_tr_b16 %0, %4\n\tds_read_b64_tr_b16 %1, %5\n\tds_read_b64_tr_b16 %2, %6\n\tds_read_b64_tr_b16 %3, %7\n\ts_waitcnt lgkmcnt(0)"
        : "=&v"(l0), "=&v"(h0), "=&v"(l1), "=&v"(h1) : "v"(a), "v"(a + d), "v"(b), "v"(b + d) : "memory");
    ra = cat4(l0, h0); rb = cat4(l1, h1);
}
__device__ __forceinline__ void tr_read4x2(unsigned a, unsigned b, unsigned d, unsigned c, unsigned e, unsigned d2, bf16x8& ra, bf16x8& rb, bf16x8& rc, bf16x8& re) {
    bf16x4 l0, h0, l1, h1, l2, h2, l3, h3;
    asm volatile("ds_read_b64_tr_b16 %0, %8\n\tds_read_b64_tr_b16 %1, %9\n\tds_read_b64_tr_b16 %2, %10\n\tds_read_b64_tr_b16 %3, %11\n\t"
                 "ds_read_b64_tr_b16 %4, %12\n\tds_read_b64_tr_b16 %5, %13\n\tds_read_b64_tr_b16 %6, %14\n\tds_read_b64_tr_b16 %7, %15\n\ts_waitcnt lgkmcnt(0)"
        : "=&v"(l0), "=&v"(h0), "=&v"(l1), "=&v"(h1), "=&v"(l2), "=&v"(h2), "=&v"(l3), "=&v"(h3)
        : "v"(a), "v"(a + d), "v"(b), "v"(b + d), "v"(c), "v"(c + d2), "v"(e), "v"(e + d2) : "memory");
    ra = cat4(l0, h0); rb = cat4(l1, h1); rc = cat4(l2, h2); re = cat4(l3, h3);
}
__device__ __forceinline__ float bf2f(short s) { return __uint_as_float(((unsigned)(unsigned short)s) << 16); }
__device__ __forceinline__ float logsigmoidf_(float x) { return fminf(x, 0.f) - log1pf(expf(-fabsf(x))); }

__device__ __forceinline__ void mlstm_item(const Ctx& C, LAS unsigned char* lds, int item, int wv) {
    int tid = (wv << 6) | lane_id_opaque(); asm volatile("" : "+v"(tid));
    const int lane = tid & 63, w = __builtin_amdgcn_readfirstlane(tid >> 6), r = lane & 15, g = lane >> 4, q4 = r >> 2, p4 = r & 3;
    const int xcd_ = item & 7, yy_ = item >> 3, vs = yy_ & 7, dir = (yy_ >> 3) & 1, bh = 2 * xcd_ + (yy_ >> 4), b = bh >> 2, h = bh & 3;
    const bf16_t* QKP = (const bf16_t*)(C.ws + WS_QKP); const bf16_t* R1B = (const bf16_t*)(C.ws + WS_R1B); const float* Gt = (const float*)(C.ws + WS_G);
    bf16_t* Y = (bf16_t*)(C.ws + (dir ? WS_YBB : WS_YBF));
    LAS float* SC = (LAS float*)(lds + ML_SC);
    LAS float* s_cs = SC, *s_rj = SC + 128, *s_iw = SC + 256, *s_emj = SC + 384, *s_w = SC + 512, *s_dn = SC + 640, *s_misc = SC + 768;
    LAS float* c_bl = SC + 784, *c_mx = SC + 816, *c_mp = SC + 848, *c_mn = SC + 880, *c_kp = SC + 912;
    float* GS = (float*)(C.ws + WS_GSC) + (size_t)item * 3 * SEQ;
    const unsigned lbase = (unsigned)(size_t)lds;
    const int pc = tid & 31, krow = tid >> 5, vrow = tid >> 2, pv = tid & 3;
    const int sw = w < 4 ? w : 11 - w;
    for (int i = tid; i < 16896 / 4; i += 512) ((LAS unsigned*)(lds + ML_CS))[i] = 0u;
    for (int i = tid; i < 16 * ML_KP / 4; i += 512) ((LAS unsigned*)(lds + ML_KS + 128 * ML_KP))[i] = 0u;
    f32x4 Cacc[3][2];
#pragma unroll
    for (int a = 0; a < 3; ++a) { Cacc[a][0] = (f32x4){0.f, 0.f, 0.f, 0.f}; Cacc[a][1] = (f32x4){0.f, 0.f, 0.f, 0.f}; }
    u32x4 kreg[8], vreg, qn[8]; float bn = 0.f, csn = 0.f, pmn = 0.f;
#define ML_TOK(c_, j_) ((size_t)b * SEQ + (dir ? SEQ - 1 - ((c_) * 128 + (j_)) : ((c_) * 128 + (j_))))
#define ML_PREFETCH(c_) do { \
        _Pragma("unroll") for (int i = 0; i < 8; ++i) kreg[i] = *(const u32x4*)(QKP + ML_TOK(c_, krow + 16 * i) * 2048 + 1024 + h * 256 + 8 * pc); \
        vreg = *(const u32x4*)(R1B + ML_TOK(c_, vrow) * 2048 + h * 256 + vs * 32 + 8 * pv); \
        { const bf16_t* qp = QKP + ML_TOK(c_, 16 * sw + r) * 2048 + h * 256 + 8 * g; _Pragma("unroll") for (int kk = 0; kk < 8; ++kk) qn[kk] = *(const u32x4*)(qp + 32 * kk); } \
        if (tid < 128) { const int ta = (c_) * 128 + tid; bn = GS[ta]; csn = GS[SEQ + ta]; pmn = GS[2 * SEQ + ta]; } } while (0)
    {
        float gi[8], gf[8];
#pragma unroll
        for (int u = 0; u < 8; ++u) { const int ta = (4 * w) * 128 + u * 64 + lane; const size_t tk = (size_t)b * SEQ + (dir ? SEQ - 1 - ta : ta);
            gi[u] = Gt[tk * 16 + (dir * 2) * 4 + h]; gf[u] = Gt[tk * 16 + (dir * 2 + 1) * 4 + h]; }
#pragma unroll
        for (int q = 0; q < 4; ++q) {
            const int c = 4 * w + q; float carry_b = 0.f, carry_m = -3.0e38f;
#pragma unroll
            for (int hf = 0; hf < 2; ++hf) {
                const int ta = c * 128 + hf * 64 + lane;
                const float ip = gi[2 * q + hf], fp = gf[2 * q + hf];
                float xs = logsigmoidf_(fp);
#pragma unroll
                for (int o = 1; o < 64; o <<= 1) { const float y = __shfl_up(xs, o); if (lane >= o) xs += y; }
                const float bj = xs + carry_b; const float cj = ip - bj; float pm = cj;
#pragma unroll
                for (int o = 1; o < 64; o <<= 1) { const float y = __shfl_up(pm, o); if (lane >= o) pm = fmaxf(pm, y); }
                pm = fmaxf(pm, carry_m);
                GS[ta] = bj; GS[SEQ + ta] = cj; GS[2 * SEQ + ta] = pm;
                carry_b = __shfl(bj, 63); carry_m = __shfl(pm, 63);
            }
            if (lane == 0) { c_bl[c] = carry_b; c_mx[c] = carry_m; }
        }
        __syncthreads();
        if (tid == 0) { float m = 0.f;
            for (int c = 0; c < 32; ++c) { const float bl = c_bl[c], mn = fmaxf(bl + m, bl + c_mx[c]); c_mp[c] = m; c_mn[c] = mn; c_kp[c] = __expf(bl + m - mn); m = mn; } }
        __syncthreads();
    }
    ML_PREFETCH(0);
    __syncthreads();
#define ML_BAR() do { asm volatile("s_waitcnt lgkmcnt(0)" ::: "memory"); __builtin_amdgcn_s_barrier(); asm volatile("" ::: "memory"); } while (0)
#pragma unroll 1
    for (int c = 0; c < 32; ++c) {
        const float m_prev = c_mp[c], m_new = c_mn[c], keep = c_kp[c], b_last = c_bl[c];
        if (tid < 128) {
            const float inter = bn + m_prev, mj = fmaxf(inter, bn + pmn);
            s_cs[tid] = csn; s_rj[tid] = bn - mj; s_iw[tid] = __expf(inter - mj); s_emj[tid] = __expf(-mj); s_w[tid] = __expf(b_last + csn - m_new);
        }
        ML_BAR();
#pragma unroll
        for (int i = 0; i < 8; ++i) *(LAS u32x4*)(lds + ML_KS + (krow + 16 * i) * ML_KP + pc * 16) = kreg[i];
        {
            *(LAS u32x4*)(lds + ML_VS + vrow * ML_VP + pv * 16) = vreg;
            float f[8]; unpack8(vreg, f); const float ws_ = s_w[vrow];
            u32x4 o; o.x = pk2(f[0] * ws_, f[1] * ws_); o.y = pk2(f[2] * ws_, f[3] * ws_); o.z = pk2(f[4] * ws_, f[5] * ws_); o.w = pk2(f[6] * ws_, f[7] * ws_);
            *(LAS u32x4*)(lds + ML_VW + vrow * ML_VP + pv * 16) = o;
        }
        bf16x8 qf[8];
#pragma unroll
        for (int kk = 0; kk < 8; ++kk) qf[kk] = __builtin_bit_cast(bf16x8, qn[kk]);
        unsigned short ogr[4][2];
#pragma unroll
        for (int i = 0; i < 4; ++i)
#pragma unroll
            for (int vt = 0; vt < 2; ++vt) ogr[i][vt] = R1B[ML_TOK(c, 16 * sw + 4 * g + i) * 2048 + 1024 + h * 256 + vs * 32 + 16 * vt + r];
        if (c < 31) ML_PREFETCH(c + 1);
        ML_BAR();
        {
            const float rjv = s_rj[16 * sw + r]; const int jloc = 16 * sw + r; float den1 = 0.f;
#pragma unroll 2
            for (int st = 0; st < 8; ++st) {
                if (st <= sw) {
                    f32x4 acc = {0.f, 0.f, 0.f, 0.f};
#pragma unroll
                    for (int kk = 0; kk < 8; ++kk) { const bf16x8 kf = *(const LAS bf16x8*)(lds + ML_KS + (16 * st + r) * ML_KP + (32 * kk + 8 * g) * 2); acc = __builtin_amdgcn_mfma_f32_16x16x32_bf16(kf, qf[kk], acc, 0, 0, 0); }
                    const f32x4 c4 = *(const LAS f32x4*)(s_cs + 16 * st + 4 * g);
                    float v[4];
#pragma unroll
                    for (int i = 0; i < 4; ++i) { const int s = 16 * st + 4 * g + i; const float d = (s <= jloc) ? __expf(rjv + c4[i]) : 0.f; v[i] = acc[i] * d; den1 += v[i]; }
                    u32x2 o; o.x = pk2(v[0], v[1]); o.y = pk2(v[2], v[3]);
                    *(LAS u32x2*)(lds + ML_SS + jloc * ML_SP + (16 * st + 4 * g) * 2) = o;
                } else if (st == sw + 1 && !(sw & 1)) {
                    u32x2 o = {0u, 0u}; *(LAS u32x2*)(lds + ML_SS + jloc * ML_SP + (16 * st + 4 * g) * 2) = o;
                }
            }
            den1 += __shfl_xor(den1, 16); den1 += __shfl_xor(den1, 32);
            f32x4 dacc = {0.f, 0.f, 0.f, 0.f};
#pragma unroll
            for (int kk = 0; kk < 8; ++kk) { const bf16x8 kf = *(const LAS bf16x8*)(lds + ML_KS + (128 + r) * ML_KP + (32 * kk + 8 * g) * 2); dacc = __builtin_amdgcn_mfma_f32_16x16x32_bf16(kf, qf[kk], dacc, 0, 0, 0); }
            const float d2 = dacc[0];
            if (g == 0) s_dn[jloc] = den1 + s_iw[jloc] * d2;
        }
        ML_BAR();
        {
            f32x4 n1[2], n2[2];
#pragma unroll
            for (int vt = 0; vt < 2; ++vt) { n1[vt] = (f32x4){0.f, 0.f, 0.f, 0.f}; n2[vt] = (f32x4){0.f, 0.f, 0.f, 0.f}; }
            const int nks = (sw >> 1) + 1;
#pragma unroll 1
            for (int ks = 0; ks < nks; ++ks) {
                const bf16x8 af = *(const LAS bf16x8*)(lds + ML_SS + (16 * sw + r) * ML_SP + (32 * ks + 8 * g) * 2);
                const unsigned a0 = lbase + ML_VS + (32 * ks + 8 * g + q4) * ML_VP + (4 * p4) * 2;
                bf16x8 b0, b1; tr_read2x2(a0, a0 + 32, 4 * ML_VP, b0, b1);
                n1[0] = __builtin_amdgcn_mfma_f32_16x16x32_bf16(af, b0, n1[0], 0, 0, 0); n1[1] = __builtin_amdgcn_mfma_f32_16x16x32_bf16(af, b1, n1[1], 0, 0, 0);
            }
#pragma unroll
            for (int kk = 0; kk < 8; ++kk)
#pragma unroll
                for (int vt = 0; vt < 2; ++vt) { const bf16x8 cf = *(const LAS bf16x8*)(lds + ML_CS + (16 * vt + r) * ML_CP + (32 * kk + 8 * g) * 2); n2[vt] = __builtin_amdgcn_mfma_f32_16x16x32_bf16(qf[kk], cf, n2[vt], 0, 0, 0); }
            const f32x4 iw4 = *(const LAS f32x4*)(s_iw + 16 * sw + 4 * g), dn4 = *(const LAS f32x4*)(s_dn + 16 * sw + 4 * g), em4 = *(const LAS f32x4*)(s_emj + 16 * sw + 4 * g);
#pragma unroll
            for (int i = 0; i < 4; ++i) {
                const size_t tok = ML_TOK(c, 16 * sw + 4 * g + i);
                const float inv = 1.0f / fmaxf(fabsf(dn4[i]), em4[i]);
#pragma unroll
                for (int vt = 0; vt < 2; ++vt) { const int col = h * 256 + vs * 32 + 16 * vt + r;
                    const float og = __uint_as_float(((unsigned)ogr[i][vt]) << 16);
                    const float hv = (n1[vt][i] + iw4[i] * n2[vt][i]) * inv * og;
                    Y[blk_off((int)tok, col, 1024)] = (bf16_t)f2bf(hv); }
            }
        }
        ML_BAR();
        {
#pragma unroll
            for (int a = 0; a < 3; ++a) { Cacc[a][0] *= keep; Cacc[a][1] *= keep; }
#pragma unroll 1
            for (int ks = 0; ks < 4; ++ks) {
                bf16x8 af[3], bq[2];
                { const unsigned av = lbase + ML_VW + (32 * ks + 8 * g + q4) * ML_VP + (4 * p4) * 2, ak = lbase + ML_KS + (32 * ks + 8 * g + q4) * ML_KP + (32 * w + 4 * p4) * 2;
                  tr_read4x2(av, av + 32, 4 * ML_VP, ak, ak + 32, 4 * ML_KP, af[0], af[1], bq[0], bq[1]); }
                { const f32x4 wa = *(const LAS f32x4*)(s_w + 32 * ks + 8 * g), wb = *(const LAS f32x4*)(s_w + 32 * ks + 8 * g + 4);
                  u32x4 o; o.x = pk2(wa[0], wa[1]); o.y = pk2(wa[2], wa[3]); o.z = pk2(wb[0], wb[1]); o.w = pk2(wb[2], wb[3]);
                  if (r != 0) { o.x = 0u; o.y = 0u; o.z = 0u; o.w = 0u; }
                  af[2] = __builtin_bit_cast(bf16x8, o); }
#pragma unroll
                for (int nt = 0; nt < 2; ++nt)
#pragma unroll
                    for (int mt = 0; mt < 3; ++mt) Cacc[mt][nt] = __builtin_amdgcn_mfma_f32_16x16x32_bf16(af[mt], bq[nt], Cacc[mt][nt], 0, 0, 0);
            }
#pragma unroll
            for (int mt = 0; mt < 2; ++mt)
#pragma unroll
                for (int nt = 0; nt < 2; ++nt)
#pragma unroll
                    for (int i = 0; i < 4; ++i) *(LAS bf16_t*)(lds + ML_CS + (16 * mt + 4 * g + i) * ML_CP + (32 * w + 16 * nt + r) * 2) = (bf16_t)f2bf(Cacc[mt][nt][i]);
            if (g == 0) { *(LAS bf16_t*)(lds + ML_KS + 128 * ML_KP + (32 * w + r) * 2) = (bf16_t)f2bf(Cacc[2][0][0]); *(LAS bf16_t*)(lds + ML_KS + 128 * ML_KP + (32 * w + 16 + r) * 2) = (bf16_t)f2bf(Cacc[2][1][0]); }
        }
        ML_BAR();
    }
#undef ML_BAR
#undef ML_PREFETCH
#undef ML_TOK
}
constexpr int HY_ZK = 0, HY_WB = 69632;
static_assert(HY_WB + 69632 <= LDS_BYTES, "hyena LDS map");
#define GAS __attribute__((address_space(1)))
struct HyRaw { u32x4 c; unsigned l, r; };
__device__ __forceinline__ HyRaw hy_load(const bf16_t* rowp, int tid) { HyRaw x; const GAS bf16_t* p = (const GAS bf16_t*)rowp + 8 * tid; x.c = *(const GAS u32x4*)p; x.l = p[-1]; x.r = p[8]; return x; }
__device__ __forceinline__ void hy_conv8(const HyRaw& x, int tid, float w0, float w1, float w2, float bias, float (&o)[8]) {
    float a[10];
    a[0] = tid > 0 ? __uint_as_float(x.l << 16) : 0.f; a[9] = tid < 511 ? __uint_as_float(x.r << 16) : 0.f;
    a[1] = bflo(x.c.x); a[2] = bfhi(x.c.x); a[3] = bflo(x.c.y); a[4] = bfhi(x.c.y); a[5] = bflo(x.c.z); a[6] = bfhi(x.c.z); a[7] = bflo(x.c.w); a[8] = bfhi(x.c.w);
#pragma unroll
    for (int m = 0; m < 8; ++m) o[m] = w0 * a[m] + w1 * a[m + 1] + w2 * a[m + 2] + bias;
}
__device__ __forceinline__ void hyena_item(const Ctx& C, LAS unsigned char* lds, int ch, int wv) {
    int tid = (wv << 6) | lane_id_opaque(); asm volatile("" : "+v"(tid));
    LAS f32x2* zk = (LAS f32x2*)(lds + HY_ZK); LAS f32x2* wb = (LAS f32x2*)(lds + HY_WB);
    const float* FILT = (const float*)(C.ws + WS_FILT); const bf16_t* HYb = (const bf16_t*)(C.ws + WS_HY); bf16_t* YA = (bf16_t*)(C.ws + WS_YA);
    const float* cw = C.in[3]; const float* cb = C.in[4];
    float w0[3], w1[3], w2[3], bs[3];
#pragma unroll
    for (int s = 0; s < 3; ++s) { w0[s] = cw[s * 1024 + ch]; w1[s] = cw[CONVC + s * 1024 + ch]; w2[s] = cw[2 * CONVC + s * 1024 + ch]; bs[s] = cb[s * 1024 + ch]; }
    const float hb0 = C.in[12][ch], hb1 = C.in[12][1024 + ch];
    const float* F0 = FILT + (size_t)(0 * 1024 + ch) * SEQ; const float* F1 = FILT + (size_t)(1 * 1024 + ch) * SEQ;
    const float* F2 = FILT + (size_t)(2 * 1024 + ch) * SEQ; const float* F3 = FILT + (size_t)(3 * 1024 + ch) * SEQ;
    __syncthreads();
    {
        float fa[16], fb[16];
#pragma unroll
        for (int rep = 0; rep < 8; ++rep) { const int i = tid + 512 * rep; fa[rep] = F0[i]; fb[rep] = F2[i]; }
#pragma unroll
        for (int rep = 8; rep < 16; ++rep) { const int i = tid + 512 * rep; const int j = i == SEQ ? 1 : 2 * SEQ - i; fa[rep] = F1[j]; fb[rep] = F3[j]; }
        if (tid == 0) { fa[8] = 0.f; fb[8] = 0.f; }
#pragma unroll
        for (int rep = 0; rep < 16; ++rep) { const int i = tid + 512 * rep; zk[PADI(i)] = (f32x2){fa[rep] * (1.0f / 8192.0f), fb[rep] * (1.0f / 8192.0f)}; }
    }
    fft_fwd_full(zk, tid);
    const bf16_t* rv = HYb + (size_t)ch * TOK; const bf16_t* rx1 = HYb + (size_t)(1024 + ch) * TOK; const bf16_t* rx2 = HYb + (size_t)(2048 + ch) * TOK;
    HyRaw qa = hy_load(rv, tid), qb = hy_load(rv + SEQ, tid);
#pragma unroll 1
    for (int p = 0; p < 2; ++p) {
        const int tb0 = (2 * p) * SEQ, tb1 = (2 * p + 1) * SEQ;
        f32x2 vv[8], zz[8];
        { float va[8], vb[8]; hy_conv8(qa, tid, w0[0], w1[0], w2[0], bs[0], va); hy_conv8(qb, tid, w0[0], w1[0], w2[0], bs[0], vb);
#pragma unroll
          for (int m = 0; m < 8; ++m) { vv[m].x = va[m]; vv[m].y = vb[m]; wb[PADI(8 * tid + m)] = vv[m]; } }
        qa = hy_load(rx1 + tb0, tid); qb = hy_load(rx1 + tb1, tid);
        fft_conv<0>(wb, zk, tid);
        { float xa[8], xb_[8]; hy_conv8(qa, tid, w0[1], w1[1], w2[1], bs[1], xa); hy_conv8(qb, tid, w0[1], w1[1], w2[1], bs[1], xb_);
#pragma unroll
          for (int m = 0; m < 8; ++m) { const f32x2 y = wb[PADI(8 * tid + m)]; zz[m].x = xa[m] * (y.x + vv[m].x * hb0); zz[m].y = xb_[m] * (y.y + vv[m].y * hb0); }
#pragma unroll
          for (int m = 0; m < 8; ++m) wb[PADI(8 * tid + m)] = zz[m]; }
        qa = hy_load(rx2 + tb0, tid); qb = hy_load(rx2 + tb1, tid);
        fft_conv<1>(wb, zk, tid);
        { float xa[8], xb_[8]; hy_conv8(qa, tid, w0[2], w1[2], w2[2], bs[2], xa); hy_conv8(qb, tid, w0[2], w1[2], w2[2], bs[2], xb_);
          if (p == 0) { qa = hy_load(rv + 2 * SEQ, tid); qb = hy_load(rv + 3 * SEQ, tid); }
#pragma unroll
          for (int m = 0; m < 8; ++m) { const int t = 8 * tid + m; const f32x2 y = wb[PADI(t)];
              YA[blk_off(tb0 + t, ch, 1024)] = (bf16_t)f2bf(xa[m] * (y.x + zz[m].x * hb1));
              YA[blk_off(tb1 + t, ch, 1024)] = (bf16_t)f2bf(xb_[m] * (y.y + zz[m].y * hb1)); } }
        FFT_SYNC();
    }
}
#ifndef DUP_FILT
#define DUP_FILT 0
#endif
#ifndef DUP_PRE
#define DUP_PRE 0
#endif
#ifndef DUP_P0
#define DUP_P0 0
#endif
#ifndef DUP_ML
#define DUP_ML 0
#endif
#ifndef DUP_HY
#define DUP_HY 0
#endif
#ifndef DUP_REST
#define DUP_REST 0
#endif
#ifndef DUP_GU
#define DUP_GU 0
#endif
#define XB_TMO      128
#define XB_XCNT(j)  (256  + 64 * (j))
#define XB_XSUB(j)  (1280 + 64 * (j))
#define XB_XGEN(j)  (2304 + 64 * (j))
#define XB_TOP      3328
#define XB_TOPGEN   3392
#define XCD_BAR_WORDS 3456
#define XB_SPIN_CAP (1u << 22)
__device__ __forceinline__ unsigned xb_ld(unsigned* p)              { return __hip_atomic_load(p, __ATOMIC_RELAXED, __HIP_MEMORY_SCOPE_AGENT); }
__device__ __forceinline__ unsigned xb_add(unsigned* p, unsigned v) { return __hip_atomic_fetch_add(p, v, __ATOMIC_RELAXED, __HIP_MEMORY_SCOPE_AGENT); }
__device__ __forceinline__ unsigned xb_xcc_id() { return (unsigned)__builtin_amdgcn_s_getreg((3 << 11) | 20) & 0xFu; }
#define XB_SPIN(cond, bar) do { unsigned _sp = 0; while (cond) { __builtin_amdgcn_s_sleep(1); \
    if ((++_sp & 255u) == 0u) { if (xb_ld(&(bar)[XB_TMO])) break; if (_sp > XB_SPIN_CAP) { atomicAdd(&(bar)[XB_TMO], 1u); break; } } } } while (0)
__device__ __forceinline__ void xcd_barrier_complete(unsigned* bar, unsigned x, unsigned G, unsigned& nloc, unsigned& nx) {
    unsigned sum, cnt, mine, sp = 0u;
    for (;;) {
        sum = 0u; cnt = 0u; mine = 0u;
#pragma unroll
        for (unsigned j = 0; j < 16; ++j) { const unsigned c = xb_ld(&bar[XB_XCNT(j)]); sum += c; cnt += (c > 0u) ? 1u : 0u; mine = (j == x) ? c : mine; }
        if (sum == G) break;
        __builtin_amdgcn_s_sleep(1);
        if ((++sp & 255u) == 0u) { if (xb_ld(&bar[XB_TMO])) break; if (sp > XB_SPIN_CAP) { atomicAdd(&bar[XB_TMO], 1u); break; } }
    }
    nloc = mine > 0u ? mine : 1u; nx = cnt > 0u ? cnt : 1u;
}
__device__ __forceinline__ void grid_bar(unsigned* bar, volatile LAS unsigned* st, unsigned G, int wv) {
    asm volatile("s_waitcnt vmcnt(0)" ::: "memory");
    __syncthreads();
    const int lane = lane_id_opaque();
    if (wv == 0 && lane == 0) {
        __builtin_amdgcn_s_waitcnt(0);
        const unsigned x = xb_xcc_id();
        unsigned nloc = st[0], nx = st[1];
        if (nloc == 0u) { xcd_barrier_complete(bar, x, G, nloc, nx); st[0] = nloc; st[1] = nx; }
        const unsigned old = xb_add(&bar[XB_XSUB(x)], 1u);
        const unsigned gen = old / nloc;
        if (old + 1u == (gen + 1u) * nloc) {
            __builtin_amdgcn_fence(__ATOMIC_RELEASE, "agent");
            asm volatile("s_waitcnt vmcnt(0)" ::: "memory");
            const unsigned og = xb_add(&bar[XB_TOP], 1u);
            const unsigned tg = og / nx;
            if (og + 1u == (tg + 1u) * nx) xb_add(&bar[XB_TOPGEN], 1u);
            else XB_SPIN(xb_ld(&bar[XB_TOPGEN]) == tg, bar);
            __builtin_amdgcn_fence(__ATOMIC_ACQUIRE, "agent");
            xb_add(&bar[XB_XGEN(x)], 1u);
            asm volatile("s_waitcnt vmcnt(0)" ::: "memory");
        } else {
            XB_SPIN(xb_ld(&bar[XB_XGEN(x)]) == gen, bar);
            __builtin_amdgcn_fence(__ATOMIC_ACQUIRE, "agent");
            asm volatile("s_waitcnt vmcnt(0)" ::: "memory");
        }
    }
    __syncthreads();
}
__device__ __forceinline__ void p6_finalize(const Ctx& C, int G, int bx, int wv) {
    int tid = (wv << 6) | lane_id_opaque(); asm volatile("" : "+v"(tid));
    unsigned* pcnt = (unsigned*)(C.ws + WS_PCNT); const float* ss3 = (const float*)(C.ws + WS_SS3); const float* wf = C.in[20]; float* out = C.out;
    asm volatile("s_waitcnt vmcnt(0)" ::: "memory");
    __syncthreads();
    if (tid == 0) {
        __builtin_amdgcn_fence(__ATOMIC_RELEASE, "agent"); asm volatile("s_waitcnt vmcnt(0)" ::: "memory");
        for (int i = 0; ; ++i) { const int L = i * G + bx; if (L >= 64 * 8) break; int pm, pn; pg8::tile_of(L, 64, 8, pm, pn); xb_add(&pcnt[64 * pm], 1u); }
    }
    for (int i = 0; ; ++i) {
        const int L = i * G + bx; if (L >= 64 * 8) break; int pm, pn; pg8::tile_of(L, 64, 8, pm, pn);
        if (tid == 0) { unsigned sp = 0; while (xb_ld(&pcnt[64 * pm]) < 8u) { __builtin_amdgcn_s_sleep(1); if (++sp > (1u << 20)) break; }
            __builtin_amdgcn_fence(__ATOMIC_ACQUIRE, "agent"); asm volatile("s_waitcnt vmcnt(0)" ::: "memory"); }
        __syncthreads();
        const int c4 = tid & 63; const f32x4 wv4 = *(const f32x4*)(wf + 256 * pn + 4 * c4);
#pragma unroll 1
        for (int k0 = 0; k0 < 32; k0 += 8) {
            f32x4 v[8]; float rr[8];
#pragma unroll
            for (int k = 0; k < 8; ++k) { const int row = 256 * pm + (tid >> 6) + 8 * (k0 + k);
                v[k] = *(const f32x4*)(out + (size_t)row * DM + 256 * pn + 4 * c4);
                rr[k] = __hip_atomic_load(ss3 + row, __ATOMIC_RELAXED, __HIP_MEMORY_SCOPE_AGENT); }
#pragma unroll
            for (int k = 0; k < 8; ++k) { const int row = 256 * pm + (tid >> 6) + 8 * (k0 + k); const float r = 1.0f / sqrtf(rr[k] * (1.0f / DM) + RMS_EPS);
                *(f32x4*)(out + (size_t)row * DM + 256 * pn + 4 * c4) = v[k] * r * wv4; }
        }
    }
}
struct Params { const float* in[21]; float* out; unsigned char* ws; };
__global__ void __launch_bounds__(512, 2) fwd_megakernel(Params prm) {
    extern __shared__ __attribute__((aligned(16))) unsigned char lds_raw[];
    LAS unsigned char* lds = (LAS unsigned char*)lds_raw;
    cg::grid_group grid = cg::this_grid();
    const int G = gridDim.x, bx = blockIdx.x;
    const int wv = __builtin_amdgcn_readfirstlane((int)(threadIdx.x >> 6));
    Ctx C;
#pragma unroll
    for (int i = 0; i < 21; ++i) C.in[i] = prm.in[i];
    C.out = prm.out; C.ws = prm.ws;
    unsigned char* ws = prm.ws;
    unsigned* gbar = (unsigned*)(ws + WS_BAR);
    volatile LAS unsigned* bst = (volatile LAS unsigned*)(lds + LDS_BYTES - 16);
#ifndef DUP_BAR
#define DUP_BAR 0
#endif
#define GBAR() do { for (int rb_ = 0; rb_ < 1 + DUP_BAR; ++rb_) grid_bar(gbar, bst, (unsigned)G, wv); } while (0)
    if (bx == 0) for (int i = threadIdx.x; i < XCD_BAR_WORDS; i += 512) gbar[i] = 0u;
    if (bx == 1 || G == 1) for (int i = threadIdx.x; i < 64 * 64; i += 512) ((unsigned*)(ws + WS_PCNT))[i] = 0u;
    if (threadIdx.x < 4) ((LAS unsigned*)(lds + LDS_BYTES - 16))[threadIdx.x] = 0u;
    grid.sync();
    if (threadIdx.x == 0) (void)xb_add(&gbar[XB_XCNT(xb_xcc_id())], 1u);
    for (int rep = 0; rep < 1 + DUP_P0; ++rep) { p0_prologue(C, lds, G, wv); __syncthreads(); }
    GBAR();
    for (int rep = 0; rep < 1 + DUP_FILT; ++rep) p1_filters(C, lds, G, wv);
    { HyProg P; P.K = DM; P.G = G; P.c = bx; P.W = (const bf16_t*)(ws + WS_WIN); P.X = (const bf16_t*)(ws + WS_XB); P.HY = (bf16_t*)(ws + WS_HY); P.r1 = (const float*)(ws + WS_R1S);
      pg8::gemm_stream(lds, P, wv); }
    for (int rep = 0; rep < 1 + DUP_REST; ++rep) { RestProg P; P.K = DM; P.G = G; P.c = bx; P.W = (const bf16_t*)(ws + WS_WIN); P.X = (const bf16_t*)(ws + WS_XB); P.R1A = (bf16_t*)(ws + WS_R1A); P.R1B = (bf16_t*)(ws + WS_R1B); P.R2 = (bf16_t*)prm.out; P.r1 = (const float*)(ws + WS_R1S);
      pg8::gemm_stream(lds, P, wv); }
    GBAR();
    for (int rep = 0; rep < 1 + DUP_PRE; ++rep) qk_prepass(C, G, wv);
    for (int rep = 0; rep < 1 + DUP_HY; ++rep) for (int idx = bx; idx < 1024; idx += G) { const int rd = idx >> 8, bb = idx & 255; hyena_item(C, lds, rd * 256 + (bb & 7) * 32 + (bb >> 3), wv); }
    GBAR();
    for (int rep = 0; rep < 1 + DUP_ML; ++rep) for (int item = bx; item < 256; item += G) mlstm_item(C, lds, item, wv);
    GBAR();
    { BranchProg P; P.K = 1024; P.G = G; P.c = bx; P.YA = (const bf16_t*)(ws + WS_YA); P.YBF = (const bf16_t*)(ws + WS_YBF); P.YBB = (const bf16_t*)(ws + WS_YBB);
      P.WA = (const bf16_t*)(ws + WS_WA); P.WB = (const bf16_t*)(ws + WS_WB); P.R2 = (const bf16_t*)prm.out; P.MIX = (bf16_t*)(ws + WS_MIX);
      pg8::gemm_stream(lds, P, wv); }
    GBAR();
    { ResProg P; P.K = DM; P.G = G; P.c = bx; P.A = (const bf16_t*)(ws + WS_MIX); P.B = (const bf16_t*)(ws + WS_WOUT); P.base = prm.in[0]; P.out = prm.out; P.outb = (bf16_t*)(ws + WS_X1B); P.ss = (float*)(ws + WS_SS2);
      pg8::gemm_stream(lds, P, wv); }
    GBAR();
    for (int rep = 0; rep < 1 + DUP_GU; ++rep) { GuProg P; P.K = DM; P.G = G; P.c = bx; P.X = (const bf16_t*)(ws + WS_X1B); P.W = (const bf16_t*)(ws + WS_WGU); P.HH = (bf16_t*)(ws + WS_HH); P.ss2 = (const float*)(ws + WS_SS2);
      pg8::gemm_stream(lds, P, wv); }
    GBAR();
    { ResProg P; P.K = FFH; P.G = G; P.c = bx; P.A = (const bf16_t*)(ws + WS_HH); P.B = (const bf16_t*)(ws + WS_WD); P.base = prm.out; P.out = prm.out; P.outb = nullptr; P.ss = (float*)(ws + WS_SS3);
      pg8::gemm_stream(lds, P, wv); }
    p6_finalize(C, G, bx, wv);
}

extern "C" void kernel_launch(void* const* d_in, const int* in_sizes, int n_in, void* d_out, int out_size, void* d_ws, size_t ws_size, hipStream_t stream) {
    static int grid = 0;
    if (grid == 0) {
        int dev = 0, cus = 0, per_cu = 0;
        hipGetDevice(&dev); hipDeviceGetAttribute(&cus, hipDeviceAttributeMultiprocessorCount, dev);
        if (hipFuncSetAttribute((const void*)fwd_megakernel, hipFuncAttributeMaxDynamicSharedMemorySize, LDS_BYTES) != hipSuccess) { fprintf(stderr, "kernel_launch: hipFuncSetAttribute failed\n"); grid = -1; return; }
        if (hipOccupancyMaxActiveBlocksPerMultiprocessor(&per_cu, (const void*)fwd_megakernel, 512, LDS_BYTES) != hipSuccess || per_cu < 1) { fprintf(stderr, "kernel_launch: occupancy query gave %d\n", per_cu); per_cu = 1; }
        (void)hipGetLastError();
        grid = cus * 1;
        if (n_in != 21 || ws_size < WS_END) { fprintf(stderr, "kernel_launch: unexpected n_in %d or ws %zu\n", n_in, ws_size); grid = -1; return; }
    }
    if (grid < 0) return;
    Params p{};
    for (int i = 0; i < 21; ++i) p.in[i] = (const float*)d_in[i];
    p.out = (float*)d_out; p.ws = (unsigned char*)d_ws;
    void* args[] = {&p};
    hipError_t e = hipLaunchCooperativeKernel((const void*)fwd_megakernel, dim3(grid), dim3(512), args, LDS_BYTES, stream);
    if (e != hipSuccess) fprintf(stderr, "cooperative launch failed: %s (grid %d)\n", hipGetErrorString(e), grid);
}
```

```cpp
#include <hip/hip_runtime.h>
#include <hip/hip_cooperative_groups.h>
#include <cstdio>
namespace cg = cooperative_groups;

#define LAS __attribute__((address_space(3)))
typedef unsigned short bf16_t;
typedef short bf16x8 __attribute__((ext_vector_type(8)));
typedef short bf16x4 __attribute__((ext_vector_type(4)));
typedef float f32x4 __attribute__((ext_vector_type(4)));
typedef float f32x2 __attribute__((ext_vector_type(2)));
typedef unsigned u32x4 __attribute__((ext_vector_type(4)));
typedef unsigned u32x2 __attribute__((ext_vector_type(2)));

constexpr int NB = 4, SEQ = 4096, TOK = NB * SEQ, DM = 2048, HW = 1024, MW = 1024, NHEAD = 4, DH = 256, FFH = 5632;
constexpr int CONVC = 5120, INCOLS = 11280, NFILT = 4096;
constexpr float RMS_EPS = 1e-6f;
constexpr size_t MiB = 1u << 20;
constexpr size_t WS_PCNT = 393216, WS_BAR = 262144, WS_R1S = 0, WS_SS2 = 65536, WS_SS3 = 131072, WS_G = 1 * MiB, WS_H2 = 2 * MiB;
constexpr size_t WS_WA = 4 * MiB, WS_WB = 8 * MiB, WS_WOUT = 12 * MiB, WS_WGU = 20 * MiB, WS_WD = 64 * MiB, WS_WIN = 86 * MiB, WS_XB = 130 * MiB;
constexpr size_t WS_FILT = 194 * MiB, WS_HY = 258 * MiB, WS_R1A = 354 * MiB, WS_R1B = 418 * MiB, WS_END = 494 * MiB;
constexpr size_t WS_QKP = 86 * MiB, WS_YA = 150 * MiB, WS_YBF = 354 * MiB, WS_YBB = 386 * MiB, WS_X1B = 86 * MiB, WS_MIX = 194 * MiB, WS_HH = 258 * MiB;
constexpr size_t WS_GSC = 482 * MiB;
constexpr int LDS_BYTES = 155648;

__device__ __forceinline__ unsigned f2bf(float f) { unsigned u = __float_as_uint(f); return (u + 0x7fffu + ((u >> 16) & 1u)) >> 16; }
__device__ __forceinline__ unsigned pk2(float lo, float hi) { unsigned r; asm volatile("v_cvt_pk_bf16_f32 %0, %1, %2" : "=v"(r) : "v"(lo), "v"(hi)); return r; }
__device__ __forceinline__ float bflo(unsigned w) { return __uint_as_float(w << 16); }
__device__ __forceinline__ float bfhi(unsigned w) { return __uint_as_float(w & 0xffff0000u); }
__device__ __forceinline__ float wave_sum(float v) {
#pragma unroll
    for (int o = 1; o < 64; o <<= 1) v += __shfl_xor(v, o);
    return v;
}
__device__ __forceinline__ size_t blk_off(int row, int k, int K) { return ((size_t)(row >> 7) * (size_t)(K >> 6) + (size_t)(k >> 6)) * 8192 + (size_t)((row & 127) * 64 + (k & 63)); }
__device__ __forceinline__ int lane_id_opaque() { int l; asm volatile("v_mbcnt_lo_u32_b32 %0, -1, 0\n\tv_mbcnt_hi_u32_b32 %0, -1, %0" : "=v"(l)); return l; }
__device__ __forceinline__ float sigmoidf_(float x) { return 1.0f / (1.0f + __expf(-x)); }
__device__ __forceinline__ float siluf_(float x) { return x / (1.0f + __expf(-x)); }

namespace pg8 {
constexpr int BM = 256, BK = 64, HALF = 128, HTB = HALF * BK * 2, STAGE_BYTES = 8 * HTB, NXCD = 8, WGM = 8;
__device__ __forceinline__ int lds_byte(int r, int c) { const int st = (r >> 4) * 2 + (c >> 5), rr = r & 15, cc = c & 31, ob = rr * 64 + cc * 2; return st * 1024 + (ob ^ (((ob >> 9) & 1) << 5)); }
__device__ __forceinline__ void stage_rc(int b, int& R, int& C) { const int st = b / 1024, sb = b % 1024, swz = sb ^ (((sb >> 9) & 1) << 5); R = (st >> 1) * 16 + swz / 64; C = (st & 1) * 32 + (swz % 64) / 2; }
__device__ __forceinline__ int perm32(int rho) { const int n = rho >> 4, i = rho & 15; return 8 * (i >> 2) + 4 * n + (i & 3); }
struct GUnit { const char* A; const char* B; int pm, pn, sub; };
__device__ __forceinline__ void tile_of(int L, int nM, int nN, int& pm, int& pn) {
    const int nwg = nM * nN; int wgid = L; { const int q = nwg / NXCD, r = nwg % NXCD, xcd = wgid % NXCD, off = wgid / NXCD; wgid = (xcd < r ? xcd * (q + 1) : r * (q + 1) + (xcd - r) * q) + off; }
    const int nig = WGM * nN, gid = wgid / nig, fm = gid * WGM, gsz = (nM - fm) < WGM ? (nM - fm) : WGM;
    pm = fm + ((wgid % nig) % gsz); pn = (wgid % nig) / gsz;
}
typedef f32x4 Acc[2][2][4][2];
template <class Prog>
__device__ __forceinline__ void gemm_stream(LAS unsigned char* lds, const Prog& P, int wv) {
    int tid = (wv << 6) | lane_id_opaque(); asm volatile("" : "+v"(tid));
    const int wid = __builtin_amdgcn_readfirstlane(tid >> 6), lane = tid & 63, wr = wid >> 2, wc = wid & 3, fr = lane & 15, fq = lane >> 4;
    const int K = P.K, nt = K / BK;
    unsigned voffA[2], voffB[2];
#pragma unroll
    for (int i = 0; i < 2; ++i) { int R, C; stage_rc(tid * 16 + i * 8192, R, C); const int Rb = Prog::PERM ? ((R & ~31) + perm32(R & 31)) : R;
        voffA[i] = (unsigned)(R * 64 + C) * 2u; voffB[i] = (unsigned)(Rb * 64 + C) * 2u; }
    const size_t kstep = (size_t)(HALF * BK * 2);
    const size_t hstep = (size_t)HALF * K * 2;
    const unsigned ldsw = (unsigned)wid * 1024u;
    const int aoff = lds_byte(wr * 64 + fr, fq * 8), boff = lds_byte(wc * 32 + fr, fq * 8);
#define PG8_SA(b, h) (((b) * 2 + (h)) * HTB)
#define PG8_SB(b, h) ((4 + (b) * 2 + (h)) * HTB)
#define PG8_STAGE(bufoff, gbase, voff) do { _Pragma("unroll") for (int _i = 0; _i < 2; ++_i) \
        __builtin_amdgcn_global_load_lds((const unsigned*)((const char*)(gbase) + (voff)[_i]), (LAS unsigned*)(lds + (bufoff) + ldsw + _i * 8192), 16, 0, 0); } while (0)
#define PG8_LDA(dst, b, h) do { _Pragma("unroll") for (int m = 0; m < 4; ++m) _Pragma("unroll") for (int k = 0; k < 2; ++k) dst[m][k] = *(const LAS bf16x8*)(lds + PG8_SA(b, h) + aoff + m * 2048 + k * 1024); } while (0)
#define PG8_LDB(dst, b, h) do { _Pragma("unroll") for (int n = 0; n < 2; ++n) _Pragma("unroll") for (int k = 0; k < 2; ++k) dst[n][k] = *(const LAS bf16x8*)(lds + PG8_SB(b, h) + boff + n * 2048 + k * 1024); } while (0)
#define PG8_MMA(ai, bj, At, Bt) do { __builtin_amdgcn_s_setprio(1); _Pragma("unroll") for (int m = 0; m < 4; ++m) _Pragma("unroll") for (int n = 0; n < 2; ++n) _Pragma("unroll") for (int k = 0; k < 2; ++k) \
        acc[ai][bj][m][n] = __builtin_amdgcn_mfma_f32_16x16x32_bf16(Bt[n][k], At[m][k], acc[ai][bj][m][n], 0, 0, 0); __builtin_amdgcn_s_setprio(0); } while (0)
#define PG8_WAIT_V(n) asm volatile("s_waitcnt vmcnt(" #n ")" ::: "memory")
#define PG8_WAIT_L(n) asm volatile("s_waitcnt lgkmcnt(" #n ")" ::: "memory")
#define PG8_BAR __builtin_amdgcn_s_barrier()
#define PG8_SCHED __builtin_amdgcn_sched_barrier(0)
    GUnit cur, nxt; int ui = 0;
    if (!P.next(0, cur)) return;
    f32x4 acc[2][2][4][2];
#pragma unroll
    for (int a = 0; a < 2; ++a)
#pragma unroll
        for (int b = 0; b < 2; ++b)
#pragma unroll
            for (int m = 0; m < 4; ++m)
#pragma unroll
                for (int n = 0; n < 2; ++n) acc[a][b][m][n] = (f32x4){0.f, 0.f, 0.f, 0.f};
    bf16x8 At[4][2], B0[2][2], B1[2][2];
    const char* cA = cur.A; const char* cB = cur.B;
    PG8_STAGE(PG8_SB(0, 0), cB, voffB); PG8_STAGE(PG8_SA(0, 0), cA, voffA); PG8_STAGE(PG8_SB(0, 1), cB + hstep, voffB); PG8_STAGE(PG8_SA(0, 1), cA + hstep, voffA);
    if (wr == 1) PG8_BAR;
    PG8_WAIT_V(4); PG8_BAR;
    PG8_STAGE(PG8_SB(1, 0), cB + kstep, voffB); PG8_STAGE(PG8_SA(1, 0), cA + kstep, voffA); PG8_STAGE(PG8_SB(1, 1), cB + hstep + kstep, voffB);
    PG8_WAIT_V(6); PG8_BAR;
    for (;;) {
        const bool has_next = P.next(ui + 1, nxt);
        const char* nA = has_next ? nxt.A : cA; const char* nB = has_next ? nxt.B : cB;
        for (int t = 0; t < nt; t += 2) {
            const bool last = (t == nt - 2);
            const char* a1 = cA + (size_t)(t + 1) * kstep;
            const char* a2 = last ? nA : cA + (size_t)(t + 2) * kstep; const char* b2 = last ? nB : cB + (size_t)(t + 2) * kstep;
            const char* a3 = a2 + kstep; const char* b3 = b2 + kstep;
            PG8_LDB(B0, 0, 0); PG8_SCHED; PG8_LDA(At, 0, 0); PG8_STAGE(PG8_SA(1, 1), a1 + hstep, voffA);
            PG8_WAIT_L(8); PG8_BAR; PG8_WAIT_L(0); PG8_MMA(0, 0, At, B0); PG8_BAR; PG8_SCHED;
            PG8_LDB(B1, 0, 1); PG8_STAGE(PG8_SB(0, 0), b2, voffB);
            PG8_BAR; PG8_WAIT_L(0); PG8_MMA(0, 1, At, B1); PG8_BAR;
            PG8_LDA(At, 0, 1); PG8_STAGE(PG8_SA(0, 0), a2, voffA);
            PG8_BAR; PG8_WAIT_L(0); PG8_MMA(1, 0, At, B0); PG8_BAR; PG8_SCHED;
            PG8_STAGE(PG8_SB(0, 1), b2 + hstep, voffB);
            PG8_WAIT_V(6); PG8_BAR; PG8_MMA(1, 1, At, B1); PG8_BAR;
            PG8_LDB(B0, 1, 0); PG8_SCHED; PG8_LDA(At, 1, 0); PG8_STAGE(PG8_SA(0, 1), a2 + hstep, voffA);
            PG8_WAIT_L(8); PG8_BAR; PG8_WAIT_L(0); PG8_MMA(0, 0, At, B0); PG8_BAR; PG8_SCHED;
            PG8_LDB(B1, 1, 1); PG8_STAGE(PG8_SB(1, 0), b3, voffB);
            PG8_BAR; PG8_WAIT_L(0); PG8_MMA(0, 1, At, B1); PG8_BAR;
            PG8_LDA(At, 1, 1); PG8_STAGE(PG8_SA(1, 0), a3, voffA);
            PG8_BAR; PG8_WAIT_L(0); PG8_MMA(1, 0, At, B0); PG8_BAR; PG8_SCHED;
            PG8_STAGE(PG8_SB(1, 1), b3 + hstep, voffB);
            PG8_WAIT_V(6); PG8_BAR; PG8_MMA(1, 1, At, B1); PG8_BAR;
        }
        P.epi(acc, cur, wr, wc, fr, fq);
        if (!has_next) break;
        cur = nxt; cA = nA; cB = nB; ++ui;
    }
    PG8_WAIT_V(0);
    if (wr == 0) PG8_BAR;
    PG8_BAR;
#undef PG8_SA
#undef PG8_SB
#undef PG8_STAGE
#undef PG8_LDA
#undef PG8_LDB
#undef PG8_MMA
#undef PG8_WAIT_V
#undef PG8_WAIT_L
#undef PG8_BAR
#undef PG8_SCHED
}
__device__ __forceinline__ void zero_acc(Acc& acc) {
#pragma unroll
    for (int a = 0; a < 2; ++a)
#pragma unroll
        for (int b = 0; b < 2; ++b)
#pragma unroll
            for (int m = 0; m < 4; ++m)
#pragma unroll
                for (int n = 0; n < 2; ++n) acc[a][b][m][n] = (f32x4){0.f, 0.f, 0.f, 0.f};
}
}
using pg8::GUnit; using pg8::Acc;
__device__ __forceinline__ void unpack8(u32x4 w, float (&f)[8]) { f[0] = bflo(w.x); f[1] = bfhi(w.x); f[2] = bflo(w.y); f[3] = bfhi(w.y); f[4] = bflo(w.z); f[5] = bfhi(w.z); f[6] = bflo(w.w); f[7] = bfhi(w.w); }
struct HyProg {
    static constexpr bool PERM = true; int K, G, c; const bf16_t* W; const bf16_t* X; bf16_t* HY; const float* r1;
    __device__ __forceinline__ bool next(int i, GUnit& u) const { const int L = i * G + c; if (L >= 12 * 64) return false; pg8::tile_of(L, 12, 64, u.pm, u.pn);
        u.A = (const char*)(W + (size_t)u.pm * 256 * DM); u.B = (const char*)(X + (size_t)u.pn * 256 * DM); u.sub = 0; return true; }
    __device__ __forceinline__ void epi(Acc& acc, const GUnit& u, int wr, int wc, int fr, int fq) const {
        const int row0 = u.pm * 256 + wr * 64 + fr, col0 = u.pn * 256 + wc * 32 + 8 * fq;
        f32x4 sc[2][2];
#pragma unroll
        for (int bj = 0; bj < 2; ++bj) { sc[bj][0] = *(const f32x4*)(r1 + col0 + bj * 128); sc[bj][1] = *(const f32x4*)(r1 + col0 + bj * 128 + 4); }
#pragma unroll
        for (int ai = 0; ai < 2; ++ai)
#pragma unroll
            for (int m = 0; m < 4; ++m) { bf16_t* rowp = HY + (size_t)(row0 + ai * 128 + m * 16) * TOK + col0;
#pragma unroll
                for (int bj = 0; bj < 2; ++bj) { const f32x4 v0 = acc[ai][bj][m][0] * sc[bj][0], v1 = acc[ai][bj][m][1] * sc[bj][1];
                    u32x4 w; w.x = pk2(v0[0], v0[1]); w.y = pk2(v0[2], v0[3]); w.z = pk2(v1[0], v1[1]); w.w = pk2(v1[2], v1[3]);
                    *(u32x4*)(rowp + bj * 128) = w; } }
        pg8::zero_acc(acc);
    }
};
struct RestProg {
    static constexpr bool PERM = true; int K, G, c; const bf16_t* W; const bf16_t* X; bf16_t* R1A; bf16_t* R1B; bf16_t* R2; const float* r1;
    __device__ __forceinline__ bool next(int i, GUnit& u) const { const int L = i * G + c; if (L >= 64 * 32) return false; pg8::tile_of(L, 64, 32, u.pm, u.pn);
        u.A = (const char*)(X + (size_t)u.pm * 256 * DM); u.B = (const char*)(W + (size_t)(3072 + u.pn * 256) * DM); u.sub = 0; return true; }
    __device__ __forceinline__ void epi(Acc& acc, const GUnit& u, int wr, int wc, int fr, int fq) const {
        const int row0 = u.pm * 256 + wr * 64 + fr; const bool sg = u.pn >= 12;
        bf16_t* base = u.pn < 8 ? R1A + u.pn * 256 : (u.pn < 16 ? R1B + (u.pn - 8) * 256 : R2 + (u.pn - 16) * 256);
        const int pitch = u.pn < 16 ? 2048 : 4096;
        const int col0 = wc * 32 + 8 * fq;
        float rs[2][4];
#pragma unroll
        for (int ai = 0; ai < 2; ++ai)
#pragma unroll
            for (int m = 0; m < 4; ++m) rs[ai][m] = r1[row0 + ai * 128 + m * 16];
#pragma unroll
        for (int ai = 0; ai < 2; ++ai)
#pragma unroll
            for (int m = 0; m < 4; ++m) { const int row = row0 + ai * 128 + m * 16; const float s = rs[ai][m]; bf16_t* rowp = base + (size_t)row * pitch + col0;
#pragma unroll
                for (int bj = 0; bj < 2; ++bj) { f32x4 v0 = acc[ai][bj][m][0] * s, v1 = acc[ai][bj][m][1] * s;
                    if (sg) {
#pragma unroll
                        for (int j = 0; j < 4; ++j) { v0[j] = sigmoidf_(v0[j]); v1[j] = sigmoidf_(v1[j]); } }
                    u32x4 w; w.x = pk2(v0[0], v0[1]); w.y = pk2(v0[2], v0[3]); w.z = pk2(v1[0], v1[1]); w.w = pk2(v1[2], v1[3]);
                    *(u32x4*)(rowp + bj * 128) = w; } }
        pg8::zero_acc(acc);
    }
};
struct BranchProg {
    static constexpr bool PERM = true; int K, G, c; const bf16_t *YA, *YBF, *YBB, *WA, *WB; const bf16_t* R2; bf16_t* MIX;
    __device__ __forceinline__ bool next(int i, GUnit& u) const { const int ti = i / 3, sub = i - 3 * ti; const int L = ti * G + c; if (L >= 64 * 8) return false; pg8::tile_of(L, 64, 8, u.pm, u.pn);
        const bf16_t* a = sub == 0 ? YA : (sub == 1 ? YBF : YBB); const bf16_t* b = sub == 0 ? WA : WB;
        u.A = (const char*)(a + (size_t)u.pm * 256 * 1024); u.B = (const char*)(b + (size_t)u.pn * 256 * 1024); u.sub = sub; return true; }
    __device__ __forceinline__ void epi(Acc& acc, const GUnit& u, int wr, int wc, int fr, int fq) const {
        if (u.sub == 1) return;
        const int row0 = u.pm * 256 + wr * 64 + fr, col0 = u.pn * 256 + wc * 32 + 8 * fq;
#pragma unroll
        for (int ai = 0; ai < 2; ++ai) {
            u32x4 gbw[4][2], gaw[4][2];
#pragma unroll
            for (int m = 0; m < 4; ++m)
#pragma unroll
                for (int bj = 0; bj < 2; ++bj) { const bf16_t* gp = R2 + (size_t)(row0 + ai * 128 + m * 16) * 4096 + col0 + bj * 128;
                    gbw[m][bj] = *(const u32x4*)(gp + 2048); if (u.sub == 0) gaw[m][bj] = *(const u32x4*)gp; else gaw[m][bj] = gbw[m][bj]; }
#pragma unroll
            for (int m = 0; m < 4; ++m) { const int row = row0 + ai * 128 + m * 16;
#pragma unroll
                for (int bj = 0; bj < 2; ++bj) {
                    float gb[8], ga[8]; unpack8(gbw[m][bj], gb); unpack8(gaw[m][bj], ga);
                    if (u.sub == 0) {
#pragma unroll
                        for (int j = 0; j < 4; ++j) { acc[ai][bj][m][0][j] *= ga[j] / fmaxf(gb[j], 1e-30f); acc[ai][bj][m][1][j] *= ga[4 + j] / fmaxf(gb[4 + j], 1e-30f); }
                    } else {
                        f32x4 v0 = acc[ai][bj][m][0], v1 = acc[ai][bj][m][1];
#pragma unroll
                        for (int j = 0; j < 4; ++j) { v0[j] *= fmaxf(gb[j], 1e-30f); v1[j] *= fmaxf(gb[4 + j], 1e-30f); }
                        u32x4 w; w.x = pk2(v0[0], v0[1]); w.y = pk2(v0[2], v0[3]); w.z = pk2(v1[0], v1[1]); w.w = pk2(v1[2], v1[3]);
                        *(u32x4*)(MIX + blk_off(row, col0 + bj * 128, DM)) = w;
                    } } }
        }
        if (u.sub == 2) pg8::zero_acc(acc);
    }
};
struct ResProg {
    static constexpr bool PERM = false; int K, G, c; const bf16_t* A; const bf16_t* B; const float* base; const bf16_t* base16; float* out; bf16_t* outb; float* ss;
    __device__ __forceinline__ bool next(int i, GUnit& u) const { const int L = i * G + c; if (L >= 64 * 8) return false; pg8::tile_of(L, 64, 8, u.pm, u.pn);
        u.A = (const char*)(A + (size_t)u.pm * 256 * K); u.B = (const char*)(B + (size_t)u.pn * 256 * K); u.sub = 0; return true; }
    __device__ __forceinline__ void epi(Acc& acc, const GUnit& u, int wr, int wc, int fr, int fq) const {
        const int row0 = u.pm * 256 + wr * 64 + fr, col0 = u.pn * 256 + wc * 32 + 4 * fq;
#pragma unroll
        for (int ai = 0; ai < 2; ++ai) {
            f32x4 bs[4][2][2];
#pragma unroll
            for (int m = 0; m < 4; ++m)
#pragma unroll
                for (int bj = 0; bj < 2; ++bj)
#pragma unroll
                    for (int n = 0; n < 2; ++n) { const int row = row0 + ai * 128 + m * 16, col = col0 + bj * 128 + n * 16;
                        if (base16) { const u32x2 w = *(const u32x2*)(base16 + blk_off(row, col, DM)); bs[m][bj][n] = (f32x4){bflo(w.x), bfhi(w.x), bflo(w.y), bfhi(w.y)}; }
                        else bs[m][bj][n] = *(const f32x4*)(base + (size_t)row * DM + col); }
#pragma unroll
            for (int m = 0; m < 4; ++m) { const int row = row0 + ai * 128 + m * 16; const size_t off = (size_t)row * DM + col0; float s = 0.f;
#pragma unroll
                for (int bj = 0; bj < 2; ++bj)
#pragma unroll
                    for (int n = 0; n < 2; ++n) { const f32x4 o = bs[m][bj][n] + acc[ai][bj][m][n];
                        if (out) *(f32x4*)(out + off + bj * 128 + n * 16) = o;
                        s += (o[0] * o[0] + o[1] * o[1]) + (o[2] * o[2] + o[3] * o[3]);
                        if (outb) { u32x2 w; w.x = pk2(o[0], o[1]); w.y = pk2(o[2], o[3]); *(u32x2*)(outb + blk_off(row, col0 + bj * 128 + n * 16, DM)) = w; } }
                s += __shfl_xor(s, 16); s += __shfl_xor(s, 32);
                if (fq == 0) unsafeAtomicAdd(ss + row, s); }
        }
        pg8::zero_acc(acc);
    }
};
struct GuProg {
    static constexpr bool PERM = true; int K, G, c; const bf16_t* X; const bf16_t* W; bf16_t* HH; const float* ss2;
    __device__ __forceinline__ bool next(int i, GUnit& u) const { const int L = i * G + c; if (L >= 64 * 44) return false; pg8::tile_of(L, 64, 44, u.pm, u.pn);
        u.A = (const char*)(X + (size_t)u.pm * 256 * DM); u.B = (const char*)(W + (size_t)u.pn * 256 * DM); u.sub = 0; return true; }
    __device__ __forceinline__ void epi(Acc& acc, const GUnit& u, int wr, int wc, int fr, int fq) const {
        const int row0 = u.pm * 256 + wr * 64 + fr, col0 = u.pn * 128 + wc * 32 + 8 * fq;
        float sq[2][4];
#pragma unroll
        for (int ai = 0; ai < 2; ++ai)
#pragma unroll
            for (int m = 0; m < 4; ++m) sq[ai][m] = ss2[row0 + ai * 128 + m * 16];
#pragma unroll
        for (int ai = 0; ai < 2; ++ai)
#pragma unroll
            for (int m = 0; m < 4; ++m) { const int row = row0 + ai * 128 + m * 16; const float r2 = 1.0f / sqrtf(sq[ai][m] * (1.0f / DM) + RMS_EPS);
                float hv[8];
#pragma unroll
                for (int n = 0; n < 2; ++n)
#pragma unroll
                    for (int j = 0; j < 4; ++j) { const float g = acc[ai][0][m][n][j] * r2, uu = acc[ai][1][m][n][j] * r2; hv[4 * n + j] = siluf_(g) * uu; }
                u32x4 w; w.x = pk2(hv[0], hv[1]); w.y = pk2(hv[2], hv[3]); w.z = pk2(hv[4], hv[5]); w.w = pk2(hv[6], hv[7]);
                *(u32x4*)(HH + blk_off(row, col0, FFH)) = w; }
        pg8::zero_acc(acc);
    }
};
struct Ctx {
    const float* in[21]; float* out; unsigned char* ws;
};
struct TpItem { const float* W; const float* ks; bf16_t* WT; int Nsrc, K, dst_row0, src_col0, kb; };
__device__ __forceinline__ TpItem tp_decode(const Ctx& C, int it) {
    constexpr int I_IN = 32 * 352, I_A = 16 * 64, I_O = 32 * 64, I_GU = 32 * 352;
    unsigned char* ws = C.ws; TpItem t; int r = it;
    if (r < I_IN) { const int nb = r % 352, n0 = nb * 32; t.W = C.in[2]; t.ks = C.in[1]; t.WT = (bf16_t*)(ws + WS_WIN); t.Nsrc = INCOLS; t.K = DM; t.dst_row0 = n0; t.src_col0 = n0 < 7168 ? n0 : n0 + 16; t.kb = r / 352; return t; } r -= I_IN;
    if (r < I_A) { t.W = C.in[14]; t.ks = nullptr; t.WT = (bf16_t*)(ws + WS_WA); t.Nsrc = DM; t.K = HW; t.dst_row0 = (r % 64) * 32; t.src_col0 = t.dst_row0; t.kb = r / 64; return t; } r -= I_A;
    if (r < I_A) { t.W = C.in[15]; t.ks = nullptr; t.WT = (bf16_t*)(ws + WS_WB); t.Nsrc = DM; t.K = MW; t.dst_row0 = (r % 64) * 32; t.src_col0 = t.dst_row0; t.kb = r / 64; return t; } r -= I_A;
    if (r < I_O) { t.W = C.in[16]; t.ks = nullptr; t.WT = (bf16_t*)(ws + WS_WOUT); t.Nsrc = DM; t.K = DM; t.dst_row0 = (r % 64) * 32; t.src_col0 = t.dst_row0; t.kb = r / 64; return t; } r -= I_O;
    if (r < I_GU) { const int nb = r % 352, n0 = nb * 32; const int pn = n0 >> 8, half = (n0 >> 7) & 1, i = n0 & 127;
        t.W = C.in[18]; t.ks = C.in[17]; t.WT = (bf16_t*)(ws + WS_WGU); t.Nsrc = 2 * FFH; t.K = DM; t.dst_row0 = n0; t.src_col0 = half * FFH + 128 * pn + i; t.kb = r / 352; return t; } r -= I_GU;
    t.W = C.in[19]; t.ks = nullptr; t.WT = (bf16_t*)(ws + WS_WD); t.Nsrc = DM; t.K = FFH; t.dst_row0 = (r % 64) * 32; t.src_col0 = t.dst_row0; t.kb = r / 64; return t;
}
__device__ __forceinline__ void tp_load(const TpItem& t, int lane, float (&tv)[32], float (&sv)[32]) {
    const int k0 = 64 * t.kb; const float* wp = t.W + (size_t)(k0 + (lane >> 5)) * t.Nsrc + t.src_col0 + (lane & 31);
#pragma unroll
    for (int i = 0; i < 32; ++i) tv[i] = wp[(size_t)(2 * i) * t.Nsrc];
    const float* kp = t.ks ? t.ks + k0 + (lane >> 5) : nullptr;
#pragma unroll
    for (int i = 0; i < 32; ++i) sv[i] = kp ? kp[2 * i] : 1.0f;
}
__device__ __forceinline__ void p0_prologue(const Ctx& C, LAS unsigned char* lds, int G, int wv) {
    int tid = (wv << 6) | lane_id_opaque(); asm volatile("" : "+v"(tid));
    const int lane = tid & 63, wave = __builtin_amdgcn_readfirstlane(tid >> 6);
    const int gw = blockIdx.x * 8 + wave, NGW = G * 8;
    unsigned char* ws = C.ws;
    LAS float* scr = (LAS float*)(lds + wave * 8704);
    {
        constexpr int NIT = 32 * 352 + 2 * 16 * 64 + 32 * 64 + 32 * 352 + 88 * 64;
        float tv[32], sv[32]; TpItem cur, nxt; int it = gw;
        if (it < NIT) { cur = tp_decode(C, it); tp_load(cur, lane, tv, sv); }
        while (it < NIT) {
#pragma unroll
            for (int i = 0; i < 32; ++i) scr[(2 * i + (lane >> 5)) * 33 + (lane & 31)] = tv[i] * sv[i];
            asm volatile("s_waitcnt lgkmcnt(0)" ::: "memory");
            const int nit = it + NGW;
            if (nit < NIT) { nxt = tp_decode(C, nit); tp_load(nxt, lane, tv, sv); }
            const int c = lane & 7, k0 = 64 * cur.kb;
#pragma unroll
            for (int j = 0; j < 4; ++j) { const int n = (lane >> 3) + 8 * j; const LAS float* sp = scr + (8 * c) * 33 + n;
                u32x4 o; o.x = pk2(sp[0 * 33], sp[1 * 33]); o.y = pk2(sp[2 * 33], sp[3 * 33]); o.z = pk2(sp[4 * 33], sp[5 * 33]); o.w = pk2(sp[6 * 33], sp[7 * 33]);
                *(u32x4*)(cur.WT + blk_off(cur.dst_row0 + n, k0 + 8 * c, cur.K)) = o; }
            asm volatile("s_waitcnt lgkmcnt(0)" ::: "memory");
            cur = nxt; it = nit;
        }
    }
    for (int i = blockIdx.x * 512 + tid; i < TOK; i += G * 512) { ((float*)(ws + WS_SS2))[i] = 0.f; ((float*)(ws + WS_SS3))[i] = 0.f; }
    {
        const float* w1 = C.in[5]; const float* b1 = C.in[6]; const float* f1 = C.in[7]; const float* w2 = C.in[8]; const float* b2 = C.in[9]; const float* f2 = C.in[10];
        float* h2 = (float*)(ws + WS_H2);
        for (int t = gw; t < SEQ; t += NGW) {
            const float tl = (float)t / (float)(SEQ - 1);
            const float omega = 6.283185307179586f * (float)t / (float)SEQ;
            float a = b1[lane] + tl * w1[lane];
            float sn, cs;
            { const int bi = lane & 15; const float fr = 1e-4f + (float)bi * ((15.0f - 1e-4f) / 15.0f); sincosf(omega * fr, &sn, &cs); }
#pragma unroll
            for (int i = 0; i < 16; ++i) a += __shfl(cs, i) * w1[(1 + i) * 64 + lane] - __shfl(sn, i) * w1[(17 + i) * 64 + lane];
            const float h1 = sinf(f1[lane] * a);
            float a2 = b2[lane];
#pragma unroll 8
            for (int i = 0; i < 64; ++i) a2 += __shfl(h1, i) * w2[i * 64 + lane];
            h2[t * 64 + lane] = sinf(f2[lane] * a2);
        }
    }
    __syncthreads();
    {
        constexpr int WGP = 2056;
        LAS bf16_t* wgb = (LAS bf16_t*)lds;
        const float* w_in = C.in[2]; const float* nw = C.in[1];
#pragma unroll 1
        for (int i0 = tid; i0 < DM * 16; i0 += 512 * 16) { float tw[16], tn[16];
#pragma unroll
            for (int u = 0; u < 16; ++u) { const int i = i0 + 512 * u, k = i >> 4, g = i & 15; tw[u] = w_in[(size_t)k * INCOLS + 7168 + g]; tn[u] = nw[k]; }
#pragma unroll
            for (int u = 0; u < 16; ++u) { const int i = i0 + 512 * u, k = i >> 4, g = i & 15; wgb[g * WGP + k] = (bf16_t)f2bf(tw[u] * tn[u]); } }
        __syncthreads();
        const float* x = C.in[0]; bf16_t* xb = (bf16_t*)(ws + WS_XB); float* r1 = (float*)(ws + WS_R1S); float* Gt = (float*)(ws + WS_G); const float* gbias = C.in[13];
        const int r = lane & 15, g = lane >> 4; const bool act = r < 8;
        for (int rb = gw; rb < TOK / 8; rb += NGW) {
            const int row = rb * 8 + (r & 7);
            const float* xp = x + (size_t)row * DM + 8 * g;
            f32x4 acc = {0.f, 0.f, 0.f, 0.f}; float ss = 0.f;
#pragma unroll 1
            for (int k8 = 0; k8 < 64; k8 += 8) {
                f32x4 la[8], lb[8];
#pragma unroll
                for (int u = 0; u < 8; ++u) { la[u] = *(const f32x4*)(xp + 32 * (k8 + u)); lb[u] = *(const f32x4*)(xp + 32 * (k8 + u) + 4); }
#pragma unroll
                for (int u = 0; u < 8; ++u) { const int kk = k8 + u; const f32x4 a = la[u], b = lb[u];
                    ss += ((a.x * a.x + a.y * a.y) + (a.z * a.z + a.w * a.w)) + ((b.x * b.x + b.y * b.y) + (b.z * b.z + b.w * b.w));
                    u32x4 o; o.x = pk2(a.x, a.y); o.y = pk2(a.z, a.w); o.z = pk2(b.x, b.y); o.w = pk2(b.z, b.w);
                    *(u32x4*)(xb + blk_off(row, 32 * kk + 8 * g, DM)) = o;
                    if (!act) { o.x = 0u; o.y = 0u; o.z = 0u; o.w = 0u; }
                    const bf16x8 bw = *(const LAS bf16x8*)(wgb + r * WGP + 32 * kk + 8 * g);
                    acc = __builtin_amdgcn_mfma_f32_16x16x32_bf16(__builtin_bit_cast(bf16x8, o), bw, acc, 0, 0, 0); }
            }
            ss += __shfl_xor(ss, 16); ss += __shfl_xor(ss, 32);
            const float rinv = 1.0f / sqrtf(ss * (1.0f / DM) + RMS_EPS);
            const float gb = gbias[r];
#pragma unroll
            for (int i = 0; i < 4; ++i) { const int m = 4 * g + i; const float rv = __shfl(rinv, m & 7); if (g < 2) Gt[(size_t)(rb * 8 + m) * 16 + r] = acc[i] * rv + gb; }
            if (lane < 8) r1[rb * 8 + lane] = rinv;
        }
    }
}
__device__ __forceinline__ void p1_filters(const Ctx& C, LAS unsigned char* lds, int G, int wv) {
    int tid = (wv << 6) | lane_id_opaque(); asm volatile("" : "+v"(tid));
    const int lane = tid & 63, w = tid >> 6, r = lane & 15, g = lane >> 4;
    const float* w3 = C.in[11]; const float* h2 = (const float*)(C.ws + WS_H2); float* FILT = (float*)(C.ws + WS_FILT);
    for (int item = blockIdx.x; item < 256; item += G) {
        const int n0 = 64 * (item >> 2), t0 = 1024 * (item & 3) + 128 * w;
        bf16x8 af[4][2];
#pragma unroll
        for (int mt = 0; mt < 4; ++mt)
#pragma unroll
            for (int ks = 0; ks < 2; ++ks) { float v[8];
#pragma unroll
                for (int e = 0; e < 8; ++e) v[e] = w3[(size_t)(32 * ks + 8 * g + e) * NFILT + n0 + 16 * mt + r];
                u32x4 o; o.x = pk2(v[0], v[1]); o.y = pk2(v[2], v[3]); o.z = pk2(v[4], v[5]); o.w = pk2(v[6], v[7]); af[mt][ks] = __builtin_bit_cast(bf16x8, o); }
        float dl[4][4];
#pragma unroll
        for (int mt = 0; mt < 4; ++mt)
#pragma unroll
            for (int i = 0; i < 4; ++i) { const int ch = (n0 + 16 * mt + 4 * g + i) & 1023; const float mind = -3.0701134573253945f, maxd = -15.350567286626973f;
                dl[mt][i] = fabsf(mind + (float)ch * ((maxd - mind) / 1023.0f)); }
        bf16x8 bfr[8][2];
#pragma unroll
        for (int nt = 0; nt < 8; ++nt) { const int t = t0 + 16 * nt + r;
#pragma unroll
            for (int ks = 0; ks < 2; ++ks) { const f32x4 a = *(const f32x4*)(h2 + (size_t)t * 64 + 32 * ks + 8 * g), b = *(const f32x4*)(h2 + (size_t)t * 64 + 32 * ks + 8 * g + 4);
                u32x4 o; o.x = pk2(a.x, a.y); o.y = pk2(a.z, a.w); o.z = pk2(b.x, b.y); o.w = pk2(b.z, b.w); bfr[nt][ks] = __builtin_bit_cast(bf16x8, o); } }
#pragma unroll
        for (int nt = 0; nt < 8; ++nt) {
            const int t = t0 + 16 * nt + r;
            const float tl = (float)t / (float)(SEQ - 1);
#pragma unroll
            for (int mt = 0; mt < 4; ++mt) {
                f32x4 acc = {0.f, 0.f, 0.f, 0.f};
                acc = __builtin_amdgcn_mfma_f32_16x16x32_bf16(af[mt][0], bfr[nt][0], acc, 0, 0, 0);
                acc = __builtin_amdgcn_mfma_f32_16x16x32_bf16(af[mt][1], bfr[nt][1], acc, 0, 0, 0);
#pragma unroll
                for (int i = 0; i < 4; ++i) FILT[(size_t)(n0 + 16 * mt + 4 * g + i) * SEQ + t] = acc[i] * expf(-tl * dl[mt][i]);
            }
        }
    }
}
__device__ __forceinline__ void p7_final(const Ctx& C, int G, int wv) {
    int tid = (wv << 6) | lane_id_opaque(); asm volatile("" : "+v"(tid));
    const int lane = tid & 63, wave = tid >> 6, gw = blockIdx.x * 8 + wave, NGW = G * 8;
    const float* ss3 = (const float*)(C.ws + WS_SS3); const float* wf = C.in[20];
    f32x4 w[8];
#pragma unroll
    for (int j = 0; j < 8; ++j) w[j] = ((const f32x4*)wf)[64 * j + lane];
    for (int row = gw; row < TOK; row += 2 * NGW) {
        const int row2 = row + NGW;
        const bool has2 = row2 < TOK;
        const float r = 1.0f / sqrtf(ss3[row] * (1.0f / DM) + RMS_EPS), r2 = has2 ? 1.0f / sqrtf(ss3[row2] * (1.0f / DM) + RMS_EPS) : 0.f;
        f32x4* p = (f32x4*)(C.out + (size_t)row * DM) + lane; f32x4* p2 = (f32x4*)(C.out + (size_t)(has2 ? row2 : row) * DM) + lane;
        f32x4 v[8], u[8];
#pragma unroll
        for (int j = 0; j < 8; ++j) { v[j] = p[64 * j]; u[j] = p2[64 * j]; }
#pragma unroll
        for (int j = 0; j < 8; ++j) p[64 * j] = v[j] * r * w[j];
        if (has2) {
#pragma unroll
            for (int j = 0; j < 8; ++j) p2[64 * j] = u[j] * r2 * w[j]; }
    }
}
#ifndef FFT_HOST
#define FFT_DEV __device__ __forceinline__
#define FFT_PTR LAS f32x2*
#define FFT_SIN(x) __builtin_amdgcn_sinf(x)
#define FFT_COS(x) __builtin_amdgcn_cosf(x)
#else
#define FFT_DEV static inline
#define FFT_PTR f32x2*
#define FFT_SIN(x) sinf(6.283185307179586f * (x))
#define FFT_COS(x) cosf(6.283185307179586f * (x))
#endif
#define PADI(i) ((i) + ((i) >> 4))
FFT_DEV f32x2 cmul(f32x2 a, f32x2 b) { f32x2 r; r.x = a.x * b.x - a.y * b.y; r.y = a.x * b.y + a.y * b.x; return r; }
FFT_DEV f32x2 cmulc(f32x2 a, f32x2 b) { f32x2 r; r.x = a.x * b.x + a.y * b.y; r.y = a.y * b.x - a.x * b.y; return r; }
FFT_DEV f32x2 twid(float frac) { f32x2 r; r.x = FFT_COS(frac); r.y = -FFT_SIN(frac); return r; }
template <int M, int CJ> FFT_DEV f32x2 rot8(f32x2 d) {
    const float R = 0.70710678118654752f; f32x2 r;
    if (M == 0) return d;
    if (M == 2) { if (!CJ) { r.x = d.y; r.y = -d.x; } else { r.x = -d.y; r.y = d.x; } return r; }
    if (M == 1) { if (!CJ) { r.x = R * (d.x + d.y); r.y = R * (d.y - d.x); } else { r.x = R * (d.x - d.y); r.y = R * (d.x + d.y); } return r; }
    if (!CJ) { r.x = R * (d.y - d.x); r.y = -R * (d.x + d.y); } else { r.x = -R * (d.x + d.y); r.y = R * (d.x - d.y); } return r;
}
template <int INV, int ZHI, int LOW> FFT_DEV void fft_r8_pass(FFT_PTR buf, int s, int ls  , int tid) {
#pragma unroll 1
    for (int rep = 0; rep < 2; ++rep) {
        const int bf = tid + rep * 512, j = bf & (s - 1), blk = bf >> ls, base = blk * 8 * s + j;
        f32x2 x[8];
#pragma unroll
        for (int m = 0; m < (ZHI ? 4 : 8); ++m) x[m] = buf[PADI(base + m * s)];
        f32x2 w1 = twid((float)j / (float)(8 * s));
        f32x2 w2 = cmul(w1, w1), w4 = cmul(w2, w2);
        if (!INV) {
            if (ZHI) {
                x[4] = cmul(x[0], w1); x[5] = cmul(rot8<1, 0>(x[1]), w1); x[6] = cmul(rot8<2, 0>(x[2]), w1); x[7] = cmul(rot8<3, 0>(x[3]), w1);
            } else {
                { f32x2 a = x[0], b = x[4]; x[0] = a + b; x[4] = cmul(a - b, w1); }
                { f32x2 a = x[1], b = x[5]; x[1] = a + b; x[5] = cmul(rot8<1, 0>(a - b), w1); }
                { f32x2 a = x[2], b = x[6]; x[2] = a + b; x[6] = cmul(rot8<2, 0>(a - b), w1); }
                { f32x2 a = x[3], b = x[7]; x[3] = a + b; x[7] = cmul(rot8<3, 0>(a - b), w1); }
            }
#pragma unroll
            for (int h = 0; h < 8; h += 4) {
                { f32x2 a = x[h], b = x[h + 2]; x[h] = a + b; x[h + 2] = cmul(a - b, w2); }
                { f32x2 a = x[h + 1], b = x[h + 3]; x[h + 1] = a + b; x[h + 3] = cmul(rot8<2, 0>(a - b), w2); }
            }
#pragma unroll
            for (int m = 0; m < 8; m += 2) { f32x2 a = x[m], b = x[m + 1]; x[m] = a + b; x[m + 1] = cmul(a - b, w4); }
        } else {
#pragma unroll
            for (int m = 0; m < 8; m += 2) { f32x2 a = x[m], b = cmulc(x[m + 1], w4); x[m] = a + b; x[m + 1] = a - b; }
#pragma unroll
            for (int h = 0; h < 8; h += 4) {
                { f32x2 a = x[h], b = cmulc(x[h + 2], w2); x[h] = a + b; x[h + 2] = a - b; }
                { f32x2 a = x[h + 1], b = rot8<2, 1>(cmulc(x[h + 3], w2)); x[h + 1] = a + b; x[h + 3] = a - b; }
            }
            { f32x2 a = x[0], b = cmulc(x[4], w1); x[0] = a + b; if (!LOW) x[4] = a - b; }
            { f32x2 a = x[1], b = rot8<1, 1>(cmulc(x[5], w1)); x[1] = a + b; if (!LOW) x[5] = a - b; }
            { f32x2 a = x[2], b = rot8<2, 1>(cmulc(x[6], w1)); x[2] = a + b; if (!LOW) x[6] = a - b; }
            { f32x2 a = x[3], b = rot8<3, 1>(cmulc(x[7], w1)); x[3] = a + b; if (!LOW) x[7] = a - b; }
        }
#pragma unroll
        for (int m = 0; m < (LOW ? 4 : 8); ++m) buf[PADI(base + m * s)] = x[m];
    }
}
FFT_DEV void fft_r2_span1(FFT_PTR buf, int tid) {
#pragma unroll
    for (int rep = 0; rep < 8; ++rep) { const int p = 2 * (tid + rep * 512); f32x2 a = buf[PADI(p)], b = buf[PADI(p + 1)]; buf[PADI(p)] = a + b; buf[PADI(p + 1)] = a - b; }
}
template <int J, int CJ> FFT_DEV f32x2 rot16(f32x2 d) {
    const float C1 = 0.92387953251128674f, S1 = 0.38268343236508977f;
    if ((J & 1) == 0) return rot8<J / 2, CJ>(d);
    const float wr = (J == 1) ? C1 : (J == 3) ? S1 : (J == 5) ? -S1 : -C1;
    const float wi = ((J == 1) ? -S1 : (J == 3) ? -C1 : (J == 5) ? -C1 : -S1) * (CJ ? -1.f : 1.f);
    f32x2 r; r.x = d.x * wr - d.y * wi; r.y = d.x * wi + d.y * wr; return r;
}
FFT_DEV unsigned brev13(unsigned p);
FFT_DEV void fft16_dif(f32x2 (&x)[16]) {
#define BF_(i, j, ROT) { const f32x2 a_ = x[i], b_ = x[j]; x[i] = a_ + b_; x[j] = ROT(a_ - b_); }
    BF_(0, 8, (rot16<0, 0>)) BF_(1, 9, (rot16<1, 0>)) BF_(2, 10, (rot16<2, 0>)) BF_(3, 11, (rot16<3, 0>)) BF_(4, 12, (rot16<4, 0>)) BF_(5, 13, (rot16<5, 0>)) BF_(6, 14, (rot16<6, 0>)) BF_(7, 15, (rot16<7, 0>))
#pragma unroll
    for (int h = 0; h < 16; h += 8) { BF_(h + 0, h + 4, (rot8<0, 0>)) BF_(h + 1, h + 5, (rot8<1, 0>)) BF_(h + 2, h + 6, (rot8<2, 0>)) BF_(h + 3, h + 7, (rot8<3, 0>)) }
#pragma unroll
    for (int h = 0; h < 16; h += 4) { BF_(h + 0, h + 2, (rot8<0, 0>)) BF_(h + 1, h + 3, (rot8<2, 0>)) }
#pragma unroll
    for (int h = 0; h < 16; h += 2) { BF_(h, h + 1, (rot8<0, 0>)) }
#undef BF_
}
FFT_DEV void fft16_dit_inv(f32x2 (&x)[16]) {
#define BI_(i, j, ROT) { const f32x2 a_ = x[i], b_ = ROT(x[j]); x[i] = a_ + b_; x[j] = a_ - b_; }
#pragma unroll
    for (int h = 0; h < 16; h += 2) { BI_(h, h + 1, (rot8<0, 1>)) }
#pragma unroll
    for (int h = 0; h < 16; h += 4) { BI_(h + 0, h + 2, (rot8<0, 1>)) BI_(h + 1, h + 3, (rot8<2, 1>)) }
#pragma unroll
    for (int h = 0; h < 16; h += 8) { BI_(h + 0, h + 4, (rot8<0, 1>)) BI_(h + 1, h + 5, (rot8<1, 1>)) BI_(h + 2, h + 6, (rot8<2, 1>)) BI_(h + 3, h + 7, (rot8<3, 1>)) }
    BI_(0, 8, (rot16<0, 1>)) BI_(1, 9, (rot16<1, 1>)) BI_(2, 10, (rot16<2, 1>)) BI_(3, 11, (rot16<3, 1>)) BI_(4, 12, (rot16<4, 1>)) BI_(5, 13, (rot16<5, 1>)) BI_(6, 14, (rot16<6, 1>)) BI_(7, 15, (rot16<7, 1>))
#undef BI_
}
template <int MODE> FFT_DEV void fft_mid_pass(FFT_PTR wb, FFT_PTR zk, int tid) {
    f32x2 x[16];
#pragma unroll
    for (int e = 0; e < 16; ++e) x[e] = wb[PADI(16 * tid + e)];
    fft16_dif(x);
    if (MODE != 0) {
#pragma unroll
        for (int e = 0; e < 16; ++e) {
            const unsigned p = 16u * (unsigned)tid + (unsigned)e, f = brev13(p), fn = (8192u - f) & 8191u, pn = brev13(fn);
            const f32x2 zf = zk[PADI(p)], zn = zk[PADI(pn)];
            f32x2 kf;
            if (MODE == 1) { kf.x = 0.5f * (zf.x + zn.x); kf.y = 0.5f * (zf.y - zn.y); }
            else           { kf.x = 0.5f * (zf.y + zn.y); kf.y = 0.5f * (zn.x - zf.x); }
            x[e] = cmul(x[e], kf);
        }
        fft16_dit_inv(x);
    }
#pragma unroll
    for (int e = 0; e < 16; ++e) wb[PADI(16 * tid + e)] = x[e];
}
#ifndef FFT_HOST
#define FFT_SYNC() do { asm volatile("s_waitcnt lgkmcnt(0)" ::: "memory"); __builtin_amdgcn_s_barrier(); asm volatile("" ::: "memory"); } while (0)
__device__ __forceinline__ void fft_fwd_full(FFT_PTR buf, int tid) {
    FFT_SYNC(); fft_r8_pass<0, 0, 0>(buf, 1024, 10, tid); FFT_SYNC(); fft_r8_pass<0, 0, 0>(buf, 128, 7, tid); FFT_SYNC(); fft_r8_pass<0, 0, 0>(buf, 16, 4, tid); FFT_SYNC();
    fft_mid_pass<0>(buf, buf, tid); FFT_SYNC();
}
template <int WHICH> __device__ __forceinline__ void fft_conv(FFT_PTR wb, FFT_PTR zk, int tid) {
    FFT_SYNC(); fft_r8_pass<0, 1, 0>(wb, 1024, 10, tid); FFT_SYNC(); fft_r8_pass<0, 0, 0>(wb, 128, 7, tid); FFT_SYNC(); fft_r8_pass<0, 0, 0>(wb, 16, 4, tid); FFT_SYNC();
    fft_mid_pass<1 + WHICH>(wb, zk, tid); FFT_SYNC();
    fft_r8_pass<1, 0, 0>(wb, 16, 4, tid); FFT_SYNC(); fft_r8_pass<1, 0, 0>(wb, 128, 7, tid); FFT_SYNC(); fft_r8_pass<1, 0, 1>(wb, 1024, 10, tid); FFT_SYNC();
}
#endif
FFT_DEV unsigned brev13(unsigned p) {
    unsigned r = 0;
#ifndef FFT_HOST
    r = __brev(p) >> 19;
#else
    for (int i = 0; i < 13; ++i) r |= ((p >> i) & 1u) << (12 - i);
#endif
    return r;
}
FFT_DEV void fft_pointwise(FFT_PTR wb, FFT_PTR zk, int which, int tid) {
#pragma unroll 4
    for (int rep = 0; rep < 16; ++rep) {
        const unsigned p = tid + rep * 512, f = brev13(p), fn = (8192u - f) & 8191u, pn = brev13(fn);
        const f32x2 zf = zk[PADI(p)], zn = zk[PADI(pn)];
        f32x2 kf;
        if (which == 0) { kf.x = 0.5f * (zf.x + zn.x); kf.y = 0.5f * (zf.y - zn.y); }
        else            { kf.x = 0.5f * (zf.y + zn.y); kf.y = 0.5f * (zn.x - zf.x); }
        wb[PADI(p)] = cmul(wb[PADI(p)], kf);
    }
}
__device__ __forceinline__ void qk_prepass(const Ctx& C, int G, int wv) {
    int tid = (wv << 6) | lane_id_opaque(); asm volatile("" : "+v"(tid));
    const bf16_t* R1A = (const bf16_t*)(C.ws + WS_R1A); bf16_t* QKP = (bf16_t*)(C.ws + WS_QKP);
    const float* cw = C.in[3]; const float* cb = C.in[4];
    const int cg8 = tid & 255, half = tid >> 8, col = 8 * cg8;
    float k0[8], k1[8], k2[8], kb[8];
    { const int ch = 3072 + col;
      const f32x4 t0 = *(const f32x4*)(cw + ch), t1 = *(const f32x4*)(cw + ch + 4), t2 = *(const f32x4*)(cw + CONVC + ch), t3 = *(const f32x4*)(cw + CONVC + ch + 4);
      const f32x4 t4 = *(const f32x4*)(cw + 2 * CONVC + ch), t5 = *(const f32x4*)(cw + 2 * CONVC + ch + 4), t6 = *(const f32x4*)(cb + ch), t7 = *(const f32x4*)(cb + ch + 4);
#pragma unroll
      for (int e = 0; e < 4; ++e) { k0[e] = t0[e]; k0[4 + e] = t1[e]; k1[e] = t2[e]; k1[4 + e] = t3[e]; k2[e] = t4[e]; k2[4 + e] = t5[e]; kb[e] = t6[e]; kb[4 + e] = t7[e]; } }
    const float osc = col >= 1024 ? 0.0625f : 1.0f;
    for (int run = blockIdx.x; run < TOK / 64; run += G) {
        const int row0 = run * 64 + half * 32;
#pragma unroll 1
        for (int i0 = 0; i0 < 32; i0 += 4) {
            u32x4 w0[4], w1[4], w2[4];
#pragma unroll
            for (int u = 0; u < 4; ++u) { const int row = row0 + i0 + u, t = row & (SEQ - 1); const bf16_t* p = R1A + (size_t)row * 2048 + col;
                w0[u] = *(const u32x4*)(t > 0 ? p - 2048 : p); w1[u] = *(const u32x4*)p; w2[u] = *(const u32x4*)(t < SEQ - 1 ? p + 2048 : p); }
#pragma unroll
            for (int u = 0; u < 4; ++u) { const int row = row0 + i0 + u, t = row & (SEQ - 1);
                const u32x4 z = {0u, 0u, 0u, 0u}; if (t == 0) w0[u] = z; if (t == SEQ - 1) w2[u] = z;
                float a0[8], a1[8], a2[8]; unpack8(w0[u], a0); unpack8(w1[u], a1); unpack8(w2[u], a2);
                float v[8];
#pragma unroll
                for (int e = 0; e < 8; ++e) v[e] = siluf_(k0[e] * a0[e] + k1[e] * a1[e] + k2[e] * a2[e] + kb[e]) * osc;
                u32x4 o; o.x = pk2(v[0], v[1]); o.y = pk2(v[2], v[3]); o.z = pk2(v[4], v[5]); o.w = pk2(v[6], v[7]);
                *(u32x4*)(QKP + (size_t)row * 2048 + col) = o; }
        }
    }
}
constexpr int ML_KS = 0, ML_KP = 528, ML_SS = 76032, ML_SP = 272, ML_VS = 110848, ML_VP = 80, ML_VW = 121088, ML_CS = 131328, ML_CP = 528, ML_SC = 148224;
static_assert(ML_SC + 7 * 512 + 64 + 5 * 128 <= LDS_BYTES - 16, "mLSTM LDS map");
__device__ __forceinline__ bf16x8 tr_read2(unsigned a0, unsigned a1) {
    bf16x4 lo, hi;
    asm volatile("ds_read_b64_tr_b16 %0, %2\n\tds_read_b64_tr_b16 %1, %3\n\ts_waitcnt lgkmcnt(0)" : "=&v"(lo), "=&v"(hi) : "v"(a0), "v"(a1) : "memory");
    bf16x8 r; r[0] = lo[0]; r[1] = lo[1]; r[2] = lo[2]; r[3] = lo[3]; r[4] = hi[0]; r[5] = hi[1]; r[6] = hi[2]; r[7] = hi[3]; return r;
}
__device__ __forceinline__ bf16x8 cat4(bf16x4 lo, bf16x4 hi) { bf16x8 r; r[0] = lo[0]; r[1] = lo[1]; r[2] = lo[2]; r[3] = lo[3]; r[4] = hi[0]; r[5] = hi[1]; r[6] = hi[2]; r[7] = hi[3]; return r; }
__device__ __forceinline__ void tr_read2x2(unsigned a, unsigned b, unsigned d, bf16x8& ra, bf16x8& rb) {
    bf16x4 l0, h0, l1, h1;
    asm volatile("ds_read_b64_tr_b16 %0, %4\n\tds_read_b64_tr_b16 %1, %5\n\tds_read_b64_tr_b16 %2, %6\n\tds_read_b64_tr_b16 %3, %7\n\ts_waitcnt lgkmcnt(0)"
        : "=&v"(l0), "=&v"(h0), "=&v"(l1), "=&v"(h1) : "v"(a), "v"(a + d), "v"(b), "v"(b + d) : "memory");
    ra = cat4(l0, h0); rb = cat4(l1, h1);
}
__device__ __forceinline__ void tr_read4x2(unsigned a, unsigned b, unsigned d, unsigned c, unsigned e, unsigned d2, bf16x8& ra, bf16x8& rb, bf16x8& rc, bf16x8& re) {
    bf16x4 l0, h0, l1, h1, l2, h2, l3, h3;
    asm volatile("ds_read_b64_tr_b16 %0, %8\n\tds_read_b64_tr_b16 %1, %9\n\tds_read_b64_tr_b16 %2, %10\n\tds_read_b64_tr_b16 %3, %11\n\t"
                 "ds_read_b64_tr_b16 %4, %12\n\tds_read_b64_tr_b16 %5, %13\n\tds_read_b64_tr_b16 %6, %14\n\tds_read_b64_tr_b16 %7, %15\n\ts_waitcnt lgkmcnt(0)"
        : "=&v"(l0), "=&v"(h0), "=&v"(l1), "=&v"(h1), "=&v"(l2), "=&v"(h2), "=&v"(l3), "=&v"(h3)
        : "v"(a), "v"(a + d), "v"(b), "v"(b + d), "v"(c), "v"(c + d2), "v"(e), "v"(e + d2) : "memory");
    ra = cat4(l0, h0); rb = cat4(l1, h1); rc = cat4(l2, h2); re = cat4(l3, h3);
}
__device__ __forceinline__ float bf2f(short s) { return __uint_as_float(((unsigned)(unsigned short)s) << 16); }
__device__ __forceinline__ float logsigmoidf_(float x) { return fminf(x, 0.f) - log1pf(expf(-fabsf(x))); }

__device__ __forceinline__ void mlstm_item(const Ctx& C, LAS unsigned char* lds, int item, int wv) {
    int tid = (wv << 6) | lane_id_opaque(); asm volatile("" : "+v"(tid));
    const int lane = tid & 63, w = __builtin_amdgcn_readfirstlane(tid >> 6), r = lane & 15, g = lane >> 4, q4 = r >> 2, p4 = r & 3;
    const int xcd_ = item & 7, yy_ = item >> 3, vs = yy_ & 7, dir = (yy_ >> 3) & 1, bh = 2 * xcd_ + (yy_ >> 4), b = bh >> 2, h = bh & 3;
    const bf16_t* QKP = (const bf16_t*)(C.ws + WS_QKP); const bf16_t* R1B = (const bf16_t*)(C.ws + WS_R1B); const float* Gt = (const float*)(C.ws + WS_G);
    bf16_t* Y = (bf16_t*)(C.ws + (dir ? WS_YBB : WS_YBF));
    LAS float* SC = (LAS float*)(lds + ML_SC);
    LAS float* s_cs = SC, *s_rj = SC + 128, *s_iw = SC + 256, *s_emj = SC + 384, *s_w = SC + 512, *s_dn = SC + 640, *s_misc = SC + 768;
    LAS float* c_bl = SC + 784, *c_mx = SC + 816, *c_mp = SC + 848, *c_mn = SC + 880, *c_kp = SC + 912;
    float* GS = (float*)(C.ws + WS_GSC) + (size_t)item * 3 * SEQ;
    const unsigned lbase = (unsigned)(size_t)lds;
    const int pc = tid & 31, krow = tid >> 5, vrow = tid >> 2, pv = tid & 3;
    const int sw = w < 4 ? w : 11 - w;
    for (int i = tid; i < 16896 / 4; i += 512) ((LAS unsigned*)(lds + ML_CS))[i] = 0u;
    for (int i = tid; i < 16 * ML_KP / 4; i += 512) ((LAS unsigned*)(lds + ML_KS + 128 * ML_KP))[i] = 0u;
    f32x4 Cacc[3][2];
#pragma unroll
    for (int a = 0; a < 3; ++a) { Cacc[a][0] = (f32x4){0.f, 0.f, 0.f, 0.f}; Cacc[a][1] = (f32x4){0.f, 0.f, 0.f, 0.f}; }
    u32x4 kreg[8], vreg, qn[8]; float bn = 0.f, csn = 0.f, pmn = 0.f;
#define ML_TOK(c_, j_) ((size_t)b * SEQ + (dir ? SEQ - 1 - ((c_) * 128 + (j_)) : ((c_) * 128 + (j_))))
#define ML_PREFETCH(c_) do { \
        _Pragma("unroll") for (int i = 0; i < 8; ++i) kreg[i] = *(const u32x4*)(QKP + ML_TOK(c_, krow + 16 * i) * 2048 + 1024 + h * 256 + 8 * pc); \
        vreg = *(const u32x4*)(R1B + ML_TOK(c_, vrow) * 2048 + h * 256 + vs * 32 + 8 * pv); \
        { const bf16_t* qp = QKP + ML_TOK(c_, 16 * sw + r) * 2048 + h * 256 + 8 * g; _Pragma("unroll") for (int kk = 0; kk < 8; ++kk) qn[kk] = *(const u32x4*)(qp + 32 * kk); } \
        if (tid < 128) { const int ta = (c_) * 128 + tid; bn = GS[ta]; csn = GS[SEQ + ta]; pmn = GS[2 * SEQ + ta]; } } while (0)
    {
        float gi[8], gf[8];
#pragma unroll
        for (int u = 0; u < 8; ++u) { const int ta = (4 * w) * 128 + u * 64 + lane; const size_t tk = (size_t)b * SEQ + (dir ? SEQ - 1 - ta : ta);
            gi[u] = Gt[tk * 16 + (dir * 2) * 4 + h]; gf[u] = Gt[tk * 16 + (dir * 2 + 1) * 4 + h]; }
#pragma unroll
        for (int q = 0; q < 4; ++q) {
            const int c = 4 * w + q; float carry_b = 0.f, carry_m = -3.0e38f;
#pragma unroll
            for (int hf = 0; hf < 2; ++hf) {
                const int ta = c * 128 + hf * 64 + lane;
                const float ip = gi[2 * q + hf], fp = gf[2 * q + hf];
                float xs = logsigmoidf_(fp);
#pragma unroll
                for (int o = 1; o < 64; o <<= 1) { const float y = __shfl_up(xs, o); if (lane >= o) xs += y; }
                const float bj = xs + carry_b; const float cj = ip - bj; float pm = cj;
#pragma unroll
                for (int o = 1; o < 64; o <<= 1) { const float y = __shfl_up(pm, o); if (lane >= o) pm = fmaxf(pm, y); }
                pm = fmaxf(pm, carry_m);
                GS[ta] = bj; GS[SEQ + ta] = cj; GS[2 * SEQ + ta] = pm;
                carry_b = __shfl(bj, 63); carry_m = __shfl(pm, 63);
            }
            if (lane == 0) { c_bl[c] = carry_b; c_mx[c] = carry_m; }
        }
        __syncthreads();
        if (tid == 0) { float m = 0.f;
            for (int c = 0; c < 32; ++c) { const float bl = c_bl[c], mn = fmaxf(bl + m, bl + c_mx[c]); c_mp[c] = m; c_mn[c] = mn; c_kp[c] = __expf(bl + m - mn); m = mn; } }
        __syncthreads();
    }
    ML_PREFETCH(0);
    __syncthreads();
#define ML_BAR() do { asm volatile("s_waitcnt lgkmcnt(0)" ::: "memory"); __builtin_amdgcn_s_barrier(); asm volatile("" ::: "memory"); } while (0)
#pragma unroll 1
    for (int c = 0; c < 32; ++c) {
        const float m_prev = c_mp[c], m_new = c_mn[c], keep = c_kp[c], b_last = c_bl[c];
        if (tid < 128) {
            const float inter = bn + m_prev, mj = fmaxf(inter, bn + pmn);
            s_cs[tid] = csn; s_rj[tid] = bn - mj; s_iw[tid] = __expf(inter - mj); s_emj[tid] = __expf(-mj); s_w[tid] = __expf(b_last + csn - m_new);
        }
        ML_BAR();
#pragma unroll
        for (int i = 0; i < 8; ++i) *(LAS u32x4*)(lds + ML_KS + (krow + 16 * i) * ML_KP + pc * 16) = kreg[i];
        {
            *(LAS u32x4*)(lds + ML_VS + vrow * ML_VP + pv * 16) = vreg;
            float f[8]; unpack8(vreg, f); const float ws_ = s_w[vrow];
            u32x4 o; o.x = pk2(f[0] * ws_, f[1] * ws_); o.y = pk2(f[2] * ws_, f[3] * ws_); o.z = pk2(f[4] * ws_, f[5] * ws_); o.w = pk2(f[6] * ws_, f[7] * ws_);
            *(LAS u32x4*)(lds + ML_VW + vrow * ML_VP + pv * 16) = o;
        }
        bf16x8 qf[8];
#pragma unroll
        for (int kk = 0; kk < 8; ++kk) qf[kk] = __builtin_bit_cast(bf16x8, qn[kk]);
        unsigned short ogr[4][2];
#pragma unroll
        for (int i = 0; i < 4; ++i)
#pragma unroll
            for (int vt = 0; vt < 2; ++vt) ogr[i][vt] = R1B[ML_TOK(c, 16 * sw + 4 * g + i) * 2048 + 1024 + h * 256 + vs * 32 + 16 * vt + r];
        if (c < 31) ML_PREFETCH(c + 1);
        ML_BAR();
        {
            const float rjv = s_rj[16 * sw + r]; const int jloc = 16 * sw + r; float den1 = 0.f;
#pragma unroll 2
            for (int st = 0; st < 8; ++st) {
                if (st <= sw) {
                    f32x4 acc = {0.f, 0.f, 0.f, 0.f};
#pragma unroll
                    for (int kk = 0; kk < 8; ++kk) { const bf16x8 kf = *(const LAS bf16x8*)(lds + ML_KS + (16 * st + r) * ML_KP + (32 * kk + 8 * g) * 2); acc = __builtin_amdgcn_mfma_f32_16x16x32_bf16(kf, qf[kk], acc, 0, 0, 0); }
                    const f32x4 c4 = *(const LAS f32x4*)(s_cs + 16 * st + 4 * g);
                    float v[4];
#pragma unroll
                    for (int i = 0; i < 4; ++i) { const int s = 16 * st + 4 * g + i; const float d = (s <= jloc) ? __expf(rjv + c4[i]) : 0.f; v[i] = acc[i] * d; den1 += v[i]; }
                    u32x2 o; o.x = pk2(v[0], v[1]); o.y = pk2(v[2], v[3]);
                    *(LAS u32x2*)(lds + ML_SS + jloc * ML_SP + (16 * st + 4 * g) * 2) = o;
                } else if (st == sw + 1 && !(sw & 1)) {
                    u32x2 o = {0u, 0u}; *(LAS u32x2*)(lds + ML_SS + jloc * ML_SP + (16 * st + 4 * g) * 2) = o;
                }
            }
            den1 += __shfl_xor(den1, 16); den1 += __shfl_xor(den1, 32);
            f32x4 dacc = {0.f, 0.f, 0.f, 0.f};
#pragma unroll
            for (int kk = 0; kk < 8; ++kk) { const bf16x8 kf = *(const LAS bf16x8*)(lds + ML_KS + (128 + r) * ML_KP + (32 * kk + 8 * g) * 2); dacc = __builtin_amdgcn_mfma_f32_16x16x32_bf16(kf, qf[kk], dacc, 0, 0, 0); }
            const float d2 = dacc[0];
            if (g == 0) s_dn[jloc] = den1 + s_iw[jloc] * d2;
        }
        ML_BAR();
        {
            f32x4 n1[2], n2[2];
#pragma unroll
            for (int vt = 0; vt < 2; ++vt) { n1[vt] = (f32x4){0.f, 0.f, 0.f, 0.f}; n2[vt] = (f32x4){0.f, 0.f, 0.f, 0.f}; }
            const int nks = (sw >> 1) + 1;
#pragma unroll 1
            for (int ks = 0; ks < nks; ++ks) {
                const bf16x8 af = *(const LAS bf16x8*)(lds + ML_SS + (16 * sw + r) * ML_SP + (32 * ks + 8 * g) * 2);
                const unsigned a0 = lbase + ML_VS + (32 * ks + 8 * g + q4) * ML_VP + (4 * p4) * 2;
                bf16x8 b0, b1; tr_read2x2(a0, a0 + 32, 4 * ML_VP, b0, b1);
                n1[0] = __builtin_amdgcn_mfma_f32_16x16x32_bf16(af, b0, n1[0], 0, 0, 0); n1[1] = __builtin_amdgcn_mfma_f32_16x16x32_bf16(af, b1, n1[1], 0, 0, 0);
            }
#pragma unroll
            for (int kk = 0; kk < 8; ++kk)
#pragma unroll
                for (int vt = 0; vt < 2; ++vt) { const bf16x8 cf = *(const LAS bf16x8*)(lds + ML_CS + (16 * vt + r) * ML_CP + (32 * kk + 8 * g) * 2); n2[vt] = __builtin_amdgcn_mfma_f32_16x16x32_bf16(qf[kk], cf, n2[vt], 0, 0, 0); }
            const f32x4 iw4 = *(const LAS f32x4*)(s_iw + 16 * sw + 4 * g), dn4 = *(const LAS f32x4*)(s_dn + 16 * sw + 4 * g), em4 = *(const LAS f32x4*)(s_emj + 16 * sw + 4 * g);
#pragma unroll
            for (int i = 0; i < 4; ++i) {
                const size_t tok = ML_TOK(c, 16 * sw + 4 * g + i);
                const float inv = 1.0f / fmaxf(fabsf(dn4[i]), em4[i]);
#pragma unroll
                for (int vt = 0; vt < 2; ++vt) { const int col = h * 256 + vs * 32 + 16 * vt + r;
                    const float og = __uint_as_float(((unsigned)ogr[i][vt]) << 16);
                    const float hv = (n1[vt][i] + iw4[i] * n2[vt][i]) * inv * og;
                    Y[blk_off((int)tok, col, 1024)] = (bf16_t)f2bf(hv); }
            }
        }
        ML_BAR();
        {
#pragma unroll
            for (int a = 0; a < 3; ++a) { Cacc[a][0] *= keep; Cacc[a][1] *= keep; }
#pragma unroll 1
            for (int ks = 0; ks < 4; ++ks) {
                bf16x8 af[3], bq[2];
                { const unsigned av = lbase + ML_VW + (32 * ks + 8 * g + q4) * ML_VP + (4 * p4) * 2, ak = lbase + ML_KS + (32 * ks + 8 * g + q4) * ML_KP + (32 * w + 4 * p4) * 2;
                  tr_read4x2(av, av + 32, 4 * ML_VP, ak, ak + 32, 4 * ML_KP, af[0], af[1], bq[0], bq[1]); }
                { const f32x4 wa = *(const LAS f32x4*)(s_w + 32 * ks + 8 * g), wb = *(const LAS f32x4*)(s_w + 32 * ks + 8 * g + 4);
                  u32x4 o; o.x = pk2(wa[0], wa[1]); o.y = pk2(wa[2], wa[3]); o.z = pk2(wb[0], wb[1]); o.w = pk2(wb[2], wb[3]);
                  if (r != 0) { o.x = 0u; o.y = 0u; o.z = 0u; o.w = 0u; }
                  af[2] = __builtin_bit_cast(bf16x8, o); }
#pragma unroll
                for (int nt = 0; nt < 2; ++nt)
#pragma unroll
                    for (int mt = 0; mt < 3; ++mt) Cacc[mt][nt] = __builtin_amdgcn_mfma_f32_16x16x32_bf16(af[mt], bq[nt], Cacc[mt][nt], 0, 0, 0);
            }
#pragma unroll
            for (int mt = 0; mt < 2; ++mt)
#pragma unroll
                for (int nt = 0; nt < 2; ++nt)
#pragma unroll
                    for (int i = 0; i < 4; ++i) *(LAS bf16_t*)(lds + ML_CS + (16 * mt + 4 * g + i) * ML_CP + (32 * w + 16 * nt + r) * 2) = (bf16_t)f2bf(Cacc[mt][nt][i]);
            if (g == 0) { *(LAS bf16_t*)(lds + ML_KS + 128 * ML_KP + (32 * w + r) * 2) = (bf16_t)f2bf(Cacc[2][0][0]); *(LAS bf16_t*)(lds + ML_KS + 128 * ML_KP + (32 * w + 16 + r) * 2) = (bf16_t)f2bf(Cacc[2][1][0]); }
        }
        ML_BAR();
    }
#undef ML_BAR
#undef ML_PREFETCH
#undef ML_TOK
}
constexpr int HY_ZK = 0, HY_WB = 69632;
static_assert(HY_WB + 69632 <= LDS_BYTES, "hyena LDS map");
#define GAS __attribute__((address_space(1)))
struct HyRaw { u32x4 c; unsigned l, r; };
__device__ __forceinline__ HyRaw hy_load(const bf16_t* rowp, int tid) { HyRaw x; const GAS bf16_t* p = (const GAS bf16_t*)rowp + 8 * tid; x.c = *(const GAS u32x4*)p; x.l = p[-1]; x.r = p[8]; return x; }
__device__ __forceinline__ void hy_conv8(const HyRaw& x, int tid, float w0, float w1, float w2, float bias, float (&o)[8]) {
    float a[10];
    a[0] = tid > 0 ? __uint_as_float(x.l << 16) : 0.f; a[9] = tid < 511 ? __uint_as_float(x.r << 16) : 0.f;
    a[1] = bflo(x.c.x); a[2] = bfhi(x.c.x); a[3] = bflo(x.c.y); a[4] = bfhi(x.c.y); a[5] = bflo(x.c.z); a[6] = bfhi(x.c.z); a[7] = bflo(x.c.w); a[8] = bfhi(x.c.w);
#pragma unroll
    for (int m = 0; m < 8; ++m) o[m] = w0 * a[m] + w1 * a[m + 1] + w2 * a[m + 2] + bias;
}
__device__ __forceinline__ void hyena_item(const Ctx& C, LAS unsigned char* lds, int ch, int wv) {
    int tid = (wv << 6) | lane_id_opaque(); asm volatile("" : "+v"(tid));
    LAS f32x2* zk = (LAS f32x2*)(lds + HY_ZK); LAS f32x2* wb = (LAS f32x2*)(lds + HY_WB);
    const float* FILT = (const float*)(C.ws + WS_FILT); const bf16_t* HYb = (const bf16_t*)(C.ws + WS_HY); bf16_t* YA = (bf16_t*)(C.ws + WS_YA);
    const float* cw = C.in[3]; const float* cb = C.in[4];
    float w0[3], w1[3], w2[3], bs[3];
#pragma unroll
    for (int s = 0; s < 3; ++s) { w0[s] = cw[s * 1024 + ch]; w1[s] = cw[CONVC + s * 1024 + ch]; w2[s] = cw[2 * CONVC + s * 1024 + ch]; bs[s] = cb[s * 1024 + ch]; }
    const float hb0 = C.in[12][ch], hb1 = C.in[12][1024 + ch];
    const float* F0 = FILT + (size_t)(0 * 1024 + ch) * SEQ; const float* F1 = FILT + (size_t)(1 * 1024 + ch) * SEQ;
    const float* F2 = FILT + (size_t)(2 * 1024 + ch) * SEQ; const float* F3 = FILT + (size_t)(3 * 1024 + ch) * SEQ;
    __syncthreads();
    {
        float fa[16], fb[16];
#pragma unroll
        for (int rep = 0; rep < 8; ++rep) { const int i = tid + 512 * rep; fa[rep] = F0[i]; fb[rep] = F2[i]; }
#pragma unroll
        for (int rep = 8; rep < 16; ++rep) { const int i = tid + 512 * rep; const int j = i == SEQ ? 1 : 2 * SEQ - i; fa[rep] = F1[j]; fb[rep] = F3[j]; }
        if (tid == 0) { fa[8] = 0.f; fb[8] = 0.f; }
#pragma unroll
        for (int rep = 0; rep < 16; ++rep) { const int i = tid + 512 * rep; zk[PADI(i)] = (f32x2){fa[rep] * (1.0f / 8192.0f), fb[rep] * (1.0f / 8192.0f)}; }
    }
    fft_fwd_full(zk, tid);
    const bf16_t* rv = HYb + (size_t)ch * TOK; const bf16_t* rx1 = HYb + (size_t)(1024 + ch) * TOK; const bf16_t* rx2 = HYb + (size_t)(2048 + ch) * TOK;
    HyRaw qa = hy_load(rv, tid), qb = hy_load(rv + SEQ, tid);
#pragma unroll 1
    for (int p = 0; p < 2; ++p) {
        const int tb0 = (2 * p) * SEQ, tb1 = (2 * p + 1) * SEQ;
        f32x2 vv[8], zz[8];
        { float va[8], vb[8]; hy_conv8(qa, tid, w0[0], w1[0], w2[0], bs[0], va); hy_conv8(qb, tid, w0[0], w1[0], w2[0], bs[0], vb);
#pragma unroll
          for (int m = 0; m < 8; ++m) { vv[m].x = va[m]; vv[m].y = vb[m]; wb[PADI(8 * tid + m)] = vv[m]; } }
        qa = hy_load(rx1 + tb0, tid); qb = hy_load(rx1 + tb1, tid);
        fft_conv<0>(wb, zk, tid);
        { float xa[8], xb_[8]; hy_conv8(qa, tid, w0[1], w1[1], w2[1], bs[1], xa); hy_conv8(qb, tid, w0[1], w1[1], w2[1], bs[1], xb_);
#pragma unroll
          for (int m = 0; m < 8; ++m) { const f32x2 y = wb[PADI(8 * tid + m)]; zz[m].x = xa[m] * (y.x + vv[m].x * hb0); zz[m].y = xb_[m] * (y.y + vv[m].y * hb0); }
#pragma unroll
          for (int m = 0; m < 8; ++m) wb[PADI(8 * tid + m)] = zz[m]; }
        qa = hy_load(rx2 + tb0, tid); qb = hy_load(rx2 + tb1, tid);
        fft_conv<1>(wb, zk, tid);
        { float xa[8], xb_[8]; hy_conv8(qa, tid, w0[2], w1[2], w2[2], bs[2], xa); hy_conv8(qb, tid, w0[2], w1[2], w2[2], bs[2], xb_);
          if (p == 0) { qa = hy_load(rv + 2 * SEQ, tid); qb = hy_load(rv + 3 * SEQ, tid); }
#pragma unroll
          for (int m = 0; m < 8; ++m) { const int t = 8 * tid + m; const f32x2 y = wb[PADI(t)];
              YA[blk_off(tb0 + t, ch, 1024)] = (bf16_t)f2bf(xa[m] * (y.x + zz[m].x * hb1));
              YA[blk_off(tb1 + t, ch, 1024)] = (bf16_t)f2bf(xb_[m] * (y.y + zz[m].y * hb1)); } }
        FFT_SYNC();
    }
}
#ifndef DUP_FILT
#define DUP_FILT 0
#endif
#ifndef DUP_PRE
#define DUP_PRE 0
#endif
#ifndef DUP_P0
#define DUP_P0 0
#endif
#ifndef DUP_ML
#define DUP_ML 0
#endif
#ifndef DUP_HY
#define DUP_HY 0
#endif
#ifndef DUP_REST
#define DUP_REST 0
#endif
#ifndef DUP_GU
#define DUP_GU 0
#endif
#define XB_TMO      128
#define XB_XCNT(j)  (256  + 64 * (j))
#define XB_XSUB(j)  (1280 + 64 * (j))
#define XB_XGEN(j)  (2304 + 64 * (j))
#define XB_TOP      3328
#define XB_TOPGEN   3392
#define XCD_BAR_WORDS 3456
#define XB_SPIN_CAP (1u << 22)
__device__ __forceinline__ unsigned xb_ld(unsigned* p)              { return __hip_atomic_load(p, __ATOMIC_RELAXED, __HIP_MEMORY_SCOPE_AGENT); }
__device__ __forceinline__ unsigned xb_add(unsigned* p, unsigned v) { return __hip_atomic_fetch_add(p, v, __ATOMIC_RELAXED, __HIP_MEMORY_SCOPE_AGENT); }
__device__ __forceinline__ unsigned xb_xcc_id() { return (unsigned)__builtin_amdgcn_s_getreg((3 << 11) | 20) & 0xFu; }
#define XB_SPIN(cond, bar) do { unsigned _sp = 0; while (cond) { __builtin_amdgcn_s_sleep(1); \
    if ((++_sp & 255u) == 0u) { if (xb_ld(&(bar)[XB_TMO])) break; if (_sp > XB_SPIN_CAP) { atomicAdd(&(bar)[XB_TMO], 1u); break; } } } } while (0)
__device__ __forceinline__ void xcd_barrier_complete(unsigned* bar, unsigned x, unsigned G, unsigned& nloc, unsigned& nx) {
    unsigned sum, cnt, mine, sp = 0u;
    for (;;) {
        sum = 0u; cnt = 0u; mine = 0u;
#pragma unroll
        for (unsigned j = 0; j < 16; ++j) { const unsigned c = xb_ld(&bar[XB_XCNT(j)]); sum += c; cnt += (c > 0u) ? 1u : 0u; mine = (j == x) ? c : mine; }
        if (sum == G) break;
        __builtin_amdgcn_s_sleep(1);
        if ((++sp & 255u) == 0u) { if (xb_ld(&bar[XB_TMO])) break; if (sp > XB_SPIN_CAP) { atomicAdd(&bar[XB_TMO], 1u); break; } }
    }
    nloc = mine > 0u ? mine : 1u; nx = cnt > 0u ? cnt : 1u;
}
__device__ __forceinline__ void grid_bar(unsigned* bar, volatile LAS unsigned* st, unsigned G, int wv) {
    asm volatile("s_waitcnt vmcnt(0)" ::: "memory");
    __syncthreads();
    const int lane = lane_id_opaque();
    if (wv == 0 && lane == 0) {
        __builtin_amdgcn_s_waitcnt(0);
        const unsigned x = xb_xcc_id();
        unsigned nloc = st[0], nx = st[1];
        if (nloc == 0u) { xcd_barrier_complete(bar, x, G, nloc, nx); st[0] = nloc; st[1] = nx; }
        const unsigned old = xb_add(&bar[XB_XSUB(x)], 1u);
        const unsigned gen = old / nloc;
        if (old + 1u == (gen + 1u) * nloc) {
            __builtin_amdgcn_fence(__ATOMIC_RELEASE, "agent");
            asm volatile("s_waitcnt vmcnt(0)" ::: "memory");
            const unsigned og = xb_add(&bar[XB_TOP], 1u);
            const unsigned tg = og / nx;
            if (og + 1u == (tg + 1u) * nx) xb_add(&bar[XB_TOPGEN], 1u);
            else XB_SPIN(xb_ld(&bar[XB_TOPGEN]) == tg, bar);
            __builtin_amdgcn_fence(__ATOMIC_ACQUIRE, "agent");
            xb_add(&bar[XB_XGEN(x)], 1u);
            asm volatile("s_waitcnt vmcnt(0)" ::: "memory");
        } else {
            XB_SPIN(xb_ld(&bar[XB_XGEN(x)]) == gen, bar);
            __builtin_amdgcn_fence(__ATOMIC_ACQUIRE, "agent");
            asm volatile("s_waitcnt vmcnt(0)" ::: "memory");
        }
    }
    __syncthreads();
}
__device__ __forceinline__ void p6_finalize(const Ctx& C, int G, int bx, int wv) {
    int tid = (wv << 6) | lane_id_opaque(); asm volatile("" : "+v"(tid));
    unsigned* pcnt = (unsigned*)(C.ws + WS_PCNT); const float* ss3 = (const float*)(C.ws + WS_SS3); const float* wf = C.in[20]; float* out = C.out;
    asm volatile("s_waitcnt vmcnt(0)" ::: "memory");
    __syncthreads();
    if (tid == 0) {
        __builtin_amdgcn_fence(__ATOMIC_RELEASE, "agent"); asm volatile("s_waitcnt vmcnt(0)" ::: "memory");
        for (int i = 0; ; ++i) { const int L = i * G + bx; if (L >= 64 * 8) break; int pm, pn; pg8::tile_of(L, 64, 8, pm, pn); xb_add(&pcnt[64 * pm], 1u); }
    }
    for (int i = 0; ; ++i) {
        const int L = i * G + bx; if (L >= 64 * 8) break; int pm, pn; pg8::tile_of(L, 64, 8, pm, pn);
        if (tid == 0) { unsigned sp = 0; while (xb_ld(&pcnt[64 * pm]) < 8u) { __builtin_amdgcn_s_sleep(1); if (++sp > (1u << 20)) break; }
            __builtin_amdgcn_fence(__ATOMIC_ACQUIRE, "agent"); asm volatile("s_waitcnt vmcnt(0)" ::: "memory"); }
        __syncthreads();
        const int c4 = tid & 63; const f32x4 wv4 = *(const f32x4*)(wf + 256 * pn + 4 * c4);
#pragma unroll 1
        for (int k0 = 0; k0 < 32; k0 += 8) {
            f32x4 v[8]; float rr[8];
#pragma unroll
            for (int k = 0; k < 8; ++k) { const int row = 256 * pm + (tid >> 6) + 8 * (k0 + k);
                v[k] = *(const f32x4*)(out + (size_t)row * DM + 256 * pn + 4 * c4);
                rr[k] = __hip_atomic_load(ss3 + row, __ATOMIC_RELAXED, __HIP_MEMORY_SCOPE_AGENT); }
#pragma unroll
            for (int k = 0; k < 8; ++k) { const int row = 256 * pm + (tid >> 6) + 8 * (k0 + k); const float r = 1.0f / sqrtf(rr[k] * (1.0f / DM) + RMS_EPS);
                *(f32x4*)(out + (size_t)row * DM + 256 * pn + 4 * c4) = v[k] * r * wv4; }
        }
    }
}
struct Params { const float* in[21]; float* out; unsigned char* ws; };
__global__ void __launch_bounds__(512, 2) fwd_megakernel(Params prm) {
    extern __shared__ __attribute__((aligned(16))) unsigned char lds_raw[];
    LAS unsigned char* lds = (LAS unsigned char*)lds_raw;
    cg::grid_group grid = cg::this_grid();
    const int G = gridDim.x, bx = blockIdx.x;
    const int wv = __builtin_amdgcn_readfirstlane((int)(threadIdx.x >> 6));
    Ctx C;
#pragma unroll
    for (int i = 0; i < 21; ++i) C.in[i] = prm.in[i];
    C.out = prm.out; C.ws = prm.ws;
    unsigned char* ws = prm.ws;
    unsigned* gbar = (unsigned*)(ws + WS_BAR);
    volatile LAS unsigned* bst = (volatile LAS unsigned*)(lds + LDS_BYTES - 16);
#ifndef DUP_BAR
#define DUP_BAR 0
#endif
#define GBAR() do { for (int rb_ = 0; rb_ < 1 + DUP_BAR; ++rb_) grid_bar(gbar, bst, (unsigned)G, wv); } while (0)
    if (bx == 0) for (int i = threadIdx.x; i < XCD_BAR_WORDS; i += 512) gbar[i] = 0u;
    if (bx == 1 || G == 1) for (int i = threadIdx.x; i < 64 * 64; i += 512) ((unsigned*)(ws + WS_PCNT))[i] = 0u;
    if (threadIdx.x < 4) ((LAS unsigned*)(lds + LDS_BYTES - 16))[threadIdx.x] = 0u;
    grid.sync();
    if (threadIdx.x == 0) (void)xb_add(&gbar[XB_XCNT(xb_xcc_id())], 1u);
    for (int rep = 0; rep < 1 + DUP_P0; ++rep) { p0_prologue(C, lds, G, wv); __syncthreads(); }
    GBAR();
    for (int rep = 0; rep < 1 + DUP_FILT; ++rep) p1_filters(C, lds, G, wv);
    { HyProg P; P.K = DM; P.G = G; P.c = bx; P.W = (const bf16_t*)(ws + WS_WIN); P.X = (const bf16_t*)(ws + WS_XB); P.HY = (bf16_t*)(ws + WS_HY); P.r1 = (const float*)(ws + WS_R1S);
      pg8::gemm_stream(lds, P, wv); }
    for (int rep = 0; rep < 1 + DUP_REST; ++rep) { RestProg P; P.K = DM; P.G = G; P.c = bx; P.W = (const bf16_t*)(ws + WS_WIN); P.X = (const bf16_t*)(ws + WS_XB); P.R1A = (bf16_t*)(ws + WS_R1A); P.R1B = (bf16_t*)(ws + WS_R1B); P.R2 = (bf16_t*)prm.out; P.r1 = (const float*)(ws + WS_R1S);
      pg8::gemm_stream(lds, P, wv); }
    GBAR();
    for (int rep = 0; rep < 1 + DUP_PRE; ++rep) qk_prepass(C, G, wv);
    for (int rep = 0; rep < 1 + DUP_HY; ++rep) for (int idx = bx; idx < 1024; idx += G) { const int rd = idx >> 8, bb = idx & 255; hyena_item(C, lds, rd * 256 + (bb & 7) * 32 + (bb >> 3), wv); }
    GBAR();
    for (int rep = 0; rep < 1 + DUP_ML; ++rep) for (int item = bx; item < 256; item += G) mlstm_item(C, lds, item, wv);
    GBAR();
    { BranchProg P; P.K = 1024; P.G = G; P.c = bx; P.YA = (const bf16_t*)(ws + WS_YA); P.YBF = (const bf16_t*)(ws + WS_YBF); P.YBB = (const bf16_t*)(ws + WS_YBB);
      P.WA = (const bf16_t*)(ws + WS_WA); P.WB = (const bf16_t*)(ws + WS_WB); P.R2 = (const bf16_t*)prm.out; P.MIX = (bf16_t*)(ws + WS_MIX);
      pg8::gemm_stream(lds, P, wv); }
    GBAR();
    { ResProg P; P.K = DM; P.G = G; P.c = bx; P.A = (const bf16_t*)(ws + WS_MIX); P.B = (const bf16_t*)(ws + WS_WOUT); P.base = prm.in[0]; P.base16 = nullptr; P.out = nullptr; P.outb = (bf16_t*)(ws + WS_X1B); P.ss = (float*)(ws + WS_SS2);
      pg8::gemm_stream(lds, P, wv); }
    GBAR();
    for (int rep = 0; rep < 1 + DUP_GU; ++rep) { GuProg P; P.K = DM; P.G = G; P.c = bx; P.X = (const bf16_t*)(ws + WS_X1B); P.W = (const bf16_t*)(ws + WS_WGU); P.HH = (bf16_t*)(ws + WS_HH); P.ss2 = (const float*)(ws + WS_SS2);
      pg8::gemm_stream(lds, P, wv); }
    GBAR();
    { ResProg P; P.K = FFH; P.G = G; P.c = bx; P.A = (const bf16_t*)(ws + WS_HH); P.B = (const bf16_t*)(ws + WS_WD); P.base = nullptr; P.base16 = (const bf16_t*)(ws + WS_X1B); P.out = prm.out; P.outb = nullptr; P.ss = (float*)(ws + WS_SS3);
      pg8::gemm_stream(lds, P, wv); }
    p6_finalize(C, G, bx, wv);
}

extern "C" void kernel_launch(void* const* d_in, const int* in_sizes, int n_in, void* d_out, int out_size, void* d_ws, size_t ws_size, hipStream_t stream) {
    static int grid = 0;
    if (grid == 0) {
        int dev = 0, cus = 0, per_cu = 0;
        hipGetDevice(&dev); hipDeviceGetAttribute(&cus, hipDeviceAttributeMultiprocessorCount, dev);
        if (hipFuncSetAttribute((const void*)fwd_megakernel, hipFuncAttributeMaxDynamicSharedMemorySize, LDS_BYTES) != hipSuccess) { fprintf(stderr, "kernel_launch: hipFuncSetAttribute failed\n"); grid = -1; return; }
        if (hipOccupancyMaxActiveBlocksPerMultiprocessor(&per_cu, (const void*)fwd_megakernel, 512, LDS_BYTES) != hipSuccess || per_cu < 1) { fprintf(stderr, "kernel_launch: occupancy query gave %d\n", per_cu); per_cu = 1; }
        (void)hipGetLastError();
        grid = cus * 1;
        if (n_in != 21 || ws_size < WS_END) { fprintf(stderr, "kernel_launch: unexpected n_in %d or ws %zu\n", n_in, ws_size); grid = -1; return; }
    }
    if (grid < 0) return;
    Params p{};
    for (int i = 0; i < 21; ++i) p.in[i] = (const float*)d_in[i];
    p.out = (float*)d_out; p.ws = (unsigned char*)d_ws;
    void* args[] = {&p};
    hipError_t e = hipLaunchCooperativeKernel((const void*)fwd_megakernel, dim3(grid), dim3(512), args, LDS_BYTES, stream);
    if (e != hipSuccess) fprintf(stderr, "cooperative launch failed: %s (grid %d)\n", hipGetErrorString(e), grid);
}
```

```cpp
#include <hip/hip_runtime.h>
#include <hip/hip_cooperative_groups.h>
#include <cstdio>
namespace cg = cooperative_groups;

#define LAS __attribute__((address_space(3)))
typedef unsigned short bf16_t;
typedef short bf16x8 __attribute__((ext_vector_type(8)));
typedef short bf16x4 __attribute__((ext_vector_type(4)));
typedef float f32x4 __attribute__((ext_vector_type(4)));
typedef float f32x2 __attribute__((ext_vector_type(2)));
typedef unsigned u32x4 __attribute__((ext_vector_type(4)));
typedef unsigned u32x2 __attribute__((ext_vector_type(2)));

constexpr int NB = 4, SEQ = 4096, TOK = NB * SEQ, DM = 2048, HW = 1024, MW = 1024, NHEAD = 4, DH = 256, FFH = 5632;
constexpr int CONVC = 5120, INCOLS = 11280, NFILT = 4096;
constexpr float RMS_EPS = 1e-6f;
constexpr size_t MiB = 1u << 20;
constexpr size_t WS_PCNT = 393216, WS_BAR = 262144, WS_R1S = 0, WS_SS2 = 65536, WS_SS3 = 131072, WS_G = 1 * MiB, WS_H2 = 2 * MiB;
constexpr size_t WS_WA = 4 * MiB, WS_WB = 8 * MiB, WS_WOUT = 12 * MiB, WS_WGU = 20 * MiB, WS_WD = 64 * MiB, WS_WIN = 86 * MiB, WS_XB = 130 * MiB;
constexpr size_t WS_FILT = 194 * MiB, WS_HY = 258 * MiB, WS_R1A = 354 * MiB, WS_R1B = 418 * MiB, WS_END = 494 * MiB;
constexpr size_t WS_QKP = 86 * MiB, WS_YA = 150 * MiB, WS_YBF = 354 * MiB, WS_YBB = 386 * MiB, WS_X1B = 86 * MiB, WS_MIX = 194 * MiB, WS_HH = 258 * MiB;
constexpr size_t WS_GSC = 482 * MiB;
constexpr int LDS_BYTES = 155648;

__device__ __forceinline__ unsigned f2bf(float f) { unsigned u = __float_as_uint(f); return (u + 0x7fffu + ((u >> 16) & 1u)) >> 16; }
__device__ __forceinline__ unsigned pk2(float lo, float hi) { unsigned r; asm volatile("v_cvt_pk_bf16_f32 %0, %1, %2" : "=v"(r) : "v"(lo), "v"(hi)); return r; }
__device__ __forceinline__ float bflo(unsigned w) { return __uint_as_float(w << 16); }
__device__ __forceinline__ float bfhi(unsigned w) { return __uint_as_float(w & 0xffff0000u); }
__device__ __forceinline__ float wave_sum(float v) {
#pragma unroll
    for (int o = 1; o < 64; o <<= 1) v += __shfl_xor(v, o);
    return v;
}
__device__ __forceinline__ size_t blk_off(int row, int k, int K) { return ((size_t)(row >> 7) * (size_t)(K >> 6) + (size_t)(k >> 6)) * 8192 + (size_t)((row & 127) * 64 + (k & 63)); }
__device__ __forceinline__ int lane_id_opaque() { int l; asm volatile("v_mbcnt_lo_u32_b32 %0, -1, 0\n\tv_mbcnt_hi_u32_b32 %0, -1, %0" : "=v"(l)); return l; }
__device__ __forceinline__ float sigmoidf_(float x) { return 1.0f / (1.0f + __expf(-x)); }
__device__ __forceinline__ float siluf_(float x) { return x / (1.0f + __expf(-x)); }

namespace pg8 {
constexpr int BM = 256, BK = 64, HALF = 128, HTB = HALF * BK * 2, STAGE_BYTES = 8 * HTB, NXCD = 8, WGM = 8;
__device__ __forceinline__ int lds_byte(int r, int c) { const int st = (r >> 4) * 2 + (c >> 5), rr = r & 15, cc = c & 31, ob = rr * 64 + cc * 2; return st * 1024 + (ob ^ (((ob >> 9) & 1) << 5)); }
__device__ __forceinline__ void stage_rc(int b, int& R, int& C) { const int st = b / 1024, sb = b % 1024, swz = sb ^ (((sb >> 9) & 1) << 5); R = (st >> 1) * 16 + swz / 64; C = (st & 1) * 32 + (swz % 64) / 2; }
__device__ __forceinline__ int perm32(int rho) { const int n = rho >> 4, i = rho & 15; return 8 * (i >> 2) + 4 * n + (i & 3); }
struct GUnit { const char* A; const char* B; int pm, pn, sub; };
__device__ __forceinline__ void tile_of(int L, int nM, int nN, int& pm, int& pn) {
    const int nwg = nM * nN; int wgid = L; { const int q = nwg / NXCD, r = nwg % NXCD, xcd = wgid % NXCD, off = wgid / NXCD; wgid = (xcd < r ? xcd * (q + 1) : r * (q + 1) + (xcd - r) * q) + off; }
    const int nig = WGM * nN, gid = wgid / nig, fm = gid * WGM, gsz = (nM - fm) < WGM ? (nM - fm) : WGM;
    pm = fm + ((wgid % nig) % gsz); pn = (wgid % nig) / gsz;
}
typedef f32x4 Acc[2][2][4][2];
template <class Prog>
__device__ __forceinline__ void gemm_stream(LAS unsigned char* lds, const Prog& P, int wv) {
    int tid = (wv << 6) | lane_id_opaque(); asm volatile("" : "+v"(tid));
    const int wid = __builtin_amdgcn_readfirstlane(tid >> 6), lane = tid & 63, wr = wid >> 2, wc = wid & 3, fr = lane & 15, fq = lane >> 4;
    const int K = P.K, nt = K / BK;
    unsigned voffA[2], voffB[2];
#pragma unroll
    for (int i = 0; i < 2; ++i) { int R, C; stage_rc(tid * 16 + i * 8192, R, C); const int Rb = Prog::PERM ? ((R & ~31) + perm32(R & 31)) : R;
        voffA[i] = (unsigned)(R * 64 + C) * 2u; voffB[i] = (unsigned)(Rb * 64 + C) * 2u; }
    const size_t kstep = (size_t)(HALF * BK * 2);
    const size_t hstep = (size_t)HALF * K * 2;
    const unsigned ldsw = (unsigned)wid * 1024u;
    const int aoff = lds_byte(wr * 64 + fr, fq * 8), boff = lds_byte(wc * 32 + fr, fq * 8);
#define PG8_SA(b, h) (((b) * 2 + (h)) * HTB)
#define PG8_SB(b, h) ((4 + (b) * 2 + (h)) * HTB)
#define PG8_STAGE(bufoff, gbase, voff) do { _Pragma("unroll") for (int _i = 0; _i < 2; ++_i) \
        __builtin_amdgcn_global_load_lds((const unsigned*)((const char*)(gbase) + (voff)[_i]), (LAS unsigned*)(lds + (bufoff) + ldsw + _i * 8192), 16, 0, 0); } while (0)
#define PG8_LDA(dst, b, h) do { _Pragma("unroll") for (int m = 0; m < 4; ++m) _Pragma("unroll") for (int k = 0; k < 2; ++k) dst[m][k] = *(const LAS bf16x8*)(lds + PG8_SA(b, h) + aoff + m * 2048 + k * 1024); } while (0)
#define PG8_LDB(dst, b, h) do { _Pragma("unroll") for (int n = 0; n < 2; ++n) _Pragma("unroll") for (int k = 0; k < 2; ++k) dst[n][k] = *(const LAS bf16x8*)(lds + PG8_SB(b, h) + boff + n * 2048 + k * 1024); } while (0)
#define PG8_MMA(ai, bj, At, Bt) do { __builtin_amdgcn_s_setprio(1); _Pragma("unroll") for (int m = 0; m < 4; ++m) _Pragma("unroll") for (int n = 0; n < 2; ++n) _Pragma("unroll") for (int k = 0; k < 2; ++k) \
        acc[ai][bj][m][n] = __builtin_amdgcn_mfma_f32_16x16x32_bf16(Bt[n][k], At[m][k], acc[ai][bj][m][n], 0, 0, 0); __builtin_amdgcn_s_setprio(0); } while (0)
#define PG8_WAIT_V(n) asm volatile("s_waitcnt vmcnt(" #n ")" ::: "memory")
#define PG8_WAIT_L(n) asm volatile("s_waitcnt lgkmcnt(" #n ")" ::: "memory")
#define PG8_BAR __builtin_amdgcn_s_barrier()
#define PG8_SCHED __builtin_amdgcn_sched_barrier(0)
    GUnit cur, nxt; int ui = 0;
    if (!P.next(0, cur)) return;
    f32x4 acc[2][2][4][2];
#pragma unroll
    for (int a = 0; a < 2; ++a)
#pragma unroll
        for (int b = 0; b < 2; ++b)
#pragma unroll
            for (int m = 0; m < 4; ++m)
#pragma unroll
                for (int n = 0; n < 2; ++n) acc[a][b][m][n] = (f32x4){0.f, 0.f, 0.f, 0.f};
    bf16x8 At[4][2], B0[2][2], B1[2][2];
    const char* cA = cur.A; const char* cB = cur.B;
    PG8_STAGE(PG8_SB(0, 0), cB, voffB); PG8_STAGE(PG8_SA(0, 0), cA, voffA); PG8_STAGE(PG8_SB(0, 1), cB + hstep, voffB); PG8_STAGE(PG8_SA(0, 1), cA + hstep, voffA);
    if (wr == 1) PG8_BAR;
    PG8_WAIT_V(4); PG8_BAR;
    PG8_STAGE(PG8_SB(1, 0), cB + kstep, voffB); PG8_STAGE(PG8_SA(1, 0), cA + kstep, voffA); PG8_STAGE(PG8_SB(1, 1), cB + hstep + kstep, voffB);
    PG8_WAIT_V(6); PG8_BAR;
    for (;;) {
        const bool has_next = P.next(ui + 1, nxt);
        const char* nA = has_next ? nxt.A : cA; const char* nB = has_next ? nxt.B : cB;
        for (int t = 0; t < nt; t += 2) {
            const bool last = (t == nt - 2);
            const char* a1 = cA + (size_t)(t + 1) * kstep;
            const char* a2 = last ? nA : cA + (size_t)(t + 2) * kstep; const char* b2 = last ? nB : cB + (size_t)(t + 2) * kstep;
            const char* a3 = a2 + kstep; const char* b3 = b2 + kstep;
            PG8_LDB(B0, 0, 0); PG8_SCHED; PG8_LDA(At, 0, 0); PG8_STAGE(PG8_SA(1, 1), a1 + hstep, voffA);
            PG8_WAIT_L(8); PG8_BAR; PG8_WAIT_L(0); PG8_MMA(0, 0, At, B0); PG8_BAR; PG8_SCHED;
            PG8_LDB(B1, 0, 1); PG8_STAGE(PG8_SB(0, 0), b2, voffB);
            PG8_BAR; PG8_WAIT_L(0); PG8_MMA(0, 1, At, B1); PG8_BAR;
            PG8_LDA(At, 0, 1); PG8_STAGE(PG8_SA(0, 0), a2, voffA);
            PG8_BAR; PG8_WAIT_L(0); PG8_MMA(1, 0, At, B0); PG8_BAR; PG8_SCHED;
            PG8_STAGE(PG8_SB(0, 1), b2 + hstep, voffB);
            PG8_WAIT_V(6); PG8_BAR; PG8_MMA(1, 1, At, B1); PG8_BAR;
            PG8_LDB(B0, 1, 0); PG8_SCHED; PG8_LDA(At, 1, 0); PG8_STAGE(PG8_SA(0, 1), a2 + hstep, voffA);
            PG8_WAIT_L(8); PG8_BAR; PG8_WAIT_L(0); PG8_MMA(0, 0, At, B0); PG8_BAR; PG8_SCHED;
            PG8_LDB(B1, 1, 1); PG8_STAGE(PG8_SB(1, 0), b3, voffB);
            PG8_BAR; PG8_WAIT_L(0); PG8_MMA(0, 1, At, B1); PG8_BAR;
            PG8_LDA(At, 1, 1); PG8_STAGE(PG8_SA(1, 0), a3, voffA);
            PG8_BAR; PG8_WAIT_L(0); PG8_MMA(1, 0, At, B0); PG8_BAR; PG8_SCHED;
            PG8_STAGE(PG8_SB(1, 1), b3 + hstep, voffB);
            PG8_WAIT_V(6); PG8_BAR; PG8_MMA(1, 1, At, B1); PG8_BAR;
        }
        P.epi(acc, cur, wr, wc, fr, fq);
        if (!has_next) break;
        cur = nxt; cA = nA; cB = nB; ++ui;
    }
    PG8_WAIT_V(0);
    if (wr == 0) PG8_BAR;
    PG8_BAR;
#undef PG8_SA
#undef PG8_SB
#undef PG8_STAGE
#undef PG8_LDA
#undef PG8_LDB
#undef PG8_MMA
#undef PG8_WAIT_V
#undef PG8_WAIT_L
#undef PG8_BAR
#undef PG8_SCHED
}
__device__ __forceinline__ void zero_acc(Acc& acc) {
#pragma unroll
    for (int a = 0; a < 2; ++a)
#pragma unroll
        for (int b = 0; b < 2; ++b)
#pragma unroll
            for (int m = 0; m < 4; ++m)
#pragma unroll
                for (int n = 0; n < 2; ++n) acc[a][b][m][n] = (f32x4){0.f, 0.f, 0.f, 0.f};
}
}
using pg8::GUnit; using pg8::Acc;
__device__ __forceinline__ void unpack8(u32x4 w, float (&f)[8]) { f[0] = bflo(w.x); f[1] = bfhi(w.x); f[2] = bflo(w.y); f[3] = bfhi(w.y); f[4] = bflo(w.z); f[5] = bfhi(w.z); f[6] = bflo(w.w); f[7] = bfhi(w.w); }
struct HyProg {
    static constexpr bool PERM = true; int K, G, c; const bf16_t* W; const bf16_t* X; bf16_t* HY; const float* r1;
    __device__ __forceinline__ bool next(int i, GUnit& u) const { const int L = i * G + c; if (L >= 12 * 64) return false; pg8::tile_of(L, 12, 64, u.pm, u.pn);
        u.A = (const char*)(W + (size_t)u.pm * 256 * DM); u.B = (const char*)(X + (size_t)u.pn * 256 * DM); u.sub = 0; return true; }
    __device__ __forceinline__ void epi(Acc& acc, const GUnit& u, int wr, int wc, int fr, int fq) const {
        const int row0 = u.pm * 256 + wr * 64 + fr, col0 = u.pn * 256 + wc * 32 + 8 * fq;
        f32x4 sc[2][2];
#pragma unroll
        for (int bj = 0; bj < 2; ++bj) { sc[bj][0] = *(const f32x4*)(r1 + col0 + bj * 128); sc[bj][1] = *(const f32x4*)(r1 + col0 + bj * 128 + 4); }
#pragma unroll
        for (int ai = 0; ai < 2; ++ai)
#pragma unroll
            for (int m = 0; m < 4; ++m) { bf16_t* rowp = HY + (size_t)(row0 + ai * 128 + m * 16) * TOK + col0;
#pragma unroll
                for (int bj = 0; bj < 2; ++bj) { const f32x4 v0 = acc[ai][bj][m][0] * sc[bj][0], v1 = acc[ai][bj][m][1] * sc[bj][1];
                    u32x4 w; w.x = pk2(v0[0], v0[1]); w.y = pk2(v0[2], v0[3]); w.z = pk2(v1[0], v1[1]); w.w = pk2(v1[2], v1[3]);
                    *(u32x4*)(rowp + bj * 128) = w; } }
        pg8::zero_acc(acc);
    }
};
struct RestProg {
    static constexpr bool PERM = true; int K, G, c; const bf16_t* W; const bf16_t* X; bf16_t* R1A; bf16_t* R1B; bf16_t* R2; const float* r1;
    __device__ __forceinline__ bool next(int i, GUnit& u) const { const int L = i * G + c; if (L >= 64 * 32) return false; pg8::tile_of(L, 64, 32, u.pm, u.pn);
        u.A = (const char*)(X + (size_t)u.pm * 256 * DM); u.B = (const char*)(W + (size_t)(3072 + u.pn * 256) * DM); u.sub = 0; return true; }
    __device__ __forceinline__ void epi(Acc& acc, const GUnit& u, int wr, int wc, int fr, int fq) const {
        const int row0 = u.pm * 256 + wr * 64 + fr; const bool sg = u.pn >= 12;
        bf16_t* base = u.pn < 8 ? R1A + u.pn * 256 : (u.pn < 16 ? R1B + (u.pn - 8) * 256 : R2 + (u.pn - 16) * 256);
        const int pitch = u.pn < 16 ? 2048 : 4096;
        const int col0 = wc * 32 + 8 * fq;
        float rs[2][4];
#pragma unroll
        for (int ai = 0; ai < 2; ++ai)
#pragma unroll
            for (int m = 0; m < 4; ++m) rs[ai][m] = r1[row0 + ai * 128 + m * 16];
#pragma unroll
        for (int ai = 0; ai < 2; ++ai)
#pragma unroll
            for (int m = 0; m < 4; ++m) { const int row = row0 + ai * 128 + m * 16; const float s = rs[ai][m]; bf16_t* rowp = base + (size_t)row * pitch + col0;
#pragma unroll
                for (int bj = 0; bj < 2; ++bj) { f32x4 v0 = acc[ai][bj][m][0] * s, v1 = acc[ai][bj][m][1] * s;
                    if (sg) {
#pragma unroll
                        for (int j = 0; j < 4; ++j) { v0[j] = sigmoidf_(v0[j]); v1[j] = sigmoidf_(v1[j]); } }
                    u32x4 w; w.x = pk2(v0[0], v0[1]); w.y = pk2(v0[2], v0[3]); w.z = pk2(v1[0], v1[1]); w.w = pk2(v1[2], v1[3]);
                    *(u32x4*)(rowp + bj * 128) = w; } }
        pg8::zero_acc(acc);
    }
};
struct BranchProg {
    static constexpr bool PERM = true; int K, G, c; const bf16_t *YA, *YBF, *YBB, *WA, *WB; const bf16_t* R2; bf16_t* MIX;
    __device__ __forceinline__ bool next(int i, GUnit& u) const { const int ti = i / 3, sub = i - 3 * ti; const int L = ti * G + c; if (L >= 64 * 8) return false; pg8::tile_of(L, 64, 8, u.pm, u.pn);
        const bf16_t* a = sub == 0 ? YA : (sub == 1 ? YBF : YBB); const bf16_t* b = sub == 0 ? WA : WB;
        u.A = (const char*)(a + (size_t)u.pm * 256 * 1024); u.B = (const char*)(b + (size_t)u.pn * 256 * 1024); u.sub = sub; return true; }
    __device__ __forceinline__ void epi(Acc& acc, const GUnit& u, int wr, int wc, int fr, int fq) const {
        if (u.sub == 1) return;
        const int row0 = u.pm * 256 + wr * 64 + fr, col0 = u.pn * 256 + wc * 32 + 8 * fq;
#pragma unroll
        for (int ai = 0; ai < 2; ++ai) {
            u32x4 gbw[4][2], gaw[4][2];
#pragma unroll
            for (int m = 0; m < 4; ++m)
#pragma unroll
                for (int bj = 0; bj < 2; ++bj) { const bf16_t* gp = R2 + (size_t)(row0 + ai * 128 + m * 16) * 4096 + col0 + bj * 128;
                    gbw[m][bj] = *(const u32x4*)(gp + 2048); if (u.sub == 0) gaw[m][bj] = *(const u32x4*)gp; else gaw[m][bj] = gbw[m][bj]; }
#pragma unroll
            for (int m = 0; m < 4; ++m) { const int row = row0 + ai * 128 + m * 16;
#pragma unroll
                for (int bj = 0; bj < 2; ++bj) {
                    float gb[8], ga[8]; unpack8(gbw[m][bj], gb); unpack8(gaw[m][bj], ga);
                    if (u.sub == 0) {
#pragma unroll
                        for (int j = 0; j < 4; ++j) { acc[ai][bj][m][0][j] *= ga[j] / fmaxf(gb[j], 1e-30f); acc[ai][bj][m][1][j] *= ga[4 + j] / fmaxf(gb[4 + j], 1e-30f); }
                    } else {
                        f32x4 v0 = acc[ai][bj][m][0], v1 = acc[ai][bj][m][1];
#pragma unroll
                        for (int j = 0; j < 4; ++j) { v0[j] *= fmaxf(gb[j], 1e-30f); v1[j] *= fmaxf(gb[4 + j], 1e-30f); }
                        u32x4 w; w.x = pk2(v0[0], v0[1]); w.y = pk2(v0[2], v0[3]); w.z = pk2(v1[0], v1[1]); w.w = pk2(v1[2], v1[3]);
                        *(u32x4*)(MIX + blk_off(row, col0 + bj * 128, DM)) = w;
                    } } }
        }
        if (u.sub == 2) pg8::zero_acc(acc);
    }
};
struct ResProg {
    static constexpr bool PERM = false; int K, G, c; const bf16_t* A; const bf16_t* B; const float* base; const bf16_t* base16; float* out; bf16_t* outb; float* ss;
    __device__ __forceinline__ bool next(int i, GUnit& u) const { const int L = i * G + c; if (L >= 64 * 8) return false; pg8::tile_of(L, 64, 8, u.pm, u.pn);
        u.A = (const char*)(A + (size_t)u.pm * 256 * K); u.B = (const char*)(B + (size_t)u.pn * 256 * K); u.sub = 0; return true; }
    __device__ __forceinline__ void epi(Acc& acc, const GUnit& u, int wr, int wc, int fr, int fq) const {
        const int row0 = u.pm * 256 + wr * 64 + fr, col0 = u.pn * 256 + wc * 32 + 4 * fq;
#pragma unroll
        for (int ai = 0; ai < 2; ++ai) {
            f32x4 bs[4][2][2];
#pragma unroll
            for (int m = 0; m < 4; ++m)
#pragma unroll
                for (int bj = 0; bj < 2; ++bj)
#pragma unroll
                    for (int n = 0; n < 2; ++n) { const int row = row0 + ai * 128 + m * 16, col = col0 + bj * 128 + n * 16;
                        if (base16) { const u32x2 w = *(const u32x2*)(base16 + blk_off(row, col, DM)); bs[m][bj][n] = (f32x4){bflo(w.x), bfhi(w.x), bflo(w.y), bfhi(w.y)}; }
                        else bs[m][bj][n] = *(const f32x4*)(base + (size_t)row * DM + col); }
#pragma unroll
            for (int m = 0; m < 4; ++m) { const int row = row0 + ai * 128 + m * 16; const size_t off = (size_t)row * DM + col0; float s = 0.f;
#pragma unroll
                for (int bj = 0; bj < 2; ++bj)
#pragma unroll
                    for (int n = 0; n < 2; ++n) { const f32x4 o = bs[m][bj][n] + acc[ai][bj][m][n];
                        if (out) *(f32x4*)(out + off + bj * 128 + n * 16) = o;
                        s += (o[0] * o[0] + o[1] * o[1]) + (o[2] * o[2] + o[3] * o[3]);
                        if (outb) { u32x2 w; w.x = pk2(o[0], o[1]); w.y = pk2(o[2], o[3]); *(u32x2*)(outb + blk_off(row, col0 + bj * 128 + n * 16, DM)) = w; } }
                s += __shfl_xor(s, 16); s += __shfl_xor(s, 32);
                if (fq == 0) unsafeAtomicAdd(ss + row, s); }
        }
        pg8::zero_acc(acc);
    }
};
struct GuProg {
    static constexpr bool PERM = true; int K, G, c; const bf16_t* X; const bf16_t* W; bf16_t* HH; const float* ss2;
    __device__ __forceinline__ bool next(int i, GUnit& u) const { const int L = i * G + c; if (L >= 64 * 44) return false; pg8::tile_of(L, 64, 44, u.pm, u.pn);
        u.A = (const char*)(X + (size_t)u.pm * 256 * DM); u.B = (const char*)(W + (size_t)u.pn * 256 * DM); u.sub = 0; return true; }
    __device__ __forceinline__ void epi(Acc& acc, const GUnit& u, int wr, int wc, int fr, int fq) const {
        const int row0 = u.pm * 256 + wr * 64 + fr, col0 = u.pn * 128 + wc * 32 + 8 * fq;
        float sq[2][4];
#pragma unroll
        for (int ai = 0; ai < 2; ++ai)
#pragma unroll
            for (int m = 0; m < 4; ++m) sq[ai][m] = ss2[row0 + ai * 128 + m * 16];
#pragma unroll
        for (int ai = 0; ai < 2; ++ai)
#pragma unroll
            for (int m = 0; m < 4; ++m) { const int row = row0 + ai * 128 + m * 16; const float r2 = 1.0f / sqrtf(sq[ai][m] * (1.0f / DM) + RMS_EPS);
                float hv[8];
#pragma unroll
                for (int n = 0; n < 2; ++n)
#pragma unroll
                    for (int j = 0; j < 4; ++j) { const float g = acc[ai][0][m][n][j] * r2, uu = acc[ai][1][m][n][j] * r2; hv[4 * n + j] = siluf_(g) * uu; }
                u32x4 w; w.x = pk2(hv[0], hv[1]); w.y = pk2(hv[2], hv[3]); w.z = pk2(hv[4], hv[5]); w.w = pk2(hv[6], hv[7]);
                *(u32x4*)(HH + blk_off(row, col0, FFH)) = w; }
        pg8::zero_acc(acc);
    }
};
struct Ctx {
    const float* in[21]; float* out; unsigned char* ws;
};
struct TpItem { const float* W; const float* ks; bf16_t* WT; int Nsrc, K, dst_row0, src_col0, kb; };
__device__ __forceinline__ TpItem tp_decode(const Ctx& C, int it) {
    constexpr int I_IN = 32 * 352, I_A = 16 * 64, I_O = 32 * 64, I_GU = 32 * 352;
    unsigned char* ws = C.ws; TpItem t; int r = it;
    if (r < I_IN) { const int nb = r % 352, n0 = nb * 32; t.W = C.in[2]; t.ks = C.in[1]; t.WT = (bf16_t*)(ws + WS_WIN); t.Nsrc = INCOLS; t.K = DM; t.dst_row0 = n0; t.src_col0 = n0 < 7168 ? n0 : n0 + 16; t.kb = r / 352; return t; } r -= I_IN;
    if (r < I_A) { t.W = C.in[14]; t.ks = nullptr; t.WT = (bf16_t*)(ws + WS_WA); t.Nsrc = DM; t.K = HW; t.dst_row0 = (r % 64) * 32; t.src_col0 = t.dst_row0; t.kb = r / 64; return t; } r -= I_A;
    if (r < I_A) { t.W = C.in[15]; t.ks = nullptr; t.WT = (bf16_t*)(ws + WS_WB); t.Nsrc = DM; t.K = MW; t.dst_row0 = (r % 64) * 32; t.src_col0 = t.dst_row0; t.kb = r / 64; return t; } r -= I_A;
    if (r < I_O) { t.W = C.in[16]; t.ks = nullptr; t.WT = (bf16_t*)(ws + WS_WOUT); t.Nsrc = DM; t.K = DM; t.dst_row0 = (r % 64) * 32; t.src_col0 = t.dst_row0; t.kb = r / 64; return t; } r -= I_O;
    if (r < I_GU) { const int nb = r % 352, n0 = nb * 32; const int pn = n0 >> 8, half = (n0 >> 7) & 1, i = n0 & 127;
        t.W = C.in[18]; t.ks = C.in[17]; t.WT = (bf16_t*)(ws + WS_WGU); t.Nsrc = 2 * FFH; t.K = DM; t.dst_row0 = n0; t.src_col0 = half * FFH + 128 * pn + i; t.kb = r / 352; return t; } r -= I_GU;
    t.W = C.in[19]; t.ks = nullptr; t.WT = (bf16_t*)(ws + WS_WD); t.Nsrc = DM; t.K = FFH; t.dst_row0 = (r % 64) * 32; t.src_col0 = t.dst_row0; t.kb = r / 64; return t;
}
__device__ __forceinline__ void tp_load(const TpItem& t, int lane, float (&tv)[32], float (&sv)[32]) {
    const int k0 = 64 * t.kb; const float* wp = t.W + (size_t)(k0 + (lane >> 5)) * t.Nsrc + t.src_col0 + (lane & 31);
#pragma unroll
    for (int i = 0; i < 32; ++i) tv[i] = wp[(size_t)(2 * i) * t.Nsrc];
    const float* kp = t.ks ? t.ks + k0 + (lane >> 5) : nullptr;
#pragma unroll
    for (int i = 0; i < 32; ++i) sv[i] = kp ? kp[2 * i] : 1.0f;
}
__device__ __forceinline__ void p0_prologue(const Ctx& C, LAS unsigned char* lds, int G, int wv) {
    int tid = (wv << 6) | lane_id_opaque(); asm volatile("" : "+v"(tid));
    const int lane = tid & 63, wave = __builtin_amdgcn_readfirstlane(tid >> 6);
    const int gw = blockIdx.x * 8 + wave, NGW = G * 8;
    unsigned char* ws = C.ws;
    LAS float* scr = (LAS float*)(lds + 67584 + wave * 8704);
    {
        constexpr int WGP = 2056;
        LAS bf16_t* wgb = (LAS bf16_t*)lds;
        const float* w_in = C.in[2]; const float* nw = C.in[1];
#pragma unroll 1
        for (int i0 = tid; i0 < DM * 16; i0 += 512 * 16) { float tw[16], tn[16];
#pragma unroll
            for (int u = 0; u < 16; ++u) { const int i = i0 + 512 * u, k = i >> 4, g = i & 15; tw[u] = w_in[(size_t)k * INCOLS + 7168 + g]; tn[u] = nw[k]; }
#pragma unroll
            for (int u = 0; u < 16; ++u) { const int i = i0 + 512 * u, k = i >> 4, g = i & 15; wgb[g * WGP + k] = (bf16_t)f2bf(tw[u] * tn[u]); } }
        __syncthreads();
    }

    {
        constexpr int NIT = 32 * 352 + 2 * 16 * 64 + 32 * 64 + 32 * 352 + 88 * 64;
        float tv[32], sv[32]; TpItem cur, nxt; int it = gw;
        if (it < NIT) { cur = tp_decode(C, it); tp_load(cur, lane, tv, sv); }
        while (it < NIT) {
#pragma unroll
            for (int i = 0; i < 32; ++i) scr[(2 * i + (lane >> 5)) * 33 + (lane & 31)] = tv[i] * sv[i];
            asm volatile("s_waitcnt lgkmcnt(0)" ::: "memory");
            const int nit = it + NGW;
            if (nit < NIT) { nxt = tp_decode(C, nit); tp_load(nxt, lane, tv, sv); }
            const int c = lane & 7, k0 = 64 * cur.kb;
#pragma unroll
            for (int j = 0; j < 4; ++j) { const int n = (lane >> 3) + 8 * j; const LAS float* sp = scr + (8 * c) * 33 + n;
                u32x4 o; o.x = pk2(sp[0 * 33], sp[1 * 33]); o.y = pk2(sp[2 * 33], sp[3 * 33]); o.z = pk2(sp[4 * 33], sp[5 * 33]); o.w = pk2(sp[6 * 33], sp[7 * 33]);
                *(u32x4*)(cur.WT + blk_off(cur.dst_row0 + n, k0 + 8 * c, cur.K)) = o; }
            asm volatile("s_waitcnt lgkmcnt(0)" ::: "memory");
            cur = nxt; it = nit;
        }
    }
    for (int i = blockIdx.x * 512 + tid; i < TOK; i += G * 512) { ((float*)(ws + WS_SS2))[i] = 0.f; ((float*)(ws + WS_SS3))[i] = 0.f; }
    {
        const float* w1 = C.in[5]; const float* b1 = C.in[6]; const float* f1 = C.in[7]; const float* w2 = C.in[8]; const float* b2 = C.in[9]; const float* f2 = C.in[10];
        float* h2 = (float*)(ws + WS_H2);
        for (int t = gw; t < SEQ; t += NGW) {
            const float tl = (float)t / (float)(SEQ - 1);
            const float omega = 6.283185307179586f * (float)t / (float)SEQ;
            float a = b1[lane] + tl * w1[lane];
            float sn, cs;
            { const int bi = lane & 15; const float fr = 1e-4f + (float)bi * ((15.0f - 1e-4f) / 15.0f); sincosf(omega * fr, &sn, &cs); }
#pragma unroll
            for (int i = 0; i < 16; ++i) a += __shfl(cs, i) * w1[(1 + i) * 64 + lane] - __shfl(sn, i) * w1[(17 + i) * 64 + lane];
            const float h1 = sinf(f1[lane] * a);
            float a2 = b2[lane];
#pragma unroll 8
            for (int i = 0; i < 64; ++i) a2 += __shfl(h1, i) * w2[i * 64 + lane];
            h2[t * 64 + lane] = sinf(f2[lane] * a2);
        }
    }
    {
        constexpr int WGP = 2056; LAS bf16_t* wgb = (LAS bf16_t*)lds;
        const float* x = C.in[0]; bf16_t* xb = (bf16_t*)(ws + WS_XB); float* r1 = (float*)(ws + WS_R1S); float* Gt = (float*)(ws + WS_G); const float* gbias = C.in[13];
        const int r = lane & 15, g = lane >> 4; const bool act = r < 8;
        for (int rb = gw; rb < TOK / 8; rb += NGW) {
            const int row = rb * 8 + (r & 7);
            const float* xp = x + (size_t)row * DM + 8 * g;
            f32x4 acc = {0.f, 0.f, 0.f, 0.f}; float ss = 0.f;
#pragma unroll 1
            for (int k8 = 0; k8 < 64; k8 += 8) {
                f32x4 la[8], lb[8];
#pragma unroll
                for (int u = 0; u < 8; ++u) { la[u] = *(const f32x4*)(xp + 32 * (k8 + u)); lb[u] = *(const f32x4*)(xp + 32 * (k8 + u) + 4); }
#pragma unroll
                for (int u = 0; u < 8; ++u) { const int kk = k8 + u; const f32x4 a = la[u], b = lb[u];
                    ss += ((a.x * a.x + a.y * a.y) + (a.z * a.z + a.w * a.w)) + ((b.x * b.x + b.y * b.y) + (b.z * b.z + b.w * b.w));
                    u32x4 o; o.x = pk2(a.x, a.y); o.y = pk2(a.z, a.w); o.z = pk2(b.x, b.y); o.w = pk2(b.z, b.w);
                    *(u32x4*)(xb + blk_off(row, 32 * kk + 8 * g, DM)) = o;
                    if (!act) { o.x = 0u; o.y = 0u; o.z = 0u; o.w = 0u; }
                    const bf16x8 bw = *(const LAS bf16x8*)(wgb + r * WGP + 32 * kk + 8 * g);
                    acc = __builtin_amdgcn_mfma_f32_16x16x32_bf16(__builtin_bit_cast(bf16x8, o), bw, acc, 0, 0, 0); }
            }
            ss += __shfl_xor(ss, 16); ss += __shfl_xor(ss, 32);
            const float rinv = 1.0f / sqrtf(ss * (1.0f / DM) + RMS_EPS);
            const float gb = gbias[r];
#pragma unroll
            for (int i = 0; i < 4; ++i) { const int m = 4 * g + i; const float rv = __shfl(rinv, m & 7); if (g < 2) Gt[(size_t)(rb * 8 + m) * 16 + r] = acc[i] * rv + gb; }
            if (lane < 8) r1[rb * 8 + lane] = rinv;
        }
    }
}
__device__ __forceinline__ void p1_filters(const Ctx& C, LAS unsigned char* lds, int G, int wv) {
    int tid = (wv << 6) | lane_id_opaque(); asm volatile("" : "+v"(tid));
    const int lane = tid & 63, w = tid >> 6, r = lane & 15, g = lane >> 4;
    const float* w3 = C.in[11]; const float* h2 = (const float*)(C.ws + WS_H2); float* FILT = (float*)(C.ws + WS_FILT);
    for (int item = blockIdx.x; item < 256; item += G) {
        const int n0 = 64 * (item >> 2), t0 = 1024 * (item & 3) + 128 * w;
        bf16x8 af[4][2];
#pragma unroll
        for (int mt = 0; mt < 4; ++mt)
#pragma unroll
            for (int ks = 0; ks < 2; ++ks) { float v[8];
#pragma unroll
                for (int e = 0; e < 8; ++e) v[e] = w3[(size_t)(32 * ks + 8 * g + e) * NFILT + n0 + 16 * mt + r];
                u32x4 o; o.x = pk2(v[0], v[1]); o.y = pk2(v[2], v[3]); o.z = pk2(v[4], v[5]); o.w = pk2(v[6], v[7]); af[mt][ks] = __builtin_bit_cast(bf16x8, o); }
        float dl[4][4];
#pragma unroll
        for (int mt = 0; mt < 4; ++mt)
#pragma unroll
            for (int i = 0; i < 4; ++i) { const int ch = (n0 + 16 * mt + 4 * g + i) & 1023; const float mind = -3.0701134573253945f, maxd = -15.350567286626973f;
                dl[mt][i] = fabsf(mind + (float)ch * ((maxd - mind) / 1023.0f)); }
        bf16x8 bfr[8][2];
#pragma unroll
        for (int nt = 0; nt < 8; ++nt) { const int t = t0 + 16 * nt + r;
#pragma unroll
            for (int ks = 0; ks < 2; ++ks) { const f32x4 a = *(const f32x4*)(h2 + (size_t)t * 64 + 32 * ks + 8 * g), b = *(const f32x4*)(h2 + (size_t)t * 64 + 32 * ks + 8 * g + 4);
                u32x4 o; o.x = pk2(a.x, a.y); o.y = pk2(a.z, a.w); o.z = pk2(b.x, b.y); o.w = pk2(b.z, b.w); bfr[nt][ks] = __builtin_bit_cast(bf16x8, o); } }
#pragma unroll
        for (int nt = 0; nt < 8; ++nt) {
            const int t = t0 + 16 * nt + r;
            const float tl = (float)t / (float)(SEQ - 1);
#pragma unroll
            for (int mt = 0; mt < 4; ++mt) {
                f32x4 acc = {0.f, 0.f, 0.f, 0.f};
                acc = __builtin_amdgcn_mfma_f32_16x16x32_bf16(af[mt][0], bfr[nt][0], acc, 0, 0, 0);
                acc = __builtin_amdgcn_mfma_f32_16x16x32_bf16(af[mt][1], bfr[nt][1], acc, 0, 0, 0);
#pragma unroll
                for (int i = 0; i < 4; ++i) FILT[(size_t)(n0 + 16 * mt + 4 * g + i) * SEQ + t] = acc[i] * expf(-tl * dl[mt][i]);
            }
        }
    }
}
__device__ __forceinline__ void p7_final(const Ctx& C, int G, int wv) {
    int tid = (wv << 6) | lane_id_opaque(); asm volatile("" : "+v"(tid));
    const int lane = tid & 63, wave = tid >> 6, gw = blockIdx.x * 8 + wave, NGW = G * 8;
    const float* ss3 = (const float*)(C.ws + WS_SS3); const float* wf = C.in[20];
    f32x4 w[8];
#pragma unroll
    for (int j = 0; j < 8; ++j) w[j] = ((const f32x4*)wf)[64 * j + lane];
    for (int row = gw; row < TOK; row += 2 * NGW) {
        const int row2 = row + NGW;
        const bool has2 = row2 < TOK;
        const float r = 1.0f / sqrtf(ss3[row] * (1.0f / DM) + RMS_EPS), r2 = has2 ? 1.0f / sqrtf(ss3[row2] * (1.0f / DM) + RMS_EPS) : 0.f;
        f32x4* p = (f32x4*)(C.out + (size_t)row * DM) + lane; f32x4* p2 = (f32x4*)(C.out + (size_t)(has2 ? row2 : row) * DM) + lane;
        f32x4 v[8], u[8];
#pragma unroll
        for (int j = 0; j < 8; ++j) { v[j] = p[64 * j]; u[j] = p2[64 * j]; }
#pragma unroll
        for (int j = 0; j < 8; ++j) p[64 * j] = v[j] * r * w[j];
        if (has2) {
#pragma unroll
            for (int j = 0; j < 8; ++j) p2[64 * j] = u[j] * r2 * w[j]; }
    }
}
#ifndef FFT_HOST
#define FFT_DEV __device__ __forceinline__
#define FFT_PTR LAS f32x2*
#define FFT_SIN(x) __builtin_amdgcn_sinf(x)
#define FFT_COS(x) __builtin_amdgcn_cosf(x)
#else
#define FFT_DEV static inline
#define FFT_PTR f32x2*
#define FFT_SIN(x) sinf(6.283185307179586f * (x))
#define FFT_COS(x) cosf(6.283185307179586f * (x))
#endif
#define PADI(i) ((i) + ((i) >> 4))
FFT_DEV f32x2 cmul(f32x2 a, f32x2 b) { f32x2 r; r.x = a.x * b.x - a.y * b.y; r.y = a.x * b.y + a.y * b.x; return r; }
FFT_DEV f32x2 cmulc(f32x2 a, f32x2 b) { f32x2 r; r.x = a.x * b.x + a.y * b.y; r.y = a.y * b.x - a.x * b.y; return r; }
FFT_DEV f32x2 twid(float frac) { f32x2 r; r.x = FFT_COS(frac); r.y = -FFT_SIN(frac); return r; }
template <int M, int CJ> FFT_DEV f32x2 rot8(f32x2 d) {
    const float R = 0.70710678118654752f; f32x2 r;
    if (M == 0) return d;
    if (M == 2) { if (!CJ) { r.x = d.y; r.y = -d.x; } else { r.x = -d.y; r.y = d.x; } return r; }
    if (M == 1) { if (!CJ) { r.x = R * (d.x + d.y); r.y = R * (d.y - d.x); } else { r.x = R * (d.x - d.y); r.y = R * (d.x + d.y); } return r; }
    if (!CJ) { r.x = R * (d.y - d.x); r.y = -R * (d.x + d.y); } else { r.x = -R * (d.x + d.y); r.y = R * (d.x - d.y); } return r;
}
template <int INV, int ZHI, int LOW> FFT_DEV void fft_r8_pass(FFT_PTR buf, int s, int ls  , int tid) {
#pragma unroll 1
    for (int rep = 0; rep < 2; ++rep) {
        const int bf = tid + rep * 512, j = bf & (s - 1), blk = bf >> ls, base = blk * 8 * s + j;
        f32x2 x[8];
#pragma unroll
        for (int m = 0; m < (ZHI ? 4 : 8); ++m) x[m] = buf[PADI(base + m * s)];
        f32x2 w1 = twid((float)j / (float)(8 * s));
        f32x2 w2 = cmul(w1, w1), w4 = cmul(w2, w2);
        if (!INV) {
            if (ZHI) {
                x[4] = cmul(x[0], w1); x[5] = cmul(rot8<1, 0>(x[1]), w1); x[6] = cmul(rot8<2, 0>(x[2]), w1); x[7] = cmul(rot8<3, 0>(x[3]), w1);
            } else {
                { f32x2 a = x[0], b = x[4]; x[0] = a + b; x[4] = cmul(a - b, w1); }
                { f32x2 a = x[1], b = x[5]; x[1] = a + b; x[5] = cmul(rot8<1, 0>(a - b), w1); }
                { f32x2 a = x[2], b = x[6]; x[2] = a + b; x[6] = cmul(rot8<2, 0>(a - b), w1); }
                { f32x2 a = x[3], b = x[7]; x[3] = a + b; x[7] = cmul(rot8<3, 0>(a - b), w1); }
            }
#pragma unroll
            for (int h = 0; h < 8; h += 4) {
                { f32x2 a = x[h], b = x[h + 2]; x[h] = a + b; x[h + 2] = cmul(a - b, w2); }
                { f32x2 a = x[h + 1], b = x[h + 3]; x[h + 1] = a + b; x[h + 3] = cmul(rot8<2, 0>(a - b), w2); }
            }
#pragma unroll
            for (int m = 0; m < 8; m += 2) { f32x2 a = x[m], b = x[m + 1]; x[m] = a + b; x[m + 1] = cmul(a - b, w4); }
        } else {
#pragma unroll
            for (int m = 0; m < 8; m += 2) { f32x2 a = x[m], b = cmulc(x[m + 1], w4); x[m] = a + b; x[m + 1] = a - b; }
#pragma unroll
            for (int h = 0; h < 8; h += 4) {
                { f32x2 a = x[h], b = cmulc(x[h + 2], w2); x[h] = a + b; x[h + 2] = a - b; }
                { f32x2 a = x[h + 1], b = rot8<2, 1>(cmulc(x[h + 3], w2)); x[h + 1] = a + b; x[h + 3] = a - b; }
            }
            { f32x2 a = x[0], b = cmulc(x[4], w1); x[0] = a + b; if (!LOW) x[4] = a - b; }
            { f32x2 a = x[1], b = rot8<1, 1>(cmulc(x[5], w1)); x[1] = a + b; if (!LOW) x[5] = a - b; }
            { f32x2 a = x[2], b = rot8<2, 1>(cmulc(x[6], w1)); x[2] = a + b; if (!LOW) x[6] = a - b; }
            { f32x2 a = x[3], b = rot8<3, 1>(cmulc(x[7], w1)); x[3] = a + b; if (!LOW) x[7] = a - b; }
        }
#pragma unroll
        for (int m = 0; m < (LOW ? 4 : 8); ++m) buf[PADI(base + m * s)] = x[m];
    }
}
FFT_DEV void fft_r2_span1(FFT_PTR buf, int tid) {
#pragma unroll
    for (int rep = 0; rep < 8; ++rep) { const int p = 2 * (tid + rep * 512); f32x2 a = buf[PADI(p)], b = buf[PADI(p + 1)]; buf[PADI(p)] = a + b; buf[PADI(p + 1)] = a - b; }
}
template <int J, int CJ> FFT_DEV f32x2 rot16(f32x2 d) {
    const float C1 = 0.92387953251128674f, S1 = 0.38268343236508977f;
    if ((J & 1) == 0) return rot8<J / 2, CJ>(d);
    const float wr = (J == 1) ? C1 : (J == 3) ? S1 : (J == 5) ? -S1 : -C1;
    const float wi = ((J == 1) ? -S1 : (J == 3) ? -C1 : (J == 5) ? -C1 : -S1) * (CJ ? -1.f : 1.f);
    f32x2 r; r.x = d.x * wr - d.y * wi; r.y = d.x * wi + d.y * wr; return r;
}
FFT_DEV unsigned brev13(unsigned p);
FFT_DEV void fft16_dif(f32x2 (&x)[16]) {
#define BF_(i, j, ROT) { const f32x2 a_ = x[i], b_ = x[j]; x[i] = a_ + b_; x[j] = ROT(a_ - b_); }
    BF_(0, 8, (rot16<0, 0>)) BF_(1, 9, (rot16<1, 0>)) BF_(2, 10, (rot16<2, 0>)) BF_(3, 11, (rot16<3, 0>)) BF_(4, 12, (rot16<4, 0>)) BF_(5, 13, (rot16<5, 0>)) BF_(6, 14, (rot16<6, 0>)) BF_(7, 15, (rot16<7, 0>))
#pragma unroll
    for (int h = 0; h < 16; h += 8) { BF_(h + 0, h + 4, (rot8<0, 0>)) BF_(h + 1, h + 5, (rot8<1, 0>)) BF_(h + 2, h + 6, (rot8<2, 0>)) BF_(h + 3, h + 7, (rot8<3, 0>)) }
#pragma unroll
    for (int h = 0; h < 16; h += 4) { BF_(h + 0, h + 2, (rot8<0, 0>)) BF_(h + 1, h + 3, (rot8<2, 0>)) }
#pragma unroll
    for (int h = 0; h < 16; h += 2) { BF_(h, h + 1, (rot8<0, 0>)) }
#undef BF_
}
FFT_DEV void fft16_dit_inv(f32x2 (&x)[16]) {
#define BI_(i, j, ROT) { const f32x2 a_ = x[i], b_ = ROT(x[j]); x[i] = a_ + b_; x[j] = a_ - b_; }
#pragma unroll
    for (int h = 0; h < 16; h += 2) { BI_(h, h + 1, (rot8<0, 1>)) }
#pragma unroll
    for (int h = 0; h < 16; h += 4) { BI_(h + 0, h + 2, (rot8<0, 1>)) BI_(h + 1, h + 3, (rot8<2, 1>)) }
#pragma unroll
    for (int h = 0; h < 16; h += 8) { BI_(h + 0, h + 4, (rot8<0, 1>)) BI_(h + 1, h + 5, (rot8<1, 1>)) BI_(h + 2, h + 6, (rot8<2, 1>)) BI_(h + 3, h + 7, (rot8<3, 1>)) }
    BI_(0, 8, (rot16<0, 1>)) BI_(1, 9, (rot16<1, 1>)) BI_(2, 10, (rot16<2, 1>)) BI_(3, 11, (rot16<3, 1>)) BI_(4, 12, (rot16<4, 1>)) BI_(5, 13, (rot16<5, 1>)) BI_(6, 14, (rot16<6, 1>)) BI_(7, 15, (rot16<7, 1>))
#undef BI_
}
template <int MODE> FFT_DEV void fft_mid_pass(FFT_PTR wb, FFT_PTR zk, int tid) {
    f32x2 x[16];
#pragma unroll
    for (int e = 0; e < 16; ++e) x[e] = wb[PADI(16 * tid + e)];
    fft16_dif(x);
    if (MODE != 0) {
#pragma unroll
        for (int e = 0; e < 16; ++e) {
            const unsigned p = 16u * (unsigned)tid + (unsigned)e, f = brev13(p), fn = (8192u - f) & 8191u, pn = brev13(fn);
            const f32x2 zf = zk[PADI(p)], zn = zk[PADI(pn)];
            f32x2 kf;
            if (MODE == 1) { kf.x = 0.5f * (zf.x + zn.x); kf.y = 0.5f * (zf.y - zn.y); }
            else           { kf.x = 0.5f * (zf.y + zn.y); kf.y = 0.5f * (zn.x - zf.x); }
            x[e] = cmul(x[e], kf);
        }
        fft16_dit_inv(x);
    }
#pragma unroll
    for (int e = 0; e < 16; ++e) wb[PADI(16 * tid + e)] = x[e];
}
#ifndef FFT_HOST
#define FFT_SYNC() do { asm volatile("s_waitcnt lgkmcnt(0)" ::: "memory"); __builtin_amdgcn_s_barrier(); asm volatile("" ::: "memory"); } while (0)
__device__ __forceinline__ void fft_fwd_full(FFT_PTR buf, int tid) {
    FFT_SYNC(); fft_r8_pass<0, 0, 0>(buf, 1024, 10, tid); FFT_SYNC(); fft_r8_pass<0, 0, 0>(buf, 128, 7, tid); FFT_SYNC(); fft_r8_pass<0, 0, 0>(buf, 16, 4, tid); FFT_SYNC();
    fft_mid_pass<0>(buf, buf, tid); FFT_SYNC();
}
template <int WHICH> __device__ __forceinline__ void fft_conv(FFT_PTR wb, FFT_PTR zk, int tid) {
    FFT_SYNC(); fft_r8_pass<0, 1, 0>(wb, 1024, 10, tid); FFT_SYNC(); fft_r8_pass<0, 0, 0>(wb, 128, 7, tid); FFT_SYNC(); fft_r8_pass<0, 0, 0>(wb, 16, 4, tid); FFT_SYNC();
    fft_mid_pass<1 + WHICH>(wb, zk, tid); FFT_SYNC();
    fft_r8_pass<1, 0, 0>(wb, 16, 4, tid); FFT_SYNC(); fft_r8_pass<1, 0, 0>(wb, 128, 7, tid); FFT_SYNC(); fft_r8_pass<1, 0, 1>(wb, 1024, 10, tid); FFT_SYNC();
}
#endif
FFT_DEV unsigned brev13(unsigned p) {
    unsigned r = 0;
#ifndef FFT_HOST
    r = __brev(p) >> 19;
#else
    for (int i = 0; i < 13; ++i) r |= ((p >> i) & 1u) << (12 - i);
#endif
    return r;
}
FFT_DEV void fft_pointwise(FFT_PTR wb, FFT_PTR zk, int which, int tid) {
#pragma unroll 4
    for (int rep = 0; rep < 16; ++rep) {
        const unsigned p = tid + rep * 512, f = brev13(p), fn = (8192u - f) & 8191u, pn = brev13(fn);
        const f32x2 zf = zk[PADI(p)], zn = zk[PADI(pn)];
        f32x2 kf;
        if (which == 0) { kf.x = 0.5f * (zf.x + zn.x); kf.y = 0.5f * (zf.y - zn.y); }
        else            { kf.x = 0.5f * (zf.y + zn.y); kf.y = 0.5f * (zn.x - zf.x); }
        wb[PADI(p)] = cmul(wb[PADI(p)], kf);
    }
}
__device__ __forceinline__ void qk_prepass(const Ctx& C, int G, int wv) {
    int tid = (wv << 6) | lane_id_opaque(); asm volatile("" : "+v"(tid));
    const bf16_t* R1A = (const bf16_t*)(C.ws + WS_R1A); bf16_t* QKP = (bf16_t*)(C.ws + WS_QKP);
    const float* cw = C.in[3]; const float* cb = C.in[4];
    const int cg8 = tid & 255, half = tid >> 8, col = 8 * cg8;
    float k0[8], k1[8], k2[8], kb[8];
    { const int ch = 3072 + col;
      const f32x4 t0 = *(const f32x4*)(cw + ch), t1 = *(const f32x4*)(cw + ch + 4), t2 = *(const f32x4*)(cw + CONVC + ch), t3 = *(const f32x4*)(cw + CONVC + ch + 4);
      const f32x4 t4 = *(const f32x4*)(cw + 2 * CONVC + ch), t5 = *(const f32x4*)(cw + 2 * CONVC + ch + 4), t6 = *(const f32x4*)(cb + ch), t7 = *(const f32x4*)(cb + ch + 4);
#pragma unroll
      for (int e = 0; e < 4; ++e) { k0[e] = t0[e]; k0[4 + e] = t1[e]; k1[e] = t2[e]; k1[4 + e] = t3[e]; k2[e] = t4[e]; k2[4 + e] = t5[e]; kb[e] = t6[e]; kb[4 + e] = t7[e]; } }
    const float osc = col >= 1024 ? 0.0625f : 1.0f;
    for (int run = blockIdx.x; run < TOK / 64; run += G) {
        const int row0 = run * 64 + half * 32;
#pragma unroll 1
        for (int i0 = 0; i0 < 32; i0 += 4) {
            u32x4 w0[4], w1[4], w2[4];
#pragma unroll
            for (int u = 0; u < 4; ++u) { const int row = row0 + i0 + u, t = row & (SEQ - 1); const bf16_t* p = R1A + (size_t)row * 2048 + col;
                w0[u] = *(const u32x4*)(t > 0 ? p - 2048 : p); w1[u] = *(const u32x4*)p; w2[u] = *(const u32x4*)(t < SEQ - 1 ? p + 2048 : p); }
#pragma unroll
            for (int u = 0; u < 4; ++u) { const int row = row0 + i0 + u, t = row & (SEQ - 1);
                const u32x4 z = {0u, 0u, 0u, 0u}; if (t == 0) w0[u] = z; if (t == SEQ - 1) w2[u] = z;
                float a0[8], a1[8], a2[8]; unpack8(w0[u], a0); unpack8(w1[u], a1); unpack8(w2[u], a2);
                float v[8];
#pragma unroll
                for (int e = 0; e < 8; ++e) v[e] = siluf_(k0[e] * a0[e] + k1[e] * a1[e] + k2[e] * a2[e] + kb[e]) * osc;
                u32x4 o; o.x = pk2(v[0], v[1]); o.y = pk2(v[2], v[3]); o.z = pk2(v[4], v[5]); o.w = pk2(v[6], v[7]);
                *(u32x4*)(QKP + (size_t)row * 2048 + col) = o; }
        }
    }
}
constexpr int ML_KS = 0, ML_KP = 528, ML_SS = 76032, ML_SP = 272, ML_VS = 110848, ML_VP = 80, ML_VW = 121088, ML_CS = 131328, ML_CP = 528, ML_SC = 148224;
static_assert(ML_SC + 7 * 512 + 64 + 5 * 128 <= LDS_BYTES - 16, "mLSTM LDS map");
__device__ __forceinline__ bf16x8 tr_read2(unsigned a0, unsigned a1) {
    bf16x4 lo, hi;
    asm volatile("ds_read_b64_tr_b16 %0, %2\n\tds_read_b64_tr_b16 %1, %3\n\ts_waitcnt lgkmcnt(0)" : "=&v"(lo), "=&v"(hi) : "v"(a0), "v"(a1) : "memory");
    bf16x8 r; r[0] = lo[0]; r[1] = lo[1]; r[2] = lo[2]; r[3] = lo[3]; r[4] = hi[0]; r[5] = hi[1]; r[6] = hi[2]; r[7] = hi[3]; return r;
}
__device__ __forceinline__ bf16x8 cat4(bf16x4 lo, bf16x4 hi) { bf16x8 r; r[0] = lo[0]; r[1] = lo[1]; r[2] = lo[2]; r[3] = lo[3]; r[4] = hi[0]; r[5] = hi[1]; r[6] = hi[2]; r[7] = hi[3]; return r; }
__device__ __forceinline__ void tr_read2x2(unsigned a, unsigned b, unsigned d, bf16x8& ra, bf16x8& rb) {
    bf16x4 l0, h0, l1, h1;
    asm volatile("ds_read_b64_tr_b16 %0, %4\n\tds_read_b64_tr_b16 %1, %5\n\tds_read_b64_tr_b16 %2, %6\n\tds_read_b64_tr_b16 %3, %7\n\ts_waitcnt lgkmcnt(0)"
        : "=&v"(l0), "=&v"(h0), "=&v"(l1), "=&v"(h1) : "v"(a), "v"(a + d), "v"(b), "v"(b + d) : "memory");
    ra = cat4(l0, h0); rb = cat4(l1, h1);
}
__device__ __forceinline__ void tr_read4x2(unsigned a, unsigned b, unsigned d, unsigned c, unsigned e, unsigned d2, bf16x8& ra, bf16x8& rb, bf16x8& rc, bf16x8& re) {
    bf16x4 l0, h0, l1, h1, l2, h2, l3, h3;
    asm volatile("ds_read_b64_tr_b16 %0, %8\n\tds_read_b64_tr_b16 %1, %9\n\tds_read_b64_tr_b16 %2, %10\n\tds_read_b64_tr_b16 %3, %11\n\t"
                 "ds_read_b64_tr_b16 %4, %12\n\tds_read_b64_tr_b16 %5, %13\n\tds_read_b64_tr_b16 %6, %14\n\tds_read_b64_tr_b16 %7, %15\n\ts_waitcnt lgkmcnt(0)"
        : "=&v"(l0), "=&v"(h0), "=&v"(l1), "=&v"(h1), "=&v"(l2), "=&v"(h2), "=&v"(l3), "=&v"(h3)
        : "v"(a), "v"(a + d), "v"(b), "v"(b + d), "v"(c), "v"(c + d2), "v"(e), "v"(e + d2) : "memory");
    ra = cat4(l0, h0); rb = cat4(l1, h1); rc = cat4(l2, h2); re = cat4(l3, h3);
}
__device__ __forceinline__ float bf2f(short s) { return __uint_as_float(((unsigned)(unsigned short)s) << 16); }
__device__ __forceinline__ float logsigmoidf_(float x) { return fminf(x, 0.f) - log1pf(expf(-fabsf(x))); }

__device__ __forceinline__ void mlstm_item(const Ctx& C, LAS unsigned char* lds, int item, int wv) {
    int tid = (wv << 6) | lane_id_opaque(); asm volatile("" : "+v"(tid));
    const int lane = tid & 63, w = __builtin_amdgcn_readfirstlane(tid >> 6), r = lane & 15, g = lane >> 4, q4 = r >> 2, p4 = r & 3;
    const int xcd_ = item & 7, yy_ = item >> 3, vs = yy_ & 7, dir = (yy_ >> 3) & 1, bh = 2 * xcd_ + (yy_ >> 4), b = bh >> 2, h = bh & 3;
    const bf16_t* QKP = (const bf16_t*)(C.ws + WS_QKP); const bf16_t* R1B = (const bf16_t*)(C.ws + WS_R1B); const float* Gt = (const float*)(C.ws + WS_G);
    bf16_t* Y = (bf16_t*)(C.ws + (dir ? WS_YBB : WS_YBF));
    LAS float* SC = (LAS float*)(lds + ML_SC);
    LAS float* s_cs = SC, *s_rj = SC + 128, *s_iw = SC + 256, *s_emj = SC + 384, *s_w = SC + 512, *s_dn = SC + 640, *s_misc = SC + 768;
    LAS float* c_bl = SC + 784, *c_mx = SC + 816, *c_mp = SC + 848, *c_mn = SC + 880, *c_kp = SC + 912;
    float* GS = (float*)(C.ws + WS_GSC) + (size_t)item * 3 * SEQ;
    const unsigned lbase = (unsigned)(size_t)lds;
    const int pc = tid & 31, krow = tid >> 5, vrow = tid >> 2, pv = tid & 3;
    const int sw = w < 4 ? w : 11 - w;
    for (int i = tid; i < 16896 / 4; i += 512) ((LAS unsigned*)(lds + ML_CS))[i] = 0u;
    for (int i = tid; i < 16 * ML_KP / 4; i += 512) ((LAS unsigned*)(lds + ML_KS + 128 * ML_KP))[i] = 0u;
    f32x4 Cacc[3][2];
#pragma unroll
    for (int a = 0; a < 3; ++a) { Cacc[a][0] = (f32x4){0.f, 0.f, 0.f, 0.f}; Cacc[a][1] = (f32x4){0.f, 0.f, 0.f, 0.f}; }
    u32x4 kreg[8], vreg, qn[8]; float bn = 0.f, csn = 0.f, pmn = 0.f;
#define ML_TOK(c_, j_) ((size_t)b * SEQ + (dir ? SEQ - 1 - ((c_) * 128 + (j_)) : ((c_) * 128 + (j_))))
#define ML_PREFETCH(c_) do { \
        _Pragma("unroll") for (int i = 0; i < 8; ++i) kreg[i] = *(const u32x4*)(QKP + ML_TOK(c_, krow + 16 * i) * 2048 + 1024 + h * 256 + 8 * pc); \
        vreg = *(const u32x4*)(R1B + ML_TOK(c_, vrow) * 2048 + h * 256 + vs * 32 + 8 * pv); \
        { const bf16_t* qp = QKP + ML_TOK(c_, 16 * sw + r) * 2048 + h * 256 + 8 * g; _Pragma("unroll") for (int kk = 0; kk < 8; ++kk) qn[kk] = *(const u32x4*)(qp + 32 * kk); } \
        if (tid < 128) { const int ta = (c_) * 128 + tid; bn = GS[ta]; csn = GS[SEQ + ta]; pmn = GS[2 * SEQ + ta]; } } while (0)
    {
        float gi[8], gf[8];
#pragma unroll
        for (int u = 0; u < 8; ++u) { const int ta = (4 * w) * 128 + u * 64 + lane; const size_t tk = (size_t)b * SEQ + (dir ? SEQ - 1 - ta : ta);
            gi[u] = Gt[tk * 16 + (dir * 2) * 4 + h]; gf[u] = Gt[tk * 16 + (dir * 2 + 1) * 4 + h]; }
#pragma unroll
        for (int q = 0; q < 4; ++q) {
            const int c = 4 * w + q; float carry_b = 0.f, carry_m = -3.0e38f;
#pragma unroll
            for (int hf = 0; hf < 2; ++hf) {
                const int ta = c * 128 + hf * 64 + lane;
                const float ip = gi[2 * q + hf], fp = gf[2 * q + hf];
                float xs = logsigmoidf_(fp);
#pragma unroll
                for (int o = 1; o < 64; o <<= 1) { const float y = __shfl_up(xs, o); if (lane >= o) xs += y; }
                const float bj = xs + carry_b; const float cj = ip - bj; float pm = cj;
#pragma unroll
                for (int o = 1; o < 64; o <<= 1) { const float y = __shfl_up(pm, o); if (lane >= o) pm = fmaxf(pm, y); }
                pm = fmaxf(pm, carry_m);
                GS[ta] = bj; GS[SEQ + ta] = cj; GS[2 * SEQ + ta] = pm;
                carry_b = __shfl(bj, 63); carry_m = __shfl(pm, 63);
            }
            if (lane == 0) { c_bl[c] = carry_b; c_mx[c] = carry_m; }
        }
        __syncthreads();
        if (tid == 0) { float m = 0.f;
            for (int c = 0; c < 32; ++c) { const float bl = c_bl[c], mn = fmaxf(bl + m, bl + c_mx[c]); c_mp[c] = m; c_mn[c] = mn; c_kp[c] = __expf(bl + m - mn); m = mn; } }
        __syncthreads();
    }
    ML_PREFETCH(0);
    __syncthreads();
#define ML_BAR() do { asm volatile("s_waitcnt lgkmcnt(0)" ::: "memory"); __builtin_amdgcn_s_barrier(); asm volatile("" ::: "memory"); } while (0)
#pragma unroll 1
    for (int c = 0; c < 32; ++c) {
        const float m_prev = c_mp[c], m_new = c_mn[c], keep = c_kp[c], b_last = c_bl[c];
        if (tid < 128) {
            const float inter = bn + m_prev, mj = fmaxf(inter, bn + pmn);
            s_cs[tid] = csn; s_rj[tid] = bn - mj; s_iw[tid] = __expf(inter - mj); s_emj[tid] = __expf(-mj); s_w[tid] = __expf(b_last + csn - m_new);
        }
        ML_BAR();
#pragma unroll
        for (int i = 0; i < 8; ++i) *(LAS u32x4*)(lds + ML_KS + (krow + 16 * i) * ML_KP + pc * 16) = kreg[i];
        {
            *(LAS u32x4*)(lds + ML_VS + vrow * ML_VP + pv * 16) = vreg;
            float f[8]; unpack8(vreg, f); const float ws_ = s_w[vrow];
            u32x4 o; o.x = pk2(f[0] * ws_, f[1] * ws_); o.y = pk2(f[2] * ws_, f[3] * ws_); o.z = pk2(f[4] * ws_, f[5] * ws_); o.w = pk2(f[6] * ws_, f[7] * ws_);
            *(LAS u32x4*)(lds + ML_VW + vrow * ML_VP + pv * 16) = o;
        }
        bf16x8 qf[8];
#pragma unroll
        for (int kk = 0; kk < 8; ++kk) qf[kk] = __builtin_bit_cast(bf16x8, qn[kk]);
        unsigned short ogr[4][2];
#pragma unroll
        for (int i = 0; i < 4; ++i)
#pragma unroll
            for (int vt = 0; vt < 2; ++vt) ogr[i][vt] = R1B[ML_TOK(c, 16 * sw + 4 * g + i) * 2048 + 1024 + h * 256 + vs * 32 + 16 * vt + r];
        if (c < 31) ML_PREFETCH(c + 1);
        ML_BAR();
        {
            const float rjv = s_rj[16 * sw + r]; const int jloc = 16 * sw + r; float den1 = 0.f;
#pragma unroll 2
            for (int st = 0; st < 8; ++st) {
                if (st <= sw) {
                    f32x4 acc = {0.f, 0.f, 0.f, 0.f};
#pragma unroll
                    for (int kk = 0; kk < 8; ++kk) { const bf16x8 kf = *(const LAS bf16x8*)(lds + ML_KS + (16 * st + r) * ML_KP + (32 * kk + 8 * g) * 2); acc = __builtin_amdgcn_mfma_f32_16x16x32_bf16(kf, qf[kk], acc, 0, 0, 0); }
                    const f32x4 c4 = *(const LAS f32x4*)(s_cs + 16 * st + 4 * g);
                    float v[4];
#pragma unroll
                    for (int i = 0; i < 4; ++i) { const int s = 16 * st + 4 * g + i; const float d = (s <= jloc) ? __expf(rjv + c4[i]) : 0.f; v[i] = acc[i] * d; den1 += v[i]; }
                    u32x2 o; o.x = pk2(v[0], v[1]); o.y = pk2(v[2], v[3]);
                    *(LAS u32x2*)(lds + ML_SS + jloc * ML_SP + (16 * st + 4 * g) * 2) = o;
                } else if (st == sw + 1 && !(sw & 1)) {
                    u32x2 o = {0u, 0u}; *(LAS u32x2*)(lds + ML_SS + jloc * ML_SP + (16 * st + 4 * g) * 2) = o;
                }
            }
            den1 += __shfl_xor(den1, 16); den1 += __shfl_xor(den1, 32);
            f32x4 dacc = {0.f, 0.f, 0.f, 0.f};
#pragma unroll
            for (int kk = 0; kk < 8; ++kk) { const bf16x8 kf = *(const LAS bf16x8*)(lds + ML_KS + (128 + r) * ML_KP + (32 * kk + 8 * g) * 2); dacc = __builtin_amdgcn_mfma_f32_16x16x32_bf16(kf, qf[kk], dacc, 0, 0, 0); }
            const float d2 = dacc[0];
            if (g == 0) s_dn[jloc] = den1 + s_iw[jloc] * d2;
        }
        ML_BAR();
        {
            f32x4 n1[2], n2[2];
#pragma unroll
            for (int vt = 0; vt < 2; ++vt) { n1[vt] = (f32x4){0.f, 0.f, 0.f, 0.f}; n2[vt] = (f32x4){0.f, 0.f, 0.f, 0.f}; }
            const int nks = (sw >> 1) + 1;
#pragma unroll 1
            for (int ks = 0; ks < nks; ++ks) {
                const bf16x8 af = *(const LAS bf16x8*)(lds + ML_SS + (16 * sw + r) * ML_SP + (32 * ks + 8 * g) * 2);
                const unsigned a0 = lbase + ML_VS + (32 * ks + 8 * g + q4) * ML_VP + (4 * p4) * 2;
                bf16x8 b0, b1; tr_read2x2(a0, a0 + 32, 4 * ML_VP, b0, b1);
                n1[0] = __builtin_amdgcn_mfma_f32_16x16x32_bf16(af, b0, n1[0], 0, 0, 0); n1[1] = __builtin_amdgcn_mfma_f32_16x16x32_bf16(af, b1, n1[1], 0, 0, 0);
            }
#pragma unroll
            for (int kk = 0; kk < 8; ++kk)
#pragma unroll
                for (int vt = 0; vt < 2; ++vt) { const bf16x8 cf = *(const LAS bf16x8*)(lds + ML_CS + (16 * vt + r) * ML_CP + (32 * kk + 8 * g) * 2); n2[vt] = __builtin_amdgcn_mfma_f32_16x16x32_bf16(qf[kk], cf, n2[vt], 0, 0, 0); }
            const f32x4 iw4 = *(const LAS f32x4*)(s_iw + 16 * sw + 4 * g), dn4 = *(const LAS f32x4*)(s_dn + 16 * sw + 4 * g), em4 = *(const LAS f32x4*)(s_emj + 16 * sw + 4 * g);
#pragma unroll
            for (int i = 0; i < 4; ++i) {
                const size_t tok = ML_TOK(c, 16 * sw + 4 * g + i);
                const float inv = 1.0f / fmaxf(fabsf(dn4[i]), em4[i]);
#pragma unroll
                for (int vt = 0; vt < 2; ++vt) { const int col = h * 256 + vs * 32 + 16 * vt + r;
                    const float og = __uint_as_float(((unsigned)ogr[i][vt]) << 16);
                    const float hv = (n1[vt][i] + iw4[i] * n2[vt][i]) * inv * og;
                    Y[blk_off((int)tok, col, 1024)] = (bf16_t)f2bf(hv); }
            }
        }
        ML_BAR();
        {
#pragma unroll
            for (int a = 0; a < 3; ++a) { Cacc[a][0] *= keep; Cacc[a][1] *= keep; }
#pragma unroll 1
            for (int ks = 0; ks < 4; ++ks) {
                bf16x8 af[3], bq[2];
                { const unsigned av = lbase + ML_VW + (32 * ks + 8 * g + q4) * ML_VP + (4 * p4) * 2, ak = lbase + ML_KS + (32 * ks + 8 * g + q4) * ML_KP + (32 * w + 4 * p4) * 2;
                  tr_read4x2(av, av + 32, 4 * ML_VP, ak, ak + 32, 4 * ML_KP, af[0], af[1], bq[0], bq[1]); }
                { const f32x4 wa = *(const LAS f32x4*)(s_w + 32 * ks + 8 * g), wb = *(const LAS f32x4*)(s_w + 32 * ks + 8 * g + 4);
                  u32x4 o; o.x = pk2(wa[0], wa[1]); o.y = pk2(wa[2], wa[3]); o.z = pk2(wb[0], wb[1]); o.w = pk2(wb[2], wb[3]);
                  if (r != 0) { o.x = 0u; o.y = 0u; o.z = 0u; o.w = 0u; }
                  af[2] = __builtin_bit_cast(bf16x8, o); }
#pragma unroll
                for (int nt = 0; nt < 2; ++nt)
#pragma unroll
                    for (int mt = 0; mt < 3; ++mt) Cacc[mt][nt] = __builtin_amdgcn_mfma_f32_16x16x32_bf16(af[mt], bq[nt], Cacc[mt][nt], 0, 0, 0);
            }
#pragma unroll
            for (int mt = 0; mt < 2; ++mt)
#pragma unroll
                for (int nt = 0; nt < 2; ++nt)
#pragma unroll
                    for (int i = 0; i < 4; ++i) *(LAS bf16_t*)(lds + ML_CS + (16 * mt + 4 * g + i) * ML_CP + (32 * w + 16 * nt + r) * 2) = (bf16_t)f2bf(Cacc[mt][nt][i]);
            if (g == 0) { *(LAS bf16_t*)(lds + ML_KS + 128 * ML_KP + (32 * w + r) * 2) = (bf16_t)f2bf(Cacc[2][0][0]); *(LAS bf16_t*)(lds + ML_KS + 128 * ML_KP + (32 * w + 16 + r) * 2) = (bf16_t)f2bf(Cacc[2][1][0]); }
        }
        ML_BAR();
    }
#undef ML_BAR
#undef ML_PREFETCH
#undef ML_TOK
}
constexpr int HY_ZK = 0, HY_WB = 69632;
static_assert(HY_WB + 69632 <= LDS_BYTES, "hyena LDS map");
#define GAS __attribute__((address_space(1)))
struct HyRaw { u32x4 c; unsigned l, r; };
__device__ __forceinline__ HyRaw hy_load(const bf16_t* rowp, int tid) { HyRaw x; const GAS bf16_t* p = (const GAS bf16_t*)rowp + 8 * tid; x.c = *(const GAS u32x4*)p; x.l = p[-1]; x.r = p[8]; return x; }
__device__ __forceinline__ void hy_conv8(const HyRaw& x, int tid, float w0, float w1, float w2, float bias, float (&o)[8]) {
    float a[10];
    a[0] = tid > 0 ? __uint_as_float(x.l << 16) : 0.f; a[9] = tid < 511 ? __uint_as_float(x.r << 16) : 0.f;
    a[1] = bflo(x.c.x); a[2] = bfhi(x.c.x); a[3] = bflo(x.c.y); a[4] = bfhi(x.c.y); a[5] = bflo(x.c.z); a[6] = bfhi(x.c.z); a[7] = bflo(x.c.w); a[8] = bfhi(x.c.w);
#pragma unroll
    for (int m = 0; m < 8; ++m) o[m] = w0 * a[m] + w1 * a[m + 1] + w2 * a[m + 2] + bias;
}
__device__ __forceinline__ void hyena_item(const Ctx& C, LAS unsigned char* lds, int ch, int wv) {
    int tid = (wv << 6) | lane_id_opaque(); asm volatile("" : "+v"(tid));
    LAS f32x2* zk = (LAS f32x2*)(lds + HY_ZK); LAS f32x2* wb = (LAS f32x2*)(lds + HY_WB);
    const float* FILT = (const float*)(C.ws + WS_FILT); const bf16_t* HYb = (const bf16_t*)(C.ws + WS_HY); bf16_t* YA = (bf16_t*)(C.ws + WS_YA);
    const float* cw = C.in[3]; const float* cb = C.in[4];
    float w0[3], w1[3], w2[3], bs[3];
#pragma unroll
    for (int s = 0; s < 3; ++s) { w0[s] = cw[s * 1024 + ch]; w1[s] = cw[CONVC + s * 1024 + ch]; w2[s] = cw[2 * CONVC + s * 1024 + ch]; bs[s] = cb[s * 1024 + ch]; }
    const float hb0 = C.in[12][ch], hb1 = C.in[12][1024 + ch];
    const float* F0 = FILT + (size_t)(0 * 1024 + ch) * SEQ; const float* F1 = FILT + (size_t)(1 * 1024 + ch) * SEQ;
    const float* F2 = FILT + (size_t)(2 * 1024 + ch) * SEQ; const float* F3 = FILT + (size_t)(3 * 1024 + ch) * SEQ;
    __syncthreads();
    {
        float fa[16], fb[16];
#pragma unroll
        for (int rep = 0; rep < 8; ++rep) { const int i = tid + 512 * rep; fa[rep] = F0[i]; fb[rep] = F2[i]; }
#pragma unroll
        for (int rep = 8; rep < 16; ++rep) { const int i = tid + 512 * rep; const int j = i == SEQ ? 1 : 2 * SEQ - i; fa[rep] = F1[j]; fb[rep] = F3[j]; }
        if (tid == 0) { fa[8] = 0.f; fb[8] = 0.f; }
#pragma unroll
        for (int rep = 0; rep < 16; ++rep) { const int i = tid + 512 * rep; zk[PADI(i)] = (f32x2){fa[rep] * (1.0f / 8192.0f), fb[rep] * (1.0f / 8192.0f)}; }
    }
    fft_fwd_full(zk, tid);
    const bf16_t* rv = HYb + (size_t)ch * TOK; const bf16_t* rx1 = HYb + (size_t)(1024 + ch) * TOK; const bf16_t* rx2 = HYb + (size_t)(2048 + ch) * TOK;
    HyRaw qa = hy_load(rv, tid), qb = hy_load(rv + SEQ, tid);
#pragma unroll 1
    for (int p = 0; p < 2; ++p) {
        const int tb0 = (2 * p) * SEQ, tb1 = (2 * p + 1) * SEQ;
        f32x2 vv[8], zz[8];
        { float va[8], vb[8]; hy_conv8(qa, tid, w0[0], w1[0], w2[0], bs[0], va); hy_conv8(qb, tid, w0[0], w1[0], w2[0], bs[0], vb);
#pragma unroll
          for (int m = 0; m < 8; ++m) { vv[m].x = va[m]; vv[m].y = vb[m]; wb[PADI(8 * tid + m)] = vv[m]; } }
        qa = hy_load(rx1 + tb0, tid); qb = hy_load(rx1 + tb1, tid);
        fft_conv<0>(wb, zk, tid);
        { float xa[8], xb_[8]; hy_conv8(qa, tid, w0[1], w1[1], w2[1], bs[1], xa); hy_conv8(qb, tid, w0[1], w1[1], w2[1], bs[1], xb_);
#pragma unroll
          for (int m = 0; m < 8; ++m) { const f32x2 y = wb[PADI(8 * tid + m)]; zz[m].x = xa[m] * (y.x + vv[m].x * hb0); zz[m].y = xb_[m] * (y.y + vv[m].y * hb0); }
#pragma unroll
          for (int m = 0; m < 8; ++m) wb[PADI(8 * tid + m)] = zz[m]; }
        qa = hy_load(rx2 + tb0, tid); qb = hy_load(rx2 + tb1, tid);
        fft_conv<1>(wb, zk, tid);
        { float xa[8], xb_[8]; hy_conv8(qa, tid, w0[2], w1[2], w2[2], bs[2], xa); hy_conv8(qb, tid, w0[2], w1[2], w2[2], bs[2], xb_);
          if (p == 0) { qa = hy_load(rv + 2 * SEQ, tid); qb = hy_load(rv + 3 * SEQ, tid); }
#pragma unroll
          for (int m = 0; m < 8; ++m) { const int t = 8 * tid + m; const f32x2 y = wb[PADI(t)];
              YA[blk_off(tb0 + t, ch, 1024)] = (bf16_t)f2bf(xa[m] * (y.x + zz[m].x * hb1));
              YA[blk_off(tb1 + t, ch, 1024)] = (bf16_t)f2bf(xb_[m] * (y.y + zz[m].y * hb1)); } }
        FFT_SYNC();
    }
}
#ifndef DUP_FILT
#define DUP_FILT 0
#endif
#ifndef DUP_PRE
#define DUP_PRE 0
#endif
#ifndef DUP_P0
#define DUP_P0 0
#endif
#ifndef DUP_ML
#define DUP_ML 0
#endif
#ifndef DUP_HY
#define DUP_HY 0
#endif
#ifndef DUP_REST
#define DUP_REST 0
#endif
#ifndef DUP_GU
#define DUP_GU 0
#endif
#define XB_TMO      128
#define XB_XCNT(j)  (256  + 64 * (j))
#define XB_XSUB(j)  (1280 + 64 * (j))
#define XB_XGEN(j)  (2304 + 64 * (j))
#define XB_TOP      3328
#define XB_TOPGEN   3392
#define XCD_BAR_WORDS 3456
#define XB_SPIN_CAP (1u << 22)
__device__ __forceinline__ unsigned xb_ld(unsigned* p)              { return __hip_atomic_load(p, __ATOMIC_RELAXED, __HIP_MEMORY_SCOPE_AGENT); }
__device__ __forceinline__ unsigned xb_add(unsigned* p, unsigned v) { return __hip_atomic_fetch_add(p, v, __ATOMIC_RELAXED, __HIP_MEMORY_SCOPE_AGENT); }
__device__ __forceinline__ unsigned xb_xcc_id() { return (unsigned)__builtin_amdgcn_s_getreg((3 << 11) | 20) & 0xFu; }
#define XB_SPIN(cond, bar) do { unsigned _sp = 0; while (cond) { __builtin_amdgcn_s_sleep(1); \
    if ((++_sp & 255u) == 0u) { if (xb_ld(&(bar)[XB_TMO])) break; if (_sp > XB_SPIN_CAP) { atomicAdd(&(bar)[XB_TMO], 1u); break; } } } } while (0)
__device__ __forceinline__ void xcd_barrier_complete(unsigned* bar, unsigned x, unsigned G, unsigned& nloc, unsigned& nx) {
    unsigned sum, cnt, mine, sp = 0u;
    for (;;) {
        sum = 0u; cnt = 0u; mine = 0u;
#pragma unroll
        for (unsigned j = 0; j < 16; ++j) { const unsigned c = xb_ld(&bar[XB_XCNT(j)]); sum += c; cnt += (c > 0u) ? 1u : 0u; mine = (j == x) ? c : mine; }
        if (sum == G) break;
        __builtin_amdgcn_s_sleep(1);
        if ((++sp & 255u) == 0u) { if (xb_ld(&bar[XB_TMO])) break; if (sp > XB_SPIN_CAP) { atomicAdd(&bar[XB_TMO], 1u); break; } }
    }
    nloc = mine > 0u ? mine : 1u; nx = cnt > 0u ? cnt : 1u;
}
__device__ __forceinline__ void grid_bar(unsigned* bar, volatile LAS unsigned* st, unsigned G, int wv) {
    asm volatile("s_waitcnt vmcnt(0)" ::: "memory");
    __syncthreads();
    const int lane = lane_id_opaque();
    if (wv == 0 && lane == 0) {
        __builtin_amdgcn_s_waitcnt(0);
        const unsigned x = xb_xcc_id();
        unsigned nloc = st[0], nx = st[1];
        if (nloc == 0u) { xcd_barrier_complete(bar, x, G, nloc, nx); st[0] = nloc; st[1] = nx; }
        const unsigned old = xb_add(&bar[XB_XSUB(x)], 1u);
        const unsigned gen = old / nloc;
        if (old + 1u == (gen + 1u) * nloc) {
            __builtin_amdgcn_fence(__ATOMIC_RELEASE, "agent");
            asm volatile("s_waitcnt vmcnt(0)" ::: "memory");
            const unsigned og = xb_add(&bar[XB_TOP], 1u);
            const unsigned tg = og / nx;
            if (og + 1u == (tg + 1u) * nx) xb_add(&bar[XB_TOPGEN], 1u);
            else XB_SPIN(xb_ld(&bar[XB_TOPGEN]) == tg, bar);
            __builtin_amdgcn_fence(__ATOMIC_ACQUIRE, "agent");
            xb_add(&bar[XB_XGEN(x)], 1u);
            asm volatile("s_waitcnt vmcnt(0)" ::: "memory");
        } else {
            XB_SPIN(xb_ld(&bar[XB_XGEN(x)]) == gen, bar);
            __builtin_amdgcn_fence(__ATOMIC_ACQUIRE, "agent");
            asm volatile("s_waitcnt vmcnt(0)" ::: "memory");
        }
    }
    __syncthreads();
}
__device__ __forceinline__ void p6_finalize(const Ctx& C, int G, int bx, int wv) {
    int tid = (wv << 6) | lane_id_opaque(); asm volatile("" : "+v"(tid));
    unsigned* pcnt = (unsigned*)(C.ws + WS_PCNT); const float* ss3 = (const float*)(C.ws + WS_SS3); const float* wf = C.in[20]; float* out = C.out;
    asm volatile("s_waitcnt vmcnt(0)" ::: "memory");
    __syncthreads();
    if (tid == 0) {
        __builtin_amdgcn_fence(__ATOMIC_RELEASE, "agent"); asm volatile("s_waitcnt vmcnt(0)" ::: "memory");
        for (int i = 0; ; ++i) { const int L = i * G + bx; if (L >= 64 * 8) break; int pm, pn; pg8::tile_of(L, 64, 8, pm, pn); xb_add(&pcnt[64 * pm], 1u); }
    }
    for (int i = 0; ; ++i) {
        const int L = i * G + bx; if (L >= 64 * 8) break; int pm, pn; pg8::tile_of(L, 64, 8, pm, pn);
        if (tid == 0) { unsigned sp = 0; while (xb_ld(&pcnt[64 * pm]) < 8u) { __builtin_amdgcn_s_sleep(1); if (++sp > (1u << 20)) break; }
            __builtin_amdgcn_fence(__ATOMIC_ACQUIRE, "agent"); asm volatile("s_waitcnt vmcnt(0)" ::: "memory"); }
        __syncthreads();
        const int c4 = tid & 63; const f32x4 wv4 = *(const f32x4*)(wf + 256 * pn + 4 * c4);
#pragma unroll 1
        for (int k0 = 0; k0 < 32; k0 += 8) {
            f32x4 v[8]; float rr[8];
#pragma unroll
            for (int k = 0; k < 8; ++k) { const int row = 256 * pm + (tid >> 6) + 8 * (k0 + k);
                v[k] = *(const f32x4*)(out + (size_t)row * DM + 256 * pn + 4 * c4);
                rr[k] = __hip_atomic_load(ss3 + row, __ATOMIC_RELAXED, __HIP_MEMORY_SCOPE_AGENT); }
#pragma unroll
            for (int k = 0; k < 8; ++k) { const int row = 256 * pm + (tid >> 6) + 8 * (k0 + k); const float r = 1.0f / sqrtf(rr[k] * (1.0f / DM) + RMS_EPS);
                *(f32x4*)(out + (size_t)row * DM + 256 * pn + 4 * c4) = v[k] * r * wv4; }
        }
    }
}
struct Params { const float* in[21]; float* out; unsigned char* ws; };
__global__ void __launch_bounds__(512, 2) fwd_megakernel(Params prm) {
    extern __shared__ __attribute__((aligned(16))) unsigned char lds_raw[];
    LAS unsigned char* lds = (LAS unsigned char*)lds_raw;
    cg::grid_group grid = cg::this_grid();
    const int G = gridDim.x, bx = blockIdx.x;
    const int wv = __builtin_amdgcn_readfirstlane((int)(threadIdx.x >> 6));
    Ctx C;
#pragma unroll
    for (int i = 0; i < 21; ++i) C.in[i] = prm.in[i];
    C.out = prm.out; C.ws = prm.ws;
    unsigned char* ws = prm.ws;
    unsigned* gbar = (unsigned*)(ws + WS_BAR);
    volatile LAS unsigned* bst = (volatile LAS unsigned*)(lds + LDS_BYTES - 16);
#ifndef DUP_BAR
#define DUP_BAR 0
#endif
#define GBAR() do { for (int rb_ = 0; rb_ < 1 + DUP_BAR; ++rb_) grid_bar(gbar, bst, (unsigned)G, wv); } while (0)
    if (bx == 0) for (int i = threadIdx.x; i < XCD_BAR_WORDS; i += 512) gbar[i] = 0u;
    if (bx == 1 || G == 1) for (int i = threadIdx.x; i < 64 * 64; i += 512) ((unsigned*)(ws + WS_PCNT))[i] = 0u;
    if (threadIdx.x < 4) ((LAS unsigned*)(lds + LDS_BYTES - 16))[threadIdx.x] = 0u;
    grid.sync();
    if (threadIdx.x == 0) (void)xb_add(&gbar[XB_XCNT(xb_xcc_id())], 1u);
    for (int rep = 0; rep < 1 + DUP_P0; ++rep) { p0_prologue(C, lds, G, wv); __syncthreads(); }
    GBAR();
    for (int rep = 0; rep < 1 + DUP_FILT; ++rep) p1_filters(C, lds, G, wv);
    { HyProg P; P.K = DM; P.G = G; P.c = bx; P.W = (const bf16_t*)(ws + WS_WIN); P.X = (const bf16_t*)(ws + WS_XB); P.HY = (bf16_t*)(ws + WS_HY); P.r1 = (const float*)(ws + WS_R1S);
      pg8::gemm_stream(lds, P, wv); }
    for (int rep = 0; rep < 1 + DUP_REST; ++rep) { RestProg P; P.K = DM; P.G = G; P.c = bx; P.W = (const bf16_t*)(ws + WS_WIN); P.X = (const bf16_t*)(ws + WS_XB); P.R1A = (bf16_t*)(ws + WS_R1A); P.R1B = (bf16_t*)(ws + WS_R1B); P.R2 = (bf16_t*)prm.out; P.r1 = (const float*)(ws + WS_R1S);
      pg8::gemm_stream(lds, P, wv); }
    GBAR();
    for (int rep = 0; rep < 1 + DUP_PRE; ++rep) qk_prepass(C, G, wv);
    for (int rep = 0; rep < 1 + DUP_HY; ++rep) for (int idx = bx; idx < 1024; idx += G) { const int rd = idx >> 8, bb = idx & 255; hyena_item(C, lds, rd * 256 + (bb & 7) * 32 + (bb >> 3), wv); }
    GBAR();
    for (int rep = 0; rep < 1 + DUP_ML; ++rep) for (int item = bx; item < 256; item += G) mlstm_item(C, lds, item, wv);
    GBAR();
    { BranchProg P; P.K = 1024; P.G = G; P.c = bx; P.YA = (const bf16_t*)(ws + WS_YA); P.YBF = (const bf16_t*)(ws + WS_YBF); P.YBB = (const bf16_t*)(ws + WS_YBB);
      P.WA = (const bf16_t*)(ws + WS_WA); P.WB = (const bf16_t*)(ws + WS_WB); P.R2 = (const bf16_t*)prm.out; P.MIX = (bf16_t*)(ws + WS_MIX);
      pg8::gemm_stream(lds, P, wv); }
    GBAR();
    { ResProg P; P.K = DM; P.G = G; P.c = bx; P.A = (const bf16_t*)(ws + WS_MIX); P.B = (const bf16_t*)(ws + WS_WOUT); P.base = prm.in[0]; P.base16 = nullptr; P.out = nullptr; P.outb = (bf16_t*)(ws + WS_X1B); P.ss = (float*)(ws + WS_SS2);
      pg8::gemm_stream(lds, P, wv); }
    GBAR();
    for (int rep = 0; rep < 1 + DUP_GU; ++rep) { GuProg P; P.K = DM; P.G = G; P.c = bx; P.X = (const bf16_t*)(ws + WS_X1B); P.W = (const bf16_t*)(ws + WS_WGU); P.HH = (bf16_t*)(ws + WS_HH); P.ss2 = (const float*)(ws + WS_SS2);
      pg8::gemm_stream(lds, P, wv); }
    GBAR();
    { ResProg P; P.K = FFH; P.G = G; P.c = bx; P.A = (const bf16_t*)(ws + WS_HH); P.B = (const bf16_t*)(ws + WS_WD); P.base = nullptr; P.base16 = (const bf16_t*)(ws + WS_X1B); P.out = prm.out; P.outb = nullptr; P.ss = (float*)(ws + WS_SS3);
      pg8::gemm_stream(lds, P, wv); }
    p6_finalize(C, G, bx, wv);
}

extern "C" void kernel_launch(void* const* d_in, const int* in_sizes, int n_in, void* d_out, int out_size, void* d_ws, size_t ws_size, hipStream_t stream) {
    static int grid = 0;
    if (grid == 0) {
        int dev = 0, cus = 0, per_cu = 0;
        hipGetDevice(&dev); hipDeviceGetAttribute(&cus, hipDeviceAttributeMultiprocessorCount, dev);
        if (hipFuncSetAttribute((const void*)fwd_megakernel, hipFuncAttributeMaxDynamicSharedMemorySize, LDS_BYTES) != hipSuccess) { fprintf(stderr, "kernel_launch: hipFuncSetAttribute failed\n"); grid = -1; return; }
        if (hipOccupancyMaxActiveBlocksPerMultiprocessor(&per_cu, (const void*)fwd_megakernel, 512, LDS_BYTES) != hipSuccess || per_cu < 1) { fprintf(stderr, "kernel_launch: occupancy query gave %d\n", per_cu); per_cu = 1; }
        (void)hipGetLastError();
        grid = cus * 1;
        if (n_in != 21 || ws_size < WS_END) { fprintf(stderr, "kernel_launch: unexpected n_in %d or ws %zu\n", n_in, ws_size); grid = -1; return; }
    }
    if (grid < 0) return;
    Params p{};
    for (int i = 0; i < 21; ++i) p.in[i] = (const float*)d_in[i];
    p.out = (float*)d_out; p.ws = (unsigned char*)d_ws;
    void* args[] = {&p};
    hipError_t e = hipLaunchCooperativeKernel((const void*)fwd_megakernel, dim3(grid), dim3(512), args, LDS_BYTES, stream);
    if (e != hipSuccess) fprintf(stderr, "cooperative launch failed: %s (grid %d)\n", hipGetErrorString(e), grid);
}
```

```cpp
#include <hip/hip_runtime.h>
#include <hip/hip_cooperative_groups.h>
#include <cstdio>
namespace cg = cooperative_groups;

#define LAS __attribute__((address_space(3)))
typedef unsigned short bf16_t;
typedef short bf16x8 __attribute__((ext_vector_type(8)));
typedef short bf16x4 __attribute__((ext_vector_type(4)));
typedef float f32x4 __attribute__((ext_vector_type(4)));
typedef float f32x2 __attribute__((ext_vector_type(2)));
typedef unsigned u32x4 __attribute__((ext_vector_type(4)));
typedef unsigned u32x2 __attribute__((ext_vector_type(2)));

constexpr int NB = 4, SEQ = 4096, TOK = NB * SEQ, DM = 2048, HW = 1024, MW = 1024, NHEAD = 4, DH = 256, FFH = 5632;
constexpr int CONVC = 5120, INCOLS = 11280, NFILT = 4096;
constexpr float RMS_EPS = 1e-6f;
constexpr size_t MiB = 1u << 20;
constexpr size_t WS_PCNT = 393216, WS_BAR = 262144, WS_R1S = 0, WS_SS2 = 65536, WS_SS3 = 131072, WS_G = 1 * MiB, WS_H2 = 2 * MiB;
constexpr size_t WS_WA = 4 * MiB, WS_WB = 8 * MiB, WS_WOUT = 12 * MiB, WS_WGU = 20 * MiB, WS_WD = 64 * MiB, WS_WIN = 86 * MiB, WS_XB = 130 * MiB;
constexpr size_t WS_FILT = 194 * MiB, WS_HY = 258 * MiB, WS_R1A = 354 * MiB, WS_R1B = 418 * MiB, WS_END = 494 * MiB;
constexpr size_t WS_QKP = 86 * MiB, WS_YA = 150 * MiB, WS_YBF = 354 * MiB, WS_YBB = 386 * MiB, WS_X1B = 86 * MiB, WS_MIX = 194 * MiB, WS_HH = 258 * MiB;
constexpr size_t WS_GSC = 482 * MiB;
constexpr int LDS_BYTES = 155648;

__device__ __forceinline__ unsigned f2bf(float f) { unsigned u = __float_as_uint(f); return (u + 0x7fffu + ((u >> 16) & 1u)) >> 16; }
__device__ __forceinline__ unsigned pk2(float lo, float hi) { unsigned r; asm volatile("v_cvt_pk_bf16_f32 %0, %1, %2" : "=v"(r) : "v"(lo), "v"(hi)); return r; }
__device__ __forceinline__ float bflo(unsigned w) { return __uint_as_float(w << 16); }
__device__ __forceinline__ float bfhi(unsigned w) { return __uint_as_float(w & 0xffff0000u); }
__device__ __forceinline__ float wave_sum(float v) {
#pragma unroll
    for (int o = 1; o < 64; o <<= 1) v += __shfl_xor(v, o);
    return v;
}
__device__ __forceinline__ size_t blk_off(int row, int k, int K) { return ((size_t)(row >> 7) * (size_t)(K >> 6) + (size_t)(k >> 6)) * 8192 + (size_t)((row & 127) * 64 + (k & 63)); }
__device__ __forceinline__ int lane_id_opaque() { int l; asm volatile("v_mbcnt_lo_u32_b32 %0, -1, 0\n\tv_mbcnt_hi_u32_b32 %0, -1, %0" : "=v"(l)); return l; }
__device__ __forceinline__ float sigmoidf_(float x) { return 1.0f / (1.0f + __expf(-x)); }
__device__ __forceinline__ float siluf_(float x) { return x / (1.0f + __expf(-x)); }

namespace pg8 {
constexpr int BM = 256, BK = 64, HALF = 128, HTB = HALF * BK * 2, STAGE_BYTES = 8 * HTB, NXCD = 8, WGM = 8;
__device__ __forceinline__ int lds_byte(int r, int c) { const int st = (r >> 4) * 2 + (c >> 5), rr = r & 15, cc = c & 31, ob = rr * 64 + cc * 2; return st * 1024 + (ob ^ (((ob >> 9) & 1) << 5)); }
__device__ __forceinline__ void stage_rc(int b, int& R, int& C) { const int st = b / 1024, sb = b % 1024, swz = sb ^ (((sb >> 9) & 1) << 5); R = (st >> 1) * 16 + swz / 64; C = (st & 1) * 32 + (swz % 64) / 2; }
__device__ __forceinline__ int perm32(int rho) { const int n = rho >> 4, i = rho & 15; return 8 * (i >> 2) + 4 * n + (i & 3); }
struct GUnit { const char* A; const char* B; int pm, pn, sub; };
__device__ __forceinline__ void tile_of(int L, int nM, int nN, int& pm, int& pn) {
    const int nwg = nM * nN; int wgid = L; { const int q = nwg / NXCD, r = nwg % NXCD, xcd = wgid % NXCD, off = wgid / NXCD; wgid = (xcd < r ? xcd * (q + 1) : r * (q + 1) + (xcd - r) * q) + off; }
    const int nig = WGM * nN, gid = wgid / nig, fm = gid * WGM, gsz = (nM - fm) < WGM ? (nM - fm) : WGM;
    pm = fm + ((wgid % nig) % gsz); pn = (wgid % nig) / gsz;
}
typedef f32x4 Acc[2][2][4][2];
template <class Prog>
__device__ __forceinline__ void gemm_stream(LAS unsigned char* lds, const Prog& P, int wv) {
    int tid = (wv << 6) | lane_id_opaque(); asm volatile("" : "+v"(tid));
    const int wid = __builtin_amdgcn_readfirstlane(tid >> 6), lane = tid & 63, wr = wid >> 2, wc = wid & 3, fr = lane & 15, fq = lane >> 4;
    const int K = P.K, nt = K / BK;
    unsigned voffA[2], voffB[2];
#pragma unroll
    for (int i = 0; i < 2; ++i) { int R, C; stage_rc(tid * 16 + i * 8192, R, C); const int Rb = Prog::PERM ? ((R & ~31) + perm32(R & 31)) : R;
        voffA[i] = (unsigned)(R * 64 + C) * 2u; voffB[i] = (unsigned)(Rb * 64 + C) * 2u; }
    const size_t kstep = (size_t)(HALF * BK * 2);
    const size_t hstep = (size_t)HALF * K * 2;
    const unsigned ldsw = (unsigned)wid * 1024u;
    const int aoff = lds_byte(wr * 64 + fr, fq * 8), boff = lds_byte(wc * 32 + fr, fq * 8);
#define PG8_SA(b, h) (((b) * 2 + (h)) * HTB)
#define PG8_SB(b, h) ((4 + (b) * 2 + (h)) * HTB)
#define PG8_STAGE(bufoff, gbase, voff) do { _Pragma("unroll") for (int _i = 0; _i < 2; ++_i) \
        __builtin_amdgcn_global_load_lds((const unsigned*)((const char*)(gbase) + (voff)[_i]), (LAS unsigned*)(lds + (bufoff) + ldsw + _i * 8192), 16, 0, 0); } while (0)
#define PG8_LDA(dst, b, h) do { _Pragma("unroll") for (int m = 0; m < 4; ++m) _Pragma("unroll") for (int k = 0; k < 2; ++k) dst[m][k] = *(const LAS bf16x8*)(lds + PG8_SA(b, h) + aoff + m * 2048 + k * 1024); } while (0)
#define PG8_LDB(dst, b, h) do { _Pragma("unroll") for (int n = 0; n < 2; ++n) _Pragma("unroll") for (int k = 0; k < 2; ++k) dst[n][k] = *(const LAS bf16x8*)(lds + PG8_SB(b, h) + boff + n * 2048 + k * 1024); } while (0)
#define PG8_MMA(ai, bj, At, Bt) do { __builtin_amdgcn_s_setprio(1); _Pragma("unroll") for (int m = 0; m < 4; ++m) _Pragma("unroll") for (int n = 0; n < 2; ++n) _Pragma("unroll") for (int k = 0; k < 2; ++k) \
        acc[ai][bj][m][n] = __builtin_amdgcn_mfma_f32_16x16x32_bf16(Bt[n][k], At[m][k], acc[ai][bj][m][n], 0, 0, 0); __builtin_amdgcn_s_setprio(0); } while (0)
#define PG8_WAIT_V(n) asm volatile("s_waitcnt vmcnt(" #n ")" ::: "memory")
#define PG8_WAIT_L(n) asm volatile("s_waitcnt lgkmcnt(" #n ")" ::: "memory")
#define PG8_BAR __builtin_amdgcn_s_barrier()
#define PG8_SCHED __builtin_amdgcn_sched_barrier(0)
    GUnit cur, nxt; int ui = 0;
    if (!P.next(0, cur)) return;
    f32x4 acc[2][2][4][2];
#pragma unroll
    for (int a = 0; a < 2; ++a)
#pragma unroll
        for (int b = 0; b < 2; ++b)
#pragma unroll
            for (int m = 0; m < 4; ++m)
#pragma unroll
                for (int n = 0; n < 2; ++n) acc[a][b][m][n] = (f32x4){0.f, 0.f, 0.f, 0.f};
    bf16x8 At[4][2], B0[2][2], B1[2][2];
    const char* cA = cur.A; const char* cB = cur.B;
    PG8_STAGE(PG8_SB(0, 0), cB, voffB); PG8_STAGE(PG8_SA(0, 0), cA, voffA); PG8_STAGE(PG8_SB(0, 1), cB + hstep, voffB); PG8_STAGE(PG8_SA(0, 1), cA + hstep, voffA);
    if (wr == 1) PG8_BAR;
    PG8_WAIT_V(4); PG8_BAR;
    PG8_STAGE(PG8_SB(1, 0), cB + kstep, voffB); PG8_STAGE(PG8_SA(1, 0), cA + kstep, voffA); PG8_STAGE(PG8_SB(1, 1), cB + hstep + kstep, voffB);
    PG8_WAIT_V(6); PG8_BAR;
    for (;;) {
        const bool has_next = P.next(ui + 1, nxt);
        const char* nA = has_next ? nxt.A : cA; const char* nB = has_next ? nxt.B : cB;
        for (int t = 0; t < nt; t += 2) {
            const bool last = (t == nt - 2);
            const char* a1 = cA + (size_t)(t + 1) * kstep;
            const char* a2 = last ? nA : cA + (size_t)(t + 2) * kstep; const char* b2 = last ? nB : cB + (size_t)(t + 2) * kstep;
            const char* a3 = a2 + kstep; const char* b3 = b2 + kstep;
            PG8_LDB(B0, 0, 0); PG8_SCHED; PG8_LDA(At, 0, 0); PG8_STAGE(PG8_SA(1, 1), a1 + hstep, voffA);
            PG8_WAIT_L(8); PG8_BAR; PG8_WAIT_L(0); PG8_MMA(0, 0, At, B0); PG8_BAR; PG8_SCHED;
            PG8_LDB(B1, 0, 1); PG8_STAGE(PG8_SB(0, 0), b2, voffB);
            PG8_BAR; PG8_WAIT_L(0); PG8_MMA(0, 1, At, B1); PG8_BAR;
            PG8_LDA(At, 0, 1); PG8_STAGE(PG8_SA(0, 0), a2, voffA);
            PG8_BAR; PG8_WAIT_L(0); PG8_MMA(1, 0, At, B0); PG8_BAR; PG8_SCHED;
            PG8_STAGE(PG8_SB(0, 1), b2 + hstep, voffB);
            PG8_WAIT_V(6); PG8_BAR; PG8_MMA(1, 1, At, B1); PG8_BAR;
            PG8_LDB(B0, 1, 0); PG8_SCHED; PG8_LDA(At, 1, 0); PG8_STAGE(PG8_SA(0, 1), a2 + hstep, voffA);
            PG8_WAIT_L(8); PG8_BAR; PG8_WAIT_L(0); PG8_MMA(0, 0, At, B0); PG8_BAR; PG8_SCHED;
            PG8_LDB(B1, 1, 1); PG8_STAGE(PG8_SB(1, 0), b3, voffB);
            PG8_BAR; PG8_WAIT_L(0); PG8_MMA(0, 1, At, B1); PG8_BAR;
            PG8_LDA(At, 1, 1); PG8_STAGE(PG8_SA(1, 0), a3, voffA);
            PG8_BAR; PG8_WAIT_L(0); PG8_MMA(1, 0, At, B0); PG8_BAR; PG8_SCHED;
            PG8_STAGE(PG8_SB(1, 1), b3 + hstep, voffB);
            PG8_WAIT_V(6); PG8_BAR; PG8_MMA(1, 1, At, B1); PG8_BAR;
        }
        if (Prog::FUSE_LAST && !has_next) break;
        P.epi(acc, cur, wr, wc, fr, fq);
        if (!has_next) break;
        cur = nxt; cA = nA; cB = nB; ++ui;
    }
    PG8_WAIT_V(0);
    if (wr == 0) PG8_BAR;
    PG8_BAR;
    if constexpr (Prog::FUSE_LAST) P.epi_last(acc, cur, wr, wc, fr, fq, wv);
#undef PG8_SA
#undef PG8_SB
#undef PG8_STAGE
#undef PG8_LDA
#undef PG8_LDB
#undef PG8_MMA
#undef PG8_WAIT_V
#undef PG8_WAIT_L
#undef PG8_BAR
#undef PG8_SCHED
}
__device__ __forceinline__ void zero_acc(Acc& acc) {
#pragma unroll
    for (int a = 0; a < 2; ++a)
#pragma unroll
        for (int b = 0; b < 2; ++b)
#pragma unroll
            for (int m = 0; m < 4; ++m)
#pragma unroll
                for (int n = 0; n < 2; ++n) acc[a][b][m][n] = (f32x4){0.f, 0.f, 0.f, 0.f};
}
}
using pg8::GUnit; using pg8::Acc;
__device__ __forceinline__ void unpack8(u32x4 w, float (&f)[8]) { f[0] = bflo(w.x); f[1] = bfhi(w.x); f[2] = bflo(w.y); f[3] = bfhi(w.y); f[4] = bflo(w.z); f[5] = bfhi(w.z); f[6] = bflo(w.w); f[7] = bfhi(w.w); }
struct HyProg {
    static constexpr bool FUSE_LAST = false; static constexpr bool PERM = true; int K, G, c; const bf16_t* W; const bf16_t* X; bf16_t* HY; const float* r1;
    __device__ __forceinline__ bool next(int i, GUnit& u) const { const int L = i * G + c; if (L >= 12 * 64) return false; pg8::tile_of(L, 12, 64, u.pm, u.pn);
        u.A = (const char*)(W + (size_t)u.pm * 256 * DM); u.B = (const char*)(X + (size_t)u.pn * 256 * DM); u.sub = 0; return true; }
    __device__ __forceinline__ void epi(Acc& acc, const GUnit& u, int wr, int wc, int fr, int fq) const {
        const int row0 = u.pm * 256 + wr * 64 + fr, col0 = u.pn * 256 + wc * 32 + 8 * fq;
        f32x4 sc[2][2];
#pragma unroll
        for (int bj = 0; bj < 2; ++bj) { sc[bj][0] = *(const f32x4*)(r1 + col0 + bj * 128); sc[bj][1] = *(const f32x4*)(r1 + col0 + bj * 128 + 4); }
#pragma unroll
        for (int ai = 0; ai < 2; ++ai)
#pragma unroll
            for (int m = 0; m < 4; ++m) { bf16_t* rowp = HY + (size_t)(row0 + ai * 128 + m * 16) * TOK + col0;
#pragma unroll
                for (int bj = 0; bj < 2; ++bj) { const f32x4 v0 = acc[ai][bj][m][0] * sc[bj][0], v1 = acc[ai][bj][m][1] * sc[bj][1];
                    u32x4 w; w.x = pk2(v0[0], v0[1]); w.y = pk2(v0[2], v0[3]); w.z = pk2(v1[0], v1[1]); w.w = pk2(v1[2], v1[3]);
                    *(u32x4*)(rowp + bj * 128) = w; } }
        pg8::zero_acc(acc);
    }
};
struct RestProg {
    static constexpr bool FUSE_LAST = false; static constexpr bool PERM = true; int K, G, c; const bf16_t* W; const bf16_t* X; bf16_t* R1A; bf16_t* R1B; bf16_t* R2; const float* r1;
    __device__ __forceinline__ bool next(int i, GUnit& u) const { const int L = i * G + c; if (L >= 64 * 32) return false; pg8::tile_of(L, 64, 32, u.pm, u.pn);
        u.A = (const char*)(X + (size_t)u.pm * 256 * DM); u.B = (const char*)(W + (size_t)(3072 + u.pn * 256) * DM); u.sub = 0; return true; }
    __device__ __forceinline__ void epi(Acc& acc, const GUnit& u, int wr, int wc, int fr, int fq) const {
        const int row0 = u.pm * 256 + wr * 64 + fr; const bool sg = u.pn >= 12;
        bf16_t* base = u.pn < 8 ? R1A + u.pn * 256 : (u.pn < 16 ? R1B + (u.pn - 8) * 256 : R2 + (u.pn - 16) * 256);
        const int pitch = u.pn < 16 ? 2048 : 4096;
        const int col0 = wc * 32 + 8 * fq;
        float rs[2][4];
#pragma unroll
        for (int ai = 0; ai < 2; ++ai)
#pragma unroll
            for (int m = 0; m < 4; ++m) rs[ai][m] = r1[row0 + ai * 128 + m * 16];
#pragma unroll
        for (int ai = 0; ai < 2; ++ai)
#pragma unroll
            for (int m = 0; m < 4; ++m) { const int row = row0 + ai * 128 + m * 16; const float s = rs[ai][m]; bf16_t* rowp = base + (size_t)row * pitch + col0;
#pragma unroll
                for (int bj = 0; bj < 2; ++bj) { f32x4 v0 = acc[ai][bj][m][0] * s, v1 = acc[ai][bj][m][1] * s;
                    if (sg) {
#pragma unroll
                        for (int j = 0; j < 4; ++j) { v0[j] = sigmoidf_(v0[j]); v1[j] = sigmoidf_(v1[j]); } }
                    u32x4 w; w.x = pk2(v0[0], v0[1]); w.y = pk2(v0[2], v0[3]); w.z = pk2(v1[0], v1[1]); w.w = pk2(v1[2], v1[3]);
                    *(u32x4*)(rowp + bj * 128) = w; } }
        pg8::zero_acc(acc);
    }
};
struct BranchProg {
    static constexpr bool FUSE_LAST = false; static constexpr bool PERM = true; int K, G, c; const bf16_t *YA, *YBF, *YBB, *WA, *WB; const bf16_t* R2; bf16_t* MIX;
    __device__ __forceinline__ bool next(int i, GUnit& u) const { const int ti = i / 3, sub = i - 3 * ti; const int L = ti * G + c; if (L >= 64 * 8) return false; pg8::tile_of(L, 64, 8, u.pm, u.pn);
        const bf16_t* a = sub == 0 ? YA : (sub == 1 ? YBF : YBB); const bf16_t* b = sub == 0 ? WA : WB;
        u.A = (const char*)(a + (size_t)u.pm * 256 * 1024); u.B = (const char*)(b + (size_t)u.pn * 256 * 1024); u.sub = sub; return true; }
    __device__ __forceinline__ void epi(Acc& acc, const GUnit& u, int wr, int wc, int fr, int fq) const {
        if (u.sub == 1) return;
        const int row0 = u.pm * 256 + wr * 64 + fr, col0 = u.pn * 256 + wc * 32 + 8 * fq;
#pragma unroll
        for (int ai = 0; ai < 2; ++ai) {
            u32x4 gbw[4][2], gaw[4][2];
#pragma unroll
            for (int m = 0; m < 4; ++m)
#pragma unroll
                for (int bj = 0; bj < 2; ++bj) { const bf16_t* gp = R2 + (size_t)(row0 + ai * 128 + m * 16) * 4096 + col0 + bj * 128;
                    gbw[m][bj] = *(const u32x4*)(gp + 2048); if (u.sub == 0) gaw[m][bj] = *(const u32x4*)gp; else gaw[m][bj] = gbw[m][bj]; }
#pragma unroll
            for (int m = 0; m < 4; ++m) { const int row = row0 + ai * 128 + m * 16;
#pragma unroll
                for (int bj = 0; bj < 2; ++bj) {
                    float gb[8], ga[8]; unpack8(gbw[m][bj], gb); unpack8(gaw[m][bj], ga);
                    if (u.sub == 0) {
#pragma unroll
                        for (int j = 0; j < 4; ++j) { acc[ai][bj][m][0][j] *= ga[j] / fmaxf(gb[j], 1e-30f); acc[ai][bj][m][1][j] *= ga[4 + j] / fmaxf(gb[4 + j], 1e-30f); }
                    } else {
                        f32x4 v0 = acc[ai][bj][m][0], v1 = acc[ai][bj][m][1];
#pragma unroll
                        for (int j = 0; j < 4; ++j) { v0[j] *= fmaxf(gb[j], 1e-30f); v1[j] *= fmaxf(gb[4 + j], 1e-30f); }
                        u32x4 w; w.x = pk2(v0[0], v0[1]); w.y = pk2(v0[2], v0[3]); w.z = pk2(v1[0], v1[1]); w.w = pk2(v1[2], v1[3]);
                        *(u32x4*)(MIX + blk_off(row, col0 + bj * 128, DM)) = w;
                    } } }
        }
        if (u.sub == 2) pg8::zero_acc(acc);
    }
};
template <bool FUSE> struct ResProg {
    static constexpr bool PERM = false, FUSE_LAST = FUSE; int K, G, c; unsigned* pcnt; const float* wf; const bf16_t* A; const bf16_t* B; const float* base; const bf16_t* base16; float* out; bf16_t* outb; float* ss;
    __device__ __forceinline__ bool next(int i, GUnit& u) const { const int L = i * G + c; if (L >= 64 * 8) return false; pg8::tile_of(L, 64, 8, u.pm, u.pn);
        u.A = (const char*)(A + (size_t)u.pm * 256 * K); u.B = (const char*)(B + (size_t)u.pn * 256 * K); u.sub = 0; return true; }
    __device__ __forceinline__ void epi(Acc& acc, const GUnit& u, int wr, int wc, int fr, int fq) const {
        const int row0 = u.pm * 256 + wr * 64 + fr, col0 = u.pn * 256 + wc * 32 + 4 * fq;
#pragma unroll
        for (int ai = 0; ai < 2; ++ai) {
            f32x4 bs[4][2][2];
#pragma unroll
            for (int m = 0; m < 4; ++m)
#pragma unroll
                for (int bj = 0; bj < 2; ++bj)
#pragma unroll
                    for (int n = 0; n < 2; ++n) { const int row = row0 + ai * 128 + m * 16, col = col0 + bj * 128 + n * 16;
                        if (base16) { const u32x2 w = *(const u32x2*)(base16 + blk_off(row, col, DM)); bs[m][bj][n] = (f32x4){bflo(w.x), bfhi(w.x), bflo(w.y), bfhi(w.y)}; }
                        else bs[m][bj][n] = *(const f32x4*)(base + (size_t)row * DM + col); }
#pragma unroll
            for (int m = 0; m < 4; ++m) { const int row = row0 + ai * 128 + m * 16; const size_t off = (size_t)row * DM + col0; float s = 0.f;
#pragma unroll
                for (int bj = 0; bj < 2; ++bj)
#pragma unroll
                    for (int n = 0; n < 2; ++n) { const f32x4 o = bs[m][bj][n] + acc[ai][bj][m][n];
                        if (out) *(f32x4*)(out + off + bj * 128 + n * 16) = o;
                        s += (o[0] * o[0] + o[1] * o[1]) + (o[2] * o[2] + o[3] * o[3]);
                        if (outb) { u32x2 w; w.x = pk2(o[0], o[1]); w.y = pk2(o[2], o[3]); *(u32x2*)(outb + blk_off(row, col0 + bj * 128 + n * 16, DM)) = w; } }
                s += __shfl_xor(s, 16); s += __shfl_xor(s, 32);
                if (fq == 0) unsafeAtomicAdd(ss + row, s); }
        }
        pg8::zero_acc(acc);
    }
    __device__ __forceinline__ void epi_last(Acc& acc, const GUnit& u, int wr, int wc, int fr, int fq, int wv) const {
        const int row0 = u.pm * 256 + wr * 64 + fr, col0 = u.pn * 256 + wc * 32 + 4 * fq;
#pragma unroll
        for (int ai = 0; ai < 2; ++ai) {
            u32x2 bw[4][2][2];
#pragma unroll
            for (int m = 0; m < 4; ++m)
#pragma unroll
                for (int bj = 0; bj < 2; ++bj)
#pragma unroll
                    for (int n = 0; n < 2; ++n) bw[m][bj][n] = *(const u32x2*)(base16 + blk_off(row0 + ai * 128 + m * 16, col0 + bj * 128 + n * 16, DM));
#pragma unroll
            for (int m = 0; m < 4; ++m) { const int row = row0 + ai * 128 + m * 16; float s = 0.f;
#pragma unroll
                for (int bj = 0; bj < 2; ++bj)
#pragma unroll
                    for (int n = 0; n < 2; ++n) { const u32x2 w = bw[m][bj][n]; const f32x4 o = (f32x4){bflo(w.x), bfhi(w.x), bflo(w.y), bfhi(w.y)} + acc[ai][bj][m][n];
                        acc[ai][bj][m][n] = o; s += (o[0] * o[0] + o[1] * o[1]) + (o[2] * o[2] + o[3] * o[3]); }
                s += __shfl_xor(s, 16); s += __shfl_xor(s, 32);
                if (fq == 0) unsafeAtomicAdd(ss + row, s); }
        }
        asm volatile("s_waitcnt vmcnt(0)" ::: "memory");
        __syncthreads();
        const int lane = lane_id_opaque();
        if (wv == 0 && lane == 0) {
            __builtin_amdgcn_fence(__ATOMIC_RELEASE, "agent"); asm volatile("s_waitcnt vmcnt(0)" ::: "memory");
            for (int i = 0; ; ++i) { const int L = i * G + c; if (L >= 64 * 8) break; int pm, pn; pg8::tile_of(L, 64, 8, pm, pn); __hip_atomic_fetch_add(&pcnt[64 * pm], 1u, __ATOMIC_RELAXED, __HIP_MEMORY_SCOPE_AGENT); }
            unsigned sp = 0; while (__hip_atomic_load(&pcnt[64 * u.pm], __ATOMIC_RELAXED, __HIP_MEMORY_SCOPE_AGENT) < 8u) { __builtin_amdgcn_s_sleep(1); if (++sp > (1u << 20)) break; }
            __builtin_amdgcn_fence(__ATOMIC_ACQUIRE, "agent"); asm volatile("s_waitcnt vmcnt(0)" ::: "memory");
        }
        __syncthreads();
        f32x4 wv4[2][2];
#pragma unroll
        for (int bj = 0; bj < 2; ++bj)
#pragma unroll
            for (int n = 0; n < 2; ++n) wv4[bj][n] = *(const f32x4*)(wf + col0 + bj * 128 + n * 16);
        float rr[2][4];
#pragma unroll
        for (int ai = 0; ai < 2; ++ai)
#pragma unroll
            for (int m = 0; m < 4; ++m) rr[ai][m] = __hip_atomic_load(ss + row0 + ai * 128 + m * 16, __ATOMIC_RELAXED, __HIP_MEMORY_SCOPE_AGENT);
#pragma unroll
        for (int ai = 0; ai < 2; ++ai)
#pragma unroll
            for (int m = 0; m < 4; ++m) { const int row = row0 + ai * 128 + m * 16; const float r = 1.0f / sqrtf(rr[ai][m] * (1.0f / DM) + RMS_EPS);
#pragma unroll
                for (int bj = 0; bj < 2; ++bj)
#pragma unroll
                    for (int n = 0; n < 2; ++n) *(f32x4*)(out + (size_t)row * DM + col0 + bj * 128 + n * 16) = acc[ai][bj][m][n] * r * wv4[bj][n]; }
    }
};
struct GuProg {
    static constexpr bool FUSE_LAST = false; static constexpr bool PERM = true; int K, G, c; const bf16_t* X; const bf16_t* W; bf16_t* HH; const float* ss2;
    __device__ __forceinline__ bool next(int i, GUnit& u) const { const int L = i * G + c; if (L >= 64 * 44) return false; pg8::tile_of(L, 64, 44, u.pm, u.pn);
        u.A = (const char*)(X + (size_t)u.pm * 256 * DM); u.B = (const char*)(W + (size_t)u.pn * 256 * DM); u.sub = 0; return true; }
    __device__ __forceinline__ void epi(Acc& acc, const GUnit& u, int wr, int wc, int fr, int fq) const {
        const int row0 = u.pm * 256 + wr * 64 + fr, col0 = u.pn * 128 + wc * 32 + 8 * fq;
        float sq[2][4];
#pragma unroll
        for (int ai = 0; ai < 2; ++ai)
#pragma unroll
            for (int m = 0; m < 4; ++m) sq[ai][m] = ss2[row0 + ai * 128 + m * 16];
#pragma unroll
        for (int ai = 0; ai < 2; ++ai)
#pragma unroll
            for (int m = 0; m < 4; ++m) { const int row = row0 + ai * 128 + m * 16; const float r2 = 1.0f / sqrtf(sq[ai][m] * (1.0f / DM) + RMS_EPS);
                float hv[8];
#pragma unroll
                for (int n = 0; n < 2; ++n)
#pragma unroll
                    for (int j = 0; j < 4; ++j) { const float g = acc[ai][0][m][n][j] * r2, uu = acc[ai][1][m][n][j] * r2; hv[4 * n + j] = siluf_(g) * uu; }
                u32x4 w; w.x = pk2(hv[0], hv[1]); w.y = pk2(hv[2], hv[3]); w.z = pk2(hv[4], hv[5]); w.w = pk2(hv[6], hv[7]);
                *(u32x4*)(HH + blk_off(row, col0, FFH)) = w; }
        pg8::zero_acc(acc);
    }
};
struct Ctx {
    const float* in[21]; float* out; unsigned char* ws;
};
struct TpItem { const float* W; const float* ks; bf16_t* WT; int Nsrc, K, dst_row0, src_col0, kb; };
__device__ __forceinline__ TpItem tp_decode(const Ctx& C, int it) {
    constexpr int I_IN = 32 * 352, I_A = 16 * 64, I_O = 32 * 64, I_GU = 32 * 352;
    unsigned char* ws = C.ws; TpItem t; int r = it;
    if (r < I_IN) { const int nb = r % 352, n0 = nb * 32; t.W = C.in[2]; t.ks = C.in[1]; t.WT = (bf16_t*)(ws + WS_WIN); t.Nsrc = INCOLS; t.K = DM; t.dst_row0 = n0; t.src_col0 = n0 < 7168 ? n0 : n0 + 16; t.kb = r / 352; return t; } r -= I_IN;
    if (r < I_A) { t.W = C.in[14]; t.ks = nullptr; t.WT = (bf16_t*)(ws + WS_WA); t.Nsrc = DM; t.K = HW; t.dst_row0 = (r % 64) * 32; t.src_col0 = t.dst_row0; t.kb = r / 64; return t; } r -= I_A;
    if (r < I_A) { t.W = C.in[15]; t.ks = nullptr; t.WT = (bf16_t*)(ws + WS_WB); t.Nsrc = DM; t.K = MW; t.dst_row0 = (r % 64) * 32; t.src_col0 = t.dst_row0; t.kb = r / 64; return t; } r -= I_A;
    if (r < I_O) { t.W = C.in[16]; t.ks = nullptr; t.WT = (bf16_t*)(ws + WS_WOUT); t.Nsrc = DM; t.K = DM; t.dst_row0 = (r % 64) * 32; t.src_col0 = t.dst_row0; t.kb = r / 64; return t; } r -= I_O;
    if (r < I_GU) { const int nb = r % 352, n0 = nb * 32; const int pn = n0 >> 8, half = (n0 >> 7) & 1, i = n0 & 127;
        t.W = C.in[18]; t.ks = C.in[17]; t.WT = (bf16_t*)(ws + WS_WGU); t.Nsrc = 2 * FFH; t.K = DM; t.dst_row0 = n0; t.src_col0 = half * FFH + 128 * pn + i; t.kb = r / 352; return t; } r -= I_GU;
    t.W = C.in[19]; t.ks = nullptr; t.WT = (bf16_t*)(ws + WS_WD); t.Nsrc = DM; t.K = FFH; t.dst_row0 = (r % 64) * 32; t.src_col0 = t.dst_row0; t.kb = r / 64; return t;
}
__device__ __forceinline__ void tp_load(const TpItem& t, int lane, float (&tv)[32], float (&sv)[32]) {
    const int k0 = 64 * t.kb; const float* wp = t.W + (size_t)(k0 + (lane >> 5)) * t.Nsrc + t.src_col0 + (lane & 31);
#pragma unroll
    for (int i = 0; i < 32; ++i) tv[i] = wp[(size_t)(2 * i) * t.Nsrc];
    const float* kp = t.ks ? t.ks + k0 + (lane >> 5) : nullptr;
#pragma unroll
    for (int i = 0; i < 32; ++i) sv[i] = kp ? kp[2 * i] : 1.0f;
}
__device__ __forceinline__ void p0_prologue(const Ctx& C, LAS unsigned char* lds, int G, int wv) {
    int tid = (wv << 6) | lane_id_opaque(); asm volatile("" : "+v"(tid));
    const int lane = tid & 63, wave = __builtin_amdgcn_readfirstlane(tid >> 6);
    const int gw = blockIdx.x * 8 + wave, NGW = G * 8;
    unsigned char* ws = C.ws;
    LAS float* scr = (LAS float*)(lds + 67584 + wave * 8704);
    {
        constexpr int WGP = 2056;
        LAS bf16_t* wgb = (LAS bf16_t*)lds;
        const float* w_in = C.in[2]; const float* nw = C.in[1];
#pragma unroll 1
        for (int i0 = tid; i0 < DM * 16; i0 += 512 * 16) { float tw[16], tn[16];
#pragma unroll
            for (int u = 0; u < 16; ++u) { const int i = i0 + 512 * u, k = i >> 4, g = i & 15; tw[u] = w_in[(size_t)k * INCOLS + 7168 + g]; tn[u] = nw[k]; }
#pragma unroll
            for (int u = 0; u < 16; ++u) { const int i = i0 + 512 * u, k = i >> 4, g = i & 15; wgb[g * WGP + k] = (bf16_t)f2bf(tw[u] * tn[u]); } }
        __syncthreads();
    }

    {
        constexpr int NIT = 32 * 352 + 2 * 16 * 64 + 32 * 64 + 32 * 352 + 88 * 64;
        float tv[32], sv[32]; TpItem cur, nxt; int it = gw;
        if (it < NIT) { cur = tp_decode(C, it); tp_load(cur, lane, tv, sv); }
        while (it < NIT) {
#pragma unroll
            for (int i = 0; i < 32; ++i) scr[(2 * i + (lane >> 5)) * 33 + (lane & 31)] = tv[i] * sv[i];
            asm volatile("s_waitcnt lgkmcnt(0)" ::: "memory");
            const int nit = it + NGW;
            if (nit < NIT) { nxt = tp_decode(C, nit); tp_load(nxt, lane, tv, sv); }
            const int c = lane & 7, k0 = 64 * cur.kb;
#pragma unroll
            for (int j = 0; j < 4; ++j) { const int n = (lane >> 3) + 8 * j; const LAS float* sp = scr + (8 * c) * 33 + n;
                u32x4 o; o.x = pk2(sp[0 * 33], sp[1 * 33]); o.y = pk2(sp[2 * 33], sp[3 * 33]); o.z = pk2(sp[4 * 33], sp[5 * 33]); o.w = pk2(sp[6 * 33], sp[7 * 33]);
                *(u32x4*)(cur.WT + blk_off(cur.dst_row0 + n, k0 + 8 * c, cur.K)) = o; }
            asm volatile("s_waitcnt lgkmcnt(0)" ::: "memory");
            cur = nxt; it = nit;
        }
    }
    for (int i = blockIdx.x * 512 + tid; i < TOK; i += G * 512) { ((float*)(ws + WS_SS2))[i] = 0.f; ((float*)(ws + WS_SS3))[i] = 0.f; }
    {
        const float* w1 = C.in[5]; const float* b1 = C.in[6]; const float* f1 = C.in[7]; const float* w2 = C.in[8]; const float* b2 = C.in[9]; const float* f2 = C.in[10];
        float* h2 = (float*)(ws + WS_H2);
        for (int t = gw; t < SEQ; t += NGW) {
            const float tl = (float)t / (float)(SEQ - 1);
            const float omega = 6.283185307179586f * (float)t / (float)SEQ;
            float a = b1[lane] + tl * w1[lane];
            float sn, cs;
            { const int bi = lane & 15; const float fr = 1e-4f + (float)bi * ((15.0f - 1e-4f) / 15.0f); sincosf(omega * fr, &sn, &cs); }
#pragma unroll
            for (int i = 0; i < 16; ++i) a += __shfl(cs, i) * w1[(1 + i) * 64 + lane] - __shfl(sn, i) * w1[(17 + i) * 64 + lane];
            const float h1 = sinf(f1[lane] * a);
            float a2 = b2[lane];
#pragma unroll 8
            for (int i = 0; i < 64; ++i) a2 += __shfl(h1, i) * w2[i * 64 + lane];
            h2[t * 64 + lane] = sinf(f2[lane] * a2);
        }
    }
    {
        constexpr int WGP = 2056; LAS bf16_t* wgb = (LAS bf16_t*)lds;
        const float* x = C.in[0]; bf16_t* xb = (bf16_t*)(ws + WS_XB); float* r1 = (float*)(ws + WS_R1S); float* Gt = (float*)(ws + WS_G); const float* gbias = C.in[13];
        const int r = lane & 15, g = lane >> 4; const bool act = r < 8;
        for (int rb = gw; rb < TOK / 8; rb += NGW) {
            const int row = rb * 8 + (r & 7);
            const float* xp = x + (size_t)row * DM + 8 * g;
            f32x4 acc = {0.f, 0.f, 0.f, 0.f}; float ss = 0.f;
#pragma unroll 1
            for (int k8 = 0; k8 < 64; k8 += 8) {
                f32x4 la[8], lb[8];
#pragma unroll
                for (int u = 0; u < 8; ++u) { la[u] = *(const f32x4*)(xp + 32 * (k8 + u)); lb[u] = *(const f32x4*)(xp + 32 * (k8 + u) + 4); }
#pragma unroll
                for (int u = 0; u < 8; ++u) { const int kk = k8 + u; const f32x4 a = la[u], b = lb[u];
                    ss += ((a.x * a.x + a.y * a.y) + (a.z * a.z + a.w * a.w)) + ((b.x * b.x + b.y * b.y) + (b.z * b.z + b.w * b.w));
                    u32x4 o; o.x = pk2(a.x, a.y); o.y = pk2(a.z, a.w); o.z = pk2(b.x, b.y); o.w = pk2(b.z, b.w);
                    *(u32x4*)(xb + blk_off(row, 32 * kk + 8 * g, DM)) = o;
                    if (!act) { o.x = 0u; o.y = 0u; o.z = 0u; o.w = 0u; }
                    const bf16x8 bw = *(const LAS bf16x8*)(wgb + r * WGP + 32 * kk + 8 * g);
                    acc = __builtin_amdgcn_mfma_f32_16x16x32_bf16(__builtin_bit_cast(bf16x8, o), bw, acc, 0, 0, 0); }
            }
            ss += __shfl_xor(ss, 16); ss += __shfl_xor(ss, 32);
            const float rinv = 1.0f / sqrtf(ss * (1.0f / DM) + RMS_EPS);
            const float gb = gbias[r];
#pragma unroll
            for (int i = 0; i < 4; ++i) { const int m = 4 * g + i; const float rv = __shfl(rinv, m & 7); if (g < 2) Gt[(size_t)(rb * 8 + m) * 16 + r] = acc[i] * rv + gb; }
            if (lane < 8) r1[rb * 8 + lane] = rinv;
        }
    }
}
__device__ __forceinline__ void p1_filters(const Ctx& C, LAS unsigned char* lds, int G, int wv) {
    int tid = (wv << 6) | lane_id_opaque(); asm volatile("" : "+v"(tid));
    const int lane = tid & 63, w = tid >> 6, r = lane & 15, g = lane >> 4;
    const float* w3 = C.in[11]; const float* h2 = (const float*)(C.ws + WS_H2); float* FILT = (float*)(C.ws + WS_FILT);
    for (int item = blockIdx.x; item < 256; item += G) {
        const int n0 = 64 * (item >> 2), t0 = 1024 * (item & 3) + 128 * w;
        bf16x8 af[4][2];
#pragma unroll
        for (int mt = 0; mt < 4; ++mt)
#pragma unroll
            for (int ks = 0; ks < 2; ++ks) { float v[8];
#pragma unroll
                for (int e = 0; e < 8; ++e) v[e] = w3[(size_t)(32 * ks + 8 * g + e) * NFILT + n0 + 16 * mt + r];
                u32x4 o; o.x = pk2(v[0], v[1]); o.y = pk2(v[2], v[3]); o.z = pk2(v[4], v[5]); o.w = pk2(v[6], v[7]); af[mt][ks] = __builtin_bit_cast(bf16x8, o); }
        float dl[4][4];
#pragma unroll
        for (int mt = 0; mt < 4; ++mt)
#pragma unroll
            for (int i = 0; i < 4; ++i) { const int ch = (n0 + 16 * mt + 4 * g + i) & 1023; const float mind = -3.0701134573253945f, maxd = -15.350567286626973f;
                dl[mt][i] = fabsf(mind + (float)ch * ((maxd - mind) / 1023.0f)); }
        bf16x8 bfr[8][2];
#pragma unroll
        for (int nt = 0; nt < 8; ++nt) { const int t = t0 + 16 * nt + r;
#pragma unroll
            for (int ks = 0; ks < 2; ++ks) { const f32x4 a = *(const f32x4*)(h2 + (size_t)t * 64 + 32 * ks + 8 * g), b = *(const f32x4*)(h2 + (size_t)t * 64 + 32 * ks + 8 * g + 4);
                u32x4 o; o.x = pk2(a.x, a.y); o.y = pk2(a.z, a.w); o.z = pk2(b.x, b.y); o.w = pk2(b.z, b.w); bfr[nt][ks] = __builtin_bit_cast(bf16x8, o); } }
#pragma unroll
        for (int nt = 0; nt < 8; ++nt) {
            const int t = t0 + 16 * nt + r;
            const float tl = (float)t / (float)(SEQ - 1);
#pragma unroll
            for (int mt = 0; mt < 4; ++mt) {
                f32x4 acc = {0.f, 0.f, 0.f, 0.f};
                acc = __builtin_amdgcn_mfma_f32_16x16x32_bf16(af[mt][0], bfr[nt][0], acc, 0, 0, 0);
                acc = __builtin_amdgcn_mfma_f32_16x16x32_bf16(af[mt][1], bfr[nt][1], acc, 0, 0, 0);
#pragma unroll
                for (int i = 0; i < 4; ++i) FILT[(size_t)(n0 + 16 * mt + 4 * g + i) * SEQ + t] = acc[i] * expf(-tl * dl[mt][i]);
            }
        }
    }
}
__device__ __forceinline__ void p7_final(const Ctx& C, int G, int wv) {
    int tid = (wv << 6) | lane_id_opaque(); asm volatile("" : "+v"(tid));
    const int lane = tid & 63, wave = tid >> 6, gw = blockIdx.x * 8 + wave, NGW = G * 8;
    const float* ss3 = (const float*)(C.ws + WS_SS3); const float* wf = C.in[20];
    f32x4 w[8];
#pragma unroll
    for (int j = 0; j < 8; ++j) w[j] = ((const f32x4*)wf)[64 * j + lane];
    for (int row = gw; row < TOK; row += 2 * NGW) {
        const int row2 = row + NGW;
        const bool has2 = row2 < TOK;
        const float r = 1.0f / sqrtf(ss3[row] * (1.0f / DM) + RMS_EPS), r2 = has2 ? 1.0f / sqrtf(ss3[row2] * (1.0f / DM) + RMS_EPS) : 0.f;
        f32x4* p = (f32x4*)(C.out + (size_t)row * DM) + lane; f32x4* p2 = (f32x4*)(C.out + (size_t)(has2 ? row2 : row) * DM) + lane;
        f32x4 v[8], u[8];
#pragma unroll
        for (int j = 0; j < 8; ++j) { v[j] = p[64 * j]; u[j] = p2[64 * j]; }
#pragma unroll
        for (int j = 0; j < 8; ++j) p[64 * j] = v[j] * r * w[j];
        if (has2) {
#pragma unroll
            for (int j = 0; j < 8; ++j) p2[64 * j] = u[j] * r2 * w[j]; }
    }
}
#ifndef FFT_HOST
#define FFT_DEV __device__ __forceinline__
#define FFT_PTR LAS f32x2*
#define FFT_SIN(x) __builtin_amdgcn_sinf(x)
#define FFT_COS(x) __builtin_amdgcn_cosf(x)
#else
#define FFT_DEV static inline
#define FFT_PTR f32x2*
#define FFT_SIN(x) sinf(6.283185307179586f * (x))
#define FFT_COS(x) cosf(6.283185307179586f * (x))
#endif
#define PADI(i) ((i) + ((i) >> 4))
FFT_DEV f32x2 cmul(f32x2 a, f32x2 b) { f32x2 r; r.x = a.x * b.x - a.y * b.y; r.y = a.x * b.y + a.y * b.x; return r; }
FFT_DEV f32x2 cmulc(f32x2 a, f32x2 b) { f32x2 r; r.x = a.x * b.x + a.y * b.y; r.y = a.y * b.x - a.x * b.y; return r; }
FFT_DEV f32x2 twid(float frac) { f32x2 r; r.x = FFT_COS(frac); r.y = -FFT_SIN(frac); return r; }
template <int M, int CJ> FFT_DEV f32x2 rot8(f32x2 d) {
    const float R = 0.70710678118654752f; f32x2 r;
    if (M == 0) return d;
    if (M == 2) { if (!CJ) { r.x = d.y; r.y = -d.x; } else { r.x = -d.y; r.y = d.x; } return r; }
    if (M == 1) { if (!CJ) { r.x = R * (d.x + d.y); r.y = R * (d.y - d.x); } else { r.x = R * (d.x - d.y); r.y = R * (d.x + d.y); } return r; }
    if (!CJ) { r.x = R * (d.y - d.x); r.y = -R * (d.x + d.y); } else { r.x = -R * (d.x + d.y); r.y = R * (d.x - d.y); } return r;
}
template <int INV, int ZHI, int LOW> FFT_DEV void fft_r8_pass(FFT_PTR buf, int s, int ls  , int tid) {
#pragma unroll 1
    for (int rep = 0; rep < 2; ++rep) {
        const int bf = tid + rep * 512, j = bf & (s - 1), blk = bf >> ls, base = blk * 8 * s + j;
        f32x2 x[8];
#pragma unroll
        for (int m = 0; m < (ZHI ? 4 : 8); ++m) x[m] = buf[PADI(base + m * s)];
        f32x2 w1 = twid((float)j / (float)(8 * s));
        f32x2 w2 = cmul(w1, w1), w4 = cmul(w2, w2);
        if (!INV) {
            if (ZHI) {
                x[4] = cmul(x[0], w1); x[5] = cmul(rot8<1, 0>(x[1]), w1); x[6] = cmul(rot8<2, 0>(x[2]), w1); x[7] = cmul(rot8<3, 0>(x[3]), w1);
            } else {
                { f32x2 a = x[0], b = x[4]; x[0] = a + b; x[4] = cmul(a - b, w1); }
                { f32x2 a = x[1], b = x[5]; x[1] = a + b; x[5] = cmul(rot8<1, 0>(a - b), w1); }
                { f32x2 a = x[2], b = x[6]; x[2] = a + b; x[6] = cmul(rot8<2, 0>(a - b), w1); }
                { f32x2 a = x[3], b = x[7]; x[3] = a + b; x[7] = cmul(rot8<3, 0>(a - b), w1); }
            }
#pragma unroll
            for (int h = 0; h < 8; h += 4) {
                { f32x2 a = x[h], b = x[h + 2]; x[h] = a + b; x[h + 2] = cmul(a - b, w2); }
                { f32x2 a = x[h + 1], b = x[h + 3]; x[h + 1] = a + b; x[h + 3] = cmul(rot8<2, 0>(a - b), w2); }
            }
#pragma unroll
            for (int m = 0; m < 8; m += 2) { f32x2 a = x[m], b = x[m + 1]; x[m] = a + b; x[m + 1] = cmul(a - b, w4); }
        } else {
#pragma unroll
            for (int m = 0; m < 8; m += 2) { f32x2 a = x[m], b = cmulc(x[m + 1], w4); x[m] = a + b; x[m + 1] = a - b; }
#pragma unroll
            for (int h = 0; h < 8; h += 4) {
                { f32x2 a = x[h], b = cmulc(x[h + 2], w2); x[h] = a + b; x[h + 2] = a - b; }
                { f32x2 a = x[h + 1], b = rot8<2, 1>(cmulc(x[h + 3], w2)); x[h + 1] = a + b; x[h + 3] = a - b; }
            }
            { f32x2 a = x[0], b = cmulc(x[4], w1); x[0] = a + b; if (!LOW) x[4] = a - b; }
            { f32x2 a = x[1], b = rot8<1, 1>(cmulc(x[5], w1)); x[1] = a + b; if (!LOW) x[5] = a - b; }
            { f32x2 a = x[2], b = rot8<2, 1>(cmulc(x[6], w1)); x[2] = a + b; if (!LOW) x[6] = a - b; }
            { f32x2 a = x[3], b = rot8<3, 1>(cmulc(x[7], w1)); x[3] = a + b; if (!LOW) x[7] = a - b; }
        }
#pragma unroll
        for (int m = 0; m < (LOW ? 4 : 8); ++m) buf[PADI(base + m * s)] = x[m];
    }
}
FFT_DEV void fft_r2_span1(FFT_PTR buf, int tid) {
#pragma unroll
    for (int rep = 0; rep < 8; ++rep) { const int p = 2 * (tid + rep * 512); f32x2 a = buf[PADI(p)], b = buf[PADI(p + 1)]; buf[PADI(p)] = a + b; buf[PADI(p + 1)] = a - b; }
}
template <int J, int CJ> FFT_DEV f32x2 rot16(f32x2 d) {
    const float C1 = 0.92387953251128674f, S1 = 0.38268343236508977f;
    if ((J & 1) == 0) return rot8<J / 2, CJ>(d);
    const float wr = (J == 1) ? C1 : (J == 3) ? S1 : (J == 5) ? -S1 : -C1;
    const float wi = ((J == 1) ? -S1 : (J == 3) ? -C1 : (J == 5) ? -C1 : -S1) * (CJ ? -1.f : 1.f);
    f32x2 r; r.x = d.x * wr - d.y * wi; r.y = d.x * wi + d.y * wr; return r;
}
FFT_DEV unsigned brev13(unsigned p);
FFT_DEV void fft16_dif(f32x2 (&x)[16]) {
#define BF_(i, j, ROT) { const f32x2 a_ = x[i], b_ = x[j]; x[i] = a_ + b_; x[j] = ROT(a_ - b_); }
    BF_(0, 8, (rot16<0, 0>)) BF_(1, 9, (rot16<1, 0>)) BF_(2, 10, (rot16<2, 0>)) BF_(3, 11, (rot16<3, 0>)) BF_(4, 12, (rot16<4, 0>)) BF_(5, 13, (rot16<5, 0>)) BF_(6, 14, (rot16<6, 0>)) BF_(7, 15, (rot16<7, 0>))
#pragma unroll
    for (int h = 0; h < 16; h += 8) { BF_(h + 0, h + 4, (rot8<0, 0>)) BF_(h + 1, h + 5, (rot8<1, 0>)) BF_(h + 2, h + 6, (rot8<2, 0>)) BF_(h + 3, h + 7, (rot8<3, 0>)) }
#pragma unroll
    for (int h = 0; h < 16; h += 4) { BF_(h + 0, h + 2, (rot8<0, 0>)) BF_(h + 1, h + 3, (rot8<2, 0>)) }
#pragma unroll
    for (int h = 0; h < 16; h += 2) { BF_(h, h + 1, (rot8<0, 0>)) }
#undef BF_
}
FFT_DEV void fft16_dit_inv(f32x2 (&x)[16]) {
#define BI_(i, j, ROT) { const f32x2 a_ = x[i], b_ = ROT(x[j]); x[i] = a_ + b_; x[j] = a_ - b_; }
#pragma unroll
    for (int h = 0; h < 16; h += 2) { BI_(h, h + 1, (rot8<0, 1>)) }
#pragma unroll
    for (int h = 0; h < 16; h += 4) { BI_(h + 0, h + 2, (rot8<0, 1>)) BI_(h + 1, h + 3, (rot8<2, 1>)) }
#pragma unroll
    for (int h = 0; h < 16; h += 8) { BI_(h + 0, h + 4, (rot8<0, 1>)) BI_(h + 1, h + 5, (rot8<1, 1>)) BI_(h + 2, h + 6, (rot8<2, 1>)) BI_(h + 3, h + 7, (rot8<3, 1>)) }
    BI_(0, 8, (rot16<0, 1>)) BI_(1, 9, (rot16<1, 1>)) BI_(2, 10, (rot16<2, 1>)) BI_(3, 11, (rot16<3, 1>)) BI_(4, 12, (rot16<4, 1>)) BI_(5, 13, (rot16<5, 1>)) BI_(6, 14, (rot16<6, 1>)) BI_(7, 15, (rot16<7, 1>))
#undef BI_
}
template <int MODE> FFT_DEV void fft_mid_pass(FFT_PTR wb, FFT_PTR zk, int tid) {
    f32x2 x[16];
#pragma unroll
    for (int e = 0; e < 16; ++e) x[e] = wb[PADI(16 * tid + e)];
    fft16_dif(x);
    if (MODE != 0) {
#pragma unroll
        for (int e = 0; e < 16; ++e) {
            const unsigned p = 16u * (unsigned)tid + (unsigned)e, f = brev13(p), fn = (8192u - f) & 8191u, pn = brev13(fn);
            const f32x2 zf = zk[PADI(p)], zn = zk[PADI(pn)];
            f32x2 kf;
            if (MODE == 1) { kf.x = 0.5f * (zf.x + zn.x); kf.y = 0.5f * (zf.y - zn.y); }
            else           { kf.x = 0.5f * (zf.y + zn.y); kf.y = 0.5f * (zn.x - zf.x); }
            x[e] = cmul(x[e], kf);
        }
        fft16_dit_inv(x);
    }
#pragma unroll
    for (int e = 0; e < 16; ++e) wb[PADI(16 * tid + e)] = x[e];
}
#ifndef FFT_HOST
#define FFT_SYNC() do { asm volatile("s_waitcnt lgkmcnt(0)" ::: "memory"); __builtin_amdgcn_s_barrier(); asm volatile("" ::: "memory"); } while (0)
__device__ __forceinline__ void fft_fwd_full(FFT_PTR buf, int tid) {
    FFT_SYNC(); fft_r8_pass<0, 0, 0>(buf, 1024, 10, tid); FFT_SYNC(); fft_r8_pass<0, 0, 0>(buf, 128, 7, tid); FFT_SYNC(); fft_r8_pass<0, 0, 0>(buf, 16, 4, tid); FFT_SYNC();
    fft_mid_pass<0>(buf, buf, tid); FFT_SYNC();
}
template <int WHICH> __device__ __forceinline__ void fft_conv(FFT_PTR wb, FFT_PTR zk, int tid) {
    FFT_SYNC(); fft_r8_pass<0, 1, 0>(wb, 1024, 10, tid); FFT_SYNC(); fft_r8_pass<0, 0, 0>(wb, 128, 7, tid); FFT_SYNC(); fft_r8_pass<0, 0, 0>(wb, 16, 4, tid); FFT_SYNC();
    fft_mid_pass<1 + WHICH>(wb, zk, tid); FFT_SYNC();
    fft_r8_pass<1, 0, 0>(wb, 16, 4, tid); FFT_SYNC(); fft_r8_pass<1, 0, 0>(wb, 128, 7, tid); FFT_SYNC(); fft_r8_pass<1, 0, 1>(wb, 1024, 10, tid); FFT_SYNC();
}
#endif
FFT_DEV unsigned brev13(unsigned p) {
    unsigned r = 0;
#ifndef FFT_HOST
    r = __brev(p) >> 19;
#else
    for (int i = 0; i < 13; ++i) r |= ((p >> i) & 1u) << (12 - i);
#endif
    return r;
}
FFT_DEV void fft_pointwise(FFT_PTR wb, FFT_PTR zk, int which, int tid) {
#pragma unroll 4
    for (int rep = 0; rep < 16; ++rep) {
        const unsigned p = tid + rep * 512, f = brev13(p), fn = (8192u - f) & 8191u, pn = brev13(fn);
        const f32x2 zf = zk[PADI(p)], zn = zk[PADI(pn)];
        f32x2 kf;
        if (which == 0) { kf.x = 0.5f * (zf.x + zn.x); kf.y = 0.5f * (zf.y - zn.y); }
        else            { kf.x = 0.5f * (zf.y + zn.y); kf.y = 0.5f * (zn.x - zf.x); }
        wb[PADI(p)] = cmul(wb[PADI(p)], kf);
    }
}
__device__ __forceinline__ void qk_prepass(const Ctx& C, int G, int wv) {
    int tid = (wv << 6) | lane_id_opaque(); asm volatile("" : "+v"(tid));
    const bf16_t* R1A = (const bf16_t*)(C.ws + WS_R1A); bf16_t* QKP = (bf16_t*)(C.ws + WS_QKP);
    const float* cw = C.in[3]; const float* cb = C.in[4];
    const int cg8 = tid & 255, half = tid >> 8, col = 8 * cg8;
    float k0[8], k1[8], k2[8], kb[8];
    { const int ch = 3072 + col;
      const f32x4 t0 = *(const f32x4*)(cw + ch), t1 = *(const f32x4*)(cw + ch + 4), t2 = *(const f32x4*)(cw + CONVC + ch), t3 = *(const f32x4*)(cw + CONVC + ch + 4);
      const f32x4 t4 = *(const f32x4*)(cw + 2 * CONVC + ch), t5 = *(const f32x4*)(cw + 2 * CONVC + ch + 4), t6 = *(const f32x4*)(cb + ch), t7 = *(const f32x4*)(cb + ch + 4);
#pragma unroll
      for (int e = 0; e < 4; ++e) { k0[e] = t0[e]; k0[4 + e] = t1[e]; k1[e] = t2[e]; k1[4 + e] = t3[e]; k2[e] = t4[e]; k2[4 + e] = t5[e]; kb[e] = t6[e]; kb[4 + e] = t7[e]; } }
    const float osc = col >= 1024 ? 0.0625f : 1.0f;
    for (int run = blockIdx.x; run < TOK / 64; run += G) {
        const int row0 = run * 64 + half * 32;
#pragma unroll 1
        for (int i0 = 0; i0 < 32; i0 += 4) {
            u32x4 w0[4], w1[4], w2[4];
#pragma unroll
            for (int u = 0; u < 4; ++u) { const int row = row0 + i0 + u, t = row & (SEQ - 1); const bf16_t* p = R1A + (size_t)row * 2048 + col;
                w0[u] = *(const u32x4*)(t > 0 ? p - 2048 : p); w1[u] = *(const u32x4*)p; w2[u] = *(const u32x4*)(t < SEQ - 1 ? p + 2048 : p); }
#pragma unroll
            for (int u = 0; u < 4; ++u) { const int row = row0 + i0 + u, t = row & (SEQ - 1);
                const u32x4 z = {0u, 0u, 0u, 0u}; if (t == 0) w0[u] = z; if (t == SEQ - 1) w2[u] = z;
                float a0[8], a1[8], a2[8]; unpack8(w0[u], a0); unpack8(w1[u], a1); unpack8(w2[u], a2);
                float v[8];
#pragma unroll
                for (int e = 0; e < 8; ++e) v[e] = siluf_(k0[e] * a0[e] + k1[e] * a1[e] + k2[e] * a2[e] + kb[e]) * osc;
                u32x4 o; o.x = pk2(v[0], v[1]); o.y = pk2(v[2], v[3]); o.z = pk2(v[4], v[5]); o.w = pk2(v[6], v[7]);
                *(u32x4*)(QKP + (size_t)row * 2048 + col) = o; }
        }
    }
}
constexpr int ML_KS = 0, ML_KP = 528, ML_SS = 76032, ML_SP = 272, ML_VS = 110848, ML_VP = 80, ML_VW = 121088, ML_CS = 131328, ML_CP = 528, ML_SC = 148224;
static_assert(ML_SC + 7 * 512 + 64 + 5 * 128 <= LDS_BYTES - 16, "mLSTM LDS map");
__device__ __forceinline__ bf16x8 tr_read2(unsigned a0, unsigned a1) {
    bf16x4 lo, hi;
    asm volatile("ds_read_b64_tr_b16 %0, %2\n\tds_read_b64_tr_b16 %1, %3\n\ts_waitcnt lgkmcnt(0)" : "=&v"(lo), "=&v"(hi) : "v"(a0), "v"(a1) : "memory");
    bf16x8 r; r[0] = lo[0]; r[1] = lo[1]; r[2] = lo[2]; r[3] = lo[3]; r[4] = hi[0]; r[5] = hi[1]; r[6] = hi[2]; r[7] = hi[3]; return r;
}
__device__ __forceinline__ bf16x8 cat4(bf16x4 lo, bf16x4 hi) { bf16x8 r; r[0] = lo[0]; r[1] = lo[1]; r[2] = lo[2]; r[3] = lo[3]; r[4] = hi[0]; r[5] = hi[1]; r[6] = hi[2]; r[7] = hi[3]; return r; }
__device__ __forceinline__ void tr_read2x2(unsigned a, unsigned b, unsigned d, bf16x8& ra, bf16x8& rb) {
    bf16x4 l0, h0, l1, h1;
    asm volatile("ds_read_b64_tr_b16 %0, %4\n\tds_read_b64_tr_b16 %1, %5\n\tds_read_b64_tr_b16 %2, %6\n\tds_read_b64_tr_b16 %3, %7\n\ts_waitcnt lgkmcnt(0)"
        : "=&v"(l0), "=&v"(h0), "=&v"(l1), "=&v"(h1) : "v"(a), "v"(a + d), "v"(b), "v"(b + d) : "memory");
    ra = cat4(l0, h0); rb = cat4(l1, h1);
}
__device__ __forceinline__ void tr_read4x2(unsigned a, unsigned b, unsigned d, unsigned c, unsigned e, unsigned d2, bf16x8& ra, bf16x8& rb, bf16x8& rc, bf16x8& re) {
    bf16x4 l0, h0, l1, h1, l2, h2, l3, h3;
    asm volatile("ds_read_b64_tr_b16 %0, %8\n\tds_read_b64_tr_b16 %1, %9\n\tds_read_b64_tr_b16 %2, %10\n\tds_read_b64_tr_b16 %3, %11\n\t"
                 "ds_read_b64_tr_b16 %4, %12\n\tds_read_b64_tr_b16 %5, %13\n\tds_read_b64_tr_b16 %6, %14\n\tds_read_b64_tr_b16 %7, %15\n\ts_waitcnt lgkmcnt(0)"
        : "=&v"(l0), "=&v"(h0), "=&v"(l1), "=&v"(h1), "=&v"(l2), "=&v"(h2), "=&v"(l3), "=&v"(h3)
        : "v"(a), "v"(a + d), "v"(b), "v"(b + d), "v"(c), "v"(c + d2), "v"(e), "v"(e + d2) : "memory");
    ra = cat4(l0, h0); rb = cat4(l1, h1); rc = cat4(l2, h2); re = cat4(l3, h3);
}
__device__ __forceinline__ float bf2f(short s) { return __uint_as_float(((unsigned)(unsigned short)s) << 16); }
__device__ __forceinline__ float logsigmoidf_(float x) { return fminf(x, 0.f) - log1pf(expf(-fabsf(x))); }

__device__ __forceinline__ void mlstm_item(const Ctx& C, LAS unsigned char* lds, int item, int wv) {
    int tid = (wv << 6) | lane_id_opaque(); asm volatile("" : "+v"(tid));
    const int lane = tid & 63, w = __builtin_amdgcn_readfirstlane(tid >> 6), r = lane & 15, g = lane >> 4, q4 = r >> 2, p4 = r & 3;
    const int xcd_ = item & 7, yy_ = item >> 3, vs = yy_ & 7, dir = (yy_ >> 3) & 1, bh = 2 * xcd_ + (yy_ >> 4), b = bh >> 2, h = bh & 3;
    const bf16_t* QKP = (const bf16_t*)(C.ws + WS_QKP); const bf16_t* R1B = (const bf16_t*)(C.ws + WS_R1B); const float* Gt = (const float*)(C.ws + WS_G);
    bf16_t* Y = (bf16_t*)(C.ws + (dir ? WS_YBB : WS_YBF));
    LAS float* SC = (LAS float*)(lds + ML_SC);
    LAS float* s_cs = SC, *s_rj = SC + 128, *s_iw = SC + 256, *s_emj = SC + 384, *s_w = SC + 512, *s_dn = SC + 640, *s_misc = SC + 768;
    LAS float* c_bl = SC + 784, *c_mx = SC + 816, *c_mp = SC + 848, *c_mn = SC + 880, *c_kp = SC + 912;
    float* GS = (float*)(C.ws + WS_GSC) + (size_t)item * 3 * SEQ;
    const unsigned lbase = (unsigned)(size_t)lds;
    const int pc = tid & 31, krow = tid >> 5, vrow = tid >> 2, pv = tid & 3;
    const int sw = w < 4 ? w : 11 - w;
    for (int i = tid; i < 16896 / 4; i += 512) ((LAS unsigned*)(lds + ML_CS))[i] = 0u;
    for (int i = tid; i < 16 * ML_KP / 4; i += 512) ((LAS unsigned*)(lds + ML_KS + 128 * ML_KP))[i] = 0u;
    f32x4 Cacc[3][2];
#pragma unroll
    for (int a = 0; a < 3; ++a) { Cacc[a][0] = (f32x4){0.f, 0.f, 0.f, 0.f}; Cacc[a][1] = (f32x4){0.f, 0.f, 0.f, 0.f}; }
    u32x4 kreg[8], vreg, qn[8]; float bn = 0.f, csn = 0.f, pmn = 0.f;
#define ML_TOK(c_, j_) ((size_t)b * SEQ + (dir ? SEQ - 1 - ((c_) * 128 + (j_)) : ((c_) * 128 + (j_))))
#define ML_PREFETCH(c_) do { \
        _Pragma("unroll") for (int i = 0; i < 8; ++i) kreg[i] = *(const u32x4*)(QKP + ML_TOK(c_, krow + 16 * i) * 2048 + 1024 + h * 256 + 8 * pc); \
        vreg = *(const u32x4*)(R1B + ML_TOK(c_, vrow) * 2048 + h * 256 + vs * 32 + 8 * pv); \
        { const bf16_t* qp = QKP + ML_TOK(c_, 16 * sw + r) * 2048 + h * 256 + 8 * g; _Pragma("unroll") for (int kk = 0; kk < 8; ++kk) qn[kk] = *(const u32x4*)(qp + 32 * kk); } \
        if (tid < 128) { const int ta = (c_) * 128 + tid; bn = GS[ta]; csn = GS[SEQ + ta]; pmn = GS[2 * SEQ + ta]; } } while (0)
    {
        float gi[8], gf[8];
#pragma unroll
        for (int u = 0; u < 8; ++u) { const int ta = (4 * w) * 128 + u * 64 + lane; const size_t tk = (size_t)b * SEQ + (dir ? SEQ - 1 - ta : ta);
            gi[u] = Gt[tk * 16 + (dir * 2) * 4 + h]; gf[u] = Gt[tk * 16 + (dir * 2 + 1) * 4 + h]; }
#pragma unroll
        for (int q = 0; q < 4; ++q) {
            const int c = 4 * w + q; float carry_b = 0.f, carry_m = -3.0e38f;
#pragma unroll
            for (int hf = 0; hf < 2; ++hf) {
                const int ta = c * 128 + hf * 64 + lane;
                const float ip = gi[2 * q + hf], fp = gf[2 * q + hf];
                float xs = logsigmoidf_(fp);
#pragma unroll
                for (int o = 1; o < 64; o <<= 1) { const float y = __shfl_up(xs, o); if (lane >= o) xs += y; }
                const float bj = xs + carry_b; const float cj = ip - bj; float pm = cj;
#pragma unroll
                for (int o = 1; o < 64; o <<= 1) { const float y = __shfl_up(pm, o); if (lane >= o) pm = fmaxf(pm, y); }
                pm = fmaxf(pm, carry_m);
                GS[ta] = bj; GS[SEQ + ta] = cj; GS[2 * SEQ + ta] = pm;
                carry_b = __shfl(bj, 63); carry_m = __shfl(pm, 63);
            }
            if (lane == 0) { c_bl[c] = carry_b; c_mx[c] = carry_m; }
        }
        __syncthreads();
        if (tid == 0) { float m = 0.f;
            for (int c = 0; c < 32; ++c) { const float bl = c_bl[c], mn = fmaxf(bl + m, bl + c_mx[c]); c_mp[c] = m; c_mn[c] = mn; c_kp[c] = __expf(bl + m - mn); m = mn; } }
        __syncthreads();
    }
    ML_PREFETCH(0);
    __syncthreads();
#define ML_BAR() do { asm volatile("s_waitcnt lgkmcnt(0)" ::: "memory"); __builtin_amdgcn_s_barrier(); asm volatile("" ::: "memory"); } while (0)
#pragma unroll 1
    for (int c = 0; c < 32; ++c) {
        const float m_prev = c_mp[c], m_new = c_mn[c], keep = c_kp[c], b_last = c_bl[c];
        if (tid < 128) {
            const float inter = bn + m_prev, mj = fmaxf(inter, bn + pmn);
            s_cs[tid] = csn; s_rj[tid] = bn - mj; s_iw[tid] = __expf(inter - mj); s_emj[tid] = __expf(-mj); s_w[tid] = __expf(b_last + csn - m_new);
        }
        ML_BAR();
#pragma unroll
        for (int i = 0; i < 8; ++i) *(LAS u32x4*)(lds + ML_KS + (krow + 16 * i) * ML_KP + pc * 16) = kreg[i];
        {
            *(LAS u32x4*)(lds + ML_VS + vrow * ML_VP + pv * 16) = vreg;
            float f[8]; unpack8(vreg, f); const float ws_ = s_w[vrow];
            u32x4 o; o.x = pk2(f[0] * ws_, f[1] * ws_); o.y = pk2(f[2] * ws_, f[3] * ws_); o.z = pk2(f[4] * ws_, f[5] * ws_); o.w = pk2(f[6] * ws_, f[7] * ws_);
            *(LAS u32x4*)(lds + ML_VW + vrow * ML_VP + pv * 16) = o;
        }
        bf16x8 qf[8];
#pragma unroll
        for (int kk = 0; kk < 8; ++kk) qf[kk] = __builtin_bit_cast(bf16x8, qn[kk]);
        unsigned short ogr[4][2];
#pragma unroll
        for (int i = 0; i < 4; ++i)
#pragma unroll
            for (int vt = 0; vt < 2; ++vt) ogr[i][vt] = R1B[ML_TOK(c, 16 * sw + 4 * g + i) * 2048 + 1024 + h * 256 + vs * 32 + 16 * vt + r];
        if (c < 31) ML_PREFETCH(c + 1);
        ML_BAR();
        {
            const float rjv = s_rj[16 * sw + r]; const int jloc = 16 * sw + r; float den1 = 0.f;
#pragma unroll 2
            for (int st = 0; st < 8; ++st) {
                if (st <= sw) {
                    f32x4 acc = {0.f, 0.f, 0.f, 0.f};
#pragma unroll
                    for (int kk = 0; kk < 8; ++kk) { const bf16x8 kf = *(const LAS bf16x8*)(lds + ML_KS + (16 * st + r) * ML_KP + (32 * kk + 8 * g) * 2); acc = __builtin_amdgcn_mfma_f32_16x16x32_bf16(kf, qf[kk], acc, 0, 0, 0); }
                    const f32x4 c4 = *(const LAS f32x4*)(s_cs + 16 * st + 4 * g);
                    float v[4];
#pragma unroll
                    for (int i = 0; i < 4; ++i) { const int s = 16 * st + 4 * g + i; const float d = (s <= jloc) ? __expf(rjv + c4[i]) : 0.f; v[i] = acc[i] * d; den1 += v[i]; }
                    u32x2 o; o.x = pk2(v[0], v[1]); o.y = pk2(v[2], v[3]);
                    *(LAS u32x2*)(lds + ML_SS + jloc * ML_SP + (16 * st + 4 * g) * 2) = o;
                } else if (st == sw + 1 && !(sw & 1)) {
                    u32x2 o = {0u, 0u}; *(LAS u32x2*)(lds + ML_SS + jloc * ML_SP + (16 * st + 4 * g) * 2) = o;
                }
            }
            den1 += __shfl_xor(den1, 16); den1 += __shfl_xor(den1, 32);
            f32x4 dacc = {0.f, 0.f, 0.f, 0.f};
#pragma unroll
            for (int kk = 0; kk < 8; ++kk) { const bf16x8 kf = *(const LAS bf16x8*)(lds + ML_KS + (128 + r) * ML_KP + (32 * kk + 8 * g) * 2); dacc = __builtin_amdgcn_mfma_f32_16x16x32_bf16(kf, qf[kk], dacc, 0, 0, 0); }
            const float d2 = dacc[0];
            if (g == 0) s_dn[jloc] = den1 + s_iw[jloc] * d2;
        }
        ML_BAR();
        {
            f32x4 n1[2], n2[2];
#pragma unroll
            for (int vt = 0; vt < 2; ++vt) { n1[vt] = (f32x4){0.f, 0.f, 0.f, 0.f}; n2[vt] = (f32x4){0.f, 0.f, 0.f, 0.f}; }
            const int nks = (sw >> 1) + 1;
#pragma unroll 1
            for (int ks = 0; ks < nks; ++ks) {
                const bf16x8 af = *(const LAS bf16x8*)(lds + ML_SS + (16 * sw + r) * ML_SP + (32 * ks + 8 * g) * 2);
                const unsigned a0 = lbase + ML_VS + (32 * ks + 8 * g + q4) * ML_VP + (4 * p4) * 2;
                bf16x8 b0, b1; tr_read2x2(a0, a0 + 32, 4 * ML_VP, b0, b1);
                n1[0] = __builtin_amdgcn_mfma_f32_16x16x32_bf16(af, b0, n1[0], 0, 0, 0); n1[1] = __builtin_amdgcn_mfma_f32_16x16x32_bf16(af, b1, n1[1], 0, 0, 0);
            }
#pragma unroll
            for (int kk = 0; kk < 8; ++kk)
#pragma unroll
                for (int vt = 0; vt < 2; ++vt) { const bf16x8 cf = *(const LAS bf16x8*)(lds + ML_CS + (16 * vt + r) * ML_CP + (32 * kk + 8 * g) * 2); n2[vt] = __builtin_amdgcn_mfma_f32_16x16x32_bf16(qf[kk], cf, n2[vt], 0, 0, 0); }
            const f32x4 iw4 = *(const LAS f32x4*)(s_iw + 16 * sw + 4 * g), dn4 = *(const LAS f32x4*)(s_dn + 16 * sw + 4 * g), em4 = *(const LAS f32x4*)(s_emj + 16 * sw + 4 * g);
#pragma unroll
            for (int i = 0; i < 4; ++i) {
                const size_t tok = ML_TOK(c, 16 * sw + 4 * g + i);
                const float inv = 1.0f / fmaxf(fabsf(dn4[i]), em4[i]);
#pragma unroll
                for (int vt = 0; vt < 2; ++vt) { const int col = h * 256 + vs * 32 + 16 * vt + r;
                    const float og = __uint_as_float(((unsigned)ogr[i][vt]) << 16);
                    const float hv = (n1[vt][i] + iw4[i] * n2[vt][i]) * inv * og;
                    Y[blk_off((int)tok, col, 1024)] = (bf16_t)f2bf(hv); }
            }
        }
        ML_BAR();
        {
#pragma unroll
            for (int a = 0; a < 3; ++a) { Cacc[a][0] *= keep; Cacc[a][1] *= keep; }
#pragma unroll 1
            for (int ks = 0; ks < 4; ++ks) {
                bf16x8 af[3], bq[2];
                { const unsigned av = lbase + ML_VW + (32 * ks + 8 * g + q4) * ML_VP + (4 * p4) * 2, ak = lbase + ML_KS + (32 * ks + 8 * g + q4) * ML_KP + (32 * w + 4 * p4) * 2;
                  tr_read4x2(av, av + 32, 4 * ML_VP, ak, ak + 32, 4 * ML_KP, af[0], af[1], bq[0], bq[1]); }
                { const f32x4 wa = *(const LAS f32x4*)(s_w + 32 * ks + 8 * g), wb = *(const LAS f32x4*)(s_w + 32 * ks + 8 * g + 4);
                  u32x4 o; o.x = pk2(wa[0], wa[1]); o.y = pk2(wa[2], wa[3]); o.z = pk2(wb[0], wb[1]); o.w = pk2(wb[2], wb[3]);
                  if (r != 0) { o.x = 0u; o.y = 0u; o.z = 0u; o.w = 0u; }
                  af[2] = __builtin_bit_cast(bf16x8, o); }
#pragma unroll
                for (int nt = 0; nt < 2; ++nt)
#pragma unroll
                    for (int mt = 0; mt < 3; ++mt) Cacc[mt][nt] = __builtin_amdgcn_mfma_f32_16x16x32_bf16(af[mt], bq[nt], Cacc[mt][nt], 0, 0, 0);
            }
#pragma unroll
            for (int mt = 0; mt < 2; ++mt)
#pragma unroll
                for (int nt = 0; nt < 2; ++nt)
#pragma unroll
                    for (int i = 0; i < 4; ++i) *(LAS bf16_t*)(lds + ML_CS + (16 * mt + 4 * g + i) * ML_CP + (32 * w + 16 * nt + r) * 2) = (bf16_t)f2bf(Cacc[mt][nt][i]);
            if (g == 0) { *(LAS bf16_t*)(lds + ML_KS + 128 * ML_KP + (32 * w + r) * 2) = (bf16_t)f2bf(Cacc[2][0][0]); *(LAS bf16_t*)(lds + ML_KS + 128 * ML_KP + (32 * w + 16 + r) * 2) = (bf16_t)f2bf(Cacc[2][1][0]); }
        }
        ML_BAR();
    }
#undef ML_BAR
#undef ML_PREFETCH
#undef ML_TOK
}
constexpr int HY_ZK = 0, HY_WB = 69632;
static_assert(HY_WB + 69632 <= LDS_BYTES, "hyena LDS map");
#define GAS __attribute__((address_space(1)))
struct HyRaw { u32x4 c; unsigned l, r; };
__device__ __forceinline__ HyRaw hy_load(const bf16_t* rowp, int tid) { HyRaw x; const GAS bf16_t* p = (const GAS bf16_t*)rowp + 8 * tid; x.c = *(const GAS u32x4*)p; x.l = p[-1]; x.r = p[8]; return x; }
__device__ __forceinline__ void hy_conv8(const HyRaw& x, int tid, float w0, float w1, float w2, float bias, float (&o)[8]) {
    float a[10];
    a[0] = tid > 0 ? __uint_as_float(x.l << 16) : 0.f; a[9] = tid < 511 ? __uint_as_float(x.r << 16) : 0.f;
    a[1] = bflo(x.c.x); a[2] = bfhi(x.c.x); a[3] = bflo(x.c.y); a[4] = bfhi(x.c.y); a[5] = bflo(x.c.z); a[6] = bfhi(x.c.z); a[7] = bflo(x.c.w); a[8] = bfhi(x.c.w);
#pragma unroll
    for (int m = 0; m < 8; ++m) o[m] = w0 * a[m] + w1 * a[m + 1] + w2 * a[m + 2] + bias;
}
__device__ __forceinline__ void hyena_item(const Ctx& C, LAS unsigned char* lds, int ch, int wv) {
    int tid = (wv << 6) | lane_id_opaque(); asm volatile("" : "+v"(tid));
    LAS f32x2* zk = (LAS f32x2*)(lds + HY_ZK); LAS f32x2* wb = (LAS f32x2*)(lds + HY_WB);
    const float* FILT = (const float*)(C.ws + WS_FILT); const bf16_t* HYb = (const bf16_t*)(C.ws + WS_HY); bf16_t* YA = (bf16_t*)(C.ws + WS_YA);
    const float* cw = C.in[3]; const float* cb = C.in[4];
    float w0[3], w1[3], w2[3], bs[3];
#pragma unroll
    for (int s = 0; s < 3; ++s) { w0[s] = cw[s * 1024 + ch]; w1[s] = cw[CONVC + s * 1024 + ch]; w2[s] = cw[2 * CONVC + s * 1024 + ch]; bs[s] = cb[s * 1024 + ch]; }
    const float hb0 = C.in[12][ch], hb1 = C.in[12][1024 + ch];
    const float* F0 = FILT + (size_t)(0 * 1024 + ch) * SEQ; const float* F1 = FILT + (size_t)(1 * 1024 + ch) * SEQ;
    const float* F2 = FILT + (size_t)(2 * 1024 + ch) * SEQ; const float* F3 = FILT + (size_t)(3 * 1024 + ch) * SEQ;
    __syncthreads();
    {
        float fa[16], fb[16];
#pragma unroll
        for (int rep = 0; rep < 8; ++rep) { const int i = tid + 512 * rep; fa[rep] = F0[i]; fb[rep] = F2[i]; }
#pragma unroll
        for (int rep = 8; rep < 16; ++rep) { const int i = tid + 512 * rep; const int j = i == SEQ ? 1 : 2 * SEQ - i; fa[rep] = F1[j]; fb[rep] = F3[j]; }
        if (tid == 0) { fa[8] = 0.f; fb[8] = 0.f; }
#pragma unroll
        for (int rep = 0; rep < 16; ++rep) { const int i = tid + 512 * rep; zk[PADI(i)] = (f32x2){fa[rep] * (1.0f / 8192.0f), fb[rep] * (1.0f / 8192.0f)}; }
    }
    fft_fwd_full(zk, tid);
    const bf16_t* rv = HYb + (size_t)ch * TOK; const bf16_t* rx1 = HYb + (size_t)(1024 + ch) * TOK; const bf16_t* rx2 = HYb + (size_t)(2048 + ch) * TOK;
    HyRaw qa = hy_load(rv, tid), qb = hy_load(rv + SEQ, tid);
#pragma unroll 1
    for (int p = 0; p < 2; ++p) {
        const int tb0 = (2 * p) * SEQ, tb1 = (2 * p + 1) * SEQ;
        f32x2 vv[8], zz[8];
        { float va[8], vb[8]; hy_conv8(qa, tid, w0[0], w1[0], w2[0], bs[0], va); hy_conv8(qb, tid, w0[0], w1[0], w2[0], bs[0], vb);
#pragma unroll
          for (int m = 0; m < 8; ++m) { vv[m].x = va[m]; vv[m].y = vb[m]; wb[PADI(8 * tid + m)] = vv[m]; } }
        qa = hy_load(rx1 + tb0, tid); qb = hy_load(rx1 + tb1, tid);
        fft_conv<0>(wb, zk, tid);
        { float xa[8], xb_[8]; hy_conv8(qa, tid, w0[1], w1[1], w2[1], bs[1], xa); hy_conv8(qb, tid, w0[1], w1[1], w2[1], bs[1], xb_);
#pragma unroll
          for (int m = 0; m < 8; ++m) { const f32x2 y = wb[PADI(8 * tid + m)]; zz[m].x = xa[m] * (y.x + vv[m].x * hb0); zz[m].y = xb_[m] * (y.y + vv[m].y * hb0); }
#pragma unroll
          for (int m = 0; m < 8; ++m) wb[PADI(8 * tid + m)] = zz[m]; }
        qa = hy_load(rx2 + tb0, tid); qb = hy_load(rx2 + tb1, tid);
        fft_conv<1>(wb, zk, tid);
        { float xa[8], xb_[8]; hy_conv8(qa, tid, w0[2], w1[2], w2[2], bs[2], xa); hy_conv8(qb, tid, w0[2], w1[2], w2[2], bs[2], xb_);
          if (p == 0) { qa = hy_load(rv + 2 * SEQ, tid); qb = hy_load(rv + 3 * SEQ, tid); }
#pragma unroll
          for (int m = 0; m < 8; ++m) { const int t = 8 * tid + m; const f32x2 y = wb[PADI(t)];
              YA[blk_off(tb0 + t, ch, 1024)] = (bf16_t)f2bf(xa[m] * (y.x + zz[m].x * hb1));
              YA[blk_off(tb1 + t, ch, 1024)] = (bf16_t)f2bf(xb_[m] * (y.y + zz[m].y * hb1)); } }
        FFT_SYNC();
    }
}
#ifndef DUP_FILT
#define DUP_FILT 0
#endif
#ifndef DUP_PRE
#define DUP_PRE 0
#endif
#ifndef DUP_P0
#define DUP_P0 0
#endif
#ifndef DUP_ML
#define DUP_ML 0
#endif
#ifndef DUP_HY
#define DUP_HY 0
#endif
#ifndef DUP_REST
#define DUP_REST 0
#endif
#ifndef DUP_GU
#define DUP_GU 0
#endif
#define XB_TMO      128
#define XB_XCNT(j)  (256  + 64 * (j))
#define XB_XSUB(j)  (1280 + 64 * (j))
#define XB_XGEN(j)  (2304 + 64 * (j))
#define XB_TOP      3328
#define XB_TOPGEN   3392
#define XCD_BAR_WORDS 3456
#define XB_SPIN_CAP (1u << 22)
__device__ __forceinline__ unsigned xb_ld(unsigned* p)              { return __hip_atomic_load(p, __ATOMIC_RELAXED, __HIP_MEMORY_SCOPE_AGENT); }
__device__ __forceinline__ unsigned xb_add(unsigned* p, unsigned v) { return __hip_atomic_fetch_add(p, v, __ATOMIC_RELAXED, __HIP_MEMORY_SCOPE_AGENT); }
__device__ __forceinline__ unsigned xb_xcc_id() { return (unsigned)__builtin_amdgcn_s_getreg((3 << 11) | 20) & 0xFu; }
#define XB_SPIN(cond, bar) do { unsigned _sp = 0; while (cond) { __builtin_amdgcn_s_sleep(1); \
    if ((++_sp & 255u) == 0u) { if (xb_ld(&(bar)[XB_TMO])) break; if (_sp > XB_SPIN_CAP) { atomicAdd(&(bar)[XB_TMO], 1u); break; } } } } while (0)
__device__ __forceinline__ void xcd_barrier_complete(unsigned* bar, unsigned x, unsigned G, unsigned& nloc, unsigned& nx) {
    unsigned sum, cnt, mine, sp = 0u;
    for (;;) {
        sum = 0u; cnt = 0u; mine = 0u;
#pragma unroll
        for (unsigned j = 0; j < 16; ++j) { const unsigned c = xb_ld(&bar[XB_XCNT(j)]); sum += c; cnt += (c > 0u) ? 1u : 0u; mine = (j == x) ? c : mine; }
        if (sum == G) break;
        __builtin_amdgcn_s_sleep(1);
        if ((++sp & 255u) == 0u) { if (xb_ld(&bar[XB_TMO])) break; if (sp > XB_SPIN_CAP) { atomicAdd(&bar[XB_TMO], 1u); break; } }
    }
    nloc = mine > 0u ? mine : 1u; nx = cnt > 0u ? cnt : 1u;
}
__device__ __forceinline__ void grid_bar(unsigned* bar, volatile LAS unsigned* st, unsigned G, int wv) {
    asm volatile("s_waitcnt vmcnt(0)" ::: "memory");
    __syncthreads();
    const int lane = lane_id_opaque();
    if (wv == 0 && lane == 0) {
        __builtin_amdgcn_s_waitcnt(0);
        const unsigned x = xb_xcc_id();
        unsigned nloc = st[0], nx = st[1];
        if (nloc == 0u) { xcd_barrier_complete(bar, x, G, nloc, nx); st[0] = nloc; st[1] = nx; }
        const unsigned old = xb_add(&bar[XB_XSUB(x)], 1u);
        const unsigned gen = old / nloc;
        if (old + 1u == (gen + 1u) * nloc) {
            __builtin_amdgcn_fence(__ATOMIC_RELEASE, "agent");
            asm volatile("s_waitcnt vmcnt(0)" ::: "memory");
            const unsigned og = xb_add(&bar[XB_TOP], 1u);
            const unsigned tg = og / nx;
            if (og + 1u == (tg + 1u) * nx) xb_add(&bar[XB_TOPGEN], 1u);
            else XB_SPIN(xb_ld(&bar[XB_TOPGEN]) == tg, bar);
            __builtin_amdgcn_fence(__ATOMIC_ACQUIRE, "agent");
            xb_add(&bar[XB_XGEN(x)], 1u);
            asm volatile("s_waitcnt vmcnt(0)" ::: "memory");
        } else {
            XB_SPIN(xb_ld(&bar[XB_XGEN(x)]) == gen, bar);
            __builtin_amdgcn_fence(__ATOMIC_ACQUIRE, "agent");
            asm volatile("s_waitcnt vmcnt(0)" ::: "memory");
        }
    }
    __syncthreads();
}
__device__ __forceinline__ void p6_finalize(const Ctx& C, int G, int bx, int wv) {
    int tid = (wv << 6) | lane_id_opaque(); asm volatile("" : "+v"(tid));
    unsigned* pcnt = (unsigned*)(C.ws + WS_PCNT); const float* ss3 = (const float*)(C.ws + WS_SS3); const float* wf = C.in[20]; float* out = C.out;
    for (int i = 0; ; ++i) {
        const int L = i * G + bx; if (L + G >= 64 * 8) break; int pm, pn; pg8::tile_of(L, 64, 8, pm, pn);
        if (tid == 0) { unsigned sp = 0; while (xb_ld(&pcnt[64 * pm]) < 8u) { __builtin_amdgcn_s_sleep(1); if (++sp > (1u << 20)) break; }
            __builtin_amdgcn_fence(__ATOMIC_ACQUIRE, "agent"); asm volatile("s_waitcnt vmcnt(0)" ::: "memory"); }
        __syncthreads();
        const int c4 = tid & 63; const f32x4 wv4 = *(const f32x4*)(wf + 256 * pn + 4 * c4);
#pragma unroll 1
        for (int k0 = 0; k0 < 32; k0 += 8) {
            f32x4 v[8]; float rr[8];
#pragma unroll
            for (int k = 0; k < 8; ++k) { const int row = 256 * pm + (tid >> 6) + 8 * (k0 + k);
                v[k] = *(const f32x4*)(out + (size_t)row * DM + 256 * pn + 4 * c4);
                rr[k] = __hip_atomic_load(ss3 + row, __ATOMIC_RELAXED, __HIP_MEMORY_SCOPE_AGENT); }
#pragma unroll
            for (int k = 0; k < 8; ++k) { const int row = 256 * pm + (tid >> 6) + 8 * (k0 + k); const float r = 1.0f / sqrtf(rr[k] * (1.0f / DM) + RMS_EPS);
                *(f32x4*)(out + (size_t)row * DM + 256 * pn + 4 * c4) = v[k] * r * wv4; }
        }
    }
}
struct Params { const float* in[21]; float* out; unsigned char* ws; };
__global__ void __launch_bounds__(512, 2) fwd_megakernel(Params prm) {
    extern __shared__ __attribute__((aligned(16))) unsigned char lds_raw[];
    LAS unsigned char* lds = (LAS unsigned char*)lds_raw;
    cg::grid_group grid = cg::this_grid();
    const int G = gridDim.x, bx = blockIdx.x;
    const int wv = __builtin_amdgcn_readfirstlane((int)(threadIdx.x >> 6));
    Ctx C;
#pragma unroll
    for (int i = 0; i < 21; ++i) C.in[i] = prm.in[i];
    C.out = prm.out; C.ws = prm.ws;
    unsigned char* ws = prm.ws;
    unsigned* gbar = (unsigned*)(ws + WS_BAR);
    volatile LAS unsigned* bst = (volatile LAS unsigned*)(lds + LDS_BYTES - 16);
#ifndef DUP_BAR
#define DUP_BAR 0
#endif
#define GBAR() do { for (int rb_ = 0; rb_ < 1 + DUP_BAR; ++rb_) grid_bar(gbar, bst, (unsigned)G, wv); } while (0)
    if (bx == 0) for (int i = threadIdx.x; i < XCD_BAR_WORDS; i += 512) gbar[i] = 0u;
    if (bx == 1 || G == 1) for (int i = threadIdx.x; i < 64 * 64; i += 512) ((unsigned*)(ws + WS_PCNT))[i] = 0u;
    if (threadIdx.x < 4) ((LAS unsigned*)(lds + LDS_BYTES - 16))[threadIdx.x] = 0u;
    grid.sync();
    if (threadIdx.x == 0) (void)xb_add(&gbar[XB_XCNT(xb_xcc_id())], 1u);
    for (int rep = 0; rep < 1 + DUP_P0; ++rep) { p0_prologue(C, lds, G, wv); __syncthreads(); }
    GBAR();
    for (int rep = 0; rep < 1 + DUP_FILT; ++rep) p1_filters(C, lds, G, wv);
    { HyProg P; P.K = DM; P.G = G; P.c = bx; P.W = (const bf16_t*)(ws + WS_WIN); P.X = (const bf16_t*)(ws + WS_XB); P.HY = (bf16_t*)(ws + WS_HY); P.r1 = (const float*)(ws + WS_R1S);
      pg8::gemm_stream(lds, P, wv); }
    for (int rep = 0; rep < 1 + DUP_REST; ++rep) { RestProg P; P.K = DM; P.G = G; P.c = bx; P.W = (const bf16_t*)(ws + WS_WIN); P.X = (const bf16_t*)(ws + WS_XB); P.R1A = (bf16_t*)(ws + WS_R1A); P.R1B = (bf16_t*)(ws + WS_R1B); P.R2 = (bf16_t*)prm.out; P.r1 = (const float*)(ws + WS_R1S);
      pg8::gemm_stream(lds, P, wv); }
    GBAR();
    for (int rep = 0; rep < 1 + DUP_PRE; ++rep) qk_prepass(C, G, wv);
    for (int rep = 0; rep < 1 + DUP_HY; ++rep) for (int idx = bx; idx < 1024; idx += G) { const int rd = idx >> 8, bb = idx & 255; hyena_item(C, lds, rd * 256 + (bb & 7) * 32 + (bb >> 3), wv); }
    GBAR();
    for (int rep = 0; rep < 1 + DUP_ML; ++rep) for (int item = bx; item < 256; item += G) mlstm_item(C, lds, item, wv);
    GBAR();
    { BranchProg P; P.K = 1024; P.G = G; P.c = bx; P.YA = (const bf16_t*)(ws + WS_YA); P.YBF = (const bf16_t*)(ws + WS_YBF); P.YBB = (const bf16_t*)(ws + WS_YBB);
      P.WA = (const bf16_t*)(ws + WS_WA); P.WB = (const bf16_t*)(ws + WS_WB); P.R2 = (const bf16_t*)prm.out; P.MIX = (bf16_t*)(ws + WS_MIX);
      pg8::gemm_stream(lds, P, wv); }
    GBAR();
    { ResProg<false> P; P.pcnt = nullptr; P.wf = nullptr; P.K = DM; P.G = G; P.c = bx; P.A = (const bf16_t*)(ws + WS_MIX); P.B = (const bf16_t*)(ws + WS_WOUT); P.base = prm.in[0]; P.base16 = nullptr; P.out = nullptr; P.outb = (bf16_t*)(ws + WS_X1B); P.ss = (float*)(ws + WS_SS2);
      pg8::gemm_stream(lds, P, wv); }
    GBAR();
    for (int rep = 0; rep < 1 + DUP_GU; ++rep) { GuProg P; P.K = DM; P.G = G; P.c = bx; P.X = (const bf16_t*)(ws + WS_X1B); P.W = (const bf16_t*)(ws + WS_WGU); P.HH = (bf16_t*)(ws + WS_HH); P.ss2 = (const float*)(ws + WS_SS2);
      pg8::gemm_stream(lds, P, wv); }
    GBAR();
    { ResProg<true> P; P.pcnt = (unsigned*)(ws + WS_PCNT); P.wf = prm.in[20]; P.K = FFH; P.G = G; P.c = bx; P.A = (const bf16_t*)(ws + WS_HH); P.B = (const bf16_t*)(ws + WS_WD); P.base = nullptr; P.base16 = (const bf16_t*)(ws + WS_X1B); P.out = prm.out; P.outb = nullptr; P.ss = (float*)(ws + WS_SS3);
      pg8::gemm_stream(lds, P, wv); }
    p6_finalize(C, G, bx, wv);
}

extern "C" void kernel_launch(void* const* d_in, const int* in_sizes, int n_in, void* d_out, int out_size, void* d_ws, size_t ws_size, hipStream_t stream) {
    static int grid = 0;
    if (grid == 0) {
        int dev = 0, cus = 0, per_cu = 0;
        hipGetDevice(&dev); hipDeviceGetAttribute(&cus, hipDeviceAttributeMultiprocessorCount, dev);
        if (hipFuncSetAttribute((const void*)fwd_megakernel, hipFuncAttributeMaxDynamicSharedMemorySize, LDS_BYTES) != hipSuccess) { fprintf(stderr, "kernel_launch: hipFuncSetAttribute failed\n"); grid = -1; return; }
        if (hipOccupancyMaxActiveBlocksPerMultiprocessor(&per_cu, (const void*)fwd_megakernel, 512, LDS_BYTES) != hipSuccess || per_cu < 1) { fprintf(stderr, "kernel_launch: occupancy query gave %d\n", per_cu); per_cu = 1; }
        (void)hipGetLastError();
        grid = cus * 1;
        if (n_in != 21 || ws_size < WS_END) { fprintf(stderr, "kernel_launch: unexpected n_in %d or ws %zu\n", n_in, ws_size); grid = -1; return; }
    }
    if (grid < 0) return;
    Params p{};
    for (int i = 0; i < 21; ++i) p.in[i] = (const float*)d_in[i];
    p.out = (float*)d_out; p.ws = (unsigned char*)d_ws;
    void* args[] = {&p};
    hipError_t e = hipLaunchCooperativeKernel((const void*)fwd_megakernel, dim3(grid), dim3(512), args, LDS_BYTES, stream);
    if (e != hipSuccess) fprintf(stderr, "cooperative launch failed: %s (grid %d)\n", hipGetErrorString(e), grid);
}
```

```cpp
#include <hip/hip_runtime.h>
#include <hip/hip_cooperative_groups.h>
#include <cstdio>
namespace cg = cooperative_groups;

#define LAS __attribute__((address_space(3)))
typedef unsigned short bf16_t;
typedef short bf16x8 __attribute__((ext_vector_type(8)));
typedef short bf16x4 __attribute__((ext_vector_type(4)));
typedef float f32x4 __attribute__((ext_vector_type(4)));
typedef float f32x2 __attribute__((ext_vector_type(2)));
typedef unsigned u32x4 __attribute__((ext_vector_type(4)));
typedef unsigned u32x2 __attribute__((ext_vector_type(2)));

constexpr int NB = 4, SEQ = 4096, TOK = NB * SEQ, DM = 2048, HW = 1024, MW = 1024, NHEAD = 4, DH = 256, FFH = 5632;
constexpr int CONVC = 5120, INCOLS = 11280, NFILT = 4096;
constexpr float RMS_EPS = 1e-6f;
constexpr size_t MiB = 1u << 20;
constexpr size_t WS_PCNT = 393216, WS_BAR = 262144, WS_R1S = 0, WS_SS2 = 65536, WS_SS3 = 131072, WS_G = 1 * MiB, WS_H2 = 2 * MiB;
constexpr size_t WS_WA = 4 * MiB, WS_WB = 8 * MiB, WS_WOUT = 12 * MiB, WS_WGU = 20 * MiB, WS_WD = 64 * MiB, WS_WIN = 86 * MiB, WS_XB = 130 * MiB;
constexpr size_t WS_FILT = 194 * MiB, WS_HY = 258 * MiB, WS_R1A = 354 * MiB, WS_R1B = 418 * MiB, WS_END = 494 * MiB;
constexpr size_t WS_QKP = 86 * MiB, WS_YA = 150 * MiB, WS_YBF = 354 * MiB, WS_YBB = 386 * MiB, WS_X1B = 86 * MiB, WS_MIX = 194 * MiB, WS_HH = 258 * MiB;
constexpr size_t WS_GSC = 482 * MiB;
constexpr int LDS_BYTES = 155648;

__device__ __forceinline__ unsigned f2bf(float f) { unsigned u = __float_as_uint(f); return (u + 0x7fffu + ((u >> 16) & 1u)) >> 16; }
__device__ __forceinline__ unsigned pk2(float lo, float hi) { unsigned r; asm volatile("v_cvt_pk_bf16_f32 %0, %1, %2" : "=v"(r) : "v"(lo), "v"(hi)); return r; }
__device__ __forceinline__ float bflo(unsigned w) { return __uint_as_float(w << 16); }
__device__ __forceinline__ float bfhi(unsigned w) { return __uint_as_float(w & 0xffff0000u); }
__device__ __forceinline__ float wave_sum(float v) {
#pragma unroll
    for (int o = 1; o < 64; o <<= 1) v += __shfl_xor(v, o);
    return v;
}
__device__ __forceinline__ size_t blk_off(int row, int k, int K) { return ((size_t)(row >> 7) * (size_t)(K >> 6) + (size_t)(k >> 6)) * 8192 + (size_t)((row & 127) * 64 + (k & 63)); }
__device__ __forceinline__ int lane_id_opaque() { int l; asm volatile("v_mbcnt_lo_u32_b32 %0, -1, 0\n\tv_mbcnt_hi_u32_b32 %0, -1, %0" : "=v"(l)); return l; }
__device__ __forceinline__ float sigmoidf_(float x) { return __builtin_amdgcn_rcpf(1.0f + __expf(-x)); }
__device__ __forceinline__ float siluf_(float x) { return x * __builtin_amdgcn_rcpf(1.0f + __expf(-x)); }

namespace pg8 {
constexpr int BM = 256, BK = 64, HALF = 128, HTB = HALF * BK * 2, STAGE_BYTES = 8 * HTB, NXCD = 8, WGM = 8;
__device__ __forceinline__ int lds_byte(int r, int c) { const int st = (r >> 4) * 2 + (c >> 5), rr = r & 15, cc = c & 31, ob = rr * 64 + cc * 2; return st * 1024 + (ob ^ (((ob >> 9) & 1) << 5)); }
__device__ __forceinline__ void stage_rc(int b, int& R, int& C) { const int st = b / 1024, sb = b % 1024, swz = sb ^ (((sb >> 9) & 1) << 5); R = (st >> 1) * 16 + swz / 64; C = (st & 1) * 32 + (swz % 64) / 2; }
__device__ __forceinline__ int perm32(int rho) { const int n = rho >> 4, i = rho & 15; return 8 * (i >> 2) + 4 * n + (i & 3); }
struct GUnit { const char* A; const char* B; int pm, pn, sub; };
__device__ __forceinline__ void tile_of(int L, int nM, int nN, int& pm, int& pn) {
    const int nwg = nM * nN; int wgid = L; { const int q = nwg / NXCD, r = nwg % NXCD, xcd = wgid % NXCD, off = wgid / NXCD; wgid = (xcd < r ? xcd * (q + 1) : r * (q + 1) + (xcd - r) * q) + off; }
    const int nig = WGM * nN, gid = wgid / nig, fm = gid * WGM, gsz = (nM - fm) < WGM ? (nM - fm) : WGM;
    pm = fm + ((wgid % nig) % gsz); pn = (wgid % nig) / gsz;
}
typedef f32x4 Acc[2][2][4][2];
template <class Prog>
__device__ __forceinline__ void gemm_stream(LAS unsigned char* lds, const Prog& P, int wv) {
    int tid = (wv << 6) | lane_id_opaque(); asm volatile("" : "+v"(tid));
    const int wid = __builtin_amdgcn_readfirstlane(tid >> 6), lane = tid & 63, wr = wid >> 2, wc = wid & 3, fr = lane & 15, fq = lane >> 4;
    const int K = P.K, nt = K / BK;
    unsigned voffA[2], voffB[2];
#pragma unroll
    for (int i = 0; i < 2; ++i) { int R, C; stage_rc(tid * 16 + i * 8192, R, C); const int Rb = Prog::PERM ? ((R & ~31) + perm32(R & 31)) : R;
        voffA[i] = (unsigned)(R * 64 + C) * 2u; voffB[i] = (unsigned)(Rb * 64 + C) * 2u; }
    const size_t kstep = (size_t)(HALF * BK * 2);
    const size_t hstep = (size_t)HALF * K * 2;
    const unsigned ldsw = (unsigned)wid * 1024u;
    const int aoff = lds_byte(wr * 64 + fr, fq * 8), boff = lds_byte(wc * 32 + fr, fq * 8);
#define PG8_SA(b, h) (((b) * 2 + (h)) * HTB)
#define PG8_SB(b, h) ((4 + (b) * 2 + (h)) * HTB)
#define PG8_STAGE(bufoff, gbase, voff) do { _Pragma("unroll") for (int _i = 0; _i < 2; ++_i) \
        __builtin_amdgcn_global_load_lds((const unsigned*)((const char*)(gbase) + (voff)[_i]), (LAS unsigned*)(lds + (bufoff) + ldsw + _i * 8192), 16, 0, 0); } while (0)
#define PG8_LDA(dst, b, h) do { _Pragma("unroll") for (int m = 0; m < 4; ++m) _Pragma("unroll") for (int k = 0; k < 2; ++k) dst[m][k] = *(const LAS bf16x8*)(lds + PG8_SA(b, h) + aoff + m * 2048 + k * 1024); } while (0)
#define PG8_LDB(dst, b, h) do { _Pragma("unroll") for (int n = 0; n < 2; ++n) _Pragma("unroll") for (int k = 0; k < 2; ++k) dst[n][k] = *(const LAS bf16x8*)(lds + PG8_SB(b, h) + boff + n * 2048 + k * 1024); } while (0)
#define PG8_MMA(ai, bj, At, Bt) do { __builtin_amdgcn_s_setprio(1); _Pragma("unroll") for (int m = 0; m < 4; ++m) _Pragma("unroll") for (int n = 0; n < 2; ++n) _Pragma("unroll") for (int k = 0; k < 2; ++k) \
        acc[ai][bj][m][n] = __builtin_amdgcn_mfma_f32_16x16x32_bf16(Bt[n][k], At[m][k], acc[ai][bj][m][n], 0, 0, 0); __builtin_amdgcn_s_setprio(0); } while (0)
#define PG8_WAIT_V(n) asm volatile("s_waitcnt vmcnt(" #n ")" ::: "memory")
#define PG8_WAIT_L(n) asm volatile("s_waitcnt lgkmcnt(" #n ")" ::: "memory")
#define PG8_BAR __builtin_amdgcn_s_barrier()
#define PG8_SCHED __builtin_amdgcn_sched_barrier(0)
    GUnit cur, nxt; int ui = 0;
    if (!P.next(0, cur)) return;
    f32x4 acc[2][2][4][2];
#pragma unroll
    for (int a = 0; a < 2; ++a)
#pragma unroll
        for (int b = 0; b < 2; ++b)
#pragma unroll
            for (int m = 0; m < 4; ++m)
#pragma unroll
                for (int n = 0; n < 2; ++n) acc[a][b][m][n] = (f32x4){0.f, 0.f, 0.f, 0.f};
    bf16x8 At[4][2], B0[2][2], B1[2][2];
    const char* cA = cur.A; const char* cB = cur.B;
    PG8_STAGE(PG8_SB(0, 0), cB, voffB); PG8_STAGE(PG8_SA(0, 0), cA, voffA); PG8_STAGE(PG8_SB(0, 1), cB + hstep, voffB); PG8_STAGE(PG8_SA(0, 1), cA + hstep, voffA);
    if (wr == 1) PG8_BAR;
    PG8_WAIT_V(4); PG8_BAR;
    PG8_STAGE(PG8_SB(1, 0), cB + kstep, voffB); PG8_STAGE(PG8_SA(1, 0), cA + kstep, voffA); PG8_STAGE(PG8_SB(1, 1), cB + hstep + kstep, voffB);
    PG8_WAIT_V(6); PG8_BAR;
    for (;;) {
        const bool has_next = P.next(ui + 1, nxt);
        const char* nA = has_next ? nxt.A : cA; const char* nB = has_next ? nxt.B : cB;
        for (int t = 0; t < nt; t += 2) {
            const bool last = (t == nt - 2);
            const char* a1 = cA + (size_t)(t + 1) * kstep;
            const char* a2 = last ? nA : cA + (size_t)(t + 2) * kstep; const char* b2 = last ? nB : cB + (size_t)(t + 2) * kstep;
            const char* a3 = a2 + kstep; const char* b3 = b2 + kstep;
            PG8_LDB(B0, 0, 0); PG8_SCHED; PG8_LDA(At, 0, 0); PG8_STAGE(PG8_SA(1, 1), a1 + hstep, voffA);
            PG8_WAIT_L(8); PG8_BAR; PG8_WAIT_L(0); PG8_MMA(0, 0, At, B0); PG8_BAR; PG8_SCHED;
            PG8_LDB(B1, 0, 1); PG8_STAGE(PG8_SB(0, 0), b2, voffB);
            PG8_BAR; PG8_WAIT_L(0); PG8_MMA(0, 1, At, B1); PG8_BAR;
            PG8_LDA(At, 0, 1); PG8_STAGE(PG8_SA(0, 0), a2, voffA);
            PG8_BAR; PG8_WAIT_L(0); PG8_MMA(1, 0, At, B0); PG8_BAR; PG8_SCHED;
            PG8_STAGE(PG8_SB(0, 1), b2 + hstep, voffB);
            PG8_WAIT_V(6); PG8_BAR; PG8_MMA(1, 1, At, B1); PG8_BAR;
            PG8_LDB(B0, 1, 0); PG8_SCHED; PG8_LDA(At, 1, 0); PG8_STAGE(PG8_SA(0, 1), a2 + hstep, voffA);
            PG8_WAIT_L(8); PG8_BAR; PG8_WAIT_L(0); PG8_MMA(0, 0, At, B0); PG8_BAR; PG8_SCHED;
            PG8_LDB(B1, 1, 1); PG8_STAGE(PG8_SB(1, 0), b3, voffB);
            PG8_BAR; PG8_WAIT_L(0); PG8_MMA(0, 1, At, B1); PG8_BAR;
            PG8_LDA(At, 1, 1); PG8_STAGE(PG8_SA(1, 0), a3, voffA);
            PG8_BAR; PG8_WAIT_L(0); PG8_MMA(1, 0, At, B0); PG8_BAR; PG8_SCHED;
            PG8_STAGE(PG8_SB(1, 1), b3 + hstep, voffB);
            PG8_WAIT_V(6); PG8_BAR; PG8_MMA(1, 1, At, B1); PG8_BAR;
        }
        if (Prog::FUSE_LAST && !has_next) break;
        P.epi(acc, cur, wr, wc, fr, fq);
        if (!has_next) break;
        cur = nxt; cA = nA; cB = nB; ++ui;
    }
    PG8_WAIT_V(0);
    if (wr == 0) PG8_BAR;
    PG8_BAR;
    if constexpr (Prog::FUSE_LAST) P.epi_last(acc, cur, wr, wc, fr, fq, wv);
#undef PG8_SA
#undef PG8_SB
#undef PG8_STAGE
#undef PG8_LDA
#undef PG8_LDB
#undef PG8_MMA
#undef PG8_WAIT_V
#undef PG8_WAIT_L
#undef PG8_BAR
#undef PG8_SCHED
}
__device__ __forceinline__ void zero_acc(Acc& acc) {
#pragma unroll
    for (int a = 0; a < 2; ++a)
#pragma unroll
        for (int b = 0; b < 2; ++b)
#pragma unroll
            for (int m = 0; m < 4; ++m)
#pragma unroll
                for (int n = 0; n < 2; ++n) acc[a][b][m][n] = (f32x4){0.f, 0.f, 0.f, 0.f};
}
}
using pg8::GUnit; using pg8::Acc;
__device__ __forceinline__ void unpack8(u32x4 w, float (&f)[8]) { f[0] = bflo(w.x); f[1] = bfhi(w.x); f[2] = bflo(w.y); f[3] = bfhi(w.y); f[4] = bflo(w.z); f[5] = bfhi(w.z); f[6] = bflo(w.w); f[7] = bfhi(w.w); }
struct HyProg {
    static constexpr bool FUSE_LAST = false; static constexpr bool PERM = true; int K, G, c; const bf16_t* W; const bf16_t* X; bf16_t* HY; const float* r1;
    __device__ __forceinline__ bool next(int i, GUnit& u) const { const int L = i * G + c; if (L >= 12 * 64) return false; pg8::tile_of(L, 12, 64, u.pm, u.pn);
        u.A = (const char*)(W + (size_t)u.pm * 256 * DM); u.B = (const char*)(X + (size_t)u.pn * 256 * DM); u.sub = 0; return true; }
    __device__ __forceinline__ void epi(Acc& acc, const GUnit& u, int wr, int wc, int fr, int fq) const {
        const int row0 = u.pm * 256 + wr * 64 + fr, col0 = u.pn * 256 + wc * 32 + 8 * fq;
        f32x4 sc[2][2];
#pragma unroll
        for (int bj = 0; bj < 2; ++bj) { sc[bj][0] = *(const f32x4*)(r1 + col0 + bj * 128); sc[bj][1] = *(const f32x4*)(r1 + col0 + bj * 128 + 4); }
#pragma unroll
        for (int ai = 0; ai < 2; ++ai)
#pragma unroll
            for (int m = 0; m < 4; ++m) { bf16_t* rowp = HY + (size_t)(row0 + ai * 128 + m * 16) * TOK + col0;
#pragma unroll
                for (int bj = 0; bj < 2; ++bj) { const f32x4 v0 = acc[ai][bj][m][0] * sc[bj][0], v1 = acc[ai][bj][m][1] * sc[bj][1];
                    u32x4 w; w.x = pk2(v0[0], v0[1]); w.y = pk2(v0[2], v0[3]); w.z = pk2(v1[0], v1[1]); w.w = pk2(v1[2], v1[3]);
                    *(u32x4*)(rowp + bj * 128) = w; } }
        pg8::zero_acc(acc);
    }
};
struct RestProg {
    static constexpr bool FUSE_LAST = false; static constexpr bool PERM = true; int K, G, c; const bf16_t* W; const bf16_t* X; bf16_t* R1A; bf16_t* R1B; bf16_t* R2; const float* r1;
    __device__ __forceinline__ bool next(int i, GUnit& u) const { const int L = i * G + c; if (L >= 64 * 32) return false; pg8::tile_of(L, 64, 32, u.pm, u.pn);
        u.A = (const char*)(X + (size_t)u.pm * 256 * DM); u.B = (const char*)(W + (size_t)(3072 + u.pn * 256) * DM); u.sub = 0; return true; }
    __device__ __forceinline__ void epi(Acc& acc, const GUnit& u, int wr, int wc, int fr, int fq) const {
        const int row0 = u.pm * 256 + wr * 64 + fr; const bool sg = u.pn >= 12;
        bf16_t* base = u.pn < 8 ? R1A + u.pn * 256 : (u.pn < 16 ? R1B + (u.pn - 8) * 256 : R2 + (u.pn - 16) * 256);
        const int pitch = u.pn < 16 ? 2048 : 4096;
        const int col0 = wc * 32 + 8 * fq;
        float rs[2][4];
#pragma unroll
        for (int ai = 0; ai < 2; ++ai)
#pragma unroll
            for (int m = 0; m < 4; ++m) rs[ai][m] = r1[row0 + ai * 128 + m * 16];
#pragma unroll
        for (int ai = 0; ai < 2; ++ai)
#pragma unroll
            for (int m = 0; m < 4; ++m) { const int row = row0 + ai * 128 + m * 16; const float s = rs[ai][m]; bf16_t* rowp = base + (size_t)row * pitch + col0;
#pragma unroll
                for (int bj = 0; bj < 2; ++bj) { f32x4 v0 = acc[ai][bj][m][0] * s, v1 = acc[ai][bj][m][1] * s;
                    if (sg) {
#pragma unroll
                        for (int j = 0; j < 4; ++j) { v0[j] = sigmoidf_(v0[j]); v1[j] = sigmoidf_(v1[j]); } }
                    u32x4 w; w.x = pk2(v0[0], v0[1]); w.y = pk2(v0[2], v0[3]); w.z = pk2(v1[0], v1[1]); w.w = pk2(v1[2], v1[3]);
                    *(u32x4*)(rowp + bj * 128) = w; } }
        pg8::zero_acc(acc);
    }
};
struct BranchProg {
    static constexpr bool FUSE_LAST = false; static constexpr bool PERM = true; int K, G, c; const bf16_t *YA, *YBF, *YBB, *WA, *WB; const bf16_t* R2; bf16_t* MIX;
    __device__ __forceinline__ bool next(int i, GUnit& u) const { const int ti = i / 3, sub = i - 3 * ti; const int L = ti * G + c; if (L >= 64 * 8) return false; pg8::tile_of(L, 64, 8, u.pm, u.pn);
        const bf16_t* a = sub == 0 ? YA : (sub == 1 ? YBF : YBB); const bf16_t* b = sub == 0 ? WA : WB;
        u.A = (const char*)(a + (size_t)u.pm * 256 * 1024); u.B = (const char*)(b + (size_t)u.pn * 256 * 1024); u.sub = sub; return true; }
    __device__ __forceinline__ void epi(Acc& acc, const GUnit& u, int wr, int wc, int fr, int fq) const {
        if (u.sub == 1) return;
        const int row0 = u.pm * 256 + wr * 64 + fr, col0 = u.pn * 256 + wc * 32 + 8 * fq;
#pragma unroll
        for (int ai = 0; ai < 2; ++ai) {
            u32x4 gbw[4][2], gaw[4][2];
#pragma unroll
            for (int m = 0; m < 4; ++m)
#pragma unroll
                for (int bj = 0; bj < 2; ++bj) { const bf16_t* gp = R2 + (size_t)(row0 + ai * 128 + m * 16) * 4096 + col0 + bj * 128;
                    gbw[m][bj] = *(const u32x4*)(gp + 2048); if (u.sub == 0) gaw[m][bj] = *(const u32x4*)gp; else gaw[m][bj] = gbw[m][bj]; }
#pragma unroll
            for (int m = 0; m < 4; ++m) { const int row = row0 + ai * 128 + m * 16;
#pragma unroll
                for (int bj = 0; bj < 2; ++bj) {
                    float gb[8], ga[8]; unpack8(gbw[m][bj], gb); unpack8(gaw[m][bj], ga);
                    if (u.sub == 0) {
#pragma unroll
                        for (int j = 0; j < 4; ++j) { acc[ai][bj][m][0][j] *= ga[j] * __builtin_amdgcn_rcpf(fmaxf(gb[j], 1e-30f)); acc[ai][bj][m][1][j] *= ga[4 + j] * __builtin_amdgcn_rcpf(fmaxf(gb[4 + j], 1e-30f)); }
                    } else {
                        f32x4 v0 = acc[ai][bj][m][0], v1 = acc[ai][bj][m][1];
#pragma unroll
                        for (int j = 0; j < 4; ++j) { v0[j] *= fmaxf(gb[j], 1e-30f); v1[j] *= fmaxf(gb[4 + j], 1e-30f); }
                        u32x4 w; w.x = pk2(v0[0], v0[1]); w.y = pk2(v0[2], v0[3]); w.z = pk2(v1[0], v1[1]); w.w = pk2(v1[2], v1[3]);
                        *(u32x4*)(MIX + blk_off(row, col0 + bj * 128, DM)) = w;
                    } } }
        }
        if (u.sub == 2) pg8::zero_acc(acc);
    }
};
template <bool FUSE> struct ResProg {
    static constexpr bool PERM = false, FUSE_LAST = FUSE; int K, G, c; unsigned* pcnt; const float* wf; const bf16_t* A; const bf16_t* B; const float* base; const bf16_t* base16; float* out; bf16_t* outb; float* ss;
    __device__ __forceinline__ bool next(int i, GUnit& u) const { const int L = i * G + c; if (L >= 64 * 8) return false; pg8::tile_of(L, 64, 8, u.pm, u.pn);
        u.A = (const char*)(A + (size_t)u.pm * 256 * K); u.B = (const char*)(B + (size_t)u.pn * 256 * K); u.sub = 0; return true; }
    __device__ __forceinline__ void epi(Acc& acc, const GUnit& u, int wr, int wc, int fr, int fq) const {
        const int row0 = u.pm * 256 + wr * 64 + fr, col0 = u.pn * 256 + wc * 32 + 4 * fq;
#pragma unroll
        for (int ai = 0; ai < 2; ++ai) {
            f32x4 bs[4][2][2];
#pragma unroll
            for (int m = 0; m < 4; ++m)
#pragma unroll
                for (int bj = 0; bj < 2; ++bj)
#pragma unroll
                    for (int n = 0; n < 2; ++n) { const int row = row0 + ai * 128 + m * 16, col = col0 + bj * 128 + n * 16;
                        if (base16) { const u32x2 w = *(const u32x2*)(base16 + blk_off(row, col, DM)); bs[m][bj][n] = (f32x4){bflo(w.x), bfhi(w.x), bflo(w.y), bfhi(w.y)}; }
                        else bs[m][bj][n] = *(const f32x4*)(base + (size_t)row * DM + col); }
#pragma unroll
            for (int m = 0; m < 4; ++m) { const int row = row0 + ai * 128 + m * 16; const size_t off = (size_t)row * DM + col0; float s = 0.f;
#pragma unroll
                for (int bj = 0; bj < 2; ++bj)
#pragma unroll
                    for (int n = 0; n < 2; ++n) { const f32x4 o = bs[m][bj][n] + acc[ai][bj][m][n];
                        if (out) *(f32x4*)(out + off + bj * 128 + n * 16) = o;
                        s += (o[0] * o[0] + o[1] * o[1]) + (o[2] * o[2] + o[3] * o[3]);
                        if (outb) { u32x2 w; w.x = pk2(o[0], o[1]); w.y = pk2(o[2], o[3]); *(u32x2*)(outb + blk_off(row, col0 + bj * 128 + n * 16, DM)) = w; } }
                s += __shfl_xor(s, 16); s += __shfl_xor(s, 32);
                if (fq == 0) unsafeAtomicAdd(ss + row, s); }
        }
        pg8::zero_acc(acc);
    }
    __device__ __forceinline__ void epi_last(Acc& acc, const GUnit& u, int wr, int wc, int fr, int fq, int wv) const {
        const int row0 = u.pm * 256 + wr * 64 + fr, col0 = u.pn * 256 + wc * 32 + 4 * fq;
#pragma unroll
        for (int ai = 0; ai < 2; ++ai) {
            u32x2 bw[4][2][2];
#pragma unroll
            for (int m = 0; m < 4; ++m)
#pragma unroll
                for (int bj = 0; bj < 2; ++bj)
#pragma unroll
                    for (int n = 0; n < 2; ++n) bw[m][bj][n] = *(const u32x2*)(base16 + blk_off(row0 + ai * 128 + m * 16, col0 + bj * 128 + n * 16, DM));
#pragma unroll
            for (int m = 0; m < 4; ++m) { const int row = row0 + ai * 128 + m * 16; float s = 0.f;
#pragma unroll
                for (int bj = 0; bj < 2; ++bj)
#pragma unroll
                    for (int n = 0; n < 2; ++n) { const u32x2 w = bw[m][bj][n]; const f32x4 o = (f32x4){bflo(w.x), bfhi(w.x), bflo(w.y), bfhi(w.y)} + acc[ai][bj][m][n];
                        acc[ai][bj][m][n] = o; s += (o[0] * o[0] + o[1] * o[1]) + (o[2] * o[2] + o[3] * o[3]); }
                s += __shfl_xor(s, 16); s += __shfl_xor(s, 32);
                if (fq == 0) unsafeAtomicAdd(ss + row, s); }
        }
        asm volatile("s_waitcnt vmcnt(0)" ::: "memory");
        __syncthreads();
        const int lane = lane_id_opaque();
        if (wv == 0 && lane == 0) {
            __builtin_amdgcn_fence(__ATOMIC_RELEASE, "agent"); asm volatile("s_waitcnt vmcnt(0)" ::: "memory");
            for (int i = 0; ; ++i) { const int L = i * G + c; if (L >= 64 * 8) break; int pm, pn; pg8::tile_of(L, 64, 8, pm, pn); __hip_atomic_fetch_add(&pcnt[64 * pm], 1u, __ATOMIC_RELAXED, __HIP_MEMORY_SCOPE_AGENT); }
            unsigned sp = 0; while (__hip_atomic_load(&pcnt[64 * u.pm], __ATOMIC_RELAXED, __HIP_MEMORY_SCOPE_AGENT) < 8u) { __builtin_amdgcn_s_sleep(1); if (++sp > (1u << 20)) break; }
            __builtin_amdgcn_fence(__ATOMIC_ACQUIRE, "agent"); asm volatile("s_waitcnt vmcnt(0)" ::: "memory");
        }
        __syncthreads();
        f32x4 wv4[2][2];
#pragma unroll
        for (int bj = 0; bj < 2; ++bj)
#pragma unroll
            for (int n = 0; n < 2; ++n) wv4[bj][n] = *(const f32x4*)(wf + col0 + bj * 128 + n * 16);
        float rr[2][4];
#pragma unroll
        for (int ai = 0; ai < 2; ++ai)
#pragma unroll
            for (int m = 0; m < 4; ++m) rr[ai][m] = __hip_atomic_load(ss + row0 + ai * 128 + m * 16, __ATOMIC_RELAXED, __HIP_MEMORY_SCOPE_AGENT);
#pragma unroll
        for (int ai = 0; ai < 2; ++ai)
#pragma unroll
            for (int m = 0; m < 4; ++m) { const int row = row0 + ai * 128 + m * 16; const float r = __builtin_amdgcn_rsqf(rr[ai][m] * (1.0f / DM) + RMS_EPS);
#pragma unroll
                for (int bj = 0; bj < 2; ++bj)
#pragma unroll
                    for (int n = 0; n < 2; ++n) *(f32x4*)(out + (size_t)row * DM + col0 + bj * 128 + n * 16) = acc[ai][bj][m][n] * r * wv4[bj][n]; }
    }
};
struct GuProg {
    static constexpr bool FUSE_LAST = false; static constexpr bool PERM = true; int K, G, c; const bf16_t* X; const bf16_t* W; bf16_t* HH; const float* ss2;
    __device__ __forceinline__ bool next(int i, GUnit& u) const { const int L = i * G + c; if (L >= 64 * 44) return false; pg8::tile_of(L, 64, 44, u.pm, u.pn);
        u.A = (const char*)(X + (size_t)u.pm * 256 * DM); u.B = (const char*)(W + (size_t)u.pn * 256 * DM); u.sub = 0; return true; }
    __device__ __forceinline__ void epi(Acc& acc, const GUnit& u, int wr, int wc, int fr, int fq) const {
        const int row0 = u.pm * 256 + wr * 64 + fr, col0 = u.pn * 128 + wc * 32 + 8 * fq;
        float sq[2][4];
#pragma unroll
        for (int ai = 0; ai < 2; ++ai)
#pragma unroll
            for (int m = 0; m < 4; ++m) sq[ai][m] = ss2[row0 + ai * 128 + m * 16];
#pragma unroll
        for (int ai = 0; ai < 2; ++ai)
#pragma unroll
            for (int m = 0; m < 4; ++m) { const int row = row0 + ai * 128 + m * 16; const float r2 = __builtin_amdgcn_rsqf(sq[ai][m] * (1.0f / DM) + RMS_EPS);
                float hv[8];
#pragma unroll
                for (int n = 0; n < 2; ++n)
#pragma unroll
                    for (int j = 0; j < 4; ++j) { const float g = acc[ai][0][m][n][j] * r2, uu = acc[ai][1][m][n][j] * r2; hv[4 * n + j] = siluf_(g) * uu; }
                u32x4 w; w.x = pk2(hv[0], hv[1]); w.y = pk2(hv[2], hv[3]); w.z = pk2(hv[4], hv[5]); w.w = pk2(hv[6], hv[7]);
                *(u32x4*)(HH + blk_off(row, col0, FFH)) = w; }
        pg8::zero_acc(acc);
    }
};
struct Ctx {
    const float* in[21]; float* out; unsigned char* ws;
};
struct TpItem { const float* W; const float* ks; bf16_t* WT; int Nsrc, K, dst_row0, src_col0, kb; };
__device__ __forceinline__ TpItem tp_decode(const Ctx& C, int it) {
    constexpr int I_IN = 32 * 352, I_A = 16 * 64, I_O = 32 * 64, I_GU = 32 * 352;
    unsigned char* ws = C.ws; TpItem t; int r = it;
    if (r < I_IN) { const int nb = r % 352, n0 = nb * 32; t.W = C.in[2]; t.ks = C.in[1]; t.WT = (bf16_t*)(ws + WS_WIN); t.Nsrc = INCOLS; t.K = DM; t.dst_row0 = n0; t.src_col0 = n0 < 7168 ? n0 : n0 + 16; t.kb = r / 352; return t; } r -= I_IN;
    if (r < I_A) { t.W = C.in[14]; t.ks = nullptr; t.WT = (bf16_t*)(ws + WS_WA); t.Nsrc = DM; t.K = HW; t.dst_row0 = (r % 64) * 32; t.src_col0 = t.dst_row0; t.kb = r / 64; return t; } r -= I_A;
    if (r < I_A) { t.W = C.in[15]; t.ks = nullptr; t.WT = (bf16_t*)(ws + WS_WB); t.Nsrc = DM; t.K = MW; t.dst_row0 = (r % 64) * 32; t.src_col0 = t.dst_row0; t.kb = r / 64; return t; } r -= I_A;
    if (r < I_O) { t.W = C.in[16]; t.ks = nullptr; t.WT = (bf16_t*)(ws + WS_WOUT); t.Nsrc = DM; t.K = DM; t.dst_row0 = (r % 64) * 32; t.src_col0 = t.dst_row0; t.kb = r / 64; return t; } r -= I_O;
    if (r < I_GU) { const int nb = r % 352, n0 = nb * 32; const int pn = n0 >> 8, half = (n0 >> 7) & 1, i = n0 & 127;
        t.W = C.in[18]; t.ks = C.in[17]; t.WT = (bf16_t*)(ws + WS_WGU); t.Nsrc = 2 * FFH; t.K = DM; t.dst_row0 = n0; t.src_col0 = half * FFH + 128 * pn + i; t.kb = r / 352; return t; } r -= I_GU;
    t.W = C.in[19]; t.ks = nullptr; t.WT = (bf16_t*)(ws + WS_WD); t.Nsrc = DM; t.K = FFH; t.dst_row0 = (r % 64) * 32; t.src_col0 = t.dst_row0; t.kb = r / 64; return t;
}
__device__ __forceinline__ void tp_load(const TpItem& t, int lane, float (&tv)[32], float (&sv)[32]) {
    const int k0 = 64 * t.kb; const float* wp = t.W + (size_t)(k0 + (lane >> 5)) * t.Nsrc + t.src_col0 + (lane & 31);
#pragma unroll
    for (int i = 0; i < 32; ++i) tv[i] = wp[(size_t)(2 * i) * t.Nsrc];
    const float* kp = t.ks ? t.ks + k0 + (lane >> 5) : nullptr;
#pragma unroll
    for (int i = 0; i < 32; ++i) sv[i] = kp ? kp[2 * i] : 1.0f;
}
__device__ __forceinline__ void p0_prologue(const Ctx& C, LAS unsigned char* lds, int G, int wv) {
    int tid = (wv << 6) | lane_id_opaque(); asm volatile("" : "+v"(tid));
    const int lane = tid & 63, wave = __builtin_amdgcn_readfirstlane(tid >> 6);
    const int gw = blockIdx.x * 8 + wave, NGW = G * 8;
    unsigned char* ws = C.ws;
    LAS float* scr = (LAS float*)(lds + 67584 + wave * 8704);
    {
        constexpr int WGP = 2056;
        LAS bf16_t* wgb = (LAS bf16_t*)lds;
        const float* w_in = C.in[2]; const float* nw = C.in[1];
#pragma unroll 1
        for (int i0 = tid; i0 < DM * 16; i0 += 512 * 16) { float tw[16], tn[16];
#pragma unroll
            for (int u = 0; u < 16; ++u) { const int i = i0 + 512 * u, k = i >> 4, g = i & 15; tw[u] = w_in[(size_t)k * INCOLS + 7168 + g]; tn[u] = nw[k]; }
#pragma unroll
            for (int u = 0; u < 16; ++u) { const int i = i0 + 512 * u, k = i >> 4, g = i & 15; wgb[g * WGP + k] = (bf16_t)f2bf(tw[u] * tn[u]); } }
        __syncthreads();
    }

    {
        constexpr int NIT = 32 * 352 + 2 * 16 * 64 + 32 * 64 + 32 * 352 + 88 * 64;
        float tv[32], sv[32]; TpItem cur, nxt; int it = gw;
        if (it < NIT) { cur = tp_decode(C, it); tp_load(cur, lane, tv, sv); }
        while (it < NIT) {
#pragma unroll
            for (int i = 0; i < 32; ++i) scr[(2 * i + (lane >> 5)) * 33 + (lane & 31)] = tv[i] * sv[i];
            asm volatile("s_waitcnt lgkmcnt(0)" ::: "memory");
            const int nit = it + NGW;
            if (nit < NIT) { nxt = tp_decode(C, nit); tp_load(nxt, lane, tv, sv); }
            const int c = lane & 7, k0 = 64 * cur.kb;
#pragma unroll
            for (int j = 0; j < 4; ++j) { const int n = (lane >> 3) + 8 * j; const LAS float* sp = scr + (8 * c) * 33 + n;
                u32x4 o; o.x = pk2(sp[0 * 33], sp[1 * 33]); o.y = pk2(sp[2 * 33], sp[3 * 33]); o.z = pk2(sp[4 * 33], sp[5 * 33]); o.w = pk2(sp[6 * 33], sp[7 * 33]);
                *(u32x4*)(cur.WT + blk_off(cur.dst_row0 + n, k0 + 8 * c, cur.K)) = o; }
            asm volatile("s_waitcnt lgkmcnt(0)" ::: "memory");
            cur = nxt; it = nit;
        }
    }
    for (int i = blockIdx.x * 512 + tid; i < TOK; i += G * 512) { ((float*)(ws + WS_SS2))[i] = 0.f; ((float*)(ws + WS_SS3))[i] = 0.f; }
    {
        const float* w1 = C.in[5]; const float* b1 = C.in[6]; const float* f1 = C.in[7]; const float* w2 = C.in[8]; const float* b2 = C.in[9]; const float* f2 = C.in[10];
        float* h2 = (float*)(ws + WS_H2);
        for (int t = gw; t < SEQ; t += NGW) {
            const float tl = (float)t / (float)(SEQ - 1);
            const float omega = 6.283185307179586f * (float)t / (float)SEQ;
            float a = b1[lane] + tl * w1[lane];
            float sn, cs;
            { const int bi = lane & 15; const float fr = 1e-4f + (float)bi * ((15.0f - 1e-4f) / 15.0f); sincosf(omega * fr, &sn, &cs); }
#pragma unroll
            for (int i = 0; i < 16; ++i) a += __shfl(cs, i) * w1[(1 + i) * 64 + lane] - __shfl(sn, i) * w1[(17 + i) * 64 + lane];
            const float h1 = sinf(f1[lane] * a);
            float a2 = b2[lane];
#pragma unroll 8
            for (int i = 0; i < 64; ++i) a2 += __shfl(h1, i) * w2[i * 64 + lane];
            h2[t * 64 + lane] = sinf(f2[lane] * a2);
        }
    }
    {
        constexpr int WGP = 2056; LAS bf16_t* wgb = (LAS bf16_t*)lds;
        const float* x = C.in[0]; bf16_t* xb = (bf16_t*)(ws + WS_XB); float* r1 = (float*)(ws + WS_R1S); float* Gt = (float*)(ws + WS_G); const float* gbias = C.in[13];
        const int r = lane & 15, g = lane >> 4; const bool act = r < 8;
        for (int rb = gw; rb < TOK / 8; rb += NGW) {
            const int row = rb * 8 + (r & 7);
            const float* xp = x + (size_t)row * DM + 8 * g;
            f32x4 acc = {0.f, 0.f, 0.f, 0.f}; float ss = 0.f;
#pragma unroll 1
            for (int k8 = 0; k8 < 64; k8 += 8) {
                f32x4 la[8], lb[8];
#pragma unroll
                for (int u = 0; u < 8; ++u) { la[u] = *(const f32x4*)(xp + 32 * (k8 + u)); lb[u] = *(const f32x4*)(xp + 32 * (k8 + u) + 4); }
#pragma unroll
                for (int u = 0; u < 8; ++u) { const int kk = k8 + u; const f32x4 a = la[u], b = lb[u];
                    ss += ((a.x * a.x + a.y * a.y) + (a.z * a.z + a.w * a.w)) + ((b.x * b.x + b.y * b.y) + (b.z * b.z + b.w * b.w));
                    u32x4 o; o.x = pk2(a.x, a.y); o.y = pk2(a.z, a.w); o.z = pk2(b.x, b.y); o.w = pk2(b.z, b.w);
                    *(u32x4*)(xb + blk_off(row, 32 * kk + 8 * g, DM)) = o;
                    if (!act) { o.x = 0u; o.y = 0u; o.z = 0u; o.w = 0u; }
                    const bf16x8 bw = *(const LAS bf16x8*)(wgb + r * WGP + 32 * kk + 8 * g);
                    acc = __builtin_amdgcn_mfma_f32_16x16x32_bf16(__builtin_bit_cast(bf16x8, o), bw, acc, 0, 0, 0); }
            }
            ss += __shfl_xor(ss, 16); ss += __shfl_xor(ss, 32);
            const float rinv = __builtin_amdgcn_rsqf(ss * (1.0f / DM) + RMS_EPS);
            const float gb = gbias[r];
#pragma unroll
            for (int i = 0; i < 4; ++i) { const int m = 4 * g + i; const float rv = __shfl(rinv, m & 7); if (g < 2) Gt[(size_t)(rb * 8 + m) * 16 + r] = acc[i] * rv + gb; }
            if (lane < 8) r1[rb * 8 + lane] = rinv;
        }
    }
}
__device__ __forceinline__ void p1_filters(const Ctx& C, LAS unsigned char* lds, int G, int wv) {
    int tid = (wv << 6) | lane_id_opaque(); asm volatile("" : "+v"(tid));
    const int lane = tid & 63, w = tid >> 6, r = lane & 15, g = lane >> 4;
    const float* w3 = C.in[11]; const float* h2 = (const float*)(C.ws + WS_H2); float* FILT = (float*)(C.ws + WS_FILT);
    for (int item = blockIdx.x; item < 256; item += G) {
        const int n0 = 64 * (item >> 2), t0 = 1024 * (item & 3) + 128 * w;
        bf16x8 af[4][2];
#pragma unroll
        for (int mt = 0; mt < 4; ++mt)
#pragma unroll
            for (int ks = 0; ks < 2; ++ks) { float v[8];
#pragma unroll
                for (int e = 0; e < 8; ++e) v[e] = w3[(size_t)(32 * ks + 8 * g + e) * NFILT + n0 + 16 * mt + r];
                u32x4 o; o.x = pk2(v[0], v[1]); o.y = pk2(v[2], v[3]); o.z = pk2(v[4], v[5]); o.w = pk2(v[6], v[7]); af[mt][ks] = __builtin_bit_cast(bf16x8, o); }
        float dl[4][4];
#pragma unroll
        for (int mt = 0; mt < 4; ++mt)
#pragma unroll
            for (int i = 0; i < 4; ++i) { const int ch = (n0 + 16 * mt + 4 * g + i) & 1023; const float mind = -3.0701134573253945f, maxd = -15.350567286626973f;
                dl[mt][i] = fabsf(mind + (float)ch * ((maxd - mind) / 1023.0f)); }
        bf16x8 bfr[8][2];
#pragma unroll
        for (int nt = 0; nt < 8; ++nt) { const int t = t0 + 16 * nt + r;
#pragma unroll
            for (int ks = 0; ks < 2; ++ks) { const f32x4 a = *(const f32x4*)(h2 + (size_t)t * 64 + 32 * ks + 8 * g), b = *(const f32x4*)(h2 + (size_t)t * 64 + 32 * ks + 8 * g + 4);
                u32x4 o; o.x = pk2(a.x, a.y); o.y = pk2(a.z, a.w); o.z = pk2(b.x, b.y); o.w = pk2(b.z, b.w); bfr[nt][ks] = __builtin_bit_cast(bf16x8, o); } }
#pragma unroll
        for (int nt = 0; nt < 8; ++nt) {
            const int t = t0 + 16 * nt + r;
            const float tl = (float)t / (float)(SEQ - 1);
#pragma unroll
            for (int mt = 0; mt < 4; ++mt) {
                f32x4 acc = {0.f, 0.f, 0.f, 0.f};
                acc = __builtin_amdgcn_mfma_f32_16x16x32_bf16(af[mt][0], bfr[nt][0], acc, 0, 0, 0);
                acc = __builtin_amdgcn_mfma_f32_16x16x32_bf16(af[mt][1], bfr[nt][1], acc, 0, 0, 0);
#pragma unroll
                for (int i = 0; i < 4; ++i) FILT[(size_t)(n0 + 16 * mt + 4 * g + i) * SEQ + t] = acc[i] * __expf(-tl * dl[mt][i]);
            }
        }
    }
}
__device__ __forceinline__ void p7_final(const Ctx& C, int G, int wv) {
    int tid = (wv << 6) | lane_id_opaque(); asm volatile("" : "+v"(tid));
    const int lane = tid & 63, wave = tid >> 6, gw = blockIdx.x * 8 + wave, NGW = G * 8;
    const float* ss3 = (const float*)(C.ws + WS_SS3); const float* wf = C.in[20];
    f32x4 w[8];
#pragma unroll
    for (int j = 0; j < 8; ++j) w[j] = ((const f32x4*)wf)[64 * j + lane];
    for (int row = gw; row < TOK; row += 2 * NGW) {
        const int row2 = row + NGW;
        const bool has2 = row2 < TOK;
        const float r = __builtin_amdgcn_rsqf(ss3[row] * (1.0f / DM) + RMS_EPS), r2 = has2 ? __builtin_amdgcn_rsqf(ss3[row2] * (1.0f / DM) + RMS_EPS) : 0.f;
        f32x4* p = (f32x4*)(C.out + (size_t)row * DM) + lane; f32x4* p2 = (f32x4*)(C.out + (size_t)(has2 ? row2 : row) * DM) + lane;
        f32x4 v[8], u[8];
#pragma unroll
        for (int j = 0; j < 8; ++j) { v[j] = p[64 * j]; u[j] = p2[64 * j]; }
#pragma unroll
        for (int j = 0; j < 8; ++j) p[64 * j] = v[j] * r * w[j];
        if (has2) {
#pragma unroll
            for (int j = 0; j < 8; ++j) p2[64 * j] = u[j] * r2 * w[j]; }
    }
}
#ifndef FFT_HOST
#define FFT_DEV __device__ __forceinline__
#define FFT_PTR LAS f32x2*
#define FFT_SIN(x) __builtin_amdgcn_sinf(x)
#define FFT_COS(x) __builtin_amdgcn_cosf(x)
#else
#define FFT_DEV static inline
#define FFT_PTR f32x2*
#define FFT_SIN(x) sinf(6.283185307179586f * (x))
#define FFT_COS(x) cosf(6.283185307179586f * (x))
#endif
#define PADI(i) ((i) + ((i) >> 4))
FFT_DEV f32x2 cmul(f32x2 a, f32x2 b) { f32x2 r; r.x = a.x * b.x - a.y * b.y; r.y = a.x * b.y + a.y * b.x; return r; }
FFT_DEV f32x2 cmulc(f32x2 a, f32x2 b) { f32x2 r; r.x = a.x * b.x + a.y * b.y; r.y = a.y * b.x - a.x * b.y; return r; }
FFT_DEV f32x2 twid(float frac) { f32x2 r; r.x = FFT_COS(frac); r.y = -FFT_SIN(frac); return r; }
template <int M, int CJ> FFT_DEV f32x2 rot8(f32x2 d) {
    const float R = 0.70710678118654752f; f32x2 r;
    if (M == 0) return d;
    if (M == 2) { if (!CJ) { r.x = d.y; r.y = -d.x; } else { r.x = -d.y; r.y = d.x; } return r; }
    if (M == 1) { if (!CJ) { r.x = R * (d.x + d.y); r.y = R * (d.y - d.x); } else { r.x = R * (d.x - d.y); r.y = R * (d.x + d.y); } return r; }
    if (!CJ) { r.x = R * (d.y - d.x); r.y = -R * (d.x + d.y); } else { r.x = -R * (d.x + d.y); r.y = R * (d.x - d.y); } return r;
}
template <int INV, int ZHI, int LOW> FFT_DEV void fft_r8_pass(FFT_PTR buf, int s, int ls  , int tid) {
#pragma unroll 1
    for (int rep = 0; rep < 2; ++rep) {
        const int bf = tid + rep * 512, j = bf & (s - 1), blk = bf >> ls, base = blk * 8 * s + j;
        f32x2 x[8];
#pragma unroll
        for (int m = 0; m < (ZHI ? 4 : 8); ++m) x[m] = buf[PADI(base + m * s)];
        f32x2 w1 = twid((float)j / (float)(8 * s));
        f32x2 w2 = cmul(w1, w1), w4 = cmul(w2, w2);
        if (!INV) {
            if (ZHI) {
                x[4] = cmul(x[0], w1); x[5] = cmul(rot8<1, 0>(x[1]), w1); x[6] = cmul(rot8<2, 0>(x[2]), w1); x[7] = cmul(rot8<3, 0>(x[3]), w1);
            } else {
                { f32x2 a = x[0], b = x[4]; x[0] = a + b; x[4] = cmul(a - b, w1); }
                { f32x2 a = x[1], b = x[5]; x[1] = a + b; x[5] = cmul(rot8<1, 0>(a - b), w1); }
                { f32x2 a = x[2], b = x[6]; x[2] = a + b; x[6] = cmul(rot8<2, 0>(a - b), w1); }
                { f32x2 a = x[3], b = x[7]; x[3] = a + b; x[7] = cmul(rot8<3, 0>(a - b), w1); }
            }
#pragma unroll
            for (int h = 0; h < 8; h += 4) {
                { f32x2 a = x[h], b = x[h + 2]; x[h] = a + b; x[h + 2] = cmul(a - b, w2); }
                { f32x2 a = x[h + 1], b = x[h + 3]; x[h + 1] = a + b; x[h + 3] = cmul(rot8<2, 0>(a - b), w2); }
            }
#pragma unroll
            for (int m = 0; m < 8; m += 2) { f32x2 a = x[m], b = x[m + 1]; x[m] = a + b; x[m + 1] = cmul(a - b, w4); }
        } else {
#pragma unroll
            for (int m = 0; m < 8; m += 2) { f32x2 a = x[m], b = cmulc(x[m + 1], w4); x[m] = a + b; x[m + 1] = a - b; }
#pragma unroll
            for (int h = 0; h < 8; h += 4) {
                { f32x2 a = x[h], b = cmulc(x[h + 2], w2); x[h] = a + b; x[h + 2] = a - b; }
                { f32x2 a = x[h + 1], b = rot8<2, 1>(cmulc(x[h + 3], w2)); x[h + 1] = a + b; x[h + 3] = a - b; }
            }
            { f32x2 a = x[0], b = cmulc(x[4], w1); x[0] = a + b; if (!LOW) x[4] = a - b; }
            { f32x2 a = x[1], b = rot8<1, 1>(cmulc(x[5], w1)); x[1] = a + b; if (!LOW) x[5] = a - b; }
            { f32x2 a = x[2], b = rot8<2, 1>(cmulc(x[6], w1)); x[2] = a + b; if (!LOW) x[6] = a - b; }
            { f32x2 a = x[3], b = rot8<3, 1>(cmulc(x[7], w1)); x[3] = a + b; if (!LOW) x[7] = a - b; }
        }
#pragma unroll
        for (int m = 0; m < (LOW ? 4 : 8); ++m) buf[PADI(base + m * s)] = x[m];
    }
}
FFT_DEV void fft_r2_span1(FFT_PTR buf, int tid) {
#pragma unroll
    for (int rep = 0; rep < 8; ++rep) { const int p = 2 * (tid + rep * 512); f32x2 a = buf[PADI(p)], b = buf[PADI(p + 1)]; buf[PADI(p)] = a + b; buf[PADI(p + 1)] = a - b; }
}
template <int J, int CJ> FFT_DEV f32x2 rot16(f32x2 d) {
    const float C1 = 0.92387953251128674f, S1 = 0.38268343236508977f;
    if ((J & 1) == 0) return rot8<J / 2, CJ>(d);
    const float wr = (J == 1) ? C1 : (J == 3) ? S1 : (J == 5) ? -S1 : -C1;
    const float wi = ((J == 1) ? -S1 : (J == 3) ? -C1 : (J == 5) ? -C1 : -S1) * (CJ ? -1.f : 1.f);
    f32x2 r; r.x = d.x * wr - d.y * wi; r.y = d.x * wi + d.y * wr; return r;
}
FFT_DEV unsigned brev13(unsigned p);
FFT_DEV void fft16_dif(f32x2 (&x)[16]) {
#define BF_(i, j, ROT) { const f32x2 a_ = x[i], b_ = x[j]; x[i] = a_ + b_; x[j] = ROT(a_ - b_); }
    BF_(0, 8, (rot16<0, 0>)) BF_(1, 9, (rot16<1, 0>)) BF_(2, 10, (rot16<2, 0>)) BF_(3, 11, (rot16<3, 0>)) BF_(4, 12, (rot16<4, 0>)) BF_(5, 13, (rot16<5, 0>)) BF_(6, 14, (rot16<6, 0>)) BF_(7, 15, (rot16<7, 0>))
#pragma unroll
    for (int h = 0; h < 16; h += 8) { BF_(h + 0, h + 4, (rot8<0, 0>)) BF_(h + 1, h + 5, (rot8<1, 0>)) BF_(h + 2, h + 6, (rot8<2, 0>)) BF_(h + 3, h + 7, (rot8<3, 0>)) }
#pragma unroll
    for (int h = 0; h < 16; h += 4) { BF_(h + 0, h + 2, (rot8<0, 0>)) BF_(h + 1, h + 3, (rot8<2, 0>)) }
#pragma unroll
    for (int h = 0; h < 16; h += 2) { BF_(h, h + 1, (rot8<0, 0>)) }
#undef BF_
}
FFT_DEV void fft16_dit_inv(f32x2 (&x)[16]) {
#define BI_(i, j, ROT) { const f32x2 a_ = x[i], b_ = ROT(x[j]); x[i] = a_ + b_; x[j] = a_ - b_; }
#pragma unroll
    for (int h = 0; h < 16; h += 2) { BI_(h, h + 1, (rot8<0, 1>)) }
#pragma unroll
    for (int h = 0; h < 16; h += 4) { BI_(h + 0, h + 2, (rot8<0, 1>)) BI_(h + 1, h + 3, (rot8<2, 1>)) }
#pragma unroll
    for (int h = 0; h < 16; h += 8) { BI_(h + 0, h + 4, (rot8<0, 1>)) BI_(h + 1, h + 5, (rot8<1, 1>)) BI_(h + 2, h + 6, (rot8<2, 1>)) BI_(h + 3, h + 7, (rot8<3, 1>)) }
    BI_(0, 8, (rot16<0, 1>)) BI_(1, 9, (rot16<1, 1>)) BI_(2, 10, (rot16<2, 1>)) BI_(3, 11, (rot16<3, 1>)) BI_(4, 12, (rot16<4, 1>)) BI_(5, 13, (rot16<5, 1>)) BI_(6, 14, (rot16<6, 1>)) BI_(7, 15, (rot16<7, 1>))
#undef BI_
}
template <int MODE> FFT_DEV void fft_mid_pass(FFT_PTR wb, FFT_PTR zk, int tid) {
    f32x2 x[16];
#pragma unroll
    for (int e = 0; e < 16; ++e) x[e] = wb[PADI(16 * tid + e)];
    fft16_dif(x);
    if (MODE != 0) {
#pragma unroll
        for (int e = 0; e < 16; ++e) {
            const unsigned p = 16u * (unsigned)tid + (unsigned)e, f = brev13(p), fn = (8192u - f) & 8191u, pn = brev13(fn);
            const f32x2 zf = zk[PADI(p)], zn = zk[PADI(pn)];
            f32x2 kf;
            if (MODE == 1) { kf.x = 0.5f * (zf.x + zn.x); kf.y = 0.5f * (zf.y - zn.y); }
            else           { kf.x = 0.5f * (zf.y + zn.y); kf.y = 0.5f * (zn.x - zf.x); }
            x[e] = cmul(x[e], kf);
        }
        fft16_dit_inv(x);
    }
#pragma unroll
    for (int e = 0; e < 16; ++e) wb[PADI(16 * tid + e)] = x[e];
}
#ifndef FFT_HOST
#define FFT_SYNC() do { asm volatile("s_waitcnt lgkmcnt(0)" ::: "memory"); __builtin_amdgcn_s_barrier(); asm volatile("" ::: "memory"); } while (0)
__device__ __forceinline__ void fft_fwd_full(FFT_PTR buf, int tid) {
    FFT_SYNC(); fft_r8_pass<0, 0, 0>(buf, 1024, 10, tid); FFT_SYNC(); fft_r8_pass<0, 0, 0>(buf, 128, 7, tid); FFT_SYNC(); fft_r8_pass<0, 0, 0>(buf, 16, 4, tid); FFT_SYNC();
    fft_mid_pass<0>(buf, buf, tid); FFT_SYNC();
}
template <int WHICH> __device__ __forceinline__ void fft_conv(FFT_PTR wb, FFT_PTR zk, int tid) {
    FFT_SYNC(); fft_r8_pass<0, 1, 0>(wb, 1024, 10, tid); FFT_SYNC(); fft_r8_pass<0, 0, 0>(wb, 128, 7, tid); FFT_SYNC(); fft_r8_pass<0, 0, 0>(wb, 16, 4, tid); FFT_SYNC();
    fft_mid_pass<1 + WHICH>(wb, zk, tid); FFT_SYNC();
    fft_r8_pass<1, 0, 0>(wb, 16, 4, tid); FFT_SYNC(); fft_r8_pass<1, 0, 0>(wb, 128, 7, tid); FFT_SYNC(); fft_r8_pass<1, 0, 1>(wb, 1024, 10, tid); FFT_SYNC();
}
#endif
FFT_DEV unsigned brev13(unsigned p) {
    unsigned r = 0;
#ifndef FFT_HOST
    r = __brev(p) >> 19;
#else
    for (int i = 0; i < 13; ++i) r |= ((p >> i) & 1u) << (12 - i);
#endif
    return r;
}
FFT_DEV void fft_pointwise(FFT_PTR wb, FFT_PTR zk, int which, int tid) {
#pragma unroll 4
    for (int rep = 0; rep < 16; ++rep) {
        const unsigned p = tid + rep * 512, f = brev13(p), fn = (8192u - f) & 8191u, pn = brev13(fn);
        const f32x2 zf = zk[PADI(p)], zn = zk[PADI(pn)];
        f32x2 kf;
        if (which == 0) { kf.x = 0.5f * (zf.x + zn.x); kf.y = 0.5f * (zf.y - zn.y); }
        else            { kf.x = 0.5f * (zf.y + zn.y); kf.y = 0.5f * (zn.x - zf.x); }
        wb[PADI(p)] = cmul(wb[PADI(p)], kf);
    }
}
__device__ __forceinline__ void qk_prepass(const Ctx& C, int G, int wv) {
    int tid = (wv << 6) | lane_id_opaque(); asm volatile("" : "+v"(tid));
    const bf16_t* R1A = (const bf16_t*)(C.ws + WS_R1A); bf16_t* QKP = (bf16_t*)(C.ws + WS_QKP);
    const float* cw = C.in[3]; const float* cb = C.in[4];
    const int cg8 = tid & 255, half = tid >> 8, col = 8 * cg8;
    float k0[8], k1[8], k2[8], kb[8];
    { const int ch = 3072 + col;
      const f32x4 t0 = *(const f32x4*)(cw + ch), t1 = *(const f32x4*)(cw + ch + 4), t2 = *(const f32x4*)(cw + CONVC + ch), t3 = *(const f32x4*)(cw + CONVC + ch + 4);
      const f32x4 t4 = *(const f32x4*)(cw + 2 * CONVC + ch), t5 = *(const f32x4*)(cw + 2 * CONVC + ch + 4), t6 = *(const f32x4*)(cb + ch), t7 = *(const f32x4*)(cb + ch + 4);
#pragma unroll
      for (int e = 0; e < 4; ++e) { k0[e] = t0[e]; k0[4 + e] = t1[e]; k1[e] = t2[e]; k1[4 + e] = t3[e]; k2[e] = t4[e]; k2[4 + e] = t5[e]; kb[e] = t6[e]; kb[4 + e] = t7[e]; } }
    const float osc = col >= 1024 ? 0.0625f : 1.0f;
    for (int run = blockIdx.x; run < TOK / 64; run += G) {
        const int row0 = run * 64 + half * 32;
#pragma unroll 1
        for (int i0 = 0; i0 < 32; i0 += 4) {
            u32x4 w0[4], w1[4], w2[4];
#pragma unroll
            for (int u = 0; u < 4; ++u) { const int row = row0 + i0 + u, t = row & (SEQ - 1); const bf16_t* p = R1A + (size_t)row * 2048 + col;
                w0[u] = *(const u32x4*)(t > 0 ? p - 2048 : p); w1[u] = *(const u32x4*)p; w2[u] = *(const u32x4*)(t < SEQ - 1 ? p + 2048 : p); }
#pragma unroll
            for (int u = 0; u < 4; ++u) { const int row = row0 + i0 + u, t = row & (SEQ - 1);
                const u32x4 z = {0u, 0u, 0u, 0u}; if (t == 0) w0[u] = z; if (t == SEQ - 1) w2[u] = z;
                float a0[8], a1[8], a2[8]; unpack8(w0[u], a0); unpack8(w1[u], a1); unpack8(w2[u], a2);
                float v[8];
#pragma unroll
                for (int e = 0; e < 8; ++e) v[e] = siluf_(k0[e] * a0[e] + k1[e] * a1[e] + k2[e] * a2[e] + kb[e]) * osc;
                u32x4 o; o.x = pk2(v[0], v[1]); o.y = pk2(v[2], v[3]); o.z = pk2(v[4], v[5]); o.w = pk2(v[6], v[7]);
                *(u32x4*)(QKP + (size_t)row * 2048 + col) = o; }
        }
    }
}
constexpr int ML_KS = 0, ML_KP = 528, ML_SS = 76032, ML_SP = 272, ML_VS = 110848, ML_VP = 80, ML_VW = 121088, ML_CS = 131328, ML_CP = 528, ML_SC = 148224;
static_assert(ML_SC + 7 * 512 + 64 + 5 * 128 <= LDS_BYTES - 16, "mLSTM LDS map");
__device__ __forceinline__ bf16x8 tr_read2(unsigned a0, unsigned a1) {
    bf16x4 lo, hi;
    asm volatile("ds_read_b64_tr_b16 %0, %2\n\tds_read_b64_tr_b16 %1, %3\n\ts_waitcnt lgkmcnt(0)" : "=&v"(lo), "=&v"(hi) : "v"(a0), "v"(a1) : "memory");
    bf16x8 r; r[0] = lo[0]; r[1] = lo[1]; r[2] = lo[2]; r[3] = lo[3]; r[4] = hi[0]; r[5] = hi[1]; r[6] = hi[2]; r[7] = hi[3]; return r;
}
__device__ __forceinline__ bf16x8 cat4(bf16x4 lo, bf16x4 hi) { bf16x8 r; r[0] = lo[0]; r[1] = lo[1]; r[2] = lo[2]; r[3] = lo[3]; r[4] = hi[0]; r[5] = hi[1]; r[6] = hi[2]; r[7] = hi[3]; return r; }
__device__ __forceinline__ void tr_read2x2(unsigned a, unsigned b, unsigned d, bf16x8& ra, bf16x8& rb) {
    bf16x4 l0, h0, l1, h1;
    asm volatile("ds_read_b64_tr_b16 %0, %4\n\tds_read_b64_tr_b16 %1, %5\n\tds_read_b64_tr_b16 %2, %6\n\tds_read_b64_tr_b16 %3, %7\n\ts_waitcnt lgkmcnt(0)"
        : "=&v"(l0), "=&v"(h0), "=&v"(l1), "=&v"(h1) : "v"(a), "v"(a + d), "v"(b), "v"(b + d) : "memory");
    ra = cat4(l0, h0); rb = cat4(l1, h1);
}
__device__ __forceinline__ void tr_read4x2(unsigned a, unsigned b, unsigned d, unsigned c, unsigned e, unsigned d2, bf16x8& ra, bf16x8& rb, bf16x8& rc, bf16x8& re) {
    bf16x4 l0, h0, l1, h1, l2, h2, l3, h3;
    asm volatile("ds_read_b64_tr_b16 %0, %8\n\tds_read_b64_tr_b16 %1, %9\n\tds_read_b64_tr_b16 %2, %10\n\tds_read_b64_tr_b16 %3, %11\n\t"
                 "ds_read_b64_tr_b16 %4, %12\n\tds_read_b64_tr_b16 %5, %13\n\tds_read_b64_tr_b16 %6, %14\n\tds_read_b64_tr_b16 %7, %15\n\ts_waitcnt lgkmcnt(0)"
        : "=&v"(l0), "=&v"(h0), "=&v"(l1), "=&v"(h1), "=&v"(l2), "=&v"(h2), "=&v"(l3), "=&v"(h3)
        : "v"(a), "v"(a + d), "v"(b), "v"(b + d), "v"(c), "v"(c + d2), "v"(e), "v"(e + d2) : "memory");
    ra = cat4(l0, h0); rb = cat4(l1, h1); rc = cat4(l2, h2); re = cat4(l3, h3);
}
__device__ __forceinline__ float bf2f(short s) { return __uint_as_float(((unsigned)(unsigned short)s) << 16); }
__device__ __forceinline__ float logsigmoidf_(float x) { return fminf(x, 0.f) - log1pf(expf(-fabsf(x))); }

__device__ __forceinline__ void mlstm_item(const Ctx& C, LAS unsigned char* lds, int item, int wv) {
    int tid = (wv << 6) | lane_id_opaque(); asm volatile("" : "+v"(tid));
    const int lane = tid & 63, w = __builtin_amdgcn_readfirstlane(tid >> 6), r = lane & 15, g = lane >> 4, q4 = r >> 2, p4 = r & 3;
    const int xcd_ = item & 7, yy_ = item >> 3, vs = yy_ & 7, dir = (yy_ >> 3) & 1, bh = 2 * xcd_ + (yy_ >> 4), b = bh >> 2, h = bh & 3;
    const bf16_t* QKP = (const bf16_t*)(C.ws + WS_QKP); const bf16_t* R1B = (const bf16_t*)(C.ws + WS_R1B); const float* Gt = (const float*)(C.ws + WS_G);
    bf16_t* Y = (bf16_t*)(C.ws + (dir ? WS_YBB : WS_YBF));
    LAS float* SC = (LAS float*)(lds + ML_SC);
    LAS float* s_cs = SC, *s_rj = SC + 128, *s_iw = SC + 256, *s_emj = SC + 384, *s_w = SC + 512, *s_dn = SC + 640, *s_misc = SC + 768;
    LAS float* c_bl = SC + 784, *c_mx = SC + 816, *c_mp = SC + 848, *c_mn = SC + 880, *c_kp = SC + 912;
    float* GS = (float*)(C.ws + WS_GSC) + (size_t)item * 3 * SEQ;
    const unsigned lbase = (unsigned)(size_t)lds;
    const int pc = tid & 31, krow = tid >> 5, vrow = tid >> 2, pv = tid & 3;
    const int sw = w < 4 ? w : 11 - w;
    for (int i = tid; i < 16896 / 4; i += 512) ((LAS unsigned*)(lds + ML_CS))[i] = 0u;
    for (int i = tid; i < 16 * ML_KP / 4; i += 512) ((LAS unsigned*)(lds + ML_KS + 128 * ML_KP))[i] = 0u;
    f32x4 Cacc[3][2];
#pragma unroll
    for (int a = 0; a < 3; ++a) { Cacc[a][0] = (f32x4){0.f, 0.f, 0.f, 0.f}; Cacc[a][1] = (f32x4){0.f, 0.f, 0.f, 0.f}; }
    u32x4 kreg[8], vreg, qn[8]; float bn = 0.f, csn = 0.f, pmn = 0.f;
#define ML_TOK(c_, j_) ((size_t)b * SEQ + (dir ? SEQ - 1 - ((c_) * 128 + (j_)) : ((c_) * 128 + (j_))))
#define ML_PREFETCH(c_) do { \
        _Pragma("unroll") for (int i = 0; i < 8; ++i) kreg[i] = *(const u32x4*)(QKP + ML_TOK(c_, krow + 16 * i) * 2048 + 1024 + h * 256 + 8 * pc); \
        vreg = *(const u32x4*)(R1B + ML_TOK(c_, vrow) * 2048 + h * 256 + vs * 32 + 8 * pv); \
        { const bf16_t* qp = QKP + ML_TOK(c_, 16 * sw + r) * 2048 + h * 256 + 8 * g; _Pragma("unroll") for (int kk = 0; kk < 8; ++kk) qn[kk] = *(const u32x4*)(qp + 32 * kk); } \
        if (tid < 128) { const int ta = (c_) * 128 + tid; bn = GS[ta]; csn = GS[SEQ + ta]; pmn = GS[2 * SEQ + ta]; } } while (0)
    {
        float gi[8], gf[8];
#pragma unroll
        for (int u = 0; u < 8; ++u) { const int ta = (4 * w) * 128 + u * 64 + lane; const size_t tk = (size_t)b * SEQ + (dir ? SEQ - 1 - ta : ta);
            gi[u] = Gt[tk * 16 + (dir * 2) * 4 + h]; gf[u] = Gt[tk * 16 + (dir * 2 + 1) * 4 + h]; }
#pragma unroll
        for (int q = 0; q < 4; ++q) {
            const int c = 4 * w + q; float carry_b = 0.f, carry_m = -3.0e38f;
#pragma unroll
            for (int hf = 0; hf < 2; ++hf) {
                const int ta = c * 128 + hf * 64 + lane;
                const float ip = gi[2 * q + hf], fp = gf[2 * q + hf];
                float xs = logsigmoidf_(fp);
#pragma unroll
                for (int o = 1; o < 64; o <<= 1) { const float y = __shfl_up(xs, o); if (lane >= o) xs += y; }
                const float bj = xs + carry_b; const float cj = ip - bj; float pm = cj;
#pragma unroll
                for (int o = 1; o < 64; o <<= 1) { const float y = __shfl_up(pm, o); if (lane >= o) pm = fmaxf(pm, y); }
                pm = fmaxf(pm, carry_m);
                GS[ta] = bj; GS[SEQ + ta] = cj; GS[2 * SEQ + ta] = pm;
                carry_b = __shfl(bj, 63); carry_m = __shfl(pm, 63);
            }
            if (lane == 0) { c_bl[c] = carry_b; c_mx[c] = carry_m; }
        }
        __syncthreads();
        if (tid == 0) { float m = 0.f;
            for (int c = 0; c < 32; ++c) { const float bl = c_bl[c], mn = fmaxf(bl + m, bl + c_mx[c]); c_mp[c] = m; c_mn[c] = mn; c_kp[c] = __expf(bl + m - mn); m = mn; } }
        __syncthreads();
    }
    ML_PREFETCH(0);
    __syncthreads();
#define ML_BAR() do { asm volatile("s_waitcnt lgkmcnt(0)" ::: "memory"); __builtin_amdgcn_s_barrier(); asm volatile("" ::: "memory"); } while (0)
#pragma unroll 1
    for (int c = 0; c < 32; ++c) {
        const float m_prev = c_mp[c], m_new = c_mn[c], keep = c_kp[c], b_last = c_bl[c];
        if (tid < 128) {
            const float inter = bn + m_prev, mj = fmaxf(inter, bn + pmn);
            s_cs[tid] = csn; s_rj[tid] = bn - mj; s_iw[tid] = __expf(inter - mj); s_emj[tid] = __expf(-mj); s_w[tid] = __expf(b_last + csn - m_new);
        }
        ML_BAR();
#pragma unroll
        for (int i = 0; i < 8; ++i) *(LAS u32x4*)(lds + ML_KS + (krow + 16 * i) * ML_KP + pc * 16) = kreg[i];
        {
            *(LAS u32x4*)(lds + ML_VS + vrow * ML_VP + pv * 16) = vreg;
            float f[8]; unpack8(vreg, f); const float ws_ = s_w[vrow];
            u32x4 o; o.x = pk2(f[0] * ws_, f[1] * ws_); o.y = pk2(f[2] * ws_, f[3] * ws_); o.z = pk2(f[4] * ws_, f[5] * ws_); o.w = pk2(f[6] * ws_, f[7] * ws_);
            *(LAS u32x4*)(lds + ML_VW + vrow * ML_VP + pv * 16) = o;
        }
        bf16x8 qf[8];
#pragma unroll
        for (int kk = 0; kk < 8; ++kk) qf[kk] = __builtin_bit_cast(bf16x8, qn[kk]);
        unsigned short ogr[4][2];
#pragma unroll
        for (int i = 0; i < 4; ++i)
#pragma unroll
            for (int vt = 0; vt < 2; ++vt) ogr[i][vt] = R1B[ML_TOK(c, 16 * sw + 4 * g + i) * 2048 + 1024 + h * 256 + vs * 32 + 16 * vt + r];
        if (c < 31) ML_PREFETCH(c + 1);
        ML_BAR();
        {
            const float rjv = s_rj[16 * sw + r]; const int jloc = 16 * sw + r; float den1 = 0.f;
#pragma unroll 2
            for (int st = 0; st < 8; ++st) {
                if (st <= sw) {
                    f32x4 acc = {0.f, 0.f, 0.f, 0.f};
#pragma unroll
                    for (int kk = 0; kk < 8; ++kk) { const bf16x8 kf = *(const LAS bf16x8*)(lds + ML_KS + (16 * st + r) * ML_KP + (32 * kk + 8 * g) * 2); acc = __builtin_amdgcn_mfma_f32_16x16x32_bf16(kf, qf[kk], acc, 0, 0, 0); }
                    const f32x4 c4 = *(const LAS f32x4*)(s_cs + 16 * st + 4 * g);
                    float v[4];
#pragma unroll
                    for (int i = 0; i < 4; ++i) { const int s = 16 * st + 4 * g + i; const float d = (s <= jloc) ? __expf(rjv + c4[i]) : 0.f; v[i] = acc[i] * d; den1 += v[i]; }
                    u32x2 o; o.x = pk2(v[0], v[1]); o.y = pk2(v[2], v[3]);
                    *(LAS u32x2*)(lds + ML_SS + jloc * ML_SP + (16 * st + 4 * g) * 2) = o;
                } else if (st == sw + 1 && !(sw & 1)) {
                    u32x2 o = {0u, 0u}; *(LAS u32x2*)(lds + ML_SS + jloc * ML_SP + (16 * st + 4 * g) * 2) = o;
                }
            }
            den1 += __shfl_xor(den1, 16); den1 += __shfl_xor(den1, 32);
            f32x4 dacc = {0.f, 0.f, 0.f, 0.f};
#pragma unroll
            for (int kk = 0; kk < 8; ++kk) { const bf16x8 kf = *(const LAS bf16x8*)(lds + ML_KS + (128 + r) * ML_KP + (32 * kk + 8 * g) * 2); dacc = __builtin_amdgcn_mfma_f32_16x16x32_bf16(kf, qf[kk], dacc, 0, 0, 0); }
            const float d2 = dacc[0];
            if (g == 0) s_dn[jloc] = den1 + s_iw[jloc] * d2;
        }
        ML_BAR();
        {
            f32x4 n1[2], n2[2];
#pragma unroll
            for (int vt = 0; vt < 2; ++vt) { n1[vt] = (f32x4){0.f, 0.f, 0.f, 0.f}; n2[vt] = (f32x4){0.f, 0.f, 0.f, 0.f}; }
            const int nks = (sw >> 1) + 1;
#pragma unroll 1
            for (int ks = 0; ks < nks; ++ks) {
                const bf16x8 af = *(const LAS bf16x8*)(lds + ML_SS + (16 * sw + r) * ML_SP + (32 * ks + 8 * g) * 2);
                const unsigned a0 = lbase + ML_VS + (32 * ks + 8 * g + q4) * ML_VP + (4 * p4) * 2;
                bf16x8 b0, b1; tr_read2x2(a0, a0 + 32, 4 * ML_VP, b0, b1);
                n1[0] = __builtin_amdgcn_mfma_f32_16x16x32_bf16(af, b0, n1[0], 0, 0, 0); n1[1] = __builtin_amdgcn_mfma_f32_16x16x32_bf16(af, b1, n1[1], 0, 0, 0);
            }
#pragma unroll
            for (int kk = 0; kk < 8; ++kk)
#pragma unroll
                for (int vt = 0; vt < 2; ++vt) { const bf16x8 cf = *(const LAS bf16x8*)(lds + ML_CS + (16 * vt + r) * ML_CP + (32 * kk + 8 * g) * 2); n2[vt] = __builtin_amdgcn_mfma_f32_16x16x32_bf16(qf[kk], cf, n2[vt], 0, 0, 0); }
            const f32x4 iw4 = *(const LAS f32x4*)(s_iw + 16 * sw + 4 * g), dn4 = *(const LAS f32x4*)(s_dn + 16 * sw + 4 * g), em4 = *(const LAS f32x4*)(s_emj + 16 * sw + 4 * g);
#pragma unroll
            for (int i = 0; i < 4; ++i) {
                const size_t tok = ML_TOK(c, 16 * sw + 4 * g + i);
                const float inv = __builtin_amdgcn_rcpf(fmaxf(fabsf(dn4[i]), em4[i]));
#pragma unroll
                for (int vt = 0; vt < 2; ++vt) { const int col = h * 256 + vs * 32 + 16 * vt + r;
                    const float og = __uint_as_float(((unsigned)ogr[i][vt]) << 16);
                    const float hv = (n1[vt][i] + iw4[i] * n2[vt][i]) * inv * og;
                    Y[blk_off((int)tok, col, 1024)] = (bf16_t)f2bf(hv); }
            }
        }
        ML_BAR();
        {
#pragma unroll
            for (int a = 0; a < 3; ++a) { Cacc[a][0] *= keep; Cacc[a][1] *= keep; }
#pragma unroll 1
            for (int ks = 0; ks < 4; ++ks) {
                bf16x8 af[3], bq[2];
                { const unsigned av = lbase + ML_VW + (32 * ks + 8 * g + q4) * ML_VP + (4 * p4) * 2, ak = lbase + ML_KS + (32 * ks + 8 * g + q4) * ML_KP + (32 * w + 4 * p4) * 2;
                  tr_read4x2(av, av + 32, 4 * ML_VP, ak, ak + 32, 4 * ML_KP, af[0], af[1], bq[0], bq[1]); }
                { const f32x4 wa = *(const LAS f32x4*)(s_w + 32 * ks + 8 * g), wb = *(const LAS f32x4*)(s_w + 32 * ks + 8 * g + 4);
                  u32x4 o; o.x = pk2(wa[0], wa[1]); o.y = pk2(wa[2], wa[3]); o.z = pk2(wb[0], wb[1]); o.w = pk2(wb[2], wb[3]);
                  if (r != 0) { o.x = 0u; o.y = 0u; o.z = 0u; o.w = 0u; }
                  af[2] = __builtin_bit_cast(bf16x8, o); }
#pragma unroll
                for (int nt = 0; nt < 2; ++nt)
#pragma unroll
                    for (int mt = 0; mt < 3; ++mt) Cacc[mt][nt] = __builtin_amdgcn_mfma_f32_16x16x32_bf16(af[mt], bq[nt], Cacc[mt][nt], 0, 0, 0);
            }
#pragma unroll
            for (int mt = 0; mt < 2; ++mt)
#pragma unroll
                for (int nt = 0; nt < 2; ++nt)
#pragma unroll
                    for (int i = 0; i < 4; ++i) *(LAS bf16_t*)(lds + ML_CS + (16 * mt + 4 * g + i) * ML_CP + (32 * w + 16 * nt + r) * 2) = (bf16_t)f2bf(Cacc[mt][nt][i]);
            if (g == 0) { *(LAS bf16_t*)(lds + ML_KS + 128 * ML_KP + (32 * w + r) * 2) = (bf16_t)f2bf(Cacc[2][0][0]); *(LAS bf16_t*)(lds + ML_KS + 128 * ML_KP + (32 * w + 16 + r) * 2) = (bf16_t)f2bf(Cacc[2][1][0]); }
        }
        ML_BAR();
    }
#undef ML_BAR
#undef ML_PREFETCH
#undef ML_TOK
}
constexpr int HY_ZK = 0, HY_WB = 69632;
static_assert(HY_WB + 69632 <= LDS_BYTES, "hyena LDS map");
#define GAS __attribute__((address_space(1)))
struct HyRaw { u32x4 c; unsigned l, r; };
__device__ __forceinline__ HyRaw hy_load(const bf16_t* rowp, int tid) { HyRaw x; const GAS bf16_t* p = (const GAS bf16_t*)rowp + 8 * tid; x.c = *(const GAS u32x4*)p; x.l = p[-1]; x.r = p[8]; return x; }
__device__ __forceinline__ void hy_conv8(const HyRaw& x, int tid, float w0, float w1, float w2, float bias, float (&o)[8]) {
    float a[10];
    a[0] = tid > 0 ? __uint_as_float(x.l << 16) : 0.f; a[9] = tid < 511 ? __uint_as_float(x.r << 16) : 0.f;
    a[1] = bflo(x.c.x); a[2] = bfhi(x.c.x); a[3] = bflo(x.c.y); a[4] = bfhi(x.c.y); a[5] = bflo(x.c.z); a[6] = bfhi(x.c.z); a[7] = bflo(x.c.w); a[8] = bfhi(x.c.w);
#pragma unroll
    for (int m = 0; m < 8; ++m) o[m] = w0 * a[m] + w1 * a[m + 1] + w2 * a[m + 2] + bias;
}
__device__ __forceinline__ void hyena_item(const Ctx& C, LAS unsigned char* lds, int ch, int wv) {
    int tid = (wv << 6) | lane_id_opaque(); asm volatile("" : "+v"(tid));
    LAS f32x2* zk = (LAS f32x2*)(lds + HY_ZK); LAS f32x2* wb = (LAS f32x2*)(lds + HY_WB);
    const float* FILT = (const float*)(C.ws + WS_FILT); const bf16_t* HYb = (const bf16_t*)(C.ws + WS_HY); bf16_t* YA = (bf16_t*)(C.ws + WS_YA);
    const float* cw = C.in[3]; const float* cb = C.in[4];
    float w0[3], w1[3], w2[3], bs[3];
#pragma unroll
    for (int s = 0; s < 3; ++s) { w0[s] = cw[s * 1024 + ch]; w1[s] = cw[CONVC + s * 1024 + ch]; w2[s] = cw[2 * CONVC + s * 1024 + ch]; bs[s] = cb[s * 1024 + ch]; }
    const float hb0 = C.in[12][ch], hb1 = C.in[12][1024 + ch];
    const float* F0 = FILT + (size_t)(0 * 1024 + ch) * SEQ; const float* F1 = FILT + (size_t)(1 * 1024 + ch) * SEQ;
    const float* F2 = FILT + (size_t)(2 * 1024 + ch) * SEQ; const float* F3 = FILT + (size_t)(3 * 1024 + ch) * SEQ;
    __syncthreads();
    {
        float fa[16], fb[16];
#pragma unroll
        for (int rep = 0; rep < 8; ++rep) { const int i = tid + 512 * rep; fa[rep] = F0[i]; fb[rep] = F2[i]; }
#pragma unroll
        for (int rep = 8; rep < 16; ++rep) { const int i = tid + 512 * rep; const int j = i == SEQ ? 1 : 2 * SEQ - i; fa[rep] = F1[j]; fb[rep] = F3[j]; }
        if (tid == 0) { fa[8] = 0.f; fb[8] = 0.f; }
#pragma unroll
        for (int rep = 0; rep < 16; ++rep) { const int i = tid + 512 * rep; zk[PADI(i)] = (f32x2){fa[rep] * (1.0f / 8192.0f), fb[rep] * (1.0f / 8192.0f)}; }
    }
    fft_fwd_full(zk, tid);
    const bf16_t* rv = HYb + (size_t)ch * TOK; const bf16_t* rx1 = HYb + (size_t)(1024 + ch) * TOK; const bf16_t* rx2 = HYb + (size_t)(2048 + ch) * TOK;
    HyRaw qa = hy_load(rv, tid), qb = hy_load(rv + SEQ, tid);
#pragma unroll 1
    for (int p = 0; p < 2; ++p) {
        const int tb0 = (2 * p) * SEQ, tb1 = (2 * p + 1) * SEQ;
        f32x2 vv[8], zz[8];
        { float va[8], vb[8]; hy_conv8(qa, tid, w0[0], w1[0], w2[0], bs[0], va); hy_conv8(qb, tid, w0[0], w1[0], w2[0], bs[0], vb);
#pragma unroll
          for (int m = 0; m < 8; ++m) { vv[m].x = va[m]; vv[m].y = vb[m]; wb[PADI(8 * tid + m)] = vv[m]; } }
        qa = hy_load(rx1 + tb0, tid); qb = hy_load(rx1 + tb1, tid);
        fft_conv<0>(wb, zk, tid);
        { float xa[8], xb_[8]; hy_conv8(qa, tid, w0[1], w1[1], w2[1], bs[1], xa); hy_conv8(qb, tid, w0[1], w1[1], w2[1], bs[1], xb_);
#pragma unroll
          for (int m = 0; m < 8; ++m) { const f32x2 y = wb[PADI(8 * tid + m)]; zz[m].x = xa[m] * (y.x + vv[m].x * hb0); zz[m].y = xb_[m] * (y.y + vv[m].y * hb0); }
#pragma unroll
          for (int m = 0; m < 8; ++m) wb[PADI(8 * tid + m)] = zz[m]; }
        qa = hy_load(rx2 + tb0, tid); qb = hy_load(rx2 + tb1, tid);
        fft_conv<1>(wb, zk, tid);
        { float xa[8], xb_[8]; hy_conv8(qa, tid, w0[2], w1[2], w2[2], bs[2], xa); hy_conv8(qb, tid, w0[2], w1[2], w2[2], bs[2], xb_);
          if (p == 0) { qa = hy_load(rv + 2 * SEQ, tid); qb = hy_load(rv + 3 * SEQ, tid); }
#pragma unroll
          for (int m = 0; m < 8; ++m) { const int t = 8 * tid + m; const f32x2 y = wb[PADI(t)];
              YA[blk_off(tb0 + t, ch, 1024)] = (bf16_t)f2bf(xa[m] * (y.x + zz[m].x * hb1));
              YA[blk_off(tb1 + t, ch, 1024)] = (bf16_t)f2bf(xb_[m] * (y.y + zz[m].y * hb1)); } }
        FFT_SYNC();
    }
}
#ifndef DUP_FILT
#define DUP_FILT 0
#endif
#ifndef DUP_PRE
#define DUP_PRE 0
#endif
#ifndef DUP_P0
#define DUP_P0 0
#endif
#ifndef DUP_ML
#define DUP_ML 0
#endif
#ifndef DUP_HY
#define DUP_HY 0
#endif
#ifndef DUP_REST
#define DUP_REST 0
#endif
#ifndef DUP_GU
#define DUP_GU 0
#endif
#define XB_TMO      128
#define XB_XCNT(j)  (256  + 64 * (j))
#define XB_XSUB(j)  (1280 + 64 * (j))
#define XB_XGEN(j)  (2304 + 64 * (j))
#define XB_TOP      3328
#define XB_TOPGEN   3392
#define XCD_BAR_WORDS 3456
#define XB_SPIN_CAP (1u << 22)
__device__ __forceinline__ unsigned xb_ld(unsigned* p)              { return __hip_atomic_load(p, __ATOMIC_RELAXED, __HIP_MEMORY_SCOPE_AGENT); }
__device__ __forceinline__ unsigned xb_add(unsigned* p, unsigned v) { return __hip_atomic_fetch_add(p, v, __ATOMIC_RELAXED, __HIP_MEMORY_SCOPE_AGENT); }
__device__ __forceinline__ unsigned xb_xcc_id() { return (unsigned)__builtin_amdgcn_s_getreg((3 << 11) | 20) & 0xFu; }
#define XB_SPIN(cond, bar) do { unsigned _sp = 0; while (cond) { __builtin_amdgcn_s_sleep(1); \
    if ((++_sp & 255u) == 0u) { if (xb_ld(&(bar)[XB_TMO])) break; if (_sp > XB_SPIN_CAP) { atomicAdd(&(bar)[XB_TMO], 1u); break; } } } } while (0)
__device__ __forceinline__ void xcd_barrier_complete(unsigned* bar, unsigned x, unsigned G, unsigned& nloc, unsigned& nx) {
    unsigned sum, cnt, mine, sp = 0u;
    for (;;) {
        sum = 0u; cnt = 0u; mine = 0u;
#pragma unroll
        for (unsigned j = 0; j < 16; ++j) { const unsigned c = xb_ld(&bar[XB_XCNT(j)]); sum += c; cnt += (c > 0u) ? 1u : 0u; mine = (j == x) ? c : mine; }
        if (sum == G) break;
        __builtin_amdgcn_s_sleep(1);
        if ((++sp & 255u) == 0u) { if (xb_ld(&bar[XB_TMO])) break; if (sp > XB_SPIN_CAP) { atomicAdd(&bar[XB_TMO], 1u); break; } }
    }
    nloc = mine > 0u ? mine : 1u; nx = cnt > 0u ? cnt : 1u;
}
__device__ __forceinline__ void grid_bar(unsigned* bar, volatile LAS unsigned* st, unsigned G, int wv) {
    asm volatile("s_waitcnt vmcnt(0)" ::: "memory");
    __syncthreads();
    const int lane = lane_id_opaque();
    if (wv == 0 && lane == 0) {
        __builtin_amdgcn_s_waitcnt(0);
        const unsigned x = xb_xcc_id();
        unsigned nloc = st[0], nx = st[1];
        if (nloc == 0u) { xcd_barrier_complete(bar, x, G, nloc, nx); st[0] = nloc; st[1] = nx; }
        const unsigned old = xb_add(&bar[XB_XSUB(x)], 1u);
        const unsigned gen = old / nloc;
        if (old + 1u == (gen + 1u) * nloc) {
            __builtin_amdgcn_fence(__ATOMIC_RELEASE, "agent");
            asm volatile("s_waitcnt vmcnt(0)" ::: "memory");
            const unsigned og = xb_add(&bar[XB_TOP], 1u);
            const unsigned tg = og / nx;
            if (og + 1u == (tg + 1u) * nx) xb_add(&bar[XB_TOPGEN], 1u);
            else XB_SPIN(xb_ld(&bar[XB_TOPGEN]) == tg, bar);
            __builtin_amdgcn_fence(__ATOMIC_ACQUIRE, "agent");
            xb_add(&bar[XB_XGEN(x)], 1u);
            asm volatile("s_waitcnt vmcnt(0)" ::: "memory");
        } else {
            XB_SPIN(xb_ld(&bar[XB_XGEN(x)]) == gen, bar);
            __builtin_amdgcn_fence(__ATOMIC_ACQUIRE, "agent");
            asm volatile("s_waitcnt vmcnt(0)" ::: "memory");
        }
    }
    __syncthreads();
}
__device__ __forceinline__ void p6_finalize(const Ctx& C, int G, int bx, int wv) {
    int tid = (wv << 6) | lane_id_opaque(); asm volatile("" : "+v"(tid));
    unsigned* pcnt = (unsigned*)(C.ws + WS_PCNT); const float* ss3 = (const float*)(C.ws + WS_SS3); const float* wf = C.in[20]; float* out = C.out;
    for (int i = 0; ; ++i) {
        const int L = i * G + bx; if (L + G >= 64 * 8) break; int pm, pn; pg8::tile_of(L, 64, 8, pm, pn);
        if (tid == 0) { unsigned sp = 0; while (xb_ld(&pcnt[64 * pm]) < 8u) { __builtin_amdgcn_s_sleep(1); if (++sp > (1u << 20)) break; }
            __builtin_amdgcn_fence(__ATOMIC_ACQUIRE, "agent"); asm volatile("s_waitcnt vmcnt(0)" ::: "memory"); }
        __syncthreads();
        const int c4 = tid & 63; const f32x4 wv4 = *(const f32x4*)(wf + 256 * pn + 4 * c4);
#pragma unroll 1
        for (int k0 = 0; k0 < 32; k0 += 8) {
            f32x4 v[8]; float rr[8];
#pragma unroll
            for (int k = 0; k < 8; ++k) { const int row = 256 * pm + (tid >> 6) + 8 * (k0 + k);
                v[k] = *(const f32x4*)(out + (size_t)row * DM + 256 * pn + 4 * c4);
                rr[k] = __hip_atomic_load(ss3 + row, __ATOMIC_RELAXED, __HIP_MEMORY_SCOPE_AGENT); }
#pragma unroll
            for (int k = 0; k < 8; ++k) { const int row = 256 * pm + (tid >> 6) + 8 * (k0 + k); const float r = __builtin_amdgcn_rsqf(rr[k] * (1.0f / DM) + RMS_EPS);
                *(f32x4*)(out + (size_t)row * DM + 256 * pn + 4 * c4) = v[k] * r * wv4; }
        }
    }
}
struct Params { const float* in[21]; float* out; unsigned char* ws; };
__global__ void __launch_bounds__(512, 2) fwd_megakernel(Params prm) {
    extern __shared__ __attribute__((aligned(16))) unsigned char lds_raw[];
    LAS unsigned char* lds = (LAS unsigned char*)lds_raw;
    cg::grid_group grid = cg::this_grid();
    const int G = gridDim.x, bx = blockIdx.x;
    const int wv = __builtin_amdgcn_readfirstlane((int)(threadIdx.x >> 6));
    Ctx C;
#pragma unroll
    for (int i = 0; i < 21; ++i) C.in[i] = prm.in[i];
    C.out = prm.out; C.ws = prm.ws;
    unsigned char* ws = prm.ws;
    unsigned* gbar = (unsigned*)(ws + WS_BAR);
    volatile LAS unsigned* bst = (volatile LAS unsigned*)(lds + LDS_BYTES - 16);
#ifndef DUP_BAR
#define DUP_BAR 0
#endif
#define GBAR() do { for (int rb_ = 0; rb_ < 1 + DUP_BAR; ++rb_) grid_bar(gbar, bst, (unsigned)G, wv); } while (0)
    if (bx == 0) for (int i = threadIdx.x; i < XCD_BAR_WORDS; i += 512) gbar[i] = 0u;
    if (bx == 1 || G == 1) for (int i = threadIdx.x; i < 64 * 64; i += 512) ((unsigned*)(ws + WS_PCNT))[i] = 0u;
    if (threadIdx.x < 4) ((LAS unsigned*)(lds + LDS_BYTES - 16))[threadIdx.x] = 0u;
    grid.sync();
    if (threadIdx.x == 0) (void)xb_add(&gbar[XB_XCNT(xb_xcc_id())], 1u);
    for (int rep = 0; rep < 1 + DUP_P0; ++rep) { p0_prologue(C, lds, G, wv); __syncthreads(); }
    GBAR();
    for (int rep = 0; rep < 1 + DUP_FILT; ++rep) p1_filters(C, lds, G, wv);
    { HyProg P; P.K = DM; P.G = G; P.c = bx; P.W = (const bf16_t*)(ws + WS_WIN); P.X = (const bf16_t*)(ws + WS_XB); P.HY = (bf16_t*)(ws + WS_HY); P.r1 = (const float*)(ws + WS_R1S);
      pg8::gemm_stream(lds, P, wv); }
    for (int rep = 0; rep < 1 + DUP_REST; ++rep) { RestProg P; P.K = DM; P.G = G; P.c = bx; P.W = (const bf16_t*)(ws + WS_WIN); P.X = (const bf16_t*)(ws + WS_XB); P.R1A = (bf16_t*)(ws + WS_R1A); P.R1B = (bf16_t*)(ws + WS_R1B); P.R2 = (bf16_t*)prm.out; P.r1 = (const float*)(ws + WS_R1S);
      pg8::gemm_stream(lds, P, wv); }
    GBAR();
    for (int rep = 0; rep < 1 + DUP_PRE; ++rep) qk_prepass(C, G, wv);
    for (int rep = 0; rep < 1 + DUP_HY; ++rep) for (int idx = bx; idx < 1024; idx += G) { const int rd = idx >> 8, bb = idx & 255; hyena_item(C, lds, rd * 256 + (bb & 7) * 32 + (bb >> 3), wv); }
    GBAR();
    for (int rep = 0; rep < 1 + DUP_ML; ++rep) for (int item = bx; item < 256; item += G) mlstm_item(C, lds, item, wv);
    GBAR();
    { BranchProg P; P.K = 1024; P.G = G; P.c = bx; P.YA = (const bf16_t*)(ws + WS_YA); P.YBF = (const bf16_t*)(ws + WS_YBF); P.YBB = (const bf16_t*)(ws + WS_YBB);
      P.WA = (const bf16_t*)(ws + WS_WA); P.WB = (const bf16_t*)(ws + WS_WB); P.R2 = (const bf16_t*)prm.out; P.MIX = (bf16_t*)(ws + WS_MIX);
      pg8::gemm_stream(lds, P, wv); }
    GBAR();
    { ResProg<false> P; P.pcnt = nullptr; P.wf = nullptr; P.K = DM; P.G = G; P.c = bx; P.A = (const bf16_t*)(ws + WS_MIX); P.B = (const bf16_t*)(ws + WS_WOUT); P.base = prm.in[0]; P.base16 = nullptr; P.out = nullptr; P.outb = (bf16_t*)(ws + WS_X1B); P.ss = (float*)(ws + WS_SS2);
      pg8::gemm_stream(lds, P, wv); }
    GBAR();
    for (int rep = 0; rep < 1 + DUP_GU; ++rep) { GuProg P; P.K = DM; P.G = G; P.c = bx; P.X = (const bf16_t*)(ws + WS_X1B); P.W = (const bf16_t*)(ws + WS_WGU); P.HH = (bf16_t*)(ws + WS_HH); P.ss2 = (const float*)(ws + WS_SS2);
      pg8::gemm_stream(lds, P, wv); }
    GBAR();
    { ResProg<true> P; P.pcnt = (unsigned*)(ws + WS_PCNT); P.wf = prm.in[20]; P.K = FFH; P.G = G; P.c = bx; P.A = (const bf16_t*)(ws + WS_HH); P.B = (const bf16_t*)(ws + WS_WD); P.base = nullptr; P.base16 = (const bf16_t*)(ws + WS_X1B); P.out = prm.out; P.outb = nullptr; P.ss = (float*)(ws + WS_SS3);
      pg8::gemm_stream(lds, P, wv); }
    p6_finalize(C, G, bx, wv);
}

extern "C" void kernel_launch(void* const* d_in, const int* in_sizes, int n_in, void* d_out, int out_size, void* d_ws, size_t ws_size, hipStream_t stream) {
    static int grid = 0;
    if (grid == 0) {
        int dev = 0, cus = 0, per_cu = 0;
        hipGetDevice(&dev); hipDeviceGetAttribute(&cus, hipDeviceAttributeMultiprocessorCount, dev);
        if (hipFuncSetAttribute((const void*)fwd_megakernel, hipFuncAttributeMaxDynamicSharedMemorySize, LDS_BYTES) != hipSuccess) { fprintf(stderr, "kernel_launch: hipFuncSetAttribute failed\n"); grid = -1; return; }
        if (hipOccupancyMaxActiveBlocksPerMultiprocessor(&per_cu, (const void*)fwd_megakernel, 512, LDS_BYTES) != hipSuccess || per_cu < 1) { fprintf(stderr, "kernel_launch: occupancy query gave %d\n", per_cu); per_cu = 1; }
        (void)hipGetLastError();
        grid = cus * 1;
        if (n_in != 21 || ws_size < WS_END) { fprintf(stderr, "kernel_launch: unexpected n_in %d or ws %zu\n", n_in, ws_size); grid = -1; return; }
    }
    if (grid < 0) return;
    Params p{};
    for (int i = 0; i < 21; ++i) p.in[i] = (const float*)d_in[i];
    p.out = (float*)d_out; p.ws = (unsigned char*)d_ws;
    void* args[] = {&p};
    hipError_t e = hipLaunchCooperativeKernel((const void*)fwd_megakernel, dim3(grid), dim3(512), args, LDS_BYTES, stream);
    if (e != hipSuccess) fprintf(stderr, "cooperative launch failed: %s (grid %d)\n", hipGetErrorString(e), grid);
}
```

```cpp
#include <hip/hip_runtime.h>
#include <hip/hip_cooperative_groups.h>
#include <cstdio>
namespace cg = cooperative_groups;

#define LAS __attribute__((address_space(3)))
typedef unsigned short bf16_t;
typedef short bf16x8 __attribute__((ext_vector_type(8)));
typedef short bf16x4 __attribute__((ext_vector_type(4)));
typedef float f32x4 __attribute__((ext_vector_type(4)));
typedef float f32x2 __attribute__((ext_vector_type(2)));
typedef unsigned u32x4 __attribute__((ext_vector_type(4)));
typedef unsigned u32x2 __attribute__((ext_vector_type(2)));

constexpr int NB = 4, SEQ = 4096, TOK = NB * SEQ, DM = 2048, HW = 1024, MW = 1024, NHEAD = 4, DH = 256, FFH = 5632;
constexpr int CONVC = 5120, INCOLS = 11280, NFILT = 4096;
constexpr float RMS_EPS = 1e-6f;
constexpr size_t MiB = 1u << 20;
constexpr size_t WS_PCNT = 393216, WS_BAR = 262144, WS_R1S = 0, WS_SS2 = 65536, WS_SS3 = 131072, WS_G = 1 * MiB, WS_H2 = 2 * MiB;
constexpr size_t WS_WA = 4 * MiB, WS_WB = 8 * MiB, WS_WOUT = 12 * MiB, WS_WGU = 20 * MiB, WS_WD = 64 * MiB, WS_WIN = 86 * MiB, WS_XB = 130 * MiB;
constexpr size_t WS_FILT = 194 * MiB, WS_HY = 258 * MiB, WS_R1A = 354 * MiB, WS_R1B = 418 * MiB, WS_END = 494 * MiB;
constexpr size_t WS_QKP = 86 * MiB, WS_YA = 150 * MiB, WS_YBF = 354 * MiB, WS_YBB = 386 * MiB, WS_X1B = 86 * MiB, WS_MIX = 194 * MiB, WS_HH = 258 * MiB;
constexpr size_t WS_GSC = 482 * MiB;
constexpr int LDS_BYTES = 155648;

__device__ __forceinline__ unsigned f2bf(float f) { unsigned u = __float_as_uint(f); return (u + 0x7fffu + ((u >> 16) & 1u)) >> 16; }
__device__ __forceinline__ unsigned pk2(float lo, float hi) { unsigned r; asm volatile("v_cvt_pk_bf16_f32 %0, %1, %2" : "=v"(r) : "v"(lo), "v"(hi)); return r; }
__device__ __forceinline__ float bflo(unsigned w) { return __uint_as_float(w << 16); }
__device__ __forceinline__ float bfhi(unsigned w) { return __uint_as_float(w & 0xffff0000u); }
__device__ __forceinline__ float wave_sum(float v) {
#pragma unroll
    for (int o = 1; o < 64; o <<= 1) v += __shfl_xor(v, o);
    return v;
}
__device__ __forceinline__ size_t blk_off(int row, int k, int K) { return ((size_t)(row >> 7) * (size_t)(K >> 6) + (size_t)(k >> 6)) * 8192 + (size_t)((row & 127) * 64 + (k & 63)); }
__device__ __forceinline__ int lane_id_opaque() { int l; asm volatile("v_mbcnt_lo_u32_b32 %0, -1, 0\n\tv_mbcnt_hi_u32_b32 %0, -1, %0" : "=v"(l)); return l; }
__device__ __forceinline__ float sigmoidf_(float x) { return __builtin_amdgcn_rcpf(1.0f + __expf(-x)); }
__device__ __forceinline__ float siluf_(float x) { return x * __builtin_amdgcn_rcpf(1.0f + __expf(-x)); }

namespace pg8 {
constexpr int BM = 256, BK = 64, HALF = 128, HTB = HALF * BK * 2, STAGE_BYTES = 8 * HTB, NXCD = 8, WGM = 8;
__device__ __forceinline__ int lds_byte(int r, int c) { const int st = (r >> 4) * 2 + (c >> 5), rr = r & 15, cc = c & 31, ob = rr * 64 + cc * 2; return st * 1024 + (ob ^ (((ob >> 9) & 1) << 5)); }
__device__ __forceinline__ void stage_rc(int b, int& R, int& C) { const int st = b / 1024, sb = b % 1024, swz = sb ^ (((sb >> 9) & 1) << 5); R = (st >> 1) * 16 + swz / 64; C = (st & 1) * 32 + (swz % 64) / 2; }
__device__ __forceinline__ int perm32(int rho) { const int n = rho >> 4, i = rho & 15; return 8 * (i >> 2) + 4 * n + (i & 3); }
struct GUnit { const char* A; const char* B; int pm, pn, sub; };
__device__ __forceinline__ void tile_of(int L, int nM, int nN, int& pm, int& pn) {
    const int nwg = nM * nN; int wgid = L; { const int q = nwg / NXCD, r = nwg % NXCD, xcd = wgid % NXCD, off = wgid / NXCD; wgid = (xcd < r ? xcd * (q + 1) : r * (q + 1) + (xcd - r) * q) + off; }
    const int nig = WGM * nN, gid = wgid / nig, fm = gid * WGM, gsz = (nM - fm) < WGM ? (nM - fm) : WGM;
    pm = fm + ((wgid % nig) % gsz); pn = (wgid % nig) / gsz;
}
typedef f32x4 Acc[2][2][4][2];
template <class Prog>
__device__ __forceinline__ void gemm_stream(LAS unsigned char* lds, const Prog& P, int wv) {
    int tid = (wv << 6) | lane_id_opaque(); asm volatile("" : "+v"(tid));
    const int wid = __builtin_amdgcn_readfirstlane(tid >> 6), lane = tid & 63, wr = wid >> 2, wc = wid & 3, fr = lane & 15, fq = lane >> 4;
    const int K = P.K, nt = K / BK;
    unsigned voffA[2], voffB[2];
#pragma unroll
    for (int i = 0; i < 2; ++i) { int R, C; stage_rc(tid * 16 + i * 8192, R, C); const int Rb = Prog::PERM ? ((R & ~31) + perm32(R & 31)) : R;
        voffA[i] = (unsigned)(R * 64 + C) * 2u; voffB[i] = (unsigned)(Rb * 64 + C) * 2u; }
    const size_t kstep = (size_t)(HALF * BK * 2);
    const size_t hstep = (size_t)HALF * K * 2;
    const unsigned ldsw = (unsigned)wid * 1024u;
    const int aoff = lds_byte(wr * 64 + fr, fq * 8), boff = lds_byte(wc * 32 + fr, fq * 8);
#define PG8_SA(b, h) (((b) * 2 + (h)) * HTB)
#define PG8_SB(b, h) ((4 + (b) * 2 + (h)) * HTB)
#define PG8_STAGE(bufoff, gbase, voff) do { _Pragma("unroll") for (int _i = 0; _i < 2; ++_i) \
        __builtin_amdgcn_global_load_lds((const unsigned*)((const char*)(gbase) + (voff)[_i]), (LAS unsigned*)(lds + (bufoff) + ldsw + _i * 8192), 16, 0, 0); } while (0)
#define PG8_LDA(dst, b, h) do { _Pragma("unroll") for (int m = 0; m < 4; ++m) _Pragma("unroll") for (int k = 0; k < 2; ++k) dst[m][k] = *(const LAS bf16x8*)(lds + PG8_SA(b, h) + aoff + m * 2048 + k * 1024); } while (0)
#define PG8_LDB(dst, b, h) do { _Pragma("unroll") for (int n = 0; n < 2; ++n) _Pragma("unroll") for (int k = 0; k < 2; ++k) dst[n][k] = *(const LAS bf16x8*)(lds + PG8_SB(b, h) + boff + n * 2048 + k * 1024); } while (0)
#define PG8_MMA(ai, bj, At, Bt) do { __builtin_amdgcn_s_setprio(1); _Pragma("unroll") for (int m = 0; m < 4; ++m) _Pragma("unroll") for (int n = 0; n < 2; ++n) _Pragma("unroll") for (int k = 0; k < 2; ++k) \
        acc[ai][bj][m][n] = __builtin_amdgcn_mfma_f32_16x16x32_bf16(Bt[n][k], At[m][k], acc[ai][bj][m][n], 0, 0, 0); __builtin_amdgcn_s_setprio(0); } while (0)
#define PG8_WAIT_V(n) asm volatile("s_waitcnt vmcnt(" #n ")" ::: "memory")
#define PG8_WAIT_L(n) asm volatile("s_waitcnt lgkmcnt(" #n ")" ::: "memory")
#define PG8_BAR __builtin_amdgcn_s_barrier()
#define PG8_SCHED __builtin_amdgcn_sched_barrier(0)
    GUnit cur, nxt; int ui = 0;
    if (!P.next(0, cur)) return;
    f32x4 acc[2][2][4][2];
#pragma unroll
    for (int a = 0; a < 2; ++a)
#pragma unroll
        for (int b = 0; b < 2; ++b)
#pragma unroll
            for (int m = 0; m < 4; ++m)
#pragma unroll
                for (int n = 0; n < 2; ++n) acc[a][b][m][n] = (f32x4){0.f, 0.f, 0.f, 0.f};
    bf16x8 At[4][2], B0[2][2], B1[2][2];
    const char* cA = cur.A; const char* cB = cur.B;
    PG8_STAGE(PG8_SB(0, 0), cB, voffB); PG8_STAGE(PG8_SA(0, 0), cA, voffA); PG8_STAGE(PG8_SB(0, 1), cB + hstep, voffB); PG8_STAGE(PG8_SA(0, 1), cA + hstep, voffA);
    if (wr == 1) PG8_BAR;
    PG8_WAIT_V(4); PG8_BAR;
    PG8_STAGE(PG8_SB(1, 0), cB + kstep, voffB); PG8_STAGE(PG8_SA(1, 0), cA + kstep, voffA); PG8_STAGE(PG8_SB(1, 1), cB + hstep + kstep, voffB);
    PG8_WAIT_V(6); PG8_BAR;
    for (;;) {
        const bool has_next = P.next(ui + 1, nxt);
        const char* nA = has_next ? nxt.A : cA; const char* nB = has_next ? nxt.B : cB;
        for (int t = 0; t < nt; t += 2) {
            const bool last = (t == nt - 2);
            const char* a1 = cA + (size_t)(t + 1) * kstep;
            const char* a2 = last ? nA : cA + (size_t)(t + 2) * kstep; const char* b2 = last ? nB : cB + (size_t)(t + 2) * kstep;
            const char* a3 = a2 + kstep; const char* b3 = b2 + kstep;
            PG8_LDB(B0, 0, 0); PG8_SCHED; PG8_LDA(At, 0, 0); PG8_STAGE(PG8_SA(1, 1), a1 + hstep, voffA);
            PG8_WAIT_L(8); PG8_BAR; PG8_WAIT_L(0); PG8_MMA(0, 0, At, B0); PG8_BAR; PG8_SCHED;
            PG8_LDB(B1, 0, 1); PG8_STAGE(PG8_SB(0, 0), b2, voffB);
            PG8_BAR; PG8_WAIT_L(0); PG8_MMA(0, 1, At, B1); PG8_BAR;
            PG8_LDA(At, 0, 1); PG8_STAGE(PG8_SA(0, 0), a2, voffA);
            PG8_BAR; PG8_WAIT_L(0); PG8_MMA(1, 0, At, B0); PG8_BAR; PG8_SCHED;
            PG8_STAGE(PG8_SB(0, 1), b2 + hstep, voffB);
            PG8_WAIT_V(6); PG8_BAR; PG8_MMA(1, 1, At, B1); PG8_BAR;
            PG8_LDB(B0, 1, 0); PG8_SCHED; PG8_LDA(At, 1, 0); PG8_STAGE(PG8_SA(0, 1), a2 + hstep, voffA);
            PG8_WAIT_L(8); PG8_BAR; PG8_WAIT_L(0); PG8_MMA(0, 0, At, B0); PG8_BAR; PG8_SCHED;
            PG8_LDB(B1, 1, 1); PG8_STAGE(PG8_SB(1, 0), b3, voffB);
            PG8_BAR; PG8_WAIT_L(0); PG8_MMA(0, 1, At, B1); PG8_BAR;
            PG8_LDA(At, 1, 1); PG8_STAGE(PG8_SA(1, 0), a3, voffA);
            PG8_BAR; PG8_WAIT_L(0); PG8_MMA(1, 0, At, B0); PG8_BAR; PG8_SCHED;
            PG8_STAGE(PG8_SB(1, 1), b3 + hstep, voffB);
            PG8_WAIT_V(6); PG8_BAR; PG8_MMA(1, 1, At, B1); PG8_BAR;
        }
        if (Prog::FUSE_LAST && !has_next) break;
        P.epi(acc, cur, wr, wc, fr, fq);
        if (!has_next) break;
        cur = nxt; cA = nA; cB = nB; ++ui;
    }
    PG8_WAIT_V(0);
    if (wr == 0) PG8_BAR;
    PG8_BAR;
    if constexpr (Prog::FUSE_LAST) P.epi_last(acc, cur, wr, wc, fr, fq, wv);
#undef PG8_SA
#undef PG8_SB
#undef PG8_STAGE
#undef PG8_LDA
#undef PG8_LDB
#undef PG8_MMA
#undef PG8_WAIT_V
#undef PG8_WAIT_L
#undef PG8_BAR
#undef PG8_SCHED
}
__device__ __forceinline__ void zero_acc(Acc& acc) {
#pragma unroll
    for (int a = 0; a < 2; ++a)
#pragma unroll
        for (int b = 0; b < 2; ++b)
#pragma unroll
            for (int m = 0; m < 4; ++m)
#pragma unroll
                for (int n = 0; n < 2; ++n) acc[a][b][m][n] = (f32x4){0.f, 0.f, 0.f, 0.f};
}
}
using pg8::GUnit; using pg8::Acc;
__device__ __forceinline__ void unpack8(u32x4 w, float (&f)[8]) { f[0] = bflo(w.x); f[1] = bfhi(w.x); f[2] = bflo(w.y); f[3] = bfhi(w.y); f[4] = bflo(w.z); f[5] = bfhi(w.z); f[6] = bflo(w.w); f[7] = bfhi(w.w); }
struct HyProg {
    static constexpr bool FUSE_LAST = false; static constexpr bool PERM = true; int K, G, c; const bf16_t* W; const bf16_t* X; bf16_t* HY; const float* r1;
    __device__ __forceinline__ bool next(int i, GUnit& u) const { const int L = i * G + c; if (L >= 12 * 64) return false; pg8::tile_of(L, 12, 64, u.pm, u.pn);
        u.A = (const char*)(W + (size_t)u.pm * 256 * DM); u.B = (const char*)(X + (size_t)u.pn * 256 * DM); u.sub = 0; return true; }
    __device__ __forceinline__ void epi(Acc& acc, const GUnit& u, int wr, int wc, int fr, int fq) const {
        const int row0 = u.pm * 256 + wr * 64 + fr, col0 = u.pn * 256 + wc * 32 + 8 * fq;
        f32x4 sc[2][2];
#pragma unroll
        for (int bj = 0; bj < 2; ++bj) { sc[bj][0] = *(const f32x4*)(r1 + col0 + bj * 128); sc[bj][1] = *(const f32x4*)(r1 + col0 + bj * 128 + 4); }
#pragma unroll
        for (int ai = 0; ai < 2; ++ai)
#pragma unroll
            for (int m = 0; m < 4; ++m) { bf16_t* rowp = HY + (size_t)(row0 + ai * 128 + m * 16) * TOK + col0;
#pragma unroll
                for (int bj = 0; bj < 2; ++bj) { const f32x4 v0 = acc[ai][bj][m][0] * sc[bj][0], v1 = acc[ai][bj][m][1] * sc[bj][1];
                    u32x4 w; w.x = pk2(v0[0], v0[1]); w.y = pk2(v0[2], v0[3]); w.z = pk2(v1[0], v1[1]); w.w = pk2(v1[2], v1[3]);
                    *(u32x4*)(rowp + bj * 128) = w; } }
        pg8::zero_acc(acc);
    }
};
struct RestProg {
    static constexpr bool FUSE_LAST = false; static constexpr bool PERM = true; int K, G, c; const bf16_t* W; const bf16_t* X; bf16_t* R1A; bf16_t* R1B; bf16_t* R2; const float* r1;
    __device__ __forceinline__ bool next(int i, GUnit& u) const { const int L = i * G + c; if (L >= 64 * 32) return false; pg8::tile_of(L, 64, 32, u.pm, u.pn);
        u.A = (const char*)(X + (size_t)u.pm * 256 * DM); u.B = (const char*)(W + (size_t)(3072 + u.pn * 256) * DM); u.sub = 0; return true; }
    __device__ __forceinline__ void epi(Acc& acc, const GUnit& u, int wr, int wc, int fr, int fq) const {
        const int row0 = u.pm * 256 + wr * 64 + fr; const bool sg = u.pn >= 12;
        bf16_t* base = u.pn < 8 ? R1A + u.pn * 256 : (u.pn < 16 ? R1B + (u.pn - 8) * 256 : R2 + (u.pn - 16) * 256);
        const int pitch = u.pn < 16 ? 2048 : 4096;
        const int col0 = wc * 32 + 8 * fq;
        float rs[2][4];
#pragma unroll
        for (int ai = 0; ai < 2; ++ai)
#pragma unroll
            for (int m = 0; m < 4; ++m) rs[ai][m] = r1[row0 + ai * 128 + m * 16];
#pragma unroll
        for (int ai = 0; ai < 2; ++ai)
#pragma unroll
            for (int m = 0; m < 4; ++m) { const int row = row0 + ai * 128 + m * 16; const float s = rs[ai][m]; bf16_t* rowp = base + (size_t)row * pitch + col0;
#pragma unroll
                for (int bj = 0; bj < 2; ++bj) { f32x4 v0 = acc[ai][bj][m][0] * s, v1 = acc[ai][bj][m][1] * s;
                    if (sg) {
#pragma unroll
                        for (int j = 0; j < 4; ++j) { v0[j] = sigmoidf_(v0[j]); v1[j] = sigmoidf_(v1[j]); } }
                    u32x4 w; w.x = pk2(v0[0], v0[1]); w.y = pk2(v0[2], v0[3]); w.z = pk2(v1[0], v1[1]); w.w = pk2(v1[2], v1[3]);
                    *(u32x4*)(rowp + bj * 128) = w; } }
        pg8::zero_acc(acc);
    }
};
struct BranchProg {
    static constexpr bool FUSE_LAST = false; static constexpr bool PERM = true; int K, G, c; const bf16_t *YA, *YBF, *YBB, *WA, *WB; const bf16_t* R2; bf16_t* MIX;
    __device__ __forceinline__ bool next(int i, GUnit& u) const { const int ti = i / 3, sub = i - 3 * ti; const int L = ti * G + c; if (L >= 64 * 8) return false; pg8::tile_of(L, 64, 8, u.pm, u.pn);
        const bf16_t* a = sub == 0 ? YA : (sub == 1 ? YBF : YBB); const bf16_t* b = sub == 0 ? WA : WB;
        u.A = (const char*)(a + (size_t)u.pm * 256 * 1024); u.B = (const char*)(b + (size_t)u.pn * 256 * 1024); u.sub = sub; return true; }
    __device__ __forceinline__ void epi(Acc& acc, const GUnit& u, int wr, int wc, int fr, int fq) const {
        if (u.sub == 1) return;
        const int row0 = u.pm * 256 + wr * 64 + fr, col0 = u.pn * 256 + wc * 32 + 8 * fq;
#pragma unroll
        for (int ai = 0; ai < 2; ++ai) {
            u32x4 gbw[4][2], gaw[4][2];
#pragma unroll
            for (int m = 0; m < 4; ++m)
#pragma unroll
                for (int bj = 0; bj < 2; ++bj) { const bf16_t* gp = R2 + (size_t)(row0 + ai * 128 + m * 16) * 4096 + col0 + bj * 128;
                    gbw[m][bj] = *(const u32x4*)(gp + 2048); if (u.sub == 0) gaw[m][bj] = *(const u32x4*)gp; else gaw[m][bj] = gbw[m][bj]; }
#pragma unroll
            for (int m = 0; m < 4; ++m) { const int row = row0 + ai * 128 + m * 16;
#pragma unroll
                for (int bj = 0; bj < 2; ++bj) {
                    float gb[8], ga[8]; unpack8(gbw[m][bj], gb); unpack8(gaw[m][bj], ga);
                    if (u.sub == 0) {
#pragma unroll
                        for (int j = 0; j < 4; ++j) { acc[ai][bj][m][0][j] *= ga[j] * __builtin_amdgcn_rcpf(fmaxf(gb[j], 1e-30f)); acc[ai][bj][m][1][j] *= ga[4 + j] * __builtin_amdgcn_rcpf(fmaxf(gb[4 + j], 1e-30f)); }
                    } else {
                        f32x4 v0 = acc[ai][bj][m][0], v1 = acc[ai][bj][m][1];
#pragma unroll
                        for (int j = 0; j < 4; ++j) { v0[j] *= fmaxf(gb[j], 1e-30f); v1[j] *= fmaxf(gb[4 + j], 1e-30f); }
                        u32x4 w; w.x = pk2(v0[0], v0[1]); w.y = pk2(v0[2], v0[3]); w.z = pk2(v1[0], v1[1]); w.w = pk2(v1[2], v1[3]);
                        *(u32x4*)(MIX + blk_off(row, col0 + bj * 128, DM)) = w;
                    } } }
        }
        if (u.sub == 2) pg8::zero_acc(acc);
    }
};
template <bool FUSE> struct ResProg {
    static constexpr bool PERM = false, FUSE_LAST = FUSE; int K, G, c; unsigned* pcnt; const float* wf; const bf16_t* A; const bf16_t* B; const float* base; const bf16_t* base16; float* out; bf16_t* outb; float* ss;
    __device__ __forceinline__ bool next(int i, GUnit& u) const { const int L = i * G + c; if (L >= 64 * 8) return false; pg8::tile_of(L, 64, 8, u.pm, u.pn);
        u.A = (const char*)(A + (size_t)u.pm * 256 * K); u.B = (const char*)(B + (size_t)u.pn * 256 * K); u.sub = 0; return true; }
    __device__ __forceinline__ void epi(Acc& acc, const GUnit& u, int wr, int wc, int fr, int fq) const {
        const int row0 = u.pm * 256 + wr * 64 + fr, col0 = u.pn * 256 + wc * 32 + 4 * fq;
#pragma unroll
        for (int ai = 0; ai < 2; ++ai) {
            f32x4 bs[4][2][2];
#pragma unroll
            for (int m = 0; m < 4; ++m)
#pragma unroll
                for (int bj = 0; bj < 2; ++bj)
#pragma unroll
                    for (int n = 0; n < 2; ++n) { const int row = row0 + ai * 128 + m * 16, col = col0 + bj * 128 + n * 16;
                        if (base16) { const u32x2 w = *(const u32x2*)(base16 + blk_off(row, col, DM)); bs[m][bj][n] = (f32x4){bflo(w.x), bfhi(w.x), bflo(w.y), bfhi(w.y)}; }
                        else bs[m][bj][n] = *(const f32x4*)(base + (size_t)row * DM + col); }
#pragma unroll
            for (int m = 0; m < 4; ++m) { const int row = row0 + ai * 128 + m * 16; const size_t off = (size_t)row * DM + col0; float s = 0.f;
#pragma unroll
                for (int bj = 0; bj < 2; ++bj)
#pragma unroll
                    for (int n = 0; n < 2; ++n) { const f32x4 o = bs[m][bj][n] + acc[ai][bj][m][n];
                        if (out) *(f32x4*)(out + off + bj * 128 + n * 16) = o;
                        s += (o[0] * o[0] + o[1] * o[1]) + (o[2] * o[2] + o[3] * o[3]);
                        if (outb) { u32x2 w; w.x = pk2(o[0], o[1]); w.y = pk2(o[2], o[3]); *(u32x2*)(outb + blk_off(row, col0 + bj * 128 + n * 16, DM)) = w; } }
                s += __shfl_xor(s, 16); s += __shfl_xor(s, 32);
                if (fq == 0) unsafeAtomicAdd(ss + row, s); }
        }
        pg8::zero_acc(acc);
    }
    __device__ __forceinline__ void epi_last(Acc& acc, const GUnit& u, int wr, int wc, int fr, int fq, int wv) const {
        const int row0 = u.pm * 256 + wr * 64 + fr, col0 = u.pn * 256 + wc * 32 + 4 * fq;
#pragma unroll
        for (int ai = 0; ai < 2; ++ai) {
            u32x2 bw[4][2][2];
#pragma unroll
            for (int m = 0; m < 4; ++m)
#pragma unroll
                for (int bj = 0; bj < 2; ++bj)
#pragma unroll
                    for (int n = 0; n < 2; ++n) bw[m][bj][n] = *(const u32x2*)(base16 + blk_off(row0 + ai * 128 + m * 16, col0 + bj * 128 + n * 16, DM));
#pragma unroll
            for (int m = 0; m < 4; ++m) { const int row = row0 + ai * 128 + m * 16; float s = 0.f;
#pragma unroll
                for (int bj = 0; bj < 2; ++bj)
#pragma unroll
                    for (int n = 0; n < 2; ++n) { const u32x2 w = bw[m][bj][n]; const f32x4 o = (f32x4){bflo(w.x), bfhi(w.x), bflo(w.y), bfhi(w.y)} + acc[ai][bj][m][n];
                        acc[ai][bj][m][n] = o; s += (o[0] * o[0] + o[1] * o[1]) + (o[2] * o[2] + o[3] * o[3]); }
                s += __shfl_xor(s, 16); s += __shfl_xor(s, 32);
                if (fq == 0) unsafeAtomicAdd(ss + row, s); }
        }
        asm volatile("s_waitcnt vmcnt(0)" ::: "memory");
        __syncthreads();
        const int lane = lane_id_opaque();
        if (wv == 0 && lane == 0) {
            __builtin_amdgcn_fence(__ATOMIC_RELEASE, "agent"); asm volatile("s_waitcnt vmcnt(0)" ::: "memory");
            for (int i = 0; ; ++i) { const int L = i * G + c; if (L >= 64 * 8) break; int pm, pn; pg8::tile_of(L, 64, 8, pm, pn); __hip_atomic_fetch_add(&pcnt[64 * pm], 1u, __ATOMIC_RELAXED, __HIP_MEMORY_SCOPE_AGENT); }
            unsigned sp = 0; while (__hip_atomic_load(&pcnt[64 * u.pm], __ATOMIC_RELAXED, __HIP_MEMORY_SCOPE_AGENT) < 8u) { __builtin_amdgcn_s_sleep(1); if (++sp > (1u << 20)) break; }
            __builtin_amdgcn_fence(__ATOMIC_ACQUIRE, "agent"); asm volatile("s_waitcnt vmcnt(0)" ::: "memory");
        }
        __syncthreads();
        f32x4 wv4[2][2];
#pragma unroll
        for (int bj = 0; bj < 2; ++bj)
#pragma unroll
            for (int n = 0; n < 2; ++n) wv4[bj][n] = *(const f32x4*)(wf + col0 + bj * 128 + n * 16);
        float rr[2][4];
#pragma unroll
        for (int ai = 0; ai < 2; ++ai)
#pragma unroll
            for (int m = 0; m < 4; ++m) rr[ai][m] = __hip_atomic_load(ss + row0 + ai * 128 + m * 16, __ATOMIC_RELAXED, __HIP_MEMORY_SCOPE_AGENT);
#pragma unroll
        for (int ai = 0; ai < 2; ++ai)
#pragma unroll
            for (int m = 0; m < 4; ++m) { const int row = row0 + ai * 128 + m * 16; const float r = __builtin_amdgcn_rsqf(rr[ai][m] * (1.0f / DM) + RMS_EPS);
#pragma unroll
                for (int bj = 0; bj < 2; ++bj)
#pragma unroll
                    for (int n = 0; n < 2; ++n) *(f32x4*)(out + (size_t)row * DM + col0 + bj * 128 + n * 16) = acc[ai][bj][m][n] * r * wv4[bj][n]; }
    }
};
struct GuProg {
    static constexpr bool FUSE_LAST = false; static constexpr bool PERM = true; int K, G, c; const bf16_t* X; const bf16_t* W; bf16_t* HH; const float* ss2;
    __device__ __forceinline__ bool next(int i, GUnit& u) const { const int L = i * G + c; if (L >= 64 * 44) return false; pg8::tile_of(L, 64, 44, u.pm, u.pn);
        u.A = (const char*)(X + (size_t)u.pm * 256 * DM); u.B = (const char*)(W + (size_t)u.pn * 256 * DM); u.sub = 0; return true; }
    __device__ __forceinline__ void epi(Acc& acc, const GUnit& u, int wr, int wc, int fr, int fq) const {
        const int row0 = u.pm * 256 + wr * 64 + fr, col0 = u.pn * 128 + wc * 32 + 8 * fq;
        float sq[2][4];
#pragma unroll
        for (int ai = 0; ai < 2; ++ai)
#pragma unroll
            for (int m = 0; m < 4; ++m) sq[ai][m] = ss2[row0 + ai * 128 + m * 16];
#pragma unroll
        for (int ai = 0; ai < 2; ++ai)
#pragma unroll
            for (int m = 0; m < 4; ++m) { const int row = row0 + ai * 128 + m * 16; const float r2 = __builtin_amdgcn_rsqf(sq[ai][m] * (1.0f / DM) + RMS_EPS);
                float hv[8];
#pragma unroll
                for (int n = 0; n < 2; ++n)
#pragma unroll
                    for (int j = 0; j < 4; ++j) { const float g = acc[ai][0][m][n][j] * r2, uu = acc[ai][1][m][n][j] * r2; hv[4 * n + j] = siluf_(g) * uu; }
                u32x4 w; w.x = pk2(hv[0], hv[1]); w.y = pk2(hv[2], hv[3]); w.z = pk2(hv[4], hv[5]); w.w = pk2(hv[6], hv[7]);
                *(u32x4*)(HH + blk_off(row, col0, FFH)) = w; }
        pg8::zero_acc(acc);
    }
};
struct Ctx {
    const float* in[21]; float* out; unsigned char* ws;
};
struct TpItem { const float* W; const float* ks; bf16_t* WT; int Nsrc, K, dst_row0, src_col0, kb; };
__device__ __forceinline__ TpItem tp_decode(const Ctx& C, int it) {
    constexpr int I_IN = 32 * 352, I_A = 16 * 64, I_O = 32 * 64, I_GU = 32 * 352;
    unsigned char* ws = C.ws; TpItem t; int r = it;
    if (r < I_IN) { const int nb = r % 352, n0 = nb * 32; t.W = C.in[2]; t.ks = C.in[1]; t.WT = (bf16_t*)(ws + WS_WIN); t.Nsrc = INCOLS; t.K = DM; t.dst_row0 = n0; t.src_col0 = n0 < 7168 ? n0 : n0 + 16; t.kb = r / 352; return t; } r -= I_IN;
    if (r < I_A) { t.W = C.in[14]; t.ks = nullptr; t.WT = (bf16_t*)(ws + WS_WA); t.Nsrc = DM; t.K = HW; t.dst_row0 = (r % 64) * 32; t.src_col0 = t.dst_row0; t.kb = r / 64; return t; } r -= I_A;
    if (r < I_A) { t.W = C.in[15]; t.ks = nullptr; t.WT = (bf16_t*)(ws + WS_WB); t.Nsrc = DM; t.K = MW; t.dst_row0 = (r % 64) * 32; t.src_col0 = t.dst_row0; t.kb = r / 64; return t; } r -= I_A;
    if (r < I_O) { t.W = C.in[16]; t.ks = nullptr; t.WT = (bf16_t*)(ws + WS_WOUT); t.Nsrc = DM; t.K = DM; t.dst_row0 = (r % 64) * 32; t.src_col0 = t.dst_row0; t.kb = r / 64; return t; } r -= I_O;
    if (r < I_GU) { const int nb = r % 352, n0 = nb * 32; const int pn = n0 >> 8, half = (n0 >> 7) & 1, i = n0 & 127;
        t.W = C.in[18]; t.ks = C.in[17]; t.WT = (bf16_t*)(ws + WS_WGU); t.Nsrc = 2 * FFH; t.K = DM; t.dst_row0 = n0; t.src_col0 = half * FFH + 128 * pn + i; t.kb = r / 352; return t; } r -= I_GU;
    t.W = C.in[19]; t.ks = nullptr; t.WT = (bf16_t*)(ws + WS_WD); t.Nsrc = DM; t.K = FFH; t.dst_row0 = (r % 64) * 32; t.src_col0 = t.dst_row0; t.kb = r / 64; return t;
}
__device__ __forceinline__ void tp_load(const TpItem& t, int lane, float (&tv)[32], float (&sv)[32]) {
    const int k0 = 64 * t.kb; const float* wp = t.W + (size_t)(k0 + (lane >> 5)) * t.Nsrc + t.src_col0 + (lane & 31);
#pragma unroll
    for (int i = 0; i < 32; ++i) tv[i] = wp[(size_t)(2 * i) * t.Nsrc];
    const float* kp = t.ks ? t.ks + k0 + (lane >> 5) : nullptr;
#pragma unroll
    for (int i = 0; i < 32; ++i) sv[i] = kp ? kp[2 * i] : 1.0f;
}
__device__ __forceinline__ void p0_prologue(const Ctx& C, LAS unsigned char* lds, int G, int wv) {
    int tid = (wv << 6) | lane_id_opaque(); asm volatile("" : "+v"(tid));
    const int lane = tid & 63, wave = __builtin_amdgcn_readfirstlane(tid >> 6);
    const int gw = blockIdx.x * 8 + wave, NGW = G * 8;
    unsigned char* ws = C.ws;
    LAS float* scr = (LAS float*)(lds + 67584 + wave * 8704);
    {
        constexpr int WGP = 2056;
        LAS bf16_t* wgb = (LAS bf16_t*)lds;
        const float* w_in = C.in[2]; const float* nw = C.in[1];
#pragma unroll 1
        for (int i0 = tid; i0 < DM * 16; i0 += 512 * 16) { float tw[16], tn[16];
#pragma unroll
            for (int u = 0; u < 16; ++u) { const int i = i0 + 512 * u, k = i >> 4, g = i & 15; tw[u] = w_in[(size_t)k * INCOLS + 7168 + g]; tn[u] = nw[k]; }
#pragma unroll
            for (int u = 0; u < 16; ++u) { const int i = i0 + 512 * u, k = i >> 4, g = i & 15; wgb[g * WGP + k] = (bf16_t)f2bf(tw[u] * tn[u]); } }
        __syncthreads();
    }

    {
        constexpr int NIT = 32 * 352 + 2 * 16 * 64 + 32 * 64 + 32 * 352 + 88 * 64;
        float tv[32], sv[32]; TpItem cur, nxt; int it = gw;
        if (it < NIT) { cur = tp_decode(C, it); tp_load(cur, lane, tv, sv); }
        while (it < NIT) {
#pragma unroll
            for (int i = 0; i < 32; ++i) scr[(2 * i + (lane >> 5)) * 33 + (lane & 31)] = tv[i] * sv[i];
            asm volatile("s_waitcnt lgkmcnt(0)" ::: "memory");
            const int nit = it + NGW;
            if (nit < NIT) { nxt = tp_decode(C, nit); tp_load(nxt, lane, tv, sv); }
            const int c = lane & 7, k0 = 64 * cur.kb;
#pragma unroll
            for (int j = 0; j < 4; ++j) { const int n = (lane >> 3) + 8 * j; const LAS float* sp = scr + (8 * c) * 33 + n;
                u32x4 o; o.x = pk2(sp[0 * 33], sp[1 * 33]); o.y = pk2(sp[2 * 33], sp[3 * 33]); o.z = pk2(sp[4 * 33], sp[5 * 33]); o.w = pk2(sp[6 * 33], sp[7 * 33]);
                *(u32x4*)(cur.WT + blk_off(cur.dst_row0 + n, k0 + 8 * c, cur.K)) = o; }
            asm volatile("s_waitcnt lgkmcnt(0)" ::: "memory");
            cur = nxt; it = nit;
        }
    }
    for (int i = blockIdx.x * 512 + tid; i < TOK; i += G * 512) { ((float*)(ws + WS_SS2))[i] = 0.f; ((float*)(ws + WS_SS3))[i] = 0.f; }
    {
        const float* w1 = C.in[5]; const float* b1 = C.in[6]; const float* f1 = C.in[7]; const float* w2 = C.in[8]; const float* b2 = C.in[9]; const float* f2 = C.in[10];
        float* h2 = (float*)(ws + WS_H2);
        for (int t = gw; t < SEQ; t += NGW) {
            const float tl = (float)t / (float)(SEQ - 1);
            const float omega = 6.283185307179586f * (float)t / (float)SEQ;
            float a = b1[lane] + tl * w1[lane];
            float sn, cs;
            { const int bi = lane & 15; const float fr = 1e-4f + (float)bi * ((15.0f - 1e-4f) / 15.0f); sincosf(omega * fr, &sn, &cs); }
#pragma unroll
            for (int i = 0; i < 16; ++i) a += __shfl(cs, i) * w1[(1 + i) * 64 + lane] - __shfl(sn, i) * w1[(17 + i) * 64 + lane];
            const float h1 = sinf(f1[lane] * a);
            float a2 = b2[lane];
#pragma unroll 8
            for (int i = 0; i < 64; ++i) a2 += __shfl(h1, i) * w2[i * 64 + lane];
            h2[t * 64 + lane] = sinf(f2[lane] * a2);
        }
    }
    {
        constexpr int WGP = 2056; LAS bf16_t* wgb = (LAS bf16_t*)lds;
        const float* x = C.in[0]; bf16_t* xb = (bf16_t*)(ws + WS_XB); float* r1 = (float*)(ws + WS_R1S); float* Gt = (float*)(ws + WS_G); const float* gbias = C.in[13];
        const int r = lane & 15, g = lane >> 4; const bool act = r < 8;
        for (int rb = gw; rb < TOK / 8; rb += NGW) {
            const int row = rb * 8 + (r & 7);
            const float* xp = x + (size_t)row * DM + 8 * g;
            f32x4 acc = {0.f, 0.f, 0.f, 0.f}; float ss = 0.f;
#pragma unroll 1
            for (int k8 = 0; k8 < 64; k8 += 8) {
                f32x4 la[8], lb[8];
#pragma unroll
                for (int u = 0; u < 8; ++u) { la[u] = *(const f32x4*)(xp + 32 * (k8 + u)); lb[u] = *(const f32x4*)(xp + 32 * (k8 + u) + 4); }
#pragma unroll
                for (int u = 0; u < 8; ++u) { const int kk = k8 + u; const f32x4 a = la[u], b = lb[u];
                    ss += ((a.x * a.x + a.y * a.y) + (a.z * a.z + a.w * a.w)) + ((b.x * b.x + b.y * b.y) + (b.z * b.z + b.w * b.w));
                    u32x4 o; o.x = pk2(a.x, a.y); o.y = pk2(a.z, a.w); o.z = pk2(b.x, b.y); o.w = pk2(b.z, b.w);
                    *(u32x4*)(xb + blk_off(row, 32 * kk + 8 * g, DM)) = o;
                    if (!act) { o.x = 0u; o.y = 0u; o.z = 0u; o.w = 0u; }
                    const bf16x8 bw = *(const LAS bf16x8*)(wgb + r * WGP + 32 * kk + 8 * g);
                    acc = __builtin_amdgcn_mfma_f32_16x16x32_bf16(__builtin_bit_cast(bf16x8, o), bw, acc, 0, 0, 0); }
            }
            ss += __shfl_xor(ss, 16); ss += __shfl_xor(ss, 32);
            const float rinv = __builtin_amdgcn_rsqf(ss * (1.0f / DM) + RMS_EPS);
            const float gb = gbias[r];
#pragma unroll
            for (int i = 0; i < 4; ++i) { const int m = 4 * g + i; const float rv = __shfl(rinv, m & 7); if (g < 2) Gt[(size_t)(rb * 8 + m) * 16 + r] = acc[i] * rv + gb; }
            if (lane < 8) r1[rb * 8 + lane] = rinv;
        }
    }
}
__device__ __forceinline__ void p1_filters(const Ctx& C, LAS unsigned char* lds, int G, int wv) {
    int tid = (wv << 6) | lane_id_opaque(); asm volatile("" : "+v"(tid));
    const int lane = tid & 63, w = tid >> 6, r = lane & 15, g = lane >> 4;
    const float* w3 = C.in[11]; const float* h2 = (const float*)(C.ws + WS_H2); float* FILT = (float*)(C.ws + WS_FILT);
    for (int item = blockIdx.x; item < 256; item += G) {
        const int n0 = 64 * (item >> 2), t0 = 1024 * (item & 3) + 128 * w;
        bf16x8 af[4][2];
#pragma unroll
        for (int mt = 0; mt < 4; ++mt)
#pragma unroll
            for (int ks = 0; ks < 2; ++ks) { float v[8];
#pragma unroll
                for (int e = 0; e < 8; ++e) v[e] = w3[(size_t)(32 * ks + 8 * g + e) * NFILT + n0 + 16 * mt + r];
                u32x4 o; o.x = pk2(v[0], v[1]); o.y = pk2(v[2], v[3]); o.z = pk2(v[4], v[5]); o.w = pk2(v[6], v[7]); af[mt][ks] = __builtin_bit_cast(bf16x8, o); }
        float dl[4][4];
#pragma unroll
        for (int mt = 0; mt < 4; ++mt)
#pragma unroll
            for (int i = 0; i < 4; ++i) { const int ch = (n0 + 16 * mt + 4 * g + i) & 1023; const float mind = -3.0701134573253945f, maxd = -15.350567286626973f;
                dl[mt][i] = fabsf(mind + (float)ch * ((maxd - mind) / 1023.0f)); }
        bf16x8 bfr[8][2];
#pragma unroll
        for (int nt = 0; nt < 8; ++nt) { const int t = t0 + 16 * nt + r;
#pragma unroll
            for (int ks = 0; ks < 2; ++ks) { const f32x4 a = *(const f32x4*)(h2 + (size_t)t * 64 + 32 * ks + 8 * g), b = *(const f32x4*)(h2 + (size_t)t * 64 + 32 * ks + 8 * g + 4);
                u32x4 o; o.x = pk2(a.x, a.y); o.y = pk2(a.z, a.w); o.z = pk2(b.x, b.y); o.w = pk2(b.z, b.w); bfr[nt][ks] = __builtin_bit_cast(bf16x8, o); } }
#pragma unroll
        for (int nt = 0; nt < 8; ++nt) {
            const int t = t0 + 16 * nt + r;
            const float tl = (float)t / (float)(SEQ - 1);
#pragma unroll
            for (int mt = 0; mt < 4; ++mt) {
                f32x4 acc = {0.f, 0.f, 0.f, 0.f};
                acc = __builtin_amdgcn_mfma_f32_16x16x32_bf16(af[mt][0], bfr[nt][0], acc, 0, 0, 0);
                acc = __builtin_amdgcn_mfma_f32_16x16x32_bf16(af[mt][1], bfr[nt][1], acc, 0, 0, 0);
#pragma unroll
                for (int i = 0; i < 4; ++i) FILT[(size_t)(n0 + 16 * mt + 4 * g + i) * SEQ + t] = acc[i] * __expf(-tl * dl[mt][i]);
            }
        }
    }
}
__device__ __forceinline__ void p7_final(const Ctx& C, int G, int wv) {
    int tid = (wv << 6) | lane_id_opaque(); asm volatile("" : "+v"(tid));
    const int lane = tid & 63, wave = tid >> 6, gw = blockIdx.x * 8 + wave, NGW = G * 8;
    const float* ss3 = (const float*)(C.ws + WS_SS3); const float* wf = C.in[20];
    f32x4 w[8];
#pragma unroll
    for (int j = 0; j < 8; ++j) w[j] = ((const f32x4*)wf)[64 * j + lane];
    for (int row = gw; row < TOK; row += 2 * NGW) {
        const int row2 = row + NGW;
        const bool has2 = row2 < TOK;
        const float r = __builtin_amdgcn_rsqf(ss3[row] * (1.0f / DM) + RMS_EPS), r2 = has2 ? __builtin_amdgcn_rsqf(ss3[row2] * (1.0f / DM) + RMS_EPS) : 0.f;
        f32x4* p = (f32x4*)(C.out + (size_t)row * DM) + lane; f32x4* p2 = (f32x4*)(C.out + (size_t)(has2 ? row2 : row) * DM) + lane;
        f32x4 v[8], u[8];
#pragma unroll
        for (int j = 0; j < 8; ++j) { v[j] = p[64 * j]; u[j] = p2[64 * j]; }
#pragma unroll
        for (int j = 0; j < 8; ++j) p[64 * j] = v[j] * r * w[j];
        if (has2) {
#pragma unroll
            for (int j = 0; j < 8; ++j) p2[64 * j] = u[j] * r2 * w[j]; }
    }
}
#ifndef FFT_HOST
#define FFT_DEV __device__ __forceinline__
#define FFT_PTR LAS f32x2*
#define FFT_SIN(x) __builtin_amdgcn_sinf(x)
#define FFT_COS(x) __builtin_amdgcn_cosf(x)
#else
#define FFT_DEV static inline
#define FFT_PTR f32x2*
#define FFT_SIN(x) sinf(6.283185307179586f * (x))
#define FFT_COS(x) cosf(6.283185307179586f * (x))
#endif
#define PADI(i) ((i) + ((i) >> 4))
FFT_DEV f32x2 cmul(f32x2 a, f32x2 b) { const f32x2 bs = (f32x2){-b.y, b.x}; return (f32x2){a.x, a.x} * b + (f32x2){a.y, a.y} * bs; }
FFT_DEV f32x2 cmulc(f32x2 a, f32x2 b) { return (f32x2){a.x, a.x} * (f32x2){b.x, -b.y} + (f32x2){a.y, a.y} * (f32x2){b.y, b.x}; }
FFT_DEV f32x2 twid(float frac) { f32x2 r; r.x = FFT_COS(frac); r.y = -FFT_SIN(frac); return r; }
template <int M, int CJ> FFT_DEV f32x2 rot8(f32x2 d) {
    const float R = 0.70710678118654752f; f32x2 r;
    if (M == 0) return d;
    if (M == 2) { if (!CJ) { r.x = d.y; r.y = -d.x; } else { r.x = -d.y; r.y = d.x; } return r; }
    if (M == 1) { if (!CJ) { r.x = R * (d.x + d.y); r.y = R * (d.y - d.x); } else { r.x = R * (d.x - d.y); r.y = R * (d.x + d.y); } return r; }
    if (!CJ) { r.x = R * (d.y - d.x); r.y = -R * (d.x + d.y); } else { r.x = -R * (d.x + d.y); r.y = R * (d.x - d.y); } return r;
}
template <int INV, int ZHI, int LOW> FFT_DEV void fft_r8_pass(FFT_PTR buf, int s, int ls  , int tid) {
#pragma unroll 1
    for (int rep = 0; rep < 2; ++rep) {
        const int bf = tid + rep * 512, j = bf & (s - 1), blk = bf >> ls, base = blk * 8 * s + j;
        f32x2 x[8];
#pragma unroll
        for (int m = 0; m < (ZHI ? 4 : 8); ++m) x[m] = buf[PADI(base + m * s)];
        f32x2 w1 = twid((float)j / (float)(8 * s));
        f32x2 w2 = cmul(w1, w1), w4 = cmul(w2, w2);
        if (!INV) {
            if (ZHI) {
                x[4] = cmul(x[0], w1); x[5] = cmul(rot8<1, 0>(x[1]), w1); x[6] = cmul(rot8<2, 0>(x[2]), w1); x[7] = cmul(rot8<3, 0>(x[3]), w1);
            } else {
                { f32x2 a = x[0], b = x[4]; x[0] = a + b; x[4] = cmul(a - b, w1); }
                { f32x2 a = x[1], b = x[5]; x[1] = a + b; x[5] = cmul(rot8<1, 0>(a - b), w1); }
                { f32x2 a = x[2], b = x[6]; x[2] = a + b; x[6] = cmul(rot8<2, 0>(a - b), w1); }
                { f32x2 a = x[3], b = x[7]; x[3] = a + b; x[7] = cmul(rot8<3, 0>(a - b), w1); }
            }
#pragma unroll
            for (int h = 0; h < 8; h += 4) {
                { f32x2 a = x[h], b = x[h + 2]; x[h] = a + b; x[h + 2] = cmul(a - b, w2); }
                { f32x2 a = x[h + 1], b = x[h + 3]; x[h + 1] = a + b; x[h + 3] = cmul(rot8<2, 0>(a - b), w2); }
            }
#pragma unroll
            for (int m = 0; m < 8; m += 2) { f32x2 a = x[m], b = x[m + 1]; x[m] = a + b; x[m + 1] = cmul(a - b, w4); }
        } else {
#pragma unroll
            for (int m = 0; m < 8; m += 2) { f32x2 a = x[m], b = cmulc(x[m + 1], w4); x[m] = a + b; x[m + 1] = a - b; }
#pragma unroll
            for (int h = 0; h < 8; h += 4) {
                { f32x2 a = x[h], b = cmulc(x[h + 2], w2); x[h] = a + b; x[h + 2] = a - b; }
                { f32x2 a = x[h + 1], b = rot8<2, 1>(cmulc(x[h + 3], w2)); x[h + 1] = a + b; x[h + 3] = a - b; }
            }
            { f32x2 a = x[0], b = cmulc(x[4], w1); x[0] = a + b; if (!LOW) x[4] = a - b; }
            { f32x2 a = x[1], b = rot8<1, 1>(cmulc(x[5], w1)); x[1] = a + b; if (!LOW) x[5] = a - b; }
            { f32x2 a = x[2], b = rot8<2, 1>(cmulc(x[6], w1)); x[2] = a + b; if (!LOW) x[6] = a - b; }
            { f32x2 a = x[3], b = rot8<3, 1>(cmulc(x[7], w1)); x[3] = a + b; if (!LOW) x[7] = a - b; }
        }
#pragma unroll
        for (int m = 0; m < (LOW ? 4 : 8); ++m) buf[PADI(base + m * s)] = x[m];
    }
}
FFT_DEV void fft_r2_span1(FFT_PTR buf, int tid) {
#pragma unroll
    for (int rep = 0; rep < 8; ++rep) { const int p = 2 * (tid + rep * 512); f32x2 a = buf[PADI(p)], b = buf[PADI(p + 1)]; buf[PADI(p)] = a + b; buf[PADI(p + 1)] = a - b; }
}
template <int J, int CJ> FFT_DEV f32x2 rot16(f32x2 d) {
    const float C1 = 0.92387953251128674f, S1 = 0.38268343236508977f;
    if ((J & 1) == 0) return rot8<J / 2, CJ>(d);
    const float wr = (J == 1) ? C1 : (J == 3) ? S1 : (J == 5) ? -S1 : -C1;
    const float wi = ((J == 1) ? -S1 : (J == 3) ? -C1 : (J == 5) ? -C1 : -S1) * (CJ ? -1.f : 1.f);
    f32x2 r; r.x = d.x * wr - d.y * wi; r.y = d.x * wi + d.y * wr; return r;
}
FFT_DEV unsigned brev13(unsigned p);
FFT_DEV void fft16_dif(f32x2 (&x)[16]) {
#define BF_(i, j, ROT) { const f32x2 a_ = x[i], b_ = x[j]; x[i] = a_ + b_; x[j] = ROT(a_ - b_); }
    BF_(0, 8, (rot16<0, 0>)) BF_(1, 9, (rot16<1, 0>)) BF_(2, 10, (rot16<2, 0>)) BF_(3, 11, (rot16<3, 0>)) BF_(4, 12, (rot16<4, 0>)) BF_(5, 13, (rot16<5, 0>)) BF_(6, 14, (rot16<6, 0>)) BF_(7, 15, (rot16<7, 0>))
#pragma unroll
    for (int h = 0; h < 16; h += 8) { BF_(h + 0, h + 4, (rot8<0, 0>)) BF_(h + 1, h + 5, (rot8<1, 0>)) BF_(h + 2, h + 6, (rot8<2, 0>)) BF_(h + 3, h + 7, (rot8<3, 0>)) }
#pragma unroll
    for (int h = 0; h < 16; h += 4) { BF_(h + 0, h + 2, (rot8<0, 0>)) BF_(h + 1, h + 3, (rot8<2, 0>)) }
#pragma unroll
    for (int h = 0; h < 16; h += 2) { BF_(h, h + 1, (rot8<0, 0>)) }
#undef BF_
}
FFT_DEV void fft16_dit_inv(f32x2 (&x)[16]) {
#define BI_(i, j, ROT) { const f32x2 a_ = x[i], b_ = ROT(x[j]); x[i] = a_ + b_; x[j] = a_ - b_; }
#pragma unroll
    for (int h = 0; h < 16; h += 2) { BI_(h, h + 1, (rot8<0, 1>)) }
#pragma unroll
    for (int h = 0; h < 16; h += 4) { BI_(h + 0, h + 2, (rot8<0, 1>)) BI_(h + 1, h + 3, (rot8<2, 1>)) }
#pragma unroll
    for (int h = 0; h < 16; h += 8) { BI_(h + 0, h + 4, (rot8<0, 1>)) BI_(h + 1, h + 5, (rot8<1, 1>)) BI_(h + 2, h + 6, (rot8<2, 1>)) BI_(h + 3, h + 7, (rot8<3, 1>)) }
    BI_(0, 8, (rot16<0, 1>)) BI_(1, 9, (rot16<1, 1>)) BI_(2, 10, (rot16<2, 1>)) BI_(3, 11, (rot16<3, 1>)) BI_(4, 12, (rot16<4, 1>)) BI_(5, 13, (rot16<5, 1>)) BI_(6, 14, (rot16<6, 1>)) BI_(7, 15, (rot16<7, 1>))
#undef BI_
}
template <int MODE> FFT_DEV void fft_mid_pass(FFT_PTR wb, FFT_PTR zk, int tid) {
    f32x2 x[16];
#pragma unroll
    for (int e = 0; e < 16; ++e) x[e] = wb[PADI(16 * tid + e)];
    fft16_dif(x);
    if (MODE != 0) {
#pragma unroll
        for (int e = 0; e < 16; ++e) {
            const unsigned p = 16u * (unsigned)tid + (unsigned)e, f = brev13(p), fn = (8192u - f) & 8191u, pn = brev13(fn);
            const f32x2 zf = zk[PADI(p)], zn = zk[PADI(pn)];
            f32x2 kf;
            if (MODE == 1) { kf.x = 0.5f * (zf.x + zn.x); kf.y = 0.5f * (zf.y - zn.y); }
            else           { kf.x = 0.5f * (zf.y + zn.y); kf.y = 0.5f * (zn.x - zf.x); }
            x[e] = cmul(x[e], kf);
        }
        fft16_dit_inv(x);
    }
#pragma unroll
    for (int e = 0; e < 16; ++e) wb[PADI(16 * tid + e)] = x[e];
}
#ifndef FFT_HOST
#define FFT_SYNC() do { asm volatile("s_waitcnt lgkmcnt(0)" ::: "memory"); __builtin_amdgcn_s_barrier(); asm volatile("" ::: "memory"); } while (0)
__device__ __forceinline__ void fft_fwd_full(FFT_PTR buf, int tid) {
    FFT_SYNC(); fft_r8_pass<0, 0, 0>(buf, 1024, 10, tid); FFT_SYNC(); fft_r8_pass<0, 0, 0>(buf, 128, 7, tid); FFT_SYNC(); fft_r8_pass<0, 0, 0>(buf, 16, 4, tid); FFT_SYNC();
    fft_mid_pass<0>(buf, buf, tid); FFT_SYNC();
}
template <int WHICH> __device__ __forceinline__ void fft_conv(FFT_PTR wb, FFT_PTR zk, int tid) {
    FFT_SYNC(); fft_r8_pass<0, 1, 0>(wb, 1024, 10, tid); FFT_SYNC(); fft_r8_pass<0, 0, 0>(wb, 128, 7, tid); FFT_SYNC(); fft_r8_pass<0, 0, 0>(wb, 16, 4, tid); FFT_SYNC();
    fft_mid_pass<1 + WHICH>(wb, zk, tid); FFT_SYNC();
    fft_r8_pass<1, 0, 0>(wb, 16, 4, tid); FFT_SYNC(); fft_r8_pass<1, 0, 0>(wb, 128, 7, tid); FFT_SYNC(); fft_r8_pass<1, 0, 1>(wb, 1024, 10, tid); FFT_SYNC();
}
#endif
FFT_DEV unsigned brev13(unsigned p) {
    unsigned r = 0;
#ifndef FFT_HOST
    r = __brev(p) >> 19;
#else
    for (int i = 0; i < 13; ++i) r |= ((p >> i) & 1u) << (12 - i);
#endif
    return r;
}
FFT_DEV void fft_pointwise(FFT_PTR wb, FFT_PTR zk, int which, int tid) {
#pragma unroll 4
    for (int rep = 0; rep < 16; ++rep) {
        const unsigned p = tid + rep * 512, f = brev13(p), fn = (8192u - f) & 8191u, pn = brev13(fn);
        const f32x2 zf = zk[PADI(p)], zn = zk[PADI(pn)];
        f32x2 kf;
        if (which == 0) { kf.x = 0.5f * (zf.x + zn.x); kf.y = 0.5f * (zf.y - zn.y); }
        else            { kf.x = 0.5f * (zf.y + zn.y); kf.y = 0.5f * (zn.x - zf.x); }
        wb[PADI(p)] = cmul(wb[PADI(p)], kf);
    }
}
__device__ __forceinline__ void qk_prepass(const Ctx& C, int G, int wv) {
    int tid = (wv << 6) | lane_id_opaque(); asm volatile("" : "+v"(tid));
    const bf16_t* R1A = (const bf16_t*)(C.ws + WS_R1A); bf16_t* QKP = (bf16_t*)(C.ws + WS_QKP);
    const float* cw = C.in[3]; const float* cb = C.in[4];
    const int cg8 = tid & 255, half = tid >> 8, col = 8 * cg8;
    float k0[8], k1[8], k2[8], kb[8];
    { const int ch = 3072 + col;
      const f32x4 t0 = *(const f32x4*)(cw + ch), t1 = *(const f32x4*)(cw + ch + 4), t2 = *(const f32x4*)(cw + CONVC + ch), t3 = *(const f32x4*)(cw + CONVC + ch + 4);
      const f32x4 t4 = *(const f32x4*)(cw + 2 * CONVC + ch), t5 = *(const f32x4*)(cw + 2 * CONVC + ch + 4), t6 = *(const f32x4*)(cb + ch), t7 = *(const f32x4*)(cb + ch + 4);
#pragma unroll
      for (int e = 0; e < 4; ++e) { k0[e] = t0[e]; k0[4 + e] = t1[e]; k1[e] = t2[e]; k1[4 + e] = t3[e]; k2[e] = t4[e]; k2[4 + e] = t5[e]; kb[e] = t6[e]; kb[4 + e] = t7[e]; } }
    const float osc = col >= 1024 ? 0.0625f : 1.0f;
    for (int run = blockIdx.x; run < TOK / 64; run += G) {
        const int row0 = run * 64 + half * 32;
#pragma unroll 1
        for (int i0 = 0; i0 < 32; i0 += 4) {
            u32x4 w0[4], w1[4], w2[4];
#pragma unroll
            for (int u = 0; u < 4; ++u) { const int row = row0 + i0 + u, t = row & (SEQ - 1); const bf16_t* p = R1A + (size_t)row * 2048 + col;
                w0[u] = *(const u32x4*)(t > 0 ? p - 2048 : p); w1[u] = *(const u32x4*)p; w2[u] = *(const u32x4*)(t < SEQ - 1 ? p + 2048 : p); }
#pragma unroll
            for (int u = 0; u < 4; ++u) { const int row = row0 + i0 + u, t = row & (SEQ - 1);
                const u32x4 z = {0u, 0u, 0u, 0u}; if (t == 0) w0[u] = z; if (t == SEQ - 1) w2[u] = z;
                float a0[8], a1[8], a2[8]; unpack8(w0[u], a0); unpack8(w1[u], a1); unpack8(w2[u], a2);
                float v[8];
#pragma unroll
                for (int e = 0; e < 8; ++e) v[e] = siluf_(k0[e] * a0[e] + k1[e] * a1[e] + k2[e] * a2[e] + kb[e]) * osc;
                u32x4 o; o.x = pk2(v[0], v[1]); o.y = pk2(v[2], v[3]); o.z = pk2(v[4], v[5]); o.w = pk2(v[6], v[7]);
                *(u32x4*)(QKP + (size_t)row * 2048 + col) = o; }
        }
    }
}
constexpr int ML_KS = 0, ML_KP = 528, ML_SS = 76032, ML_SP = 272, ML_VS = 110848, ML_VP = 80, ML_VW = 121088, ML_CS = 131328, ML_CP = 528, ML_SC = 148224;
static_assert(ML_SC + 7 * 512 + 64 + 5 * 128 <= LDS_BYTES - 16, "mLSTM LDS map");
__device__ __forceinline__ bf16x8 tr_read2(unsigned a0, unsigned a1) {
    bf16x4 lo, hi;
    asm volatile("ds_read_b64_tr_b16 %0, %2\n\tds_read_b64_tr_b16 %1, %3\n\ts_waitcnt lgkmcnt(0)" : "=&v"(lo), "=&v"(hi) : "v"(a0), "v"(a1) : "memory");
    bf16x8 r; r[0] = lo[0]; r[1] = lo[1]; r[2] = lo[2]; r[3] = lo[3]; r[4] = hi[0]; r[5] = hi[1]; r[6] = hi[2]; r[7] = hi[3]; return r;
}
__device__ __forceinline__ bf16x8 cat4(bf16x4 lo, bf16x4 hi) { bf16x8 r; r[0] = lo[0]; r[1] = lo[1]; r[2] = lo[2]; r[3] = lo[3]; r[4] = hi[0]; r[5] = hi[1]; r[6] = hi[2]; r[7] = hi[3]; return r; }
__device__ __forceinline__ void tr_read2x2(unsigned a, unsigned b, unsigned d, bf16x8& ra, bf16x8& rb) {
    bf16x4 l0, h0, l1, h1;
    asm volatile("ds_read_b64_tr_b16 %0, %4\n\tds_read_b64_tr_b16 %1, %5\n\tds_read_b64_tr_b16 %2, %6\n\tds_read_b64_tr_b16 %3, %7\n\ts_waitcnt lgkmcnt(0)"
        : "=&v"(l0), "=&v"(h0), "=&v"(l1), "=&v"(h1) : "v"(a), "v"(a + d), "v"(b), "v"(b + d) : "memory");
    ra = cat4(l0, h0); rb = cat4(l1, h1);
}
__device__ __forceinline__ void tr_read4x2(unsigned a, unsigned b, unsigned d, unsigned c, unsigned e, unsigned d2, bf16x8& ra, bf16x8& rb, bf16x8& rc, bf16x8& re) {
    bf16x4 l0, h0, l1, h1, l2, h2, l3, h3;
    asm volatile("ds_read_b64_tr_b16 %0, %8\n\tds_read_b64_tr_b16 %1, %9\n\tds_read_b64_tr_b16 %2, %10\n\tds_read_b64_tr_b16 %3, %11\n\t"
                 "ds_read_b64_tr_b16 %4, %12\n\tds_read_b64_tr_b16 %5, %13\n\tds_read_b64_tr_b16 %6, %14\n\tds_read_b64_tr_b16 %7, %15\n\ts_waitcnt lgkmcnt(0)"
        : "=&v"(l0), "=&v"(h0), "=&v"(l1), "=&v"(h1), "=&v"(l2), "=&v"(h2), "=&v"(l3), "=&v"(h3)
        : "v"(a), "v"(a + d), "v"(b), "v"(b + d), "v"(c), "v"(c + d2), "v"(e), "v"(e + d2) : "memory");
    ra = cat4(l0, h0); rb = cat4(l1, h1); rc = cat4(l2, h2); re = cat4(l3, h3);
}
__device__ __forceinline__ float bf2f(short s) { return __uint_as_float(((unsigned)(unsigned short)s) << 16); }
__device__ __forceinline__ float logsigmoidf_(float x) { return fminf(x, 0.f) - log1pf(expf(-fabsf(x))); }

__device__ __forceinline__ void mlstm_item(const Ctx& C, LAS unsigned char* lds, int item, int wv) {
    int tid = (wv << 6) | lane_id_opaque(); asm volatile("" : "+v"(tid));
    const int lane = tid & 63, w = __builtin_amdgcn_readfirstlane(tid >> 6), r = lane & 15, g = lane >> 4, q4 = r >> 2, p4 = r & 3;
    const int xcd_ = item & 7, yy_ = item >> 3, vs = yy_ & 7, dir = (yy_ >> 3) & 1, bh = 2 * xcd_ + (yy_ >> 4), b = bh >> 2, h = bh & 3;
    const bf16_t* QKP = (const bf16_t*)(C.ws + WS_QKP); const bf16_t* R1B = (const bf16_t*)(C.ws + WS_R1B); const float* Gt = (const float*)(C.ws + WS_G);
    bf16_t* Y = (bf16_t*)(C.ws + (dir ? WS_YBB : WS_YBF));
    LAS float* SC = (LAS float*)(lds + ML_SC);
    LAS float* s_cs = SC, *s_rj = SC + 128, *s_iw = SC + 256, *s_emj = SC + 384, *s_w = SC + 512, *s_dn = SC + 640, *s_misc = SC + 768;
    LAS float* c_bl = SC + 784, *c_mx = SC + 816, *c_mp = SC + 848, *c_mn = SC + 880, *c_kp = SC + 912;
    float* GS = (float*)(C.ws + WS_GSC) + (size_t)item * 3 * SEQ;
    const unsigned lbase = (unsigned)(size_t)lds;
    const int pc = tid & 31, krow = tid >> 5, vrow = tid >> 2, pv = tid & 3;
    const int sw = w < 4 ? w : 11 - w;
    for (int i = tid; i < 16896 / 4; i += 512) ((LAS unsigned*)(lds + ML_CS))[i] = 0u;
    for (int i = tid; i < 16 * ML_KP / 4; i += 512) ((LAS unsigned*)(lds + ML_KS + 128 * ML_KP))[i] = 0u;
    f32x4 Cacc[3][2];
#pragma unroll
    for (int a = 0; a < 3; ++a) { Cacc[a][0] = (f32x4){0.f, 0.f, 0.f, 0.f}; Cacc[a][1] = (f32x4){0.f, 0.f, 0.f, 0.f}; }
    u32x4 kreg[8], vreg, qn[8]; float bn = 0.f, csn = 0.f, pmn = 0.f;
#define ML_TOK(c_, j_) ((size_t)b * SEQ + (dir ? SEQ - 1 - ((c_) * 128 + (j_)) : ((c_) * 128 + (j_))))
#define ML_PREFETCH(c_) do { \
        _Pragma("unroll") for (int i = 0; i < 8; ++i) kreg[i] = *(const u32x4*)(QKP + ML_TOK(c_, krow + 16 * i) * 2048 + 1024 + h * 256 + 8 * pc); \
        vreg = *(const u32x4*)(R1B + ML_TOK(c_, vrow) * 2048 + h * 256 + vs * 32 + 8 * pv); \
        { const bf16_t* qp = QKP + ML_TOK(c_, 16 * sw + r) * 2048 + h * 256 + 8 * g; _Pragma("unroll") for (int kk = 0; kk < 8; ++kk) qn[kk] = *(const u32x4*)(qp + 32 * kk); } \
        if (tid < 128) { const int ta = (c_) * 128 + tid; bn = GS[ta]; csn = GS[SEQ + ta]; pmn = GS[2 * SEQ + ta]; } } while (0)
    {
        float gi[8], gf[8];
#pragma unroll
        for (int u = 0; u < 8; ++u) { const int ta = (4 * w) * 128 + u * 64 + lane; const size_t tk = (size_t)b * SEQ + (dir ? SEQ - 1 - ta : ta);
            gi[u] = Gt[tk * 16 + (dir * 2) * 4 + h]; gf[u] = Gt[tk * 16 + (dir * 2 + 1) * 4 + h]; }
#pragma unroll
        for (int q = 0; q < 4; ++q) {
            const int c = 4 * w + q; float carry_b = 0.f, carry_m = -3.0e38f;
#pragma unroll
            for (int hf = 0; hf < 2; ++hf) {
                const int ta = c * 128 + hf * 64 + lane;
                const float ip = gi[2 * q + hf], fp = gf[2 * q + hf];
                float xs = logsigmoidf_(fp);
#pragma unroll
                for (int o = 1; o < 64; o <<= 1) { const float y = __shfl_up(xs, o); if (lane >= o) xs += y; }
                const float bj = xs + carry_b; const float cj = ip - bj; float pm = cj;
#pragma unroll
                for (int o = 1; o < 64; o <<= 1) { const float y = __shfl_up(pm, o); if (lane >= o) pm = fmaxf(pm, y); }
                pm = fmaxf(pm, carry_m);
                GS[ta] = bj; GS[SEQ + ta] = cj; GS[2 * SEQ + ta] = pm;
                carry_b = __shfl(bj, 63); carry_m = __shfl(pm, 63);
            }
            if (lane == 0) { c_bl[c] = carry_b; c_mx[c] = carry_m; }
        }
        __syncthreads();
        if (tid == 0) { float m = 0.f;
            for (int c = 0; c < 32; ++c) { const float bl = c_bl[c], mn = fmaxf(bl + m, bl + c_mx[c]); c_mp[c] = m; c_mn[c] = mn; c_kp[c] = __expf(bl + m - mn); m = mn; } }
        __syncthreads();
    }
    ML_PREFETCH(0);
    __syncthreads();
#define ML_BAR() do { asm volatile("s_waitcnt lgkmcnt(0)" ::: "memory"); __builtin_amdgcn_s_barrier(); asm volatile("" ::: "memory"); } while (0)
#pragma unroll 1
    for (int c = 0; c < 32; ++c) {
        const float m_prev = c_mp[c], m_new = c_mn[c], keep = c_kp[c], b_last = c_bl[c];
        if (tid < 128) {
            const float inter = bn + m_prev, mj = fmaxf(inter, bn + pmn);
            s_cs[tid] = csn; s_rj[tid] = bn - mj; s_iw[tid] = __expf(inter - mj); s_emj[tid] = __expf(-mj); s_w[tid] = __expf(b_last + csn - m_new);
        }
        ML_BAR();
#pragma unroll
        for (int i = 0; i < 8; ++i) *(LAS u32x4*)(lds + ML_KS + (krow + 16 * i) * ML_KP + pc * 16) = kreg[i];
        {
            *(LAS u32x4*)(lds + ML_VS + vrow * ML_VP + pv * 16) = vreg;
            float f[8]; unpack8(vreg, f); const float ws_ = s_w[vrow];
            u32x4 o; o.x = pk2(f[0] * ws_, f[1] * ws_); o.y = pk2(f[2] * ws_, f[3] * ws_); o.z = pk2(f[4] * ws_, f[5] * ws_); o.w = pk2(f[6] * ws_, f[7] * ws_);
            *(LAS u32x4*)(lds + ML_VW + vrow * ML_VP + pv * 16) = o;
        }
        bf16x8 qf[8];
#pragma unroll
        for (int kk = 0; kk < 8; ++kk) qf[kk] = __builtin_bit_cast(bf16x8, qn[kk]);
        unsigned short ogr[4][2];
#pragma unroll
        for (int i = 0; i < 4; ++i)
#pragma unroll
            for (int vt = 0; vt < 2; ++vt) ogr[i][vt] = R1B[ML_TOK(c, 16 * sw + 4 * g + i) * 2048 + 1024 + h * 256 + vs * 32 + 16 * vt + r];
        if (c < 31) ML_PREFETCH(c + 1);
        ML_BAR();
        {
            const float rjv = s_rj[16 * sw + r]; const int jloc = 16 * sw + r; float den1 = 0.f;
#pragma unroll 2
            for (int st = 0; st < 8; ++st) {
                if (st <= sw) {
                    f32x4 acc = {0.f, 0.f, 0.f, 0.f};
#pragma unroll
                    for (int kk = 0; kk < 8; ++kk) { const bf16x8 kf = *(const LAS bf16x8*)(lds + ML_KS + (16 * st + r) * ML_KP + (32 * kk + 8 * g) * 2); acc = __builtin_amdgcn_mfma_f32_16x16x32_bf16(kf, qf[kk], acc, 0, 0, 0); }
                    const f32x4 c4 = *(const LAS f32x4*)(s_cs + 16 * st + 4 * g);
                    float v[4];
#pragma unroll
                    for (int i = 0; i < 4; ++i) { const int s = 16 * st + 4 * g + i; const float d = (s <= jloc) ? __expf(rjv + c4[i]) : 0.f; v[i] = acc[i] * d; den1 += v[i]; }
                    u32x2 o; o.x = pk2(v[0], v[1]); o.y = pk2(v[2], v[3]);
                    *(LAS u32x2*)(lds + ML_SS + jloc * ML_SP + (16 * st + 4 * g) * 2) = o;
                } else if (st == sw + 1 && !(sw & 1)) {
                    u32x2 o = {0u, 0u}; *(LAS u32x2*)(lds + ML_SS + jloc * ML_SP + (16 * st + 4 * g) * 2) = o;
                }
            }
            den1 += __shfl_xor(den1, 16); den1 += __shfl_xor(den1, 32);
            f32x4 dacc = {0.f, 0.f, 0.f, 0.f};
#pragma unroll
            for (int kk = 0; kk < 8; ++kk) { const bf16x8 kf = *(const LAS bf16x8*)(lds + ML_KS + (128 + r) * ML_KP + (32 * kk + 8 * g) * 2); dacc = __builtin_amdgcn_mfma_f32_16x16x32_bf16(kf, qf[kk], dacc, 0, 0, 0); }
            const float d2 = dacc[0];
            if (g == 0) s_dn[jloc] = den1 + s_iw[jloc] * d2;
        }
        ML_BAR();
        {
            f32x4 n1[2], n2[2];
#pragma unroll
            for (int vt = 0; vt < 2; ++vt) { n1[vt] = (f32x4){0.f, 0.f, 0.f, 0.f}; n2[vt] = (f32x4){0.f, 0.f, 0.f, 0.f}; }
            const int nks = (sw >> 1) + 1;
#pragma unroll 1
            for (int ks = 0; ks < nks; ++ks) {
                const bf16x8 af = *(const LAS bf16x8*)(lds + ML_SS + (16 * sw + r) * ML_SP + (32 * ks + 8 * g) * 2);
                const unsigned a0 = lbase + ML_VS + (32 * ks + 8 * g + q4) * ML_VP + (4 * p4) * 2;
                bf16x8 b0, b1; tr_read2x2(a0, a0 + 32, 4 * ML_VP, b0, b1);
                n1[0] = __builtin_amdgcn_mfma_f32_16x16x32_bf16(af, b0, n1[0], 0, 0, 0); n1[1] = __builtin_amdgcn_mfma_f32_16x16x32_bf16(af, b1, n1[1], 0, 0, 0);
            }
#pragma unroll
            for (int kk = 0; kk < 8; ++kk)
#pragma unroll
                for (int vt = 0; vt < 2; ++vt) { const bf16x8 cf = *(const LAS bf16x8*)(lds + ML_CS + (16 * vt + r) * ML_CP + (32 * kk + 8 * g) * 2); n2[vt] = __builtin_amdgcn_mfma_f32_16x16x32_bf16(qf[kk], cf, n2[vt], 0, 0, 0); }
            const f32x4 iw4 = *(const LAS f32x4*)(s_iw + 16 * sw + 4 * g), dn4 = *(const LAS f32x4*)(s_dn + 16 * sw + 4 * g), em4 = *(const LAS f32x4*)(s_emj + 16 * sw + 4 * g);
#pragma unroll
            for (int i = 0; i < 4; ++i) {
                const size_t tok = ML_TOK(c, 16 * sw + 4 * g + i);
                const float inv = __builtin_amdgcn_rcpf(fmaxf(fabsf(dn4[i]), em4[i]));
#pragma unroll
                for (int vt = 0; vt < 2; ++vt) { const int col = h * 256 + vs * 32 + 16 * vt + r;
                    const float og = __uint_as_float(((unsigned)ogr[i][vt]) << 16);
                    const float hv = (n1[vt][i] + iw4[i] * n2[vt][i]) * inv * og;
                    Y[blk_off((int)tok, col, 1024)] = (bf16_t)pk2(hv, 0.f); }
            }
        }
        ML_BAR();
        {
#pragma unroll
            for (int a = 0; a < 3; ++a) { Cacc[a][0] *= keep; Cacc[a][1] *= keep; }
#pragma unroll 1
            for (int ks = 0; ks < 4; ++ks) {
                bf16x8 af[3], bq[2];
                { const unsigned av = lbase + ML_VW + (32 * ks + 8 * g + q4) * ML_VP + (4 * p4) * 2, ak = lbase + ML_KS + (32 * ks + 8 * g + q4) * ML_KP + (32 * w + 4 * p4) * 2;
                  tr_read4x2(av, av + 32, 4 * ML_VP, ak, ak + 32, 4 * ML_KP, af[0], af[1], bq[0], bq[1]); }
                { const f32x4 wa = *(const LAS f32x4*)(s_w + 32 * ks + 8 * g), wb = *(const LAS f32x4*)(s_w + 32 * ks + 8 * g + 4);
                  u32x4 o; o.x = pk2(wa[0], wa[1]); o.y = pk2(wa[2], wa[3]); o.z = pk2(wb[0], wb[1]); o.w = pk2(wb[2], wb[3]);
                  if (r != 0) { o.x = 0u; o.y = 0u; o.z = 0u; o.w = 0u; }
                  af[2] = __builtin_bit_cast(bf16x8, o); }
#pragma unroll
                for (int nt = 0; nt < 2; ++nt)
#pragma unroll
                    for (int mt = 0; mt < 3; ++mt) Cacc[mt][nt] = __builtin_amdgcn_mfma_f32_16x16x32_bf16(af[mt], bq[nt], Cacc[mt][nt], 0, 0, 0);
            }
#pragma unroll
            for (int mt = 0; mt < 2; ++mt)
#pragma unroll
                for (int nt = 0; nt < 2; ++nt)
#pragma unroll
                    for (int i = 0; i < 4; ++i) *(LAS bf16_t*)(lds + ML_CS + (16 * mt + 4 * g + i) * ML_CP + (32 * w + 16 * nt + r) * 2) = (bf16_t)pk2(Cacc[mt][nt][i], 0.f);
            if (g == 0) { *(LAS bf16_t*)(lds + ML_KS + 128 * ML_KP + (32 * w + r) * 2) = (bf16_t)pk2(Cacc[2][0][0], 0.f); *(LAS bf16_t*)(lds + ML_KS + 128 * ML_KP + (32 * w + 16 + r) * 2) = (bf16_t)pk2(Cacc[2][1][0], 0.f); }
        }
        ML_BAR();
    }
#undef ML_BAR
#undef ML_PREFETCH
#undef ML_TOK
}
constexpr int HY_ZK = 0, HY_WB = 69632;
static_assert(HY_WB + 69632 <= LDS_BYTES, "hyena LDS map");
#define GAS __attribute__((address_space(1)))
struct HyRaw { u32x4 c; unsigned l, r; };
__device__ __forceinline__ HyRaw hy_load(const bf16_t* rowp, int tid) { HyRaw x; const GAS bf16_t* p = (const GAS bf16_t*)rowp + 8 * tid; x.c = *(const GAS u32x4*)p; x.l = p[-1]; x.r = p[8]; return x; }
__device__ __forceinline__ void hy_conv8(const HyRaw& x, int tid, float w0, float w1, float w2, float bias, float (&o)[8]) {
    float a[10];
    a[0] = tid > 0 ? __uint_as_float(x.l << 16) : 0.f; a[9] = tid < 511 ? __uint_as_float(x.r << 16) : 0.f;
    a[1] = bflo(x.c.x); a[2] = bfhi(x.c.x); a[3] = bflo(x.c.y); a[4] = bfhi(x.c.y); a[5] = bflo(x.c.z); a[6] = bfhi(x.c.z); a[7] = bflo(x.c.w); a[8] = bfhi(x.c.w);
#pragma unroll
    for (int m = 0; m < 8; ++m) o[m] = w0 * a[m] + w1 * a[m + 1] + w2 * a[m + 2] + bias;
}
__device__ __forceinline__ void hyena_item(const Ctx& C, LAS unsigned char* lds, int ch, int wv) {
    int tid = (wv << 6) | lane_id_opaque(); asm volatile("" : "+v"(tid));
    LAS f32x2* zk = (LAS f32x2*)(lds + HY_ZK); LAS f32x2* wb = (LAS f32x2*)(lds + HY_WB);
    const float* FILT = (const float*)(C.ws + WS_FILT); const bf16_t* HYb = (const bf16_t*)(C.ws + WS_HY); bf16_t* YA = (bf16_t*)(C.ws + WS_YA);
    const float* cw = C.in[3]; const float* cb = C.in[4];
    float w0[3], w1[3], w2[3], bs[3];
#pragma unroll
    for (int s = 0; s < 3; ++s) { w0[s] = cw[s * 1024 + ch]; w1[s] = cw[CONVC + s * 1024 + ch]; w2[s] = cw[2 * CONVC + s * 1024 + ch]; bs[s] = cb[s * 1024 + ch]; }
    const float hb0 = C.in[12][ch], hb1 = C.in[12][1024 + ch];
    const float* F0 = FILT + (size_t)(0 * 1024 + ch) * SEQ; const float* F1 = FILT + (size_t)(1 * 1024 + ch) * SEQ;
    const float* F2 = FILT + (size_t)(2 * 1024 + ch) * SEQ; const float* F3 = FILT + (size_t)(3 * 1024 + ch) * SEQ;
    __syncthreads();
    {
        float fa[16], fb[16];
#pragma unroll
        for (int rep = 0; rep < 8; ++rep) { const int i = tid + 512 * rep; fa[rep] = F0[i]; fb[rep] = F2[i]; }
#pragma unroll
        for (int rep = 8; rep < 16; ++rep) { const int i = tid + 512 * rep; const int j = i == SEQ ? 1 : 2 * SEQ - i; fa[rep] = F1[j]; fb[rep] = F3[j]; }
        if (tid == 0) { fa[8] = 0.f; fb[8] = 0.f; }
#pragma unroll
        for (int rep = 0; rep < 16; ++rep) { const int i = tid + 512 * rep; zk[PADI(i)] = (f32x2){fa[rep] * (1.0f / 8192.0f), fb[rep] * (1.0f / 8192.0f)}; }
    }
    fft_fwd_full(zk, tid);
    const bf16_t* rv = HYb + (size_t)ch * TOK; const bf16_t* rx1 = HYb + (size_t)(1024 + ch) * TOK; const bf16_t* rx2 = HYb + (size_t)(2048 + ch) * TOK;
    HyRaw qa = hy_load(rv, tid), qb = hy_load(rv + SEQ, tid);
#pragma unroll 1
    for (int p = 0; p < 2; ++p) {
        const int tb0 = (2 * p) * SEQ, tb1 = (2 * p + 1) * SEQ;
        f32x2 vv[8], zz[8];
        { float va[8], vb[8]; hy_conv8(qa, tid, w0[0], w1[0], w2[0], bs[0], va); hy_conv8(qb, tid, w0[0], w1[0], w2[0], bs[0], vb);
#pragma unroll
          for (int m = 0; m < 8; ++m) { vv[m].x = va[m]; vv[m].y = vb[m]; wb[PADI(8 * tid + m)] = vv[m]; } }
        qa = hy_load(rx1 + tb0, tid); qb = hy_load(rx1 + tb1, tid);
        fft_conv<0>(wb, zk, tid);
        { float xa[8], xb_[8]; hy_conv8(qa, tid, w0[1], w1[1], w2[1], bs[1], xa); hy_conv8(qb, tid, w0[1], w1[1], w2[1], bs[1], xb_);
#pragma unroll
          for (int m = 0; m < 8; ++m) { const f32x2 y = wb[PADI(8 * tid + m)]; zz[m].x = xa[m] * (y.x + vv[m].x * hb0); zz[m].y = xb_[m] * (y.y + vv[m].y * hb0); }
#pragma unroll
          for (int m = 0; m < 8; ++m) wb[PADI(8 * tid + m)] = zz[m]; }
        qa = hy_load(rx2 + tb0, tid); qb = hy_load(rx2 + tb1, tid);
        fft_conv<1>(wb, zk, tid);
        { float xa[8], xb_[8]; hy_conv8(qa, tid, w0[2], w1[2], w2[2], bs[2], xa); hy_conv8(qb, tid, w0[2], w1[2], w2[2], bs[2], xb_);
          if (p == 0) { qa = hy_load(rv + 2 * SEQ, tid); qb = hy_load(rv + 3 * SEQ, tid); }
#pragma unroll
          for (int m = 0; m < 8; ++m) { const int t = 8 * tid + m; const f32x2 y = wb[PADI(t)];
              YA[blk_off(tb0 + t, ch, 1024)] = (bf16_t)f2bf(xa[m] * (y.x + zz[m].x * hb1));
              YA[blk_off(tb1 + t, ch, 1024)] = (bf16_t)f2bf(xb_[m] * (y.y + zz[m].y * hb1)); } }
        FFT_SYNC();
    }
}
#ifndef DUP_FILT
#define DUP_FILT 0
#endif
#ifndef DUP_PRE
#define DUP_PRE 0
#endif
#ifndef DUP_P0
#define DUP_P0 0
#endif
#ifndef DUP_ML
#define DUP_ML 0
#endif
#ifndef DUP_HY
#define DUP_HY 0
#endif
#ifndef DUP_REST
#define DUP_REST 0
#endif
#ifndef DUP_GU
#define DUP_GU 0
#endif
#define XB_TMO      128
#define XB_XCNT(j)  (256  + 64 * (j))
#define XB_XSUB(j)  (1280 + 64 * (j))
#define XB_XGEN(j)  (2304 + 64 * (j))
#define XB_TOP      3328
#define XB_TOPGEN   3392
#define XCD_BAR_WORDS 3456
#define XB_SPIN_CAP (1u << 22)
__device__ __forceinline__ unsigned xb_ld(unsigned* p)              { return __hip_atomic_load(p, __ATOMIC_RELAXED, __HIP_MEMORY_SCOPE_AGENT); }
__device__ __forceinline__ unsigned xb_add(unsigned* p, unsigned v) { return __hip_atomic_fetch_add(p, v, __ATOMIC_RELAXED, __HIP_MEMORY_SCOPE_AGENT); }
__device__ __forceinline__ unsigned xb_xcc_id() { return (unsigned)__builtin_amdgcn_s_getreg((3 << 11) | 20) & 0xFu; }
#define XB_SPIN(cond, bar) do { unsigned _sp = 0; while (cond) { __builtin_amdgcn_s_sleep(1); \
    if ((++_sp & 255u) == 0u) { if (xb_ld(&(bar)[XB_TMO])) break; if (_sp > XB_SPIN_CAP) { atomicAdd(&(bar)[XB_TMO], 1u); break; } } } } while (0)
__device__ __forceinline__ void xcd_barrier_complete(unsigned* bar, unsigned x, unsigned G, unsigned& nloc, unsigned& nx) {
    unsigned sum, cnt, mine, sp = 0u;
    for (;;) {
        sum = 0u; cnt = 0u; mine = 0u;
#pragma unroll
        for (unsigned j = 0; j < 16; ++j) { const unsigned c = xb_ld(&bar[XB_XCNT(j)]); sum += c; cnt += (c > 0u) ? 1u : 0u; mine = (j == x) ? c : mine; }
        if (sum == G) break;
        __builtin_amdgcn_s_sleep(1);
        if ((++sp & 255u) == 0u) { if (xb_ld(&bar[XB_TMO])) break; if (sp > XB_SPIN_CAP) { atomicAdd(&bar[XB_TMO], 1u); break; } }
    }
    nloc = mine > 0u ? mine : 1u; nx = cnt > 0u ? cnt : 1u;
}
__device__ __forceinline__ void grid_bar(unsigned* bar, volatile LAS unsigned* st, unsigned G, int wv) {
    asm volatile("s_waitcnt vmcnt(0)" ::: "memory");
    __syncthreads();
    const int lane = lane_id_opaque();
    if (wv == 0 && lane == 0) {
        __builtin_amdgcn_s_waitcnt(0);
        const unsigned x = xb_xcc_id();
        unsigned nloc = st[0], nx = st[1];
        if (nloc == 0u) { xcd_barrier_complete(bar, x, G, nloc, nx); st[0] = nloc; st[1] = nx; }
        const unsigned old = xb_add(&bar[XB_XSUB(x)], 1u);
        const unsigned gen = old / nloc;
        if (old + 1u == (gen + 1u) * nloc) {
            __builtin_amdgcn_fence(__ATOMIC_RELEASE, "agent");
            asm volatile("s_waitcnt vmcnt(0)" ::: "memory");
            const unsigned og = xb_add(&bar[XB_TOP], 1u);
            const unsigned tg = og / nx;
            if (og + 1u == (tg + 1u) * nx) xb_add(&bar[XB_TOPGEN], 1u);
            else XB_SPIN(xb_ld(&bar[XB_TOPGEN]) == tg, bar);
            __builtin_amdgcn_fence(__ATOMIC_ACQUIRE, "agent");
            xb_add(&bar[XB_XGEN(x)], 1u);
            asm volatile("s_waitcnt vmcnt(0)" ::: "memory");
        } else {
            XB_SPIN(xb_ld(&bar[XB_XGEN(x)]) == gen, bar);
            __builtin_amdgcn_fence(__ATOMIC_ACQUIRE, "agent");
            asm volatile("s_waitcnt vmcnt(0)" ::: "memory");
        }
    }
    __syncthreads();
}
__device__ __forceinline__ void p6_finalize(const Ctx& C, int G, int bx, int wv) {
    int tid = (wv << 6) | lane_id_opaque(); asm volatile("" : "+v"(tid));
    unsigned* pcnt = (unsigned*)(C.ws + WS_PCNT); const float* ss3 = (const float*)(C.ws + WS_SS3); const float* wf = C.in[20]; float* out = C.out;
    for (int i = 0; ; ++i) {
        const int L = i * G + bx; if (L + G >= 64 * 8) break; int pm, pn; pg8::tile_of(L, 64, 8, pm, pn);
        if (tid == 0) { unsigned sp = 0; while (xb_ld(&pcnt[64 * pm]) < 8u) { __builtin_amdgcn_s_sleep(1); if (++sp > (1u << 20)) break; }
            __builtin_amdgcn_fence(__ATOMIC_ACQUIRE, "agent"); asm volatile("s_waitcnt vmcnt(0)" ::: "memory"); }
        __syncthreads();
        const int c4 = tid & 63; const f32x4 wv4 = *(const f32x4*)(wf + 256 * pn + 4 * c4);
#pragma unroll 1
        for (int k0 = 0; k0 < 32; k0 += 8) {
            f32x4 v[8]; float rr[8];
#pragma unroll
            for (int k = 0; k < 8; ++k) { const int row = 256 * pm + (tid >> 6) + 8 * (k0 + k);
                v[k] = *(const f32x4*)(out + (size_t)row * DM + 256 * pn + 4 * c4);
                rr[k] = __hip_atomic_load(ss3 + row, __ATOMIC_RELAXED, __HIP_MEMORY_SCOPE_AGENT); }
#pragma unroll
            for (int k = 0; k < 8; ++k) { const int row = 256 * pm + (tid >> 6) + 8 * (k0 + k); const float r = __builtin_amdgcn_rsqf(rr[k] * (1.0f / DM) + RMS_EPS);
                *(f32x4*)(out + (size_t)row * DM + 256 * pn + 4 * c4) = v[k] * r * wv4; }
        }
    }
}
struct Params { const float* in[21]; float* out; unsigned char* ws; };
__global__ void __launch_bounds__(512, 2) fwd_megakernel(Params prm) {
    extern __shared__ __attribute__((aligned(16))) unsigned char lds_raw[];
    LAS unsigned char* lds = (LAS unsigned char*)lds_raw;
    cg::grid_group grid = cg::this_grid();
    const int G = gridDim.x, bx = blockIdx.x;
    const int wv = __builtin_amdgcn_readfirstlane((int)(threadIdx.x >> 6));
    Ctx C;
#pragma unroll
    for (int i = 0; i < 21; ++i) C.in[i] = prm.in[i];
    C.out = prm.out; C.ws = prm.ws;
    unsigned char* ws = prm.ws;
    unsigned* gbar = (unsigned*)(ws + WS_BAR);
    volatile LAS unsigned* bst = (volatile LAS unsigned*)(lds + LDS_BYTES - 16);
#ifndef DUP_BAR
#define DUP_BAR 0
#endif
#define GBAR() do { for (int rb_ = 0; rb_ < 1 + DUP_BAR; ++rb_) grid_bar(gbar, bst, (unsigned)G, wv); } while (0)
    if (bx == 0) for (int i = threadIdx.x; i < XCD_BAR_WORDS; i += 512) gbar[i] = 0u;
    if (bx == 1 || G == 1) for (int i = threadIdx.x; i < 64 * 64; i += 512) ((unsigned*)(ws + WS_PCNT))[i] = 0u;
    if (threadIdx.x < 4) ((LAS unsigned*)(lds + LDS_BYTES - 16))[threadIdx.x] = 0u;
    grid.sync();
    if (threadIdx.x == 0) (void)xb_add(&gbar[XB_XCNT(xb_xcc_id())], 1u);
    for (int rep = 0; rep < 1 + DUP_P0; ++rep) { p0_prologue(C, lds, G, wv); __syncthreads(); }
    GBAR();
    for (int rep = 0; rep < 1 + DUP_FILT; ++rep) p1_filters(C, lds, G, wv);
    { HyProg P; P.K = DM; P.G = G; P.c = bx; P.W = (const bf16_t*)(ws + WS_WIN); P.X = (const bf16_t*)(ws + WS_XB); P.HY = (bf16_t*)(ws + WS_HY); P.r1 = (const float*)(ws + WS_R1S);
      pg8::gemm_stream(lds, P, wv); }
    for (int rep = 0; rep < 1 + DUP_REST; ++rep) { RestProg P; P.K = DM; P.G = G; P.c = bx; P.W = (const bf16_t*)(ws + WS_WIN); P.X = (const bf16_t*)(ws + WS_XB); P.R1A = (bf16_t*)(ws + WS_R1A); P.R1B = (bf16_t*)(ws + WS_R1B); P.R2 = (bf16_t*)prm.out; P.r1 = (const float*)(ws + WS_R1S);
      pg8::gemm_stream(lds, P, wv); }
    GBAR();
    for (int rep = 0; rep < 1 + DUP_PRE; ++rep) qk_prepass(C, G, wv);
    for (int rep = 0; rep < 1 + DUP_HY; ++rep) for (int idx = bx; idx < 1024; idx += G) { const int rd = idx >> 8, bb = idx & 255; hyena_item(C, lds, rd * 256 + (bb & 7) * 32 + (bb >> 3), wv); }
    GBAR();
    for (int rep = 0; rep < 1 + DUP_ML; ++rep) for (int item = bx; item < 256; item += G) mlstm_item(C, lds, item, wv);
    GBAR();
    { BranchProg P; P.K = 1024; P.G = G; P.c = bx; P.YA = (const bf16_t*)(ws + WS_YA); P.YBF = (const bf16_t*)(ws + WS_YBF); P.YBB = (const bf16_t*)(ws + WS_YBB);
      P.WA = (const bf16_t*)(ws + WS_WA); P.WB = (const bf16_t*)(ws + WS_WB); P.R2 = (const bf16_t*)prm.out; P.MIX = (bf16_t*)(ws + WS_MIX);
      pg8::gemm_stream(lds, P, wv); }
    GBAR();
    { ResProg<false> P; P.pcnt = nullptr; P.wf = nullptr; P.K = DM; P.G = G; P.c = bx; P.A = (const bf16_t*)(ws + WS_MIX); P.B = (const bf16_t*)(ws + WS_WOUT); P.base = prm.in[0]; P.base16 = nullptr; P.out = nullptr; P.outb = (bf16_t*)(ws + WS_X1B); P.ss = (float*)(ws + WS_SS2);
      pg8::gemm_stream(lds, P, wv); }
    GBAR();
    for (int rep = 0; rep < 1 + DUP_GU; ++rep) { GuProg P; P.K = DM; P.G = G; P.c = bx; P.X = (const bf16_t*)(ws + WS_X1B); P.W = (const bf16_t*)(ws + WS_WGU); P.HH = (bf16_t*)(ws + WS_HH); P.ss2 = (const float*)(ws + WS_SS2);
      pg8::gemm_stream(lds, P, wv); }
    GBAR();
    { ResProg<true> P; P.pcnt = (unsigned*)(ws + WS_PCNT); P.wf = prm.in[20]; P.K = FFH; P.G = G; P.c = bx; P.A = (const bf16_t*)(ws + WS_HH); P.B = (const bf16_t*)(ws + WS_WD); P.base = nullptr; P.base16 = (const bf16_t*)(ws + WS_X1B); P.out = prm.out; P.outb = nullptr; P.ss = (float*)(ws + WS_SS3);
      pg8::gemm_stream(lds, P, wv); }
    p6_finalize(C, G, bx, wv);
}

extern "C" void kernel_launch(void* const* d_in, const int* in_sizes, int n_in, void* d_out, int out_size, void* d_ws, size_t ws_size, hipStream_t stream) {
    static int grid = 0;
    if (grid == 0) {
        int dev = 0, cus = 0, per_cu = 0;
        hipGetDevice(&dev); hipDeviceGetAttribute(&cus, hipDeviceAttributeMultiprocessorCount, dev);
        if (hipFuncSetAttribute((const void*)fwd_megakernel, hipFuncAttributeMaxDynamicSharedMemorySize, LDS_BYTES) != hipSuccess) { fprintf(stderr, "kernel_launch: hipFuncSetAttribute failed\n"); grid = -1; return; }
        if (hipOccupancyMaxActiveBlocksPerMultiprocessor(&per_cu, (const void*)fwd_megakernel, 512, LDS_BYTES) != hipSuccess || per_cu < 1) { fprintf(stderr, "kernel_launch: occupancy query gave %d\n", per_cu); per_cu = 1; }
        (void)hipGetLastError();
        grid = cus * 1;
        if (n_in != 21 || ws_size < WS_END) { fprintf(stderr, "kernel_launch: unexpected n_in %d or ws %zu\n", n_in, ws_size); grid = -1; return; }
    }
    if (grid < 0) return;
    Params p{};
    for (int i = 0; i < 21; ++i) p.in[i] = (const float*)d_in[i];
    p.out = (float*)d_out; p.ws = (unsigned char*)d_ws;
    void* args[] = {&p};
    hipError_t e = hipLaunchCooperativeKernel((const void*)fwd_megakernel, dim3(grid), dim3(512), args, LDS_BYTES, stream);
    if (e != hipSuccess) fprintf(stderr, "cooperative launch failed: %s (grid %d)\n", hipGetErrorString(e), grid);
}
```

```cpp
#include <hip/hip_runtime.h>
#include <hip/hip_cooperative_groups.h>
#include <cstdio>
namespace cg = cooperative_groups;

#define LAS __attribute__((address_space(3)))
typedef unsigned short bf16_t;
typedef short bf16x8 __attribute__((ext_vector_type(8)));
typedef short bf16x4 __attribute__((ext_vector_type(4)));
typedef float f32x4 __attribute__((ext_vector_type(4)));
typedef float f32x2 __attribute__((ext_vector_type(2)));
typedef unsigned u32x4 __attribute__((ext_vector_type(4)));
typedef unsigned u32x2 __attribute__((ext_vector_type(2)));

constexpr int NB = 4, SEQ = 4096, TOK = NB * SEQ, DM = 2048, HW = 1024, MW = 1024, NHEAD = 4, DH = 256, FFH = 5632;
constexpr int CONVC = 5120, INCOLS = 11280, NFILT = 4096;
constexpr float RMS_EPS = 1e-6f;
constexpr size_t MiB = 1u << 20;
constexpr size_t WS_PCNT = 393216, WS_BAR = 262144, WS_R1S = 0, WS_SS2 = 65536, WS_SS3 = 131072, WS_G = 1 * MiB, WS_H2 = 2 * MiB;
constexpr size_t WS_WA = 4 * MiB, WS_WB = 8 * MiB, WS_WOUT = 12 * MiB, WS_WGU = 20 * MiB, WS_WD = 64 * MiB, WS_WIN = 86 * MiB, WS_XB = 130 * MiB;
constexpr size_t WS_FILT = 194 * MiB, WS_HY = 258 * MiB, WS_R1A = 354 * MiB, WS_R1B = 418 * MiB, WS_END = 494 * MiB;
constexpr size_t WS_QKP = 86 * MiB, WS_YA = 150 * MiB, WS_YBF = 354 * MiB, WS_YBB = 386 * MiB, WS_X1B = 86 * MiB, WS_MIX = 194 * MiB, WS_HH = 258 * MiB;
constexpr size_t WS_GSC = 482 * MiB;
constexpr int LDS_BYTES = 155648;

__device__ __forceinline__ unsigned f2bf(float f) { unsigned u = __float_as_uint(f); return (u + 0x7fffu + ((u >> 16) & 1u)) >> 16; }
__device__ __forceinline__ unsigned pk2(float lo, float hi) { unsigned r; asm volatile("v_cvt_pk_bf16_f32 %0, %1, %2" : "=v"(r) : "v"(lo), "v"(hi)); return r; }
__device__ __forceinline__ float bflo(unsigned w) { return __uint_as_float(w << 16); }
__device__ __forceinline__ float bfhi(unsigned w) { return __uint_as_float(w & 0xffff0000u); }
__device__ __forceinline__ float wave_sum(float v) {
#pragma unroll
    for (int o = 1; o < 64; o <<= 1) v += __shfl_xor(v, o);
    return v;
}
__device__ __forceinline__ size_t blk_off(int row, int k, int K) { return ((size_t)(row >> 7) * (size_t)(K >> 6) + (size_t)(k >> 6)) * 8192 + (size_t)((row & 127) * 64 + (k & 63)); }
__device__ __forceinline__ int lane_id_opaque() { int l; asm volatile("v_mbcnt_lo_u32_b32 %0, -1, 0\n\tv_mbcnt_hi_u32_b32 %0, -1, %0" : "=v"(l)); return l; }
__device__ __forceinline__ float sigmoidf_(float x) { return __builtin_amdgcn_rcpf(1.0f + __expf(-x)); }
__device__ __forceinline__ float siluf_(float x) { return x * __builtin_amdgcn_rcpf(1.0f + __expf(-x)); }

namespace pg8 {
constexpr int BM = 256, BK = 64, HALF = 128, HTB = HALF * BK * 2, STAGE_BYTES = 8 * HTB, NXCD = 8, WGM = 8;
__device__ __forceinline__ int lds_byte(int r, int c) { const int st = (r >> 4) * 2 + (c >> 5), rr = r & 15, cc = c & 31, ob = rr * 64 + cc * 2; return st * 1024 + (ob ^ (((ob >> 9) & 1) << 5)); }
__device__ __forceinline__ void stage_rc(int b, int& R, int& C) { const int st = b / 1024, sb = b % 1024, swz = sb ^ (((sb >> 9) & 1) << 5); R = (st >> 1) * 16 + swz / 64; C = (st & 1) * 32 + (swz % 64) / 2; }
__device__ __forceinline__ int perm32(int rho) { const int n = rho >> 4, i = rho & 15; return 8 * (i >> 2) + 4 * n + (i & 3); }
struct GUnit { const char* A; const char* B; int pm, pn, sub; };
__device__ __forceinline__ void tile_of(int L, int nM, int nN, int& pm, int& pn) {
    const int nwg = nM * nN; int wgid = L; { const int q = nwg / NXCD, r = nwg % NXCD, xcd = wgid % NXCD, off = wgid / NXCD; wgid = (xcd < r ? xcd * (q + 1) : r * (q + 1) + (xcd - r) * q) + off; }
    const int nig = WGM * nN, gid = wgid / nig, fm = gid * WGM, gsz = (nM - fm) < WGM ? (nM - fm) : WGM;
    pm = fm + ((wgid % nig) % gsz); pn = (wgid % nig) / gsz;
}
typedef f32x4 Acc[2][2][4][2];
template <class Prog>
__device__ __forceinline__ void gemm_stream(LAS unsigned char* lds, const Prog& P, int wv) {
    int tid = (wv << 6) | lane_id_opaque(); asm volatile("" : "+v"(tid));
    const int wid = __builtin_amdgcn_readfirstlane(tid >> 6), lane = tid & 63, wr = wid >> 2, wc = wid & 3, fr = lane & 15, fq = lane >> 4;
    const int K = P.K, nt = K / BK;
    unsigned voffA[2], voffB[2];
#pragma unroll
    for (int i = 0; i < 2; ++i) { int R, C; stage_rc(tid * 16 + i * 8192, R, C); const int Rb = Prog::PERM ? ((R & ~31) + perm32(R & 31)) : R;
        voffA[i] = (unsigned)(R * 64 + C) * 2u; voffB[i] = (unsigned)(Rb * 64 + C) * 2u; }
    const size_t kstep = (size_t)(HALF * BK * 2);
    const size_t hstep = (size_t)HALF * K * 2;
    const unsigned ldsw = (unsigned)wid * 1024u;
    const int aoff = lds_byte(wr * 64 + fr, fq * 8), boff = lds_byte(wc * 32 + fr, fq * 8);
#define PG8_SA(b, h) (((b) * 2 + (h)) * HTB)
#define PG8_SB(b, h) ((4 + (b) * 2 + (h)) * HTB)
#define PG8_STAGE(bufoff, gbase, voff) do { _Pragma("unroll") for (int _i = 0; _i < 2; ++_i) \
        __builtin_amdgcn_global_load_lds((const unsigned*)((const char*)(gbase) + (voff)[_i]), (LAS unsigned*)(lds + (bufoff) + ldsw + _i * 8192), 16, 0, 0); } while (0)
#define PG8_LDA(dst, b, h) do { _Pragma("unroll") for (int m = 0; m < 4; ++m) _Pragma("unroll") for (int k = 0; k < 2; ++k) dst[m][k] = *(const LAS bf16x8*)(lds + PG8_SA(b, h) + aoff + m * 2048 + k * 1024); } while (0)
#define PG8_LDB(dst, b, h) do { _Pragma("unroll") for (int n = 0; n < 2; ++n) _Pragma("unroll") for (int k = 0; k < 2; ++k) dst[n][k] = *(const LAS bf16x8*)(lds + PG8_SB(b, h) + boff + n * 2048 + k * 1024); } while (0)
#define PG8_MMA(ai, bj, At, Bt) do { __builtin_amdgcn_s_setprio(1); _Pragma("unroll") for (int m = 0; m < 4; ++m) _Pragma("unroll") for (int n = 0; n < 2; ++n) _Pragma("unroll") for (int k = 0; k < 2; ++k) \
        acc[ai][bj][m][n] = __builtin_amdgcn_mfma_f32_16x16x32_bf16(Bt[n][k], At[m][k], acc[ai][bj][m][n], 0, 0, 0); __builtin_amdgcn_s_setprio(0); } while (0)
#define PG8_WAIT_V(n) asm volatile("s_waitcnt vmcnt(" #n ")" ::: "memory")
#define PG8_WAIT_L(n) asm volatile("s_waitcnt lgkmcnt(" #n ")" ::: "memory")
#define PG8_BAR __builtin_amdgcn_s_barrier()
#define PG8_SCHED __builtin_amdgcn_sched_barrier(0)
    GUnit cur, nxt; int ui = 0;
    if (!P.next(0, cur)) return;
    f32x4 acc[2][2][4][2];
#pragma unroll
    for (int a = 0; a < 2; ++a)
#pragma unroll
        for (int b = 0; b < 2; ++b)
#pragma unroll
            for (int m = 0; m < 4; ++m)
#pragma unroll
                for (int n = 0; n < 2; ++n) acc[a][b][m][n] = (f32x4){0.f, 0.f, 0.f, 0.f};
    bf16x8 At[4][2], B0[2][2], B1[2][2];
    const char* cA = cur.A; const char* cB = cur.B;
    PG8_STAGE(PG8_SB(0, 0), cB, voffB); PG8_STAGE(PG8_SA(0, 0), cA, voffA); PG8_STAGE(PG8_SB(0, 1), cB + hstep, voffB); PG8_STAGE(PG8_SA(0, 1), cA + hstep, voffA);
    if (wr == 1) PG8_BAR;
    PG8_WAIT_V(4); PG8_BAR;
    PG8_STAGE(PG8_SB(1, 0), cB + kstep, voffB); PG8_STAGE(PG8_SA(1, 0), cA + kstep, voffA); PG8_STAGE(PG8_SB(1, 1), cB + hstep + kstep, voffB);
    PG8_WAIT_V(6); PG8_BAR;
    for (;;) {
        const bool has_next = P.next(ui + 1, nxt);
        const char* nA = has_next ? nxt.A : cA; const char* nB = has_next ? nxt.B : cB;
        for (int t = 0; t < nt; t += 2) {
            const bool last = (t == nt - 2);
            const char* a1 = cA + (size_t)(t + 1) * kstep;
            const char* a2 = last ? nA : cA + (size_t)(t + 2) * kstep; const char* b2 = last ? nB : cB + (size_t)(t + 2) * kstep;
            const char* a3 = a2 + kstep; const char* b3 = b2 + kstep;
            PG8_LDB(B0, 0, 0); PG8_SCHED; PG8_LDA(At, 0, 0); PG8_STAGE(PG8_SA(1, 1), a1 + hstep, voffA);
            PG8_WAIT_L(8); PG8_BAR; PG8_WAIT_L(0); PG8_MMA(0, 0, At, B0); PG8_BAR; PG8_SCHED;
            PG8_LDB(B1, 0, 1); PG8_STAGE(PG8_SB(0, 0), b2, voffB);
            PG8_BAR; PG8_WAIT_L(0); PG8_MMA(0, 1, At, B1); PG8_BAR;
            PG8_LDA(At, 0, 1); PG8_STAGE(PG8_SA(0, 0), a2, voffA);
            PG8_BAR; PG8_WAIT_L(0); PG8_MMA(1, 0, At, B0); PG8_BAR; PG8_SCHED;
            PG8_STAGE(PG8_SB(0, 1), b2 + hstep, voffB);
            PG8_WAIT_V(6); PG8_BAR; PG8_MMA(1, 1, At, B1); PG8_BAR;
            PG8_LDB(B0, 1, 0); PG8_SCHED; PG8_LDA(At, 1, 0); PG8_STAGE(PG8_SA(0, 1), a2 + hstep, voffA);
            PG8_WAIT_L(8); PG8_BAR; PG8_WAIT_L(0); PG8_MMA(0, 0, At, B0); PG8_BAR; PG8_SCHED;
            PG8_LDB(B1, 1, 1); PG8_STAGE(PG8_SB(1, 0), b3, voffB);
            PG8_BAR; PG8_WAIT_L(0); PG8_MMA(0, 1, At, B1); PG8_BAR;
            PG8_LDA(At, 1, 1); PG8_STAGE(PG8_SA(1, 0), a3, voffA);
            PG8_BAR; PG8_WAIT_L(0); PG8_MMA(1, 0, At, B0); PG8_BAR; PG8_SCHED;
            PG8_STAGE(PG8_SB(1, 1), b3 + hstep, voffB);
            PG8_WAIT_V(6); PG8_BAR; PG8_MMA(1, 1, At, B1); PG8_BAR;
        }
        if (Prog::FUSE_LAST && !has_next) break;
        P.epi(acc, cur, wr, wc, fr, fq);
        if (!has_next) break;
        cur = nxt; cA = nA; cB = nB; ++ui;
    }
    PG8_WAIT_V(0);
    if (wr == 0) PG8_BAR;
    PG8_BAR;
    if constexpr (Prog::FUSE_LAST) P.epi_last(acc, cur, wr, wc, fr, fq, wv);
#undef PG8_SA
#undef PG8_SB
#undef PG8_STAGE
#undef PG8_LDA
#undef PG8_LDB
#undef PG8_MMA
#undef PG8_WAIT_V
#undef PG8_WAIT_L
#undef PG8_BAR
#undef PG8_SCHED
}
__device__ __forceinline__ void zero_acc(Acc& acc) {
#pragma unroll
    for (int a = 0; a < 2; ++a)
#pragma unroll
        for (int b = 0; b < 2; ++b)
#pragma unroll
            for (int m = 0; m < 4; ++m)
#pragma unroll
                for (int n = 0; n < 2; ++n) acc[a][b][m][n] = (f32x4){0.f, 0.f, 0.f, 0.f};
}
}
using pg8::GUnit; using pg8::Acc;
__device__ __forceinline__ void unpack8(u32x4 w, float (&f)[8]) { f[0] = bflo(w.x); f[1] = bfhi(w.x); f[2] = bflo(w.y); f[3] = bfhi(w.y); f[4] = bflo(w.z); f[5] = bfhi(w.z); f[6] = bflo(w.w); f[7] = bfhi(w.w); }
struct HyProg {
    static constexpr bool FUSE_LAST = false; static constexpr bool PERM = true; int K, G, c; const bf16_t* W; const bf16_t* X; bf16_t* HY; const float* r1;
    __device__ __forceinline__ bool next(int i, GUnit& u) const { const int L = i * G + c; if (L >= 12 * 64) return false; pg8::tile_of(L, 12, 64, u.pm, u.pn);
        u.A = (const char*)(W + (size_t)u.pm * 256 * DM); u.B = (const char*)(X + (size_t)u.pn * 256 * DM); u.sub = 0; return true; }
    __device__ __forceinline__ void epi(Acc& acc, const GUnit& u, int wr, int wc, int fr, int fq) const {
        const int row0 = u.pm * 256 + wr * 64 + fr, col0 = u.pn * 256 + wc * 32 + 8 * fq;
        f32x4 sc[2][2];
#pragma unroll
        for (int bj = 0; bj < 2; ++bj) { sc[bj][0] = *(const f32x4*)(r1 + col0 + bj * 128); sc[bj][1] = *(const f32x4*)(r1 + col0 + bj * 128 + 4); }
#pragma unroll
        for (int ai = 0; ai < 2; ++ai)
#pragma unroll
            for (int m = 0; m < 4; ++m) { bf16_t* rowp = HY + (size_t)(row0 + ai * 128 + m * 16) * TOK + col0;
#pragma unroll
                for (int bj = 0; bj < 2; ++bj) { const f32x4 v0 = acc[ai][bj][m][0] * sc[bj][0], v1 = acc[ai][bj][m][1] * sc[bj][1];
                    u32x4 w; w.x = pk2(v0[0], v0[1]); w.y = pk2(v0[2], v0[3]); w.z = pk2(v1[0], v1[1]); w.w = pk2(v1[2], v1[3]);
                    *(u32x4*)(rowp + bj * 128) = w; } }
        pg8::zero_acc(acc);
    }
};
struct RestProg {
    static constexpr bool FUSE_LAST = false; static constexpr bool PERM = true; int K, G, c; const bf16_t* W; const bf16_t* X; bf16_t* R1A; bf16_t* R1B; bf16_t* R2; const float* r1;
    __device__ __forceinline__ bool next(int i, GUnit& u) const { const int L = i * G + c; if (L >= 64 * 32) return false; pg8::tile_of(L, 64, 32, u.pm, u.pn);
        u.A = (const char*)(X + (size_t)u.pm * 256 * DM); u.B = (const char*)(W + (size_t)(3072 + u.pn * 256) * DM); u.sub = 0; return true; }
    __device__ __forceinline__ void epi(Acc& acc, const GUnit& u, int wr, int wc, int fr, int fq) const {
        const int row0 = u.pm * 256 + wr * 64 + fr; const bool sg = u.pn >= 12;
        bf16_t* base = u.pn < 8 ? R1A + u.pn * 256 : (u.pn < 16 ? R1B + (u.pn - 8) * 256 : R2 + (u.pn - 16) * 256);
        const int pitch = u.pn < 16 ? 2048 : 4096;
        const int col0 = wc * 32 + 8 * fq;
        float rs[2][4];
#pragma unroll
        for (int ai = 0; ai < 2; ++ai)
#pragma unroll
            for (int m = 0; m < 4; ++m) rs[ai][m] = r1[row0 + ai * 128 + m * 16];
#pragma unroll
        for (int ai = 0; ai < 2; ++ai)
#pragma unroll
            for (int m = 0; m < 4; ++m) { const int row = row0 + ai * 128 + m * 16; const float s = rs[ai][m]; bf16_t* rowp = base + (size_t)row * pitch + col0;
#pragma unroll
                for (int bj = 0; bj < 2; ++bj) { f32x4 v0 = acc[ai][bj][m][0] * s, v1 = acc[ai][bj][m][1] * s;
                    if (sg) {
#pragma unroll
                        for (int j = 0; j < 4; ++j) { v0[j] = sigmoidf_(v0[j]); v1[j] = sigmoidf_(v1[j]); } }
                    u32x4 w; w.x = pk2(v0[0], v0[1]); w.y = pk2(v0[2], v0[3]); w.z = pk2(v1[0], v1[1]); w.w = pk2(v1[2], v1[3]);
                    *(u32x4*)(rowp + bj * 128) = w; } }
        pg8::zero_acc(acc);
    }
};
struct BranchProg {
    static constexpr bool FUSE_LAST = false; static constexpr bool PERM = true; int K, G, c; const bf16_t *YA, *YBF, *YBB, *WA, *WB; const bf16_t* R2; bf16_t* MIX;
    __device__ __forceinline__ bool next(int i, GUnit& u) const { const int ti = i / 3, sub = i - 3 * ti; const int L = ti * G + c; if (L >= 64 * 8) return false; pg8::tile_of(L, 64, 8, u.pm, u.pn);
        const bf16_t* a = sub == 0 ? YA : (sub == 1 ? YBF : YBB); const bf16_t* b = sub == 0 ? WA : WB;
        u.A = (const char*)(a + (size_t)u.pm * 256 * 1024); u.B = (const char*)(b + (size_t)u.pn * 256 * 1024); u.sub = sub; return true; }
    __device__ __forceinline__ void epi(Acc& acc, const GUnit& u, int wr, int wc, int fr, int fq) const {
        if (u.sub == 1) return;
        const int row0 = u.pm * 256 + wr * 64 + fr, col0 = u.pn * 256 + wc * 32 + 8 * fq;
#pragma unroll
        for (int ai = 0; ai < 2; ++ai) {
            u32x4 gbw[4][2], gaw[4][2];
#pragma unroll
            for (int m = 0; m < 4; ++m)
#pragma unroll
                for (int bj = 0; bj < 2; ++bj) { const bf16_t* gp = R2 + (size_t)(row0 + ai * 128 + m * 16) * 4096 + col0 + bj * 128;
                    gbw[m][bj] = *(const u32x4*)(gp + 2048); if (u.sub == 0) gaw[m][bj] = *(const u32x4*)gp; else gaw[m][bj] = gbw[m][bj]; }
#pragma unroll
            for (int m = 0; m < 4; ++m) { const int row = row0 + ai * 128 + m * 16;
#pragma unroll
                for (int bj = 0; bj < 2; ++bj) {
                    float gb[8], ga[8]; unpack8(gbw[m][bj], gb); unpack8(gaw[m][bj], ga);
                    if (u.sub == 0) {
#pragma unroll
                        for (int j = 0; j < 4; ++j) { acc[ai][bj][m][0][j] *= ga[j] * __builtin_amdgcn_rcpf(fmaxf(gb[j], 1e-30f)); acc[ai][bj][m][1][j] *= ga[4 + j] * __builtin_amdgcn_rcpf(fmaxf(gb[4 + j], 1e-30f)); }
                    } else {
                        f32x4 v0 = acc[ai][bj][m][0], v1 = acc[ai][bj][m][1];
#pragma unroll
                        for (int j = 0; j < 4; ++j) { v0[j] *= fmaxf(gb[j], 1e-30f); v1[j] *= fmaxf(gb[4 + j], 1e-30f); }
                        u32x4 w; w.x = pk2(v0[0], v0[1]); w.y = pk2(v0[2], v0[3]); w.z = pk2(v1[0], v1[1]); w.w = pk2(v1[2], v1[3]);
                        *(u32x4*)(MIX + blk_off(row, col0 + bj * 128, DM)) = w;
                    } } }
        }
        if (u.sub == 2) pg8::zero_acc(acc);
    }
};
template <bool FUSE> struct ResProg {
    static constexpr bool PERM = false, FUSE_LAST = FUSE; int K, G, c; unsigned* pcnt; const float* wf; const bf16_t* A; const bf16_t* B; const float* base; const bf16_t* base16; float* out; bf16_t* outb; float* ss;
    __device__ __forceinline__ bool next(int i, GUnit& u) const { const int L = i * G + c; if (L >= 64 * 8) return false; pg8::tile_of(L, 64, 8, u.pm, u.pn);
        u.A = (const char*)(A + (size_t)u.pm * 256 * K); u.B = (const char*)(B + (size_t)u.pn * 256 * K); u.sub = 0; return true; }
    __device__ __forceinline__ void epi(Acc& acc, const GUnit& u, int wr, int wc, int fr, int fq) const {
        const int row0 = u.pm * 256 + wr * 64 + fr, col0 = u.pn * 256 + wc * 32 + 4 * fq;
#pragma unroll
        for (int ai = 0; ai < 2; ++ai) {
            f32x4 bs[4][2][2];
#pragma unroll
            for (int m = 0; m < 4; ++m)
#pragma unroll
                for (int bj = 0; bj < 2; ++bj)
#pragma unroll
                    for (int n = 0; n < 2; ++n) { const int row = row0 + ai * 128 + m * 16, col = col0 + bj * 128 + n * 16;
                        if (base16) { const u32x2 w = *(const u32x2*)(base16 + blk_off(row, col, DM)); bs[m][bj][n] = (f32x4){bflo(w.x), bfhi(w.x), bflo(w.y), bfhi(w.y)}; }
                        else bs[m][bj][n] = *(const f32x4*)(base + (size_t)row * DM + col); }
#pragma unroll
            for (int m = 0; m < 4; ++m) { const int row = row0 + ai * 128 + m * 16; const size_t off = (size_t)row * DM + col0; float s = 0.f;
#pragma unroll
                for (int bj = 0; bj < 2; ++bj)
#pragma unroll
                    for (int n = 0; n < 2; ++n) { const f32x4 o = bs[m][bj][n] + acc[ai][bj][m][n];
                        if (out) *(f32x4*)(out + off + bj * 128 + n * 16) = o;
                        s += (o[0] * o[0] + o[1] * o[1]) + (o[2] * o[2] + o[3] * o[3]);
                        if (outb) { u32x2 w; w.x = pk2(o[0], o[1]); w.y = pk2(o[2], o[3]); *(u32x2*)(outb + blk_off(row, col0 + bj * 128 + n * 16, DM)) = w; } }
                s += __shfl_xor(s, 16); s += __shfl_xor(s, 32);
                if (fq == 0) unsafeAtomicAdd(ss + row, s); }
        }
        pg8::zero_acc(acc);
    }
    __device__ __forceinline__ void epi_last(Acc& acc, const GUnit& u, int wr, int wc, int fr, int fq, int wv) const {
        const int row0 = u.pm * 256 + wr * 64 + fr, col0 = u.pn * 256 + wc * 32 + 4 * fq;
#pragma unroll
        for (int ai = 0; ai < 2; ++ai) {
            u32x2 bw[4][2][2];
#pragma unroll
            for (int m = 0; m < 4; ++m)
#pragma unroll
                for (int bj = 0; bj < 2; ++bj)
#pragma unroll
                    for (int n = 0; n < 2; ++n) bw[m][bj][n] = *(const u32x2*)(base16 + blk_off(row0 + ai * 128 + m * 16, col0 + bj * 128 + n * 16, DM));
#pragma unroll
            for (int m = 0; m < 4; ++m) { const int row = row0 + ai * 128 + m * 16; float s = 0.f;
#pragma unroll
                for (int bj = 0; bj < 2; ++bj)
#pragma unroll
                    for (int n = 0; n < 2; ++n) { const u32x2 w = bw[m][bj][n]; const f32x4 o = (f32x4){bflo(w.x), bfhi(w.x), bflo(w.y), bfhi(w.y)} + acc[ai][bj][m][n];
                        acc[ai][bj][m][n] = o; s += (o[0] * o[0] + o[1] * o[1]) + (o[2] * o[2] + o[3] * o[3]); }
                s += __shfl_xor(s, 16); s += __shfl_xor(s, 32);
                if (fq == 0) unsafeAtomicAdd(ss + row, s); }
        }
        asm volatile("s_waitcnt vmcnt(0)" ::: "memory");
        __syncthreads();
        const int lane = lane_id_opaque();
        if (wv == 0 && lane == 0) {
            __builtin_amdgcn_fence(__ATOMIC_RELEASE, "agent"); asm volatile("s_waitcnt vmcnt(0)" ::: "memory");
            for (int i = 0; ; ++i) { const int L = i * G + c; if (L >= 64 * 8) break; int pm, pn; pg8::tile_of(L, 64, 8, pm, pn); __hip_atomic_fetch_add(&pcnt[64 * pm], 1u, __ATOMIC_RELAXED, __HIP_MEMORY_SCOPE_AGENT); }
            unsigned sp = 0; while (__hip_atomic_load(&pcnt[64 * u.pm], __ATOMIC_RELAXED, __HIP_MEMORY_SCOPE_AGENT) < 8u) { __builtin_amdgcn_s_sleep(1); if (++sp > (1u << 20)) break; }
            __builtin_amdgcn_fence(__ATOMIC_ACQUIRE, "agent"); asm volatile("s_waitcnt vmcnt(0)" ::: "memory");
        }
        __syncthreads();
        f32x4 wv4[2][2];
#pragma unroll
        for (int bj = 0; bj < 2; ++bj)
#pragma unroll
            for (int n = 0; n < 2; ++n) wv4[bj][n] = *(const f32x4*)(wf + col0 + bj * 128 + n * 16);
        float rr[2][4];
#pragma unroll
        for (int ai = 0; ai < 2; ++ai)
#pragma unroll
            for (int m = 0; m < 4; ++m) rr[ai][m] = __hip_atomic_load(ss + row0 + ai * 128 + m * 16, __ATOMIC_RELAXED, __HIP_MEMORY_SCOPE_AGENT);
#pragma unroll
        for (int ai = 0; ai < 2; ++ai)
#pragma unroll
            for (int m = 0; m < 4; ++m) { const int row = row0 + ai * 128 + m * 16; const float r = __builtin_amdgcn_rsqf(rr[ai][m] * (1.0f / DM) + RMS_EPS);
#pragma unroll
                for (int bj = 0; bj < 2; ++bj)
#pragma unroll
                    for (int n = 0; n < 2; ++n) *(f32x4*)(out + (size_t)row * DM + col0 + bj * 128 + n * 16) = acc[ai][bj][m][n] * r * wv4[bj][n]; }
    }
};
struct GuProg {
    static constexpr bool FUSE_LAST = false; static constexpr bool PERM = true; int K, G, c; const bf16_t* X; const bf16_t* W; bf16_t* HH; const float* ss2;
    __device__ __forceinline__ bool next(int i, GUnit& u) const { const int L = i * G + c; if (L >= 64 * 44) return false; pg8::tile_of(L, 64, 44, u.pm, u.pn);
        u.A = (const char*)(X + (size_t)u.pm * 256 * DM); u.B = (const char*)(W + (size_t)u.pn * 256 * DM); u.sub = 0; return true; }
    __device__ __forceinline__ void epi(Acc& acc, const GUnit& u, int wr, int wc, int fr, int fq) const {
        const int row0 = u.pm * 256 + wr * 64 + fr, col0 = u.pn * 128 + wc * 32 + 8 * fq;
        float sq[2][4];
#pragma unroll
        for (int ai = 0; ai < 2; ++ai)
#pragma unroll
            for (int m = 0; m < 4; ++m) sq[ai][m] = ss2[row0 + ai * 128 + m * 16];
#pragma unroll
        for (int ai = 0; ai < 2; ++ai)
#pragma unroll
            for (int m = 0; m < 4; ++m) { const int row = row0 + ai * 128 + m * 16; const float r2 = __builtin_amdgcn_rsqf(sq[ai][m] * (1.0f / DM) + RMS_EPS);
                float hv[8];
#pragma unroll
                for (int n = 0; n < 2; ++n)
#pragma unroll
                    for (int j = 0; j < 4; ++j) { const float g = acc[ai][0][m][n][j] * r2, uu = acc[ai][1][m][n][j] * r2; hv[4 * n + j] = siluf_(g) * uu; }
                u32x4 w; w.x = pk2(hv[0], hv[1]); w.y = pk2(hv[2], hv[3]); w.z = pk2(hv[4], hv[5]); w.w = pk2(hv[6], hv[7]);
                *(u32x4*)(HH + blk_off(row, col0, FFH)) = w; }
        pg8::zero_acc(acc);
    }
};
struct Ctx {
    const float* in[21]; float* out; unsigned char* ws;
};
struct TpItem { const float* W; const float* ks; bf16_t* WT; int Nsrc, K, dst_row0, src_col0, kb; };
__device__ __forceinline__ TpItem tp_decode(const Ctx& C, int it) {
    constexpr int I_IN = 32 * 352, I_A = 16 * 64, I_O = 32 * 64, I_GU = 32 * 352;
    unsigned char* ws = C.ws; TpItem t; int r = it;
    if (r < I_IN) { const int nb = r % 352, n0 = nb * 32; t.W = C.in[2]; t.ks = C.in[1]; t.WT = (bf16_t*)(ws + WS_WIN); t.Nsrc = INCOLS; t.K = DM; t.dst_row0 = n0; t.src_col0 = n0 < 7168 ? n0 : n0 + 16; t.kb = r / 352; return t; } r -= I_IN;
    if (r < I_A) { t.W = C.in[14]; t.ks = nullptr; t.WT = (bf16_t*)(ws + WS_WA); t.Nsrc = DM; t.K = HW; t.dst_row0 = (r % 64) * 32; t.src_col0 = t.dst_row0; t.kb = r / 64; return t; } r -= I_A;
    if (r < I_A) { t.W = C.in[15]; t.ks = nullptr; t.WT = (bf16_t*)(ws + WS_WB); t.Nsrc = DM; t.K = MW; t.dst_row0 = (r % 64) * 32; t.src_col0 = t.dst_row0; t.kb = r / 64; return t; } r -= I_A;
    if (r < I_O) { t.W = C.in[16]; t.ks = nullptr; t.WT = (bf16_t*)(ws + WS_WOUT); t.Nsrc = DM; t.K = DM; t.dst_row0 = (r % 64) * 32; t.src_col0 = t.dst_row0; t.kb = r / 64; return t; } r -= I_O;
    if (r < I_GU) { const int nb = r % 352, n0 = nb * 32; const int pn = n0 >> 8, half = (n0 >> 7) & 1, i = n0 & 127;
        t.W = C.in[18]; t.ks = C.in[17]; t.WT = (bf16_t*)(ws + WS_WGU); t.Nsrc = 2 * FFH; t.K = DM; t.dst_row0 = n0; t.src_col0 = half * FFH + 128 * pn + i; t.kb = r / 352; return t; } r -= I_GU;
    t.W = C.in[19]; t.ks = nullptr; t.WT = (bf16_t*)(ws + WS_WD); t.Nsrc = DM; t.K = FFH; t.dst_row0 = (r % 64) * 32; t.src_col0 = t.dst_row0; t.kb = r / 64; return t;
}
__device__ __forceinline__ void tp_load(const TpItem& t, int lane, float (&tv)[32], float (&sv)[32]) {
    const int k0 = 64 * t.kb; const float* wp = t.W + (size_t)(k0 + (lane >> 5)) * t.Nsrc + t.src_col0 + (lane & 31);
#pragma unroll
    for (int i = 0; i < 32; ++i) tv[i] = wp[(size_t)(2 * i) * t.Nsrc];
    const float* kp = t.ks ? t.ks + k0 + (lane >> 5) : nullptr;
#pragma unroll
    for (int i = 0; i < 32; ++i) sv[i] = kp ? kp[2 * i] : 1.0f;
}
__device__ __forceinline__ void p0_prologue(const Ctx& C, LAS unsigned char* lds, int G, int wv) {
    int tid = (wv << 6) | lane_id_opaque(); asm volatile("" : "+v"(tid));
    const int lane = tid & 63, wave = __builtin_amdgcn_readfirstlane(tid >> 6);
    const int gw = blockIdx.x * 8 + wave, NGW = G * 8;
    unsigned char* ws = C.ws;
    LAS float* scr = (LAS float*)(lds + 67584 + wave * 8704);
    {
        constexpr int WGP = 2056;
        LAS bf16_t* wgb = (LAS bf16_t*)lds;
        const float* w_in = C.in[2]; const float* nw = C.in[1];
#pragma unroll 1
        for (int i0 = tid; i0 < DM * 16; i0 += 512 * 16) { float tw[16], tn[16];
#pragma unroll
            for (int u = 0; u < 16; ++u) { const int i = i0 + 512 * u, k = i >> 4, g = i & 15; tw[u] = w_in[(size_t)k * INCOLS + 7168 + g]; tn[u] = nw[k]; }
#pragma unroll
            for (int u = 0; u < 16; ++u) { const int i = i0 + 512 * u, k = i >> 4, g = i & 15; wgb[g * WGP + k] = (bf16_t)f2bf(tw[u] * tn[u]); } }
        __syncthreads();
    }

    {
        constexpr int NIT = 32 * 352 + 2 * 16 * 64 + 32 * 64 + 32 * 352 + 88 * 64;
        float tv[32], sv[32]; TpItem cur, nxt; int it = gw;
        if (it < NIT) { cur = tp_decode(C, it); tp_load(cur, lane, tv, sv); }
        while (it < NIT) {
#pragma unroll
            for (int i = 0; i < 32; ++i) scr[(2 * i + (lane >> 5)) * 33 + (lane & 31)] = tv[i] * sv[i];
            asm volatile("s_waitcnt lgkmcnt(0)" ::: "memory");
            const int nit = it + NGW;
            if (nit < NIT) { nxt = tp_decode(C, nit); tp_load(nxt, lane, tv, sv); }
            const int c = lane & 7, k0 = 64 * cur.kb;
#pragma unroll
            for (int j = 0; j < 4; ++j) { const int n = (lane >> 3) + 8 * j; const LAS float* sp = scr + (8 * c) * 33 + n;
                u32x4 o; o.x = pk2(sp[0 * 33], sp[1 * 33]); o.y = pk2(sp[2 * 33], sp[3 * 33]); o.z = pk2(sp[4 * 33], sp[5 * 33]); o.w = pk2(sp[6 * 33], sp[7 * 33]);
                *(u32x4*)(cur.WT + blk_off(cur.dst_row0 + n, k0 + 8 * c, cur.K)) = o; }
            asm volatile("s_waitcnt lgkmcnt(0)" ::: "memory");
            cur = nxt; it = nit;
        }
    }
    for (int i = blockIdx.x * 512 + tid; i < TOK; i += G * 512) { ((float*)(ws + WS_SS2))[i] = 0.f; ((float*)(ws + WS_SS3))[i] = 0.f; }
    {
        const float* w1 = C.in[5]; const float* b1 = C.in[6]; const float* f1 = C.in[7]; const float* w2 = C.in[8]; const float* b2 = C.in[9]; const float* f2 = C.in[10];
        float* h2 = (float*)(ws + WS_H2);
        for (int t = gw; t < SEQ; t += NGW) {
            const float tl = (float)t / (float)(SEQ - 1);
            const float omega = 6.283185307179586f * (float)t / (float)SEQ;
            float a = b1[lane] + tl * w1[lane];
            float sn, cs;
            { const int bi = lane & 15; const float fr = 1e-4f + (float)bi * ((15.0f - 1e-4f) / 15.0f); sincosf(omega * fr, &sn, &cs); }
#pragma unroll
            for (int i = 0; i < 16; ++i) a += __shfl(cs, i) * w1[(1 + i) * 64 + lane] - __shfl(sn, i) * w1[(17 + i) * 64 + lane];
            const float h1 = sinf(f1[lane] * a);
            float a2 = b2[lane];
#pragma unroll 8
            for (int i = 0; i < 64; ++i) a2 += __shfl(h1, i) * w2[i * 64 + lane];
            h2[t * 64 + lane] = sinf(f2[lane] * a2);
        }
    }
    {
        constexpr int WGP = 2056; LAS bf16_t* wgb = (LAS bf16_t*)lds;
        const float* x = C.in[0]; bf16_t* xb = (bf16_t*)(ws + WS_XB); float* r1 = (float*)(ws + WS_R1S); float* Gt = (float*)(ws + WS_G); const float* gbias = C.in[13];
        const int r = lane & 15, g = lane >> 4; const bool act = r < 8;
        for (int rb = gw; rb < TOK / 8; rb += NGW) {
            const int row = rb * 8 + (r & 7);
            const float* xp = x + (size_t)row * DM + 8 * g;
            f32x4 acc = {0.f, 0.f, 0.f, 0.f}; float ss = 0.f;
#pragma unroll 1
            for (int k8 = 0; k8 < 64; k8 += 8) {
                f32x4 la[8], lb[8];
#pragma unroll
                for (int u = 0; u < 8; ++u) { la[u] = *(const f32x4*)(xp + 32 * (k8 + u)); lb[u] = *(const f32x4*)(xp + 32 * (k8 + u) + 4); }
#pragma unroll
                for (int u = 0; u < 8; ++u) { const int kk = k8 + u; const f32x4 a = la[u], b = lb[u];
                    ss += ((a.x * a.x + a.y * a.y) + (a.z * a.z + a.w * a.w)) + ((b.x * b.x + b.y * b.y) + (b.z * b.z + b.w * b.w));
                    u32x4 o; o.x = pk2(a.x, a.y); o.y = pk2(a.z, a.w); o.z = pk2(b.x, b.y); o.w = pk2(b.z, b.w);
                    *(u32x4*)(xb + blk_off(row, 32 * kk + 8 * g, DM)) = o;
                    if (!act) { o.x = 0u; o.y = 0u; o.z = 0u; o.w = 0u; }
                    const bf16x8 bw = *(const LAS bf16x8*)(wgb + r * WGP + 32 * kk + 8 * g);
                    acc = __builtin_amdgcn_mfma_f32_16x16x32_bf16(__builtin_bit_cast(bf16x8, o), bw, acc, 0, 0, 0); }
            }
            ss += __shfl_xor(ss, 16); ss += __shfl_xor(ss, 32);
            const float rinv = __builtin_amdgcn_rsqf(ss * (1.0f / DM) + RMS_EPS);
            const float gb = gbias[r];
#pragma unroll
            for (int i = 0; i < 4; ++i) { const int m = 4 * g + i; const float rv = __shfl(rinv, m & 7); if (g < 2) Gt[(size_t)(rb * 8 + m) * 16 + r] = acc[i] * rv + gb; }
            if (lane < 8) r1[rb * 8 + lane] = rinv;
        }
    }
}
__device__ __forceinline__ void p1_filters(const Ctx& C, LAS unsigned char* lds, int G, int wv) {
    int tid = (wv << 6) | lane_id_opaque(); asm volatile("" : "+v"(tid));
    const int lane = tid & 63, w = tid >> 6, r = lane & 15, g = lane >> 4;
    const float* w3 = C.in[11]; const float* h2 = (const float*)(C.ws + WS_H2); float* FILT = (float*)(C.ws + WS_FILT);
    for (int item = blockIdx.x; item < 256; item += G) {
        const int n0 = 64 * (item >> 2), t0 = 1024 * (item & 3) + 128 * w;
        bf16x8 af[4][2];
#pragma unroll
        for (int mt = 0; mt < 4; ++mt)
#pragma unroll
            for (int ks = 0; ks < 2; ++ks) { float v[8];
#pragma unroll
                for (int e = 0; e < 8; ++e) v[e] = w3[(size_t)(32 * ks + 8 * g + e) * NFILT + n0 + 16 * mt + r];
                u32x4 o; o.x = pk2(v[0], v[1]); o.y = pk2(v[2], v[3]); o.z = pk2(v[4], v[5]); o.w = pk2(v[6], v[7]); af[mt][ks] = __builtin_bit_cast(bf16x8, o); }
        float dl[4][4];
#pragma unroll
        for (int mt = 0; mt < 4; ++mt)
#pragma unroll
            for (int i = 0; i < 4; ++i) { const int ch = (n0 + 16 * mt + 4 * g + i) & 1023; const float mind = -3.0701134573253945f, maxd = -15.350567286626973f;
                dl[mt][i] = fabsf(mind + (float)ch * ((maxd - mind) / 1023.0f)); }
        bf16x8 bfr[8][2];
#pragma unroll
        for (int nt = 0; nt < 8; ++nt) { const int t = t0 + 16 * nt + r;
#pragma unroll
            for (int ks = 0; ks < 2; ++ks) { const f32x4 a = *(const f32x4*)(h2 + (size_t)t * 64 + 32 * ks + 8 * g), b = *(const f32x4*)(h2 + (size_t)t * 64 + 32 * ks + 8 * g + 4);
                u32x4 o; o.x = pk2(a.x, a.y); o.y = pk2(a.z, a.w); o.z = pk2(b.x, b.y); o.w = pk2(b.z, b.w); bfr[nt][ks] = __builtin_bit_cast(bf16x8, o); } }
#pragma unroll
        for (int nt = 0; nt < 8; ++nt) {
            const int t = t0 + 16 * nt + r;
            const float tl = (float)t / (float)(SEQ - 1);
#pragma unroll
            for (int mt = 0; mt < 4; ++mt) {
                f32x4 acc = {0.f, 0.f, 0.f, 0.f};
                acc = __builtin_amdgcn_mfma_f32_16x16x32_bf16(af[mt][0], bfr[nt][0], acc, 0, 0, 0);
                acc = __builtin_amdgcn_mfma_f32_16x16x32_bf16(af[mt][1], bfr[nt][1], acc, 0, 0, 0);
#pragma unroll
                for (int i = 0; i < 4; ++i) FILT[(size_t)(n0 + 16 * mt + 4 * g + i) * SEQ + t] = acc[i] * __expf(-tl * dl[mt][i]);
            }
        }
    }
}
__device__ __forceinline__ void p7_final(const Ctx& C, int G, int wv) {
    int tid = (wv << 6) | lane_id_opaque(); asm volatile("" : "+v"(tid));
    const int lane = tid & 63, wave = tid >> 6, gw = blockIdx.x * 8 + wave, NGW = G * 8;
    const float* ss3 = (const float*)(C.ws + WS_SS3); const float* wf = C.in[20];
    f32x4 w[8];
#pragma unroll
    for (int j = 0; j < 8; ++j) w[j] = ((const f32x4*)wf)[64 * j + lane];
    for (int row = gw; row < TOK; row += 2 * NGW) {
        const int row2 = row + NGW;
        const bool has2 = row2 < TOK;
        const float r = __builtin_amdgcn_rsqf(ss3[row] * (1.0f / DM) + RMS_EPS), r2 = has2 ? __builtin_amdgcn_rsqf(ss3[row2] * (1.0f / DM) + RMS_EPS) : 0.f;
        f32x4* p = (f32x4*)(C.out + (size_t)row * DM) + lane; f32x4* p2 = (f32x4*)(C.out + (size_t)(has2 ? row2 : row) * DM) + lane;
        f32x4 v[8], u[8];
#pragma unroll
        for (int j = 0; j < 8; ++j) { v[j] = p[64 * j]; u[j] = p2[64 * j]; }
#pragma unroll
        for (int j = 0; j < 8; ++j) p[64 * j] = v[j] * r * w[j];
        if (has2) {
#pragma unroll
            for (int j = 0; j < 8; ++j) p2[64 * j] = u[j] * r2 * w[j]; }
    }
}
#ifndef FFT_HOST
#define FFT_DEV __device__ __forceinline__
#define FFT_PTR LAS f32x2*
#define FFT_SIN(x) __builtin_amdgcn_sinf(x)
#define FFT_COS(x) __builtin_amdgcn_cosf(x)
#else
#define FFT_DEV static inline
#define FFT_PTR f32x2*
#define FFT_SIN(x) sinf(6.283185307179586f * (x))
#define FFT_COS(x) cosf(6.283185307179586f * (x))
#endif
#define PADI(i) ((i) + ((i) >> 4))
FFT_DEV f32x2 cmul(f32x2 a, f32x2 b) { const f32x2 bs = (f32x2){-b.y, b.x}; return (f32x2){a.x, a.x} * b + (f32x2){a.y, a.y} * bs; }
FFT_DEV f32x2 cmulc(f32x2 a, f32x2 b) { return (f32x2){a.x, a.x} * (f32x2){b.x, -b.y} + (f32x2){a.y, a.y} * (f32x2){b.y, b.x}; }
FFT_DEV f32x2 twid(float frac) { f32x2 r; r.x = FFT_COS(frac); r.y = -FFT_SIN(frac); return r; }
template <int M, int CJ> FFT_DEV f32x2 rot8(f32x2 d) {
    const float R = 0.70710678118654752f; f32x2 r;
    if (M == 0) return d;
    if (M == 2) { if (!CJ) { r.x = d.y; r.y = -d.x; } else { r.x = -d.y; r.y = d.x; } return r; }
    if (M == 1) { if (!CJ) { r.x = R * (d.x + d.y); r.y = R * (d.y - d.x); } else { r.x = R * (d.x - d.y); r.y = R * (d.x + d.y); } return r; }
    if (!CJ) { r.x = R * (d.y - d.x); r.y = -R * (d.x + d.y); } else { r.x = -R * (d.x + d.y); r.y = R * (d.x - d.y); } return r;
}
template <int INV, int ZHI, int LOW> FFT_DEV void fft_r8_pass(FFT_PTR buf, int s, int ls  , int tid) {
#pragma unroll 1
    for (int rep = 0; rep < 2; ++rep) {
        const int bf = tid + rep * 512, j = bf & (s - 1), blk = bf >> ls, base = blk * 8 * s + j;
        f32x2 x[8];
#pragma unroll
        for (int m = 0; m < (ZHI ? 4 : 8); ++m) x[m] = buf[PADI(base + m * s)];
        f32x2 w1 = twid((float)j / (float)(8 * s));
        f32x2 w2 = cmul(w1, w1), w4 = cmul(w2, w2);
        if (!INV) {
            if (ZHI) {
                x[4] = cmul(x[0], w1); x[5] = cmul(rot8<1, 0>(x[1]), w1); x[6] = cmul(rot8<2, 0>(x[2]), w1); x[7] = cmul(rot8<3, 0>(x[3]), w1);
            } else {
                { f32x2 a = x[0], b = x[4]; x[0] = a + b; x[4] = cmul(a - b, w1); }
                { f32x2 a = x[1], b = x[5]; x[1] = a + b; x[5] = cmul(rot8<1, 0>(a - b), w1); }
                { f32x2 a = x[2], b = x[6]; x[2] = a + b; x[6] = cmul(rot8<2, 0>(a - b), w1); }
                { f32x2 a = x[3], b = x[7]; x[3] = a + b; x[7] = cmul(rot8<3, 0>(a - b), w1); }
            }
#pragma unroll
            for (int h = 0; h < 8; h += 4) {
                { f32x2 a = x[h], b = x[h + 2]; x[h] = a + b; x[h + 2] = cmul(a - b, w2); }
                { f32x2 a = x[h + 1], b = x[h + 3]; x[h + 1] = a + b; x[h + 3] = cmul(rot8<2, 0>(a - b), w2); }
            }
#pragma unroll
            for (int m = 0; m < 8; m += 2) { f32x2 a = x[m], b = x[m + 1]; x[m] = a + b; x[m + 1] = cmul(a - b, w4); }
        } else {
#pragma unroll
            for (int m = 0; m < 8; m += 2) { f32x2 a = x[m], b = cmulc(x[m + 1], w4); x[m] = a + b; x[m + 1] = a - b; }
#pragma unroll
            for (int h = 0; h < 8; h += 4) {
                { f32x2 a = x[h], b = cmulc(x[h + 2], w2); x[h] = a + b; x[h + 2] = a - b; }
                { f32x2 a = x[h + 1], b = rot8<2, 1>(cmulc(x[h + 3], w2)); x[h + 1] = a + b; x[h + 3] = a - b; }
            }
            { f32x2 a = x[0], b = cmulc(x[4], w1); x[0] = a + b; if (!LOW) x[4] = a - b; }
            { f32x2 a = x[1], b = rot8<1, 1>(cmulc(x[5], w1)); x[1] = a + b; if (!LOW) x[5] = a - b; }
            { f32x2 a = x[2], b = rot8<2, 1>(cmulc(x[6], w1)); x[2] = a + b; if (!LOW) x[6] = a - b; }
            { f32x2 a = x[3], b = rot8<3, 1>(cmulc(x[7], w1)); x[3] = a + b; if (!LOW) x[7] = a - b; }
        }
#pragma unroll
        for (int m = 0; m < (LOW ? 4 : 8); ++m) buf[PADI(base + m * s)] = x[m];
    }
}
FFT_DEV void fft_r2_span1(FFT_PTR buf, int tid) {
#pragma unroll
    for (int rep = 0; rep < 8; ++rep) { const int p = 2 * (tid + rep * 512); f32x2 a = buf[PADI(p)], b = buf[PADI(p + 1)]; buf[PADI(p)] = a + b; buf[PADI(p + 1)] = a - b; }
}
template <int J, int CJ> FFT_DEV f32x2 rot16(f32x2 d) {
    const float C1 = 0.92387953251128674f, S1 = 0.38268343236508977f;
    if ((J & 1) == 0) return rot8<J / 2, CJ>(d);
    const float wr = (J == 1) ? C1 : (J == 3) ? S1 : (J == 5) ? -S1 : -C1;
    const float wi = ((J == 1) ? -S1 : (J == 3) ? -C1 : (J == 5) ? -C1 : -S1) * (CJ ? -1.f : 1.f);
    f32x2 r; r.x = d.x * wr - d.y * wi; r.y = d.x * wi + d.y * wr; return r;
}
FFT_DEV unsigned brev13(unsigned p);
FFT_DEV void fft16_dif(f32x2 (&x)[16]) {
#define BF_(i, j, ROT) { const f32x2 a_ = x[i], b_ = x[j]; x[i] = a_ + b_; x[j] = ROT(a_ - b_); }
    BF_(0, 8, (rot16<0, 0>)) BF_(1, 9, (rot16<1, 0>)) BF_(2, 10, (rot16<2, 0>)) BF_(3, 11, (rot16<3, 0>)) BF_(4, 12, (rot16<4, 0>)) BF_(5, 13, (rot16<5, 0>)) BF_(6, 14, (rot16<6, 0>)) BF_(7, 15, (rot16<7, 0>))
#pragma unroll
    for (int h = 0; h < 16; h += 8) { BF_(h + 0, h + 4, (rot8<0, 0>)) BF_(h + 1, h + 5, (rot8<1, 0>)) BF_(h + 2, h + 6, (rot8<2, 0>)) BF_(h + 3, h + 7, (rot8<3, 0>)) }
#pragma unroll
    for (int h = 0; h < 16; h += 4) { BF_(h + 0, h + 2, (rot8<0, 0>)) BF_(h + 1, h + 3, (rot8<2, 0>)) }
#pragma unroll
    for (int h = 0; h < 16; h += 2) { BF_(h, h + 1, (rot8<0, 0>)) }
#undef BF_
}
FFT_DEV void fft16_dit_inv(f32x2 (&x)[16]) {
#define BI_(i, j, ROT) { const f32x2 a_ = x[i], b_ = ROT(x[j]); x[i] = a_ + b_; x[j] = a_ - b_; }
#pragma unroll
    for (int h = 0; h < 16; h += 2) { BI_(h, h + 1, (rot8<0, 1>)) }
#pragma unroll
    for (int h = 0; h < 16; h += 4) { BI_(h + 0, h + 2, (rot8<0, 1>)) BI_(h + 1, h + 3, (rot8<2, 1>)) }
#pragma unroll
    for (int h = 0; h < 16; h += 8) { BI_(h + 0, h + 4, (rot8<0, 1>)) BI_(h + 1, h + 5, (rot8<1, 1>)) BI_(h + 2, h + 6, (rot8<2, 1>)) BI_(h + 3, h + 7, (rot8<3, 1>)) }
    BI_(0, 8, (rot16<0, 1>)) BI_(1, 9, (rot16<1, 1>)) BI_(2, 10, (rot16<2, 1>)) BI_(3, 11, (rot16<3, 1>)) BI_(4, 12, (rot16<4, 1>)) BI_(5, 13, (rot16<5, 1>)) BI_(6, 14, (rot16<6, 1>)) BI_(7, 15, (rot16<7, 1>))
#undef BI_
}
template <int MODE> FFT_DEV void fft_mid_pass(FFT_PTR wb, FFT_PTR zk, int tid) {
    f32x2 x[16];
#pragma unroll
    for (int e = 0; e < 16; ++e) x[e] = wb[PADI(16 * tid + e)];
    fft16_dif(x);
    if (MODE != 0) {
#pragma unroll
        for (int e = 0; e < 16; ++e) {
            const unsigned p = 16u * (unsigned)tid + (unsigned)e, f = brev13(p), fn = (8192u - f) & 8191u, pn = brev13(fn);
            const f32x2 zf = zk[PADI(p)], zn = zk[PADI(pn)];
            f32x2 kf;
            if (MODE == 1) { kf.x = 0.5f * (zf.x + zn.x); kf.y = 0.5f * (zf.y - zn.y); }
            else           { kf.x = 0.5f * (zf.y + zn.y); kf.y = 0.5f * (zn.x - zf.x); }
            x[e] = cmul(x[e], kf);
        }
        fft16_dit_inv(x);
    }
#pragma unroll
    for (int e = 0; e < 16; ++e) wb[PADI(16 * tid + e)] = x[e];
}
#ifndef FFT_HOST
#define FFT_SYNC() do { asm volatile("s_waitcnt lgkmcnt(0)" ::: "memory"); __builtin_amdgcn_s_barrier(); asm volatile("" ::: "memory"); } while (0)
__device__ __forceinline__ void fft_fwd_full(FFT_PTR buf, int tid) {
    FFT_SYNC(); fft_r8_pass<0, 0, 0>(buf, 1024, 10, tid); FFT_SYNC(); fft_r8_pass<0, 0, 0>(buf, 128, 7, tid); FFT_SYNC(); fft_r8_pass<0, 0, 0>(buf, 16, 4, tid); FFT_SYNC();
    fft_mid_pass<0>(buf, buf, tid); FFT_SYNC();
}
template <int WHICH> __device__ __forceinline__ void fft_conv(FFT_PTR wb, FFT_PTR zk, int tid) {
    FFT_SYNC(); fft_r8_pass<0, 1, 0>(wb, 1024, 10, tid); FFT_SYNC(); fft_r8_pass<0, 0, 0>(wb, 128, 7, tid); FFT_SYNC(); fft_r8_pass<0, 0, 0>(wb, 16, 4, tid); FFT_SYNC();
    fft_mid_pass<1 + WHICH>(wb, zk, tid); FFT_SYNC();
    fft_r8_pass<1, 0, 0>(wb, 16, 4, tid); FFT_SYNC(); fft_r8_pass<1, 0, 0>(wb, 128, 7, tid); FFT_SYNC(); fft_r8_pass<1, 0, 1>(wb, 1024, 10, tid); FFT_SYNC();
}
#endif
FFT_DEV unsigned brev13(unsigned p) {
    unsigned r = 0;
#ifndef FFT_HOST
    r = __brev(p) >> 19;
#else
    for (int i = 0; i < 13; ++i) r |= ((p >> i) & 1u) << (12 - i);
#endif
    return r;
}
FFT_DEV void fft_pointwise(FFT_PTR wb, FFT_PTR zk, int which, int tid) {
#pragma unroll 4
    for (int rep = 0; rep < 16; ++rep) {
        const unsigned p = tid + rep * 512, f = brev13(p), fn = (8192u - f) & 8191u, pn = brev13(fn);
        const f32x2 zf = zk[PADI(p)], zn = zk[PADI(pn)];
        f32x2 kf;
        if (which == 0) { kf.x = 0.5f * (zf.x + zn.x); kf.y = 0.5f * (zf.y - zn.y); }
        else            { kf.x = 0.5f * (zf.y + zn.y); kf.y = 0.5f * (zn.x - zf.x); }
        wb[PADI(p)] = cmul(wb[PADI(p)], kf);
    }
}
__device__ __forceinline__ void qk_prepass(const Ctx& C, int G, int wv) {
    int tid = (wv << 6) | lane_id_opaque(); asm volatile("" : "+v"(tid));
    const bf16_t* R1A = (const bf16_t*)(C.ws + WS_R1A); bf16_t* QKP = (bf16_t*)(C.ws + WS_QKP);
    const float* cw = C.in[3]; const float* cb = C.in[4];
    const int cg8 = tid & 255, half = tid >> 8, col = 8 * cg8;
    float k0[8], k1[8], k2[8], kb[8];
    { const int ch = 3072 + col;
      const f32x4 t0 = *(const f32x4*)(cw + ch), t1 = *(const f32x4*)(cw + ch + 4), t2 = *(const f32x4*)(cw + CONVC + ch), t3 = *(const f32x4*)(cw + CONVC + ch + 4);
      const f32x4 t4 = *(const f32x4*)(cw + 2 * CONVC + ch), t5 = *(const f32x4*)(cw + 2 * CONVC + ch + 4), t6 = *(const f32x4*)(cb + ch), t7 = *(const f32x4*)(cb + ch + 4);
#pragma unroll
      for (int e = 0; e < 4; ++e) { k0[e] = t0[e]; k0[4 + e] = t1[e]; k1[e] = t2[e]; k1[4 + e] = t3[e]; k2[e] = t4[e]; k2[4 + e] = t5[e]; kb[e] = t6[e]; kb[4 + e] = t7[e]; } }
    const float osc = col >= 1024 ? 0.0625f : 1.0f;
    for (int run = blockIdx.x; run < TOK / 64; run += G) {
        const int row0 = run * 64 + half * 32;
#pragma unroll 1
        for (int i0 = 0; i0 < 32; i0 += 4) {
            u32x4 w0[4], w1[4], w2[4];
#pragma unroll
            for (int u = 0; u < 4; ++u) { const int row = row0 + i0 + u, t = row & (SEQ - 1); const bf16_t* p = R1A + (size_t)row * 2048 + col;
                w0[u] = *(const u32x4*)(t > 0 ? p - 2048 : p); w1[u] = *(const u32x4*)p; w2[u] = *(const u32x4*)(t < SEQ - 1 ? p + 2048 : p); }
#pragma unroll
            for (int u = 0; u < 4; ++u) { const int row = row0 + i0 + u, t = row & (SEQ - 1);
                const u32x4 z = {0u, 0u, 0u, 0u}; if (t == 0) w0[u] = z; if (t == SEQ - 1) w2[u] = z;
                float a0[8], a1[8], a2[8]; unpack8(w0[u], a0); unpack8(w1[u], a1); unpack8(w2[u], a2);
                float v[8];
#pragma unroll
                for (int e = 0; e < 8; ++e) v[e] = siluf_(k0[e] * a0[e] + k1[e] * a1[e] + k2[e] * a2[e] + kb[e]) * osc;
                u32x4 o; o.x = pk2(v[0], v[1]); o.y = pk2(v[2], v[3]); o.z = pk2(v[4], v[5]); o.w = pk2(v[6], v[7]);
                *(u32x4*)(QKP + (size_t)row * 2048 + col) = o; }
        }
    }
}
constexpr int ML_KS = 0, ML_KP = 528, ML_SS = 76032, ML_SP = 272, ML_VS = 110848, ML_VP = 80, ML_VW = 121088, ML_CS = 131328, ML_CP = 528, ML_SC = 148224;
static_assert(ML_SC + 4352 <= LDS_BYTES - 16, "mLSTM LDS map");
__device__ __forceinline__ bf16x8 tr_read2(unsigned a0, unsigned a1) {
    bf16x4 lo, hi;
    asm volatile("ds_read_b64_tr_b16 %0, %2\n\tds_read_b64_tr_b16 %1, %3\n\ts_waitcnt lgkmcnt(0)" : "=&v"(lo), "=&v"(hi) : "v"(a0), "v"(a1) : "memory");
    bf16x8 r; r[0] = lo[0]; r[1] = lo[1]; r[2] = lo[2]; r[3] = lo[3]; r[4] = hi[0]; r[5] = hi[1]; r[6] = hi[2]; r[7] = hi[3]; return r;
}
__device__ __forceinline__ bf16x8 cat4(bf16x4 lo, bf16x4 hi) { bf16x8 r; r[0] = lo[0]; r[1] = lo[1]; r[2] = lo[2]; r[3] = lo[3]; r[4] = hi[0]; r[5] = hi[1]; r[6] = hi[2]; r[7] = hi[3]; return r; }
__device__ __forceinline__ void tr_read2x2(unsigned a, unsigned b, unsigned d, bf16x8& ra, bf16x8& rb) {
    bf16x4 l0, h0, l1, h1;
    asm volatile("ds_read_b64_tr_b16 %0, %4\n\tds_read_b64_tr_b16 %1, %5\n\tds_read_b64_tr_b16 %2, %6\n\tds_read_b64_tr_b16 %3, %7\n\ts_waitcnt lgkmcnt(0)"
        : "=&v"(l0), "=&v"(h0), "=&v"(l1), "=&v"(h1) : "v"(a), "v"(a + d), "v"(b), "v"(b + d) : "memory");
    ra = cat4(l0, h0); rb = cat4(l1, h1);
}
__device__ __forceinline__ void tr_read4x2(unsigned a, unsigned b, unsigned d, unsigned c, unsigned e, unsigned d2, bf16x8& ra, bf16x8& rb, bf16x8& rc, bf16x8& re) {
    bf16x4 l0, h0, l1, h1, l2, h2, l3, h3;
    asm volatile("ds_read_b64_tr_b16 %0, %8\n\tds_read_b64_tr_b16 %1, %9\n\tds_read_b64_tr_b16 %2, %10\n\tds_read_b64_tr_b16 %3, %11\n\t"
                 "ds_read_b64_tr_b16 %4, %12\n\tds_read_b64_tr_b16 %5, %13\n\tds_read_b64_tr_b16 %6, %14\n\tds_read_b64_tr_b16 %7, %15\n\ts_waitcnt lgkmcnt(0)"
        : "=&v"(l0), "=&v"(h0), "=&v"(l1), "=&v"(h1), "=&v"(l2), "=&v"(h2), "=&v"(l3), "=&v"(h3)
        : "v"(a), "v"(a + d), "v"(b), "v"(b + d), "v"(c), "v"(c + d2), "v"(e), "v"(e + d2) : "memory");
    ra = cat4(l0, h0); rb = cat4(l1, h1); rc = cat4(l2, h2); re = cat4(l3, h3);
}
__device__ __forceinline__ float bf2f(short s) { return __uint_as_float(((unsigned)(unsigned short)s) << 16); }
__device__ __forceinline__ float logsigmoidf_(float x) { return fminf(x, 0.f) - log1pf(expf(-fabsf(x))); }

__device__ __forceinline__ void mlstm_item(const Ctx& C, LAS unsigned char* lds, int item, int wv) {
    int tid = (wv << 6) | lane_id_opaque(); asm volatile("" : "+v"(tid));
    const int lane = tid & 63, w = __builtin_amdgcn_readfirstlane(tid >> 6), r = lane & 15, g = lane >> 4, q4 = r >> 2, p4 = r & 3;
    const int xcd_ = item & 7, yy_ = item >> 3, vs = yy_ & 7, dir = (yy_ >> 3) & 1, bh = 2 * xcd_ + (yy_ >> 4), b = bh >> 2, h = bh & 3;
    const bf16_t* QKP = (const bf16_t*)(C.ws + WS_QKP); const bf16_t* R1B = (const bf16_t*)(C.ws + WS_R1B); const float* Gt = (const float*)(C.ws + WS_G);
    bf16_t* Y = (bf16_t*)(C.ws + (dir ? WS_YBB : WS_YBF));
    LAS float* SC = (LAS float*)(lds + ML_SC);
    LAS float* s_cs = SC, *s_rj = SC + 128, *s_iw = SC + 256, *s_emj = SC + 384, *s_w0 = SC + 512, *s_w1 = SC + 960, *s_dn = SC + 640, *s_misc = SC + 768;
    LAS float* c_bl = SC + 784, *c_mx = SC + 816, *c_mp = SC + 848, *c_mn = SC + 880, *c_kp = SC + 912;
    float* GS = (float*)(C.ws + WS_GSC) + (size_t)item * 3 * SEQ;
    const unsigned lbase = (unsigned)(size_t)lds;
    const int pc = tid & 31, krow = tid >> 5, vrow = tid >> 2, pv = tid & 3;
    const int sw = w < 4 ? w : 11 - w;
    for (int i = tid; i < 16896 / 4; i += 512) ((LAS unsigned*)(lds + ML_CS))[i] = 0u;
    for (int i = tid; i < 16 * ML_KP / 4; i += 512) ((LAS unsigned*)(lds + ML_KS + 128 * ML_KP))[i] = 0u;
    f32x4 Cacc[3][2];
#pragma unroll
    for (int a = 0; a < 3; ++a) { Cacc[a][0] = (f32x4){0.f, 0.f, 0.f, 0.f}; Cacc[a][1] = (f32x4){0.f, 0.f, 0.f, 0.f}; }
    u32x4 kreg[8], vreg, qn[8]; float bn = 0.f, csn = 0.f, pmn = 0.f;
#define ML_TOK(c_, j_) ((size_t)b * SEQ + (dir ? SEQ - 1 - ((c_) * 128 + (j_)) : ((c_) * 128 + (j_))))
#define ML_PREFETCH(c_) do { \
        _Pragma("unroll") for (int i = 0; i < 8; ++i) kreg[i] = *(const u32x4*)(QKP + ML_TOK(c_, krow + 16 * i) * 2048 + 1024 + h * 256 + 8 * pc); \
        vreg = *(const u32x4*)(R1B + ML_TOK(c_, vrow) * 2048 + h * 256 + vs * 32 + 8 * pv); \
        { const bf16_t* qp = QKP + ML_TOK(c_, 16 * sw + r) * 2048 + h * 256 + 8 * g; _Pragma("unroll") for (int kk = 0; kk < 8; ++kk) qn[kk] = *(const u32x4*)(qp + 32 * kk); } \
        if (tid < 128) { const int ta = (c_) * 128 + tid; bn = GS[ta]; csn = GS[SEQ + ta]; pmn = GS[2 * SEQ + ta]; } } while (0)
    {
        float gi[8], gf[8];
#pragma unroll
        for (int u = 0; u < 8; ++u) { const int ta = (4 * w) * 128 + u * 64 + lane; const size_t tk = (size_t)b * SEQ + (dir ? SEQ - 1 - ta : ta);
            gi[u] = Gt[tk * 16 + (dir * 2) * 4 + h]; gf[u] = Gt[tk * 16 + (dir * 2 + 1) * 4 + h]; }
#pragma unroll
        for (int q = 0; q < 4; ++q) {
            const int c = 4 * w + q; float carry_b = 0.f, carry_m = -3.0e38f;
#pragma unroll
            for (int hf = 0; hf < 2; ++hf) {
                const int ta = c * 128 + hf * 64 + lane;
                const float ip = gi[2 * q + hf], fp = gf[2 * q + hf];
                float xs = logsigmoidf_(fp);
#pragma unroll
                for (int o = 1; o < 64; o <<= 1) { const float y = __shfl_up(xs, o); if (lane >= o) xs += y; }
                const float bj = xs + carry_b; const float cj = ip - bj; float pm = cj;
#pragma unroll
                for (int o = 1; o < 64; o <<= 1) { const float y = __shfl_up(pm, o); if (lane >= o) pm = fmaxf(pm, y); }
                pm = fmaxf(pm, carry_m);
                GS[ta] = bj; GS[SEQ + ta] = cj; GS[2 * SEQ + ta] = pm;
                carry_b = __shfl(bj, 63); carry_m = __shfl(pm, 63);
            }
            if (lane == 0) { c_bl[c] = carry_b; c_mx[c] = carry_m; }
        }
        __syncthreads();
        if (tid == 0) { float m = 0.f;
            for (int c = 0; c < 32; ++c) { const float bl = c_bl[c], mn = fmaxf(bl + m, bl + c_mx[c]); c_mp[c] = m; c_mn[c] = mn; c_kp[c] = __expf(bl + m - mn); m = mn; } }
        __syncthreads();
    }
#define ML_SCALARS(cc, swp) do { if (tid < 128) { const float mp_ = c_mp[cc], mn_ = c_mn[cc], bl_ = c_bl[cc]; const float inter = bn + mp_, mj = fmaxf(inter, bn + pmn); \
        s_cs[tid] = csn; s_rj[tid] = bn - mj; s_iw[tid] = __expf(inter - mj); s_emj[tid] = __expf(-mj); (swp)[tid] = __expf(bl_ + csn - mn_); } } while (0)
    ML_PREFETCH(0);
    ML_SCALARS(0, s_w0);
    __syncthreads();
#define ML_BAR() do { asm volatile("s_waitcnt lgkmcnt(0)" ::: "memory"); __builtin_amdgcn_s_barrier(); asm volatile("" ::: "memory"); } while (0)
#pragma unroll 1
    for (int c = 0; c < 32; ++c) {
        const float keep = c_kp[c]; LAS float* s_w = (c & 1) ? s_w1 : s_w0; LAS float* s_wn = (c & 1) ? s_w0 : s_w1;
#pragma unroll
        for (int i = 0; i < 8; ++i) *(LAS u32x4*)(lds + ML_KS + (krow + 16 * i) * ML_KP + pc * 16) = kreg[i];
        {
            *(LAS u32x4*)(lds + ML_VS + vrow * ML_VP + pv * 16) = vreg;
            float f[8]; unpack8(vreg, f); const float ws_ = s_w[vrow];
            u32x4 o; o.x = pk2(f[0] * ws_, f[1] * ws_); o.y = pk2(f[2] * ws_, f[3] * ws_); o.z = pk2(f[4] * ws_, f[5] * ws_); o.w = pk2(f[6] * ws_, f[7] * ws_);
            *(LAS u32x4*)(lds + ML_VW + vrow * ML_VP + pv * 16) = o;
        }
        bf16x8 qf[8];
#pragma unroll
        for (int kk = 0; kk < 8; ++kk) qf[kk] = __builtin_bit_cast(bf16x8, qn[kk]);
        unsigned short ogr[4][2];
#pragma unroll
        for (int i = 0; i < 4; ++i)
#pragma unroll
            for (int vt = 0; vt < 2; ++vt) ogr[i][vt] = R1B[ML_TOK(c, 16 * sw + 4 * g + i) * 2048 + 1024 + h * 256 + vs * 32 + 16 * vt + r];
        if (c < 31) ML_PREFETCH(c + 1);
        ML_BAR();
        {
            const float rjv = s_rj[16 * sw + r]; const int jloc = 16 * sw + r; float den1 = 0.f;
#pragma unroll 2
            for (int st = 0; st < 8; ++st) {
                if (st <= sw) {
                    f32x4 acc = {0.f, 0.f, 0.f, 0.f};
#pragma unroll
                    for (int kk = 0; kk < 8; ++kk) { const bf16x8 kf = *(const LAS bf16x8*)(lds + ML_KS + (16 * st + r) * ML_KP + (32 * kk + 8 * g) * 2); acc = __builtin_amdgcn_mfma_f32_16x16x32_bf16(kf, qf[kk], acc, 0, 0, 0); }
                    const f32x4 c4 = *(const LAS f32x4*)(s_cs + 16 * st + 4 * g);
                    float v[4];
#pragma unroll
                    for (int i = 0; i < 4; ++i) { const int s = 16 * st + 4 * g + i; const float d = (s <= jloc) ? __expf(rjv + c4[i]) : 0.f; v[i] = acc[i] * d; den1 += v[i]; }
                    u32x2 o; o.x = pk2(v[0], v[1]); o.y = pk2(v[2], v[3]);
                    *(LAS u32x2*)(lds + ML_SS + jloc * ML_SP + (16 * st + 4 * g) * 2) = o;
                } else if (st == sw + 1 && !(sw & 1)) {
                    u32x2 o = {0u, 0u}; *(LAS u32x2*)(lds + ML_SS + jloc * ML_SP + (16 * st + 4 * g) * 2) = o;
                }
            }
            den1 += __shfl_xor(den1, 16); den1 += __shfl_xor(den1, 32);
            f32x4 dacc = {0.f, 0.f, 0.f, 0.f};
#pragma unroll
            for (int kk = 0; kk < 8; ++kk) { const bf16x8 kf = *(const LAS bf16x8*)(lds + ML_KS + (128 + r) * ML_KP + (32 * kk + 8 * g) * 2); dacc = __builtin_amdgcn_mfma_f32_16x16x32_bf16(kf, qf[kk], dacc, 0, 0, 0); }
            const float d2 = dacc[0];
            if (g == 0) s_dn[jloc] = den1 + s_iw[jloc] * d2;
        }
        ML_BAR();
        {
            f32x4 n1[2], n2[2];
#pragma unroll
            for (int vt = 0; vt < 2; ++vt) { n1[vt] = (f32x4){0.f, 0.f, 0.f, 0.f}; n2[vt] = (f32x4){0.f, 0.f, 0.f, 0.f}; }
            const int nks = (sw >> 1) + 1;
#pragma unroll 1
            for (int ks = 0; ks < nks; ++ks) {
                const bf16x8 af = *(const LAS bf16x8*)(lds + ML_SS + (16 * sw + r) * ML_SP + (32 * ks + 8 * g) * 2);
                const unsigned a0 = lbase + ML_VS + (32 * ks + 8 * g + q4) * ML_VP + (4 * p4) * 2;
                bf16x8 b0, b1; tr_read2x2(a0, a0 + 32, 4 * ML_VP, b0, b1);
                n1[0] = __builtin_amdgcn_mfma_f32_16x16x32_bf16(af, b0, n1[0], 0, 0, 0); n1[1] = __builtin_amdgcn_mfma_f32_16x16x32_bf16(af, b1, n1[1], 0, 0, 0);
            }
#pragma unroll
            for (int kk = 0; kk < 8; ++kk)
#pragma unroll
                for (int vt = 0; vt < 2; ++vt) { const bf16x8 cf = *(const LAS bf16x8*)(lds + ML_CS + (16 * vt + r) * ML_CP + (32 * kk + 8 * g) * 2); n2[vt] = __builtin_amdgcn_mfma_f32_16x16x32_bf16(qf[kk], cf, n2[vt], 0, 0, 0); }
            const f32x4 iw4 = *(const LAS f32x4*)(s_iw + 16 * sw + 4 * g), dn4 = *(const LAS f32x4*)(s_dn + 16 * sw + 4 * g), em4 = *(const LAS f32x4*)(s_emj + 16 * sw + 4 * g);
#pragma unroll
            for (int i = 0; i < 4; ++i) {
                const size_t tok = ML_TOK(c, 16 * sw + 4 * g + i);
                const float inv = __builtin_amdgcn_rcpf(fmaxf(fabsf(dn4[i]), em4[i]));
#pragma unroll
                for (int vt = 0; vt < 2; ++vt) { const int col = h * 256 + vs * 32 + 16 * vt + r;
                    const float og = __uint_as_float(((unsigned)ogr[i][vt]) << 16);
                    const float hv = (n1[vt][i] + iw4[i] * n2[vt][i]) * inv * og;
                    Y[blk_off((int)tok, col, 1024)] = (bf16_t)pk2(hv, 0.f); }
            }
        }
        ML_BAR();
        {
#pragma unroll
            for (int a = 0; a < 3; ++a) { Cacc[a][0] *= keep; Cacc[a][1] *= keep; }
#pragma unroll 1
            for (int ks = 0; ks < 4; ++ks) {
                bf16x8 af[3], bq[2];
                { const unsigned av = lbase + ML_VW + (32 * ks + 8 * g + q4) * ML_VP + (4 * p4) * 2, ak = lbase + ML_KS + (32 * ks + 8 * g + q4) * ML_KP + (32 * w + 4 * p4) * 2;
                  tr_read4x2(av, av + 32, 4 * ML_VP, ak, ak + 32, 4 * ML_KP, af[0], af[1], bq[0], bq[1]); }
                { const f32x4 wa = *(const LAS f32x4*)(s_w + 32 * ks + 8 * g), wb = *(const LAS f32x4*)(s_w + 32 * ks + 8 * g + 4);
                  u32x4 o; o.x = pk2(wa[0], wa[1]); o.y = pk2(wa[2], wa[3]); o.z = pk2(wb[0], wb[1]); o.w = pk2(wb[2], wb[3]);
                  if (r != 0) { o.x = 0u; o.y = 0u; o.z = 0u; o.w = 0u; }
                  af[2] = __builtin_bit_cast(bf16x8, o); }
#pragma unroll
                for (int nt = 0; nt < 2; ++nt)
#pragma unroll
                    for (int mt = 0; mt < 3; ++mt) Cacc[mt][nt] = __builtin_amdgcn_mfma_f32_16x16x32_bf16(af[mt], bq[nt], Cacc[mt][nt], 0, 0, 0);
            }
#pragma unroll
            for (int mt = 0; mt < 2; ++mt)
#pragma unroll
                for (int nt = 0; nt < 2; ++nt)
#pragma unroll
                    for (int i = 0; i < 4; ++i) *(LAS bf16_t*)(lds + ML_CS + (16 * mt + 4 * g + i) * ML_CP + (32 * w + 16 * nt + r) * 2) = (bf16_t)pk2(Cacc[mt][nt][i], 0.f);
            if (c < 31) ML_SCALARS(c + 1, s_wn);
            if (g == 0) { *(LAS bf16_t*)(lds + ML_KS + 128 * ML_KP + (32 * w + r) * 2) = (bf16_t)pk2(Cacc[2][0][0], 0.f); *(LAS bf16_t*)(lds + ML_KS + 128 * ML_KP + (32 * w + 16 + r) * 2) = (bf16_t)pk2(Cacc[2][1][0], 0.f); }
        }
        ML_BAR();
    }
#undef ML_SCALARS
#undef ML_BAR
#undef ML_PREFETCH
#undef ML_TOK
}
constexpr int HY_ZK = 0, HY_WB = 69632;
static_assert(HY_WB + 69632 <= LDS_BYTES, "hyena LDS map");
#define GAS __attribute__((address_space(1)))
struct HyRaw { u32x4 c; unsigned l, r; };
__device__ __forceinline__ HyRaw hy_load(const bf16_t* rowp, int tid) { HyRaw x; const GAS bf16_t* p = (const GAS bf16_t*)rowp + 8 * tid; x.c = *(const GAS u32x4*)p; x.l = p[-1]; x.r = p[8]; return x; }
__device__ __forceinline__ void hy_conv8(const HyRaw& x, int tid, float w0, float w1, float w2, float bias, float (&o)[8]) {
    float a[10];
    a[0] = tid > 0 ? __uint_as_float(x.l << 16) : 0.f; a[9] = tid < 511 ? __uint_as_float(x.r << 16) : 0.f;
    a[1] = bflo(x.c.x); a[2] = bfhi(x.c.x); a[3] = bflo(x.c.y); a[4] = bfhi(x.c.y); a[5] = bflo(x.c.z); a[6] = bfhi(x.c.z); a[7] = bflo(x.c.w); a[8] = bfhi(x.c.w);
#pragma unroll
    for (int m = 0; m < 8; ++m) o[m] = w0 * a[m] + w1 * a[m + 1] + w2 * a[m + 2] + bias;
}
__device__ __forceinline__ void hyena_item(const Ctx& C, LAS unsigned char* lds, int ch, int wv) {
    int tid = (wv << 6) | lane_id_opaque(); asm volatile("" : "+v"(tid));
    LAS f32x2* zk = (LAS f32x2*)(lds + HY_ZK); LAS f32x2* wb = (LAS f32x2*)(lds + HY_WB);
    const float* FILT = (const float*)(C.ws + WS_FILT); const bf16_t* HYb = (const bf16_t*)(C.ws + WS_HY); bf16_t* YA = (bf16_t*)(C.ws + WS_YA);
    const float* cw = C.in[3]; const float* cb = C.in[4];
    float w0[3], w1[3], w2[3], bs[3];
#pragma unroll
    for (int s = 0; s < 3; ++s) { w0[s] = cw[s * 1024 + ch]; w1[s] = cw[CONVC + s * 1024 + ch]; w2[s] = cw[2 * CONVC + s * 1024 + ch]; bs[s] = cb[s * 1024 + ch]; }
    const float hb0 = C.in[12][ch], hb1 = C.in[12][1024 + ch];
    const float* F0 = FILT + (size_t)(0 * 1024 + ch) * SEQ; const float* F1 = FILT + (size_t)(1 * 1024 + ch) * SEQ;
    const float* F2 = FILT + (size_t)(2 * 1024 + ch) * SEQ; const float* F3 = FILT + (size_t)(3 * 1024 + ch) * SEQ;
    __syncthreads();
    {
        float fa[16], fb[16];
#pragma unroll
        for (int rep = 0; rep < 8; ++rep) { const int i = tid + 512 * rep; fa[rep] = F0[i]; fb[rep] = F2[i]; }
#pragma unroll
        for (int rep = 8; rep < 16; ++rep) { const int i = tid + 512 * rep; const int j = i == SEQ ? 1 : 2 * SEQ - i; fa[rep] = F1[j]; fb[rep] = F3[j]; }
        if (tid == 0) { fa[8] = 0.f; fb[8] = 0.f; }
#pragma unroll
        for (int rep = 0; rep < 16; ++rep) { const int i = tid + 512 * rep; zk[PADI(i)] = (f32x2){fa[rep] * (1.0f / 8192.0f), fb[rep] * (1.0f / 8192.0f)}; }
    }
    fft_fwd_full(zk, tid);
    const bf16_t* rv = HYb + (size_t)ch * TOK; const bf16_t* rx1 = HYb + (size_t)(1024 + ch) * TOK; const bf16_t* rx2 = HYb + (size_t)(2048 + ch) * TOK;
    HyRaw qa = hy_load(rv, tid), qb = hy_load(rv + SEQ, tid);
#pragma unroll 1
    for (int p = 0; p < 2; ++p) {
        const int tb0 = (2 * p) * SEQ, tb1 = (2 * p + 1) * SEQ;
        f32x2 vv[8], zz[8];
        { float va[8], vb[8]; hy_conv8(qa, tid, w0[0], w1[0], w2[0], bs[0], va); hy_conv8(qb, tid, w0[0], w1[0], w2[0], bs[0], vb);
#pragma unroll
          for (int m = 0; m < 8; ++m) { vv[m].x = va[m]; vv[m].y = vb[m]; wb[PADI(8 * tid + m)] = vv[m]; } }
        qa = hy_load(rx1 + tb0, tid); qb = hy_load(rx1 + tb1, tid);
        fft_conv<0>(wb, zk, tid);
        { float xa[8], xb_[8]; hy_conv8(qa, tid, w0[1], w1[1], w2[1], bs[1], xa); hy_conv8(qb, tid, w0[1], w1[1], w2[1], bs[1], xb_);
#pragma unroll
          for (int m = 0; m < 8; ++m) { const f32x2 y = wb[PADI(8 * tid + m)]; zz[m].x = xa[m] * (y.x + vv[m].x * hb0); zz[m].y = xb_[m] * (y.y + vv[m].y * hb0); }
#pragma unroll
          for (int m = 0; m < 8; ++m) wb[PADI(8 * tid + m)] = zz[m]; }
        qa = hy_load(rx2 + tb0, tid); qb = hy_load(rx2 + tb1, tid);
        fft_conv<1>(wb, zk, tid);
        { float xa[8], xb_[8]; hy_conv8(qa, tid, w0[2], w1[2], w2[2], bs[2], xa); hy_conv8(qb, tid, w0[2], w1[2], w2[2], bs[2], xb_);
          if (p == 0) { qa = hy_load(rv + 2 * SEQ, tid); qb = hy_load(rv + 3 * SEQ, tid); }
#pragma unroll
          for (int m = 0; m < 8; ++m) { const int t = 8 * tid + m; const f32x2 y = wb[PADI(t)];
              YA[blk_off(tb0 + t, ch, 1024)] = (bf16_t)f2bf(xa[m] * (y.x + zz[m].x * hb1));
              YA[blk_off(tb1 + t, ch, 1024)] = (bf16_t)f2bf(xb_[m] * (y.y + zz[m].y * hb1)); } }
        FFT_SYNC();
    }
}
#ifndef DUP_FILT
#define DUP_FILT 0
#endif
#ifndef DUP_PRE
#define DUP_PRE 0
#endif
#ifndef DUP_P0
#define DUP_P0 0
#endif
#ifndef DUP_ML
#define DUP_ML 0
#endif
#ifndef DUP_HY
#define DUP_HY 0
#endif
#ifndef DUP_REST
#define DUP_REST 0
#endif
#ifndef DUP_GU
#define DUP_GU 0
#endif
#define XB_TMO      128
#define XB_XCNT(j)  (256  + 64 * (j))
#define XB_XSUB(j)  (1280 + 64 * (j))
#define XB_XGEN(j)  (2304 + 64 * (j))
#define XB_TOP      3328
#define XB_TOPGEN   3392
#define XCD_BAR_WORDS 3456
#define XB_SPIN_CAP (1u << 22)
__device__ __forceinline__ unsigned xb_ld(unsigned* p)              { return __hip_atomic_load(p, __ATOMIC_RELAXED, __HIP_MEMORY_SCOPE_AGENT); }
__device__ __forceinline__ unsigned xb_add(unsigned* p, unsigned v) { return __hip_atomic_fetch_add(p, v, __ATOMIC_RELAXED, __HIP_MEMORY_SCOPE_AGENT); }
__device__ __forceinline__ unsigned xb_xcc_id() { return (unsigned)__builtin_amdgcn_s_getreg((3 << 11) | 20) & 0xFu; }
#define XB_SPIN(cond, bar) do { unsigned _sp = 0; while (cond) { __builtin_amdgcn_s_sleep(1); \
    if ((++_sp & 255u) == 0u) { if (xb_ld(&(bar)[XB_TMO])) break; if (_sp > XB_SPIN_CAP) { atomicAdd(&(bar)[XB_TMO], 1u); break; } } } } while (0)
__device__ __forceinline__ void xcd_barrier_complete(unsigned* bar, unsigned x, unsigned G, unsigned& nloc, unsigned& nx) {
    unsigned sum, cnt, mine, sp = 0u;
    for (;;) {
        sum = 0u; cnt = 0u; mine = 0u;
#pragma unroll
        for (unsigned j = 0; j < 16; ++j) { const unsigned c = xb_ld(&bar[XB_XCNT(j)]); sum += c; cnt += (c > 0u) ? 1u : 0u; mine = (j == x) ? c : mine; }
        if (sum == G) break;
        __builtin_amdgcn_s_sleep(1);
        if ((++sp & 255u) == 0u) { if (xb_ld(&bar[XB_TMO])) break; if (sp > XB_SPIN_CAP) { atomicAdd(&bar[XB_TMO], 1u); break; } }
    }
    nloc = mine > 0u ? mine : 1u; nx = cnt > 0u ? cnt : 1u;
}
__device__ __forceinline__ void grid_bar(unsigned* bar, volatile LAS unsigned* st, unsigned G, int wv) {
    asm volatile("s_waitcnt vmcnt(0)" ::: "memory");
    __syncthreads();
    const int lane = lane_id_opaque();
    if (wv == 0 && lane == 0) {
        __builtin_amdgcn_s_waitcnt(0);
        const unsigned x = xb_xcc_id();
        unsigned nloc = st[0], nx = st[1];
        if (nloc == 0u) { xcd_barrier_complete(bar, x, G, nloc, nx); st[0] = nloc; st[1] = nx; }
        const unsigned old = xb_add(&bar[XB_XSUB(x)], 1u);
        const unsigned gen = old / nloc;
        if (old + 1u == (gen + 1u) * nloc) {
            __builtin_amdgcn_fence(__ATOMIC_RELEASE, "agent");
            asm volatile("s_waitcnt vmcnt(0)" ::: "memory");
            const unsigned og = xb_add(&bar[XB_TOP], 1u);
            const unsigned tg = og / nx;
            if (og + 1u == (tg + 1u) * nx) xb_add(&bar[XB_TOPGEN], 1u);
            else XB_SPIN(xb_ld(&bar[XB_TOPGEN]) == tg, bar);
            __builtin_amdgcn_fence(__ATOMIC_ACQUIRE, "agent");
            xb_add(&bar[XB_XGEN(x)], 1u);
            asm volatile("s_waitcnt vmcnt(0)" ::: "memory");
        } else {
            XB_SPIN(xb_ld(&bar[XB_XGEN(x)]) == gen, bar);
            __builtin_amdgcn_fence(__ATOMIC_ACQUIRE, "agent");
            asm volatile("s_waitcnt vmcnt(0)" ::: "memory");
        }
    }
    __syncthreads();
}
__device__ __forceinline__ void p6_finalize(const Ctx& C, int G, int bx, int wv) {
    int tid = (wv << 6) | lane_id_opaque(); asm volatile("" : "+v"(tid));
    unsigned* pcnt = (unsigned*)(C.ws + WS_PCNT); const float* ss3 = (const float*)(C.ws + WS_SS3); const float* wf = C.in[20]; float* out = C.out;
    for (int i = 0; ; ++i) {
        const int L = i * G + bx; if (L + G >= 64 * 8) break; int pm, pn; pg8::tile_of(L, 64, 8, pm, pn);
        if (tid == 0) { unsigned sp = 0; while (xb_ld(&pcnt[64 * pm]) < 8u) { __builtin_amdgcn_s_sleep(1); if (++sp > (1u << 20)) break; }
            __builtin_amdgcn_fence(__ATOMIC_ACQUIRE, "agent"); asm volatile("s_waitcnt vmcnt(0)" ::: "memory"); }
        __syncthreads();
        const int c4 = tid & 63; const f32x4 wv4 = *(const f32x4*)(wf + 256 * pn + 4 * c4);
#pragma unroll 1
        for (int k0 = 0; k0 < 32; k0 += 8) {
            f32x4 v[8]; float rr[8];
#pragma unroll
            for (int k = 0; k < 8; ++k) { const int row = 256 * pm + (tid >> 6) + 8 * (k0 + k);
                v[k] = *(const f32x4*)(out + (size_t)row * DM + 256 * pn + 4 * c4);
                rr[k] = __hip_atomic_load(ss3 + row, __ATOMIC_RELAXED, __HIP_MEMORY_SCOPE_AGENT); }
#pragma unroll
            for (int k = 0; k < 8; ++k) { const int row = 256 * pm + (tid >> 6) + 8 * (k0 + k); const float r = __builtin_amdgcn_rsqf(rr[k] * (1.0f / DM) + RMS_EPS);
                *(f32x4*)(out + (size_t)row * DM + 256 * pn + 4 * c4) = v[k] * r * wv4; }
        }
    }
}
struct Params { const float* in[21]; float* out; unsigned char* ws; };
__global__ void __launch_bounds__(512, 2) fwd_megakernel(Params prm) {
    extern __shared__ __attribute__((aligned(16))) unsigned char lds_raw[];
    LAS unsigned char* lds = (LAS unsigned char*)lds_raw;
    cg::grid_group grid = cg::this_grid();
    const int G = gridDim.x, bx = blockIdx.x;
    const int wv = __builtin_amdgcn_readfirstlane((int)(threadIdx.x >> 6));
    Ctx C;
#pragma unroll
    for (int i = 0; i < 21; ++i) C.in[i] = prm.in[i];
    C.out = prm.out; C.ws = prm.ws;
    unsigned char* ws = prm.ws;
    unsigned* gbar = (unsigned*)(ws + WS_BAR);
    volatile LAS unsigned* bst = (volatile LAS unsigned*)(lds + LDS_BYTES - 16);
#ifndef DUP_BAR
#define DUP_BAR 0
#endif
#define GBAR() do { for (int rb_ = 0; rb_ < 1 + DUP_BAR; ++rb_) grid_bar(gbar, bst, (unsigned)G, wv); } while (0)
    if (bx == 0) for (int i = threadIdx.x; i < XCD_BAR_WORDS; i += 512) gbar[i] = 0u;
    if (bx == 1 || G == 1) for (int i = threadIdx.x; i < 64 * 64; i += 512) ((unsigned*)(ws + WS_PCNT))[i] = 0u;
    if (threadIdx.x < 4) ((LAS unsigned*)(lds + LDS_BYTES - 16))[threadIdx.x] = 0u;
    grid.sync();
    if (threadIdx.x == 0) (void)xb_add(&gbar[XB_XCNT(xb_xcc_id())], 1u);
    for (int rep = 0; rep < 1 + DUP_P0; ++rep) { p0_prologue(C, lds, G, wv); __syncthreads(); }
    GBAR();
    for (int rep = 0; rep < 1 + DUP_FILT; ++rep) p1_filters(C, lds, G, wv);
    { HyProg P; P.K = DM; P.G = G; P.c = bx; P.W = (const bf16_t*)(ws + WS_WIN); P.X = (const bf16_t*)(ws + WS_XB); P.HY = (bf16_t*)(ws + WS_HY); P.r1 = (const float*)(ws + WS_R1S);
      pg8::gemm_stream(lds, P, wv); }
    for (int rep = 0; rep < 1 + DUP_REST; ++rep) { RestProg P; P.K = DM; P.G = G; P.c = bx; P.W = (const bf16_t*)(ws + WS_WIN); P.X = (const bf16_t*)(ws + WS_XB); P.R1A = (bf16_t*)(ws + WS_R1A); P.R1B = (bf16_t*)(ws + WS_R1B); P.R2 = (bf16_t*)prm.out; P.r1 = (const float*)(ws + WS_R1S);
      pg8::gemm_stream(lds, P, wv); }
    GBAR();
    for (int rep = 0; rep < 1 + DUP_PRE; ++rep) qk_prepass(C, G, wv);
    for (int rep = 0; rep < 1 + DUP_HY; ++rep) for (int idx = bx; idx < 1024; idx += G) { const int rd = idx >> 8, bb = idx & 255; hyena_item(C, lds, rd * 256 + (bb & 7) * 32 + (bb >> 3), wv); }
    GBAR();
    for (int rep = 0; rep < 1 + DUP_ML; ++rep) for (int item = bx; item < 256; item += G) mlstm_item(C, lds, item, wv);
    GBAR();
    { BranchProg P; P.K = 1024; P.G = G; P.c = bx; P.YA = (const bf16_t*)(ws + WS_YA); P.YBF = (const bf16_t*)(ws + WS_YBF); P.YBB = (const bf16_t*)(ws + WS_YBB);
      P.WA = (const bf16_t*)(ws + WS_WA); P.WB = (const bf16_t*)(ws + WS_WB); P.R2 = (const bf16_t*)prm.out; P.MIX = (bf16_t*)(ws + WS_MIX);
      pg8::gemm_stream(lds, P, wv); }
    GBAR();
    { ResProg<false> P; P.pcnt = nullptr; P.wf = nullptr; P.K = DM; P.G = G; P.c = bx; P.A = (const bf16_t*)(ws + WS_MIX); P.B = (const bf16_t*)(ws + WS_WOUT); P.base = prm.in[0]; P.base16 = nullptr; P.out = nullptr; P.outb = (bf16_t*)(ws + WS_X1B); P.ss = (float*)(ws + WS_SS2);
      pg8::gemm_stream(lds, P, wv); }
    GBAR();
    for (int rep = 0; rep < 1 + DUP_GU; ++rep) { GuProg P; P.K = DM; P.G = G; P.c = bx; P.X = (const bf16_t*)(ws + WS_X1B); P.W = (const bf16_t*)(ws + WS_WGU); P.HH = (bf16_t*)(ws + WS_HH); P.ss2 = (const float*)(ws + WS_SS2);
      pg8::gemm_stream(lds, P, wv); }
    GBAR();
    { ResProg<true> P; P.pcnt = (unsigned*)(ws + WS_PCNT); P.wf = prm.in[20]; P.K = FFH; P.G = G; P.c = bx; P.A = (const bf16_t*)(ws + WS_HH); P.B = (const bf16_t*)(ws + WS_WD); P.base = nullptr; P.base16 = (const bf16_t*)(ws + WS_X1B); P.out = prm.out; P.outb = nullptr; P.ss = (float*)(ws + WS_SS3);
      pg8::gemm_stream(lds, P, wv); }
    p6_finalize(C, G, bx, wv);
}

extern "C" void kernel_launch(void* const* d_in, const int* in_sizes, int n_in, void* d_out, int out_size, void* d_ws, size_t ws_size, hipStream_t stream) {
    static int grid = 0;
    if (grid == 0) {
        int dev = 0, cus = 0, per_cu = 0;
        hipGetDevice(&dev); hipDeviceGetAttribute(&cus, hipDeviceAttributeMultiprocessorCount, dev);
        if (hipFuncSetAttribute((const void*)fwd_megakernel, hipFuncAttributeMaxDynamicSharedMemorySize, LDS_BYTES) != hipSuccess) { fprintf(stderr, "kernel_launch: hipFuncSetAttribute failed\n"); grid = -1; return; }
        if (hipOccupancyMaxActiveBlocksPerMultiprocessor(&per_cu, (const void*)fwd_megakernel, 512, LDS_BYTES) != hipSuccess || per_cu < 1) { fprintf(stderr, "kernel_launch: occupancy query gave %d\n", per_cu); per_cu = 1; }
        (void)hipGetLastError();
        grid = cus * 1;
        if (n_in != 21 || ws_size < WS_END) { fprintf(stderr, "kernel_launch: unexpected n_in %d or ws %zu\n", n_in, ws_size); grid = -1; return; }
    }
    if (grid < 0) return;
    Params p{};
    for (int i = 0; i < 21; ++i) p.in[i] = (const float*)d_in[i];
    p.out = (float*)d_out; p.ws = (unsigned char*)d_ws;
    void* args[] = {&p};
    hipError_t e = hipLaunchCooperativeKernel((const void*)fwd_megakernel, dim3(grid), dim3(512), args, LDS_BYTES, stream);
    if (e != hipSuccess) fprintf(stderr, "cooperative launch failed: %s (grid %d)\n", hipGetErrorString(e), grid);
}
```

```cpp
#include <hip/hip_runtime.h>
#include <hip/hip_cooperative_groups.h>
#include <cstdio>
namespace cg = cooperative_groups;

#define LAS __attribute__((address_space(3)))
typedef unsigned short bf16_t;
typedef short bf16x8 __attribute__((ext_vector_type(8)));
typedef short bf16x4 __attribute__((ext_vector_type(4)));
typedef float f32x4 __attribute__((ext_vector_type(4)));
typedef float f32x2 __attribute__((ext_vector_type(2)));
typedef unsigned u32x4 __attribute__((ext_vector_type(4)));
typedef unsigned u32x2 __attribute__((ext_vector_type(2)));

constexpr int NB = 4, SEQ = 4096, TOK = NB * SEQ, DM = 2048, HW = 1024, MW = 1024, NHEAD = 4, DH = 256, FFH = 5632;
constexpr int CONVC = 5120, INCOLS = 11280, NFILT = 4096;
constexpr float RMS_EPS = 1e-6f;
constexpr size_t MiB = 1u << 20;
constexpr size_t WS_PCNT = 393216, WS_BAR = 262144, WS_R1S = 0, WS_SS2 = 65536, WS_SS3 = 131072, WS_G = 1 * MiB, WS_H2 = 2 * MiB;
constexpr size_t WS_WA = 4 * MiB, WS_WB = 8 * MiB, WS_WOUT = 12 * MiB, WS_WGU = 20 * MiB, WS_WD = 64 * MiB, WS_WIN = 86 * MiB, WS_XB = 130 * MiB;
constexpr size_t WS_FILT = 194 * MiB, WS_HY = 258 * MiB, WS_R1A = 354 * MiB, WS_R1B = 418 * MiB, WS_END = 494 * MiB;
constexpr size_t WS_QKP = 86 * MiB, WS_YA = 150 * MiB, WS_YBF = 354 * MiB, WS_YBB = 386 * MiB, WS_X1B = 86 * MiB, WS_MIX = 194 * MiB, WS_HH = 258 * MiB;
constexpr size_t WS_GSC = 482 * MiB;
constexpr int LDS_BYTES = 155648;

__device__ __forceinline__ unsigned f2bf(float f) { unsigned u = __float_as_uint(f); return (u + 0x7fffu + ((u >> 16) & 1u)) >> 16; }
__device__ __forceinline__ unsigned pk2(float lo, float hi) { unsigned r; asm volatile("v_cvt_pk_bf16_f32 %0, %1, %2" : "=v"(r) : "v"(lo), "v"(hi)); return r; }
__device__ __forceinline__ float bflo(unsigned w) { return __uint_as_float(w << 16); }
__device__ __forceinline__ float bfhi(unsigned w) { return __uint_as_float(w & 0xffff0000u); }
__device__ __forceinline__ float wave_sum(float v) {
#pragma unroll
    for (int o = 1; o < 64; o <<= 1) v += __shfl_xor(v, o);
    return v;
}
__device__ __forceinline__ size_t blk_off(int row, int k, int K) { return ((size_t)(row >> 7) * (size_t)(K >> 6) + (size_t)(k >> 6)) * 8192 + (size_t)((row & 127) * 64 + (k & 63)); }
__device__ __forceinline__ int lane_id_opaque() { int l; asm volatile("v_mbcnt_lo_u32_b32 %0, -1, 0\n\tv_mbcnt_hi_u32_b32 %0, -1, %0" : "=v"(l)); return l; }
__device__ __forceinline__ float sigmoidf_(float x) { return __builtin_amdgcn_rcpf(1.0f + __expf(-x)); }
__device__ __forceinline__ float siluf_(float x) { return x * __builtin_amdgcn_rcpf(1.0f + __expf(-x)); }

namespace pg8 {
constexpr int BM = 256, BK = 64, HALF = 128, HTB = HALF * BK * 2, STAGE_BYTES = 8 * HTB, NXCD = 8, WGM = 8;
__device__ __forceinline__ int lds_byte(int r, int c) { const int st = (r >> 4) * 2 + (c >> 5), rr = r & 15, cc = c & 31, ob = rr * 64 + cc * 2; return st * 1024 + (ob ^ (((ob >> 9) & 1) << 5)); }
__device__ __forceinline__ void stage_rc(int b, int& R, int& C) { const int st = b / 1024, sb = b % 1024, swz = sb ^ (((sb >> 9) & 1) << 5); R = (st >> 1) * 16 + swz / 64; C = (st & 1) * 32 + (swz % 64) / 2; }
__device__ __forceinline__ int perm32(int rho) { const int n = rho >> 4, i = rho & 15; return 8 * (i >> 2) + 4 * n + (i & 3); }
struct GUnit { const char* A; const char* B; int pm, pn, sub; };
__device__ __forceinline__ void tile_of(int L, int nM, int nN, int& pm, int& pn) {
    const int nwg = nM * nN; int wgid = L; { const int q = nwg / NXCD, r = nwg % NXCD, xcd = wgid % NXCD, off = wgid / NXCD; wgid = (xcd < r ? xcd * (q + 1) : r * (q + 1) + (xcd - r) * q) + off; }
    const int nig = WGM * nN, gid = wgid / nig, fm = gid * WGM, gsz = (nM - fm) < WGM ? (nM - fm) : WGM;
    pm = fm + ((wgid % nig) % gsz); pn = (wgid % nig) / gsz;
}
typedef f32x4 Acc[2][2][4][2];
template <class Prog>
__device__ __forceinline__ void gemm_stream(LAS unsigned char* lds, const Prog& P, int wv) {
    int tid = (wv << 6) | lane_id_opaque(); asm volatile("" : "+v"(tid));
    const int wid = __builtin_amdgcn_readfirstlane(tid >> 6), lane = tid & 63, wr = wid >> 2, wc = wid & 3, fr = lane & 15, fq = lane >> 4;
    const int K = P.K, nt = K / BK;
    unsigned voffA[2], voffB[2];
#pragma unroll
    for (int i = 0; i < 2; ++i) { int R, C; stage_rc(tid * 16 + i * 8192, R, C); const int Rb = Prog::PERM ? ((R & ~31) + perm32(R & 31)) : R;
        voffA[i] = (unsigned)(R * 64 + C) * 2u; voffB[i] = (unsigned)(Rb * 64 + C) * 2u; }
    const size_t kstep = (size_t)(HALF * BK * 2);
    const size_t hstep = (size_t)HALF * K * 2;
    const unsigned ldsw = (unsigned)wid * 1024u;
    const int aoff = lds_byte(wr * 64 + fr, fq * 8), boff = lds_byte(wc * 32 + fr, fq * 8);
#define PG8_SA(b, h) (((b) * 2 + (h)) * HTB)
#define PG8_SB(b, h) ((4 + (b) * 2 + (h)) * HTB)
#define PG8_STAGE(bufoff, gbase, voff) do { _Pragma("unroll") for (int _i = 0; _i < 2; ++_i) \
        __builtin_amdgcn_global_load_lds((const unsigned*)((const char*)(gbase) + (voff)[_i]), (LAS unsigned*)(lds + (bufoff) + ldsw + _i * 8192), 16, 0, 0); } while (0)
#define PG8_LDA(dst, b, h) do { _Pragma("unroll") for (int m = 0; m < 4; ++m) _Pragma("unroll") for (int k = 0; k < 2; ++k) dst[m][k] = *(const LAS bf16x8*)(lds + PG8_SA(b, h) + aoff + m * 2048 + k * 1024); } while (0)
#define PG8_LDB(dst, b, h) do { _Pragma("unroll") for (int n = 0; n < 2; ++n) _Pragma("unroll") for (int k = 0; k < 2; ++k) dst[n][k] = *(const LAS bf16x8*)(lds + PG8_SB(b, h) + boff + n * 2048 + k * 1024); } while (0)
#define PG8_MMA(ai, bj, At, Bt) do { __builtin_amdgcn_s_setprio(1); _Pragma("unroll") for (int m = 0; m < 4; ++m) _Pragma("unroll") for (int n = 0; n < 2; ++n) _Pragma("unroll") for (int k = 0; k < 2; ++k) \
        acc[ai][bj][m][n] = __builtin_amdgcn_mfma_f32_16x16x32_bf16(Bt[n][k], At[m][k], acc[ai][bj][m][n], 0, 0, 0); __builtin_amdgcn_s_setprio(0); } while (0)
#define PG8_WAIT_V(n) asm volatile("s_waitcnt vmcnt(" #n ")" ::: "memory")
#define PG8_WAIT_L(n) asm volatile("s_waitcnt lgkmcnt(" #n ")" ::: "memory")
#define PG8_BAR __builtin_amdgcn_s_barrier()
#define PG8_SCHED __builtin_amdgcn_sched_barrier(0)
    GUnit cur, nxt; int ui = 0;
    if (!P.next(0, cur)) return;
    f32x4 acc[2][2][4][2];
#pragma unroll
    for (int a = 0; a < 2; ++a)
#pragma unroll
        for (int b = 0; b < 2; ++b)
#pragma unroll
            for (int m = 0; m < 4; ++m)
#pragma unroll
                for (int n = 0; n < 2; ++n) acc[a][b][m][n] = (f32x4){0.f, 0.f, 0.f, 0.f};
    bf16x8 At[4][2], B0[2][2], B1[2][2];
    const char* cA = cur.A; const char* cB = cur.B;
    PG8_STAGE(PG8_SB(0, 0), cB, voffB); PG8_STAGE(PG8_SA(0, 0), cA, voffA); PG8_STAGE(PG8_SB(0, 1), cB + hstep, voffB); PG8_STAGE(PG8_SA(0, 1), cA + hstep, voffA);
    if (wr == 1) PG8_BAR;
    PG8_WAIT_V(4); PG8_BAR;
    PG8_STAGE(PG8_SB(1, 0), cB + kstep, voffB); PG8_STAGE(PG8_SA(1, 0), cA + kstep, voffA); PG8_STAGE(PG8_SB(1, 1), cB + hstep + kstep, voffB);
    PG8_WAIT_V(6); PG8_BAR;
    for (;;) {
        const bool has_next = P.next(ui + 1, nxt);
        const char* nA = has_next ? nxt.A : cA; const char* nB = has_next ? nxt.B : cB;
        for (int t = 0; t < nt; t += 2) {
            const bool last = (t == nt - 2);
            const char* a1 = cA + (size_t)(t + 1) * kstep;
            const char* a2 = last ? nA : cA + (size_t)(t + 2) * kstep; const char* b2 = last ? nB : cB + (size_t)(t + 2) * kstep;
            const char* a3 = a2 + kstep; const char* b3 = b2 + kstep;
            PG8_LDB(B0, 0, 0); PG8_SCHED; PG8_LDA(At, 0, 0); PG8_STAGE(PG8_SA(1, 1), a1 + hstep, voffA);
            PG8_WAIT_L(8); PG8_BAR; PG8_WAIT_L(0); PG8_MMA(0, 0, At, B0); PG8_BAR; PG8_SCHED;
            PG8_LDB(B1, 0, 1); PG8_STAGE(PG8_SB(0, 0), b2, voffB);
            PG8_BAR; PG8_WAIT_L(0); PG8_MMA(0, 1, At, B1); PG8_BAR;
            PG8_LDA(At, 0, 1); PG8_STAGE(PG8_SA(0, 0), a2, voffA);
            PG8_BAR; PG8_WAIT_L(0); PG8_MMA(1, 0, At, B0); PG8_BAR; PG8_SCHED;
            PG8_STAGE(PG8_SB(0, 1), b2 + hstep, voffB);
            PG8_WAIT_V(6); PG8_BAR; PG8_MMA(1, 1, At, B1); PG8_BAR;
            PG8_LDB(B0, 1, 0); PG8_SCHED; PG8_LDA(At, 1, 0); PG8_STAGE(PG8_SA(0, 1), a2 + hstep, voffA);
            PG8_WAIT_L(8); PG8_BAR; PG8_WAIT_L(0); PG8_MMA(0, 0, At, B0); PG8_BAR; PG8_SCHED;
            PG8_LDB(B1, 1, 1); PG8_STAGE(PG8_SB(1, 0), b3, voffB);
            PG8_BAR; PG8_WAIT_L(0); PG8_MMA(0, 1, At, B1); PG8_BAR;
            PG8_LDA(At, 1, 1); PG8_STAGE(PG8_SA(1, 0), a3, voffA);
            PG8_BAR; PG8_WAIT_L(0); PG8_MMA(1, 0, At, B0); PG8_BAR; PG8_SCHED;
            PG8_STAGE(PG8_SB(1, 1), b3 + hstep, voffB);
            PG8_WAIT_V(6); PG8_BAR; PG8_MMA(1, 1, At, B1); PG8_BAR;
        }
        if (Prog::FUSE_LAST && !has_next) break;
        P.epi(acc, cur, wr, wc, fr, fq);
        if (!has_next) break;
        cur = nxt; cA = nA; cB = nB; ++ui;
    }
    PG8_WAIT_V(0);
    if (wr == 0) PG8_BAR;
    PG8_BAR;
    if constexpr (Prog::FUSE_LAST) P.epi_last(acc, cur, wr, wc, fr, fq, wv);
#undef PG8_SA
#undef PG8_SB
#undef PG8_STAGE
#undef PG8_LDA
#undef PG8_LDB
#undef PG8_MMA
#undef PG8_WAIT_V
#undef PG8_WAIT_L
#undef PG8_BAR
#undef PG8_SCHED
}
__device__ __forceinline__ void zero_acc(Acc& acc) {
#pragma unroll
    for (int a = 0; a < 2; ++a)
#pragma unroll
        for (int b = 0; b < 2; ++b)
#pragma unroll
            for (int m = 0; m < 4; ++m)
#pragma unroll
                for (int n = 0; n < 2; ++n) acc[a][b][m][n] = (f32x4){0.f, 0.f, 0.f, 0.f};
}
}
using pg8::GUnit; using pg8::Acc;
__device__ __forceinline__ void unpack8(u32x4 w, float (&f)[8]) { f[0] = bflo(w.x); f[1] = bfhi(w.x); f[2] = bflo(w.y); f[3] = bfhi(w.y); f[4] = bflo(w.z); f[5] = bfhi(w.z); f[6] = bflo(w.w); f[7] = bfhi(w.w); }
struct HyProg {
    static constexpr bool FUSE_LAST = false; static constexpr bool PERM = true; int K, G, c; const bf16_t* W; const bf16_t* X; bf16_t* HY; const float* r1;
    __device__ __forceinline__ bool next(int i, GUnit& u) const { const int L = i * G + c; if (L >= 12 * 64) return false; pg8::tile_of(L, 12, 64, u.pm, u.pn);
        u.A = (const char*)(W + (size_t)u.pm * 256 * DM); u.B = (const char*)(X + (size_t)u.pn * 256 * DM); u.sub = 0; return true; }
    __device__ __forceinline__ void epi(Acc& acc, const GUnit& u, int wr, int wc, int fr, int fq) const {
        const int row0 = u.pm * 256 + wr * 64 + fr, col0 = u.pn * 256 + wc * 32 + 8 * fq;
        f32x4 sc[2][2];
#pragma unroll
        for (int bj = 0; bj < 2; ++bj) { sc[bj][0] = *(const f32x4*)(r1 + col0 + bj * 128); sc[bj][1] = *(const f32x4*)(r1 + col0 + bj * 128 + 4); }
#pragma unroll
        for (int ai = 0; ai < 2; ++ai)
#pragma unroll
            for (int m = 0; m < 4; ++m) { bf16_t* rowp = HY + (size_t)(row0 + ai * 128 + m * 16) * TOK + col0;
#pragma unroll
                for (int bj = 0; bj < 2; ++bj) { const f32x4 v0 = acc[ai][bj][m][0] * sc[bj][0], v1 = acc[ai][bj][m][1] * sc[bj][1];
                    u32x4 w; w.x = pk2(v0[0], v0[1]); w.y = pk2(v0[2], v0[3]); w.z = pk2(v1[0], v1[1]); w.w = pk2(v1[2], v1[3]);
                    *(u32x4*)(rowp + bj * 128) = w; } }
        pg8::zero_acc(acc);
    }
};
struct RestProg {
    static constexpr bool FUSE_LAST = false; static constexpr bool PERM = true; int K, G, c; const bf16_t* W; const bf16_t* X; bf16_t* R1A; bf16_t* R1B; bf16_t* R2; const float* r1;
    __device__ __forceinline__ bool next(int i, GUnit& u) const { const int L = i * G + c; if (L >= 64 * 32) return false; pg8::tile_of(L, 64, 32, u.pm, u.pn);
        u.A = (const char*)(X + (size_t)u.pm * 256 * DM); u.B = (const char*)(W + (size_t)(3072 + u.pn * 256) * DM); u.sub = 0; return true; }
    __device__ __forceinline__ void epi(Acc& acc, const GUnit& u, int wr, int wc, int fr, int fq) const {
        const int row0 = u.pm * 256 + wr * 64 + fr; const bool sg = u.pn >= 12;
        bf16_t* base = u.pn < 8 ? R1A + u.pn * 256 : (u.pn < 16 ? R1B + (u.pn - 8) * 256 : R2 + (u.pn - 16) * 256);
        const int pitch = u.pn < 16 ? 2048 : 4096;
        const int col0 = wc * 32 + 8 * fq;
        float rs[2][4];
#pragma unroll
        for (int ai = 0; ai < 2; ++ai)
#pragma unroll
            for (int m = 0; m < 4; ++m) rs[ai][m] = r1[row0 + ai * 128 + m * 16];
#pragma unroll
        for (int ai = 0; ai < 2; ++ai)
#pragma unroll
            for (int m = 0; m < 4; ++m) { const int row = row0 + ai * 128 + m * 16; const float s = rs[ai][m]; bf16_t* rowp = base + (size_t)row * pitch + col0;
#pragma unroll
                for (int bj = 0; bj < 2; ++bj) { f32x4 v0 = acc[ai][bj][m][0] * s, v1 = acc[ai][bj][m][1] * s;
                    if (sg) {
#pragma unroll
                        for (int j = 0; j < 4; ++j) { v0[j] = sigmoidf_(v0[j]); v1[j] = sigmoidf_(v1[j]); } }
                    u32x4 w; w.x = pk2(v0[0], v0[1]); w.y = pk2(v0[2], v0[3]); w.z = pk2(v1[0], v1[1]); w.w = pk2(v1[2], v1[3]);
                    *(u32x4*)(rowp + bj * 128) = w; } }
        pg8::zero_acc(acc);
    }
};
struct InProg {
    static constexpr bool FUSE_LAST = false, PERM = true; int K, G, c; HyProg H; RestProg R;
    __device__ __forceinline__ void prefetch(const GUnit&, int, int, float (&pf)[8]) const {}
    __device__ __forceinline__ bool next(int i, GUnit& u) const {
        int L = i * G + c;
        if (L < 12 * 64) { pg8::tile_of(L, 12, 64, u.pm, u.pn); u.A = (const char*)(H.W + (size_t)u.pm * 256 * DM); u.B = (const char*)(H.X + (size_t)u.pn * 256 * DM); u.sub = 1; return true; }
        L -= 12 * 64; if (L >= 64 * 32) return false;
        pg8::tile_of(L, 64, 32, u.pm, u.pn); u.A = (const char*)(R.X + (size_t)u.pm * 256 * DM); u.B = (const char*)(R.W + (size_t)(3072 + u.pn * 256) * DM); u.sub = 0; return true; }
    __device__ __forceinline__ void epi(Acc& acc, const GUnit& u, int wr, int wc, int fr, int fq) const { if (u.sub == 1) H.epi(acc, u, wr, wc, fr, fq); else R.epi(acc, u, wr, wc, fr, fq); }
};
struct BranchProg {
    static constexpr bool FUSE_LAST = false; static constexpr bool PERM = true; int K, G, c; const bf16_t *YA, *YBF, *YBB, *WA, *WB; const bf16_t* R2; bf16_t* MIX;
    __device__ __forceinline__ bool next(int i, GUnit& u) const { const int ti = i / 3, sub = i - 3 * ti; const int L = ti * G + c; if (L >= 64 * 8) return false; pg8::tile_of(L, 64, 8, u.pm, u.pn);
        const bf16_t* a = sub == 0 ? YA : (sub == 1 ? YBF : YBB); const bf16_t* b = sub == 0 ? WA : WB;
        u.A = (const char*)(a + (size_t)u.pm * 256 * 1024); u.B = (const char*)(b + (size_t)u.pn * 256 * 1024); u.sub = sub; return true; }
    __device__ __forceinline__ void epi(Acc& acc, const GUnit& u, int wr, int wc, int fr, int fq) const {
        if (u.sub == 1) return;
        const int row0 = u.pm * 256 + wr * 64 + fr, col0 = u.pn * 256 + wc * 32 + 8 * fq;
#pragma unroll
        for (int ai = 0; ai < 2; ++ai) {
            u32x4 gbw[4][2], gaw[4][2];
#pragma unroll
            for (int m = 0; m < 4; ++m)
#pragma unroll
                for (int bj = 0; bj < 2; ++bj) { const bf16_t* gp = R2 + (size_t)(row0 + ai * 128 + m * 16) * 4096 + col0 + bj * 128;
                    gbw[m][bj] = *(const u32x4*)(gp + 2048); if (u.sub == 0) gaw[m][bj] = *(const u32x4*)gp; else gaw[m][bj] = gbw[m][bj]; }
#pragma unroll
            for (int m = 0; m < 4; ++m) { const int row = row0 + ai * 128 + m * 16;
#pragma unroll
                for (int bj = 0; bj < 2; ++bj) {
                    float gb[8], ga[8]; unpack8(gbw[m][bj], gb); unpack8(gaw[m][bj], ga);
                    if (u.sub == 0) {
#pragma unroll
                        for (int j = 0; j < 4; ++j) { acc[ai][bj][m][0][j] *= ga[j] * __builtin_amdgcn_rcpf(fmaxf(gb[j], 1e-30f)); acc[ai][bj][m][1][j] *= ga[4 + j] * __builtin_amdgcn_rcpf(fmaxf(gb[4 + j], 1e-30f)); }
                    } else {
                        f32x4 v0 = acc[ai][bj][m][0], v1 = acc[ai][bj][m][1];
#pragma unroll
                        for (int j = 0; j < 4; ++j) { v0[j] *= fmaxf(gb[j], 1e-30f); v1[j] *= fmaxf(gb[4 + j], 1e-30f); }
                        u32x4 w; w.x = pk2(v0[0], v0[1]); w.y = pk2(v0[2], v0[3]); w.z = pk2(v1[0], v1[1]); w.w = pk2(v1[2], v1[3]);
                        *(u32x4*)(MIX + blk_off(row, col0 + bj * 128, DM)) = w;
                    } } }
        }
        if (u.sub == 2) pg8::zero_acc(acc);
    }
};
template <bool FUSE> struct ResProg {
    static constexpr bool PERM = false, FUSE_LAST = FUSE; int K, G, c; unsigned* pcnt; const float* wf; const bf16_t* A; const bf16_t* B; const float* base; const bf16_t* base16; float* out; bf16_t* outb; float* ss;
    __device__ __forceinline__ bool next(int i, GUnit& u) const { const int L = i * G + c; if (L >= 64 * 8) return false; pg8::tile_of(L, 64, 8, u.pm, u.pn);
        u.A = (const char*)(A + (size_t)u.pm * 256 * K); u.B = (const char*)(B + (size_t)u.pn * 256 * K); u.sub = 0; return true; }
    __device__ __forceinline__ void epi(Acc& acc, const GUnit& u, int wr, int wc, int fr, int fq) const {
        const int row0 = u.pm * 256 + wr * 64 + fr, col0 = u.pn * 256 + wc * 32 + 4 * fq;
#pragma unroll
        for (int ai = 0; ai < 2; ++ai) {
            f32x4 bs[4][2][2];
#pragma unroll
            for (int m = 0; m < 4; ++m)
#pragma unroll
                for (int bj = 0; bj < 2; ++bj)
#pragma unroll
                    for (int n = 0; n < 2; ++n) { const int row = row0 + ai * 128 + m * 16, col = col0 + bj * 128 + n * 16;
                        if (base16) { const u32x2 w = *(const u32x2*)(base16 + blk_off(row, col, DM)); bs[m][bj][n] = (f32x4){bflo(w.x), bfhi(w.x), bflo(w.y), bfhi(w.y)}; }
                        else bs[m][bj][n] = *(const f32x4*)(base + (size_t)row * DM + col); }
#pragma unroll
            for (int m = 0; m < 4; ++m) { const int row = row0 + ai * 128 + m * 16; const size_t off = (size_t)row * DM + col0; float s = 0.f;
#pragma unroll
                for (int bj = 0; bj < 2; ++bj)
#pragma unroll
                    for (int n = 0; n < 2; ++n) { const f32x4 o = bs[m][bj][n] + acc[ai][bj][m][n];
                        if (out) *(f32x4*)(out + off + bj * 128 + n * 16) = o;
                        s += (o[0] * o[0] + o[1] * o[1]) + (o[2] * o[2] + o[3] * o[3]);
                        if (outb) { u32x2 w; w.x = pk2(o[0], o[1]); w.y = pk2(o[2], o[3]); *(u32x2*)(outb + blk_off(row, col0 + bj * 128 + n * 16, DM)) = w; } }
                s += __shfl_xor(s, 16); s += __shfl_xor(s, 32);
                if (fq == 0) unsafeAtomicAdd(ss + row, s); }
        }
        pg8::zero_acc(acc);
    }
    __device__ __forceinline__ void epi_last(Acc& acc, const GUnit& u, int wr, int wc, int fr, int fq, int wv) const {
        const int row0 = u.pm * 256 + wr * 64 + fr, col0 = u.pn * 256 + wc * 32 + 4 * fq;
#pragma unroll
        for (int ai = 0; ai < 2; ++ai) {
            u32x2 bw[4][2][2];
#pragma unroll
            for (int m = 0; m < 4; ++m)
#pragma unroll
                for (int bj = 0; bj < 2; ++bj)
#pragma unroll
                    for (int n = 0; n < 2; ++n) bw[m][bj][n] = *(const u32x2*)(base16 + blk_off(row0 + ai * 128 + m * 16, col0 + bj * 128 + n * 16, DM));
#pragma unroll
            for (int m = 0; m < 4; ++m) { const int row = row0 + ai * 128 + m * 16; float s = 0.f;
#pragma unroll
                for (int bj = 0; bj < 2; ++bj)
#pragma unroll
                    for (int n = 0; n < 2; ++n) { const u32x2 w = bw[m][bj][n]; const f32x4 o = (f32x4){bflo(w.x), bfhi(w.x), bflo(w.y), bfhi(w.y)} + acc[ai][bj][m][n];
                        acc[ai][bj][m][n] = o; s += (o[0] * o[0] + o[1] * o[1]) + (o[2] * o[2] + o[3] * o[3]); }
                s += __shfl_xor(s, 16); s += __shfl_xor(s, 32);
                if (fq == 0) unsafeAtomicAdd(ss + row, s); }
        }
        asm volatile("s_waitcnt vmcnt(0)" ::: "memory");
        __syncthreads();
        const int lane = lane_id_opaque();
        if (wv == 0 && lane == 0) {
            __builtin_amdgcn_fence(__ATOMIC_RELEASE, "agent"); asm volatile("s_waitcnt vmcnt(0)" ::: "memory");
            for (int i = 0; ; ++i) { const int L = i * G + c; if (L >= 64 * 8) break; int pm, pn; pg8::tile_of(L, 64, 8, pm, pn); __hip_atomic_fetch_add(&pcnt[64 * pm], 1u, __ATOMIC_RELAXED, __HIP_MEMORY_SCOPE_AGENT); }
            unsigned sp = 0; while (__hip_atomic_load(&pcnt[64 * u.pm], __ATOMIC_RELAXED, __HIP_MEMORY_SCOPE_AGENT) < 8u) { __builtin_amdgcn_s_sleep(1); if (++sp > (1u << 20)) break; }
            __builtin_amdgcn_fence(__ATOMIC_ACQUIRE, "agent"); asm volatile("s_waitcnt vmcnt(0)" ::: "memory");
        }
        __syncthreads();
        f32x4 wv4[2][2];
#pragma unroll
        for (int bj = 0; bj < 2; ++bj)
#pragma unroll
            for (int n = 0; n < 2; ++n) wv4[bj][n] = *(const f32x4*)(wf + col0 + bj * 128 + n * 16);
        float rr[2][4];
#pragma unroll
        for (int ai = 0; ai < 2; ++ai)
#pragma unroll
            for (int m = 0; m < 4; ++m) rr[ai][m] = __hip_atomic_load(ss + row0 + ai * 128 + m * 16, __ATOMIC_RELAXED, __HIP_MEMORY_SCOPE_AGENT);
#pragma unroll
        for (int ai = 0; ai < 2; ++ai)
#pragma unroll
            for (int m = 0; m < 4; ++m) { const int row = row0 + ai * 128 + m * 16; const float r = __builtin_amdgcn_rsqf(rr[ai][m] * (1.0f / DM) + RMS_EPS);
#pragma unroll
                for (int bj = 0; bj < 2; ++bj)
#pragma unroll
                    for (int n = 0; n < 2; ++n) *(f32x4*)(out + (size_t)row * DM + col0 + bj * 128 + n * 16) = acc[ai][bj][m][n] * r * wv4[bj][n]; }
    }
};
struct GuProg {
    static constexpr bool FUSE_LAST = false; static constexpr bool PERM = true; int K, G, c; const bf16_t* X; const bf16_t* W; bf16_t* HH; const float* ss2;
    __device__ __forceinline__ bool next(int i, GUnit& u) const { const int L = i * G + c; if (L >= 64 * 44) return false; pg8::tile_of(L, 64, 44, u.pm, u.pn);
        u.A = (const char*)(X + (size_t)u.pm * 256 * DM); u.B = (const char*)(W + (size_t)u.pn * 256 * DM); u.sub = 0; return true; }
    __device__ __forceinline__ void epi(Acc& acc, const GUnit& u, int wr, int wc, int fr, int fq) const {
        const int row0 = u.pm * 256 + wr * 64 + fr, col0 = u.pn * 128 + wc * 32 + 8 * fq;
        float sq[2][4];
#pragma unroll
        for (int ai = 0; ai < 2; ++ai)
#pragma unroll
            for (int m = 0; m < 4; ++m) sq[ai][m] = ss2[row0 + ai * 128 + m * 16];
#pragma unroll
        for (int ai = 0; ai < 2; ++ai)
#pragma unroll
            for (int m = 0; m < 4; ++m) { const int row = row0 + ai * 128 + m * 16; const float r2 = __builtin_amdgcn_rsqf(sq[ai][m] * (1.0f / DM) + RMS_EPS);
                float hv[8];
#pragma unroll
                for (int n = 0; n < 2; ++n)
#pragma unroll
                    for (int j = 0; j < 4; ++j) { const float g = acc[ai][0][m][n][j] * r2, uu = acc[ai][1][m][n][j] * r2; hv[4 * n + j] = siluf_(g) * uu; }
                u32x4 w; w.x = pk2(hv[0], hv[1]); w.y = pk2(hv[2], hv[3]); w.z = pk2(hv[4], hv[5]); w.w = pk2(hv[6], hv[7]);
                *(u32x4*)(HH + blk_off(row, col0, FFH)) = w; }
        pg8::zero_acc(acc);
    }
};
struct Ctx {
    const float* in[21]; float* out; unsigned char* ws;
};
struct TpItem { const float* W; const float* ks; bf16_t* WT; int Nsrc, K, dst_row0, src_col0, kb; };
__device__ __forceinline__ TpItem tp_decode(const Ctx& C, int it) {
    constexpr int I_IN = 32 * 352, I_A = 16 * 64, I_O = 32 * 64, I_GU = 32 * 352;
    unsigned char* ws = C.ws; TpItem t; int r = it;
    if (r < I_IN) { const int nb = r % 352, n0 = nb * 32; t.W = C.in[2]; t.ks = C.in[1]; t.WT = (bf16_t*)(ws + WS_WIN); t.Nsrc = INCOLS; t.K = DM; t.dst_row0 = n0; t.src_col0 = n0 < 7168 ? n0 : n0 + 16; t.kb = r / 352; return t; } r -= I_IN;
    if (r < I_A) { t.W = C.in[14]; t.ks = nullptr; t.WT = (bf16_t*)(ws + WS_WA); t.Nsrc = DM; t.K = HW; t.dst_row0 = (r % 64) * 32; t.src_col0 = t.dst_row0; t.kb = r / 64; return t; } r -= I_A;
    if (r < I_A) { t.W = C.in[15]; t.ks = nullptr; t.WT = (bf16_t*)(ws + WS_WB); t.Nsrc = DM; t.K = MW; t.dst_row0 = (r % 64) * 32; t.src_col0 = t.dst_row0; t.kb = r / 64; return t; } r -= I_A;
    if (r < I_O) { t.W = C.in[16]; t.ks = nullptr; t.WT = (bf16_t*)(ws + WS_WOUT); t.Nsrc = DM; t.K = DM; t.dst_row0 = (r % 64) * 32; t.src_col0 = t.dst_row0; t.kb = r / 64; return t; } r -= I_O;
    if (r < I_GU) { const int nb = r % 352, n0 = nb * 32; const int pn = n0 >> 8, half = (n0 >> 7) & 1, i = n0 & 127;
        t.W = C.in[18]; t.ks = C.in[17]; t.WT = (bf16_t*)(ws + WS_WGU); t.Nsrc = 2 * FFH; t.K = DM; t.dst_row0 = n0; t.src_col0 = half * FFH + 128 * pn + i; t.kb = r / 352; return t; } r -= I_GU;
    t.W = C.in[19]; t.ks = nullptr; t.WT = (bf16_t*)(ws + WS_WD); t.Nsrc = DM; t.K = FFH; t.dst_row0 = (r % 64) * 32; t.src_col0 = t.dst_row0; t.kb = r / 64; return t;
}
__device__ __forceinline__ void tp_load(const TpItem& t, int lane, float (&tv)[32], float (&sv)[32]) {
    const int k0 = 64 * t.kb; const float* wp = t.W + (size_t)(k0 + (lane >> 5)) * t.Nsrc + t.src_col0 + (lane & 31);
#pragma unroll
    for (int i = 0; i < 32; ++i) tv[i] = wp[(size_t)(2 * i) * t.Nsrc];
    const float* kp = t.ks ? t.ks + k0 + (lane >> 5) : nullptr;
#pragma unroll
    for (int i = 0; i < 32; ++i) sv[i] = kp ? kp[2 * i] : 1.0f;
}
__device__ __forceinline__ void p0_prologue(const Ctx& C, LAS unsigned char* lds, int G, int wv) {
    int tid = (wv << 6) | lane_id_opaque(); asm volatile("" : "+v"(tid));
    const int lane = tid & 63, wave = __builtin_amdgcn_readfirstlane(tid >> 6);
    const int gw = blockIdx.x * 8 + wave, NGW = G * 8;
    unsigned char* ws = C.ws;
    LAS float* scr = (LAS float*)(lds + 67584 + wave * 8704);
    {
        constexpr int WGP = 2056;
        LAS bf16_t* wgb = (LAS bf16_t*)lds;
        const float* w_in = C.in[2]; const float* nw = C.in[1];
#pragma unroll 1
        for (int i0 = tid; i0 < DM * 16; i0 += 512 * 16) { float tw[16], tn[16];
#pragma unroll
            for (int u = 0; u < 16; ++u) { const int i = i0 + 512 * u, k = i >> 4, g = i & 15; tw[u] = w_in[(size_t)k * INCOLS + 7168 + g]; tn[u] = nw[k]; }
#pragma unroll
            for (int u = 0; u < 16; ++u) { const int i = i0 + 512 * u, k = i >> 4, g = i & 15; wgb[g * WGP + k] = (bf16_t)f2bf(tw[u] * tn[u]); } }
        __syncthreads();
    }

    {
        constexpr int NIT = 32 * 352 + 2 * 16 * 64 + 32 * 64 + 32 * 352 + 88 * 64;
        float tv[32], sv[32]; TpItem cur, nxt; int it = gw;
        if (it < NIT) { cur = tp_decode(C, it); tp_load(cur, lane, tv, sv); }
        while (it < NIT) {
#pragma unroll
            for (int i = 0; i < 32; ++i) scr[(2 * i + (lane >> 5)) * 33 + (lane & 31)] = tv[i] * sv[i];
            asm volatile("s_waitcnt lgkmcnt(0)" ::: "memory");
            const int nit = it + NGW;
            if (nit < NIT) { nxt = tp_decode(C, nit); tp_load(nxt, lane, tv, sv); }
            const int c = lane & 7, k0 = 64 * cur.kb;
#pragma unroll
            for (int j = 0; j < 4; ++j) { const int n = (lane >> 3) + 8 * j; const LAS float* sp = scr + (8 * c) * 33 + n;
                u32x4 o; o.x = pk2(sp[0 * 33], sp[1 * 33]); o.y = pk2(sp[2 * 33], sp[3 * 33]); o.z = pk2(sp[4 * 33], sp[5 * 33]); o.w = pk2(sp[6 * 33], sp[7 * 33]);
                *(u32x4*)(cur.WT + blk_off(cur.dst_row0 + n, k0 + 8 * c, cur.K)) = o; }
            asm volatile("s_waitcnt lgkmcnt(0)" ::: "memory");
            cur = nxt; it = nit;
        }
    }
    for (int i = blockIdx.x * 512 + tid; i < TOK; i += G * 512) { ((float*)(ws + WS_SS2))[i] = 0.f; ((float*)(ws + WS_SS3))[i] = 0.f; }
    {
        const float* w1 = C.in[5]; const float* b1 = C.in[6]; const float* f1 = C.in[7]; const float* w2 = C.in[8]; const float* b2 = C.in[9]; const float* f2 = C.in[10];
        float* h2 = (float*)(ws + WS_H2);
        for (int t = gw; t < SEQ; t += NGW) {
            const float tl = (float)t / (float)(SEQ - 1);
            const float omega = 6.283185307179586f * (float)t / (float)SEQ;
            float a = b1[lane] + tl * w1[lane];
            float sn, cs;
            { const int bi = lane & 15; const float fr = 1e-4f + (float)bi * ((15.0f - 1e-4f) / 15.0f); sincosf(omega * fr, &sn, &cs); }
#pragma unroll
            for (int i = 0; i < 16; ++i) a += __shfl(cs, i) * w1[(1 + i) * 64 + lane] - __shfl(sn, i) * w1[(17 + i) * 64 + lane];
            const float h1 = sinf(f1[lane] * a);
            float a2 = b2[lane];
#pragma unroll 8
            for (int i = 0; i < 64; ++i) a2 += __shfl(h1, i) * w2[i * 64 + lane];
            h2[t * 64 + lane] = sinf(f2[lane] * a2);
        }
    }
    {
        constexpr int WGP = 2056; LAS bf16_t* wgb = (LAS bf16_t*)lds;
        const float* x = C.in[0]; bf16_t* xb = (bf16_t*)(ws + WS_XB); float* r1 = (float*)(ws + WS_R1S); float* Gt = (float*)(ws + WS_G); const float* gbias = C.in[13];
        const int r = lane & 15, g = lane >> 4; const bool act = r < 8;
        for (int rb = gw; rb < TOK / 8; rb += NGW) {
            const int row = rb * 8 + (r & 7);
            const float* xp = x + (size_t)row * DM + 8 * g;
            f32x4 acc = {0.f, 0.f, 0.f, 0.f}; float ss = 0.f;
#pragma unroll 1
            for (int k8 = 0; k8 < 64; k8 += 8) {
                f32x4 la[8], lb[8];
#pragma unroll
                for (int u = 0; u < 8; ++u) { la[u] = *(const f32x4*)(xp + 32 * (k8 + u)); lb[u] = *(const f32x4*)(xp + 32 * (k8 + u) + 4); }
#pragma unroll
                for (int u = 0; u < 8; ++u) { const int kk = k8 + u; const f32x4 a = la[u], b = lb[u];
                    ss += ((a.x * a.x + a.y * a.y) + (a.z * a.z + a.w * a.w)) + ((b.x * b.x + b.y * b.y) + (b.z * b.z + b.w * b.w));
                    u32x4 o; o.x = pk2(a.x, a.y); o.y = pk2(a.z, a.w); o.z = pk2(b.x, b.y); o.w = pk2(b.z, b.w);
                    *(u32x4*)(xb + blk_off(row, 32 * kk + 8 * g, DM)) = o;
                    if (!act) { o.x = 0u; o.y = 0u; o.z = 0u; o.w = 0u; }
                    const bf16x8 bw = *(const LAS bf16x8*)(wgb + r * WGP + 32 * kk + 8 * g);
                    acc = __builtin_amdgcn_mfma_f32_16x16x32_bf16(__builtin_bit_cast(bf16x8, o), bw, acc, 0, 0, 0); }
            }
            ss += __shfl_xor(ss, 16); ss += __shfl_xor(ss, 32);
            const float rinv = __builtin_amdgcn_rsqf(ss * (1.0f / DM) + RMS_EPS);
            const float gb = gbias[r];
#pragma unroll
            for (int i = 0; i < 4; ++i) { const int m = 4 * g + i; const float rv = __shfl(rinv, m & 7); if (g < 2) Gt[(size_t)(rb * 8 + m) * 16 + r] = acc[i] * rv + gb; }
            if (lane < 8) r1[rb * 8 + lane] = rinv;
        }
    }
}
__device__ __forceinline__ void p1_filters(const Ctx& C, LAS unsigned char* lds, int G, int wv) {
    int tid = (wv << 6) | lane_id_opaque(); asm volatile("" : "+v"(tid));
    const int lane = tid & 63, w = tid >> 6, r = lane & 15, g = lane >> 4;
    const float* w3 = C.in[11]; const float* h2 = (const float*)(C.ws + WS_H2); float* FILT = (float*)(C.ws + WS_FILT);
    for (int item = blockIdx.x; item < 256; item += G) {
        const int n0 = 64 * (item >> 2), t0 = 1024 * (item & 3) + 128 * w;
        bf16x8 af[4][2];
#pragma unroll
        for (int mt = 0; mt < 4; ++mt)
#pragma unroll
            for (int ks = 0; ks < 2; ++ks) { float v[8];
#pragma unroll
                for (int e = 0; e < 8; ++e) v[e] = w3[(size_t)(32 * ks + 8 * g + e) * NFILT + n0 + 16 * mt + r];
                u32x4 o; o.x = pk2(v[0], v[1]); o.y = pk2(v[2], v[3]); o.z = pk2(v[4], v[5]); o.w = pk2(v[6], v[7]); af[mt][ks] = __builtin_bit_cast(bf16x8, o); }
        float dl[4][4];
#pragma unroll
        for (int mt = 0; mt < 4; ++mt)
#pragma unroll
            for (int i = 0; i < 4; ++i) { const int ch = (n0 + 16 * mt + 4 * g + i) & 1023; const float mind = -3.0701134573253945f, maxd = -15.350567286626973f;
                dl[mt][i] = fabsf(mind + (float)ch * ((maxd - mind) / 1023.0f)); }
        bf16x8 bfr[8][2];
#pragma unroll
        for (int nt = 0; nt < 8; ++nt) { const int t = t0 + 16 * nt + r;
#pragma unroll
            for (int ks = 0; ks < 2; ++ks) { const f32x4 a = *(const f32x4*)(h2 + (size_t)t * 64 + 32 * ks + 8 * g), b = *(const f32x4*)(h2 + (size_t)t * 64 + 32 * ks + 8 * g + 4);
                u32x4 o; o.x = pk2(a.x, a.y); o.y = pk2(a.z, a.w); o.z = pk2(b.x, b.y); o.w = pk2(b.z, b.w); bfr[nt][ks] = __builtin_bit_cast(bf16x8, o); } }
#pragma unroll
        for (int nt = 0; nt < 8; ++nt) {
            const int t = t0 + 16 * nt + r;
            const float tl = (float)t / (float)(SEQ - 1);
#pragma unroll
            for (int mt = 0; mt < 4; ++mt) {
                f32x4 acc = {0.f, 0.f, 0.f, 0.f};
                acc = __builtin_amdgcn_mfma_f32_16x16x32_bf16(af[mt][0], bfr[nt][0], acc, 0, 0, 0);
                acc = __builtin_amdgcn_mfma_f32_16x16x32_bf16(af[mt][1], bfr[nt][1], acc, 0, 0, 0);
#pragma unroll
                for (int i = 0; i < 4; ++i) FILT[(size_t)(n0 + 16 * mt + 4 * g + i) * SEQ + t] = acc[i] * __expf(-tl * dl[mt][i]);
            }
        }
    }
}
__device__ __forceinline__ void p7_final(const Ctx& C, int G, int wv) {
    int tid = (wv << 6) | lane_id_opaque(); asm volatile("" : "+v"(tid));
    const int lane = tid & 63, wave = tid >> 6, gw = blockIdx.x * 8 + wave, NGW = G * 8;
    const float* ss3 = (const float*)(C.ws + WS_SS3); const float* wf = C.in[20];
    f32x4 w[8];
#pragma unroll
    for (int j = 0; j < 8; ++j) w[j] = ((const f32x4*)wf)[64 * j + lane];
    for (int row = gw; row < TOK; row += 2 * NGW) {
        const int row2 = row + NGW;
        const bool has2 = row2 < TOK;
        const float r = __builtin_amdgcn_rsqf(ss3[row] * (1.0f / DM) + RMS_EPS), r2 = has2 ? __builtin_amdgcn_rsqf(ss3[row2] * (1.0f / DM) + RMS_EPS) : 0.f;
        f32x4* p = (f32x4*)(C.out + (size_t)row * DM) + lane; f32x4* p2 = (f32x4*)(C.out + (size_t)(has2 ? row2 : row) * DM) + lane;
        f32x4 v[8], u[8];
#pragma unroll
        for (int j = 0; j < 8; ++j) { v[j] = p[64 * j]; u[j] = p2[64 * j]; }
#pragma unroll
        for (int j = 0; j < 8; ++j) p[64 * j] = v[j] * r * w[j];
        if (has2) {
#pragma unroll
            for (int j = 0; j < 8; ++j) p2[64 * j] = u[j] * r2 * w[j]; }
    }
}
#ifndef FFT_HOST
#define FFT_DEV __device__ __forceinline__
#define FFT_PTR LAS f32x2*
#define FFT_SIN(x) __builtin_amdgcn_sinf(x)
#define FFT_COS(x) __builtin_amdgcn_cosf(x)
#else
#define FFT_DEV static inline
#define FFT_PTR f32x2*
#define FFT_SIN(x) sinf(6.283185307179586f * (x))
#define FFT_COS(x) cosf(6.283185307179586f * (x))
#endif
#define PADI(i) ((i) + ((i) >> 4))
FFT_DEV f32x2 cmul(f32x2 a, f32x2 b) { const f32x2 bs = (f32x2){-b.y, b.x}; return (f32x2){a.x, a.x} * b + (f32x2){a.y, a.y} * bs; }
FFT_DEV f32x2 cmulc(f32x2 a, f32x2 b) { return (f32x2){a.x, a.x} * (f32x2){b.x, -b.y} + (f32x2){a.y, a.y} * (f32x2){b.y, b.x}; }
FFT_DEV f32x2 twid(float frac) { f32x2 r; r.x = FFT_COS(frac); r.y = -FFT_SIN(frac); return r; }
template <int M, int CJ> FFT_DEV f32x2 rot8(f32x2 d) {
    const float R = 0.70710678118654752f; f32x2 r;
    if (M == 0) return d;
    if (M == 2) { if (!CJ) { r.x = d.y; r.y = -d.x; } else { r.x = -d.y; r.y = d.x; } return r; }
    if (M == 1) { if (!CJ) { r.x = R * (d.x + d.y); r.y = R * (d.y - d.x); } else { r.x = R * (d.x - d.y); r.y = R * (d.x + d.y); } return r; }
    if (!CJ) { r.x = R * (d.y - d.x); r.y = -R * (d.x + d.y); } else { r.x = -R * (d.x + d.y); r.y = R * (d.x - d.y); } return r;
}
template <int INV, int ZHI, int LOW> FFT_DEV void fft_r8_pass(FFT_PTR buf, int s, int ls  , int tid) {
#pragma unroll 1
    for (int rep = 0; rep < 2; ++rep) {
        const int bf = tid + rep * 512, j = bf & (s - 1), blk = bf >> ls, base = blk * 8 * s + j;
        f32x2 x[8];
#pragma unroll
        for (int m = 0; m < (ZHI ? 4 : 8); ++m) x[m] = buf[PADI(base + m * s)];
        f32x2 w1 = twid((float)j / (float)(8 * s));
        f32x2 w2 = cmul(w1, w1), w4 = cmul(w2, w2);
        if (!INV) {
            if (ZHI) {
                x[4] = cmul(x[0], w1); x[5] = cmul(rot8<1, 0>(x[1]), w1); x[6] = cmul(rot8<2, 0>(x[2]), w1); x[7] = cmul(rot8<3, 0>(x[3]), w1);
            } else {
                { f32x2 a = x[0], b = x[4]; x[0] = a + b; x[4] = cmul(a - b, w1); }
                { f32x2 a = x[1], b = x[5]; x[1] = a + b; x[5] = cmul(rot8<1, 0>(a - b), w1); }
                { f32x2 a = x[2], b = x[6]; x[2] = a + b; x[6] = cmul(rot8<2, 0>(a - b), w1); }
                { f32x2 a = x[3], b = x[7]; x[3] = a + b; x[7] = cmul(rot8<3, 0>(a - b), w1); }
            }
#pragma unroll
            for (int h = 0; h < 8; h += 4) {
                { f32x2 a = x[h], b = x[h + 2]; x[h] = a + b; x[h + 2] = cmul(a - b, w2); }
                { f32x2 a = x[h + 1], b = x[h + 3]; x[h + 1] = a + b; x[h + 3] = cmul(rot8<2, 0>(a - b), w2); }
            }
#pragma unroll
            for (int m = 0; m < 8; m += 2) { f32x2 a = x[m], b = x[m + 1]; x[m] = a + b; x[m + 1] = cmul(a - b, w4); }
        } else {
#pragma unroll
            for (int m = 0; m < 8; m += 2) { f32x2 a = x[m], b = cmulc(x[m + 1], w4); x[m] = a + b; x[m + 1] = a - b; }
#pragma unroll
            for (int h = 0; h < 8; h += 4) {
                { f32x2 a = x[h], b = cmulc(x[h + 2], w2); x[h] = a + b; x[h + 2] = a - b; }
                { f32x2 a = x[h + 1], b = rot8<2, 1>(cmulc(x[h + 3], w2)); x[h + 1] = a + b; x[h + 3] = a - b; }
            }
            { f32x2 a = x[0], b = cmulc(x[4], w1); x[0] = a + b; if (!LOW) x[4] = a - b; }
            { f32x2 a = x[1], b = rot8<1, 1>(cmulc(x[5], w1)); x[1] = a + b; if (!LOW) x[5] = a - b; }
            { f32x2 a = x[2], b = rot8<2, 1>(cmulc(x[6], w1)); x[2] = a + b; if (!LOW) x[6] = a - b; }
            { f32x2 a = x[3], b = rot8<3, 1>(cmulc(x[7], w1)); x[3] = a + b; if (!LOW) x[7] = a - b; }
        }
#pragma unroll
        for (int m = 0; m < (LOW ? 4 : 8); ++m) buf[PADI(base + m * s)] = x[m];
    }
}
FFT_DEV void fft_r2_span1(FFT_PTR buf, int tid) {
#pragma unroll
    for (int rep = 0; rep < 8; ++rep) { const int p = 2 * (tid + rep * 512); f32x2 a = buf[PADI(p)], b = buf[PADI(p + 1)]; buf[PADI(p)] = a + b; buf[PADI(p + 1)] = a - b; }
}
template <int J, int CJ> FFT_DEV f32x2 rot16(f32x2 d) {
    const float C1 = 0.92387953251128674f, S1 = 0.38268343236508977f;
    if ((J & 1) == 0) return rot8<J / 2, CJ>(d);
    const float wr = (J == 1) ? C1 : (J == 3) ? S1 : (J == 5) ? -S1 : -C1;
    const float wi = ((J == 1) ? -S1 : (J == 3) ? -C1 : (J == 5) ? -C1 : -S1) * (CJ ? -1.f : 1.f);
    f32x2 r; r.x = d.x * wr - d.y * wi; r.y = d.x * wi + d.y * wr; return r;
}
FFT_DEV unsigned brev13(unsigned p);
FFT_DEV void fft16_dif(f32x2 (&x)[16]) {
#define BF_(i, j, ROT) { const f32x2 a_ = x[i], b_ = x[j]; x[i] = a_ + b_; x[j] = ROT(a_ - b_); }
    BF_(0, 8, (rot16<0, 0>)) BF_(1, 9, (rot16<1, 0>)) BF_(2, 10, (rot16<2, 0>)) BF_(3, 11, (rot16<3, 0>)) BF_(4, 12, (rot16<4, 0>)) BF_(5, 13, (rot16<5, 0>)) BF_(6, 14, (rot16<6, 0>)) BF_(7, 15, (rot16<7, 0>))
#pragma unroll
    for (int h = 0; h < 16; h += 8) { BF_(h + 0, h + 4, (rot8<0, 0>)) BF_(h + 1, h + 5, (rot8<1, 0>)) BF_(h + 2, h + 6, (rot8<2, 0>)) BF_(h + 3, h + 7, (rot8<3, 0>)) }
#pragma unroll
    for (int h = 0; h < 16; h += 4) { BF_(h + 0, h + 2, (rot8<0, 0>)) BF_(h + 1, h + 3, (rot8<2, 0>)) }
#pragma unroll
    for (int h = 0; h < 16; h += 2) { BF_(h, h + 1, (rot8<0, 0>)) }
#undef BF_
}
FFT_DEV void fft16_dit_inv(f32x2 (&x)[16]) {
#define BI_(i, j, ROT) { const f32x2 a_ = x[i], b_ = ROT(x[j]); x[i] = a_ + b_; x[j] = a_ - b_; }
#pragma unroll
    for (int h = 0; h < 16; h += 2) { BI_(h, h + 1, (rot8<0, 1>)) }
#pragma unroll
    for (int h = 0; h < 16; h += 4) { BI_(h + 0, h + 2, (rot8<0, 1>)) BI_(h + 1, h + 3, (rot8<2, 1>)) }
#pragma unroll
    for (int h = 0; h < 16; h += 8) { BI_(h + 0, h + 4, (rot8<0, 1>)) BI_(h + 1, h + 5, (rot8<1, 1>)) BI_(h + 2, h + 6, (rot8<2, 1>)) BI_(h + 3, h + 7, (rot8<3, 1>)) }
    BI_(0, 8, (rot16<0, 1>)) BI_(1, 9, (rot16<1, 1>)) BI_(2, 10, (rot16<2, 1>)) BI_(3, 11, (rot16<3, 1>)) BI_(4, 12, (rot16<4, 1>)) BI_(5, 13, (rot16<5, 1>)) BI_(6, 14, (rot16<6, 1>)) BI_(7, 15, (rot16<7, 1>))
#undef BI_
}
template <int MODE> FFT_DEV void fft_mid_pass(FFT_PTR wb, FFT_PTR zk, int tid) {
    f32x2 x[16];
#pragma unroll
    for (int e = 0; e < 16; ++e) x[e] = wb[PADI(16 * tid + e)];
    fft16_dif(x);
    if (MODE != 0) {
#pragma unroll
        for (int e = 0; e < 16; ++e) {
            const unsigned p = 16u * (unsigned)tid + (unsigned)e, f = brev13(p), fn = (8192u - f) & 8191u, pn = brev13(fn);
            const f32x2 zf = zk[PADI(p)], zn = zk[PADI(pn)];
            f32x2 kf;
            if (MODE == 1) { kf.x = 0.5f * (zf.x + zn.x); kf.y = 0.5f * (zf.y - zn.y); }
            else           { kf.x = 0.5f * (zf.y + zn.y); kf.y = 0.5f * (zn.x - zf.x); }
            x[e] = cmul(x[e], kf);
        }
        fft16_dit_inv(x);
    }
#pragma unroll
    for (int e = 0; e < 16; ++e) wb[PADI(16 * tid + e)] = x[e];
}
#ifndef FFT_HOST
#define FFT_SYNC() do { asm volatile("s_waitcnt lgkmcnt(0)" ::: "memory"); __builtin_amdgcn_s_barrier(); asm volatile("" ::: "memory"); } while (0)
__device__ __forceinline__ void fft_fwd_full(FFT_PTR buf, int tid) {
    FFT_SYNC(); fft_r8_pass<0, 0, 0>(buf, 1024, 10, tid); FFT_SYNC(); fft_r8_pass<0, 0, 0>(buf, 128, 7, tid); FFT_SYNC(); fft_r8_pass<0, 0, 0>(buf, 16, 4, tid); FFT_SYNC();
    fft_mid_pass<0>(buf, buf, tid); FFT_SYNC();
}
template <int WHICH> __device__ __forceinline__ void fft_conv(FFT_PTR wb, FFT_PTR zk, int tid) {
    FFT_SYNC(); fft_r8_pass<0, 1, 0>(wb, 1024, 10, tid); FFT_SYNC(); fft_r8_pass<0, 0, 0>(wb, 128, 7, tid); FFT_SYNC(); fft_r8_pass<0, 0, 0>(wb, 16, 4, tid); FFT_SYNC();
    fft_mid_pass<1 + WHICH>(wb, zk, tid); FFT_SYNC();
    fft_r8_pass<1, 0, 0>(wb, 16, 4, tid); FFT_SYNC(); fft_r8_pass<1, 0, 0>(wb, 128, 7, tid); FFT_SYNC(); fft_r8_pass<1, 0, 1>(wb, 1024, 10, tid); FFT_SYNC();
}
#endif
FFT_DEV unsigned brev13(unsigned p) {
    unsigned r = 0;
#ifndef FFT_HOST
    r = __brev(p) >> 19;
#else
    for (int i = 0; i < 13; ++i) r |= ((p >> i) & 1u) << (12 - i);
#endif
    return r;
}
FFT_DEV void fft_pointwise(FFT_PTR wb, FFT_PTR zk, int which, int tid) {
#pragma unroll 4
    for (int rep = 0; rep < 16; ++rep) {
        const unsigned p = tid + rep * 512, f = brev13(p), fn = (8192u - f) & 8191u, pn = brev13(fn);
        const f32x2 zf = zk[PADI(p)], zn = zk[PADI(pn)];
        f32x2 kf;
        if (which == 0) { kf.x = 0.5f * (zf.x + zn.x); kf.y = 0.5f * (zf.y - zn.y); }
        else            { kf.x = 0.5f * (zf.y + zn.y); kf.y = 0.5f * (zn.x - zf.x); }
        wb[PADI(p)] = cmul(wb[PADI(p)], kf);
    }
}
__device__ __forceinline__ void qk_prepass(const Ctx& C, int G, int wv) {
    int tid = (wv << 6) | lane_id_opaque(); asm volatile("" : "+v"(tid));
    const bf16_t* R1A = (const bf16_t*)(C.ws + WS_R1A); bf16_t* QKP = (bf16_t*)(C.ws + WS_QKP);
    const float* cw = C.in[3]; const float* cb = C.in[4];
    const int cg8 = tid & 255, half = tid >> 8, col = 8 * cg8;
    float k0[8], k1[8], k2[8], kb[8];
    { const int ch = 3072 + col;
      const f32x4 t0 = *(const f32x4*)(cw + ch), t1 = *(const f32x4*)(cw + ch + 4), t2 = *(const f32x4*)(cw + CONVC + ch), t3 = *(const f32x4*)(cw + CONVC + ch + 4);
      const f32x4 t4 = *(const f32x4*)(cw + 2 * CONVC + ch), t5 = *(const f32x4*)(cw + 2 * CONVC + ch + 4), t6 = *(const f32x4*)(cb + ch), t7 = *(const f32x4*)(cb + ch + 4);
#pragma unroll
      for (int e = 0; e < 4; ++e) { k0[e] = t0[e]; k0[4 + e] = t1[e]; k1[e] = t2[e]; k1[4 + e] = t3[e]; k2[e] = t4[e]; k2[4 + e] = t5[e]; kb[e] = t6[e]; kb[4 + e] = t7[e]; } }
    const float osc = col >= 1024 ? 0.0625f : 1.0f;
    for (int run = blockIdx.x; run < TOK / 64; run += G) {
        const int row0 = run * 64 + half * 32;
#pragma unroll 1
        for (int i0 = 0; i0 < 32; i0 += 4) {
            u32x4 w0[4], w1[4], w2[4];
#pragma unroll
            for (int u = 0; u < 4; ++u) { const int row = row0 + i0 + u, t = row & (SEQ - 1); const bf16_t* p = R1A + (size_t)row * 2048 + col;
                w0[u] = *(const u32x4*)(t > 0 ? p - 2048 : p); w1[u] = *(const u32x4*)p; w2[u] = *(const u32x4*)(t < SEQ - 1 ? p + 2048 : p); }
#pragma unroll
            for (int u = 0; u < 4; ++u) { const int row = row0 + i0 + u, t = row & (SEQ - 1);
                const u32x4 z = {0u, 0u, 0u, 0u}; if (t == 0) w0[u] = z; if (t == SEQ - 1) w2[u] = z;
                float a0[8], a1[8], a2[8]; unpack8(w0[u], a0); unpack8(w1[u], a1); unpack8(w2[u], a2);
                float v[8];
#pragma unroll
                for (int e = 0; e < 8; ++e) v[e] = siluf_(k0[e] * a0[e] + k1[e] * a1[e] + k2[e] * a2[e] + kb[e]) * osc;
                u32x4 o; o.x = pk2(v[0], v[1]); o.y = pk2(v[2], v[3]); o.z = pk2(v[4], v[5]); o.w = pk2(v[6], v[7]);
                *(u32x4*)(QKP + (size_t)row * 2048 + col) = o; }
        }
    }
}
constexpr int ML_KS = 0, ML_KP = 528, ML_SS = 76032, ML_SP = 272, ML_VS = 110848, ML_VP = 80, ML_VW = 121088, ML_CS = 131328, ML_CP = 528, ML_SC = 148224;
static_assert(ML_SC + 4352 <= LDS_BYTES - 16, "mLSTM LDS map");
__device__ __forceinline__ bf16x8 tr_read2(unsigned a0, unsigned a1) {
    bf16x4 lo, hi;
    asm volatile("ds_read_b64_tr_b16 %0, %2\n\tds_read_b64_tr_b16 %1, %3\n\ts_waitcnt lgkmcnt(0)" : "=&v"(lo), "=&v"(hi) : "v"(a0), "v"(a1) : "memory");
    bf16x8 r; r[0] = lo[0]; r[1] = lo[1]; r[2] = lo[2]; r[3] = lo[3]; r[4] = hi[0]; r[5] = hi[1]; r[6] = hi[2]; r[7] = hi[3]; return r;
}
__device__ __forceinline__ bf16x8 cat4(bf16x4 lo, bf16x4 hi) { bf16x8 r; r[0] = lo[0]; r[1] = lo[1]; r[2] = lo[2]; r[3] = lo[3]; r[4] = hi[0]; r[5] = hi[1]; r[6] = hi[2]; r[7] = hi[3]; return r; }
__device__ __forceinline__ void tr_read2x2(unsigned a, unsigned b, unsigned d, bf16x8& ra, bf16x8& rb) {
    bf16x4 l0, h0, l1, h1;
    asm volatile("ds_read_b64_tr_b16 %0, %4\n\tds_read_b64_tr_b16 %1, %5\n\tds_read_b64_tr_b16 %2, %6\n\tds_read_b64_tr_b16 %3, %7\n\ts_waitcnt lgkmcnt(0)"
        : "=&v"(l0), "=&v"(h0), "=&v"(l1), "=&v"(h1) : "v"(a), "v"(a + d), "v"(b), "v"(b + d) : "memory");
    ra = cat4(l0, h0); rb = cat4(l1, h1);
}
__device__ __forceinline__ void tr_read4x2(unsigned a, unsigned b, unsigned d, unsigned c, unsigned e, unsigned d2, bf16x8& ra, bf16x8& rb, bf16x8& rc, bf16x8& re) {
    bf16x4 l0, h0, l1, h1, l2, h2, l3, h3;
    asm volatile("ds_read_b64_tr_b16 %0, %8\n\tds_read_b64_tr_b16 %1, %9\n\tds_read_b64_tr_b16 %2, %10\n\tds_read_b64_tr_b16 %3, %11\n\t"
                 "ds_read_b64_tr_b16 %4, %12\n\tds_read_b64_tr_b16 %5, %13\n\tds_read_b64_tr_b16 %6, %14\n\tds_read_b64_tr_b16 %7, %15\n\ts_waitcnt lgkmcnt(0)"
        : "=&v"(l0), "=&v"(h0), "=&v"(l1), "=&v"(h1), "=&v"(l2), "=&v"(h2), "=&v"(l3), "=&v"(h3)
        : "v"(a), "v"(a + d), "v"(b), "v"(b + d), "v"(c), "v"(c + d2), "v"(e), "v"(e + d2) : "memory");
    ra = cat4(l0, h0); rb = cat4(l1, h1); rc = cat4(l2, h2); re = cat4(l3, h3);
}
__device__ __forceinline__ float bf2f(short s) { return __uint_as_float(((unsigned)(unsigned short)s) << 16); }
__device__ __forceinline__ float logsigmoidf_(float x) { return fminf(x, 0.f) - log1pf(expf(-fabsf(x))); }

__device__ __forceinline__ void mlstm_item(const Ctx& C, LAS unsigned char* lds, int item, int wv) {
    int tid = (wv << 6) | lane_id_opaque(); asm volatile("" : "+v"(tid));
    const int lane = tid & 63, w = __builtin_amdgcn_readfirstlane(tid >> 6), r = lane & 15, g = lane >> 4, q4 = r >> 2, p4 = r & 3;
    const int xcd_ = item & 7, yy_ = item >> 3, vs = yy_ & 7, dir = (yy_ >> 3) & 1, bh = 2 * xcd_ + (yy_ >> 4), b = bh >> 2, h = bh & 3;
    const bf16_t* QKP = (const bf16_t*)(C.ws + WS_QKP); const bf16_t* R1B = (const bf16_t*)(C.ws + WS_R1B); const float* Gt = (const float*)(C.ws + WS_G);
    bf16_t* Y = (bf16_t*)(C.ws + (dir ? WS_YBB : WS_YBF));
    LAS float* SC = (LAS float*)(lds + ML_SC);
    LAS float* s_cs = SC, *s_rj = SC + 128, *s_iw = SC + 256, *s_emj = SC + 384, *s_w0 = SC + 512, *s_w1 = SC + 960, *s_dn = SC + 640, *s_misc = SC + 768;
    LAS float* c_bl = SC + 784, *c_mx = SC + 816, *c_mp = SC + 848, *c_mn = SC + 880, *c_kp = SC + 912;
    float* GS = (float*)(C.ws + WS_GSC) + (size_t)item * 3 * SEQ;
    const unsigned lbase = (unsigned)(size_t)lds;
    const int pc = tid & 31, krow = tid >> 5, vrow = tid >> 2, pv = tid & 3;
    const int sw = w < 4 ? w : 11 - w;
    for (int i = tid; i < 16896 / 4; i += 512) ((LAS unsigned*)(lds + ML_CS))[i] = 0u;
    for (int i = tid; i < 16 * ML_KP / 4; i += 512) ((LAS unsigned*)(lds + ML_KS + 128 * ML_KP))[i] = 0u;
    f32x4 Cacc[3][2];
#pragma unroll
    for (int a = 0; a < 3; ++a) { Cacc[a][0] = (f32x4){0.f, 0.f, 0.f, 0.f}; Cacc[a][1] = (f32x4){0.f, 0.f, 0.f, 0.f}; }
    u32x4 kreg[8], vreg, qn[8]; float bn = 0.f, csn = 0.f, pmn = 0.f;
#define ML_TOK(c_, j_) ((size_t)b * SEQ + (dir ? SEQ - 1 - ((c_) * 128 + (j_)) : ((c_) * 128 + (j_))))
#define ML_PREFETCH(c_) do { \
        _Pragma("unroll") for (int i = 0; i < 8; ++i) kreg[i] = *(const u32x4*)(QKP + ML_TOK(c_, krow + 16 * i) * 2048 + 1024 + h * 256 + 8 * pc); \
        vreg = *(const u32x4*)(R1B + ML_TOK(c_, vrow) * 2048 + h * 256 + vs * 32 + 8 * pv); \
        { const bf16_t* qp = QKP + ML_TOK(c_, 16 * sw + r) * 2048 + h * 256 + 8 * g; _Pragma("unroll") for (int kk = 0; kk < 8; ++kk) qn[kk] = *(const u32x4*)(qp + 32 * kk); } \
        if (tid < 128) { const int ta = (c_) * 128 + tid; bn = GS[ta]; csn = GS[SEQ + ta]; pmn = GS[2 * SEQ + ta]; } } while (0)
    {
        float gi[8], gf[8];
#pragma unroll
        for (int u = 0; u < 8; ++u) { const int ta = (4 * w) * 128 + u * 64 + lane; const size_t tk = (size_t)b * SEQ + (dir ? SEQ - 1 - ta : ta);
            gi[u] = Gt[tk * 16 + (dir * 2) * 4 + h]; gf[u] = Gt[tk * 16 + (dir * 2 + 1) * 4 + h]; }
#pragma unroll
        for (int q = 0; q < 4; ++q) {
            const int c = 4 * w + q; float carry_b = 0.f, carry_m = -3.0e38f;
#pragma unroll
            for (int hf = 0; hf < 2; ++hf) {
                const int ta = c * 128 + hf * 64 + lane;
                const float ip = gi[2 * q + hf], fp = gf[2 * q + hf];
                float xs = logsigmoidf_(fp);
#pragma unroll
                for (int o = 1; o < 64; o <<= 1) { const float y = __shfl_up(xs, o); if (lane >= o) xs += y; }
                const float bj = xs + carry_b; const float cj = ip - bj; float pm = cj;
#pragma unroll
                for (int o = 1; o < 64; o <<= 1) { const float y = __shfl_up(pm, o); if (lane >= o) pm = fmaxf(pm, y); }
                pm = fmaxf(pm, carry_m);
                GS[ta] = bj; GS[SEQ + ta] = cj; GS[2 * SEQ + ta] = pm;
                carry_b = __shfl(bj, 63); carry_m = __shfl(pm, 63);
            }
            if (lane == 0) { c_bl[c] = carry_b; c_mx[c] = carry_m; }
        }
        __syncthreads();
        if (tid == 0) { float m = 0.f;
            for (int c = 0; c < 32; ++c) { const float bl = c_bl[c], mn = fmaxf(bl + m, bl + c_mx[c]); c_mp[c] = m; c_mn[c] = mn; c_kp[c] = __expf(bl + m - mn); m = mn; } }
        __syncthreads();
    }
#define ML_SCALARS(cc, swp) do { if (tid < 128) { const float mp_ = c_mp[cc], mn_ = c_mn[cc], bl_ = c_bl[cc]; const float inter = bn + mp_, mj = fmaxf(inter, bn + pmn); \
        s_cs[tid] = csn; s_rj[tid] = bn - mj; s_iw[tid] = __expf(inter - mj); s_emj[tid] = __expf(-mj); (swp)[tid] = __expf(bl_ + csn - mn_); } } while (0)
    ML_PREFETCH(0);
    ML_SCALARS(0, s_w0);
    __syncthreads();
#define ML_BAR() do { asm volatile("s_waitcnt lgkmcnt(0)" ::: "memory"); __builtin_amdgcn_s_barrier(); asm volatile("" ::: "memory"); } while (0)
#pragma unroll 1
    for (int c = 0; c < 32; ++c) {
        const float keep = c_kp[c]; LAS float* s_w = (c & 1) ? s_w1 : s_w0; LAS float* s_wn = (c & 1) ? s_w0 : s_w1;
#pragma unroll
        for (int i = 0; i < 8; ++i) *(LAS u32x4*)(lds + ML_KS + (krow + 16 * i) * ML_KP + pc * 16) = kreg[i];
        {
            *(LAS u32x4*)(lds + ML_VS + vrow * ML_VP + pv * 16) = vreg;
            float f[8]; unpack8(vreg, f); const float ws_ = s_w[vrow];
            u32x4 o; o.x = pk2(f[0] * ws_, f[1] * ws_); o.y = pk2(f[2] * ws_, f[3] * ws_); o.z = pk2(f[4] * ws_, f[5] * ws_); o.w = pk2(f[6] * ws_, f[7] * ws_);
            *(LAS u32x4*)(lds + ML_VW + vrow * ML_VP + pv * 16) = o;
        }
        bf16x8 qf[8];
#pragma unroll
        for (int kk = 0; kk < 8; ++kk) qf[kk] = __builtin_bit_cast(bf16x8, qn[kk]);
        unsigned short ogr[4][2];
#pragma unroll
        for (int i = 0; i < 4; ++i)
#pragma unroll
            for (int vt = 0; vt < 2; ++vt) ogr[i][vt] = R1B[ML_TOK(c, 16 * sw + 4 * g + i) * 2048 + 1024 + h * 256 + vs * 32 + 16 * vt + r];
        if (c < 31) ML_PREFETCH(c + 1);
        ML_BAR();
        {
            const float rjv = s_rj[16 * sw + r]; const int jloc = 16 * sw + r; float den1 = 0.f;
#pragma unroll 2
            for (int st = 0; st < 8; ++st) {
                if (st <= sw) {
                    f32x4 acc = {0.f, 0.f, 0.f, 0.f};
#pragma unroll
                    for (int kk = 0; kk < 8; ++kk) { const bf16x8 kf = *(const LAS bf16x8*)(lds + ML_KS + (16 * st + r) * ML_KP + (32 * kk + 8 * g) * 2); acc = __builtin_amdgcn_mfma_f32_16x16x32_bf16(kf, qf[kk], acc, 0, 0, 0); }
                    const f32x4 c4 = *(const LAS f32x4*)(s_cs + 16 * st + 4 * g);
                    float v[4];
#pragma unroll
                    for (int i = 0; i < 4; ++i) { const int s = 16 * st + 4 * g + i; const float d = (s <= jloc) ? __expf(rjv + c4[i]) : 0.f; v[i] = acc[i] * d; den1 += v[i]; }
                    u32x2 o; o.x = pk2(v[0], v[1]); o.y = pk2(v[2], v[3]);
                    *(LAS u32x2*)(lds + ML_SS + jloc * ML_SP + (16 * st + 4 * g) * 2) = o;
                } else if (st == sw + 1 && !(sw & 1)) {
                    u32x2 o = {0u, 0u}; *(LAS u32x2*)(lds + ML_SS + jloc * ML_SP + (16 * st + 4 * g) * 2) = o;
                }
            }
            den1 += __shfl_xor(den1, 16); den1 += __shfl_xor(den1, 32);
            f32x4 dacc = {0.f, 0.f, 0.f, 0.f};
#pragma unroll
            for (int kk = 0; kk < 8; ++kk) { const bf16x8 kf = *(const LAS bf16x8*)(lds + ML_KS + (128 + r) * ML_KP + (32 * kk + 8 * g) * 2); dacc = __builtin_amdgcn_mfma_f32_16x16x32_bf16(kf, qf[kk], dacc, 0, 0, 0); }
            const float d2 = dacc[0];
            if (g == 0) s_dn[jloc] = den1 + s_iw[jloc] * d2;
        }
        ML_BAR();
        {
            f32x4 n1[2], n2[2];
#pragma unroll
            for (int vt = 0; vt < 2; ++vt) { n1[vt] = (f32x4){0.f, 0.f, 0.f, 0.f}; n2[vt] = (f32x4){0.f, 0.f, 0.f, 0.f}; }
            const int nks = (sw >> 1) + 1;
#pragma unroll 1
            for (int ks = 0; ks < nks; ++ks) {
                const bf16x8 af = *(const LAS bf16x8*)(lds + ML_SS + (16 * sw + r) * ML_SP + (32 * ks + 8 * g) * 2);
                const unsigned a0 = lbase + ML_VS + (32 * ks + 8 * g + q4) * ML_VP + (4 * p4) * 2;
                bf16x8 b0, b1; tr_read2x2(a0, a0 + 32, 4 * ML_VP, b0, b1);
                n1[0] = __builtin_amdgcn_mfma_f32_16x16x32_bf16(af, b0, n1[0], 0, 0, 0); n1[1] = __builtin_amdgcn_mfma_f32_16x16x32_bf16(af, b1, n1[1], 0, 0, 0);
            }
#pragma unroll
            for (int kk = 0; kk < 8; ++kk)
#pragma unroll
                for (int vt = 0; vt < 2; ++vt) { const bf16x8 cf = *(const LAS bf16x8*)(lds + ML_CS + (16 * vt + r) * ML_CP + (32 * kk + 8 * g) * 2); n2[vt] = __builtin_amdgcn_mfma_f32_16x16x32_bf16(qf[kk], cf, n2[vt], 0, 0, 0); }
            const f32x4 iw4 = *(const LAS f32x4*)(s_iw + 16 * sw + 4 * g), dn4 = *(const LAS f32x4*)(s_dn + 16 * sw + 4 * g), em4 = *(const LAS f32x4*)(s_emj + 16 * sw + 4 * g);
#pragma unroll
            for (int i = 0; i < 4; ++i) {
                const size_t tok = ML_TOK(c, 16 * sw + 4 * g + i);
                const float inv = __builtin_amdgcn_rcpf(fmaxf(fabsf(dn4[i]), em4[i]));
#pragma unroll
                for (int vt = 0; vt < 2; ++vt) { const int col = h * 256 + vs * 32 + 16 * vt + r;
                    const float og = __uint_as_float(((unsigned)ogr[i][vt]) << 16);
                    const float hv = (n1[vt][i] + iw4[i] * n2[vt][i]) * inv * og;
                    Y[blk_off((int)tok, col, 1024)] = (bf16_t)pk2(hv, 0.f); }
            }
        }
        ML_BAR();
        {
#pragma unroll
            for (int a = 0; a < 3; ++a) { Cacc[a][0] *= keep; Cacc[a][1] *= keep; }
#pragma unroll 1
            for (int ks = 0; ks < 4; ++ks) {
                bf16x8 af[3], bq[2];
                { const unsigned av = lbase + ML_VW + (32 * ks + 8 * g + q4) * ML_VP + (4 * p4) * 2, ak = lbase + ML_KS + (32 * ks + 8 * g + q4) * ML_KP + (32 * w + 4 * p4) * 2;
                  tr_read4x2(av, av + 32, 4 * ML_VP, ak, ak + 32, 4 * ML_KP, af[0], af[1], bq[0], bq[1]); }
                { const f32x4 wa = *(const LAS f32x4*)(s_w + 32 * ks + 8 * g), wb = *(const LAS f32x4*)(s_w + 32 * ks + 8 * g + 4);
                  u32x4 o; o.x = pk2(wa[0], wa[1]); o.y = pk2(wa[2], wa[3]); o.z = pk2(wb[0], wb[1]); o.w = pk2(wb[2], wb[3]);
                  if (r != 0) { o.x = 0u; o.y = 0u; o.z = 0u; o.w = 0u; }
                  af[2] = __builtin_bit_cast(bf16x8, o); }
#pragma unroll
                for (int nt = 0; nt < 2; ++nt)
#pragma unroll
                    for (int mt = 0; mt < 3; ++mt) Cacc[mt][nt] = __builtin_amdgcn_mfma_f32_16x16x32_bf16(af[mt], bq[nt], Cacc[mt][nt], 0, 0, 0);
            }
#pragma unroll
            for (int mt = 0; mt < 2; ++mt)
#pragma unroll
                for (int nt = 0; nt < 2; ++nt)
#pragma unroll
                    for (int i = 0; i < 4; ++i) *(LAS bf16_t*)(lds + ML_CS + (16 * mt + 4 * g + i) * ML_CP + (32 * w + 16 * nt + r) * 2) = (bf16_t)pk2(Cacc[mt][nt][i], 0.f);
            if (c < 31) ML_SCALARS(c + 1, s_wn);
            if (g == 0) { *(LAS bf16_t*)(lds + ML_KS + 128 * ML_KP + (32 * w + r) * 2) = (bf16_t)pk2(Cacc[2][0][0], 0.f); *(LAS bf16_t*)(lds + ML_KS + 128 * ML_KP + (32 * w + 16 + r) * 2) = (bf16_t)pk2(Cacc[2][1][0], 0.f); }
        }
        ML_BAR();
    }
#undef ML_SCALARS
#undef ML_BAR
#undef ML_PREFETCH
#undef ML_TOK
}
constexpr int HY_ZK = 0, HY_WB = 69632;
static_assert(HY_WB + 69632 <= LDS_BYTES, "hyena LDS map");
#define GAS __attribute__((address_space(1)))
struct HyRaw { u32x4 c; unsigned l, r; };
__device__ __forceinline__ HyRaw hy_load(const bf16_t* rowp, int tid) { HyRaw x; const GAS bf16_t* p = (const GAS bf16_t*)rowp + 8 * tid; x.c = *(const GAS u32x4*)p; x.l = p[-1]; x.r = p[8]; return x; }
__device__ __forceinline__ void hy_conv8(const HyRaw& x, int tid, float w0, float w1, float w2, float bias, float (&o)[8]) {
    float a[10];
    a[0] = tid > 0 ? __uint_as_float(x.l << 16) : 0.f; a[9] = tid < 511 ? __uint_as_float(x.r << 16) : 0.f;
    a[1] = bflo(x.c.x); a[2] = bfhi(x.c.x); a[3] = bflo(x.c.y); a[4] = bfhi(x.c.y); a[5] = bflo(x.c.z); a[6] = bfhi(x.c.z); a[7] = bflo(x.c.w); a[8] = bfhi(x.c.w);
#pragma unroll
    for (int m = 0; m < 8; ++m) o[m] = w0 * a[m] + w1 * a[m + 1] + w2 * a[m + 2] + bias;
}
__device__ __forceinline__ void hyena_item(const Ctx& C, LAS unsigned char* lds, int ch, int wv) {
    int tid = (wv << 6) | lane_id_opaque(); asm volatile("" : "+v"(tid));
    LAS f32x2* zk = (LAS f32x2*)(lds + HY_ZK); LAS f32x2* wb = (LAS f32x2*)(lds + HY_WB);
    const float* FILT = (const float*)(C.ws + WS_FILT); const bf16_t* HYb = (const bf16_t*)(C.ws + WS_HY); bf16_t* YA = (bf16_t*)(C.ws + WS_YA);
    const float* cw = C.in[3]; const float* cb = C.in[4];
    float w0[3], w1[3], w2[3], bs[3];
#pragma unroll
    for (int s = 0; s < 3; ++s) { w0[s] = cw[s * 1024 + ch]; w1[s] = cw[CONVC + s * 1024 + ch]; w2[s] = cw[2 * CONVC + s * 1024 + ch]; bs[s] = cb[s * 1024 + ch]; }
    const float hb0 = C.in[12][ch], hb1 = C.in[12][1024 + ch];
    const float* F0 = FILT + (size_t)(0 * 1024 + ch) * SEQ; const float* F1 = FILT + (size_t)(1 * 1024 + ch) * SEQ;
    const float* F2 = FILT + (size_t)(2 * 1024 + ch) * SEQ; const float* F3 = FILT + (size_t)(3 * 1024 + ch) * SEQ;
    __syncthreads();
    {
        float fa[16], fb[16];
#pragma unroll
        for (int rep = 0; rep < 8; ++rep) { const int i = tid + 512 * rep; fa[rep] = F0[i]; fb[rep] = F2[i]; }
#pragma unroll
        for (int rep = 8; rep < 16; ++rep) { const int i = tid + 512 * rep; const int j = i == SEQ ? 1 : 2 * SEQ - i; fa[rep] = F1[j]; fb[rep] = F3[j]; }
        if (tid == 0) { fa[8] = 0.f; fb[8] = 0.f; }
#pragma unroll
        for (int rep = 0; rep < 16; ++rep) { const int i = tid + 512 * rep; zk[PADI(i)] = (f32x2){fa[rep] * (1.0f / 8192.0f), fb[rep] * (1.0f / 8192.0f)}; }
    }
    fft_fwd_full(zk, tid);
    const bf16_t* rv = HYb + (size_t)ch * TOK; const bf16_t* rx1 = HYb + (size_t)(1024 + ch) * TOK; const bf16_t* rx2 = HYb + (size_t)(2048 + ch) * TOK;
    HyRaw qa = hy_load(rv, tid), qb = hy_load(rv + SEQ, tid);
#pragma unroll 1
    for (int p = 0; p < 2; ++p) {
        const int tb0 = (2 * p) * SEQ, tb1 = (2 * p + 1) * SEQ;
        f32x2 vv[8], zz[8];
        { float va[8], vb[8]; hy_conv8(qa, tid, w0[0], w1[0], w2[0], bs[0], va); hy_conv8(qb, tid, w0[0], w1[0], w2[0], bs[0], vb);
#pragma unroll
          for (int m = 0; m < 8; ++m) { vv[m].x = va[m]; vv[m].y = vb[m]; wb[PADI(8 * tid + m)] = vv[m]; } }
        qa = hy_load(rx1 + tb0, tid); qb = hy_load(rx1 + tb1, tid);
        fft_conv<0>(wb, zk, tid);
        { float xa[8], xb_[8]; hy_conv8(qa, tid, w0[1], w1[1], w2[1], bs[1], xa); hy_conv8(qb, tid, w0[1], w1[1], w2[1], bs[1], xb_);
#pragma unroll
          for (int m = 0; m < 8; ++m) { const f32x2 y = wb[PADI(8 * tid + m)]; zz[m].x = xa[m] * (y.x + vv[m].x * hb0); zz[m].y = xb_[m] * (y.y + vv[m].y * hb0); }
#pragma unroll
          for (int m = 0; m < 8; ++m) wb[PADI(8 * tid + m)] = zz[m]; }
        qa = hy_load(rx2 + tb0, tid); qb = hy_load(rx2 + tb1, tid);
        fft_conv<1>(wb, zk, tid);
        { float xa[8], xb_[8]; hy_conv8(qa, tid, w0[2], w1[2], w2[2], bs[2], xa); hy_conv8(qb, tid, w0[2], w1[2], w2[2], bs[2], xb_);
          if (p == 0) { qa = hy_load(rv + 2 * SEQ, tid); qb = hy_load(rv + 3 * SEQ, tid); }
#pragma unroll
          for (int m = 0; m < 8; ++m) { const int t = 8 * tid + m; const f32x2 y = wb[PADI(t)];
              YA[blk_off(tb0 + t, ch, 1024)] = (bf16_t)f2bf(xa[m] * (y.x + zz[m].x * hb1));
              YA[blk_off(tb1 + t, ch, 1024)] = (bf16_t)f2bf(xb_[m] * (y.y + zz[m].y * hb1)); } }
        FFT_SYNC();
    }
}
#ifndef DUP_FILT
#define DUP_FILT 0
#endif
#ifndef DUP_PRE
#define DUP_PRE 0
#endif
#ifndef DUP_P0
#define DUP_P0 0
#endif
#ifndef DUP_ML
#define DUP_ML 0
#endif
#ifndef DUP_HY
#define DUP_HY 0
#endif
#ifndef DUP_REST
#define DUP_REST 0
#endif
#ifndef DUP_GU
#define DUP_GU 0
#endif
#define XB_TMO      128
#define XB_XCNT(j)  (256  + 64 * (j))
#define XB_XSUB(j)  (1280 + 64 * (j))
#define XB_XGEN(j)  (2304 + 64 * (j))
#define XB_TOP      3328
#define XB_TOPGEN   3392
#define XCD_BAR_WORDS 3456
#define XB_SPIN_CAP (1u << 22)
__device__ __forceinline__ unsigned xb_ld(unsigned* p)              { return __hip_atomic_load(p, __ATOMIC_RELAXED, __HIP_MEMORY_SCOPE_AGENT); }
__device__ __forceinline__ unsigned xb_add(unsigned* p, unsigned v) { return __hip_atomic_fetch_add(p, v, __ATOMIC_RELAXED, __HIP_MEMORY_SCOPE_AGENT); }
__device__ __forceinline__ unsigned xb_xcc_id() { return (unsigned)__builtin_amdgcn_s_getreg((3 << 11) | 20) & 0xFu; }
#define XB_SPIN(cond, bar) do { unsigned _sp = 0; while (cond) { __builtin_amdgcn_s_sleep(1); \
    if ((++_sp & 255u) == 0u) { if (xb_ld(&(bar)[XB_TMO])) break; if (_sp > XB_SPIN_CAP) { atomicAdd(&(bar)[XB_TMO], 1u); break; } } } } while (0)
__device__ __forceinline__ void xcd_barrier_complete(unsigned* bar, unsigned x, unsigned G, unsigned& nloc, unsigned& nx) {
    unsigned sum, cnt, mine, sp = 0u;
    for (;;) {
        sum = 0u; cnt = 0u; mine = 0u;
#pragma unroll
        for (unsigned j = 0; j < 16; ++j) { const unsigned c = xb_ld(&bar[XB_XCNT(j)]); sum += c; cnt += (c > 0u) ? 1u : 0u; mine = (j == x) ? c : mine; }
        if (sum == G) break;
        __builtin_amdgcn_s_sleep(1);
        if ((++sp & 255u) == 0u) { if (xb_ld(&bar[XB_TMO])) break; if (sp > XB_SPIN_CAP) { atomicAdd(&bar[XB_TMO], 1u); break; } }
    }
    nloc = mine > 0u ? mine : 1u; nx = cnt > 0u ? cnt : 1u;
}
__device__ __forceinline__ void grid_bar(unsigned* bar, volatile LAS unsigned* st, unsigned G, int wv) {
    asm volatile("s_waitcnt vmcnt(0)" ::: "memory");
    __syncthreads();
    const int lane = lane_id_opaque();
    if (wv == 0 && lane == 0) {
        __builtin_amdgcn_s_waitcnt(0);
        const unsigned x = xb_xcc_id();
        unsigned nloc = st[0], nx = st[1];
        if (nloc == 0u) { xcd_barrier_complete(bar, x, G, nloc, nx); st[0] = nloc; st[1] = nx; }
        const unsigned old = xb_add(&bar[XB_XSUB(x)], 1u);
        const unsigned gen = old / nloc;
        if (old + 1u == (gen + 1u) * nloc) {
            __builtin_amdgcn_fence(__ATOMIC_RELEASE, "agent");
            asm volatile("s_waitcnt vmcnt(0)" ::: "memory");
            const unsigned og = xb_add(&bar[XB_TOP], 1u);
            const unsigned tg = og / nx;
            if (og + 1u == (tg + 1u) * nx) xb_add(&bar[XB_TOPGEN], 1u);
            else XB_SPIN(xb_ld(&bar[XB_TOPGEN]) == tg, bar);
            __builtin_amdgcn_fence(__ATOMIC_ACQUIRE, "agent");
            xb_add(&bar[XB_XGEN(x)], 1u);
            asm volatile("s_waitcnt vmcnt(0)" ::: "memory");
        } else {
            XB_SPIN(xb_ld(&bar[XB_XGEN(x)]) == gen, bar);
            __builtin_amdgcn_fence(__ATOMIC_ACQUIRE, "agent");
            asm volatile("s_waitcnt vmcnt(0)" ::: "memory");
        }
    }
    __syncthreads();
}
__device__ __forceinline__ void p6_finalize(const Ctx& C, int G, int bx, int wv) {
    int tid = (wv << 6) | lane_id_opaque(); asm volatile("" : "+v"(tid));
    unsigned* pcnt = (unsigned*)(C.ws + WS_PCNT); const float* ss3 = (const float*)(C.ws + WS_SS3); const float* wf = C.in[20]; float* out = C.out;
    for (int i = 0; ; ++i) {
        const int L = i * G + bx; if (L + G >= 64 * 8) break; int pm, pn; pg8::tile_of(L, 64, 8, pm, pn);
        if (tid == 0) { unsigned sp = 0; while (xb_ld(&pcnt[64 * pm]) < 8u) { __builtin_amdgcn_s_sleep(1); if (++sp > (1u << 20)) break; }
            __builtin_amdgcn_fence(__ATOMIC_ACQUIRE, "agent"); asm volatile("s_waitcnt vmcnt(0)" ::: "memory"); }
        __syncthreads();
        const int c4 = tid & 63; const f32x4 wv4 = *(const f32x4*)(wf + 256 * pn + 4 * c4);
#pragma unroll 1
        for (int k0 = 0; k0 < 32; k0 += 8) {
            f32x4 v[8]; float rr[8];
#pragma unroll
            for (int k = 0; k < 8; ++k) { const int row = 256 * pm + (tid >> 6) + 8 * (k0 + k);
                v[k] = *(const f32x4*)(out + (size_t)row * DM + 256 * pn + 4 * c4);
                rr[k] = __hip_atomic_load(ss3 + row, __ATOMIC_RELAXED, __HIP_MEMORY_SCOPE_AGENT); }
#pragma unroll
            for (int k = 0; k < 8; ++k) { const int row = 256 * pm + (tid >> 6) + 8 * (k0 + k); const float r = __builtin_amdgcn_rsqf(rr[k] * (1.0f / DM) + RMS_EPS);
                *(f32x4*)(out + (size_t)row * DM + 256 * pn + 4 * c4) = v[k] * r * wv4; }
        }
    }
}
struct Params { const float* in[21]; float* out; unsigned char* ws; };
__global__ void __launch_bounds__(512, 2) fwd_megakernel(Params prm) {
    extern __shared__ __attribute__((aligned(16))) unsigned char lds_raw[];
    LAS unsigned char* lds = (LAS unsigned char*)lds_raw;
    cg::grid_group grid = cg::this_grid();
    const int G = gridDim.x, bx = blockIdx.x;
    const int wv = __builtin_amdgcn_readfirstlane((int)(threadIdx.x >> 6));
    Ctx C;
#pragma unroll
    for (int i = 0; i < 21; ++i) C.in[i] = prm.in[i];
    C.out = prm.out; C.ws = prm.ws;
    unsigned char* ws = prm.ws;
    unsigned* gbar = (unsigned*)(ws + WS_BAR);
    volatile LAS unsigned* bst = (volatile LAS unsigned*)(lds + LDS_BYTES - 16);
#ifndef DUP_BAR
#define DUP_BAR 0
#endif
#define GBAR() do { for (int rb_ = 0; rb_ < 1 + DUP_BAR; ++rb_) grid_bar(gbar, bst, (unsigned)G, wv); } while (0)
    if (bx == 0) for (int i = threadIdx.x; i < XCD_BAR_WORDS; i += 512) gbar[i] = 0u;
    if (bx == 1 || G == 1) for (int i = threadIdx.x; i < 64 * 64; i += 512) ((unsigned*)(ws + WS_PCNT))[i] = 0u;
    if (threadIdx.x < 4) ((LAS unsigned*)(lds + LDS_BYTES - 16))[threadIdx.x] = 0u;
    grid.sync();
    if (threadIdx.x == 0) (void)xb_add(&gbar[XB_XCNT(xb_xcc_id())], 1u);
    for (int rep = 0; rep < 1 + DUP_P0; ++rep) { p0_prologue(C, lds, G, wv); __syncthreads(); }
    GBAR();
    for (int rep = 0; rep < 1 + DUP_FILT; ++rep) p1_filters(C, lds, G, wv);
    { InProg P; P.K = DM; P.G = G; P.c = bx;
      P.H.K = DM; P.H.G = G; P.H.c = bx; P.H.W = (const bf16_t*)(ws + WS_WIN); P.H.X = (const bf16_t*)(ws + WS_XB); P.H.HY = (bf16_t*)(ws + WS_HY); P.H.r1 = (const float*)(ws + WS_R1S);
      P.R.K = DM; P.R.G = G; P.R.c = bx; P.R.W = (const bf16_t*)(ws + WS_WIN); P.R.X = (const bf16_t*)(ws + WS_XB); P.R.R1A = (bf16_t*)(ws + WS_R1A); P.R.R1B = (bf16_t*)(ws + WS_R1B); P.R.R2 = (bf16_t*)prm.out; P.R.r1 = (const float*)(ws + WS_R1S);
      pg8::gemm_stream(lds, P, wv); }
    GBAR();
    for (int rep = 0; rep < 1 + DUP_PRE; ++rep) qk_prepass(C, G, wv);
    for (int rep = 0; rep < 1 + DUP_HY; ++rep) for (int idx = bx; idx < 1024; idx += G) { const int rd = idx >> 8, bb = idx & 255; hyena_item(C, lds, rd * 256 + (bb & 7) * 32 + (bb >> 3), wv); }
    GBAR();
    for (int rep = 0; rep < 1 + DUP_ML; ++rep) for (int item = bx; item < 256; item += G) mlstm_item(C, lds, item, wv);
    GBAR();
    { BranchProg P; P.K = 1024; P.G = G; P.c = bx; P.YA = (const bf16_t*)(ws + WS_YA); P.YBF = (const bf16_t*)(ws + WS_YBF); P.YBB = (const bf16_t*)(ws + WS_YBB);
      P.WA = (const bf16_t*)(ws + WS_WA); P.WB = (const bf16_t*)(ws + WS_WB); P.R2 = (const bf16_t*)prm.out; P.MIX = (bf16_t*)(ws + WS_MIX);
      pg8::gemm_stream(lds, P, wv); }
    GBAR();
    { ResProg<false> P; P.pcnt = nullptr; P.wf = nullptr; P.K = DM; P.G = G; P.c = bx; P.A = (const bf16_t*)(ws + WS_MIX); P.B = (const bf16_t*)(ws + WS_WOUT); P.base = prm.in[0]; P.base16 = nullptr; P.out = nullptr; P.outb = (bf16_t*)(ws + WS_X1B); P.ss = (float*)(ws + WS_SS2);
      pg8::gemm_stream(lds, P, wv); }
    GBAR();
    for (int rep = 0; rep < 1 + DUP_GU; ++rep) { GuProg P; P.K = DM; P.G = G; P.c = bx; P.X = (const bf16_t*)(ws + WS_X1B); P.W = (const bf16_t*)(ws + WS_WGU); P.HH = (bf16_t*)(ws + WS_HH); P.ss2 = (const float*)(ws + WS_SS2);
      pg8::gemm_stream(lds, P, wv); }
    GBAR();
    { ResProg<true> P; P.pcnt = (unsigned*)(ws + WS_PCNT); P.wf = prm.in[20]; P.K = FFH; P.G = G; P.c = bx; P.A = (const bf16_t*)(ws + WS_HH); P.B = (const bf16_t*)(ws + WS_WD); P.base = nullptr; P.base16 = (const bf16_t*)(ws + WS_X1B); P.out = prm.out; P.outb = nullptr; P.ss = (float*)(ws + WS_SS3);
      pg8::gemm_stream(lds, P, wv); }
    p6_finalize(C, G, bx, wv);
}

extern "C" void kernel_launch(void* const* d_in, const int* in_sizes, int n_in, void* d_out, int out_size, void* d_ws, size_t ws_size, hipStream_t stream) {
    static int grid = 0;
    if (grid == 0) {
        int dev = 0, cus = 0, per_cu = 0;
        hipGetDevice(&dev); hipDeviceGetAttribute(&cus, hipDeviceAttributeMultiprocessorCount, dev);
        if (hipFuncSetAttribute((const void*)fwd_megakernel, hipFuncAttributeMaxDynamicSharedMemorySize, LDS_BYTES) != hipSuccess) { fprintf(stderr, "kernel_launch: hipFuncSetAttribute failed\n"); grid = -1; return; }
        if (hipOccupancyMaxActiveBlocksPerMultiprocessor(&per_cu, (const void*)fwd_megakernel, 512, LDS_BYTES) != hipSuccess || per_cu < 1) { fprintf(stderr, "kernel_launch: occupancy query gave %d\n", per_cu); per_cu = 1; }
        (void)hipGetLastError();
        grid = cus * 1;
        if (n_in != 21 || ws_size < WS_END) { fprintf(stderr, "kernel_launch: unexpected n_in %d or ws %zu\n", n_in, ws_size); grid = -1; return; }
    }
    if (grid < 0) return;
    Params p{};
    for (int i = 0; i < 21; ++i) p.in[i] = (const float*)d_in[i];
    p.out = (float*)d_out; p.ws = (unsigned char*)d_ws;
    void* args[] = {&p};
    hipError_t e = hipLaunchCooperativeKernel((const void*)fwd_megakernel, dim3(grid), dim3(512), args, LDS_BYTES, stream);
    if (e != hipSuccess) fprintf(stderr, "cooperative launch failed: %s (grid %d)\n", hipGetErrorString(e), grid);
}
```

```cpp
#include <hip/hip_runtime.h>
#include <hip/hip_cooperative_groups.h>
#include <cstdio>
namespace cg = cooperative_groups;

#define LAS __attribute__((address_space(3)))
typedef unsigned short bf16_t;
typedef short bf16x8 __attribute__((ext_vector_type(8)));
typedef short bf16x4 __attribute__((ext_vector_type(4)));
typedef float f32x4 __attribute__((ext_vector_type(4)));
typedef float f32x2 __attribute__((ext_vector_type(2)));
typedef unsigned u32x4 __attribute__((ext_vector_type(4)));
typedef unsigned u32x2 __attribute__((ext_vector_type(2)));

constexpr int NB = 4, SEQ = 4096, TOK = NB * SEQ, DM = 2048, HW = 1024, MW = 1024, NHEAD = 4, DH = 256, FFH = 5632;
constexpr int CONVC = 5120, INCOLS = 11280, NFILT = 4096;
constexpr float RMS_EPS = 1e-6f;
constexpr size_t MiB = 1u << 20;
constexpr size_t WS_PCNT = 393216, WS_BAR = 262144, WS_R1S = 0, WS_SS2 = 65536, WS_SS3 = 131072, WS_G = 1 * MiB, WS_H2 = 2 * MiB;
constexpr size_t WS_WA = 4 * MiB, WS_WB = 8 * MiB, WS_WOUT = 12 * MiB, WS_WGU = 20 * MiB, WS_WD = 64 * MiB, WS_WIN = 86 * MiB, WS_XB = 130 * MiB;
constexpr size_t WS_FILT = 194 * MiB, WS_HY = 258 * MiB, WS_R1A = 354 * MiB, WS_R1B = 418 * MiB, WS_END = 494 * MiB;
constexpr size_t WS_QKP = 86 * MiB, WS_YA = 150 * MiB, WS_YBF = 354 * MiB, WS_YBB = 386 * MiB, WS_X1B = 86 * MiB, WS_MIX = 194 * MiB, WS_HH = 258 * MiB;
constexpr size_t WS_GSC = 482 * MiB;
constexpr int LDS_BYTES = 155648;

__device__ __forceinline__ unsigned f2bf(float f) { unsigned u = __float_as_uint(f); return (u + 0x7fffu + ((u >> 16) & 1u)) >> 16; }
__device__ __forceinline__ unsigned pk2(float lo, float hi) { unsigned r; asm volatile("v_cvt_pk_bf16_f32 %0, %1, %2" : "=v"(r) : "v"(lo), "v"(hi)); return r; }
__device__ __forceinline__ float bflo(unsigned w) { return __uint_as_float(w << 16); }
__device__ __forceinline__ float bfhi(unsigned w) { return __uint_as_float(w & 0xffff0000u); }
__device__ __forceinline__ float wave_sum(float v) {
#pragma unroll
    for (int o = 1; o < 64; o <<= 1) v += __shfl_xor(v, o);
    return v;
}
__device__ __forceinline__ size_t blk_off(int row, int k, int K) { return ((size_t)(row >> 7) * (size_t)(K >> 6) + (size_t)(k >> 6)) * 8192 + (size_t)((row & 127) * 64 + (k & 63)); }
__device__ __forceinline__ int lane_id_opaque() { int l; asm volatile("v_mbcnt_lo_u32_b32 %0, -1, 0\n\tv_mbcnt_hi_u32_b32 %0, -1, %0" : "=v"(l)); return l; }
__device__ __forceinline__ float sigmoidf_(float x) { return __builtin_amdgcn_rcpf(1.0f + __expf(-x)); }
__device__ __forceinline__ f32x4 sigmoid4(f32x4 v) {
    const f32x4 t = v * (-1.4426950408889634f);
    f32x4 e; e.x = __builtin_amdgcn_exp2f(t.x); e.y = __builtin_amdgcn_exp2f(t.y); e.z = __builtin_amdgcn_exp2f(t.z); e.w = __builtin_amdgcn_exp2f(t.w);
    const f32x4 d = e + 1.0f;
    f32x4 r; r.x = __builtin_amdgcn_rcpf(d.x); r.y = __builtin_amdgcn_rcpf(d.y); r.z = __builtin_amdgcn_rcpf(d.z); r.w = __builtin_amdgcn_rcpf(d.w);
    return r;
}
__device__ __forceinline__ float siluf_(float x) { return x * __builtin_amdgcn_rcpf(1.0f + __expf(-x)); }

namespace pg8 {
constexpr int BM = 256, BK = 64, HALF = 128, HTB = HALF * BK * 2, STAGE_BYTES = 8 * HTB, NXCD = 8, WGM = 8;
__device__ __forceinline__ int lds_byte(int r, int c) { const int st = (r >> 4) * 2 + (c >> 5), rr = r & 15, cc = c & 31, ob = rr * 64 + cc * 2; return st * 1024 + (ob ^ (((ob >> 9) & 1) << 5)); }
__device__ __forceinline__ void stage_rc(int b, int& R, int& C) { const int st = b / 1024, sb = b % 1024, swz = sb ^ (((sb >> 9) & 1) << 5); R = (st >> 1) * 16 + swz / 64; C = (st & 1) * 32 + (swz % 64) / 2; }
__device__ __forceinline__ int perm32(int rho) { const int n = rho >> 4, i = rho & 15; return 8 * (i >> 2) + 4 * n + (i & 3); }
struct GUnit { const char* A; const char* B; int pm, pn, sub; };
__device__ __forceinline__ void tile_of(int L, int nM, int nN, int& pm, int& pn) {
    const int nwg = nM * nN; int wgid = L; { const int q = nwg / NXCD, r = nwg % NXCD, xcd = wgid % NXCD, off = wgid / NXCD; wgid = (xcd < r ? xcd * (q + 1) : r * (q + 1) + (xcd - r) * q) + off; }
    const int nig = WGM * nN, gid = wgid / nig, fm = gid * WGM, gsz = (nM - fm) < WGM ? (nM - fm) : WGM;
    pm = fm + ((wgid % nig) % gsz); pn = (wgid % nig) / gsz;
}
typedef f32x4 Acc[2][2][4][2];
template <class Prog>
__device__ __forceinline__ void gemm_stream(LAS unsigned char* lds, const Prog& P, int wv) {
    int tid = (wv << 6) | lane_id_opaque(); asm volatile("" : "+v"(tid));
    const int wid = __builtin_amdgcn_readfirstlane(tid >> 6), lane = tid & 63, wr = wid >> 2, wc = wid & 3, fr = lane & 15, fq = lane >> 4;
    const int K = P.K, nt = K / BK;
    unsigned voffA[2], voffB[2];
#pragma unroll
    for (int i = 0; i < 2; ++i) { int R, C; stage_rc(tid * 16 + i * 8192, R, C); const int Rb = Prog::PERM ? ((R & ~31) + perm32(R & 31)) : R;
        voffA[i] = (unsigned)(R * 64 + C) * 2u; voffB[i] = (unsigned)(Rb * 64 + C) * 2u; }
    const size_t kstep = (size_t)(HALF * BK * 2);
    const size_t hstep = (size_t)HALF * K * 2;
    const unsigned ldsw = (unsigned)wid * 1024u;
    const int aoff = lds_byte(wr * 64 + fr, fq * 8), boff = lds_byte(wc * 32 + fr, fq * 8);
#define PG8_SA(b, h) (((b) * 2 + (h)) * HTB)
#define PG8_SB(b, h) ((4 + (b) * 2 + (h)) * HTB)
#define PG8_STAGE(bufoff, gbase, voff) do { _Pragma("unroll") for (int _i = 0; _i < 2; ++_i) \
        __builtin_amdgcn_global_load_lds((const unsigned*)((const char*)(gbase) + (voff)[_i]), (LAS unsigned*)(lds + (bufoff) + ldsw + _i * 8192), 16, 0, 0); } while (0)
#define PG8_LDA(dst, b, h) do { _Pragma("unroll") for (int m = 0; m < 4; ++m) _Pragma("unroll") for (int k = 0; k < 2; ++k) dst[m][k] = *(const LAS bf16x8*)(lds + PG8_SA(b, h) + aoff + m * 2048 + k * 1024); } while (0)
#define PG8_LDB(dst, b, h) do { _Pragma("unroll") for (int n = 0; n < 2; ++n) _Pragma("unroll") for (int k = 0; k < 2; ++k) dst[n][k] = *(const LAS bf16x8*)(lds + PG8_SB(b, h) + boff + n * 2048 + k * 1024); } while (0)
#define PG8_MMA(ai, bj, At, Bt) do { __builtin_amdgcn_s_setprio(1); _Pragma("unroll") for (int m = 0; m < 4; ++m) _Pragma("unroll") for (int n = 0; n < 2; ++n) _Pragma("unroll") for (int k = 0; k < 2; ++k) \
        acc[ai][bj][m][n] = __builtin_amdgcn_mfma_f32_16x16x32_bf16(Bt[n][k], At[m][k], acc[ai][bj][m][n], 0, 0, 0); __builtin_amdgcn_s_setprio(0); } while (0)
#define PG8_WAIT_V(n) asm volatile("s_waitcnt vmcnt(" #n ")" ::: "memory")
#define PG8_WAIT_L(n) asm volatile("s_waitcnt lgkmcnt(" #n ")" ::: "memory")
#define PG8_BAR __builtin_amdgcn_s_barrier()
#define PG8_SCHED __builtin_amdgcn_sched_barrier(0)
    GUnit cur, nxt; int ui = 0;
    if (!P.next(0, cur)) return;
    f32x4 acc[2][2][4][2];
#pragma unroll
    for (int a = 0; a < 2; ++a)
#pragma unroll
        for (int b = 0; b < 2; ++b)
#pragma unroll
            for (int m = 0; m < 4; ++m)
#pragma unroll
                for (int n = 0; n < 2; ++n) acc[a][b][m][n] = (f32x4){0.f, 0.f, 0.f, 0.f};
    bf16x8 At[4][2], B0[2][2], B1[2][2];
    const char* cA = cur.A; const char* cB = cur.B;
    PG8_STAGE(PG8_SB(0, 0), cB, voffB); PG8_STAGE(PG8_SA(0, 0), cA, voffA); PG8_STAGE(PG8_SB(0, 1), cB + hstep, voffB); PG8_STAGE(PG8_SA(0, 1), cA + hstep, voffA);
    if (wr == 1) PG8_BAR;
    PG8_WAIT_V(4); PG8_BAR;
    PG8_STAGE(PG8_SB(1, 0), cB + kstep, voffB); PG8_STAGE(PG8_SA(1, 0), cA + kstep, voffA); PG8_STAGE(PG8_SB(1, 1), cB + hstep + kstep, voffB);
    PG8_WAIT_V(6); PG8_BAR;
    for (;;) {
        const bool has_next = P.next(ui + 1, nxt);
        const char* nA = has_next ? nxt.A : cA; const char* nB = has_next ? nxt.B : cB;
        for (int t = 0; t < nt; t += 2) {
            const bool last = (t == nt - 2);
            const char* a1 = cA + (size_t)(t + 1) * kstep;
            const char* a2 = last ? nA : cA + (size_t)(t + 2) * kstep; const char* b2 = last ? nB : cB + (size_t)(t + 2) * kstep;
            const char* a3 = a2 + kstep; const char* b3 = b2 + kstep;
            PG8_LDB(B0, 0, 0); PG8_SCHED; PG8_LDA(At, 0, 0); PG8_STAGE(PG8_SA(1, 1), a1 + hstep, voffA);
            PG8_WAIT_L(8); PG8_BAR; PG8_WAIT_L(0); PG8_MMA(0, 0, At, B0); PG8_BAR; PG8_SCHED;
            PG8_LDB(B1, 0, 1); PG8_STAGE(PG8_SB(0, 0), b2, voffB);
            PG8_BAR; PG8_WAIT_L(0); PG8_MMA(0, 1, At, B1); PG8_BAR;
            PG8_LDA(At, 0, 1); PG8_STAGE(PG8_SA(0, 0), a2, voffA);
            PG8_BAR; PG8_WAIT_L(0); PG8_MMA(1, 0, At, B0); PG8_BAR; PG8_SCHED;
            PG8_STAGE(PG8_SB(0, 1), b2 + hstep, voffB);
            PG8_WAIT_V(6); PG8_BAR; PG8_MMA(1, 1, At, B1); PG8_BAR;
            PG8_LDB(B0, 1, 0); PG8_SCHED; PG8_LDA(At, 1, 0); PG8_STAGE(PG8_SA(0, 1), a2 + hstep, voffA);
            PG8_WAIT_L(8); PG8_BAR; PG8_WAIT_L(0); PG8_MMA(0, 0, At, B0); PG8_BAR; PG8_SCHED;
            PG8_LDB(B1, 1, 1); PG8_STAGE(PG8_SB(1, 0), b3, voffB);
            PG8_BAR; PG8_WAIT_L(0); PG8_MMA(0, 1, At, B1); PG8_BAR;
            PG8_LDA(At, 1, 1); PG8_STAGE(PG8_SA(1, 0), a3, voffA);
            PG8_BAR; PG8_WAIT_L(0); PG8_MMA(1, 0, At, B0); PG8_BAR; PG8_SCHED;
            PG8_STAGE(PG8_SB(1, 1), b3 + hstep, voffB);
            PG8_WAIT_V(6); PG8_BAR; PG8_MMA(1, 1, At, B1); PG8_BAR;
        }
        if (Prog::FUSE_LAST && !has_next) break;
        P.epi(acc, cur, wr, wc, fr, fq);
        if (!has_next) break;
        cur = nxt; cA = nA; cB = nB; ++ui;
    }
    PG8_WAIT_V(0);
    if (wr == 0) PG8_BAR;
    PG8_BAR;
    if constexpr (Prog::FUSE_LAST) P.epi_last(acc, cur, wr, wc, fr, fq, wv);
#undef PG8_SA
#undef PG8_SB
#undef PG8_STAGE
#undef PG8_LDA
#undef PG8_LDB
#undef PG8_MMA
#undef PG8_WAIT_V
#undef PG8_WAIT_L
#undef PG8_BAR
#undef PG8_SCHED
}
__device__ __forceinline__ void zero_acc(Acc& acc) {
#pragma unroll
    for (int a = 0; a < 2; ++a)
#pragma unroll
        for (int b = 0; b < 2; ++b)
#pragma unroll
            for (int m = 0; m < 4; ++m)
#pragma unroll
                for (int n = 0; n < 2; ++n) acc[a][b][m][n] = (f32x4){0.f, 0.f, 0.f, 0.f};
}
}
using pg8::GUnit; using pg8::Acc;
__device__ __forceinline__ void unpack8(u32x4 w, float (&f)[8]) { f[0] = bflo(w.x); f[1] = bfhi(w.x); f[2] = bflo(w.y); f[3] = bfhi(w.y); f[4] = bflo(w.z); f[5] = bfhi(w.z); f[6] = bflo(w.w); f[7] = bfhi(w.w); }
struct HyProg {
    static constexpr bool FUSE_LAST = false; static constexpr bool PERM = true; int K, G, c; const bf16_t* W; const bf16_t* X; bf16_t* HY; const float* r1;
    __device__ __forceinline__ bool next(int i, GUnit& u) const { const int L = i * G + c; if (L >= 12 * 64) return false; pg8::tile_of(L, 12, 64, u.pm, u.pn);
        u.A = (const char*)(W + (size_t)u.pm * 256 * DM); u.B = (const char*)(X + (size_t)u.pn * 256 * DM); u.sub = 0; return true; }
    __device__ __forceinline__ void epi(Acc& acc, const GUnit& u, int wr, int wc, int fr, int fq) const {
        const int row0 = u.pm * 256 + wr * 64 + fr, col0 = u.pn * 256 + wc * 32 + 8 * fq;
        f32x4 sc[2][2];
#pragma unroll
        for (int bj = 0; bj < 2; ++bj) { sc[bj][0] = *(const f32x4*)(r1 + col0 + bj * 128); sc[bj][1] = *(const f32x4*)(r1 + col0 + bj * 128 + 4); }
#pragma unroll
        for (int ai = 0; ai < 2; ++ai)
#pragma unroll
            for (int m = 0; m < 4; ++m) { bf16_t* rowp = HY + (size_t)(row0 + ai * 128 + m * 16) * TOK + col0;
#pragma unroll
                for (int bj = 0; bj < 2; ++bj) { const f32x4 v0 = acc[ai][bj][m][0] * sc[bj][0], v1 = acc[ai][bj][m][1] * sc[bj][1];
                    u32x4 w; w.x = pk2(v0[0], v0[1]); w.y = pk2(v0[2], v0[3]); w.z = pk2(v1[0], v1[1]); w.w = pk2(v1[2], v1[3]);
                    *(u32x4*)(rowp + bj * 128) = w; } }
        pg8::zero_acc(acc);
    }
};
struct RestProg {
    static constexpr bool FUSE_LAST = false; static constexpr bool PERM = true; int K, G, c; const bf16_t* W; const bf16_t* X; bf16_t* R1A; bf16_t* R1B; bf16_t* R2; const float* r1;
    __device__ __forceinline__ bool next(int i, GUnit& u) const { const int L = i * G + c; if (L >= 64 * 32) return false; pg8::tile_of(L, 64, 32, u.pm, u.pn);
        u.A = (const char*)(X + (size_t)u.pm * 256 * DM); u.B = (const char*)(W + (size_t)(3072 + u.pn * 256) * DM); u.sub = 0; return true; }
    __device__ __forceinline__ void epi(Acc& acc, const GUnit& u, int wr, int wc, int fr, int fq) const {
        const int row0 = u.pm * 256 + wr * 64 + fr; const bool sg = u.pn >= 12;
        bf16_t* base = u.pn < 8 ? R1A + u.pn * 256 : (u.pn < 16 ? R1B + (u.pn - 8) * 256 : R2 + (u.pn - 16) * 256);
        const int pitch = u.pn < 16 ? 2048 : 4096;
        const int col0 = wc * 32 + 8 * fq;
        float rs[2][4];
#pragma unroll
        for (int ai = 0; ai < 2; ++ai)
#pragma unroll
            for (int m = 0; m < 4; ++m) rs[ai][m] = r1[row0 + ai * 128 + m * 16];
#pragma unroll
        for (int ai = 0; ai < 2; ++ai)
#pragma unroll
            for (int m = 0; m < 4; ++m) { const int row = row0 + ai * 128 + m * 16; const float s = rs[ai][m]; bf16_t* rowp = base + (size_t)row * pitch + col0;
#pragma unroll
                for (int bj = 0; bj < 2; ++bj) { f32x4 v0 = acc[ai][bj][m][0] * s, v1 = acc[ai][bj][m][1] * s;
                    if (sg) {
#pragma unroll
                        for (int j = 0; j < 4; ++j) { v0[j] = sigmoidf_(v0[j]); v1[j] = sigmoidf_(v1[j]); } }
                    u32x4 w; w.x = pk2(v0[0], v0[1]); w.y = pk2(v0[2], v0[3]); w.z = pk2(v1[0], v1[1]); w.w = pk2(v1[2], v1[3]);
                    *(u32x4*)(rowp + bj * 128) = w; } }
        pg8::zero_acc(acc);
    }
};
struct InProg {
    static constexpr bool FUSE_LAST = false, PERM = true; int K, G, c; HyProg H; RestProg R;
    __device__ __forceinline__ void prefetch(const GUnit&, int, int, float (&pf)[8]) const {}
    __device__ __forceinline__ bool next(int i, GUnit& u) const {
        int L = i * G + c;
        if (L < 12 * 64) { pg8::tile_of(L, 12, 64, u.pm, u.pn); u.A = (const char*)(H.W + (size_t)u.pm * 256 * DM); u.B = (const char*)(H.X + (size_t)u.pn * 256 * DM); u.sub = 1; return true; }
        L -= 12 * 64; if (L >= 64 * 32) return false;
        pg8::tile_of(L, 64, 32, u.pm, u.pn); u.A = (const char*)(R.X + (size_t)u.pm * 256 * DM); u.B = (const char*)(R.W + (size_t)(3072 + u.pn * 256) * DM); u.sub = 0; return true; }
    __device__ __forceinline__ void epi(Acc& acc, const GUnit& u, int wr, int wc, int fr, int fq) const { if (u.sub == 1) H.epi(acc, u, wr, wc, fr, fq); else R.epi(acc, u, wr, wc, fr, fq); }
};
struct BranchProg {
    static constexpr bool FUSE_LAST = false; static constexpr bool PERM = true; int K, G, c; const bf16_t *YA, *YBF, *YBB, *WA, *WB; const bf16_t* R2; bf16_t* MIX;
    __device__ __forceinline__ bool next(int i, GUnit& u) const { const int ti = i / 3, sub = i - 3 * ti; const int L = ti * G + c; if (L >= 64 * 8) return false; pg8::tile_of(L, 64, 8, u.pm, u.pn);
        const bf16_t* a = sub == 0 ? YA : (sub == 1 ? YBF : YBB); const bf16_t* b = sub == 0 ? WA : WB;
        u.A = (const char*)(a + (size_t)u.pm * 256 * 1024); u.B = (const char*)(b + (size_t)u.pn * 256 * 1024); u.sub = sub; return true; }
    __device__ __forceinline__ void epi(Acc& acc, const GUnit& u, int wr, int wc, int fr, int fq) const {
        if (u.sub == 1) return;
        const int row0 = u.pm * 256 + wr * 64 + fr, col0 = u.pn * 256 + wc * 32 + 8 * fq;
#pragma unroll
        for (int ai = 0; ai < 2; ++ai) {
            u32x4 gbw[4][2], gaw[4][2];
#pragma unroll
            for (int m = 0; m < 4; ++m)
#pragma unroll
                for (int bj = 0; bj < 2; ++bj) { const bf16_t* gp = R2 + (size_t)(row0 + ai * 128 + m * 16) * 4096 + col0 + bj * 128;
                    gbw[m][bj] = *(const u32x4*)(gp + 2048); if (u.sub == 0) gaw[m][bj] = *(const u32x4*)gp; else gaw[m][bj] = gbw[m][bj]; }
#pragma unroll
            for (int m = 0; m < 4; ++m) { const int row = row0 + ai * 128 + m * 16;
#pragma unroll
                for (int bj = 0; bj < 2; ++bj) {
                    float gb[8], ga[8]; unpack8(gbw[m][bj], gb); unpack8(gaw[m][bj], ga);
                    if (u.sub == 0) {
#pragma unroll
                        for (int j = 0; j < 4; ++j) { acc[ai][bj][m][0][j] *= ga[j] * __builtin_amdgcn_rcpf(fmaxf(gb[j], 1e-30f)); acc[ai][bj][m][1][j] *= ga[4 + j] * __builtin_amdgcn_rcpf(fmaxf(gb[4 + j], 1e-30f)); }
                    } else {
                        f32x4 v0 = acc[ai][bj][m][0], v1 = acc[ai][bj][m][1];
#pragma unroll
                        for (int j = 0; j < 4; ++j) { v0[j] *= fmaxf(gb[j], 1e-30f); v1[j] *= fmaxf(gb[4 + j], 1e-30f); }
                        u32x4 w; w.x = pk2(v0[0], v0[1]); w.y = pk2(v0[2], v0[3]); w.z = pk2(v1[0], v1[1]); w.w = pk2(v1[2], v1[3]);
                        *(u32x4*)(MIX + blk_off(row, col0 + bj * 128, DM)) = w;
                    } } }
        }
        if (u.sub == 2) pg8::zero_acc(acc);
    }
};
template <bool FUSE> struct ResProg {
    static constexpr bool PERM = false, FUSE_LAST = FUSE; int K, G, c; unsigned* pcnt; const float* wf; const bf16_t* A; const bf16_t* B; const float* base; const bf16_t* base16; float* out; bf16_t* outb; float* ss;
    __device__ __forceinline__ bool next(int i, GUnit& u) const { const int L = i * G + c; if (L >= 64 * 8) return false; pg8::tile_of(L, 64, 8, u.pm, u.pn);
        u.A = (const char*)(A + (size_t)u.pm * 256 * K); u.B = (const char*)(B + (size_t)u.pn * 256 * K); u.sub = 0; return true; }
    __device__ __forceinline__ void epi(Acc& acc, const GUnit& u, int wr, int wc, int fr, int fq) const {
        const int row0 = u.pm * 256 + wr * 64 + fr, col0 = u.pn * 256 + wc * 32 + 4 * fq;
#pragma unroll
        for (int ai = 0; ai < 2; ++ai) {
            f32x4 bs[4][2][2];
#pragma unroll
            for (int m = 0; m < 4; ++m)
#pragma unroll
                for (int bj = 0; bj < 2; ++bj)
#pragma unroll
                    for (int n = 0; n < 2; ++n) { const int row = row0 + ai * 128 + m * 16, col = col0 + bj * 128 + n * 16;
                        if (base16) { const u32x2 w = *(const u32x2*)(base16 + blk_off(row, col, DM)); bs[m][bj][n] = (f32x4){bflo(w.x), bfhi(w.x), bflo(w.y), bfhi(w.y)}; }
                        else bs[m][bj][n] = *(const f32x4*)(base + (size_t)row * DM + col); }
#pragma unroll
            for (int m = 0; m < 4; ++m) { const int row = row0 + ai * 128 + m * 16; const size_t off = (size_t)row * DM + col0; float s = 0.f;
#pragma unroll
                for (int bj = 0; bj < 2; ++bj)
#pragma unroll
                    for (int n = 0; n < 2; ++n) { const f32x4 o = bs[m][bj][n] + acc[ai][bj][m][n];
                        if (out) *(f32x4*)(out + off + bj * 128 + n * 16) = o;
                        s += (o[0] * o[0] + o[1] * o[1]) + (o[2] * o[2] + o[3] * o[3]);
                        if (outb) { u32x2 w; w.x = pk2(o[0], o[1]); w.y = pk2(o[2], o[3]); *(u32x2*)(outb + blk_off(row, col0 + bj * 128 + n * 16, DM)) = w; } }
                s += __shfl_xor(s, 16); s += __shfl_xor(s, 32);
                if (fq == 0) unsafeAtomicAdd(ss + row, s); }
        }
        pg8::zero_acc(acc);
    }
    __device__ __forceinline__ void epi_last(Acc& acc, const GUnit& u, int wr, int wc, int fr, int fq, int wv) const {
        const int row0 = u.pm * 256 + wr * 64 + fr, col0 = u.pn * 256 + wc * 32 + 4 * fq;
#pragma unroll
        for (int ai = 0; ai < 2; ++ai) {
            u32x2 bw[4][2][2];
#pragma unroll
            for (int m = 0; m < 4; ++m)
#pragma unroll
                for (int bj = 0; bj < 2; ++bj)
#pragma unroll
                    for (int n = 0; n < 2; ++n) bw[m][bj][n] = *(const u32x2*)(base16 + blk_off(row0 + ai * 128 + m * 16, col0 + bj * 128 + n * 16, DM));
#pragma unroll
            for (int m = 0; m < 4; ++m) { const int row = row0 + ai * 128 + m * 16; float s = 0.f;
#pragma unroll
                for (int bj = 0; bj < 2; ++bj)
#pragma unroll
                    for (int n = 0; n < 2; ++n) { const u32x2 w = bw[m][bj][n]; const f32x4 o = (f32x4){bflo(w.x), bfhi(w.x), bflo(w.y), bfhi(w.y)} + acc[ai][bj][m][n];
                        acc[ai][bj][m][n] = o; s += (o[0] * o[0] + o[1] * o[1]) + (o[2] * o[2] + o[3] * o[3]); }
                s += __shfl_xor(s, 16); s += __shfl_xor(s, 32);
                if (fq == 0) unsafeAtomicAdd(ss + row, s); }
        }
        asm volatile("s_waitcnt vmcnt(0)" ::: "memory");
        __syncthreads();
        const int lane = lane_id_opaque();
        if (wv == 0 && lane == 0) {
            __builtin_amdgcn_fence(__ATOMIC_RELEASE, "agent"); asm volatile("s_waitcnt vmcnt(0)" ::: "memory");
            for (int i = 0; ; ++i) { const int L = i * G + c; if (L >= 64 * 8) break; int pm, pn; pg8::tile_of(L, 64, 8, pm, pn); __hip_atomic_fetch_add(&pcnt[64 * pm], 1u, __ATOMIC_RELAXED, __HIP_MEMORY_SCOPE_AGENT); }
            unsigned sp = 0; while (__hip_atomic_load(&pcnt[64 * u.pm], __ATOMIC_RELAXED, __HIP_MEMORY_SCOPE_AGENT) < 8u) { __builtin_amdgcn_s_sleep(1); if (++sp > (1u << 20)) break; }
            __builtin_amdgcn_fence(__ATOMIC_ACQUIRE, "agent"); asm volatile("s_waitcnt vmcnt(0)" ::: "memory");
        }
        __syncthreads();
        f32x4 wv4[2][2];
#pragma unroll
        for (int bj = 0; bj < 2; ++bj)
#pragma unroll
            for (int n = 0; n < 2; ++n) wv4[bj][n] = *(const f32x4*)(wf + col0 + bj * 128 + n * 16);
        float rr[2][4];
#pragma unroll
        for (int ai = 0; ai < 2; ++ai)
#pragma unroll
            for (int m = 0; m < 4; ++m) rr[ai][m] = __hip_atomic_load(ss + row0 + ai * 128 + m * 16, __ATOMIC_RELAXED, __HIP_MEMORY_SCOPE_AGENT);
#pragma unroll
        for (int ai = 0; ai < 2; ++ai)
#pragma unroll
            for (int m = 0; m < 4; ++m) { const int row = row0 + ai * 128 + m * 16; const float r = __builtin_amdgcn_rsqf(rr[ai][m] * (1.0f / DM) + RMS_EPS);
#pragma unroll
                for (int bj = 0; bj < 2; ++bj)
#pragma unroll
                    for (int n = 0; n < 2; ++n) *(f32x4*)(out + (size_t)row * DM + col0 + bj * 128 + n * 16) = acc[ai][bj][m][n] * r * wv4[bj][n]; }
    }
};
struct GuProg {
    static constexpr bool FUSE_LAST = false; static constexpr bool PERM = true; int K, G, c; const bf16_t* X; const bf16_t* W; bf16_t* HH; const float* ss2;
    __device__ __forceinline__ bool next(int i, GUnit& u) const { const int L = i * G + c; if (L >= 64 * 44) return false; pg8::tile_of(L, 64, 44, u.pm, u.pn);
        u.A = (const char*)(X + (size_t)u.pm * 256 * DM); u.B = (const char*)(W + (size_t)u.pn * 256 * DM); u.sub = 0; return true; }
    __device__ __forceinline__ void epi(Acc& acc, const GUnit& u, int wr, int wc, int fr, int fq) const {
        const int row0 = u.pm * 256 + wr * 64 + fr, col0 = u.pn * 128 + wc * 32 + 8 * fq;
        float sq[2][4];
#pragma unroll
        for (int ai = 0; ai < 2; ++ai)
#pragma unroll
            for (int m = 0; m < 4; ++m) sq[ai][m] = ss2[row0 + ai * 128 + m * 16];
#pragma unroll
        for (int ai = 0; ai < 2; ++ai)
#pragma unroll
            for (int m = 0; m < 4; ++m) { const int row = row0 + ai * 128 + m * 16; const float r2 = __builtin_amdgcn_rsqf(sq[ai][m] * (1.0f / DM) + RMS_EPS);
                const f32x4 g0 = acc[ai][0][m][0] * r2, g1 = acc[ai][0][m][1] * r2, u0 = acc[ai][1][m][0] * r2, u1 = acc[ai][1][m][1] * r2;
                const f32x4 h0 = g0 * sigmoid4(g0) * u0, h1 = g1 * sigmoid4(g1) * u1;
                u32x4 w; w.x = pk2(h0[0], h0[1]); w.y = pk2(h0[2], h0[3]); w.z = pk2(h1[0], h1[1]); w.w = pk2(h1[2], h1[3]);
                *(u32x4*)(HH + blk_off(row, col0, FFH)) = w; }
        pg8::zero_acc(acc);
    }
};
struct Ctx {
    const float* in[21]; float* out; unsigned char* ws;
};
struct TpItem { const float* W; const float* ks; bf16_t* WT; int Nsrc, K, dst_row0, src_col0, kb; };
__device__ __forceinline__ TpItem tp_decode(const Ctx& C, int it) {
    constexpr int I_IN = 32 * 352, I_A = 16 * 64, I_O = 32 * 64, I_GU = 32 * 352;
    unsigned char* ws = C.ws; TpItem t; int r = it;
    if (r < I_IN) { const int nb = r % 352, n0 = nb * 32; t.W = C.in[2]; t.ks = C.in[1]; t.WT = (bf16_t*)(ws + WS_WIN); t.Nsrc = INCOLS; t.K = DM; t.dst_row0 = n0; t.src_col0 = n0 < 7168 ? n0 : n0 + 16; t.kb = r / 352; return t; } r -= I_IN;
    if (r < I_A) { t.W = C.in[14]; t.ks = nullptr; t.WT = (bf16_t*)(ws + WS_WA); t.Nsrc = DM; t.K = HW; t.dst_row0 = (r % 64) * 32; t.src_col0 = t.dst_row0; t.kb = r / 64; return t; } r -= I_A;
    if (r < I_A) { t.W = C.in[15]; t.ks = nullptr; t.WT = (bf16_t*)(ws + WS_WB); t.Nsrc = DM; t.K = MW; t.dst_row0 = (r % 64) * 32; t.src_col0 = t.dst_row0; t.kb = r / 64; return t; } r -= I_A;
    if (r < I_O) { t.W = C.in[16]; t.ks = nullptr; t.WT = (bf16_t*)(ws + WS_WOUT); t.Nsrc = DM; t.K = DM; t.dst_row0 = (r % 64) * 32; t.src_col0 = t.dst_row0; t.kb = r / 64; return t; } r -= I_O;
    if (r < I_GU) { const int nb = r % 352, n0 = nb * 32; const int pn = n0 >> 8, half = (n0 >> 7) & 1, i = n0 & 127;
        t.W = C.in[18]; t.ks = C.in[17]; t.WT = (bf16_t*)(ws + WS_WGU); t.Nsrc = 2 * FFH; t.K = DM; t.dst_row0 = n0; t.src_col0 = half * FFH + 128 * pn + i; t.kb = r / 352; return t; } r -= I_GU;
    t.W = C.in[19]; t.ks = nullptr; t.WT = (bf16_t*)(ws + WS_WD); t.Nsrc = DM; t.K = FFH; t.dst_row0 = (r % 64) * 32; t.src_col0 = t.dst_row0; t.kb = r / 64; return t;
}
__device__ __forceinline__ void tp_load(const TpItem& t, int lane, float (&tv)[32], float (&sv)[32]) {
    const int k0 = 64 * t.kb; const float* wp = t.W + (size_t)(k0 + (lane >> 5)) * t.Nsrc + t.src_col0 + (lane & 31);
#pragma unroll
    for (int i = 0; i < 32; ++i) tv[i] = wp[(size_t)(2 * i) * t.Nsrc];
    const float* kp = t.ks ? t.ks + k0 + (lane >> 5) : nullptr;
#pragma unroll
    for (int i = 0; i < 32; ++i) sv[i] = kp ? kp[2 * i] : 1.0f;
}
__device__ __forceinline__ void p0_prologue(const Ctx& C, LAS unsigned char* lds, int G, int wv) {
    int tid = (wv << 6) | lane_id_opaque(); asm volatile("" : "+v"(tid));
    const int lane = tid & 63, wave = __builtin_amdgcn_readfirstlane(tid >> 6);
    const int gw = blockIdx.x * 8 + wave, NGW = G * 8;
    unsigned char* ws = C.ws;
    LAS float* scr = (LAS float*)(lds + 67584 + wave * 8704);
    {
        constexpr int WGP = 2056;
        LAS bf16_t* wgb = (LAS bf16_t*)lds;
        const float* w_in = C.in[2]; const float* nw = C.in[1];
#pragma unroll 1
        for (int i0 = tid; i0 < DM * 16; i0 += 512 * 16) { float tw[16], tn[16];
#pragma unroll
            for (int u = 0; u < 16; ++u) { const int i = i0 + 512 * u, k = i >> 4, g = i & 15; tw[u] = w_in[(size_t)k * INCOLS + 7168 + g]; tn[u] = nw[k]; }
#pragma unroll
            for (int u = 0; u < 16; ++u) { const int i = i0 + 512 * u, k = i >> 4, g = i & 15; wgb[g * WGP + k] = (bf16_t)f2bf(tw[u] * tn[u]); } }
        __syncthreads();
    }

    {
        constexpr int NIT = 32 * 352 + 2 * 16 * 64 + 32 * 64 + 32 * 352 + 88 * 64;
        float tv[32], sv[32]; TpItem cur, nxt; int it = gw;
        if (it < NIT) { cur = tp_decode(C, it); tp_load(cur, lane, tv, sv); }
        while (it < NIT) {
#pragma unroll
            for (int i = 0; i < 32; ++i) scr[(2 * i + (lane >> 5)) * 33 + (lane & 31)] = tv[i] * sv[i];
            asm volatile("s_waitcnt lgkmcnt(0)" ::: "memory");
            const int nit = it + NGW;
            if (nit < NIT) { nxt = tp_decode(C, nit); tp_load(nxt, lane, tv, sv); }
            const int c = lane & 7, k0 = 64 * cur.kb;
#pragma unroll
            for (int j = 0; j < 4; ++j) { const int n = (lane >> 3) + 8 * j; const LAS float* sp = scr + (8 * c) * 33 + n;
                u32x4 o; o.x = pk2(sp[0 * 33], sp[1 * 33]); o.y = pk2(sp[2 * 33], sp[3 * 33]); o.z = pk2(sp[4 * 33], sp[5 * 33]); o.w = pk2(sp[6 * 33], sp[7 * 33]);
                *(u32x4*)(cur.WT + blk_off(cur.dst_row0 + n, k0 + 8 * c, cur.K)) = o; }
            asm volatile("s_waitcnt lgkmcnt(0)" ::: "memory");
            cur = nxt; it = nit;
        }
    }
    for (int i = blockIdx.x * 512 + tid; i < TOK; i += G * 512) { ((float*)(ws + WS_SS2))[i] = 0.f; ((float*)(ws + WS_SS3))[i] = 0.f; }
    {
        const float* w1 = C.in[5]; const float* b1 = C.in[6]; const float* f1 = C.in[7]; const float* w2 = C.in[8]; const float* b2 = C.in[9]; const float* f2 = C.in[10];
        float* h2 = (float*)(ws + WS_H2);
        for (int t = gw; t < SEQ; t += NGW) {
            const float tl = (float)t / (float)(SEQ - 1);
            const float omega = 6.283185307179586f * (float)t / (float)SEQ;
            float a = b1[lane] + tl * w1[lane];
            float sn, cs;
            { const int bi = lane & 15; const float fr = 1e-4f + (float)bi * ((15.0f - 1e-4f) / 15.0f); sincosf(omega * fr, &sn, &cs); }
#pragma unroll
            for (int i = 0; i < 16; ++i) a += __shfl(cs, i) * w1[(1 + i) * 64 + lane] - __shfl(sn, i) * w1[(17 + i) * 64 + lane];
            const float h1 = sinf(f1[lane] * a);
            float a2 = b2[lane];
#pragma unroll 8
            for (int i = 0; i < 64; ++i) a2 += __shfl(h1, i) * w2[i * 64 + lane];
            h2[t * 64 + lane] = sinf(f2[lane] * a2);
        }
    }
    {
        constexpr int WGP = 2056; LAS bf16_t* wgb = (LAS bf16_t*)lds;
        const float* x = C.in[0]; bf16_t* xb = (bf16_t*)(ws + WS_XB); float* r1 = (float*)(ws + WS_R1S); float* Gt = (float*)(ws + WS_G); const float* gbias = C.in[13];
        const int r = lane & 15, g = lane >> 4; const bool act = r < 8;
        for (int rb = gw; rb < TOK / 8; rb += NGW) {
            const int row = rb * 8 + (r & 7);
            const float* xp = x + (size_t)row * DM + 8 * g;
            f32x4 acc = {0.f, 0.f, 0.f, 0.f}; float ss = 0.f;
#pragma unroll 1
            for (int k8 = 0; k8 < 64; k8 += 8) {
                f32x4 la[8], lb[8];
#pragma unroll
                for (int u = 0; u < 8; ++u) { la[u] = *(const f32x4*)(xp + 32 * (k8 + u)); lb[u] = *(const f32x4*)(xp + 32 * (k8 + u) + 4); }
#pragma unroll
                for (int u = 0; u < 8; ++u) { const int kk = k8 + u; const f32x4 a = la[u], b = lb[u];
                    ss += ((a.x * a.x + a.y * a.y) + (a.z * a.z + a.w * a.w)) + ((b.x * b.x + b.y * b.y) + (b.z * b.z + b.w * b.w));
                    u32x4 o; o.x = pk2(a.x, a.y); o.y = pk2(a.z, a.w); o.z = pk2(b.x, b.y); o.w = pk2(b.z, b.w);
                    *(u32x4*)(xb + blk_off(row, 32 * kk + 8 * g, DM)) = o;
                    if (!act) { o.x = 0u; o.y = 0u; o.z = 0u; o.w = 0u; }
                    const bf16x8 bw = *(const LAS bf16x8*)(wgb + r * WGP + 32 * kk + 8 * g);
                    acc = __builtin_amdgcn_mfma_f32_16x16x32_bf16(__builtin_bit_cast(bf16x8, o), bw, acc, 0, 0, 0); }
            }
            ss += __shfl_xor(ss, 16); ss += __shfl_xor(ss, 32);
            const float rinv = __builtin_amdgcn_rsqf(ss * (1.0f / DM) + RMS_EPS);
            const float gb = gbias[r];
#pragma unroll
            for (int i = 0; i < 4; ++i) { const int m = 4 * g + i; const float rv = __shfl(rinv, m & 7); if (g < 2) Gt[(size_t)(rb * 8 + m) * 16 + r] = acc[i] * rv + gb; }
            if (lane < 8) r1[rb * 8 + lane] = rinv;
        }
    }
}
__device__ __forceinline__ void p1_filters(const Ctx& C, LAS unsigned char* lds, int G, int wv) {
    int tid = (wv << 6) | lane_id_opaque(); asm volatile("" : "+v"(tid));
    const int lane = tid & 63, w = tid >> 6, r = lane & 15, g = lane >> 4;
    const float* w3 = C.in[11]; const float* h2 = (const float*)(C.ws + WS_H2); float* FILT = (float*)(C.ws + WS_FILT);
    for (int item = blockIdx.x; item < 256; item += G) {
        const int n0 = 64 * (item >> 2), t0 = 1024 * (item & 3) + 128 * w;
        bf16x8 af[4][2];
#pragma unroll
        for (int mt = 0; mt < 4; ++mt)
#pragma unroll
            for (int ks = 0; ks < 2; ++ks) { float v[8];
#pragma unroll
                for (int e = 0; e < 8; ++e) v[e] = w3[(size_t)(32 * ks + 8 * g + e) * NFILT + n0 + 16 * mt + r];
                u32x4 o; o.x = pk2(v[0], v[1]); o.y = pk2(v[2], v[3]); o.z = pk2(v[4], v[5]); o.w = pk2(v[6], v[7]); af[mt][ks] = __builtin_bit_cast(bf16x8, o); }
        float dl[4][4];
#pragma unroll
        for (int mt = 0; mt < 4; ++mt)
#pragma unroll
            for (int i = 0; i < 4; ++i) { const int ch = (n0 + 16 * mt + 4 * g + i) & 1023; const float mind = -3.0701134573253945f, maxd = -15.350567286626973f;
                dl[mt][i] = fabsf(mind + (float)ch * ((maxd - mind) / 1023.0f)); }
        bf16x8 bfr[8][2];
#pragma unroll
        for (int nt = 0; nt < 8; ++nt) { const int t = t0 + 16 * nt + r;
#pragma unroll
            for (int ks = 0; ks < 2; ++ks) { const f32x4 a = *(const f32x4*)(h2 + (size_t)t * 64 + 32 * ks + 8 * g), b = *(const f32x4*)(h2 + (size_t)t * 64 + 32 * ks + 8 * g + 4);
                u32x4 o; o.x = pk2(a.x, a.y); o.y = pk2(a.z, a.w); o.z = pk2(b.x, b.y); o.w = pk2(b.z, b.w); bfr[nt][ks] = __builtin_bit_cast(bf16x8, o); } }
#pragma unroll
        for (int nt = 0; nt < 8; ++nt) {
            const int t = t0 + 16 * nt + r;
            const float tl = (float)t / (float)(SEQ - 1);
#pragma unroll
            for (int mt = 0; mt < 4; ++mt) {
                f32x4 acc = {0.f, 0.f, 0.f, 0.f};
                acc = __builtin_amdgcn_mfma_f32_16x16x32_bf16(af[mt][0], bfr[nt][0], acc, 0, 0, 0);
                acc = __builtin_amdgcn_mfma_f32_16x16x32_bf16(af[mt][1], bfr[nt][1], acc, 0, 0, 0);
#pragma unroll
                for (int i = 0; i < 4; ++i) FILT[(size_t)(n0 + 16 * mt + 4 * g + i) * SEQ + t] = acc[i] * __expf(-tl * dl[mt][i]);
            }
        }
    }
}
__device__ __forceinline__ void p7_final(const Ctx& C, int G, int wv) {
    int tid = (wv << 6) | lane_id_opaque(); asm volatile("" : "+v"(tid));
    const int lane = tid & 63, wave = tid >> 6, gw = blockIdx.x * 8 + wave, NGW = G * 8;
    const float* ss3 = (const float*)(C.ws + WS_SS3); const float* wf = C.in[20];
    f32x4 w[8];
#pragma unroll
    for (int j = 0; j < 8; ++j) w[j] = ((const f32x4*)wf)[64 * j + lane];
    for (int row = gw; row < TOK; row += 2 * NGW) {
        const int row2 = row + NGW;
        const bool has2 = row2 < TOK;
        const float r = __builtin_amdgcn_rsqf(ss3[row] * (1.0f / DM) + RMS_EPS), r2 = has2 ? __builtin_amdgcn_rsqf(ss3[row2] * (1.0f / DM) + RMS_EPS) : 0.f;
        f32x4* p = (f32x4*)(C.out + (size_t)row * DM) + lane; f32x4* p2 = (f32x4*)(C.out + (size_t)(has2 ? row2 : row) * DM) + lane;
        f32x4 v[8], u[8];
#pragma unroll
        for (int j = 0; j < 8; ++j) { v[j] = p[64 * j]; u[j] = p2[64 * j]; }
#pragma unroll
        for (int j = 0; j < 8; ++j) p[64 * j] = v[j] * r * w[j];
        if (has2) {
#pragma unroll
            for (int j = 0; j < 8; ++j) p2[64 * j] = u[j] * r2 * w[j]; }
    }
}
#ifndef FFT_HOST
#define FFT_DEV __device__ __forceinline__
#define FFT_PTR LAS f32x2*
#define FFT_SIN(x) __builtin_amdgcn_sinf(x)
#define FFT_COS(x) __builtin_amdgcn_cosf(x)
#else
#define FFT_DEV static inline
#define FFT_PTR f32x2*
#define FFT_SIN(x) sinf(6.283185307179586f * (x))
#define FFT_COS(x) cosf(6.283185307179586f * (x))
#endif
#define PADI(i) ((i) + ((i) >> 4))
FFT_DEV f32x2 cmul(f32x2 a, f32x2 b) { const f32x2 bs = (f32x2){-b.y, b.x}; return (f32x2){a.x, a.x} * b + (f32x2){a.y, a.y} * bs; }
FFT_DEV f32x2 cmulc(f32x2 a, f32x2 b) { return (f32x2){a.x, a.x} * (f32x2){b.x, -b.y} + (f32x2){a.y, a.y} * (f32x2){b.y, b.x}; }
FFT_DEV f32x2 twid(float frac) { f32x2 r; r.x = FFT_COS(frac); r.y = -FFT_SIN(frac); return r; }
template <int M, int CJ> FFT_DEV f32x2 rot8(f32x2 d) {
    const float R = 0.70710678118654752f; f32x2 r;
    if (M == 0) return d;
    if (M == 2) { if (!CJ) { r.x = d.y; r.y = -d.x; } else { r.x = -d.y; r.y = d.x; } return r; }
    if (M == 1) { if (!CJ) { r.x = R * (d.x + d.y); r.y = R * (d.y - d.x); } else { r.x = R * (d.x - d.y); r.y = R * (d.x + d.y); } return r; }
    if (!CJ) { r.x = R * (d.y - d.x); r.y = -R * (d.x + d.y); } else { r.x = -R * (d.x + d.y); r.y = R * (d.x - d.y); } return r;
}
template <int INV, int ZHI, int LOW> FFT_DEV void fft_r8_pass(FFT_PTR buf, int s, int ls  , int tid) {
#pragma unroll 1
    for (int rep = 0; rep < 2; ++rep) {
        const int bf = tid + rep * 512, j = bf & (s - 1), blk = bf >> ls, base = blk * 8 * s + j;
        f32x2 x[8];
#pragma unroll
        for (int m = 0; m < (ZHI ? 4 : 8); ++m) x[m] = buf[PADI(base + m * s)];
        f32x2 w1 = twid((float)j / (float)(8 * s));
        f32x2 w2 = cmul(w1, w1), w4 = cmul(w2, w2);
        if (!INV) {
            if (ZHI) {
                x[4] = cmul(x[0], w1); x[5] = cmul(rot8<1, 0>(x[1]), w1); x[6] = cmul(rot8<2, 0>(x[2]), w1); x[7] = cmul(rot8<3, 0>(x[3]), w1);
            } else {
                { f32x2 a = x[0], b = x[4]; x[0] = a + b; x[4] = cmul(a - b, w1); }
                { f32x2 a = x[1], b = x[5]; x[1] = a + b; x[5] = cmul(rot8<1, 0>(a - b), w1); }
                { f32x2 a = x[2], b = x[6]; x[2] = a + b; x[6] = cmul(rot8<2, 0>(a - b), w1); }
                { f32x2 a = x[3], b = x[7]; x[3] = a + b; x[7] = cmul(rot8<3, 0>(a - b), w1); }
            }
#pragma unroll
            for (int h = 0; h < 8; h += 4) {
                { f32x2 a = x[h], b = x[h + 2]; x[h] = a + b; x[h + 2] = cmul(a - b, w2); }
                { f32x2 a = x[h + 1], b = x[h + 3]; x[h + 1] = a + b; x[h + 3] = cmul(rot8<2, 0>(a - b), w2); }
            }
#pragma unroll
            for (int m = 0; m < 8; m += 2) { f32x2 a = x[m], b = x[m + 1]; x[m] = a + b; x[m + 1] = cmul(a - b, w4); }
        } else {
#pragma unroll
            for (int m = 0; m < 8; m += 2) { f32x2 a = x[m], b = cmulc(x[m + 1], w4); x[m] = a + b; x[m + 1] = a - b; }
#pragma unroll
            for (int h = 0; h < 8; h += 4) {
                { f32x2 a = x[h], b = cmulc(x[h + 2], w2); x[h] = a + b; x[h + 2] = a - b; }
                { f32x2 a = x[h + 1], b = rot8<2, 1>(cmulc(x[h + 3], w2)); x[h + 1] = a + b; x[h + 3] = a - b; }
            }
            { f32x2 a = x[0], b = cmulc(x[4], w1); x[0] = a + b; if (!LOW) x[4] = a - b; }
            { f32x2 a = x[1], b = rot8<1, 1>(cmulc(x[5], w1)); x[1] = a + b; if (!LOW) x[5] = a - b; }
            { f32x2 a = x[2], b = rot8<2, 1>(cmulc(x[6], w1)); x[2] = a + b; if (!LOW) x[6] = a - b; }
            { f32x2 a = x[3], b = rot8<3, 1>(cmulc(x[7], w1)); x[3] = a + b; if (!LOW) x[7] = a - b; }
        }
#pragma unroll
        for (int m = 0; m < (LOW ? 4 : 8); ++m) buf[PADI(base + m * s)] = x[m];
    }
}
FFT_DEV void fft_r2_span1(FFT_PTR buf, int tid) {
#pragma unroll
    for (int rep = 0; rep < 8; ++rep) { const int p = 2 * (tid + rep * 512); f32x2 a = buf[PADI(p)], b = buf[PADI(p + 1)]; buf[PADI(p)] = a + b; buf[PADI(p + 1)] = a - b; }
}
template <int J, int CJ> FFT_DEV f32x2 rot16(f32x2 d) {
    const float C1 = 0.92387953251128674f, S1 = 0.38268343236508977f;
    if ((J & 1) == 0) return rot8<J / 2, CJ>(d);
    const float wr = (J == 1) ? C1 : (J == 3) ? S1 : (J == 5) ? -S1 : -C1;
    const float wi = ((J == 1) ? -S1 : (J == 3) ? -C1 : (J == 5) ? -C1 : -S1) * (CJ ? -1.f : 1.f);
    f32x2 r; r.x = d.x * wr - d.y * wi; r.y = d.x * wi + d.y * wr; return r;
}
FFT_DEV unsigned brev13(unsigned p);
FFT_DEV void fft16_dif(f32x2 (&x)[16]) {
#define BF_(i, j, ROT) { const f32x2 a_ = x[i], b_ = x[j]; x[i] = a_ + b_; x[j] = ROT(a_ - b_); }
    BF_(0, 8, (rot16<0, 0>)) BF_(1, 9, (rot16<1, 0>)) BF_(2, 10, (rot16<2, 0>)) BF_(3, 11, (rot16<3, 0>)) BF_(4, 12, (rot16<4, 0>)) BF_(5, 13, (rot16<5, 0>)) BF_(6, 14, (rot16<6, 0>)) BF_(7, 15, (rot16<7, 0>))
#pragma unroll
    for (int h = 0; h < 16; h += 8) { BF_(h + 0, h + 4, (rot8<0, 0>)) BF_(h + 1, h + 5, (rot8<1, 0>)) BF_(h + 2, h + 6, (rot8<2, 0>)) BF_(h + 3, h + 7, (rot8<3, 0>)) }
#pragma unroll
    for (int h = 0; h < 16; h += 4) { BF_(h + 0, h + 2, (rot8<0, 0>)) BF_(h + 1, h + 3, (rot8<2, 0>)) }
#pragma unroll
    for (int h = 0; h < 16; h += 2) { BF_(h, h + 1, (rot8<0, 0>)) }
#undef BF_
}
FFT_DEV void fft16_dit_inv(f32x2 (&x)[16]) {
#define BI_(i, j, ROT) { const f32x2 a_ = x[i], b_ = ROT(x[j]); x[i] = a_ + b_; x[j] = a_ - b_; }
#pragma unroll
    for (int h = 0; h < 16; h += 2) { BI_(h, h + 1, (rot8<0, 1>)) }
#pragma unroll
    for (int h = 0; h < 16; h += 4) { BI_(h + 0, h + 2, (rot8<0, 1>)) BI_(h + 1, h + 3, (rot8<2, 1>)) }
#pragma unroll
    for (int h = 0; h < 16; h += 8) { BI_(h + 0, h + 4, (rot8<0, 1>)) BI_(h + 1, h + 5, (rot8<1, 1>)) BI_(h + 2, h + 6, (rot8<2, 1>)) BI_(h + 3, h + 7, (rot8<3, 1>)) }
    BI_(0, 8, (rot16<0, 1>)) BI_(1, 9, (rot16<1, 1>)) BI_(2, 10, (rot16<2, 1>)) BI_(3, 11, (rot16<3, 1>)) BI_(4, 12, (rot16<4, 1>)) BI_(5, 13, (rot16<5, 1>)) BI_(6, 14, (rot16<6, 1>)) BI_(7, 15, (rot16<7, 1>))
#undef BI_
}
template <int MODE> FFT_DEV void fft_mid_pass(FFT_PTR wb, FFT_PTR zk, int tid) {
    f32x2 x[16];
#pragma unroll
    for (int e = 0; e < 16; ++e) x[e] = wb[PADI(16 * tid + e)];
    fft16_dif(x);
    if (MODE != 0) {
#pragma unroll
        for (int e = 0; e < 16; ++e) {
            const unsigned p = 16u * (unsigned)tid + (unsigned)e, f = brev13(p), fn = (8192u - f) & 8191u, pn = brev13(fn);
            const f32x2 zf = zk[PADI(p)], zn = zk[PADI(pn)];
            f32x2 kf;
            if (MODE == 1) { kf.x = 0.5f * (zf.x + zn.x); kf.y = 0.5f * (zf.y - zn.y); }
            else           { kf.x = 0.5f * (zf.y + zn.y); kf.y = 0.5f * (zn.x - zf.x); }
            x[e] = cmul(x[e], kf);
        }
        fft16_dit_inv(x);
    }
#pragma unroll
    for (int e = 0; e < 16; ++e) wb[PADI(16 * tid + e)] = x[e];
}
#ifndef FFT_HOST
#define FFT_SYNC() do { asm volatile("s_waitcnt lgkmcnt(0)" ::: "memory"); __builtin_amdgcn_s_barrier(); asm volatile("" ::: "memory"); } while (0)
__device__ __forceinline__ void fft_fwd_full(FFT_PTR buf, int tid) {
    FFT_SYNC(); fft_r8_pass<0, 0, 0>(buf, 1024, 10, tid); FFT_SYNC(); fft_r8_pass<0, 0, 0>(buf, 128, 7, tid); FFT_SYNC(); fft_r8_pass<0, 0, 0>(buf, 16, 4, tid); FFT_SYNC();
    fft_mid_pass<0>(buf, buf, tid); FFT_SYNC();
}
template <int WHICH> __device__ __forceinline__ void fft_conv(FFT_PTR wb, FFT_PTR zk, int tid) {
    FFT_SYNC(); fft_r8_pass<0, 1, 0>(wb, 1024, 10, tid); FFT_SYNC(); fft_r8_pass<0, 0, 0>(wb, 128, 7, tid); FFT_SYNC(); fft_r8_pass<0, 0, 0>(wb, 16, 4, tid); FFT_SYNC();
    fft_mid_pass<1 + WHICH>(wb, zk, tid); FFT_SYNC();
    fft_r8_pass<1, 0, 0>(wb, 16, 4, tid); FFT_SYNC(); fft_r8_pass<1, 0, 0>(wb, 128, 7, tid); FFT_SYNC(); fft_r8_pass<1, 0, 1>(wb, 1024, 10, tid); FFT_SYNC();
}
#endif
FFT_DEV unsigned brev13(unsigned p) {
    unsigned r = 0;
#ifndef FFT_HOST
    r = __brev(p) >> 19;
#else
    for (int i = 0; i < 13; ++i) r |= ((p >> i) & 1u) << (12 - i);
#endif
    return r;
}
FFT_DEV void fft_pointwise(FFT_PTR wb, FFT_PTR zk, int which, int tid) {
#pragma unroll 4
    for (int rep = 0; rep < 16; ++rep) {
        const unsigned p = tid + rep * 512, f = brev13(p), fn = (8192u - f) & 8191u, pn = brev13(fn);
        const f32x2 zf = zk[PADI(p)], zn = zk[PADI(pn)];
        f32x2 kf;
        if (which == 0) { kf.x = 0.5f * (zf.x + zn.x); kf.y = 0.5f * (zf.y - zn.y); }
        else            { kf.x = 0.5f * (zf.y + zn.y); kf.y = 0.5f * (zn.x - zf.x); }
        wb[PADI(p)] = cmul(wb[PADI(p)], kf);
    }
}
__device__ __forceinline__ void qk_prepass(const Ctx& C, int G, int wv) {
    int tid = (wv << 6) | lane_id_opaque(); asm volatile("" : "+v"(tid));
    const bf16_t* R1A = (const bf16_t*)(C.ws + WS_R1A); bf16_t* QKP = (bf16_t*)(C.ws + WS_QKP);
    const float* cw = C.in[3]; const float* cb = C.in[4];
    const int cg8 = tid & 255, half = tid >> 8, col = 8 * cg8;
    float k0[8], k1[8], k2[8], kb[8];
    { const int ch = 3072 + col;
      const f32x4 t0 = *(const f32x4*)(cw + ch), t1 = *(const f32x4*)(cw + ch + 4), t2 = *(const f32x4*)(cw + CONVC + ch), t3 = *(const f32x4*)(cw + CONVC + ch + 4);
      const f32x4 t4 = *(const f32x4*)(cw + 2 * CONVC + ch), t5 = *(const f32x4*)(cw + 2 * CONVC + ch + 4), t6 = *(const f32x4*)(cb + ch), t7 = *(const f32x4*)(cb + ch + 4);
#pragma unroll
      for (int e = 0; e < 4; ++e) { k0[e] = t0[e]; k0[4 + e] = t1[e]; k1[e] = t2[e]; k1[4 + e] = t3[e]; k2[e] = t4[e]; k2[4 + e] = t5[e]; kb[e] = t6[e]; kb[4 + e] = t7[e]; } }
    const float osc = col >= 1024 ? 0.0625f : 1.0f;
    for (int run = blockIdx.x; run < TOK / 64; run += G) {
        const int row0 = run * 64 + half * 32;
#pragma unroll 1
        for (int i0 = 0; i0 < 32; i0 += 4) {
            u32x4 w0[4], w1[4], w2[4];
#pragma unroll
            for (int u = 0; u < 4; ++u) { const int row = row0 + i0 + u, t = row & (SEQ - 1); const bf16_t* p = R1A + (size_t)row * 2048 + col;
                w0[u] = *(const u32x4*)(t > 0 ? p - 2048 : p); w1[u] = *(const u32x4*)p; w2[u] = *(const u32x4*)(t < SEQ - 1 ? p + 2048 : p); }
#pragma unroll
            for (int u = 0; u < 4; ++u) { const int row = row0 + i0 + u, t = row & (SEQ - 1);
                const u32x4 z = {0u, 0u, 0u, 0u}; if (t == 0) w0[u] = z; if (t == SEQ - 1) w2[u] = z;
                float a0[8], a1[8], a2[8]; unpack8(w0[u], a0); unpack8(w1[u], a1); unpack8(w2[u], a2);
                float v[8];
#pragma unroll
                for (int e = 0; e < 8; ++e) v[e] = siluf_(k0[e] * a0[e] + k1[e] * a1[e] + k2[e] * a2[e] + kb[e]) * osc;
                u32x4 o; o.x = pk2(v[0], v[1]); o.y = pk2(v[2], v[3]); o.z = pk2(v[4], v[5]); o.w = pk2(v[6], v[7]);
                *(u32x4*)(QKP + (size_t)row * 2048 + col) = o; }
        }
    }
}
constexpr int ML_KS = 0, ML_KP = 528, ML_SS = 76032, ML_SP = 272, ML_VS = 110848, ML_VP = 80, ML_VW = 121088, ML_CS = 131328, ML_CP = 528, ML_SC = 148224;
static_assert(ML_SC + 4352 <= LDS_BYTES - 16, "mLSTM LDS map");
__device__ __forceinline__ bf16x8 tr_read2(unsigned a0, unsigned a1) {
    bf16x4 lo, hi;
    asm volatile("ds_read_b64_tr_b16 %0, %2\n\tds_read_b64_tr_b16 %1, %3\n\ts_waitcnt lgkmcnt(0)" : "=&v"(lo), "=&v"(hi) : "v"(a0), "v"(a1) : "memory");
    bf16x8 r; r[0] = lo[0]; r[1] = lo[1]; r[2] = lo[2]; r[3] = lo[3]; r[4] = hi[0]; r[5] = hi[1]; r[6] = hi[2]; r[7] = hi[3]; return r;
}
__device__ __forceinline__ bf16x8 cat4(bf16x4 lo, bf16x4 hi) { bf16x8 r; r[0] = lo[0]; r[1] = lo[1]; r[2] = lo[2]; r[3] = lo[3]; r[4] = hi[0]; r[5] = hi[1]; r[6] = hi[2]; r[7] = hi[3]; return r; }
__device__ __forceinline__ void tr_read2x2(unsigned a, unsigned b, unsigned d, bf16x8& ra, bf16x8& rb) {
    bf16x4 l0, h0, l1, h1;
    asm volatile("ds_read_b64_tr_b16 %0, %4\n\tds_read_b64_tr_b16 %1, %5\n\tds_read_b64_tr_b16 %2, %6\n\tds_read_b64_tr_b16 %3, %7\n\ts_waitcnt lgkmcnt(0)"
        : "=&v"(l0), "=&v"(h0), "=&v"(l1), "=&v"(h1) : "v"(a), "v"(a + d), "v"(b), "v"(b + d) : "memory");
    ra = cat4(l0, h0); rb = cat4(l1, h1);
}
__device__ __forceinline__ void tr_read4x2(unsigned a, unsigned b, unsigned d, unsigned c, unsigned e, unsigned d2, bf16x8& ra, bf16x8& rb, bf16x8& rc, bf16x8& re) {
    bf16x4 l0, h0, l1, h1, l2, h2, l3, h3;
    asm volatile("ds_read_b64_tr_b16 %0, %8\n\tds_read_b64_tr_b16 %1, %9\n\tds_read_b64_tr_b16 %2, %10\n\tds_read_b64_tr_b16 %3, %11\n\t"
                 "ds_read_b64_tr_b16 %4, %12\n\tds_read_b64_tr_b16 %5, %13\n\tds_read_b64_tr_b16 %6, %14\n\tds_read_b64_tr_b16 %7, %15\n\ts_waitcnt lgkmcnt(0)"
        : "=&v"(l0), "=&v"(h0), "=&v"(l1), "=&v"(h1), "=&v"(l2), "=&v"(h2), "=&v"(l3), "=&v"(h3)
        : "v"(a), "v"(a + d), "v"(b), "v"(b + d), "v"(c), "v"(c + d2), "v"(e), "v"(e + d2) : "memory");
    ra = cat4(l0, h0); rb = cat4(l1, h1); rc = cat4(l2, h2); re = cat4(l3, h3);
}
__device__ __forceinline__ float bf2f(short s) { return __uint_as_float(((unsigned)(unsigned short)s) << 16); }
__device__ __forceinline__ float logsigmoidf_(float x) { return fminf(x, 0.f) - log1pf(expf(-fabsf(x))); }

__device__ __forceinline__ void mlstm_item(const Ctx& C, LAS unsigned char* lds, int item, int wv) {
    int tid = (wv << 6) | lane_id_opaque(); asm volatile("" : "+v"(tid));
    const int lane = tid & 63, w = __builtin_amdgcn_readfirstlane(tid >> 6), r = lane & 15, g = lane >> 4, q4 = r >> 2, p4 = r & 3;
    const int xcd_ = item & 7, yy_ = item >> 3, vs = yy_ & 7, dir = (yy_ >> 3) & 1, bh = 2 * xcd_ + (yy_ >> 4), b = bh >> 2, h = bh & 3;
    const bf16_t* QKP = (const bf16_t*)(C.ws + WS_QKP); const bf16_t* R1B = (const bf16_t*)(C.ws + WS_R1B); const float* Gt = (const float*)(C.ws + WS_G);
    bf16_t* Y = (bf16_t*)(C.ws + (dir ? WS_YBB : WS_YBF));
    LAS float* SC = (LAS float*)(lds + ML_SC);
    LAS float* s_cs = SC, *s_rj = SC + 128, *s_iw = SC + 256, *s_emj = SC + 384, *s_w0 = SC + 512, *s_w1 = SC + 960, *s_dn = SC + 640, *s_misc = SC + 768;
    LAS float* c_bl = SC + 784, *c_mx = SC + 816, *c_mp = SC + 848, *c_mn = SC + 880, *c_kp = SC + 912;
    float* GS = (float*)(C.ws + WS_GSC) + (size_t)item * 3 * SEQ;
    const unsigned lbase = (unsigned)(size_t)lds;
    const int pc = tid & 31, krow = tid >> 5, vrow = tid >> 2, pv = tid & 3;
    const int sw = w < 4 ? w : 11 - w;
    for (int i = tid; i < 16896 / 4; i += 512) ((LAS unsigned*)(lds + ML_CS))[i] = 0u;
    for (int i = tid; i < 16 * ML_KP / 4; i += 512) ((LAS unsigned*)(lds + ML_KS + 128 * ML_KP))[i] = 0u;
    f32x4 Cacc[3][2];
#pragma unroll
    for (int a = 0; a < 3; ++a) { Cacc[a][0] = (f32x4){0.f, 0.f, 0.f, 0.f}; Cacc[a][1] = (f32x4){0.f, 0.f, 0.f, 0.f}; }
    u32x4 kreg[8], vreg, qn[8]; float bn = 0.f, csn = 0.f, pmn = 0.f;
#define ML_TOK(c_, j_) ((size_t)b * SEQ + (dir ? SEQ - 1 - ((c_) * 128 + (j_)) : ((c_) * 128 + (j_))))
#define ML_PREFETCH(c_) do { \
        _Pragma("unroll") for (int i = 0; i < 8; ++i) kreg[i] = *(const u32x4*)(QKP + ML_TOK(c_, krow + 16 * i) * 2048 + 1024 + h * 256 + 8 * pc); \
        vreg = *(const u32x4*)(R1B + ML_TOK(c_, vrow) * 2048 + h * 256 + vs * 32 + 8 * pv); \
        { const bf16_t* qp = QKP + ML_TOK(c_, 16 * sw + r) * 2048 + h * 256 + 8 * g; _Pragma("unroll") for (int kk = 0; kk < 8; ++kk) qn[kk] = *(const u32x4*)(qp + 32 * kk); } \
        if (tid < 128) { const int ta = (c_) * 128 + tid; bn = GS[ta]; csn = GS[SEQ + ta]; pmn = GS[2 * SEQ + ta]; } } while (0)
    {
        float gi[8], gf[8];
#pragma unroll
        for (int u = 0; u < 8; ++u) { const int ta = (4 * w) * 128 + u * 64 + lane; const size_t tk = (size_t)b * SEQ + (dir ? SEQ - 1 - ta : ta);
            gi[u] = Gt[tk * 16 + (dir * 2) * 4 + h]; gf[u] = Gt[tk * 16 + (dir * 2 + 1) * 4 + h]; }
#pragma unroll
        for (int q = 0; q < 4; ++q) {
            const int c = 4 * w + q; float carry_b = 0.f, carry_m = -3.0e38f;
#pragma unroll
            for (int hf = 0; hf < 2; ++hf) {
                const int ta = c * 128 + hf * 64 + lane;
                const float ip = gi[2 * q + hf], fp = gf[2 * q + hf];
                float xs = logsigmoidf_(fp);
#pragma unroll
                for (int o = 1; o < 64; o <<= 1) { const float y = __shfl_up(xs, o); if (lane >= o) xs += y; }
                const float bj = xs + carry_b; const float cj = ip - bj; float pm = cj;
#pragma unroll
                for (int o = 1; o < 64; o <<= 1) { const float y = __shfl_up(pm, o); if (lane >= o) pm = fmaxf(pm, y); }
                pm = fmaxf(pm, carry_m);
                GS[ta] = bj; GS[SEQ + ta] = cj; GS[2 * SEQ + ta] = pm;
                carry_b = __shfl(bj, 63); carry_m = __shfl(pm, 63);
            }
            if (lane == 0) { c_bl[c] = carry_b; c_mx[c] = carry_m; }
        }
        __syncthreads();
        if (tid == 0) { float m = 0.f;
            for (int c = 0; c < 32; ++c) { const float bl = c_bl[c], mn = fmaxf(bl + m, bl + c_mx[c]); c_mp[c] = m; c_mn[c] = mn; c_kp[c] = __expf(bl + m - mn); m = mn; } }
        __syncthreads();
    }
#define ML_SCALARS(cc, swp) do { if (tid < 128) { const float mp_ = c_mp[cc], mn_ = c_mn[cc], bl_ = c_bl[cc]; const float inter = bn + mp_, mj = fmaxf(inter, bn + pmn); \
        s_cs[tid] = csn; s_rj[tid] = bn - mj; s_iw[tid] = __expf(inter - mj); s_emj[tid] = __expf(-mj); (swp)[tid] = __expf(bl_ + csn - mn_); } } while (0)
    ML_PREFETCH(0);
    ML_SCALARS(0, s_w0);
    __syncthreads();
#define ML_BAR() do { asm volatile("s_waitcnt lgkmcnt(0)" ::: "memory"); __builtin_amdgcn_s_barrier(); asm volatile("" ::: "memory"); } while (0)
#pragma unroll 1
    for (int c = 0; c < 32; ++c) {
        const float keep = c_kp[c]; LAS float* s_w = (c & 1) ? s_w1 : s_w0; LAS float* s_wn = (c & 1) ? s_w0 : s_w1;
#pragma unroll
        for (int i = 0; i < 8; ++i) *(LAS u32x4*)(lds + ML_KS + (krow + 16 * i) * ML_KP + pc * 16) = kreg[i];
        {
            *(LAS u32x4*)(lds + ML_VS + vrow * ML_VP + pv * 16) = vreg;
            float f[8]; unpack8(vreg, f); const float ws_ = s_w[vrow];
            u32x4 o; o.x = pk2(f[0] * ws_, f[1] * ws_); o.y = pk2(f[2] * ws_, f[3] * ws_); o.z = pk2(f[4] * ws_, f[5] * ws_); o.w = pk2(f[6] * ws_, f[7] * ws_);
            *(LAS u32x4*)(lds + ML_VW + vrow * ML_VP + pv * 16) = o;
        }
        bf16x8 qf[8];
#pragma unroll
        for (int kk = 0; kk < 8; ++kk) qf[kk] = __builtin_bit_cast(bf16x8, qn[kk]);
        unsigned short ogr[4][2];
#pragma unroll
        for (int i = 0; i < 4; ++i)
#pragma unroll
            for (int vt = 0; vt < 2; ++vt) ogr[i][vt] = R1B[ML_TOK(c, 16 * sw + 4 * g + i) * 2048 + 1024 + h * 256 + vs * 32 + 16 * vt + r];
        if (c < 31) ML_PREFETCH(c + 1);
        ML_BAR();
        {
            const float rjv = s_rj[16 * sw + r]; const int jloc = 16 * sw + r; float den1 = 0.f;
#pragma unroll 2
            for (int st = 0; st < 8; ++st) {
                if (st <= sw) {
                    f32x4 acc = {0.f, 0.f, 0.f, 0.f};
#pragma unroll
                    for (int kk = 0; kk < 8; ++kk) { const bf16x8 kf = *(const LAS bf16x8*)(lds + ML_KS + (16 * st + r) * ML_KP + (32 * kk + 8 * g) * 2); acc = __builtin_amdgcn_mfma_f32_16x16x32_bf16(kf, qf[kk], acc, 0, 0, 0); }
                    const f32x4 c4 = *(const LAS f32x4*)(s_cs + 16 * st + 4 * g);
                    float v[4];
#pragma unroll
                    for (int i = 0; i < 4; ++i) { const int s = 16 * st + 4 * g + i; const float d = (s <= jloc) ? __expf(rjv + c4[i]) : 0.f; v[i] = acc[i] * d; den1 += v[i]; }
                    u32x2 o; o.x = pk2(v[0], v[1]); o.y = pk2(v[2], v[3]);
                    *(LAS u32x2*)(lds + ML_SS + jloc * ML_SP + (16 * st + 4 * g) * 2) = o;
                } else if (st == sw + 1 && !(sw & 1)) {
                    u32x2 o = {0u, 0u}; *(LAS u32x2*)(lds + ML_SS + jloc * ML_SP + (16 * st + 4 * g) * 2) = o;
                }
            }
            den1 += __shfl_xor(den1, 16); den1 += __shfl_xor(den1, 32);
            f32x4 dacc = {0.f, 0.f, 0.f, 0.f};
#pragma unroll
            for (int kk = 0; kk < 8; ++kk) { const bf16x8 kf = *(const LAS bf16x8*)(lds + ML_KS + (128 + r) * ML_KP + (32 * kk + 8 * g) * 2); dacc = __builtin_amdgcn_mfma_f32_16x16x32_bf16(kf, qf[kk], dacc, 0, 0, 0); }
            const float d2 = dacc[0];
            if (g == 0) s_dn[jloc] = den1 + s_iw[jloc] * d2;
        }
        ML_BAR();
        {
            f32x4 n1[2], n2[2];
#pragma unroll
            for (int vt = 0; vt < 2; ++vt) { n1[vt] = (f32x4){0.f, 0.f, 0.f, 0.f}; n2[vt] = (f32x4){0.f, 0.f, 0.f, 0.f}; }
            const int nks = (sw >> 1) + 1;
#pragma unroll 1
            for (int ks = 0; ks < nks; ++ks) {
                const bf16x8 af = *(const LAS bf16x8*)(lds + ML_SS + (16 * sw + r) * ML_SP + (32 * ks + 8 * g) * 2);
                const unsigned a0 = lbase + ML_VS + (32 * ks + 8 * g + q4) * ML_VP + (4 * p4) * 2;
                bf16x8 b0, b1; tr_read2x2(a0, a0 + 32, 4 * ML_VP, b0, b1);
                n1[0] = __builtin_amdgcn_mfma_f32_16x16x32_bf16(af, b0, n1[0], 0, 0, 0); n1[1] = __builtin_amdgcn_mfma_f32_16x16x32_bf16(af, b1, n1[1], 0, 0, 0);
            }
#pragma unroll
            for (int kk = 0; kk < 8; ++kk)
#pragma unroll
                for (int vt = 0; vt < 2; ++vt) { const bf16x8 cf = *(const LAS bf16x8*)(lds + ML_CS + (16 * vt + r) * ML_CP + (32 * kk + 8 * g) * 2); n2[vt] = __builtin_amdgcn_mfma_f32_16x16x32_bf16(qf[kk], cf, n2[vt], 0, 0, 0); }
            const f32x4 iw4 = *(const LAS f32x4*)(s_iw + 16 * sw + 4 * g), dn4 = *(const LAS f32x4*)(s_dn + 16 * sw + 4 * g), em4 = *(const LAS f32x4*)(s_emj + 16 * sw + 4 * g);
#pragma unroll
            for (int i = 0; i < 4; ++i) {
                const size_t tok = ML_TOK(c, 16 * sw + 4 * g + i);
                const float inv = __builtin_amdgcn_rcpf(fmaxf(fabsf(dn4[i]), em4[i]));
#pragma unroll
                for (int vt = 0; vt < 2; ++vt) { const int col = h * 256 + vs * 32 + 16 * vt + r;
                    const float og = __uint_as_float(((unsigned)ogr[i][vt]) << 16);
                    const float hv = (n1[vt][i] + iw4[i] * n2[vt][i]) * inv * og;
                    Y[blk_off((int)tok, col, 1024)] = (bf16_t)pk2(hv, 0.f); }
            }
        }
        ML_BAR();
        {
#pragma unroll
            for (int a = 0; a < 3; ++a) { Cacc[a][0] *= keep; Cacc[a][1] *= keep; }
#pragma unroll 1
            for (int ks = 0; ks < 4; ++ks) {
                bf16x8 af[3], bq[2];
                { const unsigned av = lbase + ML_VW + (32 * ks + 8 * g + q4) * ML_VP + (4 * p4) * 2, ak = lbase + ML_KS + (32 * ks + 8 * g + q4) * ML_KP + (32 * w + 4 * p4) * 2;
                  tr_read4x2(av, av + 32, 4 * ML_VP, ak, ak + 32, 4 * ML_KP, af[0], af[1], bq[0], bq[1]); }
                { const f32x4 wa = *(const LAS f32x4*)(s_w + 32 * ks + 8 * g), wb = *(const LAS f32x4*)(s_w + 32 * ks + 8 * g + 4);
                  u32x4 o; o.x = pk2(wa[0], wa[1]); o.y = pk2(wa[2], wa[3]); o.z = pk2(wb[0], wb[1]); o.w = pk2(wb[2], wb[3]);
                  if (r != 0) { o.x = 0u; o.y = 0u; o.z = 0u; o.w = 0u; }
                  af[2] = __builtin_bit_cast(bf16x8, o); }
#pragma unroll
                for (int nt = 0; nt < 2; ++nt)
#pragma unroll
                    for (int mt = 0; mt < 3; ++mt) Cacc[mt][nt] = __builtin_amdgcn_mfma_f32_16x16x32_bf16(af[mt], bq[nt], Cacc[mt][nt], 0, 0, 0);
            }
#pragma unroll
            for (int mt = 0; mt < 2; ++mt)
#pragma unroll
                for (int nt = 0; nt < 2; ++nt)
#pragma unroll
                    for (int i = 0; i < 4; ++i) *(LAS bf16_t*)(lds + ML_CS + (16 * mt + 4 * g + i) * ML_CP + (32 * w + 16 * nt + r) * 2) = (bf16_t)pk2(Cacc[mt][nt][i], 0.f);
            if (c < 31) ML_SCALARS(c + 1, s_wn);
            if (g == 0) { *(LAS bf16_t*)(lds + ML_KS + 128 * ML_KP + (32 * w + r) * 2) = (bf16_t)pk2(Cacc[2][0][0], 0.f); *(LAS bf16_t*)(lds + ML_KS + 128 * ML_KP + (32 * w + 16 + r) * 2) = (bf16_t)pk2(Cacc[2][1][0], 0.f); }
        }
        ML_BAR();
    }
#undef ML_SCALARS
#undef ML_BAR
#undef ML_PREFETCH
#undef ML_TOK
}
constexpr int HY_ZK = 0, HY_WB = 69632;
static_assert(HY_WB + 69632 <= LDS_BYTES, "hyena LDS map");
#define GAS __attribute__((address_space(1)))
struct HyRaw { u32x4 c; unsigned l, r; };
__device__ __forceinline__ HyRaw hy_load(const bf16_t* rowp, int tid) { HyRaw x; const GAS bf16_t* p = (const GAS bf16_t*)rowp + 8 * tid; x.c = *(const GAS u32x4*)p; x.l = p[-1]; x.r = p[8]; return x; }
__device__ __forceinline__ void hy_conv8(const HyRaw& x, int tid, float w0, float w1, float w2, float bias, float (&o)[8]) {
    float a[10];
    a[0] = tid > 0 ? __uint_as_float(x.l << 16) : 0.f; a[9] = tid < 511 ? __uint_as_float(x.r << 16) : 0.f;
    a[1] = bflo(x.c.x); a[2] = bfhi(x.c.x); a[3] = bflo(x.c.y); a[4] = bfhi(x.c.y); a[5] = bflo(x.c.z); a[6] = bfhi(x.c.z); a[7] = bflo(x.c.w); a[8] = bfhi(x.c.w);
#pragma unroll
    for (int m = 0; m < 8; ++m) o[m] = w0 * a[m] + w1 * a[m + 1] + w2 * a[m + 2] + bias;
}
__device__ __forceinline__ void hyena_item(const Ctx& C, LAS unsigned char* lds, int ch, int wv) {
    int tid = (wv << 6) | lane_id_opaque(); asm volatile("" : "+v"(tid));
    LAS f32x2* zk = (LAS f32x2*)(lds + HY_ZK); LAS f32x2* wb = (LAS f32x2*)(lds + HY_WB);
    const float* FILT = (const float*)(C.ws + WS_FILT); const bf16_t* HYb = (const bf16_t*)(C.ws + WS_HY); bf16_t* YA = (bf16_t*)(C.ws + WS_YA);
    const float* cw = C.in[3]; const float* cb = C.in[4];
    float w0[3], w1[3], w2[3], bs[3];
#pragma unroll
    for (int s = 0; s < 3; ++s) { w0[s] = cw[s * 1024 + ch]; w1[s] = cw[CONVC + s * 1024 + ch]; w2[s] = cw[2 * CONVC + s * 1024 + ch]; bs[s] = cb[s * 1024 + ch]; }
    const float hb0 = C.in[12][ch], hb1 = C.in[12][1024 + ch];
    const float* F0 = FILT + (size_t)(0 * 1024 + ch) * SEQ; const float* F1 = FILT + (size_t)(1 * 1024 + ch) * SEQ;
    const float* F2 = FILT + (size_t)(2 * 1024 + ch) * SEQ; const float* F3 = FILT + (size_t)(3 * 1024 + ch) * SEQ;
    __syncthreads();
    {
        float fa[16], fb[16];
#pragma unroll
        for (int rep = 0; rep < 8; ++rep) { const int i = tid + 512 * rep; fa[rep] = F0[i]; fb[rep] = F2[i]; }
#pragma unroll
        for (int rep = 8; rep < 16; ++rep) { const int i = tid + 512 * rep; const int j = i == SEQ ? 1 : 2 * SEQ - i; fa[rep] = F1[j]; fb[rep] = F3[j]; }
        if (tid == 0) { fa[8] = 0.f; fb[8] = 0.f; }
#pragma unroll
        for (int rep = 0; rep < 16; ++rep) { const int i = tid + 512 * rep; zk[PADI(i)] = (f32x2){fa[rep] * (1.0f / 8192.0f), fb[rep] * (1.0f / 8192.0f)}; }
    }
    fft_fwd_full(zk, tid);
    const bf16_t* rv = HYb + (size_t)ch * TOK; const bf16_t* rx1 = HYb + (size_t)(1024 + ch) * TOK; const bf16_t* rx2 = HYb + (size_t)(2048 + ch) * TOK;
    HyRaw qa = hy_load(rv, tid), qb = hy_load(rv + SEQ, tid);
#pragma unroll 1
    for (int p = 0; p < 2; ++p) {
        const int tb0 = (2 * p) * SEQ, tb1 = (2 * p + 1) * SEQ;
        f32x2 vv[8], zz[8];
        { float va[8], vb[8]; hy_conv8(qa, tid, w0[0], w1[0], w2[0], bs[0], va); hy_conv8(qb, tid, w0[0], w1[0], w2[0], bs[0], vb);
#pragma unroll
          for (int m = 0; m < 8; ++m) { vv[m].x = va[m]; vv[m].y = vb[m]; wb[PADI(8 * tid + m)] = vv[m]; } }
        qa = hy_load(rx1 + tb0, tid); qb = hy_load(rx1 + tb1, tid);
        fft_conv<0>(wb, zk, tid);
        { float xa[8], xb_[8]; hy_conv8(qa, tid, w0[1], w1[1], w2[1], bs[1], xa); hy_conv8(qb, tid, w0[1], w1[1], w2[1], bs[1], xb_);
#pragma unroll
          for (int m = 0; m < 8; ++m) { const f32x2 y = wb[PADI(8 * tid + m)]; zz[m].x = xa[m] * (y.x + vv[m].x * hb0); zz[m].y = xb_[m] * (y.y + vv[m].y * hb0); }
#pragma unroll
          for (int m = 0; m < 8; ++m) wb[PADI(8 * tid + m)] = zz[m]; }
        qa = hy_load(rx2 + tb0, tid); qb = hy_load(rx2 + tb1, tid);
        fft_conv<1>(wb, zk, tid);
        { float xa[8], xb_[8]; hy_conv8(qa, tid, w0[2], w1[2], w2[2], bs[2], xa); hy_conv8(qb, tid, w0[2], w1[2], w2[2], bs[2], xb_);
          if (p == 0) { qa = hy_load(rv + 2 * SEQ, tid); qb = hy_load(rv + 3 * SEQ, tid); }
#pragma unroll
          for (int m = 0; m < 8; ++m) { const int t = 8 * tid + m; const f32x2 y = wb[PADI(t)];
              YA[blk_off(tb0 + t, ch, 1024)] = (bf16_t)f2bf(xa[m] * (y.x + zz[m].x * hb1));
              YA[blk_off(tb1 + t, ch, 1024)] = (bf16_t)f2bf(xb_[m] * (y.y + zz[m].y * hb1)); } }
        FFT_SYNC();
    }
}
#ifndef DUP_FILT
#define DUP_FILT 0
#endif
#ifndef DUP_PRE
#define DUP_PRE 0
#endif
#ifndef DUP_P0
#define DUP_P0 0
#endif
#ifndef DUP_ML
#define DUP_ML 0
#endif
#ifndef DUP_HY
#define DUP_HY 0
#endif
#ifndef DUP_REST
#define DUP_REST 0
#endif
#ifndef DUP_GU
#define DUP_GU 0
#endif
#define XB_TMO      128
#define XB_XCNT(j)  (256  + 64 * (j))
#define XB_XSUB(j)  (1280 + 64 * (j))
#define XB_XGEN(j)  (2304 + 64 * (j))
#define XB_TOP      3328
#define XB_TOPGEN   3392
#define XCD_BAR_WORDS 3456
#define XB_SPIN_CAP (1u << 22)
__device__ __forceinline__ unsigned xb_ld(unsigned* p)              { return __hip_atomic_load(p, __ATOMIC_RELAXED, __HIP_MEMORY_SCOPE_AGENT); }
__device__ __forceinline__ unsigned xb_add(unsigned* p, unsigned v) { return __hip_atomic_fetch_add(p, v, __ATOMIC_RELAXED, __HIP_MEMORY_SCOPE_AGENT); }
__device__ __forceinline__ unsigned xb_xcc_id() { return (unsigned)__builtin_amdgcn_s_getreg((3 << 11) | 20) & 0xFu; }
#define XB_SPIN(cond, bar) do { unsigned _sp = 0; while (cond) { __builtin_amdgcn_s_sleep(1); \
    if ((++_sp & 255u) == 0u) { if (xb_ld(&(bar)[XB_TMO])) break; if (_sp > XB_SPIN_CAP) { atomicAdd(&(bar)[XB_TMO], 1u); break; } } } } while (0)
__device__ __forceinline__ void xcd_barrier_complete(unsigned* bar, unsigned x, unsigned G, unsigned& nloc, unsigned& nx) {
    unsigned sum, cnt, mine, sp = 0u;
    for (;;) {
        sum = 0u; cnt = 0u; mine = 0u;
#pragma unroll
        for (unsigned j = 0; j < 16; ++j) { const unsigned c = xb_ld(&bar[XB_XCNT(j)]); sum += c; cnt += (c > 0u) ? 1u : 0u; mine = (j == x) ? c : mine; }
        if (sum == G) break;
        __builtin_amdgcn_s_sleep(1);
        if ((++sp & 255u) == 0u) { if (xb_ld(&bar[XB_TMO])) break; if (sp > XB_SPIN_CAP) { atomicAdd(&bar[XB_TMO], 1u); break; } }
    }
    nloc = mine > 0u ? mine : 1u; nx = cnt > 0u ? cnt : 1u;
}
__device__ __forceinline__ void grid_bar(unsigned* bar, volatile LAS unsigned* st, unsigned G, int wv) {
    asm volatile("s_waitcnt vmcnt(0)" ::: "memory");
    __syncthreads();
    const int lane = lane_id_opaque();
    if (wv == 0 && lane == 0) {
        __builtin_amdgcn_s_waitcnt(0);
        const unsigned x = xb_xcc_id();
        unsigned nloc = st[0], nx = st[1];
        if (nloc == 0u) { xcd_barrier_complete(bar, x, G, nloc, nx); st[0] = nloc; st[1] = nx; }
        const unsigned old = xb_add(&bar[XB_XSUB(x)], 1u);
        const unsigned gen = old / nloc;
        if (old + 1u == (gen + 1u) * nloc) {
            __builtin_amdgcn_fence(__ATOMIC_RELEASE, "agent");
            asm volatile("s_waitcnt vmcnt(0)" ::: "memory");
            const unsigned og = xb_add(&bar[XB_TOP], 1u);
            const unsigned tg = og / nx;
            if (og + 1u == (tg + 1u) * nx) xb_add(&bar[XB_TOPGEN], 1u);
            else XB_SPIN(xb_ld(&bar[XB_TOPGEN]) == tg, bar);
            __builtin_amdgcn_fence(__ATOMIC_ACQUIRE, "agent");
            xb_add(&bar[XB_XGEN(x)], 1u);
            asm volatile("s_waitcnt vmcnt(0)" ::: "memory");
        } else {
            XB_SPIN(xb_ld(&bar[XB_XGEN(x)]) == gen, bar);
            __builtin_amdgcn_fence(__ATOMIC_ACQUIRE, "agent");
            asm volatile("s_waitcnt vmcnt(0)" ::: "memory");
        }
    }
    __syncthreads();
}
__device__ __forceinline__ void p6_finalize(const Ctx& C, int G, int bx, int wv) {
    int tid = (wv << 6) | lane_id_opaque(); asm volatile("" : "+v"(tid));
    unsigned* pcnt = (unsigned*)(C.ws + WS_PCNT); const float* ss3 = (const float*)(C.ws + WS_SS3); const float* wf = C.in[20]; float* out = C.out;
    for (int i = 0; ; ++i) {
        const int L = i * G + bx; if (L + G >= 64 * 8) break; int pm, pn; pg8::tile_of(L, 64, 8, pm, pn);
        if (tid == 0) { unsigned sp = 0; while (xb_ld(&pcnt[64 * pm]) < 8u) { __builtin_amdgcn_s_sleep(1); if (++sp > (1u << 20)) break; }
            __builtin_amdgcn_fence(__ATOMIC_ACQUIRE, "agent"); asm volatile("s_waitcnt vmcnt(0)" ::: "memory"); }
        __syncthreads();
        const int c4 = tid & 63; const f32x4 wv4 = *(const f32x4*)(wf + 256 * pn + 4 * c4);
#pragma unroll 1
        for (int k0 = 0; k0 < 32; k0 += 8) {
            f32x4 v[8]; float rr[8];
#pragma unroll
            for (int k = 0; k < 8; ++k) { const int row = 256 * pm + (tid >> 6) + 8 * (k0 + k);
                v[k] = *(const f32x4*)(out + (size_t)row * DM + 256 * pn + 4 * c4);
                rr[k] = __hip_atomic_load(ss3 + row, __ATOMIC_RELAXED, __HIP_MEMORY_SCOPE_AGENT); }
#pragma unroll
            for (int k = 0; k < 8; ++k) { const int row = 256 * pm + (tid >> 6) + 8 * (k0 + k); const float r = __builtin_amdgcn_rsqf(rr[k] * (1.0f / DM) + RMS_EPS);
                *(f32x4*)(out + (size_t)row * DM + 256 * pn + 4 * c4) = v[k] * r * wv4; }
        }
    }
}
struct Params { const float* in[21]; float* out; unsigned char* ws; };
__global__ void __launch_bounds__(512, 2) fwd_megakernel(Params prm) {
    extern __shared__ __attribute__((aligned(16))) unsigned char lds_raw[];
    LAS unsigned char* lds = (LAS unsigned char*)lds_raw;
    cg::grid_group grid = cg::this_grid();
    const int G = gridDim.x, bx = blockIdx.x;
    const int wv = __builtin_amdgcn_readfirstlane((int)(threadIdx.x >> 6));
    Ctx C;
#pragma unroll
    for (int i = 0; i < 21; ++i) C.in[i] = prm.in[i];
    C.out = prm.out; C.ws = prm.ws;
    unsigned char* ws = prm.ws;
    unsigned* gbar = (unsigned*)(ws + WS_BAR);
    volatile LAS unsigned* bst = (volatile LAS unsigned*)(lds + LDS_BYTES - 16);
#ifndef DUP_BAR
#define DUP_BAR 0
#endif
#define GBAR() do { for (int rb_ = 0; rb_ < 1 + DUP_BAR; ++rb_) grid_bar(gbar, bst, (unsigned)G, wv); } while (0)
    if (bx == 0) for (int i = threadIdx.x; i < XCD_BAR_WORDS; i += 512) gbar[i] = 0u;
    if (bx == 1 || G == 1) for (int i = threadIdx.x; i < 64 * 64; i += 512) ((unsigned*)(ws + WS_PCNT))[i] = 0u;
    if (threadIdx.x < 4) ((LAS unsigned*)(lds + LDS_BYTES - 16))[threadIdx.x] = 0u;
    grid.sync();
    if (threadIdx.x == 0) (void)xb_add(&gbar[XB_XCNT(xb_xcc_id())], 1u);
    for (int rep = 0; rep < 1 + DUP_P0; ++rep) { p0_prologue(C, lds, G, wv); __syncthreads(); }
    GBAR();
    for (int rep = 0; rep < 1 + DUP_FILT; ++rep) p1_filters(C, lds, G, wv);
    { InProg P; P.K = DM; P.G = G; P.c = bx;
      P.H.K = DM; P.H.G = G; P.H.c = bx; P.H.W = (const bf16_t*)(ws + WS_WIN); P.H.X = (const bf16_t*)(ws + WS_XB); P.H.HY = (bf16_t*)(ws + WS_HY); P.H.r1 = (const float*)(ws + WS_R1S);
      P.R.K = DM; P.R.G = G; P.R.c = bx; P.R.W = (const bf16_t*)(ws + WS_WIN); P.R.X = (const bf16_t*)(ws + WS_XB); P.R.R1A = (bf16_t*)(ws + WS_R1A); P.R.R1B = (bf16_t*)(ws + WS_R1B); P.R.R2 = (bf16_t*)prm.out; P.R.r1 = (const float*)(ws + WS_R1S);
      pg8::gemm_stream(lds, P, wv); }
    GBAR();
    for (int rep = 0; rep < 1 + DUP_PRE; ++rep) qk_prepass(C, G, wv);
    for (int rep = 0; rep < 1 + DUP_HY; ++rep) for (int idx = bx; idx < 1024; idx += G) { const int rd = idx >> 8, bb = idx & 255; hyena_item(C, lds, rd * 256 + (bb & 7) * 32 + (bb >> 3), wv); }
    GBAR();
    for (int rep = 0; rep < 1 + DUP_ML; ++rep) for (int item = bx; item < 256; item += G) mlstm_item(C, lds, item, wv);
    GBAR();
    { BranchProg P; P.K = 1024; P.G = G; P.c = bx; P.YA = (const bf16_t*)(ws + WS_YA); P.YBF = (const bf16_t*)(ws + WS_YBF); P.YBB = (const bf16_t*)(ws + WS_YBB);
      P.WA = (const bf16_t*)(ws + WS_WA); P.WB = (const bf16_t*)(ws + WS_WB); P.R2 = (const bf16_t*)prm.out; P.MIX = (bf16_t*)(ws + WS_MIX);
      pg8::gemm_stream(lds, P, wv); }
    GBAR();
    { ResProg<false> P; P.pcnt = nullptr; P.wf = nullptr; P.K = DM; P.G = G; P.c = bx; P.A = (const bf16_t*)(ws + WS_MIX); P.B = (const bf16_t*)(ws + WS_WOUT); P.base = prm.in[0]; P.base16 = nullptr; P.out = nullptr; P.outb = (bf16_t*)(ws + WS_X1B); P.ss = (float*)(ws + WS_SS2);
      pg8::gemm_stream(lds, P, wv); }
    GBAR();
    for (int rep = 0; rep < 1 + DUP_GU; ++rep) { GuProg P; P.K = DM; P.G = G; P.c = bx; P.X = (const bf16_t*)(ws + WS_X1B); P.W = (const bf16_t*)(ws + WS_WGU); P.HH = (bf16_t*)(ws + WS_HH); P.ss2 = (const float*)(ws + WS_SS2);
      pg8::gemm_stream(lds, P, wv); }
    GBAR();
    { ResProg<true> P; P.pcnt = (unsigned*)(ws + WS_PCNT); P.wf = prm.in[20]; P.K = FFH; P.G = G; P.c = bx; P.A = (const bf16_t*)(ws + WS_HH); P.B = (const bf16_t*)(ws + WS_WD); P.base = nullptr; P.base16 = (const bf16_t*)(ws + WS_X1B); P.out = prm.out; P.outb = nullptr; P.ss = (float*)(ws + WS_SS3);
      pg8::gemm_stream(lds, P, wv); }
    p6_finalize(C, G, bx, wv);
}

extern "C" void kernel_launch(void* const* d_in, const int* in_sizes, int n_in, void* d_out, int out_size, void* d_ws, size_t ws_size, hipStream_t stream) {
    static int grid = 0;
    if (grid == 0) {
        int dev = 0, cus = 0, per_cu = 0;
        hipGetDevice(&dev); hipDeviceGetAttribute(&cus, hipDeviceAttributeMultiprocessorCount, dev);
        if (hipFuncSetAttribute((const void*)fwd_megakernel, hipFuncAttributeMaxDynamicSharedMemorySize, LDS_BYTES) != hipSuccess) { fprintf(stderr, "kernel_launch: hipFuncSetAttribute failed\n"); grid = -1; return; }
        if (hipOccupancyMaxActiveBlocksPerMultiprocessor(&per_cu, (const void*)fwd_megakernel, 512, LDS_BYTES) != hipSuccess || per_cu < 1) { fprintf(stderr, "kernel_launch: occupancy query gave %d\n", per_cu); per_cu = 1; }
        (void)hipGetLastError();
        grid = cus * 1;
        if (n_in != 21 || ws_size < WS_END) { fprintf(stderr, "kernel_launch: unexpected n_in %d or ws %zu\n", n_in, ws_size); grid = -1; return; }
    }
    if (grid < 0) return;
    Params p{};
    for (int i = 0; i < 21; ++i) p.in[i] = (const float*)d_in[i];
    p.out = (float*)d_out; p.ws = (unsigned char*)d_ws;
    void* args[] = {&p};
    hipError_t e = hipLaunchCooperativeKernel((const void*)fwd_megakernel, dim3(grid), dim3(512), args, LDS_BYTES, stream);
    if (e != hipSuccess) fprintf(stderr, "cooperative launch failed: %s (grid %d)\n", hipGetErrorString(e), grid);
}
```
